# Optimizing an MI355X kernel written in HIP

```python
import jax
import jax.numpy as jnp
from jax import lax
import numpy as np

D_MODEL = 1024
BATCH = 32
SEQ = 2048
DEPTH = 1

MLA_HEADS = 8
MLA_NOPE_DIM = 64
MLA_ROPE_DIM = 32
MLA_QK_DIM = MLA_NOPE_DIM + MLA_ROPE_DIM
MLA_V_DIM = 64
MLA_Q_LORA = 256
MLA_KV_LORA = 128
MLA_WIDTH = MLA_HEADS * MLA_V_DIM
MOBA_HEADS = 8
MOBA_HEAD_DIM = 64
MOBA_BLOCK = 256
MOBA_TOPK = 3
MOBA_WIDTH = MOBA_HEADS * MOBA_HEAD_DIM
MIX_WIDTH = MLA_WIDTH + MOBA_WIDTH
IN_SPLITS = [
    MLA_Q_LORA,
    MLA_Q_LORA + MLA_KV_LORA,
    MLA_Q_LORA + MLA_KV_LORA + MLA_ROPE_DIM,
    MLA_Q_LORA + MLA_KV_LORA + MLA_ROPE_DIM + MOBA_WIDTH,
    MLA_Q_LORA + MLA_KV_LORA + MLA_ROPE_DIM + 2 * MOBA_WIDTH,
]
IN_WIDTH = MLA_Q_LORA + MLA_KV_LORA + MLA_ROPE_DIM + 3 * MOBA_WIDTH
ROPE_THETA = 10000.0
NORM_EPS = 1e-6
ATTN_Q_BLOCK = 128
MOBA_Q_CHUNK = 16
N_GROUPS = 4
EXPERTS_PER_GROUP = 8
N_EXPERTS = N_GROUPS * EXPERTS_PER_GROUP
EXPERT_TOPK = 2
EXPERT_HIDDEN = 256
MOE_ROW_BLOCK = 256

kernel_name = 'hymba_style_mla_moba_hiermoe_block'


def rms_norm(x, g):
    xf = x.astype(jnp.float32)
    y = xf * lax.rsqrt(jnp.mean(xf * xf, axis=-1, keepdims=True) + NORM_EPS)
    return (y * g.astype(jnp.float32)).astype(x.dtype)


def rope_tables(seq, dim):
    inv_freq = ROPE_THETA ** (-(jnp.arange(0, dim, 2, dtype=jnp.float32) / dim))
    ang = jnp.arange(seq, dtype=jnp.float32)[:, None] * inv_freq[None, :]
    return jnp.cos(ang), jnp.sin(ang)


def apply_rope(x, cos, sin):
    x1, x2 = jnp.split(x, 2, axis=-1)
    c = cos[None, :, None, :].astype(x.dtype)
    s = sin[None, :, None, :].astype(x.dtype)
    return jnp.concatenate([x1 * c - x2 * s, x2 * c + x1 * s], axis=-1)


def causal_attention_blocked(q, k, v, scale):
    B, S, H, dq = q.shape
    n_qb = S // ATTN_Q_BLOCK
    q_blocks = q.reshape(B, n_qb, ATTN_Q_BLOCK, H, dq).transpose(1, 0, 2, 3, 4)
    k_pos = jnp.arange(S)

    def one_block(args):
        qi, bi = args
        s = jnp.einsum('bqhd,bkhd->bhqk', qi, k, preferred_element_type=jnp.float32) * scale
        q_pos = bi * ATTN_Q_BLOCK + jnp.arange(ATTN_Q_BLOCK)
        s = jnp.where(k_pos[None, :] <= q_pos[:, None], s, -jnp.inf)
        p = jax.nn.softmax(s, axis=-1).astype(v.dtype)
        return jnp.einsum('bhqk,bkhd->bqhd', p, v)

    out = lax.map(one_block, (q_blocks, jnp.arange(n_qb)))
    return out.transpose(1, 0, 2, 3, 4).reshape(B, S, H, v.shape[-1])


def moba_attention(q, k, v):
    B, S, H, d = q.shape
    nb = -(-S // MOBA_BLOCK)
    pad = nb * MOBA_BLOCK - S
    kp = jnp.pad(k, ((0, 0), (0, pad), (0, 0), (0, 0)))
    vp = jnp.pad(v, ((0, 0), (0, pad), (0, 0), (0, 0)))
    k_blocks = kp.reshape(B, nb, MOBA_BLOCK, H, d).transpose(0, 3, 1, 2, 4)
    v_blocks = vp.reshape(B, nb, MOBA_BLOCK, H, d).transpose(0, 3, 1, 2, 4)
    k_mean = jnp.mean(k_blocks.astype(jnp.float32), axis=3).astype(k.dtype)
    top_k = min(MOBA_TOPK, nb)
    n_chunks = S // MOBA_Q_CHUNK
    q_chunks = q.reshape(B, n_chunks, MOBA_Q_CHUNK, H, d).transpose(1, 0, 2, 3, 4)
    scale = d ** -0.5
    b_idx = jnp.arange(B)[:, None, None, None]
    h_idx = jnp.arange(H)[None, :, None, None]
    neg = jnp.finfo(jnp.float32).min
    blk_pos = jnp.arange(MOBA_BLOCK)

    def one_chunk(args):
        qi, ci = args
        q_start = ci * MOBA_Q_CHUNK
        q_pos = q_start + jnp.arange(MOBA_Q_CHUNK)
        cur = q_start // MOBA_BLOCK
        gate = jnp.einsum('bqhd,bhnd->bhqn', qi, k_mean, preferred_element_type=jnp.float32)
        gate = jnp.where(jnp.arange(nb) < cur, gate, neg)
        _, sel = lax.top_k(gate, top_k)
        slot_ok = jnp.arange(top_k) < cur
        k_sel = k_blocks[b_idx, h_idx, sel]
        v_sel = v_blocks[b_idx, h_idx, sel]
        s_sel = jnp.einsum('bqhd,bhqjkd->bhqjk', qi, k_sel, preferred_element_type=jnp.float32) * scale
        s_sel = jnp.where(slot_ok[:, None], s_sel, -jnp.inf)
        s_sel = s_sel.reshape(B, H, MOBA_Q_CHUNK, top_k * MOBA_BLOCK)
        k_own = lax.dynamic_index_in_dim(k_blocks, cur, axis=2, keepdims=False)
        v_own = lax.dynamic_index_in_dim(v_blocks, cur, axis=2, keepdims=False)
        s_own = jnp.einsum('bqhd,bhkd->bhqk', qi, k_own, preferred_element_type=jnp.float32) * scale
        k_pos = cur * MOBA_BLOCK + blk_pos
        s_own = jnp.where(k_pos[None, :] <= q_pos[:, None], s_own, -jnp.inf)
        p = jax.nn.softmax(jnp.concatenate([s_sel, s_own], axis=-1), axis=-1).astype(v.dtype)
        p_sel = p[..., : top_k * MOBA_BLOCK].reshape(B, H, MOBA_Q_CHUNK, top_k, MOBA_BLOCK)
        p_own = p[..., top_k * MOBA_BLOCK:]
        return (jnp.einsum('bhqjk,bhqjkd->bqhd', p_sel, v_sel)
                + jnp.einsum('bhqk,bhkd->bqhd', p_own, v_own))

    out = lax.map(one_chunk, (q_chunks, jnp.arange(n_chunks)))
    return out.transpose(1, 0, 2, 3, 4).reshape(B, S, H, d)


def hierarchical_moe(h, w_rg, b_rg, w_re, b_re, w_gate, w_up, w_down):
    T, D = h.shape
    g_logits = (h @ w_rg).astype(jnp.float32) + b_rg.astype(jnp.float32)
    g_prob = jax.nn.softmax(g_logits, axis=-1)
    _, g_top = lax.top_k(g_logits, 1)
    g_sel = g_top[:, 0]
    g_w = jnp.take_along_axis(g_prob, g_top, axis=-1)[:, 0]
    e_logits = ((h @ w_re).astype(jnp.float32) + b_re.astype(jnp.float32)).reshape(T, N_GROUPS, EXPERTS_PER_GROUP)
    e_in_group = jnp.take_along_axis(e_logits, g_sel[:, None, None], axis=1)[:, 0]
    e_vals, e_top = lax.top_k(e_in_group, EXPERT_TOPK)
    e_w = jax.nn.softmax(e_vals, axis=-1)
    weights = g_w[:, None] * e_w
    expert_ids = g_sel[:, None] * EXPERTS_PER_GROUP + e_top

    A = T * EXPERT_TOPK
    e_flat = expert_ids.reshape(A).astype(jnp.int32)
    tok_flat = jnp.repeat(jnp.arange(T, dtype=jnp.int32), EXPERT_TOPK)
    w_flat = weights.reshape(A)
    order = jnp.argsort(e_flat)
    e_sorted = e_flat[order]
    counts = jnp.zeros((N_EXPERTS,), jnp.int32).at[e_flat].add(1)
    padded = (counts + MOE_ROW_BLOCK - 1) // MOE_ROW_BLOCK * MOE_ROW_BLOCK
    pad_end = jnp.cumsum(padded)
    pad_start = pad_end - padded
    start = jnp.cumsum(counts) - counts
    dest = pad_start[e_sorted] + (jnp.arange(A, dtype=jnp.int32) - start[e_sorted])
    n_blocks = -(-A // MOE_ROW_BLOCK) + N_EXPERTS
    P = n_blocks * MOE_ROW_BLOCK
    row_tok = jnp.zeros((P,), jnp.int32).at[dest].set(tok_flat[order])
    row_w = jnp.zeros((P,), h.dtype).at[dest].set(w_flat[order].astype(h.dtype))
    block_expert = jnp.minimum(
        jnp.searchsorted(pad_end, jnp.arange(n_blocks, dtype=jnp.int32) * MOE_ROW_BLOCK, side='right'),
        N_EXPERTS - 1).astype(jnp.int32)

    def one_block(args):
        toks, eid = args
        xb = h[toks]
        a = xb @ w_gate[eid]
        u = xb @ w_up[eid]
        return (jax.nn.silu(a) * u) @ w_down[eid]

    y = lax.map(one_block, (row_tok.reshape(n_blocks, MOE_ROW_BLOCK), block_expert))
    y = y.reshape(P, D) * row_w[:, None]
    return jnp.zeros((T, D), h.dtype).at[row_tok].add(y)


def setup_inputs(seed: int = 0) -> dict:
    key = jax.random.key(seed)
    ks = jax.random.split(key, 32)
    f32 = jnp.float32
    L = DEPTH

    def dense(k, shape, fan_in):
        return jax.random.normal(k, shape, f32) * fan_in ** -0.5

    def gain(k, n):
        return 1.0 + 0.02 * jax.random.normal(k, (L, n), f32)

    return {
        'x': jax.random.normal(ks[0], (BATCH, SEQ, D_MODEL), f32),
        'attn_norm_g': gain(ks[1], D_MODEL),
        'w_in': dense(ks[2], (L, D_MODEL, IN_WIDTH), D_MODEL),
        'mla_q_lat_g': gain(ks[3], MLA_Q_LORA),
        'w_q_up': dense(ks[4], (L, MLA_Q_LORA, MLA_HEADS * MLA_QK_DIM), MLA_Q_LORA),
        'mla_kv_lat_g': gain(ks[5], MLA_KV_LORA),
        'w_kv_up': dense(ks[6], (L, MLA_KV_LORA, MLA_HEADS * (MLA_NOPE_DIM + MLA_V_DIM)), MLA_KV_LORA),
        'mla_q_head_g': gain(ks[7], MLA_QK_DIM),
        'mla_k_head_g': gain(ks[8], MLA_QK_DIM),
        'moba_q_head_g': gain(ks[9], MOBA_HEAD_DIM),
        'moba_k_head_g': gain(ks[10], MOBA_HEAD_DIM),
        'out_norm_mla_g': gain(ks[11], MLA_WIDTH),
        'out_norm_moba_g': gain(ks[12], MOBA_WIDTH),
        'w_out': dense(ks[13], (L, MIX_WIDTH, D_MODEL), MIX_WIDTH),
        'ffn_norm_g': gain(ks[14], D_MODEL),
        'w_router_group': dense(ks[15], (L, D_MODEL, N_GROUPS), D_MODEL),
        'b_router_group': 0.01 * jax.random.normal(ks[16], (L, N_GROUPS), f32),
        'w_router_expert': dense(ks[17], (L, D_MODEL, N_EXPERTS), D_MODEL),
        'b_router_expert': 0.01 * jax.random.normal(ks[18], (L, N_EXPERTS), f32),
        'w_gate': dense(ks[19], (L, N_EXPERTS, D_MODEL, EXPERT_HIDDEN), D_MODEL),
        'w_up': dense(ks[20], (L, N_EXPERTS, D_MODEL, EXPERT_HIDDEN), D_MODEL),
        'w_down': dense(ks[21], (L, N_EXPERTS, EXPERT_HIDDEN, D_MODEL), EXPERT_HIDDEN),
    }


def reference(x, attn_norm_g, w_in, mla_q_lat_g, w_q_up, mla_kv_lat_g, w_kv_up,
              mla_q_head_g, mla_k_head_g, moba_q_head_g, moba_k_head_g,
              out_norm_mla_g, out_norm_moba_g, w_out, ffn_norm_g,
              w_router_group, b_router_group, w_router_expert, b_router_expert,
              w_gate, w_up, w_down):
    B, S, D = x.shape
    cos_r, sin_r = rope_tables(S, MLA_ROPE_DIM)
    cos_f, sin_f = rope_tables(S, MOBA_HEAD_DIM)
    for l in range(DEPTH):
        h = rms_norm(x, attn_norm_g[l])
        proj = h @ w_in[l]
        q_lat, kv_lat, k_pe, mq, mk, mv = jnp.split(proj, IN_SPLITS, axis=-1)

        q_lat = rms_norm(q_lat, mla_q_lat_g[l])
        q_a = (q_lat @ w_q_up[l]).reshape(B, S, MLA_HEADS, MLA_QK_DIM)
        kv_lat = rms_norm(kv_lat, mla_kv_lat_g[l])
        kv = (kv_lat @ w_kv_up[l]).reshape(B, S, MLA_HEADS, MLA_NOPE_DIM + MLA_V_DIM)
        k_nope, v_a = jnp.split(kv, [MLA_NOPE_DIM], axis=-1)
        k_pe_h = jnp.broadcast_to(k_pe[:, :, None, :], (B, S, MLA_HEADS, MLA_ROPE_DIM))
        k_a = jnp.concatenate([k_nope, k_pe_h], axis=-1)
        q_a = rms_norm(q_a, mla_q_head_g[l])
        k_a = rms_norm(k_a, mla_k_head_g[l])
        q_a = jnp.concatenate([q_a[..., :MLA_NOPE_DIM],
                               apply_rope(q_a[..., MLA_NOPE_DIM:], cos_r, sin_r)], axis=-1)
        k_a = jnp.concatenate([k_a[..., :MLA_NOPE_DIM],
                               apply_rope(k_a[..., MLA_NOPE_DIM:], cos_r, sin_r)], axis=-1)
        o_a = causal_attention_blocked(q_a, k_a, v_a, MLA_QK_DIM ** -0.5).reshape(B, S, MLA_WIDTH)

        q_b = rms_norm(mq.reshape(B, S, MOBA_HEADS, MOBA_HEAD_DIM), moba_q_head_g[l])
        k_b = rms_norm(mk.reshape(B, S, MOBA_HEADS, MOBA_HEAD_DIM), moba_k_head_g[l])
        q_b = apply_rope(q_b, cos_f, sin_f)
        k_b = apply_rope(k_b, cos_f, sin_f)
        v_b = mv.reshape(B, S, MOBA_HEADS, MOBA_HEAD_DIM)
        o_b = moba_attention(q_b, k_b, v_b).reshape(B, S, MOBA_WIDTH)

        mixed = jnp.concatenate([rms_norm(o_a, out_norm_mla_g[l]),
                                 rms_norm(o_b, out_norm_moba_g[l])], axis=-1)
        x = x + mixed @ w_out[l]

        h2 = rms_norm(x, ffn_norm_g[l]).reshape(B * S, D)
        x = x + hierarchical_moe(h2, w_router_group[l], b_router_group[l],
                                 w_router_expert[l], b_router_expert[l],
                                 w_gate[l], w_up[l], w_down[l]).reshape(B, S, D)
    return x
```

```cpp
#include <hip/hip_runtime.h>
#include <cstdio>
#include <cstdint>
namespace pg8 {
#define PG8_LAS __attribute__((address_space(3)))
typedef unsigned short bf16_t;
typedef short bf16x8 __attribute__((ext_vector_type(8)));
typedef float f32x4 __attribute__((ext_vector_type(4)));
typedef unsigned u32x4 __attribute__((ext_vector_type(4)));
constexpr int BM = 256, BK = 64, HALF = 128, HTB = HALF * BK * 2  , STAGE_BYTES = 8 * HTB, NXCD = 8, WGM = 8;

__host__ __device__ __forceinline__ int lds_byte(int r, int c) { const int st = (r >> 4) * 2 + (c >> 5), rr = r & 15, cc = c & 31, ob = rr * 64 + cc * 2; return st * 1024 + (ob ^ (((ob >> 9) & 1) << 5)); }
__host__ __device__ __forceinline__ void stage_rc(int b, int& R, int& C) { const int st = b / 1024, sb = b % 1024, swz = sb ^ (((sb >> 9) & 1) << 5); R = (st >> 1) * 16 + swz / 64; C = (st & 1) * 32 + (swz % 64) / 2; }
__host__ __device__ __forceinline__ int perm32(int rho) { const int n = rho >> 4, i = rho & 15; return 8 * (i >> 2) + 4 * n + (i & 3); }

struct Unit { int pm, pn, g0, g1, pn2, q; };
struct Gemm { const bf16_t* A; const bf16_t* Bt; int M, N, K; };

struct StaticOrder {
    int nM, nN, nwg, G, c;
    __host__ __device__ void init(int M, int N, int G_, int c_) { nM = M / BM; nN = N / BM; nwg = nM * nN; G = G_; c = c_; }
    __host__ __device__ bool next(int i, Unit& u) const {
        const long L = (long)i * G + c; if (L >= nwg) return false;
        int wgid = (int)L; { const int q = nwg / NXCD, r = nwg % NXCD, xcd = wgid % NXCD, off = wgid / NXCD; wgid = (xcd < r ? xcd * (q + 1) : r * (q + 1) + (xcd - r) * q) + off; }
        const int nig = WGM * nN, gid = wgid / nig, fm = gid * WGM, gsz = (nM - fm) < WGM ? (nM - fm) : WGM;
        u.pm = fm + ((wgid % nig) % gsz); u.pn = (wgid % nig) / gsz; u.g0 = i; u.g1 = 0; u.pn2 = 0; u.q = 0; return true;
    }
    __device__ __forceinline__ void a_ready(const Unit&) const {}
    __device__ __forceinline__ void done(const Unit&) const {}
};

__device__ __forceinline__ unsigned cvt_pk_bf16(float lo, float hi) { unsigned r; asm volatile("v_cvt_pk_bf16_f32 %0, %1, %2" : "=v"(r) : "v"(lo), "v"(hi)); return r; }
#define PG8_GAS __attribute__((address_space(1)))
struct ListEnt { int tok; float w_lo; float w_hi; float rstd; };

struct EpiBf16 {
    static constexpr bool PERM = true, AFTER_DRAIN = false, MIDHOOK = false;
    bf16_t* O; int ldc;
    __device__ __forceinline__ void operator()(const f32x4 (&acc)[2][2][4][2], const Unit& u, int wr, int wc, int fr, int fq) const {
        const int row0 = u.pm * BM + wr * 64 + fr; const int col0 = u.pn * BM + wc * 32 + 8 * fq;
#pragma unroll
        for (int ai = 0; ai < 2; ++ai)
#pragma unroll
            for (int m = 0; m < 4; ++m) { bf16_t* rowp = O + (size_t)(row0 + ai * HALF + m * 16) * ldc + col0;
#pragma unroll
                for (int bj = 0; bj < 2; ++bj) { const f32x4 v0 = acc[ai][bj][m][0], v1 = acc[ai][bj][m][1];
                    u32x4 w; w.x = cvt_pk_bf16(v0[0], v0[1]); w.y = cvt_pk_bf16(v0[2], v0[3]); w.z = cvt_pk_bf16(v1[0], v1[1]); w.w = cvt_pk_bf16(v1[2], v1[3]);
                    *(PG8_GAS u32x4*)(rowp + bj * HALF) = w; } }
    }
};
struct EpiBf16Rs {
    static constexpr bool PERM = true, AFTER_DRAIN = false, MIDHOOK = false;
    bf16_t* O; int ldc; const float* ssq; int off; float inv_n, eps;
    __device__ __forceinline__ void operator()(const f32x4 (&acc)[2][2][4][2], const Unit& u, int wr, int wc, int fr, int fq) const {
        const int row0 = u.pm * BM + wr * 64 + fr; const int col0 = u.pn * BM + wc * 32 + 8 * fq;
#pragma unroll
        for (int ai = 0; ai < 2; ++ai)
#pragma unroll
            for (int m = 0; m < 4; ++m) { const int row = row0 + ai * HALF + m * 16; PG8_GAS bf16_t* rowp = (PG8_GAS bf16_t*)O + (size_t)row * ldc + col0;
                const f32x4 sq = *(const PG8_GAS f32x4*)(ssq + (size_t)row * 8 + off); const float rs = 1.0f / sqrtf(((sq[0] + sq[1]) + (sq[2] + sq[3])) * inv_n + eps);
#pragma unroll
                for (int bj = 0; bj < 2; ++bj) { const f32x4 v0 = acc[ai][bj][m][0] * rs, v1 = acc[ai][bj][m][1] * rs;
                    u32x4 w; w.x = cvt_pk_bf16(v0[0], v0[1]); w.y = cvt_pk_bf16(v0[2], v0[3]); w.z = cvt_pk_bf16(v1[0], v1[1]); w.w = cvt_pk_bf16(v1[2], v1[3]);
                    *(PG8_GAS u32x4*)(rowp + bj * HALF) = w; } }
    }
};
struct EpiProj {
    static constexpr bool PERM = true, AFTER_DRAIN = false, MIDHOOK = false;
    unsigned char* ws; size_t o_qln, o_kvln, o_qb, o_kb, o_vb, o_ssq, o_kmean, o_rope; const float* gq; const float* gk; float qscale, eps; int seq;
    __device__ __forceinline__ void operator()(const f32x4 (&acc)[2][2][4][2], const Unit& u, int wr, int wc, int fr, int fq) const {
        const int pn = u.pn; const int row0 = u.pm * BM + wr * 64 + fr;
        bf16_t* const QLN = (bf16_t*)(ws + o_qln); bf16_t* const KVLN = (bf16_t*)(ws + o_kvln); bf16_t* const QB = (bf16_t*)(ws + o_qb); bf16_t* const KB = (bf16_t*)(ws + o_kb); bf16_t* const VB = (bf16_t*)(ws + o_vb);
        float* const SSQ = (float*)(ws + o_ssq); float* const kmean = (float*)(ws + o_kmean); const float* const rope = (const float*)(ws + o_rope);
        if (pn < 2) {
            PG8_GAS bf16_t* O = (PG8_GAS bf16_t*)(pn ? KVLN : QLN); PG8_GAS float* sq = (PG8_GAS float*)SSQ;
#pragma unroll
            for (int ai = 0; ai < 2; ++ai)
#pragma unroll
                for (int m = 0; m < 4; ++m) { const int row = row0 + ai * HALF + m * 16; PG8_GAS bf16_t* rowp = O + (size_t)row * 256 + wc * 32 + 8 * fq; float ss = 0.f;
#pragma unroll
                    for (int bj = 0; bj < 2; ++bj) { const f32x4 v0 = acc[ai][bj][m][0], v1 = acc[ai][bj][m][1];
                        if (pn == 0 || bj == 0) ss += (v0[0] * v0[0] + v0[1] * v0[1]) + (v0[2] * v0[2] + v0[3] * v0[3]) + (v1[0] * v1[0] + v1[1] * v1[1]) + (v1[2] * v1[2] + v1[3] * v1[3]);
                        u32x4 w; w.x = cvt_pk_bf16(v0[0], v0[1]); w.y = cvt_pk_bf16(v0[2], v0[3]); w.z = cvt_pk_bf16(v1[0], v1[1]); w.w = cvt_pk_bf16(v1[2], v1[3]);
                        *(PG8_GAS u32x4*)(rowp + bj * HALF) = w; }
                    ss += __shfl_xor(ss, 16); ss += __shfl_xor(ss, 32);
                    if (fq == 0) sq[(size_t)row * 8 + pn * 4 + wc] = ss; }
        } else if (pn < 6) {
            const bool isk = pn >= 4; const int head = (pn & 1) * 4 + wc; const float* gp = isk ? gk : gq; asm volatile("" : "+s"(gp)); const float sc = isk ? 1.0f : qscale;
            PG8_GAS bf16_t* O = (PG8_GAS bf16_t*)(isk ? KB : QB);
            f32x4 g0[2], g1[2];
#pragma unroll
            for (int n = 0; n < 2; ++n) { g0[n] = *(const PG8_GAS f32x4*)(gp + 8 * fq + 4 * n); g1[n] = *(const PG8_GAS f32x4*)(gp + 32 + 8 * fq + 4 * n); }
            f32x4 cs0[2] = {{0.f, 0.f, 0.f, 0.f}, {0.f, 0.f, 0.f, 0.f}}, cs1[2] = {{0.f, 0.f, 0.f, 0.f}, {0.f, 0.f, 0.f, 0.f}};
#pragma unroll
            for (int ai = 0; ai < 2; ++ai)
#pragma unroll
                for (int m = 0; m < 4; ++m) { const int row = row0 + ai * HALF + m * 16; const int pos = row & (seq - 1);
                    float ss = 0.f;
#pragma unroll
                    for (int n = 0; n < 2; ++n) { const f32x4 a = acc[ai][0][m][n], b = acc[ai][1][m][n]; ss += (a[0] * a[0] + a[1] * a[1]) + (a[2] * a[2] + a[3] * a[3]) + (b[0] * b[0] + b[1] * b[1]) + (b[2] * b[2] + b[3] * b[3]); }
                    ss += __shfl_xor(ss, 16); ss += __shfl_xor(ss, 32);
                    const float rs = 1.0f / sqrtf(ss * (1.0f / 64.0f) + eps);
                    u32x4 w1, w2; unsigned pk1[4], pk2_[4];
#pragma unroll
                    for (int n = 0; n < 2; ++n) { const f32x4 c = *(const PG8_GAS f32x4*)(rope + (size_t)pos * 32 + 8 * fq + 4 * n), sn = *(const PG8_GAS f32x4*)(rope + (size_t)seq * 32 + (size_t)pos * 32 + 8 * fq + 4 * n);
                        const f32x4 y1 = acc[ai][0][m][n] * rs * g0[n], y2 = acc[ai][1][m][n] * rs * g1[n];
                        const f32x4 o1 = (y1 * c - y2 * sn) * sc, o2 = (y2 * c + y1 * sn) * sc;
                        if (isk) { cs0[n] += o1; cs1[n] += o2; }
                        pk1[2 * n] = cvt_pk_bf16(o1[0], o1[1]); pk1[2 * n + 1] = cvt_pk_bf16(o1[2], o1[3]); pk2_[2 * n] = cvt_pk_bf16(o2[0], o2[1]); pk2_[2 * n + 1] = cvt_pk_bf16(o2[2], o2[3]); }
                    w1.x = pk1[0]; w1.y = pk1[1]; w1.z = pk1[2]; w1.w = pk1[3]; w2.x = pk2_[0]; w2.y = pk2_[1]; w2.z = pk2_[2]; w2.w = pk2_[3];
                    PG8_GAS bf16_t* rowp = O + (size_t)row * 512 + head * 64 + 8 * fq;
                    *(PG8_GAS u32x4*)rowp = w1; *(PG8_GAS u32x4*)(rowp + 32) = w2;
                    asm volatile("" : "+v"(cs0[0]), "+v"(cs0[1]), "+v"(cs1[0]), "+v"(cs1[1]) :: "memory"); }
            if (isk) {
                PG8_GAS float* km = (PG8_GAS float*)kmean + ((size_t)u.pm * 8 + head) * 64;
#pragma unroll
                for (int n = 0; n < 2; ++n)
#pragma unroll
                    for (int j = 0; j < 4; ++j) { float a = cs0[n][j], b = cs1[n][j];
#pragma unroll
                        for (int o = 1; o < 16; o <<= 1) { a += __shfl_xor(a, o); b += __shfl_xor(b, o); }
                        if (fr == 0) { __hip_atomic_fetch_add(km + 8 * fq + 4 * n + j, a * (1.0f / 256.0f), __ATOMIC_RELAXED, __HIP_MEMORY_SCOPE_AGENT); __hip_atomic_fetch_add(km + 32 + 8 * fq + 4 * n + j, b * (1.0f / 256.0f), __ATOMIC_RELAXED, __HIP_MEMORY_SCOPE_AGENT); } }
            }
        } else {
            PG8_GAS bf16_t* O = (PG8_GAS bf16_t*)VB; const int col0 = (pn - 6) * BM + wc * 32 + 8 * fq;
#pragma unroll
            for (int ai = 0; ai < 2; ++ai)
#pragma unroll
                for (int m = 0; m < 4; ++m) { PG8_GAS bf16_t* rowp = O + (size_t)(row0 + ai * HALF + m * 16) * 512 + col0;
#pragma unroll
                    for (int bj = 0; bj < 2; ++bj) { const f32x4 v0 = acc[ai][bj][m][0], v1 = acc[ai][bj][m][1];
                        u32x4 w; w.x = cvt_pk_bf16(v0[0], v0[1]); w.y = cvt_pk_bf16(v0[2], v0[3]); w.z = cvt_pk_bf16(v1[0], v1[1]); w.w = cvt_pk_bf16(v1[2], v1[3]);
                        *(PG8_GAS u32x4*)(rowp + bj * HALF) = w; } }
        }
    }
};
struct EpiKv {
    static constexpr bool PERM = true, AFTER_DRAIN = false, MIDHOOK = false;
    bf16_t* KA; bf16_t* VA; const bf16_t* KVLN; const float* ssq; const float* ropeR; const float* gk; float eps; int seq;
    __device__ __forceinline__ void operator()(const f32x4 (&acc)[2][2][4][2], const Unit& u, int wr, int wc, int fr, int fq) const {
        const int pn = u.pn; const int row0 = u.pm * BM + wr * 64 + fr;
        if (pn < 2) {
            const int head = pn * 4 + wc; const float* gp = gk; asm volatile("" : "+s"(gp));
            f32x4 g0[2], g1[2];
#pragma unroll
            for (int n = 0; n < 2; ++n) { g0[n] = *(const PG8_GAS f32x4*)(gp + 8 * fq + 4 * n); g1[n] = *(const PG8_GAS f32x4*)(gp + 32 + 8 * fq + 4 * n); }
            const f32x4 gr1 = *(const PG8_GAS f32x4*)(gp + 64 + 4 * fq), gr2 = *(const PG8_GAS f32x4*)(gp + 80 + 4 * fq);
#pragma unroll
            for (int ai = 0; ai < 2; ++ai)
#pragma unroll
                for (int m = 0; m < 4; ++m) { const int row = row0 + ai * HALF + m * 16; const int pos = row & (seq - 1);
                    const f32x4 sq = *(const PG8_GAS f32x4*)(ssq + (size_t)row * 8 + 4); const float rl = 1.0f / sqrtf(((sq[0] + sq[1]) + (sq[2] + sq[3])) * (1.0f / 128.0f) + eps);
                    const PG8_GAS bf16_t* pe = (const PG8_GAS bf16_t*)KVLN + (size_t)row * 256 + 128 + 4 * fq;
                    typedef unsigned u32x2_ __attribute__((ext_vector_type(2)));
                    const u32x2_ p1 = *(const PG8_GAS u32x2_*)pe, p2 = *(const PG8_GAS u32x2_*)(pe + 16);
                    const f32x4 e1 = {__builtin_bit_cast(float, p1.x << 16), __builtin_bit_cast(float, p1.x & 0xffff0000u), __builtin_bit_cast(float, p1.y << 16), __builtin_bit_cast(float, p1.y & 0xffff0000u)};
                    const f32x4 e2 = {__builtin_bit_cast(float, p2.x << 16), __builtin_bit_cast(float, p2.x & 0xffff0000u), __builtin_bit_cast(float, p2.y << 16), __builtin_bit_cast(float, p2.y & 0xffff0000u)};
                    f32x4 x0[2], x1[2]; float ss = (e1[0] * e1[0] + e1[1] * e1[1]) + (e1[2] * e1[2] + e1[3] * e1[3]) + (e2[0] * e2[0] + e2[1] * e2[1]) + (e2[2] * e2[2] + e2[3] * e2[3]);
#pragma unroll
                    for (int n = 0; n < 2; ++n) { x0[n] = acc[ai][0][m][n] * rl; x1[n] = acc[ai][1][m][n] * rl; const f32x4 a = x0[n], b = x1[n];
                        ss += (a[0] * a[0] + a[1] * a[1]) + (a[2] * a[2] + a[3] * a[3]) + (b[0] * b[0] + b[1] * b[1]) + (b[2] * b[2] + b[3] * b[3]); }
                    ss += __shfl_xor(ss, 16); ss += __shfl_xor(ss, 32);
                    const float rs = 1.0f / sqrtf(ss * (1.0f / 96.0f) + eps);
                    PG8_GAS bf16_t* rowp = (PG8_GAS bf16_t*)KA + (size_t)row * 768 + head * 96;
                    u32x4 w1, w2;
                    { const f32x4 a = x0[0] * rs * g0[0], b = x0[1] * rs * g0[1]; w1.x = cvt_pk_bf16(a[0], a[1]); w1.y = cvt_pk_bf16(a[2], a[3]); w1.z = cvt_pk_bf16(b[0], b[1]); w1.w = cvt_pk_bf16(b[2], b[3]); }
                    { const f32x4 a = x1[0] * rs * g1[0], b = x1[1] * rs * g1[1]; w2.x = cvt_pk_bf16(a[0], a[1]); w2.y = cvt_pk_bf16(a[2], a[3]); w2.z = cvt_pk_bf16(b[0], b[1]); w2.w = cvt_pk_bf16(b[2], b[3]); }
                    *(PG8_GAS u32x4*)(rowp + 8 * fq) = w1; *(PG8_GAS u32x4*)(rowp + 32 + 8 * fq) = w2;
                    const f32x4 c = *(const PG8_GAS f32x4*)(ropeR + (size_t)pos * 16 + 4 * fq), sn = *(const PG8_GAS f32x4*)(ropeR + (size_t)seq * 16 + (size_t)pos * 16 + 4 * fq);
                    const f32x4 y1 = e1 * rs * gr1, y2 = e2 * rs * gr2; const f32x4 o1 = y1 * c - y2 * sn, o2 = y2 * c + y1 * sn;
                    u32x2_ r1, r2; r1.x = cvt_pk_bf16(o1[0], o1[1]); r1.y = cvt_pk_bf16(o1[2], o1[3]); r2.x = cvt_pk_bf16(o2[0], o2[1]); r2.y = cvt_pk_bf16(o2[2], o2[3]);
                    *(PG8_GAS u32x2_*)(rowp + 64 + 4 * fq) = r1; *(PG8_GAS u32x2_*)(rowp + 80 + 4 * fq) = r2;
                    asm volatile("" ::: "memory"); }
        } else {
            const int col0 = (pn - 2) * BM + wc * 32 + 8 * fq;
#pragma unroll
            for (int ai = 0; ai < 2; ++ai)
#pragma unroll
                for (int m = 0; m < 4; ++m) { const int row = row0 + ai * HALF + m * 16; PG8_GAS bf16_t* rowp = (PG8_GAS bf16_t*)VA + (size_t)row * 512 + col0;
                    const f32x4 sq = *(const PG8_GAS f32x4*)(ssq + (size_t)row * 8 + 4); const float rl = 1.0f / sqrtf(((sq[0] + sq[1]) + (sq[2] + sq[3])) * (1.0f / 128.0f) + eps);
#pragma unroll
                    for (int bj = 0; bj < 2; ++bj) { const f32x4 v0 = acc[ai][bj][m][0] * rl, v1 = acc[ai][bj][m][1] * rl;
                        u32x4 w; w.x = cvt_pk_bf16(v0[0], v0[1]); w.y = cvt_pk_bf16(v0[2], v0[3]); w.z = cvt_pk_bf16(v1[0], v1[1]); w.w = cvt_pk_bf16(v1[2], v1[3]);
                        *(PG8_GAS u32x4*)(rowp + bj * HALF) = w; } }
        }
    }
};
struct EpiOut {
    static constexpr bool PERM = true, AFTER_DRAIN = false, MIDHOOK = true;
    const float* base; bf16_t* x1b; const PG8_LAS float* rsl;
    __device__ __forceinline__ void mid(f32x4 (&acc)[2][2][4][2], const Unit& u, int wr, int wc, int fr, int fq) const {
        const PG8_LAS float* rs = rsl + (u.g0 * 256 + wr * 64 + fr) * 2;
#pragma unroll
        for (int ai = 0; ai < 2; ++ai)
#pragma unroll
            for (int m = 0; m < 4; ++m) { const float ratio = rs[(ai * HALF + m * 16) * 2];
#pragma unroll
                for (int bj = 0; bj < 2; ++bj)
#pragma unroll
                    for (int n = 0; n < 2; ++n) acc[ai][bj][m][n] *= ratio; }
    }
    __device__ __forceinline__ void operator()(const f32x4 (&acc)[2][2][4][2], const Unit& u, int wr, int wc, int fr, int fq) const {
        const int row0 = u.pm * BM + wr * 64 + fr; const int col0 = u.pn * BM + wc * 32 + 8 * fq;
        const PG8_LAS float* rs = rsl + (u.g0 * 256 + wr * 64 + fr) * 2 + 1;
#pragma unroll
        for (int ai = 0; ai < 2; ++ai)
#pragma unroll
            for (int m = 0; m < 4; ++m) { const int row = row0 + ai * HALF + m * 16; const size_t off = (size_t)row * 1024 + col0; const float rb = rs[(ai * HALF + m * 16) * 2];
#pragma unroll
                for (int bj = 0; bj < 2; ++bj) { const size_t p = off + bj * HALF;
                    const f32x4 v0 = *(const PG8_GAS f32x4*)(base + p) + acc[ai][bj][m][0] * rb, v1 = *(const PG8_GAS f32x4*)(base + p + 4) + acc[ai][bj][m][1] * rb;
                    u32x4 o; o.x = cvt_pk_bf16(v0[0], v0[1]); o.y = cvt_pk_bf16(v0[2], v0[3]); o.z = cvt_pk_bf16(v1[0], v1[1]); o.w = cvt_pk_bf16(v1[2], v1[3]);
                    *(PG8_GAS u32x4*)(x1b + p) = o; }
                if (m & 1) asm volatile("" ::: "memory"); }
    }
};
struct EpiGateUp2 {
    static constexpr bool PERM = true, AFTER_DRAIN = false, MIDHOOK = false;
    bf16_t* H; const ListEnt* lists; const PG8_LAS int* cnt;
    __device__ __forceinline__ void operator()(const f32x4 (&acc)[2][2][4][2], const Unit& u, int wr, int wc, int fr, int fq) const {
        const int rt0 = wr * 64 + fr; const int col0 = (u.q >> 1) * 256 + (u.q & 1) * 128 + wc * 32 + 8 * fq; const int g = u.g0; const int n_g = cnt[g]; const bool hiexp = (u.q >> 1) != 0;
        const ListEnt* lg = lists + (size_t)g * 65536 + u.g1 * 256;
#pragma unroll
        for (int ai = 0; ai < 2; ++ai)
#pragma unroll
            for (int m = 0; m < 4; ++m) { const int rt = rt0 + ai * HALF + m * 16; const bool valid = (u.g1 * 256 + rt) < n_g;
                float w = 0.f, rsd = 0.f; if (valid) { const f32x4 le = *(const PG8_GAS f32x4*)((const PG8_GAS ListEnt*)lg + rt); w = hiexp ? le[2] : le[1]; rsd = le[3]; }
                unsigned pk[2];
#pragma unroll
                for (int n = 0; n < 2; ++n) { const f32x4 gv = acc[ai][0][m][n], uv = acc[ai][1][m][n]; float h[4];
#pragma unroll
                    for (int j = 0; j < 4; ++j) { const float a = gv[j] * rsd; const float s = a * __builtin_amdgcn_rcpf(1.0f + __builtin_amdgcn_exp2f(-1.4426950408889634f * a)); h[j] = valid ? s * (uv[j] * rsd) * w : 0.f; }
                    { int w_ = 0; w_ = __builtin_amdgcn_cvt_pk_fp8_f32(h[0] * 8.0f, h[1] * 8.0f, w_, false); w_ = __builtin_amdgcn_cvt_pk_fp8_f32(h[2] * 8.0f, h[3] * 8.0f, w_, true); pk[n] = (unsigned)w_; } }
                typedef unsigned u32x2h_ __attribute__((ext_vector_type(2))); u32x2h_ o; o.x = pk[0]; o.y = pk[1];
                *(PG8_GAS u32x2h_*)((PG8_GAS unsigned char*)H + (size_t)(u.pm * BM + rt) * 512 + col0) = o; }
    }
};
struct EpiDown2 {
    static constexpr bool PERM = true, AFTER_DRAIN = false, MIDHOOK = false;
    float* out; const bf16_t* x1b; const ListEnt* lists; const PG8_LAS int* cnt;
    __device__ __forceinline__ void operator()(const f32x4 (&acc)[2][2][4][2], const Unit& u, int wr, int wc, int fr, int fq) const {
        const int rt0 = wr * 64 + fr; const int col0 = u.q * 256 + wc * 32 + 8 * fq; const int g = u.g0; const int n_g = cnt[g];
        const ListEnt* lg = lists + (size_t)g * 65536 + u.g1 * 256;
#pragma unroll
        for (int ai = 0; ai < 2; ++ai)
#pragma unroll
            for (int m = 0; m < 4; ++m) { const int rt = rt0 + ai * HALF + m * 16; const bool valid = (u.g1 * 256 + rt) < n_g;
                if (valid) { const int tok = ((const PG8_GAS ListEnt*)lg)[rt].tok; PG8_GAS float* orow = (PG8_GAS float*)out + (size_t)tok * 1024 + col0;
#pragma unroll
                    for (int bj = 0; bj < 2; ++bj) { PG8_GAS float* p = orow + bj * HALF; const u32x4 xb = *(const PG8_GAS u32x4*)((const PG8_GAS bf16_t*)x1b + (size_t)tok * 1024 + col0 + bj * HALF);
                        f32x4 a, b; a[0] = __builtin_bit_cast(float, xb.x << 16); a[1] = __builtin_bit_cast(float, xb.x & 0xffff0000u); a[2] = __builtin_bit_cast(float, xb.y << 16); a[3] = __builtin_bit_cast(float, xb.y & 0xffff0000u);
                        b[0] = __builtin_bit_cast(float, xb.z << 16); b[1] = __builtin_bit_cast(float, xb.z & 0xffff0000u); b[2] = __builtin_bit_cast(float, xb.w << 16); b[3] = __builtin_bit_cast(float, xb.w & 0xffff0000u);
                        *(PG8_GAS f32x4*)p = a + acc[ai][bj][m][0]; *(PG8_GAS f32x4*)(p + 4) = b + acc[ai][bj][m][1]; } }
                if (m & 1) asm volatile("" ::: "memory"); }
    }
};
struct ClsOrder {
    const PG8_LAS int* tp; const PG8_LAS int* ptab; int mode, G, c; const ListEnt* lists; const PG8_LAS int* cnt;
    __device__ __forceinline__ int arow(const Unit& u, int row) const { const unsigned pos = (unsigned)(u.g1 * 256 + row); const unsigned n = (unsigned)cnt[u.g0]; const PG8_GAS ListEnt* lg = (const PG8_GAS ListEnt*)lists + (size_t)u.g0 * 65536; return lg[pos < n ? pos : 0u].tok; }
    __device__ __forceinline__ bool next(int i, Unit& u) const {
        const int nrb = tp[112]; const long L = (long)i * G + c; if (L >= (long)nrb * 4) return false;
        const int rbt = (int)(L >> 2), q = (int)(L & 3);
        int g = 0;
#pragma unroll
        for (int s = 64; s >= 1; s >>= 1) { const int gg = g + s; if (gg < 112 && tp[gg] <= rbt) g = gg; }
        const int grp = g / 28, pr = ptab[g - grp * 28], lo = pr & 15, hi = pr >> 4;
        u.pm = rbt; u.g0 = g; u.g1 = rbt - tp[g]; u.q = q;
        if (mode == 0) { u.pn = (grp * 8 + ((q >> 1) ? hi : lo)) * 2 + (q & 1); u.pn2 = 0; } else { u.pn = (grp * 8 + lo) * 4 + q; u.pn2 = (grp * 8 + hi) * 4 + q; }
        return true;
    }
    __device__ __forceinline__ void a_ready(const Unit&) const {}
    __device__ __forceinline__ void done(const Unit&) const {}
};

template <class Epi, class Sched, bool ALIGN_EPI = false, bool SP2 = false, bool GATHER = false, bool KSPLIT = false, bool F8 = false, int SCW = 0x7a7a7a7a, int SCA = 0x7f7f7f7f, bool F8ASM = false>
__device__ __forceinline__ void gemm_phase(PG8_LAS unsigned char* lds, const Gemm g, const Sched& S, const Epi& E) {
    const int tid = threadIdx.x, wid = __builtin_amdgcn_readfirstlane(tid >> 6), lane = tid & 63, wr = wid >> 2, wc = wid & 3, fr = lane & 15, fq = lane >> 4;
    const int K = g.K, nt = K / BK;
    const int PB = KSPLIT ? (K >> 1) : K;
    static_assert(!GATHER || SP2, "gathered A rows: SP2 loop only");
    unsigned voffA[2], voffB[2];
#pragma unroll
    for (int i = 0; i < 2; ++i) { int R, C; stage_rc(tid * 16 + i * 8192, R, C); const int Rb = Epi::PERM ? ((R & ~31) + perm32(R & 31)) : R;
        voffA[i] = (unsigned)(R * K + C) * 2u; voffB[i] = (unsigned)(Rb * PB + C) * 2u; }
    const size_t kstep = (size_t)(BK * 2);
    const size_t hstep = (size_t)HALF * K * 2;
    const size_t tstep = 2 * hstep;
    const size_t hstepB = (size_t)HALF * PB * 2, tstepB = 2 * hstepB;
    const unsigned ldsw = (unsigned)wid * 1024u;
    const int aoff = lds_byte(wr * 64 + fr, fq * 8), boff = lds_byte(wc * 32 + fr, fq * 8);
#define PG8_SA(b, h) (((b) * 2 + (h)) * HTB)
#define PG8_SB(b, h) ((4 + (b) * 2 + (h)) * HTB)
#define PG8_STAGE(bufoff, gbase, voff) do { _Pragma("unroll") for (int _i = 0; _i < 2; ++_i) \
        __builtin_amdgcn_global_load_lds((const unsigned*)((const char*)(gbase) + (voff)[_i]), (PG8_LAS unsigned*)(lds + (bufoff) + ldsw + _i * 8192), 16, 0, 0); } while (0)
#define PG8_LDA(dst, b, h) do { _Pragma("unroll") for (int m = 0; m < 4; ++m) _Pragma("unroll") for (int k = 0; k < 2; ++k) dst[m][k] = *(const PG8_LAS bf16x8*)(lds + PG8_SA(b, h) + aoff + m * 2048 + k * 1024); } while (0)
#define PG8_LDB(dst, b, h) do { _Pragma("unroll") for (int n = 0; n < 2; ++n) _Pragma("unroll") for (int k = 0; k < 2; ++k) dst[n][k] = *(const PG8_LAS bf16x8*)(lds + PG8_SB(b, h) + boff + n * 2048 + k * 1024); } while (0)
#define PG8_MMA(ai, bj, At, Bt) do { __builtin_amdgcn_s_setprio(1); _Pragma("unroll") for (int m = 0; m < 4; ++m) _Pragma("unroll") for (int n = 0; n < 2; ++n) { \
        if constexpr (F8) { typedef int v4i_ __attribute__((ext_vector_type(4))); typedef int v8i_ __attribute__((ext_vector_type(8))); \
            const v8i_ w8_ = __builtin_shufflevector(__builtin_bit_cast(v4i_, Bt[n][0]), __builtin_bit_cast(v4i_, Bt[n][1]), 0, 1, 2, 3, 4, 5, 6, 7); \
            const v8i_ a8_ = __builtin_shufflevector(__builtin_bit_cast(v4i_, At[m][0]), __builtin_bit_cast(v4i_, At[m][1]), 0, 1, 2, 3, 4, 5, 6, 7); \
            if constexpr (F8ASM) { asm volatile("v_mfma_scale_f32_16x16x128_f8f6f4 %0, %1, %2, %0, %3, %4 op_sel_hi:[0,0,0]" : "+v"(acc[ai][bj][m][n]) : "v"(w8_), "v"(a8_), "v"(SCW), "v"(SCA)); }     \
            else acc[ai][bj][m][n] = __builtin_amdgcn_mfma_scale_f32_16x16x128_f8f6f4(w8_, a8_, acc[ai][bj][m][n], 0, 0, 0, SCW, 0, SCA); } \
        else { _Pragma("unroll") for (int k = 0; k < 2; ++k) acc[ai][bj][m][n] = __builtin_amdgcn_mfma_f32_16x16x32_bf16(Bt[n][k], At[m][k], acc[ai][bj][m][n], 0, 0, 0); } } \
        __builtin_amdgcn_s_setprio(0); } while (0)
#define PG8_WAIT_V(n) asm volatile("s_waitcnt vmcnt(" #n ")" ::: "memory")
#define PG8_WAIT_L(n) asm volatile("s_waitcnt lgkmcnt(" #n ")" ::: "memory")
#define PG8_BAR __builtin_amdgcn_s_barrier()
#define PG8_SCHED __builtin_amdgcn_sched_barrier(0)
#define PG8_STG_A(b, h, ptr, arr) do { if constexpr (GATHER) { PG8_STAGE(PG8_SA(b, h), (ptr), (arr)[h]); } else { PG8_STAGE(PG8_SA(b, h), (ptr) + ((h) ? hstep : 0), voffA); } } while (0)
    unsigned cv[2][2] = {{0u, 0u}, {0u, 0u}}, nvp[2] = {0u, 0u};
#define PG8_GROWS(dst, unit) do { if constexpr (GATHER) { _Pragma("unroll") for (int _h = 0; _h < 2; ++_h) _Pragma("unroll") for (int _i = 0; _i < 2; ++_i) { int R_, C_; stage_rc(tid * 16 + _i * 8192, R_, C_); \
        dst[_h][_i] = (unsigned)S.arow(unit, _h * HALF + R_) * (unsigned)(K * 2) + (unsigned)(C_ * 2); } } } while (0)
    Unit cur, nxt; int ui = 0;
    if (!S.next(0, cur)) return;
    PG8_GROWS(cv, cur);
#define PG8_GROWS_P(unit) do { _Pragma("unroll") for (int _i = 0; _i < 2; ++_i) { int R_, C_; stage_rc(tid * 16 + _i * 8192, R_, C_); nvp[_i] = (unsigned)S.arow(unit, R_) | ((unsigned)S.arow(unit, HALF + R_) << 16); } } while (0)
#define PG8_UNPACK_NV() do { _Pragma("unroll") for (int _i = 0; _i < 2; ++_i) { int R_, C_; stage_rc(tid * 16 + _i * 8192, R_, C_); cv[0][_i] = (nvp[_i] & 0xffffu) * (unsigned)(K * 2) + (unsigned)(C_ * 2); cv[1][_i] = (nvp[_i] >> 16) * (unsigned)(K * 2) + (unsigned)(C_ * 2); } } while (0)
    f32x4 acc[2][2][4][2];
#pragma unroll
    for (int a = 0; a < 2; ++a)
#pragma unroll
        for (int b = 0; b < 2; ++b)
#pragma unroll
            for (int m = 0; m < 4; ++m)
#pragma unroll
                for (int n = 0; n < 2; ++n) acc[a][b][m][n] = (f32x4){0.f, 0.f, 0.f, 0.f};
    bf16x8 At[4][2], B0[2][2], B1[2][2];
    const char* cA = (const char*)g.A + (GATHER ? (size_t)0 : (size_t)cur.pm * tstep); const char* cB = (const char*)g.Bt + (size_t)cur.pn * tstepB; const char* cB2 = KSPLIT ? (const char*)g.Bt + (size_t)cur.pn2 * tstepB : cB;
    S.a_ready(cur);
    if constexpr (SP2) {
        PG8_STAGE(PG8_SB(0, 0), cB, voffB); PG8_STAGE(PG8_SB(0, 1), cB + hstepB, voffB); PG8_STG_A(0, 0, cA, cv); PG8_STG_A(0, 1, cA, cv);
        if (wr == 1) PG8_BAR;
        PG8_WAIT_V(2); PG8_BAR;
        PG8_STAGE(PG8_SB(1, 0), cB + kstep, voffB); PG8_STG_A(1, 0, cA + kstep, cv); PG8_STAGE(PG8_SB(1, 1), cB + hstepB + kstep, voffB);
        PG8_WAIT_V(6); PG8_BAR;
    } else {
        PG8_STAGE(PG8_SB(0, 0), cB, voffB); PG8_STAGE(PG8_SA(0, 0), cA, voffA); PG8_STAGE(PG8_SB(0, 1), cB + hstepB, voffB); PG8_STAGE(PG8_SA(0, 1), cA + hstep, voffA);
        if (wr == 1) PG8_BAR;
        PG8_WAIT_V(4); PG8_BAR;
        PG8_STAGE(PG8_SB(1, 0), cB + kstep, voffB); PG8_STAGE(PG8_SA(1, 0), cA + kstep, voffA); PG8_STAGE(PG8_SB(1, 1), cB + hstepB + kstep, voffB);
        PG8_WAIT_V(6); PG8_BAR;
    }
    for (;;) {
        const bool has_next = S.next(ui + 1, nxt);
        const char* nA = (has_next && !GATHER) ? (const char*)g.A + (size_t)nxt.pm * tstep : cA; const char* nB = has_next ? (const char*)g.Bt + (size_t)nxt.pn * tstepB : cB; const char* nB2 = (KSPLIT && has_next) ? (const char*)g.Bt + (size_t)nxt.pn2 * tstepB : cB2;
        if constexpr (GATHER) { if (has_next) { PG8_GROWS_P(nxt); } else { PG8_GROWS_P(cur); } }
        const int tspan = Epi::MIDHOOK ? (nt >> 1) : nt;
        for (int t0 = 0; t0 < nt; t0 += tspan) {
        if constexpr (Epi::MIDHOOK) { if (t0 != 0) E.mid(acc, cur, wr, wc, fr, fq); }
        for (int t = t0; t < t0 + tspan; t += 2) {
            const bool last = (t == nt - 2);
            const char* a1 = cA + (size_t)(t + 1) * kstep;
            const char* a2 = last ? nA : cA + (size_t)(t + 2) * kstep; const char* b2 = last ? nB : ((KSPLIT && t + 2 >= (nt >> 1)) ? cB2 + (size_t)(t + 2 - (nt >> 1)) * kstep : cB + (size_t)(t + 2) * kstep);
            const char* a3 = a2 + kstep; const char* b3 = b2 + kstep;
            if (last && has_next) S.a_ready(nxt);
            if constexpr (SP2) {
            PG8_LDB(B0, 0, 0); PG8_LDB(B1, 0, 1); PG8_SCHED; PG8_LDA(At, 0, 0); PG8_STG_A(1, 1, a1, cv);
            if constexpr (GATHER) { if (last) { PG8_UNPACK_NV(); } }
            PG8_WAIT_V(8); PG8_WAIT_L(0); PG8_BAR; PG8_MMA(0, 0, At, B0); PG8_MMA(0, 1, At, B1); PG8_BAR; PG8_SCHED;
            PG8_LDA(At, 0, 1); PG8_STAGE(PG8_SB(0, 0), b2, voffB); PG8_STAGE(PG8_SB(0, 1), b2 + hstepB, voffB); PG8_STG_A(0, 0, a2, cv);
            PG8_WAIT_V(8); PG8_WAIT_L(0); PG8_BAR; PG8_MMA(1, 0, At, B0); PG8_MMA(1, 1, At, B1); PG8_BAR; PG8_SCHED;
            PG8_LDB(B0, 1, 0); PG8_LDB(B1, 1, 1); PG8_SCHED; PG8_LDA(At, 1, 0); PG8_STG_A(0, 1, a2, cv);
            PG8_WAIT_V(8); PG8_WAIT_L(0); PG8_BAR; PG8_MMA(0, 0, At, B0); PG8_MMA(0, 1, At, B1); PG8_BAR; PG8_SCHED;
            PG8_LDA(At, 1, 1); PG8_STAGE(PG8_SB(1, 0), b3, voffB); PG8_STAGE(PG8_SB(1, 1), b3 + hstepB, voffB); PG8_STG_A(1, 0, a3, cv);
            PG8_WAIT_V(8); PG8_WAIT_L(0); PG8_BAR; PG8_MMA(1, 0, At, B0); PG8_MMA(1, 1, At, B1); PG8_BAR; PG8_SCHED;
            } else {
            PG8_LDB(B0, 0, 0); PG8_SCHED; PG8_LDA(At, 0, 0); PG8_STAGE(PG8_SA(1, 1), a1 + hstep, voffA);
            PG8_WAIT_L(8); PG8_BAR; PG8_WAIT_L(0); PG8_MMA(0, 0, At, B0); PG8_BAR; PG8_SCHED;
            PG8_LDB(B1, 0, 1); PG8_STAGE(PG8_SB(0, 0), b2, voffB);
            PG8_BAR; PG8_WAIT_L(0); PG8_MMA(0, 1, At, B1); PG8_BAR;
            PG8_LDA(At, 0, 1); PG8_STAGE(PG8_SA(0, 0), a2, voffA);
            PG8_BAR; PG8_WAIT_L(0); PG8_MMA(1, 0, At, B0); PG8_BAR; PG8_SCHED;
            PG8_STAGE(PG8_SB(0, 1), b2 + hstepB, voffB);
            PG8_WAIT_V(6); PG8_BAR; PG8_MMA(1, 1, At, B1); PG8_BAR;
            PG8_LDB(B0, 1, 0); PG8_SCHED; PG8_LDA(At, 1, 0); PG8_STAGE(PG8_SA(0, 1), a2 + hstep, voffA);
            PG8_WAIT_L(8); PG8_BAR; PG8_WAIT_L(0); PG8_MMA(0, 0, At, B0); PG8_BAR; PG8_SCHED;
            PG8_LDB(B1, 1, 1); PG8_STAGE(PG8_SB(1, 0), b3, voffB);
            PG8_BAR; PG8_WAIT_L(0); PG8_MMA(0, 1, At, B1); PG8_BAR;
            PG8_LDA(At, 1, 1); PG8_STAGE(PG8_SA(1, 0), a3, voffA);
            PG8_BAR; PG8_WAIT_L(0); PG8_MMA(1, 0, At, B0); PG8_BAR; PG8_SCHED;
            PG8_STAGE(PG8_SB(1, 1), b3 + hstepB, voffB);
            PG8_WAIT_V(6); PG8_BAR; PG8_MMA(1, 1, At, B1); PG8_BAR;
            }
        }
        }
        if constexpr (ALIGN_EPI) { if (wr == 0) PG8_BAR; }
        if constexpr (!Epi::AFTER_DRAIN) { int t2 = threadIdx.x; asm volatile("" : "+v"(t2));
            const int wid2 = __builtin_amdgcn_readfirstlane(t2 >> 6), lane2 = t2 & 63; E(acc, cur, wid2 >> 2, wid2 & 3, lane2 & 15, lane2 >> 4); S.done(cur); }
        if (!has_next) break;
#pragma unroll
        for (int a = 0; a < 2; ++a)
#pragma unroll
            for (int b = 0; b < 2; ++b)
#pragma unroll
                for (int m = 0; m < 4; ++m)
#pragma unroll
                    for (int n = 0; n < 2; ++n) acc[a][b][m][n] = (f32x4){0.f, 0.f, 0.f, 0.f};
        cur = nxt; cA = nA; cB = nB; cB2 = nB2; ++ui;
        if constexpr (ALIGN_EPI) { if (wr == 1) PG8_BAR; }
    }
    PG8_WAIT_V(0);
    if constexpr (!ALIGN_EPI) { if (wr == 0) PG8_BAR; }
    PG8_BAR;
    if constexpr (Epi::AFTER_DRAIN) { E.fused(acc, cur, wr, wc, fr, fq, lds, wid, lane); S.done(cur); }
#undef PG8_SA
#undef PG8_SB
#undef PG8_STAGE
#undef PG8_LDA
#undef PG8_LDB
#undef PG8_MMA
#undef PG8_WAIT_V
#undef PG8_WAIT_L
#undef PG8_BAR
#undef PG8_SCHED
#undef PG8_STG_A
#undef PG8_GROWS
#undef PG8_GROWS_P
#undef PG8_UNPACK_NV
}
}
constexpr int BATCH = 32, SEQ = 2048, D = 1024, T = BATCH * SEQ;
constexpr int NPROJ = 2048;
constexpr int CQ = 0, CKV = 256, CPE = 384, CMQ = 416, CMK = 928, CMV = 1440, NPROJ_REAL = 1952;
constexpr int NH = 8;
constexpr float EPS = 1e-6f;
constexpr float LOG2E = 1.4426950408889634f;
constexpr float C2A = 0.10206207261596575f * LOG2E;
constexpr float C2B = 0.125f * LOG2E;
constexpr int NCLS = 112;
constexpr int LIST_CAP = 65536;

constexpr size_t MiB = 1u << 20;
constexpr size_t WS_CTL = 0, CTL_ZERO_BYTES = 2 * MiB;
constexpr size_t WS_KMEAN = 1 * MiB;
constexpr size_t WS_WIN = 2 * MiB;
constexpr size_t WS_WQ = 6 * MiB;
constexpr size_t WS_WKV = 7 * MiB;
constexpr size_t WS_WO = 8 * MiB;
constexpr size_t WS_WGU = 10 * MiB;
constexpr size_t WS_WD = 42 * MiB;
constexpr size_t WS_ROPE = 58 * MiB;
constexpr size_t WS_WRE = 59 * MiB;
constexpr size_t WS_SSQ = 60 * MiB;
constexpr size_t WS_XN = 64 * MiB;
constexpr size_t WS_VB = 192 * MiB;
constexpr size_t WS_Y0 = 64 * MiB;
constexpr size_t WS_X1B = 768 * MiB;
constexpr size_t WS_YH = 256 * MiB;
constexpr size_t WS_QB = 448 * MiB;
constexpr size_t WS_KB = 512 * MiB;
constexpr size_t WS_QA = 584 * MiB;
constexpr size_t WS_VA = 680 * MiB;
constexpr size_t WS_KA = 808 * MiB;
constexpr size_t WS_QLN = 904 * MiB;
constexpr size_t WS_KVLN = 936 * MiB;
constexpr size_t WS_LISTS = 648 * MiB;
constexpr size_t WS_OSSQ = 904 * MiB;
constexpr size_t WS_END = 1024 * MiB;
constexpr size_t WS_H = WS_KB;
constexpr int CW_TMO = 0, CW_CODE = 1;
constexpr int CW_BAR = 4096;
constexpr int CW_GCNT = 16384;

constexpr int RING_BYTES = 131072;
constexpr int P8_XT = 0, P8_XT_WAVE = 32 * 68 * 4, P8_WC = 69632, P8_WRG = 86016, P8_RT = 102400;
constexpr int LDSCTL_OFF = 155648, LDS_BYTES = 159744;
constexpr int TP_OFF = LDSCTL_OFF + 256, CNT_OFF = LDSCTL_OFF + 768, PT_OFF = LDSCTL_OFF + 1280;

#define GAS __attribute__((address_space(1)))
#define LAS __attribute__((address_space(3)))
typedef unsigned short bf16;
typedef unsigned v4u __attribute__((ext_vector_type(4)));
typedef unsigned v2u __attribute__((ext_vector_type(2)));
typedef float f32x4 __attribute__((ext_vector_type(4)));
typedef float f32x2 __attribute__((ext_vector_type(2)));
typedef float f32x16 __attribute__((ext_vector_type(16)));
typedef short bf16x8 __attribute__((ext_vector_type(8)));
typedef short s16x4 __attribute__((ext_vector_type(4)));
typedef GAS unsigned gu32;
#define RLX_AGENT __ATOMIC_RELAXED, __HIP_MEMORY_SCOPE_AGENT
__device__ __forceinline__ unsigned f2bf(float f) { unsigned u = __builtin_bit_cast(unsigned, f); return (u + 0x7fffu + ((u >> 16) & 1u)) >> 16; }
__device__ __forceinline__ unsigned pk2(float lo, float hi) { return f2bf(lo) | (f2bf(hi) << 16); }
__device__ __forceinline__ float bflo(unsigned w) { return __builtin_bit_cast(float, w << 16); }
__device__ __forceinline__ float bfhi(unsigned w) { return __builtin_bit_cast(float, w & 0xffff0000u); }
__device__ __forceinline__ float wave_sum(float v) {
#pragma unroll
    for (int o = 1; o < 64; o <<= 1) v += __shfl_xor(v, o);
    return v;
}
__device__ __forceinline__ float sum8(float v) { v += __shfl_xor(v, 1); v += __shfl_xor(v, 2); v += __shfl_xor(v, 4); return v; }

#define XB_TMO      128
#define XB_XCNT(j)  (256  + 64 * (j))
#define XB_XSUB(j)  (1280 + 64 * (j))
#define XB_XGEN(j)  (2304 + 64 * (j))
#define XB_TOP      3328
#define XB_TOPGEN   3392
#define XCD_BAR_WORDS 3456
#define XB_SPIN_CAP (1u << 18)

__device__ __forceinline__ unsigned xb_ld(unsigned* p)              { return __hip_atomic_load(p, __ATOMIC_RELAXED, __HIP_MEMORY_SCOPE_AGENT); }
__device__ __forceinline__ unsigned xb_add(unsigned* p, unsigned v) { return __hip_atomic_fetch_add(p, v, __ATOMIC_RELAXED, __HIP_MEMORY_SCOPE_AGENT); }
__device__ __forceinline__ unsigned xb_xcc_id() { return (unsigned)__builtin_amdgcn_s_getreg((3 << 11) | 20) & 0xFu; }
#define XB_SPIN(cond, bar) do { unsigned _sp = 0; while (cond) { __builtin_amdgcn_s_sleep(1); \
    if ((++_sp & 255u) == 0u) { if (xb_ld(&(bar)[XB_TMO])) break; if (_sp > XB_SPIN_CAP) { atomicAdd(&(bar)[XB_TMO], 1u); break; } } } } while (0)

struct XcdBarrier {
    unsigned* bar; unsigned x;
    volatile LAS unsigned* st;
};

__device__ __forceinline__ XcdBarrier xcd_barrier_post(unsigned* bar, volatile LAS unsigned* st) {
    XcdBarrier b; b.bar = bar; b.x = xb_xcc_id(); b.st = st;
    if (threadIdx.x == 0) (void)xb_add(&bar[XB_XCNT(b.x)], 1u);
    return b;
}
__device__ __forceinline__ void xcd_barrier_complete(unsigned* bar, unsigned x, unsigned& nloc, unsigned& nx) {
    const unsigned G = gridDim.x * gridDim.y * gridDim.z;
    unsigned sum, cnt, mine, sp = 0u;
    for (;;) {
        sum = 0u; cnt = 0u; mine = 0u;
#pragma unroll
        for (unsigned j = 0; j < 16; ++j) { const unsigned c = xb_ld(&bar[XB_XCNT(j)]); sum += c; cnt += (c > 0u) ? 1u : 0u; mine = (j == x) ? c : mine; }
        if (sum == G) break;
        __builtin_amdgcn_s_sleep(1);
        if ((++sp & 255u) == 0u) { if (xb_ld(&bar[XB_TMO])) break; if (sp > XB_SPIN_CAP) { atomicAdd(&bar[XB_TMO], 1u); break; } }
    }
    nloc = mine > 0u ? mine : 1u; nx = cnt > 0u ? cnt : 1u;
}

__device__ __forceinline__ void xcd_barrier(const XcdBarrier& b) {
    asm volatile("s_waitcnt vmcnt(0)" ::: "memory");
    __syncthreads();
    if (threadIdx.x == 0) {
        unsigned* bar = b.bar;
        __builtin_amdgcn_s_waitcnt(0);
        unsigned nloc = b.st[0], nx = b.st[1];
        if (nloc == 0u) { xcd_barrier_complete(bar, b.x, nloc, nx); b.st[0] = nloc; b.st[1] = nx; }
        const unsigned old = xb_add(&bar[XB_XSUB(b.x)], 1u);
        const unsigned gen = old / nloc;
        if (old + 1u == (gen + 1u) * nloc) {
            __builtin_amdgcn_fence(__ATOMIC_RELEASE, "agent");
            asm volatile("s_waitcnt vmcnt(0)" ::: "memory");
            const unsigned og = xb_add(&bar[XB_TOP], 1u);
            const unsigned tg = og / nx;
            if (og + 1u == (tg + 1u) * nx) xb_add(&bar[XB_TOPGEN], 1u);
            else XB_SPIN(xb_ld(&bar[XB_TOPGEN]) == tg, bar);
            __builtin_amdgcn_fence(__ATOMIC_ACQUIRE, "agent");
            xb_add(&bar[XB_XGEN(b.x)], 1u);
            asm volatile("s_waitcnt vmcnt(0)" ::: "memory");
        } else {
            XB_SPIN(xb_ld(&bar[XB_XGEN(b.x)]) == gen, bar);
            __builtin_amdgcn_fence(__ATOMIC_ACQUIRE, "agent");
            asm volatile("s_waitcnt vmcnt(0)" ::: "memory");
        }
    }
    __syncthreads();
}


__device__ __forceinline__ float att_max3(float a, float b, float c) { float r; asm("v_max3_f32 %0, %1, %2, %3" : "=v"(r) : "v"(a), "v"(b), "v"(c)); return r; }
__device__ __forceinline__ unsigned pk4_fp8(float a, float b, float c, float d) { int w = 0; w = __builtin_amdgcn_cvt_pk_fp8_f32(a, b, w, false); w = __builtin_amdgcn_cvt_pk_fp8_f32(c, d, w, true); return (unsigned)w; }
template <int DQK, bool MOBA, bool QFIN>
__device__ __forceinline__ void attn_unit(LAS unsigned char* lds, const float* qgain_, const float* ropeR_, const bf16* Qg_, int qpitch, const bf16* Kg_, int kpitch, const bf16* Vg_, int vpitch, bf16* Og_, int opitch, float* ossq_, int qb, const float* kmp_, int kmstride) {
    const GAS bf16* Qg = (const GAS bf16*)Qg_; const GAS bf16* Kg = (const GAS bf16*)Kg_; const GAS bf16* Vg = (const GAS bf16*)Vg_; GAS bf16* Og = (GAS bf16*)Og_; const GAS float* kmp = (const GAS float*)kmp_;
    constexpr int ND = DQK / 16, KSTR = DQK * 2 + 16, KBUF = 64 * KSTR, NCH = DQK / 8, VBUF = 8192;
    int tid = threadIdx.x; asm volatile("" : "+v"(tid));
    const int lane = tid & 63, r32 = lane & 31, hi = lane >> 5; const int wid = __builtin_amdgcn_readfirstlane(tid >> 6);
    LAS unsigned char* Kl = lds; LAS unsigned char* Vl = lds + 2 * KBUF;
    const GAS bf16* qrow = Qg + (size_t)(qb * 256 + wid * 32 + r32) * qpitch;
    bf16x8 qf[ND];
#pragma unroll
    for (int d0 = 0; d0 < ND; ++d0) qf[d0] = *(const GAS bf16x8*)(qrow + 16 * d0 + 8 * hi);
    if (QFIN) {
        const GAS float* qg = (const GAS float*)qgain_; const GAS float* rr = (const GAS float*)ropeR_; const int pos = qb * 256 + wid * 32 + r32;
        float x[ND][8]; float ss = 0.f;
#pragma unroll
        for (int d0 = 0; d0 < ND; ++d0) { const v4u w = __builtin_bit_cast(v4u, qf[d0]);
            x[d0][0] = bflo(w.x); x[d0][1] = bfhi(w.x); x[d0][2] = bflo(w.y); x[d0][3] = bfhi(w.y); x[d0][4] = bflo(w.z); x[d0][5] = bfhi(w.z); x[d0][6] = bflo(w.w); x[d0][7] = bfhi(w.w);
#pragma unroll
            for (int j = 0; j < 8; ++j) ss += x[d0][j] * x[d0][j]; }
        ss += __shfl_xor(ss, 32);
        const float rs = (1.0f / sqrtf(ss * (1.0f / (float)DQK) + EPS)) * C2A;
#pragma unroll
        for (int d0 = 0; d0 < ND; ++d0) { const f32x4 ga = *(const GAS f32x4*)(qg + 16 * d0 + 8 * hi), gb = *(const GAS f32x4*)(qg + 16 * d0 + 8 * hi + 4);
#pragma unroll
            for (int j = 0; j < 4; ++j) { x[d0][j] *= rs * ga[j]; x[d0][4 + j] *= rs * gb[j]; } }
        if (ND == 6) { const f32x4 ca = *(const GAS f32x4*)(rr + pos * 16 + 8 * hi), cb = *(const GAS f32x4*)(rr + pos * 16 + 8 * hi + 4), sa = *(const GAS f32x4*)(rr + SEQ * 16 + pos * 16 + 8 * hi), sb = *(const GAS f32x4*)(rr + SEQ * 16 + pos * 16 + 8 * hi + 4);
#pragma unroll
            for (int j = 0; j < 8; ++j) { const float c = j < 4 ? ca[j & 3] : cb[j & 3], s = j < 4 ? sa[j & 3] : sb[j & 3]; const float y1 = x[ND - 2][j], y2 = x[ND - 1][j]; x[ND - 2][j] = y1 * c - y2 * s; x[ND - 1][j] = y2 * c + y1 * s; } }
#pragma unroll
        for (int d0 = 0; d0 < ND; ++d0) { v4u w; w.x = pg8::cvt_pk_bf16(x[d0][0], x[d0][1]); w.y = pg8::cvt_pk_bf16(x[d0][2], x[d0][3]); w.z = pg8::cvt_pk_bf16(x[d0][4], x[d0][5]); w.w = pg8::cvt_pk_bf16(x[d0][6], x[d0][7]); qf[d0] = __builtin_bit_cast(bf16x8, w); }
    }
    unsigned sel = 0xffu;
    if (MOBA && qb > 3) {
        float gate[8];
#pragma unroll
        for (int n = 0; n < 8; ++n) { float a = 0.f;
            if (n < qb) {
#pragma unroll
                for (int d0 = 0; d0 < ND; ++d0) { const GAS float* km = kmp + (size_t)n * kmstride + 16 * d0 + 8 * hi; const f32x4 k0 = *(const GAS f32x4*)km, k1 = *(const GAS f32x4*)(km + 4);
                    const v4u qq = __builtin_bit_cast(v4u, qf[d0]);
                    a += bflo(qq.x) * k0[0] + bfhi(qq.x) * k0[1] + bflo(qq.y) * k0[2] + bfhi(qq.y) * k0[3] + bflo(qq.z) * k1[0] + bfhi(qq.z) * k1[1] + bflo(qq.w) * k1[2] + bfhi(qq.w) * k1[3]; }
                a += __shfl_xor(a, 32); }
            gate[n] = a; asm volatile("" : "+v"(a) :: "memory"); }
        sel = 0u;
#pragma unroll
        for (int n = 0; n < 8; ++n) { int rank = 0;
#pragma unroll
            for (int mm = 0; mm < 8; ++mm) { if (mm != n) { const bool before = (gate[mm] > gate[n]) || (gate[mm] == gate[n] && mm < n); rank += (mm < qb && before) ? 1 : 0; } }
            if (n < qb && rank < 3) sel |= (1u << n); }
    }
    const int krow = (DQK == 64) ? (tid >> 3) : (tid / 12), kch = (DQK == 64) ? (tid & 7) : (tid % 12);
    const int krow2 = (tid + 512) / 12, kch2 = (tid + 512) % 12; const bool k2 = (DQK == 96) && (tid < 256);
    const int vrow = tid >> 3, vch = tid & 7;
    const unsigned kst = (unsigned)(krow * KSTR + kch * 16), kst2 = (unsigned)(krow2 * KSTR + kch2 * 16);
    const unsigned vst = (unsigned)((vch >> 2) * 4096 + (vrow >> 4) * 1024 + ((vrow >> 3) & 1) * 512 + (vrow & 7) * 64 + (vch & 3) * 16);
    const int NT = 4 * (qb + 1);
    auto tile_row0 = [&](int p) -> int { return (p < 4) ? (qb * 256 + p * 64) : ((p - 4) * 64); };
    v4u kreg, kreg2 = {0u, 0u, 0u, 0u}, vreg;
    { const int r0 = tile_row0(0);
      kreg = *(const GAS v4u*)(Kg + (size_t)(r0 + krow) * kpitch + kch * 8); if (k2) kreg2 = *(const GAS v4u*)(Kg + (size_t)(r0 + krow2) * kpitch + kch2 * 8);
      vreg = *(const GAS v4u*)(Vg + (size_t)(r0 + vrow) * vpitch + vch * 8);
      *(LAS v4u*)(Kl + kst) = kreg; if (k2) *(LAS v4u*)(Kl + kst2) = kreg2; *(LAS v4u*)(Vl + vst) = vreg; }
    __syncthreads();
    float m_run = 0.f, l_run = 0.f; f32x16 o0 = {}, o1 = {};
    f32x16 negm = {};
    constexpr float THR = 8.0f;
    const int qrel = wid * 32 + r32;
    const unsigned kfo = (unsigned)(r32 * KSTR + hi * 16);
    const unsigned vfo = (unsigned)(((lane >> 4) & 1) * 32 + (lane & 3) * 8 + (4 * hi + ((lane & 15) >> 2)) * 64);
    for (int p = 0; p < NT; ++p) {
        const int cb = p & 1;
        if (p + 1 < NT) { const int r0 = tile_row0(p + 1);
            kreg = *(const GAS v4u*)(Kg + (size_t)(r0 + krow) * kpitch + kch * 8); if (k2) kreg2 = *(const GAS v4u*)(Kg + (size_t)(r0 + krow2) * kpitch + kch2 * 8);
            vreg = *(const GAS v4u*)(Vg + (size_t)(r0 + vrow) * vpitch + vch * 8); }
        const bool need = !(p < 4 && p > (wid >> 1));
        if (need) {
            const LAS unsigned char* Kb = Kl + cb * KBUF + kfo; const LAS unsigned char* Vb = Vl + cb * VBUF + vfo;
            f32x16 s0 = negm, s1 = negm;
            bf16x8 kf[2 * ND];
#pragma unroll
            for (int d0 = 0; d0 < ND; ++d0) { kf[2 * d0] = *(const LAS bf16x8*)(Kb + d0 * 32); kf[2 * d0 + 1] = *(const LAS bf16x8*)(Kb + 32 * KSTR + d0 * 32); }
            __builtin_amdgcn_sched_barrier(0);
#pragma unroll
            for (int d0 = 0; d0 < ND; ++d0) { s0 = __builtin_amdgcn_mfma_f32_32x32x16_bf16(kf[2 * d0], qf[d0], s0, 0, 0, 0); s1 = __builtin_amdgcn_mfma_f32_32x32x16_bf16(kf[2 * d0 + 1], qf[d0], s1, 0, 0, 0); }
            s16x4 vt[16];
#pragma unroll
            for (int v = 0; v < 16; ++v) vt[v] = __builtin_bit_cast(s16x4, __builtin_amdgcn_ds_read_tr16_b64_v4i16((LAS s16x4*)(Vb + (v >> 2) * 1024 + ((v >> 1) & 1) * 4096 + (v & 1) * 512)));
            __builtin_amdgcn_sched_barrier(0);
            if (p < 4) { const int kb = 64 * p + 4 * hi;
#pragma unroll
                for (int r = 0; r < 16; ++r) { const int kv = kb + (r & 3) + 8 * (r >> 2); if (kv > qrel) s0[r] = -INFINITY; if (kv + 32 > qrel) s1[r] = -INFINITY; } }
            else if (MOBA) { if (!((sel >> ((p - 4) >> 2)) & 1u)) {
#pragma unroll
                for (int r = 0; r < 16; ++r) { s0[r] = -INFINITY; s1[r] = -INFINITY; } } }
            float ra = att_max3(s0[0], s0[1], s1[0]), rb = att_max3(s0[2], s0[3], s1[1]); ra = att_max3(ra, s1[2], s1[3]);
#pragma unroll
            for (int r = 4; r < 16; r += 4) { ra = att_max3(ra, s0[r], s0[r + 1]); rb = att_max3(rb, s0[r + 2], s0[r + 3]); ra = att_max3(ra, s1[r], s1[r + 1]); rb = att_max3(rb, s1[r + 2], s1[r + 3]); }
            float rm = fmaxf(ra, rb); rm = fmaxf(rm, __shfl_xor(rm, 32));
            if (p == 0 || __any(rm > THR)) {
                const float dl = (p == 0) ? rm : fmaxf(rm, 0.f); m_run += dl;
                const float fsc = __builtin_amdgcn_exp2f(-dl); l_run *= fsc;
#pragma unroll
                for (int r = 0; r < 16; ++r) { s0[r] -= dl; s1[r] -= dl; o0[r] *= fsc; o1[r] *= fsc; negm[r] = -m_run; }
            }
            float rs0 = 0.f, rs1 = 0.f;
#pragma unroll
            for (int r = 0; r < 16; ++r) { s0[r] = __builtin_amdgcn_exp2f(s0[r]); s1[r] = __builtin_amdgcn_exp2f(s1[r]); rs0 += s0[r]; rs1 += s1[r]; }
            l_run += rs0 + rs1;
            bf16x8 pf[4];
#pragma unroll
            for (int s = 0; s < 2; ++s) { v4u a, b;
                a.x = pg8::cvt_pk_bf16(s0[8 * s + 0], s0[8 * s + 1]); a.y = pg8::cvt_pk_bf16(s0[8 * s + 2], s0[8 * s + 3]); a.z = pg8::cvt_pk_bf16(s0[8 * s + 4], s0[8 * s + 5]); a.w = pg8::cvt_pk_bf16(s0[8 * s + 6], s0[8 * s + 7]);
                b.x = pg8::cvt_pk_bf16(s1[8 * s + 0], s1[8 * s + 1]); b.y = pg8::cvt_pk_bf16(s1[8 * s + 2], s1[8 * s + 3]); b.z = pg8::cvt_pk_bf16(s1[8 * s + 4], s1[8 * s + 5]); b.w = pg8::cvt_pk_bf16(s1[8 * s + 6], s1[8 * s + 7]);
                pf[s] = __builtin_bit_cast(bf16x8, a); pf[2 + s] = __builtin_bit_cast(bf16x8, b); }
#pragma unroll
            for (int s = 0; s < 4; ++s) {
                const bf16x8 va = (bf16x8){vt[4 * s][0], vt[4 * s][1], vt[4 * s][2], vt[4 * s][3], vt[4 * s + 1][0], vt[4 * s + 1][1], vt[4 * s + 1][2], vt[4 * s + 1][3]};
                const bf16x8 vb = (bf16x8){vt[4 * s + 2][0], vt[4 * s + 2][1], vt[4 * s + 2][2], vt[4 * s + 2][3], vt[4 * s + 3][0], vt[4 * s + 3][1], vt[4 * s + 3][2], vt[4 * s + 3][3]};
                o0 = __builtin_amdgcn_mfma_f32_32x32x16_bf16(va, pf[s], o0, 0, 0, 0);
                o1 = __builtin_amdgcn_mfma_f32_32x32x16_bf16(vb, pf[s], o1, 0, 0, 0); }
        }
        if (p + 1 < NT) { const int nb = cb ^ 1;
            *(LAS v4u*)(Kl + nb * KBUF + kst) = kreg; if (k2) *(LAS v4u*)(Kl + nb * KBUF + kst2) = kreg2; *(LAS v4u*)(Vl + nb * VBUF + vst) = vreg; }
        __syncthreads();
        __syncthreads();
    }
    l_run += __shfl_xor(l_run, 32);
    const float rl = 1.0f / l_run;
    { float ss = 0.f;
#pragma unroll
      for (int r = 0; r < 16; ++r) { const float a = o0[r] * rl, b = o1[r] * rl; ss += a * a + b * b; }
      ss += __shfl_xor(ss, 32);
      if (hi == 0) ((GAS float*)ossq_)[(size_t)(qb * 256 + wid * 32 + r32) * 16] = ss; }
    LAS unsigned char* stg = lds + 65536 + wid * 4608; const float rl16 = rl * 16.0f;
#pragma unroll
    for (int g = 0; g < 4; ++g) {
        *(LAS unsigned*)(stg + r32 * 80 + (8 * g + 4 * hi)) = pk4_fp8(o0[4 * g] * rl16, o0[4 * g + 1] * rl16, o0[4 * g + 2] * rl16, o0[4 * g + 3] * rl16);
        *(LAS unsigned*)(stg + r32 * 80 + (32 + 8 * g + 4 * hi)) = pk4_fp8(o1[4 * g] * rl16, o1[4 * g + 1] * rl16, o1[4 * g + 2] * rl16, o1[4 * g + 3] * rl16); }
    asm volatile("s_waitcnt lgkmcnt(0)" ::: "memory");
    GAS unsigned char* obase = (GAS unsigned char*)Og + (size_t)(qb * 256 + wid * 32) * opitch;
#pragma unroll
    for (int i = 0; i < 2; ++i) { const int row = i * 16 + (lane >> 2), ch = lane & 3; const v4u v = *(const LAS v4u*)(stg + row * 80 + ch * 16); *(GAS v4u*)(obase + (size_t)row * opitch + ch * 16) = v; }
    asm volatile("s_waitcnt lgkmcnt(0)" ::: "memory");
}

__device__ __forceinline__ void transpose_item(const float* W_, int ldw, bf16* WT, int ldt, int k0, int n0, int dr0, int dr1, LAS float* scr, int lane, const float* kgain = nullptr) {
    const GAS float* W = (const GAS float*)W_; const int q = lane & 15, kr = lane >> 4; const bool ld_ok = (q < 8) ? (dr0 >= 0) : (dr1 >= 0);
#pragma unroll 4
    for (int i = 0; i < 16; ++i) { const int kk = 4 * i + kr; f32x4 v = {0.f, 0.f, 0.f, 0.f}; if (ld_ok) v = *(const GAS f32x4*)(W + (size_t)(k0 + kk) * ldw + n0 + 4 * q);
        if (kgain) v = v * ((const GAS float*)kgain)[k0 + kk];
        LAS float* s = scr + kk * 65 + 4 * q; s[0] = v[0]; s[1] = v[1]; s[2] = v[2]; s[3] = v[3]; }
    asm volatile("s_waitcnt lgkmcnt(0)" ::: "memory");
    const int c = lane & 7;
#pragma unroll
    for (int j = 0; j < 8; ++j) { const int n = 8 * j + (lane >> 3); const LAS float* s = scr + (8 * c) * 65 + n; const int dr = (n < 32) ? dr0 : dr1;
        v4u o; o.x = pk2(s[0 * 65], s[1 * 65]); o.y = pk2(s[2 * 65], s[3 * 65]); o.z = pk2(s[4 * 65], s[5 * 65]); o.w = pk2(s[6 * 65], s[7 * 65]);
        if (dr >= 0) *(GAS v4u*)(WT + (size_t)(dr + (n & 31)) * ldt + k0 + 8 * c) = o; }
    asm volatile("s_waitcnt lgkmcnt(0)" ::: "memory");
}

__device__ __forceinline__ void transpose_item8(const float* W_, int ldw, unsigned char* WT8, int ldt, int k0, int n0, int dr0, int dr1, LAS float* scr, int lane, float scale, const float* kgain = nullptr) {
    const GAS float* W = (const GAS float*)W_; const int q = lane & 15, kr = lane >> 4; const bool ld_ok = (q < 8) ? (dr0 >= 0) : (dr1 >= 0);
#pragma unroll 4
    for (int i = 0; i < 16; ++i) { const int kk = 4 * i + kr; f32x4 v = {0.f, 0.f, 0.f, 0.f}; if (ld_ok) v = *(const GAS f32x4*)(W + (size_t)(k0 + kk) * ldw + n0 + 4 * q);
        if (kgain) v = v * ((const GAS float*)kgain)[k0 + kk];
        v = v * scale;
        LAS float* s = scr + kk * 65 + 4 * q; s[0] = v[0]; s[1] = v[1]; s[2] = v[2]; s[3] = v[3]; }
    asm volatile("s_waitcnt lgkmcnt(0)" ::: "memory");
    const int c = lane & 7;
#pragma unroll
    for (int j = 0; j < 8; ++j) { const int n = 8 * j + (lane >> 3); const LAS float* s = scr + (8 * c) * 65 + n; const int dr = (n < 32) ? dr0 : dr1;
        v2u o; o.x = pk4_fp8(s[0 * 65], s[1 * 65], s[2 * 65], s[3 * 65]); o.y = pk4_fp8(s[4 * 65], s[5 * 65], s[6 * 65], s[7 * 65]);
        if (dr >= 0) *(GAS v2u*)((GAS unsigned char*)WT8 + (size_t)(dr + (n & 31)) * ldt + k0 + 8 * c) = o; }
    asm volatile("s_waitcnt lgkmcnt(0)" ::: "memory");
}

struct Args {
    const float* x; const float* attn_g; const float* w_in; const float* qlat_g; const float* w_qup; const float* kvlat_g; const float* w_kvup;
    const float* qhead_g; const float* khead_g; const float* mqhead_g; const float* mkhead_g; const float* onorm_a_g; const float* onorm_b_g; const float* w_out;
    const float* ffn_g; const float* w_rg; const float* b_rg; const float* w_re; const float* b_re; const float* w_gate; const float* w_up; const float* w_down;
    float* out; unsigned char* ws; int ph_lo, ph_hi;
};
enum { PH_PRO = 0, PH_PROJ, PH_UP, PH_ATTN, PH_OUT, PH_ROUTE, PH_GU, PH_D0, NPHASE };

__global__ void __launch_bounds__(512, 2) mk_fwd(Args A) {
    extern __shared__ __attribute__((aligned(16))) unsigned char lds_raw[];
    LAS unsigned char* lds = (LAS unsigned char*)lds_raw;
    const int tid0 = threadIdx.x;
    const int G = gridDim.x, bx = blockIdx.x;
#define NGW (G * 8)
#define PH_BEGIN int tid = threadIdx.x; asm volatile("" : "+v"(tid)); const int lane = tid & 63; const int wave = __builtin_amdgcn_readfirstlane(tid >> 6); const int gw = bx * 8 + wave; \
    const __attribute__((address_space(4))) Args* AP = (const __attribute__((address_space(4))) Args*)__builtin_amdgcn_kernarg_segment_ptr(); asm volatile("" : "+s"(AP)); \
    unsigned char* ws = AP->ws; (void)lane; (void)gw; (void)ws;
#define Win_t ((bf16*)(ws + WS_WIN))
#define Wq_t ((bf16*)(ws + WS_WQ))
#define Wkv_t ((bf16*)(ws + WS_WKV))
#define Wo_t ((bf16*)(ws + WS_WO))
#define Wgu_t ((bf16*)(ws + WS_WGU))
#define Wd_t ((bf16*)(ws + WS_WD))
#define ropeF ((float*)(ws + WS_ROPE))
#define ropeR (((float*)(ws + WS_ROPE)) + 2 * SEQ * 32)
#define kmean ((float*)(ws + WS_KMEAN))
#define XN ((bf16*)(ws + WS_XN))
#define X1B ((bf16*)(ws + WS_X1B))
#define VB ((bf16*)(ws + WS_VB))
#define YH ((bf16*)(ws + WS_YH))
#define Y0B ((bf16*)(ws + WS_Y0))
#define SSQ ((float*)(ws + WS_SSQ))
#define WREF ((float*)(ws + WS_WRE))
#define WRGF ((float*)(ws + WS_WRE + 131072))
#define OSSQ ((float*)(ws + WS_OSSQ))
#define QB ((bf16*)(ws + WS_QB))
#define KB ((bf16*)(ws + WS_KB))
#define QA ((bf16*)(ws + WS_QA))
#define VA ((bf16*)(ws + WS_VA))
#define KA ((bf16*)(ws + WS_KA))
#define QLN ((bf16*)(ws + WS_QLN))
#define KVLN ((bf16*)(ws + WS_KVLN))
#define HB ((bf16*)(ws + WS_H))
#define lists ((pg8::ListEnt*)(ws + WS_LISTS))
    volatile LAS unsigned* MISC = (volatile LAS unsigned*)(lds + LDSCTL_OFF);
    for (int u = tid0; u < (LDS_BYTES - LDSCTL_OFF) / 4; u += 512) ((LAS unsigned*)(lds + LDSCTL_OFF))[u] = 0u;
    __syncthreads();
    XcdBarrier bar = xcd_barrier_post((unsigned*)((gu32*)(A.ws + WS_CTL) + CW_BAR), MISC + 8);
    const int lo = A.ph_lo, hi = A.ph_hi;
#define IN(k) (lo <= (k) && (k) < hi)
#define MOE_SLOT(npn) ((G == 256) ? ((((bx >> 3) / (npn)) * 8 + (bx & 7)) * (npn) + ((bx >> 3) % (npn))) : bx)
#define SEAM(k) do { if (IN(k) && IN((k) + 1)) xcd_barrier(bar); } while (0)

    if (IN(PH_PRO)) { PH_BEGIN
        LAS float* scr = (LAS float*)(lds + wave * 16640);
        constexpr int I_IN = 16 * 31, I_QU = 4 * 12, I_KV = 2 * 16, I_WO = 16 * 16;
        constexpr int NITEMS = I_IN + I_QU + I_KV + I_WO;
        for (int it = gw; it < NITEMS; it += NGW) {
            int r = it;
            if (r < I_IN) { const int kb = r / 31, nb = r % 31; int dr[2];
#pragma unroll
                for (int h2 = 0; h2 < 2; ++h2) { const int gi = 2 * nb + h2;
                    if (gi < 13) dr[h2] = 32 * gi; else if (gi < 45) { const int q = (gi - 13) & 15, hh = q >> 1, bj = q & 1; dr[h2] = (gi < 29 ? 512 : 1024) + (hh >> 2) * 256 + bj * 128 + (hh & 3) * 32; } else if (gi < 61) dr[h2] = 1536 + (gi - 45) * 32; else dr[h2] = -1; }
                transpose_item(AP->w_in, NPROJ_REAL, Win_t, 1024, 64 * kb, 64 * nb, dr[0], dr[1], scr, lane); continue; } r -= I_IN;
            if (r < I_QU) { const int kb = r / 12, nb = r % 12; transpose_item(AP->w_qup, 768, Wq_t, 256, 64 * kb, 64 * nb, 64 * nb, 64 * nb + 32, scr, lane, AP->qlat_g); continue; } r -= I_QU;
            if (r < I_KV) { const int kb = r / 16, nb = r % 16; const int n0 = 64 * nb, hh = n0 >> 7, j0 = n0 & 127;
                const int d0 = (j0 < 64) ? ((hh >> 2) * 256 + (hh & 3) * 32) : (512 + hh * 64), d1 = (j0 < 64) ? (d0 + 128) : (d0 + 32);
                transpose_item(AP->w_kvup, 1024, Wkv_t, 256, 64 * kb, n0, d0, d1, scr, lane, AP->kvlat_g); continue; } r -= I_KV;
            if (r < I_WO) { const int kb = r / 16, nb = r % 16; transpose_item8(AP->w_out, 1024, (unsigned char*)Wo_t, 1024, 64 * kb, 64 * nb, 64 * nb, 64 * nb + 32, scr, lane, 32.0f, kb < 8 ? AP->onorm_a_g : AP->onorm_b_g - 512); continue; } r -= I_WO;
        }
        const int gt = bx * 512 + tid, NGT = G * 512;
        for (int i = gt; i < 96 * 128; i += NGT) *(GAS v4u*)(Win_t + (size_t)416 * 1024 + (size_t)i * 8) = (v4u){0u, 0u, 0u, 0u};
        for (int i = gt; i < 1024 * 16; i += NGT) *(GAS v4u*)(Wkv_t + (size_t)(i >> 4) * 256 + 128 + (i & 15) * 8) = (v4u){0u, 0u, 0u, 0u};
        for (int i = gt; i < SEQ * 48; i += NGT) {
            const int pos = i / 48, f = i % 48; const bool isF = f < 32; const int ff = isF ? f : f - 32;
            const double e = isF ? (double)ff / 32.0 : (double)ff / 16.0;
            const float invf = (float)exp2(-e * 13.287712379549449);
            const float ang = (float)pos * invf;
            const double a = (double)ang; const double kk = rint(a * 0.15915494309189535); const double rr = a - kk * 6.283185307179586;
            const float c = (float)cos(rr), s = (float)sin(rr);
            GAS float* rF = (GAS float*)ropeF; GAS float* rR = (GAS float*)ropeR;
            if (isF) { rF[pos * 32 + ff] = c; rF[SEQ * 32 + pos * 32 + ff] = s; } else { rR[pos * 16 + ff] = c; rR[SEQ * 16 + pos * 16 + ff] = s; }
        }
        for (int i = gt; i < 1024 * 8; i += NGT) { const float gk = AP->ffn_g[i >> 3]; *((GAS f32x4*)WREF + i) = *((const GAS f32x4*)AP->w_re + i) * gk; }
        for (int i = gt; i < 1024; i += NGT) { const float gk = AP->ffn_g[i]; *((GAS f32x4*)WRGF + i) = *((const GAS f32x4*)AP->w_rg + i) * gk; }
        for (int t = gw; t < T; t += 2 * NGW) {
            const int t2 = (t + NGW < T) ? t + NGW : t;
            const GAS f32x4* xr = (const GAS f32x4*)(AP->x + (size_t)t * D) + lane; const GAS f32x4* xr2 = (const GAS f32x4*)(AP->x + (size_t)t2 * D) + lane; f32x4 v[4], w[4]; float s = 0.f, s2 = 0.f;
#pragma unroll
            for (int j = 0; j < 4; ++j) { v[j] = xr[64 * j]; w[j] = xr2[64 * j]; }
#pragma unroll
            for (int j = 0; j < 4; ++j) { s += (v[j].x * v[j].x + v[j].y * v[j].y) + (v[j].z * v[j].z + v[j].w * v[j].w); s2 += (w[j].x * w[j].x + w[j].y * w[j].y) + (w[j].z * w[j].z + w[j].w * w[j].w); }
            const float rstd = 1.0f / sqrtf(wave_sum(s) * (1.f / D) + EPS), rstd2 = 1.0f / sqrtf(wave_sum(s2) * (1.f / D) + EPS);
            GAS unsigned long long* o8 = (GAS unsigned long long*)(XN + (size_t)t * D) + lane; GAS unsigned long long* o82 = (GAS unsigned long long*)(XN + (size_t)t2 * D) + lane;
#pragma unroll
            for (int j = 0; j < 4; ++j) { const f32x4 g = *((const GAS f32x4*)AP->attn_g + lane + 64 * j);
                o8[64 * j] = (unsigned long long)pk2(v[j].x * rstd * g.x, v[j].y * rstd * g.y) | ((unsigned long long)pk2(v[j].z * rstd * g.z, v[j].w * rstd * g.w) << 32);
                o82[64 * j] = (unsigned long long)pk2(w[j].x * rstd2 * g.x, w[j].y * rstd2 * g.y) | ((unsigned long long)pk2(w[j].z * rstd2 * g.z, w[j].w * rstd2 * g.w) << 32); }
        }
    }
    SEAM(PH_PRO);

    if (IN(PH_PROJ)) { PH_BEGIN
        pg8::Gemm g{XN, Win_t, T, NPROJ, D}; pg8::StaticOrder S; S.init(T, NPROJ, G, bx);
        pg8::EpiProj E{ws, WS_QLN, WS_KVLN, WS_QB, WS_KB, WS_VB, WS_SSQ, WS_KMEAN, WS_ROPE, AP->mqhead_g, AP->mkhead_g, C2B, EPS, SEQ};
        pg8::gemm_phase<pg8::EpiProj, pg8::StaticOrder, true, true>(lds, g, S, E);
    }
    SEAM(PH_PROJ);

    if (IN(PH_UP)) { PH_BEGIN
        { int K256 = 256; asm volatile("" : "+s"(K256)); pg8::Gemm g{QLN, Wq_t, T, 768, K256}; pg8::StaticOrder S; S.init(T, 768, G, bx); pg8::EpiBf16Rs E{QA, 768, SSQ, 0, 1.0f / 256.0f, EPS};
          pg8::gemm_phase<pg8::EpiBf16Rs, pg8::StaticOrder, true, true>(lds, g, S, E); }
        { int K256 = 256; asm volatile("" : "+s"(K256)); pg8::Gemm g{KVLN, Wkv_t, T, 1024, K256}; pg8::StaticOrder S; S.init(T, 1024, G, bx); pg8::EpiKv E{KA, VA, KVLN, SSQ, ropeR, AP->khead_g, EPS, SEQ};
          pg8::gemm_phase<pg8::EpiKv, pg8::StaticOrder, true, true>(lds, g, S, E); }
    }
    SEAM(PH_UP);

    if (IN(PH_ATTN)) { PH_BEGIN
        bf16* O = XN;
        auto moe_items = [&]() {
            LAS float* scr = (LAS float*)(lds + wave * 16640);
            constexpr int I_G = 32 * 64, I_U = 32 * 64, I_D = 32 * 64;
            for (int it = gw; it < I_G + I_U + I_D; it += NGW) {
                int r = it;
            if (r < I_G) { const int e = r >> 6, r2 = r & 63, kb = r2 >> 2, nb = r2 & 3; const int n0 = 64 * nb; const int d0 = (n0 >> 7) * 256 + (n0 & 127);
                    transpose_item8(AP->w_gate + (size_t)e * 1024 * 256, 256, (unsigned char*)Wgu_t + (size_t)e * 512 * 1024, 1024, 64 * kb, n0, d0, d0 + 32, scr, lane, 32.0f); continue; } r -= I_G;
                if (r < I_U) { const int e = r >> 6, r2 = r & 63, kb = r2 >> 2, nb = r2 & 3; const int n0 = 64 * nb; const int d0 = (n0 >> 7) * 256 + 128 + (n0 & 127);
                    transpose_item8(AP->w_up + (size_t)e * 1024 * 256, 256, (unsigned char*)Wgu_t + (size_t)e * 512 * 1024, 1024, 64 * kb, n0, d0, d0 + 32, scr, lane, 32.0f); continue; } r -= I_U;
                { const int e = r >> 6, r2 = r & 63, kb = r2 >> 4, nb = r2 & 15;
                    transpose_item8(AP->w_down + (size_t)e * 256 * 1024, 1024, (unsigned char*)Wd_t + (size_t)e * 1024 * 256, 256, 64 * kb, 64 * nb, 64 * nb, 64 * nb + 32, scr, lane, 16.0f); }
        }
        };
        int ucnt = 0; const int uconv = bx & 7;
        for (int u = bx; u < 512; u += G) {
            const int bh = u & 255, b = bh >> 3, h = bh & 7; const size_t r0 = (size_t)b * SEQ;
            if (u < 256) {
                for (int qb = 7; qb >= 0; --qb) { if (ucnt++ == uconv) { __syncthreads(); moe_items(); __syncthreads(); }
                    attn_unit<96, false, true>(lds, AP->qhead_g, ropeR, QA + r0 * 768 + h * 96, 768, KA + r0 * 768 + h * 96, 768, VA + r0 * 512 + h * 64, 512, (bf16*)((unsigned char*)O + r0 * 1024 + h * 64), 1024, OSSQ + r0 * 16 + h, qb, nullptr, 0); }
            } else {
                for (int qb = 7; qb >= 0; --qb) { if (ucnt++ == uconv) { __syncthreads(); moe_items(); __syncthreads(); }
                    attn_unit<64, true, false>(lds, nullptr, nullptr, QB + r0 * 512 + h * 64, 512, KB + r0 * 512 + h * 64, 512, VB + r0 * 512 + h * 64, 512, (bf16*)((unsigned char*)O + r0 * 1024 + 512 + h * 64), 1024, OSSQ + r0 * 16 + 8 + h, qb, kmean + ((size_t)b * 8 * NH + h) * 64, NH * 64); }
            }
        }
        if (ucnt <= uconv) { __syncthreads(); moe_items(); __syncthreads(); }
    }
    SEAM(PH_ATTN);

    if (IN(PH_OUT)) { PH_BEGIN
        pg8::Gemm g{XN, Wo_t, T, D, D / 2};        pg8::StaticOrder S; S.init(T, D, G, bx);
        LAS float* rsl = (LAS float*)(lds + RING_BYTES);
        { pg8::Unit uu;
          for (int i = 0; i < 12 && S.next(i, uu); ++i) if (tid < 256) { const GAS f32x4* pq = (const GAS f32x4*)((const GAS float*)OSSQ + (size_t)(uu.pm * 256 + tid) * 16); const f32x4 a0 = pq[0], a1 = pq[1], b0 = pq[2], b1 = pq[3];
              const float sa = ((a0[0] + a0[1]) + (a0[2] + a0[3])) + ((a1[0] + a1[1]) + (a1[2] + a1[3])), sb = ((b0[0] + b0[1]) + (b0[2] + b0[3])) + ((b1[0] + b1[1]) + (b1[2] + b1[3]));
              const float ra = 1.0f / sqrtf(sa * (1.0f / 512.0f) + EPS), rb = 1.0f / sqrtf(sb * (1.0f / 512.0f) + EPS);
              *(LAS f32x2*)(rsl + (i * 256 + tid) * 2) = (f32x2){ra / rb, rb}; }
          __syncthreads(); }
        pg8::EpiOut E{AP->x, X1B, rsl};
        pg8::gemm_phase<pg8::EpiOut, pg8::StaticOrder, true, true, false, false, true, 0x7a7a7a7a, 0x7b7b7b7b, true>(lds, g, S, E);
    }
    SEAM(PH_OUT);

    if (IN(PH_ROUTE)) { PH_BEGIN
        LAS float* Wrg = (LAS float*)(lds + P8_WRG); LAS float* xt = (LAS float*)(lds + P8_XT + wave * P8_XT_WAVE); LAS float* wc = (LAS float*)(lds + P8_WC);
        LAS int* rt_g = (LAS int*)(lds + P8_RT); LAS float* rt_w = (LAS float*)(lds + P8_RT + 1024); LAS int* rt_rank = (LAS int*)(lds + P8_RT + 3072);
        LAS int* lcnt = (LAS int*)(lds + P8_RT + 4096); LAS int* lbase = (LAS int*)(lds + P8_RT + 4608); LAS float* rt_rs = (LAS float*)(lds + P8_RT + 5120);
        for (int k = tid; k < 1024; k += 512) *(LAS f32x4*)(Wrg + 4 * k) = *((const GAS f32x4*)WRGF + k);
        __syncthreads();
        const int r32 = lane & 31, kh = lane >> 5;
        for (int chunk = bx; chunk < T / 256; chunk += G) {
            if (tid < NCLS) lcnt[tid] = 0;
            const int rowc = wave * 32 + r32; const size_t row0w = (size_t)chunk * 256 + wave * 32;
            const GAS bf16* xsrc = (const GAS bf16*)X1B + (row0w + (lane >> 4)) * D + 4 * (lane & 15);
            f32x16 accE = {}; float aG0 = 0.f, aG1 = 0.f, aG2 = 0.f, aG3 = 0.f, ssq = 0.f;
            *(LAS f32x4*)(wc + 4 * tid) = *((const GAS f32x4*)WREF + tid);
            for (int kc = 0; kc < 16; ++kc) {
                f32x4 st[8];
#pragma unroll
                for (int j = 0; j < 8; ++j) { const v2u xw = *(const GAS v2u*)(xsrc + (size_t)(4 * j) * D + kc * 64); st[j] = (f32x4){bflo(xw.x), bfhi(xw.x), bflo(xw.y), bfhi(xw.y)}; }
                f32x4 wnext = {0.f, 0.f, 0.f, 0.f}; if (kc + 1 < 16) wnext = *((const GAS f32x4*)WREF + (kc + 1) * 512 + tid);
#pragma unroll
                for (int j = 0; j < 8; ++j) *(LAS f32x4*)(xt + ((lane >> 4) + 4 * j) * 68 + 4 * (lane & 15)) = st[j];
                if (kc + 1 < 16) *(LAS f32x4*)(wc + ((kc + 1) & 1) * 2048 + 4 * tid) = wnext;
                { const f32x4 gv = *(const GAS f32x4*)((const GAS float*)AP->ffn_g + kc * 64 + 4 * (lane & 15));
#pragma unroll
                  for (int j = 0; j < 8; ++j) { const f32x4 hv = st[j] * gv;
                      *(GAS unsigned*)((GAS unsigned char*)YH + (size_t)(row0w + (lane >> 4) + 4 * j) * D + kc * 64 + 4 * (lane & 15)) = pk4_fp8(hv[0], hv[1], hv[2], hv[3]); } }
                __syncthreads();
                const LAS float* wcc = wc + (kc & 1) * 2048 + r32;
#pragma unroll
                for (int c = 0; c < 8; ++c) {
                    const f32x4 xv = *(const LAS f32x4*)(xt + r32 * 68 + 8 * c + 4 * kh);
                    ssq += (xv.x * xv.x + xv.y * xv.y) + (xv.z * xv.z + xv.w * xv.w);
#pragma unroll
                    for (int e = 0; e < 4; ++e) { const int kl = 8 * c + 4 * kh + e;
                        const float a = wcc[kl * 32]; accE = __builtin_amdgcn_mfma_f32_32x32x2f32(a, xv[e], accE, 0, 0, 0);
                        const f32x4 wg = *(const LAS f32x4*)(Wrg + 4 * (kc * 64 + kl)); aG0 += xv[e] * wg[0]; aG1 += xv[e] * wg[1]; aG2 += xv[e] * wg[2]; aG3 += xv[e] * wg[3]; }
                }
                __syncthreads();
            }
            ssq += __shfl_xor(ssq, 32); aG0 += __shfl_xor(aG0, 32); aG1 += __shfl_xor(aG1, 32); aG2 += __shfl_xor(aG2, 32); aG3 += __shfl_xor(aG3, 32);
            const float rstd = 1.0f / sqrtf(ssq * (1.f / D) + EPS);
            float lg[4] = {aG0 * rstd + AP->b_rg[0], aG1 * rstd + AP->b_rg[1], aG2 * rstd + AP->b_rg[2], aG3 * rstd + AP->b_rg[3]};
            int gs = 0; float gm = lg[0];
#pragma unroll
            for (int i = 1; i < 4; ++i) if (lg[i] > gm) { gm = lg[i]; gs = i; }
            float den = 0.f;
#pragma unroll
            for (int i = 0; i < 4; ++i) den += __expf(lg[i] - gm);
            const float gwt = 1.0f / den;
            float mine[4];
#pragma unroll
            for (int i = 0; i < 4; ++i) { const float v = (gs == 0) ? accE[i] : (gs == 1) ? accE[4 + i] : (gs == 2) ? accE[8 + i] : accE[12 + i]; mine[i] = v * rstd + AP->b_re[gs * 8 + 4 * kh + i]; }
            float ev[8];
#pragma unroll
            for (int i = 0; i < 4; ++i) { const float oth = __shfl_xor(mine[i], 32); ev[i] = kh ? oth : mine[i]; ev[4 + i] = kh ? mine[i] : oth; }
            int e1 = 0; float v1 = ev[0];
#pragma unroll
            for (int i = 1; i < 8; ++i) if (ev[i] > v1) { v1 = ev[i]; e1 = i; }
            int e2 = -1; float v2 = -INFINITY;
#pragma unroll
            for (int i = 0; i < 8; ++i) if (i != e1 && (e2 < 0 || ev[i] > v2)) { v2 = ev[i]; e2 = i; }
            const float ex = __expf(v2 - v1); const float w1 = gwt / (1.0f + ex), w2 = gwt * ex / (1.0f + ex);
            if (kh == 0) { const int elo = e1 < e2 ? e1 : e2, ehi = e1 < e2 ? e2 : e1;
                rt_g[rowc] = gs * 28 + ((elo * (15 - elo)) >> 1) + (ehi - elo - 1); rt_w[rowc * 2] = e1 < e2 ? w1 : w2; rt_w[rowc * 2 + 1] = e1 < e2 ? w2 : w1; rt_rs[rowc] = rstd; }
            __syncthreads();
            if (tid < 256) rt_rank[tid] = __hip_atomic_fetch_add(&lcnt[rt_g[tid]], 1, __ATOMIC_RELAXED, __HIP_MEMORY_SCOPE_WORKGROUP);
            __syncthreads();
            if (tid < NCLS) { const int n = lcnt[tid]; lbase[tid] = n ? (int)__hip_atomic_fetch_add((gu32*)(ws + WS_CTL) + CW_GCNT + 64 * tid, (unsigned)n, RLX_AGENT) : 0; }
            __syncthreads();
            if (tid < 256) { const int g = rt_g[tid]; v4u ev; ev.x = (unsigned)(chunk * 256 + tid); ev.y = __builtin_bit_cast(unsigned, rt_w[tid * 2]); ev.z = __builtin_bit_cast(unsigned, rt_w[tid * 2 + 1]); ev.w = __builtin_bit_cast(unsigned, rt_rs[tid]);
                ((GAS v4u*)lists)[(size_t)g * LIST_CAP + lbase[g] + rt_rank[tid]] = ev; }
            __syncthreads();
        }
    }
    SEAM(PH_ROUTE);

    LAS int* tp = (LAS int*)(lds + TP_OFF); LAS int* cntl = (LAS int*)(lds + CNT_OFF); LAS int* ptab = (LAS int*)(lds + PT_OFF);
    if (hi > PH_ROUTE) {
        if (tid0 == 0) { gu32* ctl = (gu32*)(A.ws + WS_CTL); int acc = 0; for (int g = 0; g < NCLS; ++g) { const int n = (int)__hip_atomic_load(ctl + CW_GCNT + 64 * g, RLX_AGENT); cntl[g] = n; tp[g] = acc; acc += (n + 255) >> 8; } tp[NCLS] = acc;
            int p = 0; for (int lo_ = 0; lo_ < 8; ++lo_) for (int hi_ = lo_ + 1; hi_ < 8; ++hi_) ptab[p++] = lo_ | (hi_ << 4); }
        __syncthreads();
    }

    if (IN(PH_GU)) { PH_BEGIN
        pg8::Gemm g{YH, Wgu_t, 0, 0, D / 2}; pg8::ClsOrder S{tp, ptab, 0, G, MOE_SLOT(4), lists, cntl};
        pg8::EpiGateUp2 E{HB, lists, cntl};
        pg8::gemm_phase<pg8::EpiGateUp2, pg8::ClsOrder, true, true, true, false, true>(lds, g, S, E);
    }
    SEAM(PH_GU);

    if (IN(PH_D0)) { PH_BEGIN
        int K512 = 256; asm volatile("" : "+s"(K512)); pg8::Gemm g{HB, Wd_t, 0, 0, K512};        pg8::ClsOrder S{tp, ptab, 1, G, MOE_SLOT(4), lists, cntl};
        pg8::EpiDown2 E{AP->out, X1B, lists, cntl};
        pg8::gemm_phase<pg8::EpiDown2, pg8::ClsOrder, true, true, false, true, true, 0x7b7b7b7b, 0x7c7c7c7c, true>(lds, g, S, E);
    }
#undef IN
#undef SEAM
}

extern "C" void kernel_launch(void* const* d_in, const int* in_sizes, int n_in, void* d_out, int out_size, void* d_ws, size_t ws_size, hipStream_t stream) {
    static int grid = 0;
    if (grid == 0) {
        if (n_in != 22 || in_sizes[0] != T * D || out_size != T * D || ws_size < WS_END) { fprintf(stderr, "kernel_launch: unexpected shapes (n_in %d, in0 %d, out %d, ws %zu); nothing launched\n", n_in, n_in > 0 ? in_sizes[0] : -1, out_size, ws_size); grid = -1; return; }
        int dev = 0, cus = 0, per_cu = 0;
        if (hipGetDevice(&dev) != hipSuccess || hipDeviceGetAttribute(&cus, hipDeviceAttributeMultiprocessorCount, dev) != hipSuccess) { grid = -1; return; }
        if (hipFuncSetAttribute((const void*)mk_fwd, hipFuncAttributeMaxDynamicSharedMemorySize, LDS_BYTES) != hipSuccess) { fprintf(stderr, "kernel_launch: hipFuncSetAttribute failed\n"); grid = -1; return; }
        if (hipOccupancyMaxActiveBlocksPerMultiprocessor(&per_cu, (const void*)mk_fwd, 512, LDS_BYTES) != hipSuccess || per_cu < 1) { fprintf(stderr, "kernel_launch: occupancy query says %d\n", per_cu); }
        (void)hipGetLastError();
        grid = cus;
    }
    if (grid < 0) return;
    if (hipMemsetAsync((char*)d_ws + WS_CTL, 0, CTL_ZERO_BYTES, stream) != hipSuccess) return;
    Args a{};
    a.x = (const float*)d_in[0]; a.attn_g = (const float*)d_in[1]; a.w_in = (const float*)d_in[2]; a.qlat_g = (const float*)d_in[3]; a.w_qup = (const float*)d_in[4];
    a.kvlat_g = (const float*)d_in[5]; a.w_kvup = (const float*)d_in[6]; a.qhead_g = (const float*)d_in[7]; a.khead_g = (const float*)d_in[8];
    a.mqhead_g = (const float*)d_in[9]; a.mkhead_g = (const float*)d_in[10]; a.onorm_a_g = (const float*)d_in[11]; a.onorm_b_g = (const float*)d_in[12];
    a.w_out = (const float*)d_in[13]; a.ffn_g = (const float*)d_in[14]; a.w_rg = (const float*)d_in[15]; a.b_rg = (const float*)d_in[16];
    a.w_re = (const float*)d_in[17]; a.b_re = (const float*)d_in[18]; a.w_gate = (const float*)d_in[19]; a.w_up = (const float*)d_in[20]; a.w_down = (const float*)d_in[21];
    a.out = (float*)d_out; a.ws = (unsigned char*)d_ws; a.ph_lo = 0; a.ph_hi = NPHASE;
    hipLaunchKernelGGL(mk_fwd, dim3(grid), dim3(512), LDS_BYTES, stream, a);
    (void)hipPeekAtLastError();
}
```

```cpp
#include <hip/hip_runtime.h>
#include <cstdio>
#include <cstdint>
namespace pg8 {
#define PG8_LAS __attribute__((address_space(3)))
typedef unsigned short bf16_t;
typedef short bf16x8 __attribute__((ext_vector_type(8)));
typedef float f32x4 __attribute__((ext_vector_type(4)));
typedef unsigned u32x4 __attribute__((ext_vector_type(4)));
constexpr int BM = 256, BK = 64, HALF = 128, HTB = HALF * BK * 2  , STAGE_BYTES = 8 * HTB, NXCD = 8, WGM = 8;

__host__ __device__ __forceinline__ int lds_byte(int r, int c) { const int st = (r >> 4) * 2 + (c >> 5), rr = r & 15, cc = c & 31, ob = rr * 64 + cc * 2; return st * 1024 + (ob ^ (((ob >> 9) & 1) << 5)); }
__host__ __device__ __forceinline__ void stage_rc(int b, int& R, int& C) { const int st = b / 1024, sb = b % 1024, swz = sb ^ (((sb >> 9) & 1) << 5); R = (st >> 1) * 16 + swz / 64; C = (st & 1) * 32 + (swz % 64) / 2; }
__host__ __device__ __forceinline__ int perm32(int rho) { const int n = rho >> 4, i = rho & 15; return 8 * (i >> 2) + 4 * n + (i & 3); }

struct Unit { int pm, pn, g0, g1, pn2, q; };
struct Gemm { const bf16_t* A; const bf16_t* Bt; int M, N, K; };

struct StaticOrder {
    int nM, nN, nwg, G, c;
    __host__ __device__ void init(int M, int N, int G_, int c_) { nM = M / BM; nN = N / BM; nwg = nM * nN; G = G_; c = c_; }
    __host__ __device__ bool next(int i, Unit& u) const {
        const long L = (long)i * G + c; if (L >= nwg) return false;
        int wgid = (int)L; { const int q = nwg / NXCD, r = nwg % NXCD, xcd = wgid % NXCD, off = wgid / NXCD; wgid = (xcd < r ? xcd * (q + 1) : r * (q + 1) + (xcd - r) * q) + off; }
        const int nig = WGM * nN, gid = wgid / nig, fm = gid * WGM, gsz = (nM - fm) < WGM ? (nM - fm) : WGM;
        u.pm = fm + ((wgid % nig) % gsz); u.pn = (wgid % nig) / gsz; u.g0 = i; u.g1 = 0; u.pn2 = 0; u.q = 0; return true;
    }
    __device__ __forceinline__ void a_ready(const Unit&) const {}
    __device__ __forceinline__ void done(const Unit&) const {}
};

__device__ __forceinline__ unsigned cvt_pk_bf16(float lo, float hi) { unsigned r; asm volatile("v_cvt_pk_bf16_f32 %0, %1, %2" : "=v"(r) : "v"(lo), "v"(hi)); return r; }
#define PG8_GAS __attribute__((address_space(1)))
struct ListEnt { int tok; float w_lo; float w_hi; float rstd; };

struct EpiBf16 {
    static constexpr bool PERM = true, AFTER_DRAIN = false, MIDHOOK = false;
    bf16_t* O; int ldc;
    __device__ __forceinline__ void operator()(const f32x4 (&acc)[2][2][4][2], const Unit& u, int wr, int wc, int fr, int fq) const {
        const int row0 = u.pm * BM + wr * 64 + fr; const int col0 = u.pn * BM + wc * 32 + 8 * fq;
#pragma unroll
        for (int ai = 0; ai < 2; ++ai)
#pragma unroll
            for (int m = 0; m < 4; ++m) { bf16_t* rowp = O + (size_t)(row0 + ai * HALF + m * 16) * ldc + col0;
#pragma unroll
                for (int bj = 0; bj < 2; ++bj) { const f32x4 v0 = acc[ai][bj][m][0], v1 = acc[ai][bj][m][1];
                    u32x4 w; w.x = cvt_pk_bf16(v0[0], v0[1]); w.y = cvt_pk_bf16(v0[2], v0[3]); w.z = cvt_pk_bf16(v1[0], v1[1]); w.w = cvt_pk_bf16(v1[2], v1[3]);
                    *(PG8_GAS u32x4*)(rowp + bj * HALF) = w; } }
    }
};
struct EpiBf16Rs {
    static constexpr bool PERM = true, AFTER_DRAIN = false, MIDHOOK = false;
    bf16_t* O; int ldc; const float* ssq; int off; float inv_n, eps;
    __device__ __forceinline__ void operator()(const f32x4 (&acc)[2][2][4][2], const Unit& u, int wr, int wc, int fr, int fq) const {
        const int row0 = u.pm * BM + wr * 64 + fr; const int col0 = u.pn * BM + wc * 32 + 8 * fq;
#pragma unroll
        for (int ai = 0; ai < 2; ++ai)
#pragma unroll
            for (int m = 0; m < 4; ++m) { const int row = row0 + ai * HALF + m * 16; PG8_GAS bf16_t* rowp = (PG8_GAS bf16_t*)O + (size_t)row * ldc + col0;
                const f32x4 sq = *(const PG8_GAS f32x4*)(ssq + (size_t)row * 8 + off); const float rs = 1.0f / sqrtf(((sq[0] + sq[1]) + (sq[2] + sq[3])) * inv_n + eps);
#pragma unroll
                for (int bj = 0; bj < 2; ++bj) { const f32x4 v0 = acc[ai][bj][m][0] * rs, v1 = acc[ai][bj][m][1] * rs;
                    u32x4 w; w.x = cvt_pk_bf16(v0[0], v0[1]); w.y = cvt_pk_bf16(v0[2], v0[3]); w.z = cvt_pk_bf16(v1[0], v1[1]); w.w = cvt_pk_bf16(v1[2], v1[3]);
                    *(PG8_GAS u32x4*)(rowp + bj * HALF) = w; } }
    }
};
struct EpiProj {
    static constexpr bool PERM = true, AFTER_DRAIN = false, MIDHOOK = false;
    unsigned char* ws; size_t o_qln, o_kvln, o_qb, o_kb, o_vb, o_ssq, o_kmean, o_rope; const float* gq; const float* gk; float qscale, eps; int seq;
    __device__ __forceinline__ void operator()(const f32x4 (&acc)[2][2][4][2], const Unit& u, int wr, int wc, int fr, int fq) const {
        const int pn = u.pn; const int row0 = u.pm * BM + wr * 64 + fr;
        bf16_t* const QLN = (bf16_t*)(ws + o_qln); bf16_t* const KVLN = (bf16_t*)(ws + o_kvln); bf16_t* const QB = (bf16_t*)(ws + o_qb); bf16_t* const KB = (bf16_t*)(ws + o_kb); bf16_t* const VB = (bf16_t*)(ws + o_vb);
        float* const SSQ = (float*)(ws + o_ssq); float* const kmean = (float*)(ws + o_kmean); const float* const rope = (const float*)(ws + o_rope);
        if (pn < 2) {
            PG8_GAS bf16_t* O = (PG8_GAS bf16_t*)(pn ? KVLN : QLN); PG8_GAS float* sq = (PG8_GAS float*)SSQ;
#pragma unroll
            for (int ai = 0; ai < 2; ++ai)
#pragma unroll
                for (int m = 0; m < 4; ++m) { const int row = row0 + ai * HALF + m * 16; PG8_GAS bf16_t* rowp = O + (size_t)row * 256 + wc * 32 + 8 * fq; float ss = 0.f;
#pragma unroll
                    for (int bj = 0; bj < 2; ++bj) { const f32x4 v0 = acc[ai][bj][m][0], v1 = acc[ai][bj][m][1];
                        if (pn == 0 || bj == 0) ss += (v0[0] * v0[0] + v0[1] * v0[1]) + (v0[2] * v0[2] + v0[3] * v0[3]) + (v1[0] * v1[0] + v1[1] * v1[1]) + (v1[2] * v1[2] + v1[3] * v1[3]);
                        u32x4 w; w.x = cvt_pk_bf16(v0[0], v0[1]); w.y = cvt_pk_bf16(v0[2], v0[3]); w.z = cvt_pk_bf16(v1[0], v1[1]); w.w = cvt_pk_bf16(v1[2], v1[3]);
                        *(PG8_GAS u32x4*)(rowp + bj * HALF) = w; }
                    ss += __shfl_xor(ss, 16); ss += __shfl_xor(ss, 32);
                    if (fq == 0) sq[(size_t)row * 8 + pn * 4 + wc] = ss; }
        } else if (pn < 6) {
            const bool isk = pn >= 4; const int head = (pn & 1) * 4 + wc; const float* gp = isk ? gk : gq; asm volatile("" : "+s"(gp)); const float sc = isk ? 1.0f : qscale;
            PG8_GAS bf16_t* O = (PG8_GAS bf16_t*)(isk ? KB : QB);
            f32x4 g0[2], g1[2];
#pragma unroll
            for (int n = 0; n < 2; ++n) { g0[n] = *(const PG8_GAS f32x4*)(gp + 8 * fq + 4 * n); g1[n] = *(const PG8_GAS f32x4*)(gp + 32 + 8 * fq + 4 * n); }
            f32x4 cs0[2] = {{0.f, 0.f, 0.f, 0.f}, {0.f, 0.f, 0.f, 0.f}}, cs1[2] = {{0.f, 0.f, 0.f, 0.f}, {0.f, 0.f, 0.f, 0.f}};
#pragma unroll
            for (int ai = 0; ai < 2; ++ai)
#pragma unroll
                for (int m = 0; m < 4; ++m) { const int row = row0 + ai * HALF + m * 16; const int pos = row & (seq - 1);
                    float ss = 0.f;
#pragma unroll
                    for (int n = 0; n < 2; ++n) { const f32x4 a = acc[ai][0][m][n], b = acc[ai][1][m][n]; ss += (a[0] * a[0] + a[1] * a[1]) + (a[2] * a[2] + a[3] * a[3]) + (b[0] * b[0] + b[1] * b[1]) + (b[2] * b[2] + b[3] * b[3]); }
                    ss += __shfl_xor(ss, 16); ss += __shfl_xor(ss, 32);
                    const float rs = 1.0f / sqrtf(ss * (1.0f / 64.0f) + eps);
                    u32x4 w1, w2; unsigned pk1[4], pk2_[4];
#pragma unroll
                    for (int n = 0; n < 2; ++n) { const f32x4 c = *(const PG8_GAS f32x4*)(rope + (size_t)pos * 32 + 8 * fq + 4 * n), sn = *(const PG8_GAS f32x4*)(rope + (size_t)seq * 32 + (size_t)pos * 32 + 8 * fq + 4 * n);
                        const f32x4 y1 = acc[ai][0][m][n] * rs * g0[n], y2 = acc[ai][1][m][n] * rs * g1[n];
                        const f32x4 o1 = (y1 * c - y2 * sn) * sc, o2 = (y2 * c + y1 * sn) * sc;
                        if (isk) { cs0[n] += o1; cs1[n] += o2; }
                        pk1[2 * n] = cvt_pk_bf16(o1[0], o1[1]); pk1[2 * n + 1] = cvt_pk_bf16(o1[2], o1[3]); pk2_[2 * n] = cvt_pk_bf16(o2[0], o2[1]); pk2_[2 * n + 1] = cvt_pk_bf16(o2[2], o2[3]); }
                    w1.x = pk1[0]; w1.y = pk1[1]; w1.z = pk1[2]; w1.w = pk1[3]; w2.x = pk2_[0]; w2.y = pk2_[1]; w2.z = pk2_[2]; w2.w = pk2_[3];
                    PG8_GAS bf16_t* rowp = O + (size_t)row * 512 + head * 64 + 8 * fq;
                    *(PG8_GAS u32x4*)rowp = w1; *(PG8_GAS u32x4*)(rowp + 32) = w2;
                    asm volatile("" : "+v"(cs0[0]), "+v"(cs0[1]), "+v"(cs1[0]), "+v"(cs1[1]) :: "memory"); }
            if (isk) {
                PG8_GAS float* km = (PG8_GAS float*)kmean + ((size_t)u.pm * 8 + head) * 64;
#pragma unroll
                for (int n = 0; n < 2; ++n)
#pragma unroll
                    for (int j = 0; j < 4; ++j) { float a = cs0[n][j], b = cs1[n][j];
#pragma unroll
                        for (int o = 1; o < 16; o <<= 1) { a += __shfl_xor(a, o); b += __shfl_xor(b, o); }
                        if (fr == 0) { __hip_atomic_fetch_add(km + 8 * fq + 4 * n + j, a * (1.0f / 256.0f), __ATOMIC_RELAXED, __HIP_MEMORY_SCOPE_AGENT); __hip_atomic_fetch_add(km + 32 + 8 * fq + 4 * n + j, b * (1.0f / 256.0f), __ATOMIC_RELAXED, __HIP_MEMORY_SCOPE_AGENT); } }
            }
        } else {
            PG8_GAS bf16_t* O = (PG8_GAS bf16_t*)VB; const int col0 = (pn - 6) * BM + wc * 32 + 8 * fq;
#pragma unroll
            for (int ai = 0; ai < 2; ++ai)
#pragma unroll
                for (int m = 0; m < 4; ++m) { PG8_GAS bf16_t* rowp = O + (size_t)(row0 + ai * HALF + m * 16) * 512 + col0;
#pragma unroll
                    for (int bj = 0; bj < 2; ++bj) { const f32x4 v0 = acc[ai][bj][m][0], v1 = acc[ai][bj][m][1];
                        u32x4 w; w.x = cvt_pk_bf16(v0[0], v0[1]); w.y = cvt_pk_bf16(v0[2], v0[3]); w.z = cvt_pk_bf16(v1[0], v1[1]); w.w = cvt_pk_bf16(v1[2], v1[3]);
                        *(PG8_GAS u32x4*)(rowp + bj * HALF) = w; } }
        }
    }
};
struct EpiKv {
    static constexpr bool PERM = true, AFTER_DRAIN = false, MIDHOOK = false;
    bf16_t* KA; bf16_t* VA; const bf16_t* KVLN; const float* ssq; const float* ropeR; const float* gk; float eps; int seq;
    __device__ __forceinline__ void operator()(const f32x4 (&acc)[2][2][4][2], const Unit& u, int wr, int wc, int fr, int fq) const {
        const int pn = u.pn; const int row0 = u.pm * BM + wr * 64 + fr;
        if (pn < 2) {
            const int head = pn * 4 + wc; const float* gp = gk; asm volatile("" : "+s"(gp));
            f32x4 g0[2], g1[2];
#pragma unroll
            for (int n = 0; n < 2; ++n) { g0[n] = *(const PG8_GAS f32x4*)(gp + 8 * fq + 4 * n); g1[n] = *(const PG8_GAS f32x4*)(gp + 32 + 8 * fq + 4 * n); }
            const f32x4 gr1 = *(const PG8_GAS f32x4*)(gp + 64 + 4 * fq), gr2 = *(const PG8_GAS f32x4*)(gp + 80 + 4 * fq);
#pragma unroll
            for (int ai = 0; ai < 2; ++ai)
#pragma unroll
                for (int m = 0; m < 4; ++m) { const int row = row0 + ai * HALF + m * 16; const int pos = row & (seq - 1);
                    const f32x4 sq = *(const PG8_GAS f32x4*)(ssq + (size_t)row * 8 + 4); const float rl = 1.0f / sqrtf(((sq[0] + sq[1]) + (sq[2] + sq[3])) * (1.0f / 128.0f) + eps);
                    const PG8_GAS bf16_t* pe = (const PG8_GAS bf16_t*)KVLN + (size_t)row * 256 + 128 + 4 * fq;
                    typedef unsigned u32x2_ __attribute__((ext_vector_type(2)));
                    const u32x2_ p1 = *(const PG8_GAS u32x2_*)pe, p2 = *(const PG8_GAS u32x2_*)(pe + 16);
                    const f32x4 e1 = {__builtin_bit_cast(float, p1.x << 16), __builtin_bit_cast(float, p1.x & 0xffff0000u), __builtin_bit_cast(float, p1.y << 16), __builtin_bit_cast(float, p1.y & 0xffff0000u)};
                    const f32x4 e2 = {__builtin_bit_cast(float, p2.x << 16), __builtin_bit_cast(float, p2.x & 0xffff0000u), __builtin_bit_cast(float, p2.y << 16), __builtin_bit_cast(float, p2.y & 0xffff0000u)};
                    f32x4 x0[2], x1[2]; float ss = (e1[0] * e1[0] + e1[1] * e1[1]) + (e1[2] * e1[2] + e1[3] * e1[3]) + (e2[0] * e2[0] + e2[1] * e2[1]) + (e2[2] * e2[2] + e2[3] * e2[3]);
#pragma unroll
                    for (int n = 0; n < 2; ++n) { x0[n] = acc[ai][0][m][n] * rl; x1[n] = acc[ai][1][m][n] * rl; const f32x4 a = x0[n], b = x1[n];
                        ss += (a[0] * a[0] + a[1] * a[1]) + (a[2] * a[2] + a[3] * a[3]) + (b[0] * b[0] + b[1] * b[1]) + (b[2] * b[2] + b[3] * b[3]); }
                    ss += __shfl_xor(ss, 16); ss += __shfl_xor(ss, 32);
                    const float rs = 1.0f / sqrtf(ss * (1.0f / 96.0f) + eps);
                    PG8_GAS bf16_t* rowp = (PG8_GAS bf16_t*)KA + (size_t)row * 768 + head * 96;
                    u32x4 w1, w2;
                    { const f32x4 a = x0[0] * rs * g0[0], b = x0[1] * rs * g0[1]; w1.x = cvt_pk_bf16(a[0], a[1]); w1.y = cvt_pk_bf16(a[2], a[3]); w1.z = cvt_pk_bf16(b[0], b[1]); w1.w = cvt_pk_bf16(b[2], b[3]); }
                    { const f32x4 a = x1[0] * rs * g1[0], b = x1[1] * rs * g1[1]; w2.x = cvt_pk_bf16(a[0], a[1]); w2.y = cvt_pk_bf16(a[2], a[3]); w2.z = cvt_pk_bf16(b[0], b[1]); w2.w = cvt_pk_bf16(b[2], b[3]); }
                    *(PG8_GAS u32x4*)(rowp + 8 * fq) = w1; *(PG8_GAS u32x4*)(rowp + 32 + 8 * fq) = w2;
                    const f32x4 c = *(const PG8_GAS f32x4*)(ropeR + (size_t)pos * 16 + 4 * fq), sn = *(const PG8_GAS f32x4*)(ropeR + (size_t)seq * 16 + (size_t)pos * 16 + 4 * fq);
                    const f32x4 y1 = e1 * rs * gr1, y2 = e2 * rs * gr2; const f32x4 o1 = y1 * c - y2 * sn, o2 = y2 * c + y1 * sn;
                    u32x2_ r1, r2; r1.x = cvt_pk_bf16(o1[0], o1[1]); r1.y = cvt_pk_bf16(o1[2], o1[3]); r2.x = cvt_pk_bf16(o2[0], o2[1]); r2.y = cvt_pk_bf16(o2[2], o2[3]);
                    *(PG8_GAS u32x2_*)(rowp + 64 + 4 * fq) = r1; *(PG8_GAS u32x2_*)(rowp + 80 + 4 * fq) = r2;
                    asm volatile("" ::: "memory"); }
        } else {
            const int col0 = (pn - 2) * BM + wc * 32 + 8 * fq;
#pragma unroll
            for (int ai = 0; ai < 2; ++ai)
#pragma unroll
                for (int m = 0; m < 4; ++m) { const int row = row0 + ai * HALF + m * 16; PG8_GAS bf16_t* rowp = (PG8_GAS bf16_t*)VA + (size_t)row * 512 + col0;
                    const f32x4 sq = *(const PG8_GAS f32x4*)(ssq + (size_t)row * 8 + 4); const float rl = 1.0f / sqrtf(((sq[0] + sq[1]) + (sq[2] + sq[3])) * (1.0f / 128.0f) + eps);
#pragma unroll
                    for (int bj = 0; bj < 2; ++bj) { const f32x4 v0 = acc[ai][bj][m][0] * rl, v1 = acc[ai][bj][m][1] * rl;
                        u32x4 w; w.x = cvt_pk_bf16(v0[0], v0[1]); w.y = cvt_pk_bf16(v0[2], v0[3]); w.z = cvt_pk_bf16(v1[0], v1[1]); w.w = cvt_pk_bf16(v1[2], v1[3]);
                        *(PG8_GAS u32x4*)(rowp + bj * HALF) = w; } }
        }
    }
};
struct EpiOut {
    static constexpr bool PERM = true, AFTER_DRAIN = false, MIDHOOK = true;
    const float* base; bf16_t* x1b; const PG8_LAS float* rsl;
    __device__ __forceinline__ void mid(f32x4 (&acc)[2][2][4][2], const Unit& u, int wr, int wc, int fr, int fq) const {
        const PG8_LAS float* rs = rsl + (u.g0 * 256 + wr * 64 + fr) * 2;
#pragma unroll
        for (int ai = 0; ai < 2; ++ai)
#pragma unroll
            for (int m = 0; m < 4; ++m) { const float ratio = rs[(ai * HALF + m * 16) * 2];
#pragma unroll
                for (int bj = 0; bj < 2; ++bj)
#pragma unroll
                    for (int n = 0; n < 2; ++n) acc[ai][bj][m][n] *= ratio; }
    }
    __device__ __forceinline__ void operator()(const f32x4 (&acc)[2][2][4][2], const Unit& u, int wr, int wc, int fr, int fq) const {
        const int row0 = u.pm * BM + wr * 64 + fr; const int col0 = u.pn * BM + wc * 32 + 8 * fq;
        const PG8_LAS float* rs = rsl + (u.g0 * 256 + wr * 64 + fr) * 2 + 1;
#pragma unroll
        for (int ai = 0; ai < 2; ++ai)
#pragma unroll
            for (int m = 0; m < 4; ++m) { const int row = row0 + ai * HALF + m * 16; const size_t off = (size_t)row * 1024 + col0; const float rb = rs[(ai * HALF + m * 16) * 2];
#pragma unroll
                for (int bj = 0; bj < 2; ++bj) { const size_t p = off + bj * HALF;
                    const f32x4 v0 = *(const PG8_GAS f32x4*)(base + p) + acc[ai][bj][m][0] * rb, v1 = *(const PG8_GAS f32x4*)(base + p + 4) + acc[ai][bj][m][1] * rb;
                    u32x4 o; o.x = cvt_pk_bf16(v0[0], v0[1]); o.y = cvt_pk_bf16(v0[2], v0[3]); o.z = cvt_pk_bf16(v1[0], v1[1]); o.w = cvt_pk_bf16(v1[2], v1[3]);
                    *(PG8_GAS u32x4*)(x1b + p) = o; }
                if (m & 1) asm volatile("" ::: "memory"); }
    }
};
struct EpiGateUp2 {
    static constexpr bool PERM = true, AFTER_DRAIN = false, MIDHOOK = false;
    bf16_t* H; const ListEnt* lists; const PG8_LAS int* cnt;
    __device__ __forceinline__ void operator()(const f32x4 (&acc)[2][2][4][2], const Unit& u, int wr, int wc, int fr, int fq) const {
        const int rt0 = wr * 64 + fr; const int col0 = (u.q >> 1) * 256 + (u.q & 1) * 128 + wc * 32 + 8 * fq; const int g = u.g0; const int n_g = cnt[g]; const bool hiexp = (u.q >> 1) != 0;
        const ListEnt* lg = lists + (size_t)g * 65536 + u.g1 * 256;
#pragma unroll
        for (int ai = 0; ai < 2; ++ai)
#pragma unroll
            for (int m = 0; m < 4; ++m) { const int rt = rt0 + ai * HALF + m * 16; const bool valid = (u.g1 * 256 + rt) < n_g;
                float w = 0.f, rsd = 0.f; if (valid) { const f32x4 le = *(const PG8_GAS f32x4*)((const PG8_GAS ListEnt*)lg + rt); w = hiexp ? le[2] : le[1]; rsd = le[3]; }
                unsigned pk[2];
#pragma unroll
                for (int n = 0; n < 2; ++n) { const f32x4 gv = acc[ai][0][m][n], uv = acc[ai][1][m][n]; float h[4];
#pragma unroll
                    for (int j = 0; j < 4; ++j) { const float a = gv[j] * rsd; const float s = a * __builtin_amdgcn_rcpf(1.0f + __builtin_amdgcn_exp2f(-1.4426950408889634f * a)); h[j] = valid ? s * (uv[j] * rsd) * w : 0.f; }
                    { int w_ = 0; w_ = __builtin_amdgcn_cvt_pk_fp8_f32(h[0] * 8.0f, h[1] * 8.0f, w_, false); w_ = __builtin_amdgcn_cvt_pk_fp8_f32(h[2] * 8.0f, h[3] * 8.0f, w_, true); pk[n] = (unsigned)w_; } }
                typedef unsigned u32x2h_ __attribute__((ext_vector_type(2))); u32x2h_ o; o.x = pk[0]; o.y = pk[1];
                *(PG8_GAS u32x2h_*)((PG8_GAS unsigned char*)H + (size_t)(u.pm * BM + rt) * 512 + col0) = o; }
    }
};
struct EpiDown2 {
    static constexpr bool PERM = true, AFTER_DRAIN = false, MIDHOOK = false;
    float* out; const bf16_t* x1b; const ListEnt* lists; const PG8_LAS int* cnt;
    __device__ __forceinline__ void operator()(const f32x4 (&acc)[2][2][4][2], const Unit& u, int wr, int wc, int fr, int fq) const {
        const int rt0 = wr * 64 + fr; const int col0 = u.q * 256 + wc * 32 + 8 * fq; const int g = u.g0; const int n_g = cnt[g];
        const ListEnt* lg = lists + (size_t)g * 65536 + u.g1 * 256;
#pragma unroll
        for (int ai = 0; ai < 2; ++ai)
#pragma unroll
            for (int m = 0; m < 4; ++m) { const int rt = rt0 + ai * HALF + m * 16; const bool valid = (u.g1 * 256 + rt) < n_g;
                if (valid) { const int tok = ((const PG8_GAS ListEnt*)lg)[rt].tok; PG8_GAS float* orow = (PG8_GAS float*)out + (size_t)tok * 1024 + col0;
#pragma unroll
                    for (int bj = 0; bj < 2; ++bj) { PG8_GAS float* p = orow + bj * HALF; const u32x4 xb = *(const PG8_GAS u32x4*)((const PG8_GAS bf16_t*)x1b + (size_t)tok * 1024 + col0 + bj * HALF);
                        f32x4 a, b; a[0] = __builtin_bit_cast(float, xb.x << 16); a[1] = __builtin_bit_cast(float, xb.x & 0xffff0000u); a[2] = __builtin_bit_cast(float, xb.y << 16); a[3] = __builtin_bit_cast(float, xb.y & 0xffff0000u);
                        b[0] = __builtin_bit_cast(float, xb.z << 16); b[1] = __builtin_bit_cast(float, xb.z & 0xffff0000u); b[2] = __builtin_bit_cast(float, xb.w << 16); b[3] = __builtin_bit_cast(float, xb.w & 0xffff0000u);
                        *(PG8_GAS f32x4*)p = a + acc[ai][bj][m][0]; *(PG8_GAS f32x4*)(p + 4) = b + acc[ai][bj][m][1]; } }
                if (m & 1) asm volatile("" ::: "memory"); }
    }
};
struct ClsOrder {
    const PG8_LAS int* tp; const PG8_LAS int* ptab; int mode, G, c; const ListEnt* lists; const PG8_LAS int* cnt;
    __device__ __forceinline__ int arow(const Unit& u, int row) const { const unsigned pos = (unsigned)(u.g1 * 256 + row); const unsigned n = (unsigned)cnt[u.g0]; const PG8_GAS ListEnt* lg = (const PG8_GAS ListEnt*)lists + (size_t)u.g0 * 65536; return lg[pos < n ? pos : 0u].tok; }
    __device__ __forceinline__ bool next(int i, Unit& u) const {
        const int nrb = tp[112]; const long L = (long)i * G + c; if (L >= (long)nrb * 4) return false;
        const int rbt = (int)(L >> 2), q = (int)(L & 3);
        int g = 0;
#pragma unroll
        for (int s = 64; s >= 1; s >>= 1) { const int gg = g + s; if (gg < 112 && tp[gg] <= rbt) g = gg; }
        const int grp = g / 28, pr = ptab[g - grp * 28], lo = pr & 15, hi = pr >> 4;
        u.pm = rbt; u.g0 = g; u.g1 = rbt - tp[g]; u.q = q;
        if (mode == 0) { u.pn = (grp * 8 + ((q >> 1) ? hi : lo)) * 2 + (q & 1); u.pn2 = 0; } else { u.pn = (grp * 8 + lo) * 4 + q; u.pn2 = (grp * 8 + hi) * 4 + q; }
        return true;
    }
    __device__ __forceinline__ void a_ready(const Unit&) const {}
    __device__ __forceinline__ void done(const Unit&) const {}
};

template <class Epi, class Sched, bool ALIGN_EPI = false, bool SP2 = false, bool GATHER = false, bool KSPLIT = false, bool F8 = false, int SCW = 0x7a7a7a7a, int SCA = 0x7f7f7f7f, bool F8ASM = false>
__device__ __forceinline__ void gemm_phase(PG8_LAS unsigned char* lds, const Gemm g, const Sched& S, const Epi& E) {
    const int tid = threadIdx.x, wid = __builtin_amdgcn_readfirstlane(tid >> 6), lane = tid & 63, wr = wid >> 2, wc = wid & 3, fr = lane & 15, fq = lane >> 4;
    const int K = g.K, nt = K / BK;
    const int PB = KSPLIT ? (K >> 1) : K;
    static_assert(!GATHER || SP2, "gathered A rows: SP2 loop only");
    unsigned voffA[2], voffB[2];
#pragma unroll
    for (int i = 0; i < 2; ++i) { int R, C; stage_rc(tid * 16 + i * 8192, R, C); const int Rb = Epi::PERM ? ((R & ~31) + perm32(R & 31)) : R;
        voffA[i] = (unsigned)(R * K + C) * 2u; voffB[i] = (unsigned)(Rb * PB + C) * 2u; }
    const size_t kstep = (size_t)(BK * 2);
    const size_t hstep = (size_t)HALF * K * 2;
    const size_t tstep = 2 * hstep;
    const size_t hstepB = (size_t)HALF * PB * 2, tstepB = 2 * hstepB;
    const unsigned ldsw = (unsigned)wid * 1024u;
    const int aoff = lds_byte(wr * 64 + fr, fq * 8), boff = lds_byte(wc * 32 + fr, fq * 8);
#define PG8_SA(b, h) (((b) * 2 + (h)) * HTB)
#define PG8_SB(b, h) ((4 + (b) * 2 + (h)) * HTB)
#define PG8_STAGE(bufoff, gbase, voff) do { _Pragma("unroll") for (int _i = 0; _i < 2; ++_i) \
        __builtin_amdgcn_global_load_lds((const unsigned*)((const char*)(gbase) + (voff)[_i]), (PG8_LAS unsigned*)(lds + (bufoff) + ldsw + _i * 8192), 16, 0, 0); } while (0)
#define PG8_LDA(dst, b, h) do { _Pragma("unroll") for (int m = 0; m < 4; ++m) _Pragma("unroll") for (int k = 0; k < 2; ++k) dst[m][k] = *(const PG8_LAS bf16x8*)(lds + PG8_SA(b, h) + aoff + m * 2048 + k * 1024); } while (0)
#define PG8_LDB(dst, b, h) do { _Pragma("unroll") for (int n = 0; n < 2; ++n) _Pragma("unroll") for (int k = 0; k < 2; ++k) dst[n][k] = *(const PG8_LAS bf16x8*)(lds + PG8_SB(b, h) + boff + n * 2048 + k * 1024); } while (0)
#define PG8_MMA(ai, bj, At, Bt) do { __builtin_amdgcn_s_setprio(1); _Pragma("unroll") for (int m = 0; m < 4; ++m) _Pragma("unroll") for (int n = 0; n < 2; ++n) { \
        if constexpr (F8) { typedef int v4i_ __attribute__((ext_vector_type(4))); typedef int v8i_ __attribute__((ext_vector_type(8))); \
            const v8i_ w8_ = __builtin_shufflevector(__builtin_bit_cast(v4i_, Bt[n][0]), __builtin_bit_cast(v4i_, Bt[n][1]), 0, 1, 2, 3, 4, 5, 6, 7); \
            const v8i_ a8_ = __builtin_shufflevector(__builtin_bit_cast(v4i_, At[m][0]), __builtin_bit_cast(v4i_, At[m][1]), 0, 1, 2, 3, 4, 5, 6, 7); \
            if constexpr (F8ASM) { asm volatile("v_mfma_scale_f32_16x16x128_f8f6f4 %0, %1, %2, %0, %3, %4 op_sel_hi:[0,0,0]" : "+v"(acc[ai][bj][m][n]) : "v"(w8_), "v"(a8_), "v"(SCW), "v"(SCA)); }     \
            else acc[ai][bj][m][n] = __builtin_amdgcn_mfma_scale_f32_16x16x128_f8f6f4(w8_, a8_, acc[ai][bj][m][n], 0, 0, 0, SCW, 0, SCA); } \
        else { _Pragma("unroll") for (int k = 0; k < 2; ++k) acc[ai][bj][m][n] = __builtin_amdgcn_mfma_f32_16x16x32_bf16(Bt[n][k], At[m][k], acc[ai][bj][m][n], 0, 0, 0); } } \
        __builtin_amdgcn_s_setprio(0); } while (0)
#define PG8_WAIT_V(n) asm volatile("s_waitcnt vmcnt(" #n ")" ::: "memory")
#define PG8_WAIT_L(n) asm volatile("s_waitcnt lgkmcnt(" #n ")" ::: "memory")
#define PG8_BAR __builtin_amdgcn_s_barrier()
#define PG8_SCHED __builtin_amdgcn_sched_barrier(0)
#define PG8_STG_A(b, h, ptr, arr) do { if constexpr (GATHER) { PG8_STAGE(PG8_SA(b, h), (ptr), (arr)[h]); } else { PG8_STAGE(PG8_SA(b, h), (ptr) + ((h) ? hstep : 0), voffA); } } while (0)
    unsigned cv[2][2] = {{0u, 0u}, {0u, 0u}}, nvp[2] = {0u, 0u};
#define PG8_GROWS(dst, unit) do { if constexpr (GATHER) { _Pragma("unroll") for (int _h = 0; _h < 2; ++_h) _Pragma("unroll") for (int _i = 0; _i < 2; ++_i) { int R_, C_; stage_rc(tid * 16 + _i * 8192, R_, C_); \
        dst[_h][_i] = (unsigned)S.arow(unit, _h * HALF + R_) * (unsigned)(K * 2) + (unsigned)(C_ * 2); } } } while (0)
    Unit cur, nxt; int ui = 0;
    if (!S.next(0, cur)) return;
    PG8_GROWS(cv, cur);
#define PG8_GROWS_P(unit) do { _Pragma("unroll") for (int _i = 0; _i < 2; ++_i) { int R_, C_; stage_rc(tid * 16 + _i * 8192, R_, C_); nvp[_i] = (unsigned)S.arow(unit, R_) | ((unsigned)S.arow(unit, HALF + R_) << 16); } } while (0)
#define PG8_UNPACK_NV() do { _Pragma("unroll") for (int _i = 0; _i < 2; ++_i) { int R_, C_; stage_rc(tid * 16 + _i * 8192, R_, C_); cv[0][_i] = (nvp[_i] & 0xffffu) * (unsigned)(K * 2) + (unsigned)(C_ * 2); cv[1][_i] = (nvp[_i] >> 16) * (unsigned)(K * 2) + (unsigned)(C_ * 2); } } while (0)
    f32x4 acc[2][2][4][2];
#pragma unroll
    for (int a = 0; a < 2; ++a)
#pragma unroll
        for (int b = 0; b < 2; ++b)
#pragma unroll
            for (int m = 0; m < 4; ++m)
#pragma unroll
                for (int n = 0; n < 2; ++n) acc[a][b][m][n] = (f32x4){0.f, 0.f, 0.f, 0.f};
    bf16x8 At[4][2], B0[2][2], B1[2][2];
    const char* cA = (const char*)g.A + (GATHER ? (size_t)0 : (size_t)cur.pm * tstep); const char* cB = (const char*)g.Bt + (size_t)cur.pn * tstepB; const char* cB2 = KSPLIT ? (const char*)g.Bt + (size_t)cur.pn2 * tstepB : cB;
    S.a_ready(cur);
    if constexpr (SP2) {
        PG8_STAGE(PG8_SB(0, 0), cB, voffB); PG8_STAGE(PG8_SB(0, 1), cB + hstepB, voffB); PG8_STG_A(0, 0, cA, cv); PG8_STG_A(0, 1, cA, cv);
        if (wr == 1) PG8_BAR;
        PG8_WAIT_V(2); PG8_BAR;
        PG8_STAGE(PG8_SB(1, 0), cB + kstep, voffB); PG8_STG_A(1, 0, cA + kstep, cv); PG8_STAGE(PG8_SB(1, 1), cB + hstepB + kstep, voffB);
        PG8_WAIT_V(6); PG8_BAR;
    } else {
        PG8_STAGE(PG8_SB(0, 0), cB, voffB); PG8_STAGE(PG8_SA(0, 0), cA, voffA); PG8_STAGE(PG8_SB(0, 1), cB + hstepB, voffB); PG8_STAGE(PG8_SA(0, 1), cA + hstep, voffA);
        if (wr == 1) PG8_BAR;
        PG8_WAIT_V(4); PG8_BAR;
        PG8_STAGE(PG8_SB(1, 0), cB + kstep, voffB); PG8_STAGE(PG8_SA(1, 0), cA + kstep, voffA); PG8_STAGE(PG8_SB(1, 1), cB + hstepB + kstep, voffB);
        PG8_WAIT_V(6); PG8_BAR;
    }
    for (;;) {
        const bool has_next = S.next(ui + 1, nxt);
        const char* nA = (has_next && !GATHER) ? (const char*)g.A + (size_t)nxt.pm * tstep : cA; const char* nB = has_next ? (const char*)g.Bt + (size_t)nxt.pn * tstepB : cB; const char* nB2 = (KSPLIT && has_next) ? (const char*)g.Bt + (size_t)nxt.pn2 * tstepB : cB2;
        if constexpr (GATHER) { if (has_next) { PG8_GROWS_P(nxt); } else { PG8_GROWS_P(cur); } }
        const int tspan = Epi::MIDHOOK ? (nt >> 1) : nt;
        for (int t0 = 0; t0 < nt; t0 += tspan) {
        if constexpr (Epi::MIDHOOK) { if (t0 != 0) E.mid(acc, cur, wr, wc, fr, fq); }
        for (int t = t0; t < t0 + tspan; t += 2) {
            const bool last = (t == nt - 2);
            const char* a1 = cA + (size_t)(t + 1) * kstep;
            const char* a2 = last ? nA : cA + (size_t)(t + 2) * kstep; const char* b2 = last ? nB : ((KSPLIT && t + 2 >= (nt >> 1)) ? cB2 + (size_t)(t + 2 - (nt >> 1)) * kstep : cB + (size_t)(t + 2) * kstep);
            const char* a3 = a2 + kstep; const char* b3 = b2 + kstep;
            if (last && has_next) S.a_ready(nxt);
            if constexpr (SP2) {
            PG8_LDB(B0, 0, 0); PG8_LDB(B1, 0, 1); PG8_SCHED; PG8_LDA(At, 0, 0); PG8_STG_A(1, 1, a1, cv);
            if constexpr (GATHER) { if (last) { PG8_UNPACK_NV(); } }
            PG8_WAIT_V(8); PG8_WAIT_L(0); PG8_BAR; PG8_MMA(0, 0, At, B0); PG8_MMA(0, 1, At, B1); PG8_BAR; PG8_SCHED;
            PG8_LDA(At, 0, 1); PG8_STAGE(PG8_SB(0, 0), b2, voffB); PG8_STAGE(PG8_SB(0, 1), b2 + hstepB, voffB); PG8_STG_A(0, 0, a2, cv);
            PG8_WAIT_V(8); PG8_WAIT_L(0); PG8_BAR; PG8_MMA(1, 0, At, B0); PG8_MMA(1, 1, At, B1); PG8_BAR; PG8_SCHED;
            PG8_LDB(B0, 1, 0); PG8_LDB(B1, 1, 1); PG8_SCHED; PG8_LDA(At, 1, 0); PG8_STG_A(0, 1, a2, cv);
            PG8_WAIT_V(8); PG8_WAIT_L(0); PG8_BAR; PG8_MMA(0, 0, At, B0); PG8_MMA(0, 1, At, B1); PG8_BAR; PG8_SCHED;
            PG8_LDA(At, 1, 1); PG8_STAGE(PG8_SB(1, 0), b3, voffB); PG8_STAGE(PG8_SB(1, 1), b3 + hstepB, voffB); PG8_STG_A(1, 0, a3, cv);
            PG8_WAIT_V(8); PG8_WAIT_L(0); PG8_BAR; PG8_MMA(1, 0, At, B0); PG8_MMA(1, 1, At, B1); PG8_BAR; PG8_SCHED;
            } else {
            PG8_LDB(B0, 0, 0); PG8_SCHED; PG8_LDA(At, 0, 0); PG8_STAGE(PG8_SA(1, 1), a1 + hstep, voffA);
            PG8_WAIT_L(8); PG8_BAR; PG8_WAIT_L(0); PG8_MMA(0, 0, At, B0); PG8_BAR; PG8_SCHED;
            PG8_LDB(B1, 0, 1); PG8_STAGE(PG8_SB(0, 0), b2, voffB);
            PG8_BAR; PG8_WAIT_L(0); PG8_MMA(0, 1, At, B1); PG8_BAR;
            PG8_LDA(At, 0, 1); PG8_STAGE(PG8_SA(0, 0), a2, voffA);
            PG8_BAR; PG8_WAIT_L(0); PG8_MMA(1, 0, At, B0); PG8_BAR; PG8_SCHED;
            PG8_STAGE(PG8_SB(0, 1), b2 + hstepB, voffB);
            PG8_WAIT_V(6); PG8_BAR; PG8_MMA(1, 1, At, B1); PG8_BAR;
            PG8_LDB(B0, 1, 0); PG8_SCHED; PG8_LDA(At, 1, 0); PG8_STAGE(PG8_SA(0, 1), a2 + hstep, voffA);
            PG8_WAIT_L(8); PG8_BAR; PG8_WAIT_L(0); PG8_MMA(0, 0, At, B0); PG8_BAR; PG8_SCHED;
            PG8_LDB(B1, 1, 1); PG8_STAGE(PG8_SB(1, 0), b3, voffB);
            PG8_BAR; PG8_WAIT_L(0); PG8_MMA(0, 1, At, B1); PG8_BAR;
            PG8_LDA(At, 1, 1); PG8_STAGE(PG8_SA(1, 0), a3, voffA);
            PG8_BAR; PG8_WAIT_L(0); PG8_MMA(1, 0, At, B0); PG8_BAR; PG8_SCHED;
            PG8_STAGE(PG8_SB(1, 1), b3 + hstepB, voffB);
            PG8_WAIT_V(6); PG8_BAR; PG8_MMA(1, 1, At, B1); PG8_BAR;
            }
        }
        }
        if constexpr (ALIGN_EPI) { if (wr == 0) PG8_BAR; }
        if constexpr (!Epi::AFTER_DRAIN) { int t2 = threadIdx.x; asm volatile("" : "+v"(t2));
            const int wid2 = __builtin_amdgcn_readfirstlane(t2 >> 6), lane2 = t2 & 63; E(acc, cur, wid2 >> 2, wid2 & 3, lane2 & 15, lane2 >> 4); S.done(cur); }
        if (!has_next) break;
#pragma unroll
        for (int a = 0; a < 2; ++a)
#pragma unroll
            for (int b = 0; b < 2; ++b)
#pragma unroll
                for (int m = 0; m < 4; ++m)
#pragma unroll
                    for (int n = 0; n < 2; ++n) acc[a][b][m][n] = (f32x4){0.f, 0.f, 0.f, 0.f};
        cur = nxt; cA = nA; cB = nB; cB2 = nB2; ++ui;
        if constexpr (ALIGN_EPI) { if (wr == 1) PG8_BAR; }
    }
    PG8_WAIT_V(0);
    if constexpr (!ALIGN_EPI) { if (wr == 0) PG8_BAR; }
    PG8_BAR;
    if constexpr (Epi::AFTER_DRAIN) { E.fused(acc, cur, wr, wc, fr, fq, lds, wid, lane); S.done(cur); }
#undef PG8_SA
#undef PG8_SB
#undef PG8_STAGE
#undef PG8_LDA
#undef PG8_LDB
#undef PG8_MMA
#undef PG8_WAIT_V
#undef PG8_WAIT_L
#undef PG8_BAR
#undef PG8_SCHED
#undef PG8_STG_A
#undef PG8_GROWS
#undef PG8_GROWS_P
#undef PG8_UNPACK_NV
}
}
constexpr int BATCH = 32, SEQ = 2048, D = 1024, T = BATCH * SEQ;
constexpr int NPROJ = 2048;
constexpr int CQ = 0, CKV = 256, CPE = 384, CMQ = 416, CMK = 928, CMV = 1440, NPROJ_REAL = 1952;
constexpr int NH = 8;
constexpr float EPS = 1e-6f;
constexpr float LOG2E = 1.4426950408889634f;
constexpr float C2A = 0.10206207261596575f * LOG2E;
constexpr float C2B = 0.125f * LOG2E;
constexpr int NCLS = 112;
constexpr int LIST_CAP = 65536;

constexpr size_t MiB = 1u << 20;
constexpr size_t WS_CTL = 0, CTL_ZERO_BYTES = 2 * MiB;
constexpr size_t WS_KMEAN = 1 * MiB;
constexpr size_t WS_WIN = 2 * MiB;
constexpr size_t WS_WQ = 6 * MiB;
constexpr size_t WS_WKV = 7 * MiB;
constexpr size_t WS_WO = 8 * MiB;
constexpr size_t WS_WGU = 10 * MiB;
constexpr size_t WS_WD = 42 * MiB;
constexpr size_t WS_ROPE = 58 * MiB;
constexpr size_t WS_WRE = 59 * MiB;
constexpr size_t WS_SSQ = 60 * MiB;
constexpr size_t WS_XN = 64 * MiB;
constexpr size_t WS_VB = 192 * MiB;
constexpr size_t WS_Y0 = 64 * MiB;
constexpr size_t WS_X1B = 768 * MiB;
constexpr size_t WS_YH = 256 * MiB;
constexpr size_t WS_QB = 448 * MiB;
constexpr size_t WS_KB = 512 * MiB;
constexpr size_t WS_QA = 584 * MiB;
constexpr size_t WS_VA = 680 * MiB;
constexpr size_t WS_KA = 808 * MiB;
constexpr size_t WS_QLN = 904 * MiB;
constexpr size_t WS_KVLN = 936 * MiB;
constexpr size_t WS_LISTS = 648 * MiB;
constexpr size_t WS_OSSQ = 904 * MiB;
constexpr size_t WS_END = 1024 * MiB;
constexpr size_t WS_H = WS_KB;
constexpr int CW_TMO = 0, CW_CODE = 1;
constexpr int CW_BAR = 4096;
constexpr int CW_GCNT = 16384;

constexpr int RING_BYTES = 131072;
constexpr int P8_XT = 0, P8_XT_WAVE = 32 * 68 * 4, P8_WC = 69632, P8_WRG = 86016, P8_RT = 102400;
constexpr int LDSCTL_OFF = 155648, LDS_BYTES = 159744;
constexpr int TP_OFF = LDSCTL_OFF + 256, CNT_OFF = LDSCTL_OFF + 768, PT_OFF = LDSCTL_OFF + 1280;

#define GAS __attribute__((address_space(1)))
#define LAS __attribute__((address_space(3)))
typedef unsigned short bf16;
typedef unsigned v4u __attribute__((ext_vector_type(4)));
typedef unsigned v2u __attribute__((ext_vector_type(2)));
typedef float f32x4 __attribute__((ext_vector_type(4)));
typedef float f32x2 __attribute__((ext_vector_type(2)));
typedef float f32x16 __attribute__((ext_vector_type(16)));
typedef short bf16x8 __attribute__((ext_vector_type(8)));
typedef short s16x4 __attribute__((ext_vector_type(4)));
typedef GAS unsigned gu32;
#define RLX_AGENT __ATOMIC_RELAXED, __HIP_MEMORY_SCOPE_AGENT
__device__ __forceinline__ unsigned f2bf(float f) { unsigned u = __builtin_bit_cast(unsigned, f); return (u + 0x7fffu + ((u >> 16) & 1u)) >> 16; }
__device__ __forceinline__ unsigned pk2(float lo, float hi) { return f2bf(lo) | (f2bf(hi) << 16); }
__device__ __forceinline__ float bflo(unsigned w) { return __builtin_bit_cast(float, w << 16); }
__device__ __forceinline__ float bfhi(unsigned w) { return __builtin_bit_cast(float, w & 0xffff0000u); }
__device__ __forceinline__ float wave_sum(float v) {
#pragma unroll
    for (int o = 1; o < 64; o <<= 1) v += __shfl_xor(v, o);
    return v;
}
__device__ __forceinline__ float sum8(float v) { v += __shfl_xor(v, 1); v += __shfl_xor(v, 2); v += __shfl_xor(v, 4); return v; }

#define XB_TMO      128
#define XB_XCNT(j)  (256  + 64 * (j))
#define XB_XSUB(j)  (1280 + 64 * (j))
#define XB_XGEN(j)  (2304 + 64 * (j))
#define XB_TOP      3328
#define XB_TOPGEN   3392
#define XCD_BAR_WORDS 3456
#define XB_SPIN_CAP (1u << 18)

__device__ __forceinline__ unsigned xb_ld(unsigned* p)              { return __hip_atomic_load(p, __ATOMIC_RELAXED, __HIP_MEMORY_SCOPE_AGENT); }
__device__ __forceinline__ unsigned xb_add(unsigned* p, unsigned v) { return __hip_atomic_fetch_add(p, v, __ATOMIC_RELAXED, __HIP_MEMORY_SCOPE_AGENT); }
__device__ __forceinline__ unsigned xb_xcc_id() { return (unsigned)__builtin_amdgcn_s_getreg((3 << 11) | 20) & 0xFu; }
#define XB_SPIN(cond, bar) do { unsigned _sp = 0; while (cond) { __builtin_amdgcn_s_sleep(1); \
    if ((++_sp & 255u) == 0u) { if (xb_ld(&(bar)[XB_TMO])) break; if (_sp > XB_SPIN_CAP) { atomicAdd(&(bar)[XB_TMO], 1u); break; } } } } while (0)

struct XcdBarrier {
    unsigned* bar; unsigned x;
    volatile LAS unsigned* st;
};

__device__ __forceinline__ XcdBarrier xcd_barrier_post(unsigned* bar, volatile LAS unsigned* st) {
    XcdBarrier b; b.bar = bar; b.x = xb_xcc_id(); b.st = st;
    if (threadIdx.x == 0) (void)xb_add(&bar[XB_XCNT(b.x)], 1u);
    return b;
}
__device__ __forceinline__ void xcd_barrier_complete(unsigned* bar, unsigned x, unsigned& nloc, unsigned& nx) {
    const unsigned G = gridDim.x * gridDim.y * gridDim.z;
    unsigned sum, cnt, mine, sp = 0u;
    for (;;) {
        sum = 0u; cnt = 0u; mine = 0u;
#pragma unroll
        for (unsigned j = 0; j < 16; ++j) { const unsigned c = xb_ld(&bar[XB_XCNT(j)]); sum += c; cnt += (c > 0u) ? 1u : 0u; mine = (j == x) ? c : mine; }
        if (sum == G) break;
        __builtin_amdgcn_s_sleep(1);
        if ((++sp & 255u) == 0u) { if (xb_ld(&bar[XB_TMO])) break; if (sp > XB_SPIN_CAP) { atomicAdd(&bar[XB_TMO], 1u); break; } }
    }
    nloc = mine > 0u ? mine : 1u; nx = cnt > 0u ? cnt : 1u;
}

__device__ __forceinline__ void xcd_barrier(const XcdBarrier& b) {
    asm volatile("s_waitcnt vmcnt(0)" ::: "memory");
    __syncthreads();
    if (threadIdx.x == 0) {
        unsigned* bar = b.bar;
        __builtin_amdgcn_s_waitcnt(0);
        unsigned nloc = b.st[0], nx = b.st[1];
        if (nloc == 0u) { xcd_barrier_complete(bar, b.x, nloc, nx); b.st[0] = nloc; b.st[1] = nx; }
        const unsigned old = xb_add(&bar[XB_XSUB(b.x)], 1u);
        const unsigned gen = old / nloc;
        if (old + 1u == (gen + 1u) * nloc) {
            __builtin_amdgcn_fence(__ATOMIC_RELEASE, "agent");
            asm volatile("s_waitcnt vmcnt(0)" ::: "memory");
            const unsigned og = xb_add(&bar[XB_TOP], 1u);
            const unsigned tg = og / nx;
            if (og + 1u == (tg + 1u) * nx) xb_add(&bar[XB_TOPGEN], 1u);
            else XB_SPIN(xb_ld(&bar[XB_TOPGEN]) == tg, bar);
            __builtin_amdgcn_fence(__ATOMIC_ACQUIRE, "agent");
            xb_add(&bar[XB_XGEN(b.x)], 1u);
            asm volatile("s_waitcnt vmcnt(0)" ::: "memory");
        } else {
            XB_SPIN(xb_ld(&bar[XB_XGEN(b.x)]) == gen, bar);
            __builtin_amdgcn_fence(__ATOMIC_ACQUIRE, "agent");
            asm volatile("s_waitcnt vmcnt(0)" ::: "memory");
        }
    }
    __syncthreads();
}


__device__ __forceinline__ float att_max3(float a, float b, float c) { float r; asm("v_max3_f32 %0, %1, %2, %3" : "=v"(r) : "v"(a), "v"(b), "v"(c)); return r; }
__device__ __forceinline__ unsigned pk4_fp8(float a, float b, float c, float d) { int w = 0; w = __builtin_amdgcn_cvt_pk_fp8_f32(a, b, w, false); w = __builtin_amdgcn_cvt_pk_fp8_f32(c, d, w, true); return (unsigned)w; }
template <int DQK, bool MOBA, bool QFIN>
__device__ __forceinline__ void attn_unit(LAS unsigned char* lds, const float* qgain_, const float* ropeR_, const bf16* Qg_, int qpitch, const bf16* Kg_, int kpitch, const bf16* Vg_, int vpitch, bf16* Og_, int opitch, float* ossq_, int qb, const float* kmp_, int kmstride) {
    const GAS bf16* Qg = (const GAS bf16*)Qg_; const GAS bf16* Kg = (const GAS bf16*)Kg_; const GAS bf16* Vg = (const GAS bf16*)Vg_; GAS bf16* Og = (GAS bf16*)Og_; const GAS float* kmp = (const GAS float*)kmp_;
    constexpr int ND = DQK / 16, NQB = (DQK + 63) / 64, KSTR = NQB * 64 + 16, KBUF = 64 * KSTR, NCH = DQK / 8, VBUF = 8192;
    typedef int v8i_ __attribute__((ext_vector_type(8))); typedef int v4i_ __attribute__((ext_vector_type(4)));
    int tid = threadIdx.x; asm volatile("" : "+v"(tid));
    const int lane = tid & 63, r32 = lane & 31, hi = lane >> 5; const int wid = __builtin_amdgcn_readfirstlane(tid >> 6);
    LAS unsigned char* Kl = lds; LAS unsigned char* Vl = lds + 2 * KBUF;
    const GAS bf16* qrow = Qg + (size_t)(qb * 256 + wid * 32 + r32) * qpitch;
    bf16x8 qf[ND];
    v8i_ q8[NQB];
#pragma unroll
    for (int d0 = 0; d0 < ND; ++d0) qf[d0] = *(const GAS bf16x8*)(qrow + 16 * d0 + 8 * hi);
    if (QFIN) {
        const GAS float* qg = (const GAS float*)qgain_; const GAS float* rr = (const GAS float*)ropeR_; const int pos = qb * 256 + wid * 32 + r32;
        float x[ND][8]; float ss = 0.f;
#pragma unroll
        for (int d0 = 0; d0 < ND; ++d0) { const v4u w = __builtin_bit_cast(v4u, qf[d0]);
            x[d0][0] = bflo(w.x); x[d0][1] = bfhi(w.x); x[d0][2] = bflo(w.y); x[d0][3] = bfhi(w.y); x[d0][4] = bflo(w.z); x[d0][5] = bfhi(w.z); x[d0][6] = bflo(w.w); x[d0][7] = bfhi(w.w);
#pragma unroll
            for (int j = 0; j < 8; ++j) ss += x[d0][j] * x[d0][j]; }
        ss += __shfl_xor(ss, 32);
        const float rs = (1.0f / sqrtf(ss * (1.0f / (float)DQK) + EPS)) * C2A;
#pragma unroll
        for (int d0 = 0; d0 < ND; ++d0) { const f32x4 ga = *(const GAS f32x4*)(qg + 16 * d0 + 8 * hi), gb = *(const GAS f32x4*)(qg + 16 * d0 + 8 * hi + 4);
#pragma unroll
            for (int j = 0; j < 4; ++j) { x[d0][j] *= rs * ga[j]; x[d0][4 + j] *= rs * gb[j]; } }
        if (ND == 6) { const f32x4 ca = *(const GAS f32x4*)(rr + pos * 16 + 8 * hi), cb = *(const GAS f32x4*)(rr + pos * 16 + 8 * hi + 4), sa = *(const GAS f32x4*)(rr + SEQ * 16 + pos * 16 + 8 * hi), sb = *(const GAS f32x4*)(rr + SEQ * 16 + pos * 16 + 8 * hi + 4);
#pragma unroll
            for (int j = 0; j < 8; ++j) { const float c = j < 4 ? ca[j & 3] : cb[j & 3], s = j < 4 ? sa[j & 3] : sb[j & 3]; const float y1 = x[ND - 2][j], y2 = x[ND - 1][j]; x[ND - 2][j] = y1 * c - y2 * s; x[ND - 1][j] = y2 * c + y1 * s; } }
#pragma unroll
        for (int b_ = 0; b_ < NQB; ++b_)
#pragma unroll
            for (int e = 0; e < 4; ++e) { const int d0 = 4 * b_ + e;
                if (d0 < ND) { q8[b_][2 * e] = (int)pk4_fp8(x[d0][0] * 8.0f, x[d0][1] * 8.0f, x[d0][2] * 8.0f, x[d0][3] * 8.0f); q8[b_][2 * e + 1] = (int)pk4_fp8(x[d0][4] * 8.0f, x[d0][5] * 8.0f, x[d0][6] * 8.0f, x[d0][7] * 8.0f); }
                else { q8[b_][2 * e] = 0; q8[b_][2 * e + 1] = 0; } }
    }
    unsigned sel = 0xffu;
    if (MOBA && qb > 3) {
        float gate[8];
#pragma unroll
        for (int n = 0; n < 8; ++n) { float a = 0.f;
            if (n < qb) {
#pragma unroll
                for (int d0 = 0; d0 < ND; ++d0) { const GAS float* km = kmp + (size_t)n * kmstride + 16 * d0 + 8 * hi; const f32x4 k0 = *(const GAS f32x4*)km, k1 = *(const GAS f32x4*)(km + 4);
                    const v4u qq = __builtin_bit_cast(v4u, qf[d0]);
                    a += bflo(qq.x) * k0[0] + bfhi(qq.x) * k0[1] + bflo(qq.y) * k0[2] + bfhi(qq.y) * k0[3] + bflo(qq.z) * k1[0] + bfhi(qq.z) * k1[1] + bflo(qq.w) * k1[2] + bfhi(qq.w) * k1[3]; }
                a += __shfl_xor(a, 32); }
            gate[n] = a; asm volatile("" : "+v"(a) :: "memory"); }
        sel = 0u;
#pragma unroll
        for (int n = 0; n < 8; ++n) { int rank = 0;
#pragma unroll
            for (int mm = 0; mm < 8; ++mm) { if (mm != n) { const bool before = (gate[mm] > gate[n]) || (gate[mm] == gate[n] && mm < n); rank += (mm < qb && before) ? 1 : 0; } }
            if (n < qb && rank < 3) sel |= (1u << n); }
    }
    if (!QFIN) {
#pragma unroll
        for (int b_ = 0; b_ < NQB; ++b_)
#pragma unroll
            for (int e = 0; e < 4; ++e) { const int d0 = 4 * b_ + e; const v4u w = __builtin_bit_cast(v4u, qf[d0 < ND ? d0 : 0]);
                if (d0 < ND) { q8[b_][2 * e] = (int)pk4_fp8(bflo(w.x) * 8.0f, bfhi(w.x) * 8.0f, bflo(w.y) * 8.0f, bfhi(w.y) * 8.0f); q8[b_][2 * e + 1] = (int)pk4_fp8(bflo(w.z) * 8.0f, bfhi(w.z) * 8.0f, bflo(w.w) * 8.0f, bfhi(w.w) * 8.0f); }
                else { q8[b_][2 * e] = 0; q8[b_][2 * e + 1] = 0; } }
    }
    const int krow = (DQK == 64) ? (tid >> 3) : (tid / 12), kch = (DQK == 64) ? (tid & 7) : (tid % 12);
    const int krow2 = (tid + 512) / 12, kch2 = (tid + 512) % 12; const bool k2 = (DQK == 96) && (tid < 256);
    const int vrow = tid >> 3, vch = tid & 7;
    const unsigned kst = (unsigned)(krow * KSTR + (kch >> 3) * 64 + (kch & 1) * 32 + ((kch >> 1) & 3) * 8), kst2 = (unsigned)(krow2 * KSTR + (kch2 >> 3) * 64 + (kch2 & 1) * 32 + ((kch2 >> 1) & 3) * 8);
    auto k8 = [&](v4u r) -> v2u { v2u o; o.x = pk4_fp8(bflo(r.x), bfhi(r.x), bflo(r.y), bfhi(r.y)); o.y = pk4_fp8(bflo(r.z), bfhi(r.z), bflo(r.w), bfhi(r.w)); return o; };
    const unsigned vst = (unsigned)((vch >> 2) * 4096 + (vrow >> 4) * 1024 + ((vrow >> 3) & 1) * 512 + (vrow & 7) * 64 + (vch & 3) * 16);
    const int NT = 4 * (qb + 1);
    auto tile_row0 = [&](int p) -> int { return (p < 4) ? (qb * 256 + p * 64) : ((p - 4) * 64); };
    v4u kreg, kreg2 = {0u, 0u, 0u, 0u}, vreg;
    { const int r0 = tile_row0(0);
      kreg = *(const GAS v4u*)(Kg + (size_t)(r0 + krow) * kpitch + kch * 8); if (k2) kreg2 = *(const GAS v4u*)(Kg + (size_t)(r0 + krow2) * kpitch + kch2 * 8);
      vreg = *(const GAS v4u*)(Vg + (size_t)(r0 + vrow) * vpitch + vch * 8);
      *(LAS v2u*)(Kl + kst) = k8(kreg); if (k2) *(LAS v2u*)(Kl + kst2) = k8(kreg2); *(LAS v4u*)(Vl + vst) = vreg; }
    if (DQK == 96 && tid < 256) *(LAS v4u*)(Kl + ((tid >> 1) & 1) * KBUF + (tid >> 2) * KSTR + 80 + (tid & 1) * 32) = (v4u){0u, 0u, 0u, 0u};
    __syncthreads();
    float m_run = 0.f, l_run = 0.f; f32x16 o0 = {}, o1 = {};
    f32x16 negm = {};
    constexpr float THR = 8.0f;
    const int qrel = wid * 32 + r32;
    const unsigned kfo = (unsigned)(r32 * KSTR + hi * 32);
    const unsigned vfo = (unsigned)(((lane >> 4) & 1) * 32 + (lane & 3) * 8 + (4 * hi + ((lane & 15) >> 2)) * 64);
    for (int p = 0; p < NT; ++p) {
        const int cb = p & 1;
        if (p + 1 < NT) { const int r0 = tile_row0(p + 1);
            kreg = *(const GAS v4u*)(Kg + (size_t)(r0 + krow) * kpitch + kch * 8); if (k2) kreg2 = *(const GAS v4u*)(Kg + (size_t)(r0 + krow2) * kpitch + kch2 * 8);
            vreg = *(const GAS v4u*)(Vg + (size_t)(r0 + vrow) * vpitch + vch * 8); }
        const bool need = !(p < 4 && p > (wid >> 1));
        if (need) {
            const LAS unsigned char* Kb = Kl + cb * KBUF + kfo; const LAS unsigned char* Vb = Vl + cb * VBUF + vfo;
            f32x16 s0 = negm, s1 = negm;
            v8i_ kf[2][NQB];
#pragma unroll
            for (int g = 0; g < 2; ++g)
#pragma unroll
                for (int b_ = 0; b_ < NQB; ++b_) { const v4i_ lo_ = *(const LAS v4i_*)(Kb + g * 32 * KSTR + b_ * 64), hi_ = *(const LAS v4i_*)(Kb + g * 32 * KSTR + b_ * 64 + 16);
                    kf[g][b_] = __builtin_shufflevector(lo_, hi_, 0, 1, 2, 3, 4, 5, 6, 7); }
            __builtin_amdgcn_sched_barrier(0);
#pragma unroll
            for (int b_ = 0; b_ < NQB; ++b_) { s0 = __builtin_amdgcn_mfma_scale_f32_32x32x64_f8f6f4(kf[0][b_], q8[b_], s0, 0, 0, 0, 0x7f7f7f7f, 0, 0x7c7c7c7c); s1 = __builtin_amdgcn_mfma_scale_f32_32x32x64_f8f6f4(kf[1][b_], q8[b_], s1, 0, 0, 0, 0x7f7f7f7f, 0, 0x7c7c7c7c); }
            s16x4 vt[16];
#pragma unroll
            for (int v = 0; v < 16; ++v) vt[v] = __builtin_bit_cast(s16x4, __builtin_amdgcn_ds_read_tr16_b64_v4i16((LAS s16x4*)(Vb + (v >> 2) * 1024 + ((v >> 1) & 1) * 4096 + (v & 1) * 512)));
            __builtin_amdgcn_sched_barrier(0);
            if (p < 4) { const int kb = 64 * p + 4 * hi;
#pragma unroll
                for (int r = 0; r < 16; ++r) { const int kv = kb + (r & 3) + 8 * (r >> 2); if (kv > qrel) s0[r] = -INFINITY; if (kv + 32 > qrel) s1[r] = -INFINITY; } }
            else if (MOBA) { if (!((sel >> ((p - 4) >> 2)) & 1u)) {
#pragma unroll
                for (int r = 0; r < 16; ++r) { s0[r] = -INFINITY; s1[r] = -INFINITY; } } }
            float ra = att_max3(s0[0], s0[1], s1[0]), rb = att_max3(s0[2], s0[3], s1[1]); ra = att_max3(ra, s1[2], s1[3]);
#pragma unroll
            for (int r = 4; r < 16; r += 4) { ra = att_max3(ra, s0[r], s0[r + 1]); rb = att_max3(rb, s0[r + 2], s0[r + 3]); ra = att_max3(ra, s1[r], s1[r + 1]); rb = att_max3(rb, s1[r + 2], s1[r + 3]); }
            float rm = fmaxf(ra, rb); rm = fmaxf(rm, __shfl_xor(rm, 32));
            if (p == 0 || __any(rm > THR)) {
                const float dl = (p == 0) ? rm : fmaxf(rm, 0.f); m_run += dl;
                const float fsc = __builtin_amdgcn_exp2f(-dl); l_run *= fsc;
#pragma unroll
                for (int r = 0; r < 16; ++r) { s0[r] -= dl; s1[r] -= dl; o0[r] *= fsc; o1[r] *= fsc; negm[r] = -m_run; }
            }
            float rs0 = 0.f, rs1 = 0.f;
#pragma unroll
            for (int r = 0; r < 16; ++r) { s0[r] = __builtin_amdgcn_exp2f(s0[r]); s1[r] = __builtin_amdgcn_exp2f(s1[r]); rs0 += s0[r]; rs1 += s1[r]; }
            l_run += rs0 + rs1;
            bf16x8 pf[4];
#pragma unroll
            for (int s = 0; s < 2; ++s) { v4u a, b;
                a.x = pg8::cvt_pk_bf16(s0[8 * s + 0], s0[8 * s + 1]); a.y = pg8::cvt_pk_bf16(s0[8 * s + 2], s0[8 * s + 3]); a.z = pg8::cvt_pk_bf16(s0[8 * s + 4], s0[8 * s + 5]); a.w = pg8::cvt_pk_bf16(s0[8 * s + 6], s0[8 * s + 7]);
                b.x = pg8::cvt_pk_bf16(s1[8 * s + 0], s1[8 * s + 1]); b.y = pg8::cvt_pk_bf16(s1[8 * s + 2], s1[8 * s + 3]); b.z = pg8::cvt_pk_bf16(s1[8 * s + 4], s1[8 * s + 5]); b.w = pg8::cvt_pk_bf16(s1[8 * s + 6], s1[8 * s + 7]);
                pf[s] = __builtin_bit_cast(bf16x8, a); pf[2 + s] = __builtin_bit_cast(bf16x8, b); }
#pragma unroll
            for (int s = 0; s < 4; ++s) {
                const bf16x8 va = (bf16x8){vt[4 * s][0], vt[4 * s][1], vt[4 * s][2], vt[4 * s][3], vt[4 * s + 1][0], vt[4 * s + 1][1], vt[4 * s + 1][2], vt[4 * s + 1][3]};
                const bf16x8 vb = (bf16x8){vt[4 * s + 2][0], vt[4 * s + 2][1], vt[4 * s + 2][2], vt[4 * s + 2][3], vt[4 * s + 3][0], vt[4 * s + 3][1], vt[4 * s + 3][2], vt[4 * s + 3][3]};
                o0 = __builtin_amdgcn_mfma_f32_32x32x16_bf16(va, pf[s], o0, 0, 0, 0);
                o1 = __builtin_amdgcn_mfma_f32_32x32x16_bf16(vb, pf[s], o1, 0, 0, 0); }
        }
        if (p + 1 < NT) { const int nb = cb ^ 1;
            *(LAS v2u*)(Kl + nb * KBUF + kst) = k8(kreg); if (k2) *(LAS v2u*)(Kl + nb * KBUF + kst2) = k8(kreg2); *(LAS v4u*)(Vl + nb * VBUF + vst) = vreg; }
        __syncthreads();
        __syncthreads();
    }
    l_run += __shfl_xor(l_run, 32);
    const float rl = 1.0f / l_run;
    { float ss = 0.f;
#pragma unroll
      for (int r = 0; r < 16; ++r) { const float a = o0[r] * rl, b = o1[r] * rl; ss += a * a + b * b; }
      ss += __shfl_xor(ss, 32);
      if (hi == 0) ((GAS float*)ossq_)[(size_t)(qb * 256 + wid * 32 + r32) * 16] = ss; }
    LAS unsigned char* stg = lds + 65536 + wid * 4608; const float rl16 = rl * 16.0f;
#pragma unroll
    for (int g = 0; g < 4; ++g) {
        *(LAS unsigned*)(stg + r32 * 80 + (8 * g + 4 * hi)) = pk4_fp8(o0[4 * g] * rl16, o0[4 * g + 1] * rl16, o0[4 * g + 2] * rl16, o0[4 * g + 3] * rl16);
        *(LAS unsigned*)(stg + r32 * 80 + (32 + 8 * g + 4 * hi)) = pk4_fp8(o1[4 * g] * rl16, o1[4 * g + 1] * rl16, o1[4 * g + 2] * rl16, o1[4 * g + 3] * rl16); }
    asm volatile("s_waitcnt lgkmcnt(0)" ::: "memory");
    GAS unsigned char* obase = (GAS unsigned char*)Og + (size_t)(qb * 256 + wid * 32) * opitch;
#pragma unroll
    for (int i = 0; i < 2; ++i) { const int row = i * 16 + (lane >> 2), ch = lane & 3; const v4u v = *(const LAS v4u*)(stg + row * 80 + ch * 16); *(GAS v4u*)(obase + (size_t)row * opitch + ch * 16) = v; }
    asm volatile("s_waitcnt lgkmcnt(0)" ::: "memory");
}

__device__ __forceinline__ void transpose_item(const float* W_, int ldw, bf16* WT, int ldt, int k0, int n0, int dr0, int dr1, LAS float* scr, int lane, const float* kgain = nullptr) {
    const GAS float* W = (const GAS float*)W_; const int q = lane & 15, kr = lane >> 4; const bool ld_ok = (q < 8) ? (dr0 >= 0) : (dr1 >= 0);
#pragma unroll 4
    for (int i = 0; i < 16; ++i) { const int kk = 4 * i + kr; f32x4 v = {0.f, 0.f, 0.f, 0.f}; if (ld_ok) v = *(const GAS f32x4*)(W + (size_t)(k0 + kk) * ldw + n0 + 4 * q);
        if (kgain) v = v * ((const GAS float*)kgain)[k0 + kk];
        LAS float* s = scr + kk * 65 + 4 * q; s[0] = v[0]; s[1] = v[1]; s[2] = v[2]; s[3] = v[3]; }
    asm volatile("s_waitcnt lgkmcnt(0)" ::: "memory");
    const int c = lane & 7;
#pragma unroll
    for (int j = 0; j < 8; ++j) { const int n = 8 * j + (lane >> 3); const LAS float* s = scr + (8 * c) * 65 + n; const int dr = (n < 32) ? dr0 : dr1;
        v4u o; o.x = pk2(s[0 * 65], s[1 * 65]); o.y = pk2(s[2 * 65], s[3 * 65]); o.z = pk2(s[4 * 65], s[5 * 65]); o.w = pk2(s[6 * 65], s[7 * 65]);
        if (dr >= 0) *(GAS v4u*)(WT + (size_t)(dr + (n & 31)) * ldt + k0 + 8 * c) = o; }
    asm volatile("s_waitcnt lgkmcnt(0)" ::: "memory");
}

__device__ __forceinline__ void transpose_item8(const float* W_, int ldw, unsigned char* WT8, int ldt, int k0, int n0, int dr0, int dr1, LAS float* scr, int lane, float scale, const float* kgain = nullptr) {
    const GAS float* W = (const GAS float*)W_; const int q = lane & 15, kr = lane >> 4; const bool ld_ok = (q < 8) ? (dr0 >= 0) : (dr1 >= 0);
#pragma unroll 4
    for (int i = 0; i < 16; ++i) { const int kk = 4 * i + kr; f32x4 v = {0.f, 0.f, 0.f, 0.f}; if (ld_ok) v = *(const GAS f32x4*)(W + (size_t)(k0 + kk) * ldw + n0 + 4 * q);
        if (kgain) v = v * ((const GAS float*)kgain)[k0 + kk];
        v = v * scale;
        LAS float* s = scr + kk * 65 + 4 * q; s[0] = v[0]; s[1] = v[1]; s[2] = v[2]; s[3] = v[3]; }
    asm volatile("s_waitcnt lgkmcnt(0)" ::: "memory");
    const int c = lane & 7;
#pragma unroll
    for (int j = 0; j < 8; ++j) { const int n = 8 * j + (lane >> 3); const LAS float* s = scr + (8 * c) * 65 + n; const int dr = (n < 32) ? dr0 : dr1;
        v2u o; o.x = pk4_fp8(s[0 * 65], s[1 * 65], s[2 * 65], s[3 * 65]); o.y = pk4_fp8(s[4 * 65], s[5 * 65], s[6 * 65], s[7 * 65]);
        if (dr >= 0) *(GAS v2u*)((GAS unsigned char*)WT8 + (size_t)(dr + (n & 31)) * ldt + k0 + 8 * c) = o; }
    asm volatile("s_waitcnt lgkmcnt(0)" ::: "memory");
}

struct Args {
    const float* x; const float* attn_g; const float* w_in; const float* qlat_g; const float* w_qup; const float* kvlat_g; const float* w_kvup;
    const float* qhead_g; const float* khead_g; const float* mqhead_g; const float* mkhead_g; const float* onorm_a_g; const float* onorm_b_g; const float* w_out;
    const float* ffn_g; const float* w_rg; const float* b_rg; const float* w_re; const float* b_re; const float* w_gate; const float* w_up; const float* w_down;
    float* out; unsigned char* ws; int ph_lo, ph_hi;
};
enum { PH_PRO = 0, PH_PROJ, PH_UP, PH_ATTN, PH_OUT, PH_ROUTE, PH_GU, PH_D0, NPHASE };

__global__ void __launch_bounds__(512, 2) mk_fwd(Args A) {
    extern __shared__ __attribute__((aligned(16))) unsigned char lds_raw[];
    LAS unsigned char* lds = (LAS unsigned char*)lds_raw;
    const int tid0 = threadIdx.x;
    const int G = gridDim.x, bx = blockIdx.x;
#define NGW (G * 8)
#define PH_BEGIN int tid = threadIdx.x; asm volatile("" : "+v"(tid)); const int lane = tid & 63; const int wave = __builtin_amdgcn_readfirstlane(tid >> 6); const int gw = bx * 8 + wave; \
    const __attribute__((address_space(4))) Args* AP = (const __attribute__((address_space(4))) Args*)__builtin_amdgcn_kernarg_segment_ptr(); asm volatile("" : "+s"(AP)); \
    unsigned char* ws = AP->ws; (void)lane; (void)gw; (void)ws;
#define Win_t ((bf16*)(ws + WS_WIN))
#define Wq_t ((bf16*)(ws + WS_WQ))
#define Wkv_t ((bf16*)(ws + WS_WKV))
#define Wo_t ((bf16*)(ws + WS_WO))
#define Wgu_t ((bf16*)(ws + WS_WGU))
#define Wd_t ((bf16*)(ws + WS_WD))
#define ropeF ((float*)(ws + WS_ROPE))
#define ropeR (((float*)(ws + WS_ROPE)) + 2 * SEQ * 32)
#define kmean ((float*)(ws + WS_KMEAN))
#define XN ((bf16*)(ws + WS_XN))
#define X1B ((bf16*)(ws + WS_X1B))
#define VB ((bf16*)(ws + WS_VB))
#define YH ((bf16*)(ws + WS_YH))
#define Y0B ((bf16*)(ws + WS_Y0))
#define SSQ ((float*)(ws + WS_SSQ))
#define WREF ((float*)(ws + WS_WRE))
#define WRGF ((float*)(ws + WS_WRE + 131072))
#define OSSQ ((float*)(ws + WS_OSSQ))
#define QB ((bf16*)(ws + WS_QB))
#define KB ((bf16*)(ws + WS_KB))
#define QA ((bf16*)(ws + WS_QA))
#define VA ((bf16*)(ws + WS_VA))
#define KA ((bf16*)(ws + WS_KA))
#define QLN ((bf16*)(ws + WS_QLN))
#define KVLN ((bf16*)(ws + WS_KVLN))
#define HB ((bf16*)(ws + WS_H))
#define lists ((pg8::ListEnt*)(ws + WS_LISTS))
    volatile LAS unsigned* MISC = (volatile LAS unsigned*)(lds + LDSCTL_OFF);
    for (int u = tid0; u < (LDS_BYTES - LDSCTL_OFF) / 4; u += 512) ((LAS unsigned*)(lds + LDSCTL_OFF))[u] = 0u;
    __syncthreads();
    XcdBarrier bar = xcd_barrier_post((unsigned*)((gu32*)(A.ws + WS_CTL) + CW_BAR), MISC + 8);
    const int lo = A.ph_lo, hi = A.ph_hi;
#define IN(k) (lo <= (k) && (k) < hi)
#define MOE_SLOT(npn) ((G == 256) ? ((((bx >> 3) / (npn)) * 8 + (bx & 7)) * (npn) + ((bx >> 3) % (npn))) : bx)
#define SEAM(k) do { if (IN(k) && IN((k) + 1)) xcd_barrier(bar); } while (0)

    if (IN(PH_PRO)) { PH_BEGIN
        LAS float* scr = (LAS float*)(lds + wave * 16640);
        constexpr int I_IN = 16 * 31, I_QU = 4 * 12, I_KV = 2 * 16, I_WO = 16 * 16, I_G = 32 * 64, I_U = 32 * 64, I_D = 32 * 64;
        constexpr int NITEMS = I_IN + I_QU + I_KV + I_WO + I_G + I_U + I_D;
        for (int it = gw; it < NITEMS; it += NGW) {
            int r = it;
            if (r < I_IN) { const int kb = r / 31, nb = r % 31; int dr[2];
#pragma unroll
                for (int h2 = 0; h2 < 2; ++h2) { const int gi = 2 * nb + h2;
                    if (gi < 13) dr[h2] = 32 * gi; else if (gi < 45) { const int q = (gi - 13) & 15, hh = q >> 1, bj = q & 1; dr[h2] = (gi < 29 ? 512 : 1024) + (hh >> 2) * 256 + bj * 128 + (hh & 3) * 32; } else if (gi < 61) dr[h2] = 1536 + (gi - 45) * 32; else dr[h2] = -1; }
                transpose_item(AP->w_in, NPROJ_REAL, Win_t, 1024, 64 * kb, 64 * nb, dr[0], dr[1], scr, lane); continue; } r -= I_IN;
            if (r < I_QU) { const int kb = r / 12, nb = r % 12; transpose_item(AP->w_qup, 768, Wq_t, 256, 64 * kb, 64 * nb, 64 * nb, 64 * nb + 32, scr, lane, AP->qlat_g); continue; } r -= I_QU;
            if (r < I_KV) { const int kb = r / 16, nb = r % 16; const int n0 = 64 * nb, hh = n0 >> 7, j0 = n0 & 127;
                const int d0 = (j0 < 64) ? ((hh >> 2) * 256 + (hh & 3) * 32) : (512 + hh * 64), d1 = (j0 < 64) ? (d0 + 128) : (d0 + 32);
                transpose_item(AP->w_kvup, 1024, Wkv_t, 256, 64 * kb, n0, d0, d1, scr, lane, AP->kvlat_g); continue; } r -= I_KV;
            if (r < I_WO) { const int kb = r / 16, nb = r % 16; transpose_item8(AP->w_out, 1024, (unsigned char*)Wo_t, 1024, 64 * kb, 64 * nb, 64 * nb, 64 * nb + 32, scr, lane, 32.0f, kb < 8 ? AP->onorm_a_g : AP->onorm_b_g - 512); continue; } r -= I_WO;
            if (r < I_G) { const int e = r >> 6, r2 = r & 63, kb = r2 >> 2, nb = r2 & 3; const int n0 = 64 * nb; const int d0 = (n0 >> 7) * 256 + (n0 & 127);
                transpose_item8(AP->w_gate + (size_t)e * 1024 * 256, 256, (unsigned char*)Wgu_t + (size_t)e * 512 * 1024, 1024, 64 * kb, n0, d0, d0 + 32, scr, lane, 32.0f); continue; } r -= I_G;
            if (r < I_U) { const int e = r >> 6, r2 = r & 63, kb = r2 >> 2, nb = r2 & 3; const int n0 = 64 * nb; const int d0 = (n0 >> 7) * 256 + 128 + (n0 & 127);
                transpose_item8(AP->w_up + (size_t)e * 1024 * 256, 256, (unsigned char*)Wgu_t + (size_t)e * 512 * 1024, 1024, 64 * kb, n0, d0, d0 + 32, scr, lane, 32.0f); continue; } r -= I_U;
            { const int e = r >> 6, r2 = r & 63, kb = r2 >> 4, nb = r2 & 15;
                transpose_item8(AP->w_down + (size_t)e * 256 * 1024, 1024, (unsigned char*)Wd_t + (size_t)e * 1024 * 256, 256, 64 * kb, 64 * nb, 64 * nb, 64 * nb + 32, scr, lane, 16.0f); }
        }
        const int gt = bx * 512 + tid, NGT = G * 512;
        for (int i = gt; i < 96 * 128; i += NGT) *(GAS v4u*)(Win_t + (size_t)416 * 1024 + (size_t)i * 8) = (v4u){0u, 0u, 0u, 0u};
        for (int i = gt; i < 1024 * 16; i += NGT) *(GAS v4u*)(Wkv_t + (size_t)(i >> 4) * 256 + 128 + (i & 15) * 8) = (v4u){0u, 0u, 0u, 0u};
        for (int i = gt; i < SEQ * 48; i += NGT) {
            const int pos = i / 48, f = i % 48; const bool isF = f < 32; const int ff = isF ? f : f - 32;
            const double e = isF ? (double)ff / 32.0 : (double)ff / 16.0;
            const float invf = (float)exp2(-e * 13.287712379549449);
            const float ang = (float)pos * invf;
            const double a = (double)ang; const double kk = rint(a * 0.15915494309189535); const double rr = a - kk * 6.283185307179586;
            const float c = (float)cos(rr), s = (float)sin(rr);
            GAS float* rF = (GAS float*)ropeF; GAS float* rR = (GAS float*)ropeR;
            if (isF) { rF[pos * 32 + ff] = c; rF[SEQ * 32 + pos * 32 + ff] = s; } else { rR[pos * 16 + ff] = c; rR[SEQ * 16 + pos * 16 + ff] = s; }
        }
        for (int i = gt; i < 1024 * 8; i += NGT) { const float gk = AP->ffn_g[i >> 3]; *((GAS f32x4*)WREF + i) = *((const GAS f32x4*)AP->w_re + i) * gk; }
        for (int i = gt; i < 1024; i += NGT) { const float gk = AP->ffn_g[i]; *((GAS f32x4*)WRGF + i) = *((const GAS f32x4*)AP->w_rg + i) * gk; }
        for (int t = gw; t < T; t += 2 * NGW) {
            const int t2 = (t + NGW < T) ? t + NGW : t;
            const GAS f32x4* xr = (const GAS f32x4*)(AP->x + (size_t)t * D) + lane; const GAS f32x4* xr2 = (const GAS f32x4*)(AP->x + (size_t)t2 * D) + lane; f32x4 v[4], w[4]; float s = 0.f, s2 = 0.f;
#pragma unroll
            for (int j = 0; j < 4; ++j) { v[j] = xr[64 * j]; w[j] = xr2[64 * j]; }
#pragma unroll
            for (int j = 0; j < 4; ++j) { s += (v[j].x * v[j].x + v[j].y * v[j].y) + (v[j].z * v[j].z + v[j].w * v[j].w); s2 += (w[j].x * w[j].x + w[j].y * w[j].y) + (w[j].z * w[j].z + w[j].w * w[j].w); }
            const float rstd = 1.0f / sqrtf(wave_sum(s) * (1.f / D) + EPS), rstd2 = 1.0f / sqrtf(wave_sum(s2) * (1.f / D) + EPS);
            GAS unsigned long long* o8 = (GAS unsigned long long*)(XN + (size_t)t * D) + lane; GAS unsigned long long* o82 = (GAS unsigned long long*)(XN + (size_t)t2 * D) + lane;
#pragma unroll
            for (int j = 0; j < 4; ++j) { const f32x4 g = *((const GAS f32x4*)AP->attn_g + lane + 64 * j);
                o8[64 * j] = (unsigned long long)pk2(v[j].x * rstd * g.x, v[j].y * rstd * g.y) | ((unsigned long long)pk2(v[j].z * rstd * g.z, v[j].w * rstd * g.w) << 32);
                o82[64 * j] = (unsigned long long)pk2(w[j].x * rstd2 * g.x, w[j].y * rstd2 * g.y) | ((unsigned long long)pk2(w[j].z * rstd2 * g.z, w[j].w * rstd2 * g.w) << 32); }
        }
    }
    SEAM(PH_PRO);

    if (IN(PH_PROJ)) { PH_BEGIN
        pg8::Gemm g{XN, Win_t, T, NPROJ, D}; pg8::StaticOrder S; S.init(T, NPROJ, G, bx);
        pg8::EpiProj E{ws, WS_QLN, WS_KVLN, WS_QB, WS_KB, WS_VB, WS_SSQ, WS_KMEAN, WS_ROPE, AP->mqhead_g, AP->mkhead_g, C2B, EPS, SEQ};
        pg8::gemm_phase<pg8::EpiProj, pg8::StaticOrder, true, true>(lds, g, S, E);
    }
    SEAM(PH_PROJ);

    if (IN(PH_UP)) { PH_BEGIN
        { int K256 = 256; asm volatile("" : "+s"(K256)); pg8::Gemm g{QLN, Wq_t, T, 768, K256}; pg8::StaticOrder S; S.init(T, 768, G, bx); pg8::EpiBf16Rs E{QA, 768, SSQ, 0, 1.0f / 256.0f, EPS};
          pg8::gemm_phase<pg8::EpiBf16Rs, pg8::StaticOrder, true, true>(lds, g, S, E); }
        { int K256 = 256; asm volatile("" : "+s"(K256)); pg8::Gemm g{KVLN, Wkv_t, T, 1024, K256}; pg8::StaticOrder S; S.init(T, 1024, G, bx); pg8::EpiKv E{KA, VA, KVLN, SSQ, ropeR, AP->khead_g, EPS, SEQ};
          pg8::gemm_phase<pg8::EpiKv, pg8::StaticOrder, true, true>(lds, g, S, E); }
    }
    SEAM(PH_UP);

    if (IN(PH_ATTN)) { PH_BEGIN
        bf16* O = XN;
        for (int u = bx; u < 512; u += G) {
            const int bh = u & 255, b = bh >> 3, h = bh & 7; const size_t r0 = (size_t)b * SEQ;
            if (u < 256) {
                for (int qb = 7; qb >= 0; --qb)
                    attn_unit<96, false, true>(lds, AP->qhead_g, ropeR, QA + r0 * 768 + h * 96, 768, KA + r0 * 768 + h * 96, 768, VA + r0 * 512 + h * 64, 512, (bf16*)((unsigned char*)O + r0 * 1024 + h * 64), 1024, OSSQ + r0 * 16 + h, qb, nullptr, 0);
            } else {
                for (int qb = 7; qb >= 0; --qb)
                    attn_unit<64, true, false>(lds, nullptr, nullptr, QB + r0 * 512 + h * 64, 512, KB + r0 * 512 + h * 64, 512, VB + r0 * 512 + h * 64, 512, (bf16*)((unsigned char*)O + r0 * 1024 + 512 + h * 64), 1024, OSSQ + r0 * 16 + 8 + h, qb, kmean + ((size_t)b * 8 * NH + h) * 64, NH * 64);
            }
        }
    }
    SEAM(PH_ATTN);

    if (IN(PH_OUT)) { PH_BEGIN
        pg8::Gemm g{XN, Wo_t, T, D, D / 2};        pg8::StaticOrder S; S.init(T, D, G, bx);
        LAS float* rsl = (LAS float*)(lds + RING_BYTES);
        { pg8::Unit uu;
          for (int i = 0; i < 12 && S.next(i, uu); ++i) if (tid < 256) { const GAS f32x4* pq = (const GAS f32x4*)((const GAS float*)OSSQ + (size_t)(uu.pm * 256 + tid) * 16); const f32x4 a0 = pq[0], a1 = pq[1], b0 = pq[2], b1 = pq[3];
              const float sa = ((a0[0] + a0[1]) + (a0[2] + a0[3])) + ((a1[0] + a1[1]) + (a1[2] + a1[3])), sb = ((b0[0] + b0[1]) + (b0[2] + b0[3])) + ((b1[0] + b1[1]) + (b1[2] + b1[3]));
              const float ra = 1.0f / sqrtf(sa * (1.0f / 512.0f) + EPS), rb = 1.0f / sqrtf(sb * (1.0f / 512.0f) + EPS);
              *(LAS f32x2*)(rsl + (i * 256 + tid) * 2) = (f32x2){ra / rb, rb}; }
          __syncthreads(); }
        pg8::EpiOut E{AP->x, X1B, rsl};
        pg8::gemm_phase<pg8::EpiOut, pg8::StaticOrder, true, true, false, false, true, 0x7a7a7a7a, 0x7b7b7b7b, true>(lds, g, S, E);
    }
    SEAM(PH_OUT);

    if (IN(PH_ROUTE)) { PH_BEGIN
        LAS float* Wrg = (LAS float*)(lds + P8_WRG); LAS float* xt = (LAS float*)(lds + P8_XT + wave * P8_XT_WAVE); LAS float* wc = (LAS float*)(lds + P8_WC);
        LAS int* rt_g = (LAS int*)(lds + P8_RT); LAS float* rt_w = (LAS float*)(lds + P8_RT + 1024); LAS int* rt_rank = (LAS int*)(lds + P8_RT + 3072);
        LAS int* lcnt = (LAS int*)(lds + P8_RT + 4096); LAS int* lbase = (LAS int*)(lds + P8_RT + 4608); LAS float* rt_rs = (LAS float*)(lds + P8_RT + 5120);
        for (int k = tid; k < 1024; k += 512) *(LAS f32x4*)(Wrg + 4 * k) = *((const GAS f32x4*)WRGF + k);
        __syncthreads();
        const int r32 = lane & 31, kh = lane >> 5;
        for (int chunk = bx; chunk < T / 256; chunk += G) {
            if (tid < NCLS) lcnt[tid] = 0;
            const int rowc = wave * 32 + r32; const size_t row0w = (size_t)chunk * 256 + wave * 32;
            const GAS bf16* xsrc = (const GAS bf16*)X1B + (row0w + (lane >> 4)) * D + 4 * (lane & 15);
            f32x16 accE = {}; float aG0 = 0.f, aG1 = 0.f, aG2 = 0.f, aG3 = 0.f, ssq = 0.f;
            *(LAS f32x4*)(wc + 4 * tid) = *((const GAS f32x4*)WREF + tid);
            for (int kc = 0; kc < 16; ++kc) {
                f32x4 st[8];
#pragma unroll
                for (int j = 0; j < 8; ++j) { const v2u xw = *(const GAS v2u*)(xsrc + (size_t)(4 * j) * D + kc * 64); st[j] = (f32x4){bflo(xw.x), bfhi(xw.x), bflo(xw.y), bfhi(xw.y)}; }
                f32x4 wnext = {0.f, 0.f, 0.f, 0.f}; if (kc + 1 < 16) wnext = *((const GAS f32x4*)WREF + (kc + 1) * 512 + tid);
#pragma unroll
                for (int j = 0; j < 8; ++j) *(LAS f32x4*)(xt + ((lane >> 4) + 4 * j) * 68 + 4 * (lane & 15)) = st[j];
                if (kc + 1 < 16) *(LAS f32x4*)(wc + ((kc + 1) & 1) * 2048 + 4 * tid) = wnext;
                { const f32x4 gv = *(const GAS f32x4*)((const GAS float*)AP->ffn_g + kc * 64 + 4 * (lane & 15));
#pragma unroll
                  for (int j = 0; j < 8; ++j) { const f32x4 hv = st[j] * gv;
                      *(GAS unsigned*)((GAS unsigned char*)YH + (size_t)(row0w + (lane >> 4) + 4 * j) * D + kc * 64 + 4 * (lane & 15)) = pk4_fp8(hv[0], hv[1], hv[2], hv[3]); } }
                __syncthreads();
                const LAS float* wcc = wc + (kc & 1) * 2048 + r32;
#pragma unroll
                for (int c = 0; c < 8; ++c) {
                    const f32x4 xv = *(const LAS f32x4*)(xt + r32 * 68 + 8 * c + 4 * kh);
                    ssq += (xv.x * xv.x + xv.y * xv.y) + (xv.z * xv.z + xv.w * xv.w);
#pragma unroll
                    for (int e = 0; e < 4; ++e) { const int kl = 8 * c + 4 * kh + e;
                        const float a = wcc[kl * 32]; accE = __builtin_amdgcn_mfma_f32_32x32x2f32(a, xv[e], accE, 0, 0, 0);
                        const f32x4 wg = *(const LAS f32x4*)(Wrg + 4 * (kc * 64 + kl)); aG0 += xv[e] * wg[0]; aG1 += xv[e] * wg[1]; aG2 += xv[e] * wg[2]; aG3 += xv[e] * wg[3]; }
                }
                __syncthreads();
            }
            ssq += __shfl_xor(ssq, 32); aG0 += __shfl_xor(aG0, 32); aG1 += __shfl_xor(aG1, 32); aG2 += __shfl_xor(aG2, 32); aG3 += __shfl_xor(aG3, 32);
            const float rstd = 1.0f / sqrtf(ssq * (1.f / D) + EPS);
            float lg[4] = {aG0 * rstd + AP->b_rg[0], aG1 * rstd + AP->b_rg[1], aG2 * rstd + AP->b_rg[2], aG3 * rstd + AP->b_rg[3]};
            int gs = 0; float gm = lg[0];
#pragma unroll
            for (int i = 1; i < 4; ++i) if (lg[i] > gm) { gm = lg[i]; gs = i; }
            float den = 0.f;
#pragma unroll
            for (int i = 0; i < 4; ++i) den += __expf(lg[i] - gm);
            const float gwt = 1.0f / den;
            float mine[4];
#pragma unroll
            for (int i = 0; i < 4; ++i) { const float v = (gs == 0) ? accE[i] : (gs == 1) ? accE[4 + i] : (gs == 2) ? accE[8 + i] : accE[12 + i]; mine[i] = v * rstd + AP->b_re[gs * 8 + 4 * kh + i]; }
            float ev[8];
#pragma unroll
            for (int i = 0; i < 4; ++i) { const float oth = __shfl_xor(mine[i], 32); ev[i] = kh ? oth : mine[i]; ev[4 + i] = kh ? mine[i] : oth; }
            int e1 = 0; float v1 = ev[0];
#pragma unroll
            for (int i = 1; i < 8; ++i) if (ev[i] > v1) { v1 = ev[i]; e1 = i; }
            int e2 = -1; float v2 = -INFINITY;
#pragma unroll
            for (int i = 0; i < 8; ++i) if (i != e1 && (e2 < 0 || ev[i] > v2)) { v2 = ev[i]; e2 = i; }
            const float ex = __expf(v2 - v1); const float w1 = gwt / (1.0f + ex), w2 = gwt * ex / (1.0f + ex);
            if (kh == 0) { const int elo = e1 < e2 ? e1 : e2, ehi = e1 < e2 ? e2 : e1;
                rt_g[rowc] = gs * 28 + ((elo * (15 - elo)) >> 1) + (ehi - elo - 1); rt_w[rowc * 2] = e1 < e2 ? w1 : w2; rt_w[rowc * 2 + 1] = e1 < e2 ? w2 : w1; rt_rs[rowc] = rstd; }
            __syncthreads();
            if (tid < 256) rt_rank[tid] = __hip_atomic_fetch_add(&lcnt[rt_g[tid]], 1, __ATOMIC_RELAXED, __HIP_MEMORY_SCOPE_WORKGROUP);
            __syncthreads();
            if (tid < NCLS) { const int n = lcnt[tid]; lbase[tid] = n ? (int)__hip_atomic_fetch_add((gu32*)(ws + WS_CTL) + CW_GCNT + 64 * tid, (unsigned)n, RLX_AGENT) : 0; }
            __syncthreads();
            if (tid < 256) { const int g = rt_g[tid]; v4u ev; ev.x = (unsigned)(chunk * 256 + tid); ev.y = __builtin_bit_cast(unsigned, rt_w[tid * 2]); ev.z = __builtin_bit_cast(unsigned, rt_w[tid * 2 + 1]); ev.w = __builtin_bit_cast(unsigned, rt_rs[tid]);
                ((GAS v4u*)lists)[(size_t)g * LIST_CAP + lbase[g] + rt_rank[tid]] = ev; }
            __syncthreads();
        }
    }
    SEAM(PH_ROUTE);

    LAS int* tp = (LAS int*)(lds + TP_OFF); LAS int* cntl = (LAS int*)(lds + CNT_OFF); LAS int* ptab = (LAS int*)(lds + PT_OFF);
    if (hi > PH_ROUTE) {
        if (tid0 == 0) { gu32* ctl = (gu32*)(A.ws + WS_CTL); int acc = 0; for (int g = 0; g < NCLS; ++g) { const int n = (int)__hip_atomic_load(ctl + CW_GCNT + 64 * g, RLX_AGENT); cntl[g] = n; tp[g] = acc; acc += (n + 255) >> 8; } tp[NCLS] = acc;
            int p = 0; for (int lo_ = 0; lo_ < 8; ++lo_) for (int hi_ = lo_ + 1; hi_ < 8; ++hi_) ptab[p++] = lo_ | (hi_ << 4); }
        __syncthreads();
    }

    if (IN(PH_GU)) { PH_BEGIN
        pg8::Gemm g{YH, Wgu_t, 0, 0, D / 2}; pg8::ClsOrder S{tp, ptab, 0, G, MOE_SLOT(4), lists, cntl};
        pg8::EpiGateUp2 E{HB, lists, cntl};
        pg8::gemm_phase<pg8::EpiGateUp2, pg8::ClsOrder, true, true, true, false, true>(lds, g, S, E);
    }
    SEAM(PH_GU);

    if (IN(PH_D0)) { PH_BEGIN
        int K512 = 256; asm volatile("" : "+s"(K512)); pg8::Gemm g{HB, Wd_t, 0, 0, K512};        pg8::ClsOrder S{tp, ptab, 1, G, MOE_SLOT(4), lists, cntl};
        pg8::EpiDown2 E{AP->out, X1B, lists, cntl};
        pg8::gemm_phase<pg8::EpiDown2, pg8::ClsOrder, true, true, false, true, true, 0x7b7b7b7b, 0x7c7c7c7c, true>(lds, g, S, E);
    }
#undef IN
#undef SEAM
}

extern "C" void kernel_launch(void* const* d_in, const int* in_sizes, int n_in, void* d_out, int out_size, void* d_ws, size_t ws_size, hipStream_t stream) {
    static int grid = 0;
    if (grid == 0) {
        if (n_in != 22 || in_sizes[0] != T * D || out_size != T * D || ws_size < WS_END) { fprintf(stderr, "kernel_launch: unexpected shapes (n_in %d, in0 %d, out %d, ws %zu); nothing launched\n", n_in, n_in > 0 ? in_sizes[0] : -1, out_size, ws_size); grid = -1; return; }
        int dev = 0, cus = 0, per_cu = 0;
        if (hipGetDevice(&dev) != hipSuccess || hipDeviceGetAttribute(&cus, hipDeviceAttributeMultiprocessorCount, dev) != hipSuccess) { grid = -1; return; }
        if (hipFuncSetAttribute((const void*)mk_fwd, hipFuncAttributeMaxDynamicSharedMemorySize, LDS_BYTES) != hipSuccess) { fprintf(stderr, "kernel_launch: hipFuncSetAttribute failed\n"); grid = -1; return; }
        if (hipOccupancyMaxActiveBlocksPerMultiprocessor(&per_cu, (const void*)mk_fwd, 512, LDS_BYTES) != hipSuccess || per_cu < 1) { fprintf(stderr, "kernel_launch: occupancy query says %d\n", per_cu); }
        (void)hipGetLastError();
        grid = cus;
    }
    if (grid < 0) return;
    if (hipMemsetAsync((char*)d_ws + WS_CTL, 0, CTL_ZERO_BYTES, stream) != hipSuccess) return;
    Args a{};
    a.x = (const float*)d_in[0]; a.attn_g = (const float*)d_in[1]; a.w_in = (const float*)d_in[2]; a.qlat_g = (const float*)d_in[3]; a.w_qup = (const float*)d_in[4];
    a.kvlat_g = (const float*)d_in[5]; a.w_kvup = (const float*)d_in[6]; a.qhead_g = (const float*)d_in[7]; a.khead_g = (const float*)d_in[8];
    a.mqhead_g = (const float*)d_in[9]; a.mkhead_g = (const float*)d_in[10]; a.onorm_a_g = (const float*)d_in[11]; a.onorm_b_g = (const float*)d_in[12];
    a.w_out = (const float*)d_in[13]; a.ffn_g = (const float*)d_in[14]; a.w_rg = (const float*)d_in[15]; a.b_rg = (const float*)d_in[16];
    a.w_re = (const float*)d_in[17]; a.b_re = (const float*)d_in[18]; a.w_gate = (const float*)d_in[19]; a.w_up = (const float*)d_in[20]; a.w_down = (const float*)d_in[21];
    a.out = (float*)d_out; a.ws = (unsigned char*)d_ws; a.ph_lo = 0; a.ph_hi = NPHASE;
    hipLaunchKernelGGL(mk_fwd, dim3(grid), dim3(512), LDS_BYTES, stream, a);
    (void)hipPeekAtLastError();
}
```

```cpp
#include <hip/hip_runtime.h>
#include <cstdio>
#include <cstdint>
namespace pg8 {
#define PG8_LAS __attribute__((address_space(3)))
typedef unsigned short bf16_t;
typedef short bf16x8 __attribute__((ext_vector_type(8)));
typedef float f32x4 __attribute__((ext_vector_type(4)));
typedef unsigned u32x4 __attribute__((ext_vector_type(4)));
constexpr int BM = 256, BK = 64, HALF = 128, HTB = HALF * BK * 2  , STAGE_BYTES = 8 * HTB, NXCD = 8, WGM = 8;

__host__ __device__ __forceinline__ int lds_byte(int r, int c) { const int st = (r >> 4) * 2 + (c >> 5), rr = r & 15, cc = c & 31, ob = rr * 64 + cc * 2; return st * 1024 + (ob ^ (((ob >> 9) & 1) << 5)); }
__host__ __device__ __forceinline__ void stage_rc(int b, int& R, int& C) { const int st = b / 1024, sb = b % 1024, swz = sb ^ (((sb >> 9) & 1) << 5); R = (st >> 1) * 16 + swz / 64; C = (st & 1) * 32 + (swz % 64) / 2; }
__host__ __device__ __forceinline__ int perm32(int rho) { const int n = rho >> 4, i = rho & 15; return 8 * (i >> 2) + 4 * n + (i & 3); }

struct Unit { int pm, pn, g0, g1, pn2, q; };
struct Gemm { const bf16_t* A; const bf16_t* Bt; int M, N, K; };

struct StaticOrder {
    int nM, nN, nwg, G, c;
    __host__ __device__ void init(int M, int N, int G_, int c_) { nM = M / BM; nN = N / BM; nwg = nM * nN; G = G_; c = c_; }
    __host__ __device__ bool next(int i, Unit& u) const {
        const long L = (long)i * G + c; if (L >= nwg) return false;
        int wgid = (int)L; { const int q = nwg / NXCD, r = nwg % NXCD, xcd = wgid % NXCD, off = wgid / NXCD; wgid = (xcd < r ? xcd * (q + 1) : r * (q + 1) + (xcd - r) * q) + off; }
        const int nig = WGM * nN, gid = wgid / nig, fm = gid * WGM, gsz = (nM - fm) < WGM ? (nM - fm) : WGM;
        u.pm = fm + ((wgid % nig) % gsz); u.pn = (wgid % nig) / gsz; u.g0 = i; u.g1 = 0; u.pn2 = 0; u.q = 0; return true;
    }
    __device__ __forceinline__ void a_ready(const Unit&) const {}
    __device__ __forceinline__ void done(const Unit&) const {}
};

__device__ __forceinline__ unsigned cvt_pk_bf16(float lo, float hi) { unsigned r; asm volatile("v_cvt_pk_bf16_f32 %0, %1, %2" : "=v"(r) : "v"(lo), "v"(hi)); return r; }
#define PG8_GAS __attribute__((address_space(1)))
struct ListEnt { int tok; float w_lo; float w_hi; float rstd; };

struct EpiBf16 {
    static constexpr bool PERM = true, AFTER_DRAIN = false, MIDHOOK = false;
    bf16_t* O; int ldc;
    __device__ __forceinline__ void operator()(const f32x4 (&acc)[2][2][4][2], const Unit& u, int wr, int wc, int fr, int fq) const {
        const int row0 = u.pm * BM + wr * 64 + fr; const int col0 = u.pn * BM + wc * 32 + 8 * fq;
#pragma unroll
        for (int ai = 0; ai < 2; ++ai)
#pragma unroll
            for (int m = 0; m < 4; ++m) { bf16_t* rowp = O + (size_t)(row0 + ai * HALF + m * 16) * ldc + col0;
#pragma unroll
                for (int bj = 0; bj < 2; ++bj) { const f32x4 v0 = acc[ai][bj][m][0], v1 = acc[ai][bj][m][1];
                    u32x4 w; w.x = cvt_pk_bf16(v0[0], v0[1]); w.y = cvt_pk_bf16(v0[2], v0[3]); w.z = cvt_pk_bf16(v1[0], v1[1]); w.w = cvt_pk_bf16(v1[2], v1[3]);
                    *(PG8_GAS u32x4*)(rowp + bj * HALF) = w; } }
    }
};
struct EpiBf16Rs {
    static constexpr bool PERM = true, AFTER_DRAIN = false, MIDHOOK = false;
    bf16_t* O; int ldc; const float* ssq; int off; float inv_n, eps;
    __device__ __forceinline__ void operator()(const f32x4 (&acc)[2][2][4][2], const Unit& u, int wr, int wc, int fr, int fq) const {
        const int row0 = u.pm * BM + wr * 64 + fr; const int col0 = u.pn * BM + wc * 32 + 8 * fq;
#pragma unroll
        for (int ai = 0; ai < 2; ++ai)
#pragma unroll
            for (int m = 0; m < 4; ++m) { const int row = row0 + ai * HALF + m * 16; PG8_GAS bf16_t* rowp = (PG8_GAS bf16_t*)O + (size_t)row * ldc + col0;
                const f32x4 sq = *(const PG8_GAS f32x4*)(ssq + (size_t)row * 8 + off); const float rs = 1.0f / sqrtf(((sq[0] + sq[1]) + (sq[2] + sq[3])) * inv_n + eps);
#pragma unroll
                for (int bj = 0; bj < 2; ++bj) { const f32x4 v0 = acc[ai][bj][m][0] * rs, v1 = acc[ai][bj][m][1] * rs;
                    u32x4 w; w.x = cvt_pk_bf16(v0[0], v0[1]); w.y = cvt_pk_bf16(v0[2], v0[3]); w.z = cvt_pk_bf16(v1[0], v1[1]); w.w = cvt_pk_bf16(v1[2], v1[3]);
                    *(PG8_GAS u32x4*)(rowp + bj * HALF) = w; } }
    }
};
struct EpiProj {
    static constexpr bool PERM = true, AFTER_DRAIN = false, MIDHOOK = false;
    unsigned char* ws; size_t o_qln, o_kvln, o_qb, o_kb, o_vb, o_ssq, o_kmean, o_rope; const float* gq; const float* gk; float qscale, eps; int seq;
    __device__ __forceinline__ void operator()(const f32x4 (&acc)[2][2][4][2], const Unit& u, int wr, int wc, int fr, int fq) const {
        const int pn = u.pn; const int row0 = u.pm * BM + wr * 64 + fr;
        bf16_t* const QLN = (bf16_t*)(ws + o_qln); bf16_t* const KVLN = (bf16_t*)(ws + o_kvln); bf16_t* const QB = (bf16_t*)(ws + o_qb); bf16_t* const KB = (bf16_t*)(ws + o_kb); bf16_t* const VB = (bf16_t*)(ws + o_vb);
        float* const SSQ = (float*)(ws + o_ssq); float* const kmean = (float*)(ws + o_kmean); const float* const rope = (const float*)(ws + o_rope);
        if (pn < 2) {
            PG8_GAS bf16_t* O = (PG8_GAS bf16_t*)(pn ? KVLN : QLN); PG8_GAS float* sq = (PG8_GAS float*)SSQ;
#pragma unroll
            for (int ai = 0; ai < 2; ++ai)
#pragma unroll
                for (int m = 0; m < 4; ++m) { const int row = row0 + ai * HALF + m * 16; PG8_GAS bf16_t* rowp = O + (size_t)row * 256 + wc * 32 + 8 * fq; float ss = 0.f;
#pragma unroll
                    for (int bj = 0; bj < 2; ++bj) { const f32x4 v0 = acc[ai][bj][m][0], v1 = acc[ai][bj][m][1];
                        if (pn == 0 || bj == 0) ss += (v0[0] * v0[0] + v0[1] * v0[1]) + (v0[2] * v0[2] + v0[3] * v0[3]) + (v1[0] * v1[0] + v1[1] * v1[1]) + (v1[2] * v1[2] + v1[3] * v1[3]);
                        u32x4 w; w.x = cvt_pk_bf16(v0[0], v0[1]); w.y = cvt_pk_bf16(v0[2], v0[3]); w.z = cvt_pk_bf16(v1[0], v1[1]); w.w = cvt_pk_bf16(v1[2], v1[3]);
                        *(PG8_GAS u32x4*)(rowp + bj * HALF) = w; }
                    ss += __shfl_xor(ss, 16); ss += __shfl_xor(ss, 32);
                    if (fq == 0) sq[(size_t)row * 8 + pn * 4 + wc] = ss; }
        } else if (pn < 6) {
            const bool isk = pn >= 4; const int head = (pn & 1) * 4 + wc; const float* gp = isk ? gk : gq; asm volatile("" : "+s"(gp)); const float sc = isk ? 1.0f : qscale;
            PG8_GAS bf16_t* O = (PG8_GAS bf16_t*)(isk ? KB : QB);
            f32x4 g0[2], g1[2];
#pragma unroll
            for (int n = 0; n < 2; ++n) { g0[n] = *(const PG8_GAS f32x4*)(gp + 8 * fq + 4 * n); g1[n] = *(const PG8_GAS f32x4*)(gp + 32 + 8 * fq + 4 * n); }
            f32x4 cs0[2] = {{0.f, 0.f, 0.f, 0.f}, {0.f, 0.f, 0.f, 0.f}}, cs1[2] = {{0.f, 0.f, 0.f, 0.f}, {0.f, 0.f, 0.f, 0.f}};
#pragma unroll
            for (int ai = 0; ai < 2; ++ai)
#pragma unroll
                for (int m = 0; m < 4; ++m) { const int row = row0 + ai * HALF + m * 16; const int pos = row & (seq - 1);
                    float ss = 0.f;
#pragma unroll
                    for (int n = 0; n < 2; ++n) { const f32x4 a = acc[ai][0][m][n], b = acc[ai][1][m][n]; ss += (a[0] * a[0] + a[1] * a[1]) + (a[2] * a[2] + a[3] * a[3]) + (b[0] * b[0] + b[1] * b[1]) + (b[2] * b[2] + b[3] * b[3]); }
                    ss += __shfl_xor(ss, 16); ss += __shfl_xor(ss, 32);
                    const float rs = 1.0f / sqrtf(ss * (1.0f / 64.0f) + eps);
                    u32x4 w1, w2; unsigned pk1[4], pk2_[4];
#pragma unroll
                    for (int n = 0; n < 2; ++n) { const f32x4 c = *(const PG8_GAS f32x4*)(rope + (size_t)pos * 32 + 8 * fq + 4 * n), sn = *(const PG8_GAS f32x4*)(rope + (size_t)seq * 32 + (size_t)pos * 32 + 8 * fq + 4 * n);
                        const f32x4 y1 = acc[ai][0][m][n] * rs * g0[n], y2 = acc[ai][1][m][n] * rs * g1[n];
                        const f32x4 o1 = (y1 * c - y2 * sn) * sc, o2 = (y2 * c + y1 * sn) * sc;
                        if (isk) { cs0[n] += o1; cs1[n] += o2; }
                        pk1[2 * n] = cvt_pk_bf16(o1[0], o1[1]); pk1[2 * n + 1] = cvt_pk_bf16(o1[2], o1[3]); pk2_[2 * n] = cvt_pk_bf16(o2[0], o2[1]); pk2_[2 * n + 1] = cvt_pk_bf16(o2[2], o2[3]); }
                    w1.x = pk1[0]; w1.y = pk1[1]; w1.z = pk1[2]; w1.w = pk1[3]; w2.x = pk2_[0]; w2.y = pk2_[1]; w2.z = pk2_[2]; w2.w = pk2_[3];
                    PG8_GAS bf16_t* rowp = O + (size_t)row * 512 + head * 64 + 8 * fq;
                    *(PG8_GAS u32x4*)rowp = w1; *(PG8_GAS u32x4*)(rowp + 32) = w2;
                    asm volatile("" : "+v"(cs0[0]), "+v"(cs0[1]), "+v"(cs1[0]), "+v"(cs1[1]) :: "memory"); }
            if (isk) {
                PG8_GAS float* km = (PG8_GAS float*)kmean + ((size_t)u.pm * 8 + head) * 64;
#pragma unroll
                for (int n = 0; n < 2; ++n)
#pragma unroll
                    for (int j = 0; j < 4; ++j) { float a = cs0[n][j], b = cs1[n][j];
#pragma unroll
                        for (int o = 1; o < 16; o <<= 1) { a += __shfl_xor(a, o); b += __shfl_xor(b, o); }
                        if (fr == 0) { __hip_atomic_fetch_add(km + 8 * fq + 4 * n + j, a * (1.0f / 256.0f), __ATOMIC_RELAXED, __HIP_MEMORY_SCOPE_AGENT); __hip_atomic_fetch_add(km + 32 + 8 * fq + 4 * n + j, b * (1.0f / 256.0f), __ATOMIC_RELAXED, __HIP_MEMORY_SCOPE_AGENT); } }
            }
        } else {
            PG8_GAS bf16_t* O = (PG8_GAS bf16_t*)VB; const int col0 = (pn - 6) * BM + wc * 32 + 8 * fq;
#pragma unroll
            for (int ai = 0; ai < 2; ++ai)
#pragma unroll
                for (int m = 0; m < 4; ++m) { PG8_GAS bf16_t* rowp = O + (size_t)(row0 + ai * HALF + m * 16) * 512 + col0;
#pragma unroll
                    for (int bj = 0; bj < 2; ++bj) { const f32x4 v0 = acc[ai][bj][m][0], v1 = acc[ai][bj][m][1];
                        u32x4 w; w.x = cvt_pk_bf16(v0[0], v0[1]); w.y = cvt_pk_bf16(v0[2], v0[3]); w.z = cvt_pk_bf16(v1[0], v1[1]); w.w = cvt_pk_bf16(v1[2], v1[3]);
                        *(PG8_GAS u32x4*)(rowp + bj * HALF) = w; } }
        }
    }
};
struct EpiKv {
    static constexpr bool PERM = true, AFTER_DRAIN = false, MIDHOOK = false;
    bf16_t* KA; bf16_t* VA; const bf16_t* KVLN; const float* ssq; const float* ropeR; const float* gk; float eps; int seq;
    __device__ __forceinline__ void operator()(const f32x4 (&acc)[2][2][4][2], const Unit& u, int wr, int wc, int fr, int fq) const {
        const int pn = u.pn; const int row0 = u.pm * BM + wr * 64 + fr;
        if (pn < 2) {
            const int head = pn * 4 + wc; const float* gp = gk; asm volatile("" : "+s"(gp));
            f32x4 g0[2], g1[2];
#pragma unroll
            for (int n = 0; n < 2; ++n) { g0[n] = *(const PG8_GAS f32x4*)(gp + 8 * fq + 4 * n); g1[n] = *(const PG8_GAS f32x4*)(gp + 32 + 8 * fq + 4 * n); }
            const f32x4 gr1 = *(const PG8_GAS f32x4*)(gp + 64 + 4 * fq), gr2 = *(const PG8_GAS f32x4*)(gp + 80 + 4 * fq);
#pragma unroll
            for (int ai = 0; ai < 2; ++ai)
#pragma unroll
                for (int m = 0; m < 4; ++m) { const int row = row0 + ai * HALF + m * 16; const int pos = row & (seq - 1);
                    const f32x4 sq = *(const PG8_GAS f32x4*)(ssq + (size_t)row * 8 + 4); const float rl = 1.0f / sqrtf(((sq[0] + sq[1]) + (sq[2] + sq[3])) * (1.0f / 128.0f) + eps);
                    const PG8_GAS bf16_t* pe = (const PG8_GAS bf16_t*)KVLN + (size_t)row * 256 + 128 + 4 * fq;
                    typedef unsigned u32x2_ __attribute__((ext_vector_type(2)));
                    const u32x2_ p1 = *(const PG8_GAS u32x2_*)pe, p2 = *(const PG8_GAS u32x2_*)(pe + 16);
                    const f32x4 e1 = {__builtin_bit_cast(float, p1.x << 16), __builtin_bit_cast(float, p1.x & 0xffff0000u), __builtin_bit_cast(float, p1.y << 16), __builtin_bit_cast(float, p1.y & 0xffff0000u)};
                    const f32x4 e2 = {__builtin_bit_cast(float, p2.x << 16), __builtin_bit_cast(float, p2.x & 0xffff0000u), __builtin_bit_cast(float, p2.y << 16), __builtin_bit_cast(float, p2.y & 0xffff0000u)};
                    f32x4 x0[2], x1[2]; float ss = (e1[0] * e1[0] + e1[1] * e1[1]) + (e1[2] * e1[2] + e1[3] * e1[3]) + (e2[0] * e2[0] + e2[1] * e2[1]) + (e2[2] * e2[2] + e2[3] * e2[3]);
#pragma unroll
                    for (int n = 0; n < 2; ++n) { x0[n] = acc[ai][0][m][n] * rl; x1[n] = acc[ai][1][m][n] * rl; const f32x4 a = x0[n], b = x1[n];
                        ss += (a[0] * a[0] + a[1] * a[1]) + (a[2] * a[2] + a[3] * a[3]) + (b[0] * b[0] + b[1] * b[1]) + (b[2] * b[2] + b[3] * b[3]); }
                    ss += __shfl_xor(ss, 16); ss += __shfl_xor(ss, 32);
                    const float rs = 1.0f / sqrtf(ss * (1.0f / 96.0f) + eps);
                    PG8_GAS bf16_t* rowp = (PG8_GAS bf16_t*)KA + (size_t)row * 768 + head * 96;
                    u32x4 w1, w2;
                    { const f32x4 a = x0[0] * rs * g0[0], b = x0[1] * rs * g0[1]; w1.x = cvt_pk_bf16(a[0], a[1]); w1.y = cvt_pk_bf16(a[2], a[3]); w1.z = cvt_pk_bf16(b[0], b[1]); w1.w = cvt_pk_bf16(b[2], b[3]); }
                    { const f32x4 a = x1[0] * rs * g1[0], b = x1[1] * rs * g1[1]; w2.x = cvt_pk_bf16(a[0], a[1]); w2.y = cvt_pk_bf16(a[2], a[3]); w2.z = cvt_pk_bf16(b[0], b[1]); w2.w = cvt_pk_bf16(b[2], b[3]); }
                    *(PG8_GAS u32x4*)(rowp + 8 * fq) = w1; *(PG8_GAS u32x4*)(rowp + 32 + 8 * fq) = w2;
                    const f32x4 c = *(const PG8_GAS f32x4*)(ropeR + (size_t)pos * 16 + 4 * fq), sn = *(const PG8_GAS f32x4*)(ropeR + (size_t)seq * 16 + (size_t)pos * 16 + 4 * fq);
                    const f32x4 y1 = e1 * rs * gr1, y2 = e2 * rs * gr2; const f32x4 o1 = y1 * c - y2 * sn, o2 = y2 * c + y1 * sn;
                    u32x2_ r1, r2; r1.x = cvt_pk_bf16(o1[0], o1[1]); r1.y = cvt_pk_bf16(o1[2], o1[3]); r2.x = cvt_pk_bf16(o2[0], o2[1]); r2.y = cvt_pk_bf16(o2[2], o2[3]);
                    *(PG8_GAS u32x2_*)(rowp + 64 + 4 * fq) = r1; *(PG8_GAS u32x2_*)(rowp + 80 + 4 * fq) = r2;
                    asm volatile("" ::: "memory"); }
        } else {
            const int col0 = (pn - 2) * BM + wc * 32 + 8 * fq;
#pragma unroll
            for (int ai = 0; ai < 2; ++ai)
#pragma unroll
                for (int m = 0; m < 4; ++m) { const int row = row0 + ai * HALF + m * 16; PG8_GAS bf16_t* rowp = (PG8_GAS bf16_t*)VA + (size_t)row * 512 + col0;
                    const f32x4 sq = *(const PG8_GAS f32x4*)(ssq + (size_t)row * 8 + 4); const float rl = 1.0f / sqrtf(((sq[0] + sq[1]) + (sq[2] + sq[3])) * (1.0f / 128.0f) + eps);
#pragma unroll
                    for (int bj = 0; bj < 2; ++bj) { const f32x4 v0 = acc[ai][bj][m][0] * rl, v1 = acc[ai][bj][m][1] * rl;
                        u32x4 w; w.x = cvt_pk_bf16(v0[0], v0[1]); w.y = cvt_pk_bf16(v0[2], v0[3]); w.z = cvt_pk_bf16(v1[0], v1[1]); w.w = cvt_pk_bf16(v1[2], v1[3]);
                        *(PG8_GAS u32x4*)(rowp + bj * HALF) = w; } }
        }
    }
};
struct EpiOut {
    static constexpr bool PERM = true, AFTER_DRAIN = false, MIDHOOK = true;
    const float* base; bf16_t* x1b; const PG8_LAS float* rsl;
    __device__ __forceinline__ void mid(f32x4 (&acc)[2][2][4][2], const Unit& u, int wr, int wc, int fr, int fq) const {
        const PG8_LAS float* rs = rsl + (u.g0 * 256 + wr * 64 + fr) * 2;
#pragma unroll
        for (int ai = 0; ai < 2; ++ai)
#pragma unroll
            for (int m = 0; m < 4; ++m) { const float ratio = rs[(ai * HALF + m * 16) * 2];
#pragma unroll
                for (int bj = 0; bj < 2; ++bj)
#pragma unroll
                    for (int n = 0; n < 2; ++n) acc[ai][bj][m][n] *= ratio; }
    }
    __device__ __forceinline__ void operator()(const f32x4 (&acc)[2][2][4][2], const Unit& u, int wr, int wc, int fr, int fq) const {
        const int row0 = u.pm * BM + wr * 64 + fr; const int col0 = u.pn * BM + wc * 32 + 8 * fq;
        const PG8_LAS float* rs = rsl + (u.g0 * 256 + wr * 64 + fr) * 2 + 1;
#pragma unroll
        for (int ai = 0; ai < 2; ++ai)
#pragma unroll
            for (int m = 0; m < 4; ++m) { const int row = row0 + ai * HALF + m * 16; const size_t off = (size_t)row * 1024 + col0; const float rb = rs[(ai * HALF + m * 16) * 2];
#pragma unroll
                for (int bj = 0; bj < 2; ++bj) { const size_t p = off + bj * HALF;
                    const f32x4 v0 = *(const PG8_GAS f32x4*)(base + p) + acc[ai][bj][m][0] * rb, v1 = *(const PG8_GAS f32x4*)(base + p + 4) + acc[ai][bj][m][1] * rb;
                    u32x4 o; o.x = cvt_pk_bf16(v0[0], v0[1]); o.y = cvt_pk_bf16(v0[2], v0[3]); o.z = cvt_pk_bf16(v1[0], v1[1]); o.w = cvt_pk_bf16(v1[2], v1[3]);
                    *(PG8_GAS u32x4*)(x1b + p) = o; }
                if (m & 1) asm volatile("" ::: "memory"); }
    }
};
struct EpiGateUp2 {
    static constexpr bool PERM = true, AFTER_DRAIN = false, MIDHOOK = false;
    bf16_t* H; const ListEnt* lists; const PG8_LAS int* cnt;
    __device__ __forceinline__ void operator()(const f32x4 (&acc)[2][2][4][2], const Unit& u, int wr, int wc, int fr, int fq) const {
        const int rt0 = wr * 64 + fr; const int col0 = (u.q >> 1) * 256 + (u.q & 1) * 128 + wc * 32 + 8 * fq; const int g = u.g0; const int n_g = cnt[g]; const bool hiexp = (u.q >> 1) != 0;
        const ListEnt* lg = lists + (size_t)g * 65536 + u.g1 * 256;
#pragma unroll
        for (int ai = 0; ai < 2; ++ai)
#pragma unroll
            for (int m = 0; m < 4; ++m) { const int rt = rt0 + ai * HALF + m * 16; const bool valid = (u.g1 * 256 + rt) < n_g;
                float w = 0.f, rsd = 0.f; if (valid) { const f32x4 le = *(const PG8_GAS f32x4*)((const PG8_GAS ListEnt*)lg + rt); w = hiexp ? le[2] : le[1]; rsd = le[3]; }
                unsigned pk[2];
#pragma unroll
                for (int n = 0; n < 2; ++n) { const f32x4 gv = acc[ai][0][m][n], uv = acc[ai][1][m][n]; float h[4];
#pragma unroll
                    for (int j = 0; j < 4; ++j) { const float a = gv[j] * rsd; const float s = a * __builtin_amdgcn_rcpf(1.0f + __builtin_amdgcn_exp2f(-1.4426950408889634f * a)); h[j] = valid ? s * (uv[j] * rsd) * w : 0.f; }
                    { int w_ = 0; w_ = __builtin_amdgcn_cvt_pk_fp8_f32(h[0] * 8.0f, h[1] * 8.0f, w_, false); w_ = __builtin_amdgcn_cvt_pk_fp8_f32(h[2] * 8.0f, h[3] * 8.0f, w_, true); pk[n] = (unsigned)w_; } }
                typedef unsigned u32x2h_ __attribute__((ext_vector_type(2))); u32x2h_ o; o.x = pk[0]; o.y = pk[1];
                *(PG8_GAS u32x2h_*)((PG8_GAS unsigned char*)H + (size_t)(u.pm * BM + rt) * 512 + col0) = o; }
    }
};
struct EpiDown2 {
    static constexpr bool PERM = true, AFTER_DRAIN = false, MIDHOOK = false;
    float* out; const bf16_t* x1b; const ListEnt* lists; const PG8_LAS int* cnt;
    __device__ __forceinline__ void operator()(const f32x4 (&acc)[2][2][4][2], const Unit& u, int wr, int wc, int fr, int fq) const {
        const int rt0 = wr * 64 + fr; const int col0 = u.q * 256 + wc * 32 + 8 * fq; const int g = u.g0; const int n_g = cnt[g];
        const ListEnt* lg = lists + (size_t)g * 65536 + u.g1 * 256;
#pragma unroll
        for (int ai = 0; ai < 2; ++ai)
#pragma unroll
            for (int m = 0; m < 4; ++m) { const int rt = rt0 + ai * HALF + m * 16; const bool valid = (u.g1 * 256 + rt) < n_g;
                if (valid) { const int tok = ((const PG8_GAS ListEnt*)lg)[rt].tok; PG8_GAS float* orow = (PG8_GAS float*)out + (size_t)tok * 1024 + col0;
#pragma unroll
                    for (int bj = 0; bj < 2; ++bj) { PG8_GAS float* p = orow + bj * HALF; const u32x4 xb = *(const PG8_GAS u32x4*)((const PG8_GAS bf16_t*)x1b + (size_t)tok * 1024 + col0 + bj * HALF);
                        f32x4 a, b; a[0] = __builtin_bit_cast(float, xb.x << 16); a[1] = __builtin_bit_cast(float, xb.x & 0xffff0000u); a[2] = __builtin_bit_cast(float, xb.y << 16); a[3] = __builtin_bit_cast(float, xb.y & 0xffff0000u);
                        b[0] = __builtin_bit_cast(float, xb.z << 16); b[1] = __builtin_bit_cast(float, xb.z & 0xffff0000u); b[2] = __builtin_bit_cast(float, xb.w << 16); b[3] = __builtin_bit_cast(float, xb.w & 0xffff0000u);
                        *(PG8_GAS f32x4*)p = a + acc[ai][bj][m][0]; *(PG8_GAS f32x4*)(p + 4) = b + acc[ai][bj][m][1]; } }
                if (m & 1) asm volatile("" ::: "memory"); }
    }
};
struct ClsOrder {
    const PG8_LAS int* tp; const PG8_LAS int* ptab; int mode, G, c; const ListEnt* lists; const PG8_LAS int* cnt;
    __device__ __forceinline__ int arow(const Unit& u, int row) const { const unsigned pos = (unsigned)(u.g1 * 256 + row); const unsigned n = (unsigned)cnt[u.g0]; const PG8_GAS ListEnt* lg = (const PG8_GAS ListEnt*)lists + (size_t)u.g0 * 65536; return lg[pos < n ? pos : 0u].tok; }
    __device__ __forceinline__ bool next(int i, Unit& u) const {
        const int nrb = tp[112]; const long L = (long)i * G + c; if (L >= (long)nrb * 4) return false;
        const int rbt = (int)(L >> 2), q = (int)(L & 3);
        int g = 0;
#pragma unroll
        for (int s = 64; s >= 1; s >>= 1) { const int gg = g + s; if (gg < 112 && tp[gg] <= rbt) g = gg; }
        const int grp = g / 28, pr = ptab[g - grp * 28], lo = pr & 15, hi = pr >> 4;
        u.pm = rbt; u.g0 = g; u.g1 = rbt - tp[g]; u.q = q;
        if (mode == 0) { u.pn = (grp * 8 + ((q >> 1) ? hi : lo)) * 2 + (q & 1); u.pn2 = 0; } else { u.pn = (grp * 8 + lo) * 4 + q; u.pn2 = (grp * 8 + hi) * 4 + q; }
        return true;
    }
    __device__ __forceinline__ void a_ready(const Unit&) const {}
    __device__ __forceinline__ void done(const Unit&) const {}
};

template <class Epi, class Sched, bool ALIGN_EPI = false, bool SP2 = false, bool GATHER = false, bool KSPLIT = false, bool F8 = false, int SCW = 0x7a7a7a7a, int SCA = 0x7f7f7f7f, bool F8ASM = false>
__device__ __forceinline__ void gemm_phase(PG8_LAS unsigned char* lds, const Gemm g, const Sched& S, const Epi& E) {
    const int tid = threadIdx.x, wid = __builtin_amdgcn_readfirstlane(tid >> 6), lane = tid & 63, wr = wid >> 2, wc = wid & 3, fr = lane & 15, fq = lane >> 4;
    const int K = g.K, nt = K / BK;
    const int PB = KSPLIT ? (K >> 1) : K;
    static_assert(!GATHER || SP2, "gathered A rows: SP2 loop only");
    unsigned voffA[2], voffB[2];
#pragma unroll
    for (int i = 0; i < 2; ++i) { int R, C; stage_rc(tid * 16 + i * 8192, R, C); const int Rb = Epi::PERM ? ((R & ~31) + perm32(R & 31)) : R;
        voffA[i] = (unsigned)(R * K + C) * 2u; voffB[i] = (unsigned)(Rb * PB + C) * 2u; }
    const size_t kstep = (size_t)(BK * 2);
    const size_t hstep = (size_t)HALF * K * 2;
    const size_t tstep = 2 * hstep;
    const size_t hstepB = (size_t)HALF * PB * 2, tstepB = 2 * hstepB;
    const unsigned ldsw = (unsigned)wid * 1024u;
    const int aoff = lds_byte(wr * 64 + fr, fq * 8), boff = lds_byte(wc * 32 + fr, fq * 8);
#define PG8_SA(b, h) (((b) * 2 + (h)) * HTB)
#define PG8_SB(b, h) ((4 + (b) * 2 + (h)) * HTB)
#define PG8_STAGE(bufoff, gbase, voff) do { _Pragma("unroll") for (int _i = 0; _i < 2; ++_i) \
        __builtin_amdgcn_global_load_lds((const unsigned*)((const char*)(gbase) + (voff)[_i]), (PG8_LAS unsigned*)(lds + (bufoff) + ldsw + _i * 8192), 16, 0, 0); } while (0)
#define PG8_LDA(dst, b, h) do { _Pragma("unroll") for (int m = 0; m < 4; ++m) _Pragma("unroll") for (int k = 0; k < 2; ++k) dst[m][k] = *(const PG8_LAS bf16x8*)(lds + PG8_SA(b, h) + aoff + m * 2048 + k * 1024); } while (0)
#define PG8_LDB(dst, b, h) do { _Pragma("unroll") for (int n = 0; n < 2; ++n) _Pragma("unroll") for (int k = 0; k < 2; ++k) dst[n][k] = *(const PG8_LAS bf16x8*)(lds + PG8_SB(b, h) + boff + n * 2048 + k * 1024); } while (0)
#define PG8_MMA(ai, bj, At, Bt) do { __builtin_amdgcn_s_setprio(1); _Pragma("unroll") for (int m = 0; m < 4; ++m) _Pragma("unroll") for (int n = 0; n < 2; ++n) { \
        if constexpr (F8) { typedef int v4i_ __attribute__((ext_vector_type(4))); typedef int v8i_ __attribute__((ext_vector_type(8))); \
            const v8i_ w8_ = __builtin_shufflevector(__builtin_bit_cast(v4i_, Bt[n][0]), __builtin_bit_cast(v4i_, Bt[n][1]), 0, 1, 2, 3, 4, 5, 6, 7); \
            const v8i_ a8_ = __builtin_shufflevector(__builtin_bit_cast(v4i_, At[m][0]), __builtin_bit_cast(v4i_, At[m][1]), 0, 1, 2, 3, 4, 5, 6, 7); \
            if constexpr (F8ASM) { asm volatile("v_mfma_scale_f32_16x16x128_f8f6f4 %0, %1, %2, %0, %3, %4 op_sel_hi:[0,0,0]" : "+v"(acc[ai][bj][m][n]) : "v"(w8_), "v"(a8_), "v"(SCW), "v"(SCA)); }     \
            else acc[ai][bj][m][n] = __builtin_amdgcn_mfma_scale_f32_16x16x128_f8f6f4(w8_, a8_, acc[ai][bj][m][n], 0, 0, 0, SCW, 0, SCA); } \
        else { _Pragma("unroll") for (int k = 0; k < 2; ++k) acc[ai][bj][m][n] = __builtin_amdgcn_mfma_f32_16x16x32_bf16(Bt[n][k], At[m][k], acc[ai][bj][m][n], 0, 0, 0); } } \
        __builtin_amdgcn_s_setprio(0); } while (0)
#define PG8_WAIT_V(n) asm volatile("s_waitcnt vmcnt(" #n ")" ::: "memory")
#define PG8_WAIT_L(n) asm volatile("s_waitcnt lgkmcnt(" #n ")" ::: "memory")
#define PG8_BAR __builtin_amdgcn_s_barrier()
#define PG8_SCHED __builtin_amdgcn_sched_barrier(0)
#define PG8_STG_A(b, h, ptr, arr) do { if constexpr (GATHER) { PG8_STAGE(PG8_SA(b, h), (ptr), (arr)[h]); } else { PG8_STAGE(PG8_SA(b, h), (ptr) + ((h) ? hstep : 0), voffA); } } while (0)
    unsigned cv[2][2] = {{0u, 0u}, {0u, 0u}}, nvp[2] = {0u, 0u};
#define PG8_GROWS(dst, unit) do { if constexpr (GATHER) { _Pragma("unroll") for (int _h = 0; _h < 2; ++_h) _Pragma("unroll") for (int _i = 0; _i < 2; ++_i) { int R_, C_; stage_rc(tid * 16 + _i * 8192, R_, C_); \
        dst[_h][_i] = (unsigned)S.arow(unit, _h * HALF + R_) * (unsigned)(K * 2) + (unsigned)(C_ * 2); } } } while (0)
    Unit cur, nxt; int ui = 0;
    if (!S.next(0, cur)) return;
    PG8_GROWS(cv, cur);
#define PG8_GROWS_P(unit) do { _Pragma("unroll") for (int _i = 0; _i < 2; ++_i) { int R_, C_; stage_rc(tid * 16 + _i * 8192, R_, C_); nvp[_i] = (unsigned)S.arow(unit, R_) | ((unsigned)S.arow(unit, HALF + R_) << 16); } } while (0)
#define PG8_UNPACK_NV() do { _Pragma("unroll") for (int _i = 0; _i < 2; ++_i) { int R_, C_; stage_rc(tid * 16 + _i * 8192, R_, C_); cv[0][_i] = (nvp[_i] & 0xffffu) * (unsigned)(K * 2) + (unsigned)(C_ * 2); cv[1][_i] = (nvp[_i] >> 16) * (unsigned)(K * 2) + (unsigned)(C_ * 2); } } while (0)
    f32x4 acc[2][2][4][2];
#pragma unroll
    for (int a = 0; a < 2; ++a)
#pragma unroll
        for (int b = 0; b < 2; ++b)
#pragma unroll
            for (int m = 0; m < 4; ++m)
#pragma unroll
                for (int n = 0; n < 2; ++n) acc[a][b][m][n] = (f32x4){0.f, 0.f, 0.f, 0.f};
    bf16x8 At[4][2], B0[2][2], B1[2][2];
    const char* cA = (const char*)g.A + (GATHER ? (size_t)0 : (size_t)cur.pm * tstep); const char* cB = (const char*)g.Bt + (size_t)cur.pn * tstepB; const char* cB2 = KSPLIT ? (const char*)g.Bt + (size_t)cur.pn2 * tstepB : cB;
    S.a_ready(cur);
    if constexpr (SP2) {
        PG8_STAGE(PG8_SB(0, 0), cB, voffB); PG8_STAGE(PG8_SB(0, 1), cB + hstepB, voffB); PG8_STG_A(0, 0, cA, cv); PG8_STG_A(0, 1, cA, cv);
        if (wr == 1) PG8_BAR;
        PG8_WAIT_V(2); PG8_BAR;
        PG8_STAGE(PG8_SB(1, 0), cB + kstep, voffB); PG8_STG_A(1, 0, cA + kstep, cv); PG8_STAGE(PG8_SB(1, 1), cB + hstepB + kstep, voffB);
        PG8_WAIT_V(6); PG8_BAR;
    } else {
        PG8_STAGE(PG8_SB(0, 0), cB, voffB); PG8_STAGE(PG8_SA(0, 0), cA, voffA); PG8_STAGE(PG8_SB(0, 1), cB + hstepB, voffB); PG8_STAGE(PG8_SA(0, 1), cA + hstep, voffA);
        if (wr == 1) PG8_BAR;
        PG8_WAIT_V(4); PG8_BAR;
        PG8_STAGE(PG8_SB(1, 0), cB + kstep, voffB); PG8_STAGE(PG8_SA(1, 0), cA + kstep, voffA); PG8_STAGE(PG8_SB(1, 1), cB + hstepB + kstep, voffB);
        PG8_WAIT_V(6); PG8_BAR;
    }
    for (;;) {
        const bool has_next = S.next(ui + 1, nxt);
        const char* nA = (has_next && !GATHER) ? (const char*)g.A + (size_t)nxt.pm * tstep : cA; const char* nB = has_next ? (const char*)g.Bt + (size_t)nxt.pn * tstepB : cB; const char* nB2 = (KSPLIT && has_next) ? (const char*)g.Bt + (size_t)nxt.pn2 * tstepB : cB2;
        if constexpr (GATHER) { if (has_next) { PG8_GROWS_P(nxt); } else { PG8_GROWS_P(cur); } }
        const int tspan = Epi::MIDHOOK ? (nt >> 1) : nt;
        for (int t0 = 0; t0 < nt; t0 += tspan) {
        if constexpr (Epi::MIDHOOK) { if (t0 != 0) E.mid(acc, cur, wr, wc, fr, fq); }
        for (int t = t0; t < t0 + tspan; t += 2) {
            const bool last = (t == nt - 2);
            const char* a1 = cA + (size_t)(t + 1) * kstep;
            const char* a2 = last ? nA : cA + (size_t)(t + 2) * kstep; const char* b2 = last ? nB : ((KSPLIT && t + 2 >= (nt >> 1)) ? cB2 + (size_t)(t + 2 - (nt >> 1)) * kstep : cB + (size_t)(t + 2) * kstep);
            const char* a3 = a2 + kstep; const char* b3 = b2 + kstep;
            if (last && has_next) S.a_ready(nxt);
            if constexpr (SP2) {
            PG8_LDB(B0, 0, 0); PG8_LDB(B1, 0, 1); PG8_SCHED; PG8_LDA(At, 0, 0); PG8_STG_A(1, 1, a1, cv);
            if constexpr (GATHER) { if (last) { PG8_UNPACK_NV(); } }
            PG8_WAIT_V(8); PG8_WAIT_L(0); PG8_BAR; PG8_MMA(0, 0, At, B0); PG8_MMA(0, 1, At, B1); PG8_BAR; PG8_SCHED;
            PG8_LDA(At, 0, 1); PG8_STAGE(PG8_SB(0, 0), b2, voffB); PG8_STAGE(PG8_SB(0, 1), b2 + hstepB, voffB); PG8_STG_A(0, 0, a2, cv);
            PG8_WAIT_V(8); PG8_WAIT_L(0); PG8_BAR; PG8_MMA(1, 0, At, B0); PG8_MMA(1, 1, At, B1); PG8_BAR; PG8_SCHED;
            PG8_LDB(B0, 1, 0); PG8_LDB(B1, 1, 1); PG8_SCHED; PG8_LDA(At, 1, 0); PG8_STG_A(0, 1, a2, cv);
            PG8_WAIT_V(8); PG8_WAIT_L(0); PG8_BAR; PG8_MMA(0, 0, At, B0); PG8_MMA(0, 1, At, B1); PG8_BAR; PG8_SCHED;
            PG8_LDA(At, 1, 1); PG8_STAGE(PG8_SB(1, 0), b3, voffB); PG8_STAGE(PG8_SB(1, 1), b3 + hstepB, voffB); PG8_STG_A(1, 0, a3, cv);
            PG8_WAIT_V(8); PG8_WAIT_L(0); PG8_BAR; PG8_MMA(1, 0, At, B0); PG8_MMA(1, 1, At, B1); PG8_BAR; PG8_SCHED;
            } else {
            PG8_LDB(B0, 0, 0); PG8_SCHED; PG8_LDA(At, 0, 0); PG8_STAGE(PG8_SA(1, 1), a1 + hstep, voffA);
            PG8_WAIT_L(8); PG8_BAR; PG8_WAIT_L(0); PG8_MMA(0, 0, At, B0); PG8_BAR; PG8_SCHED;
            PG8_LDB(B1, 0, 1); PG8_STAGE(PG8_SB(0, 0), b2, voffB);
            PG8_BAR; PG8_WAIT_L(0); PG8_MMA(0, 1, At, B1); PG8_BAR;
            PG8_LDA(At, 0, 1); PG8_STAGE(PG8_SA(0, 0), a2, voffA);
            PG8_BAR; PG8_WAIT_L(0); PG8_MMA(1, 0, At, B0); PG8_BAR; PG8_SCHED;
            PG8_STAGE(PG8_SB(0, 1), b2 + hstepB, voffB);
            PG8_WAIT_V(6); PG8_BAR; PG8_MMA(1, 1, At, B1); PG8_BAR;
            PG8_LDB(B0, 1, 0); PG8_SCHED; PG8_LDA(At, 1, 0); PG8_STAGE(PG8_SA(0, 1), a2 + hstep, voffA);
            PG8_WAIT_L(8); PG8_BAR; PG8_WAIT_L(0); PG8_MMA(0, 0, At, B0); PG8_BAR; PG8_SCHED;
            PG8_LDB(B1, 1, 1); PG8_STAGE(PG8_SB(1, 0), b3, voffB);
            PG8_BAR; PG8_WAIT_L(0); PG8_MMA(0, 1, At, B1); PG8_BAR;
            PG8_LDA(At, 1, 1); PG8_STAGE(PG8_SA(1, 0), a3, voffA);
            PG8_BAR; PG8_WAIT_L(0); PG8_MMA(1, 0, At, B0); PG8_BAR; PG8_SCHED;
            PG8_STAGE(PG8_SB(1, 1), b3 + hstepB, voffB);
            PG8_WAIT_V(6); PG8_BAR; PG8_MMA(1, 1, At, B1); PG8_BAR;
            }
        }
        }
        if constexpr (ALIGN_EPI) { if (wr == 0) PG8_BAR; }
        if constexpr (!Epi::AFTER_DRAIN) { int t2 = threadIdx.x; asm volatile("" : "+v"(t2));
            const int wid2 = __builtin_amdgcn_readfirstlane(t2 >> 6), lane2 = t2 & 63; E(acc, cur, wid2 >> 2, wid2 & 3, lane2 & 15, lane2 >> 4); S.done(cur); }
        if (!has_next) break;
#pragma unroll
        for (int a = 0; a < 2; ++a)
#pragma unroll
            for (int b = 0; b < 2; ++b)
#pragma unroll
                for (int m = 0; m < 4; ++m)
#pragma unroll
                    for (int n = 0; n < 2; ++n) acc[a][b][m][n] = (f32x4){0.f, 0.f, 0.f, 0.f};
        cur = nxt; cA = nA; cB = nB; cB2 = nB2; ++ui;
        if constexpr (ALIGN_EPI) { if (wr == 1) PG8_BAR; }
    }
    PG8_WAIT_V(0);
    if constexpr (!ALIGN_EPI) { if (wr == 0) PG8_BAR; }
    PG8_BAR;
    if constexpr (Epi::AFTER_DRAIN) { E.fused(acc, cur, wr, wc, fr, fq, lds, wid, lane); S.done(cur); }
#undef PG8_SA
#undef PG8_SB
#undef PG8_STAGE
#undef PG8_LDA
#undef PG8_LDB
#undef PG8_MMA
#undef PG8_WAIT_V
#undef PG8_WAIT_L
#undef PG8_BAR
#undef PG8_SCHED
#undef PG8_STG_A
#undef PG8_GROWS
#undef PG8_GROWS_P
#undef PG8_UNPACK_NV
}
}
constexpr int BATCH = 32, SEQ = 2048, D = 1024, T = BATCH * SEQ;
constexpr int NPROJ = 2048;
constexpr int CQ = 0, CKV = 256, CPE = 384, CMQ = 416, CMK = 928, CMV = 1440, NPROJ_REAL = 1952;
constexpr int NH = 8;
constexpr float EPS = 1e-6f;
constexpr float LOG2E = 1.4426950408889634f;
constexpr float C2A = 0.10206207261596575f * LOG2E;
constexpr float C2B = 0.125f * LOG2E;
constexpr int NCLS = 112;
constexpr int LIST_CAP = 65536;

constexpr size_t MiB = 1u << 20;
constexpr size_t WS_CTL = 0, CTL_ZERO_BYTES = 2 * MiB;
constexpr size_t WS_KMEAN = 1 * MiB;
constexpr size_t WS_WIN = 2 * MiB;
constexpr size_t WS_WQ = 6 * MiB;
constexpr size_t WS_WKV = 7 * MiB;
constexpr size_t WS_WO = 8 * MiB;
constexpr size_t WS_WGU = 10 * MiB;
constexpr size_t WS_WD = 42 * MiB;
constexpr size_t WS_ROPE = 58 * MiB;
constexpr size_t WS_WRE = 59 * MiB;
constexpr size_t WS_SSQ = 60 * MiB;
constexpr size_t WS_XN = 64 * MiB;
constexpr size_t WS_VB = 192 * MiB;
constexpr size_t WS_Y0 = 64 * MiB;
constexpr size_t WS_X1B = 768 * MiB;
constexpr size_t WS_YH = 256 * MiB;
constexpr size_t WS_QB = 448 * MiB;
constexpr size_t WS_KB = 512 * MiB;
constexpr size_t WS_QA = 584 * MiB;
constexpr size_t WS_VA = 680 * MiB;
constexpr size_t WS_KA = 808 * MiB;
constexpr size_t WS_QLN = 904 * MiB;
constexpr size_t WS_KVLN = 936 * MiB;
constexpr size_t WS_LISTS = 648 * MiB;
constexpr size_t WS_OSSQ = 904 * MiB;
constexpr size_t WS_END = 1024 * MiB;
constexpr size_t WS_H = WS_KB;
constexpr int CW_TMO = 0, CW_CODE = 1;
constexpr int CW_BAR = 4096;
constexpr int CW_GCNT = 16384;

constexpr int RING_BYTES = 131072;
constexpr int P8_XT = 0, P8_XT_WAVE = 32 * 68 * 4, P8_WC = 69632, P8_WRG = 86016, P8_RT = 102400;
constexpr int LDSCTL_OFF = 155648, LDS_BYTES = 159744;
constexpr int TP_OFF = LDSCTL_OFF + 256, CNT_OFF = LDSCTL_OFF + 768, PT_OFF = LDSCTL_OFF + 1280;

#define GAS __attribute__((address_space(1)))
#define LAS __attribute__((address_space(3)))
typedef unsigned short bf16;
typedef unsigned v4u __attribute__((ext_vector_type(4)));
typedef unsigned v2u __attribute__((ext_vector_type(2)));
typedef float f32x4 __attribute__((ext_vector_type(4)));
typedef float f32x2 __attribute__((ext_vector_type(2)));
typedef float f32x16 __attribute__((ext_vector_type(16)));
typedef short bf16x8 __attribute__((ext_vector_type(8)));
typedef short s16x4 __attribute__((ext_vector_type(4)));
typedef GAS unsigned gu32;
#define RLX_AGENT __ATOMIC_RELAXED, __HIP_MEMORY_SCOPE_AGENT
__device__ __forceinline__ unsigned f2bf(float f) { unsigned u = __builtin_bit_cast(unsigned, f); return (u + 0x7fffu + ((u >> 16) & 1u)) >> 16; }
__device__ __forceinline__ unsigned pk2(float lo, float hi) { return f2bf(lo) | (f2bf(hi) << 16); }
__device__ __forceinline__ float bflo(unsigned w) { return __builtin_bit_cast(float, w << 16); }
__device__ __forceinline__ float bfhi(unsigned w) { return __builtin_bit_cast(float, w & 0xffff0000u); }
__device__ __forceinline__ float wave_sum(float v) {
#pragma unroll
    for (int o = 1; o < 64; o <<= 1) v += __shfl_xor(v, o);
    return v;
}
__device__ __forceinline__ float sum8(float v) { v += __shfl_xor(v, 1); v += __shfl_xor(v, 2); v += __shfl_xor(v, 4); return v; }

#define XB_TMO      128
#define XB_XCNT(j)  (256  + 64 * (j))
#define XB_XSUB(j)  (1280 + 64 * (j))
#define XB_XGEN(j)  (2304 + 64 * (j))
#define XB_TOP      3328
#define XB_TOPGEN   3392
#define XCD_BAR_WORDS 3456
#define XB_SPIN_CAP (1u << 18)

__device__ __forceinline__ unsigned xb_ld(unsigned* p)              { return __hip_atomic_load(p, __ATOMIC_RELAXED, __HIP_MEMORY_SCOPE_AGENT); }
__device__ __forceinline__ unsigned xb_add(unsigned* p, unsigned v) { return __hip_atomic_fetch_add(p, v, __ATOMIC_RELAXED, __HIP_MEMORY_SCOPE_AGENT); }
__device__ __forceinline__ unsigned xb_xcc_id() { return (unsigned)__builtin_amdgcn_s_getreg((3 << 11) | 20) & 0xFu; }
#define XB_SPIN(cond, bar) do { unsigned _sp = 0; while (cond) { __builtin_amdgcn_s_sleep(1); \
    if ((++_sp & 255u) == 0u) { if (xb_ld(&(bar)[XB_TMO])) break; if (_sp > XB_SPIN_CAP) { atomicAdd(&(bar)[XB_TMO], 1u); break; } } } } while (0)

struct XcdBarrier {
    unsigned* bar; unsigned x;
    volatile LAS unsigned* st;
};

__device__ __forceinline__ XcdBarrier xcd_barrier_post(unsigned* bar, volatile LAS unsigned* st) {
    XcdBarrier b; b.bar = bar; b.x = xb_xcc_id(); b.st = st;
    if (threadIdx.x == 0) (void)xb_add(&bar[XB_XCNT(b.x)], 1u);
    return b;
}
__device__ __forceinline__ void xcd_barrier_complete(unsigned* bar, unsigned x, unsigned& nloc, unsigned& nx) {
    const unsigned G = gridDim.x * gridDim.y * gridDim.z;
    unsigned sum, cnt, mine, sp = 0u;
    for (;;) {
        sum = 0u; cnt = 0u; mine = 0u;
#pragma unroll
        for (unsigned j = 0; j < 16; ++j) { const unsigned c = xb_ld(&bar[XB_XCNT(j)]); sum += c; cnt += (c > 0u) ? 1u : 0u; mine = (j == x) ? c : mine; }
        if (sum == G) break;
        __builtin_amdgcn_s_sleep(1);
        if ((++sp & 255u) == 0u) { if (xb_ld(&bar[XB_TMO])) break; if (sp > XB_SPIN_CAP) { atomicAdd(&bar[XB_TMO], 1u); break; } }
    }
    nloc = mine > 0u ? mine : 1u; nx = cnt > 0u ? cnt : 1u;
}

__device__ __forceinline__ void xcd_barrier(const XcdBarrier& b) {
    asm volatile("s_waitcnt vmcnt(0)" ::: "memory");
    __syncthreads();
    if (threadIdx.x == 0) {
        unsigned* bar = b.bar;
        __builtin_amdgcn_s_waitcnt(0);
        unsigned nloc = b.st[0], nx = b.st[1];
        if (nloc == 0u) { xcd_barrier_complete(bar, b.x, nloc, nx); b.st[0] = nloc; b.st[1] = nx; }
        const unsigned old = xb_add(&bar[XB_XSUB(b.x)], 1u);
        const unsigned gen = old / nloc;
        if (old + 1u == (gen + 1u) * nloc) {
            __builtin_amdgcn_fence(__ATOMIC_RELEASE, "agent");
            asm volatile("s_waitcnt vmcnt(0)" ::: "memory");
            const unsigned og = xb_add(&bar[XB_TOP], 1u);
            const unsigned tg = og / nx;
            if (og + 1u == (tg + 1u) * nx) xb_add(&bar[XB_TOPGEN], 1u);
            else XB_SPIN(xb_ld(&bar[XB_TOPGEN]) == tg, bar);
            __builtin_amdgcn_fence(__ATOMIC_ACQUIRE, "agent");
            xb_add(&bar[XB_XGEN(b.x)], 1u);
            asm volatile("s_waitcnt vmcnt(0)" ::: "memory");
        } else {
            XB_SPIN(xb_ld(&bar[XB_XGEN(b.x)]) == gen, bar);
            __builtin_amdgcn_fence(__ATOMIC_ACQUIRE, "agent");
            asm volatile("s_waitcnt vmcnt(0)" ::: "memory");
        }
    }
    __syncthreads();
}


__device__ __forceinline__ float att_max3(float a, float b, float c) { float r; asm("v_max3_f32 %0, %1, %2, %3" : "=v"(r) : "v"(a), "v"(b), "v"(c)); return r; }
__device__ __forceinline__ unsigned pk4_fp8(float a, float b, float c, float d) { int w = 0; w = __builtin_amdgcn_cvt_pk_fp8_f32(a, b, w, false); w = __builtin_amdgcn_cvt_pk_fp8_f32(c, d, w, true); return (unsigned)w; }
struct AttOwn { static constexpr bool v = true; }; struct AttPast { static constexpr bool v = false; };
template <int DQK, bool MOBA, bool QFIN>
__device__ __forceinline__ void attn_unit(LAS unsigned char* lds, const float* qgain_, const float* ropeR_, const bf16* Qg_, int qpitch, const bf16* Kg_, int kpitch, const bf16* Vg_, int vpitch, bf16* Og_, int opitch, float* ossq_, int qb, const float* kmp_, int kmstride) {
    const GAS bf16* Qg = (const GAS bf16*)Qg_; const GAS bf16* Kg = (const GAS bf16*)Kg_; const GAS bf16* Vg = (const GAS bf16*)Vg_; GAS bf16* Og = (GAS bf16*)Og_; const GAS float* kmp = (const GAS float*)kmp_;
    constexpr int ND = DQK / 16, KSTR = DQK * 2 + 16, KBUF = 64 * KSTR, NCH = DQK / 8, VBUF = 8192;
    int tid = threadIdx.x; asm volatile("" : "+v"(tid));
    const int lane = tid & 63, r32 = lane & 31, hi = lane >> 5; const int wid = __builtin_amdgcn_readfirstlane(tid >> 6);
    LAS unsigned char* Kl = lds; LAS unsigned char* Vl = lds + 2 * KBUF;
    const GAS bf16* qrow = Qg + (size_t)(qb * 256 + wid * 32 + r32) * qpitch;
    bf16x8 qf[ND];
#pragma unroll
    for (int d0 = 0; d0 < ND; ++d0) qf[d0] = *(const GAS bf16x8*)(qrow + 16 * d0 + 8 * hi);
    if (QFIN) {
        const GAS float* qg = (const GAS float*)qgain_; const GAS float* rr = (const GAS float*)ropeR_; const int pos = qb * 256 + wid * 32 + r32;
        float x[ND][8]; float ss = 0.f;
#pragma unroll
        for (int d0 = 0; d0 < ND; ++d0) { const v4u w = __builtin_bit_cast(v4u, qf[d0]);
            x[d0][0] = bflo(w.x); x[d0][1] = bfhi(w.x); x[d0][2] = bflo(w.y); x[d0][3] = bfhi(w.y); x[d0][4] = bflo(w.z); x[d0][5] = bfhi(w.z); x[d0][6] = bflo(w.w); x[d0][7] = bfhi(w.w);
#pragma unroll
            for (int j = 0; j < 8; ++j) ss += x[d0][j] * x[d0][j]; }
        ss += __shfl_xor(ss, 32);
        const float rs = (1.0f / sqrtf(ss * (1.0f / (float)DQK) + EPS)) * C2A;
#pragma unroll
        for (int d0 = 0; d0 < ND; ++d0) { const f32x4 ga = *(const GAS f32x4*)(qg + 16 * d0 + 8 * hi), gb = *(const GAS f32x4*)(qg + 16 * d0 + 8 * hi + 4);
#pragma unroll
            for (int j = 0; j < 4; ++j) { x[d0][j] *= rs * ga[j]; x[d0][4 + j] *= rs * gb[j]; } }
        if (ND == 6) { const f32x4 ca = *(const GAS f32x4*)(rr + pos * 16 + 8 * hi), cb = *(const GAS f32x4*)(rr + pos * 16 + 8 * hi + 4), sa = *(const GAS f32x4*)(rr + SEQ * 16 + pos * 16 + 8 * hi), sb = *(const GAS f32x4*)(rr + SEQ * 16 + pos * 16 + 8 * hi + 4);
#pragma unroll
            for (int j = 0; j < 8; ++j) { const float c = j < 4 ? ca[j & 3] : cb[j & 3], s = j < 4 ? sa[j & 3] : sb[j & 3]; const float y1 = x[ND - 2][j], y2 = x[ND - 1][j]; x[ND - 2][j] = y1 * c - y2 * s; x[ND - 1][j] = y2 * c + y1 * s; } }
#pragma unroll
        for (int d0 = 0; d0 < ND; ++d0) { v4u w; w.x = pg8::cvt_pk_bf16(x[d0][0], x[d0][1]); w.y = pg8::cvt_pk_bf16(x[d0][2], x[d0][3]); w.z = pg8::cvt_pk_bf16(x[d0][4], x[d0][5]); w.w = pg8::cvt_pk_bf16(x[d0][6], x[d0][7]); qf[d0] = __builtin_bit_cast(bf16x8, w); }
    }
    unsigned sel = 0xffu;
    if (MOBA && qb > 3) {
        float gate[8];
#pragma unroll
        for (int n = 0; n < 8; ++n) { float a = 0.f;
            if (n < qb) {
#pragma unroll
                for (int d0 = 0; d0 < ND; ++d0) { const GAS float* km = kmp + (size_t)n * kmstride + 16 * d0 + 8 * hi; const f32x4 k0 = *(const GAS f32x4*)km, k1 = *(const GAS f32x4*)(km + 4);
                    const v4u qq = __builtin_bit_cast(v4u, qf[d0]);
                    a += bflo(qq.x) * k0[0] + bfhi(qq.x) * k0[1] + bflo(qq.y) * k0[2] + bfhi(qq.y) * k0[3] + bflo(qq.z) * k1[0] + bfhi(qq.z) * k1[1] + bflo(qq.w) * k1[2] + bfhi(qq.w) * k1[3]; }
                a += __shfl_xor(a, 32); }
            gate[n] = a; asm volatile("" : "+v"(a) :: "memory"); }
        sel = 0u;
#pragma unroll
        for (int n = 0; n < 8; ++n) { int rank = 0;
#pragma unroll
            for (int mm = 0; mm < 8; ++mm) { if (mm != n) { const bool before = (gate[mm] > gate[n]) || (gate[mm] == gate[n] && mm < n); rank += (mm < qb && before) ? 1 : 0; } }
            if (n < qb && rank < 3) sel |= (1u << n); }
    }
    const int krow = (DQK == 64) ? (tid >> 3) : (tid / 12), kch = (DQK == 64) ? (tid & 7) : (tid % 12);
    const int krow2 = (tid + 512) / 12, kch2 = (tid + 512) % 12; const bool k2 = (DQK == 96) && (tid < 256);
    const int vrow = tid >> 3, vch = tid & 7;
    const unsigned kst = (unsigned)(krow * KSTR + kch * 16), kst2 = (unsigned)(krow2 * KSTR + kch2 * 16);
    const unsigned vst = (unsigned)((vch >> 2) * 4096 + (vrow >> 4) * 1024 + ((vrow >> 3) & 1) * 512 + (vrow & 7) * 64 + (vch & 3) * 16);
    const int NT = 4 * (qb + 1);
    auto tile_row0 = [&](int p) -> int { return (p < 4) ? (qb * 256 + p * 64) : ((p - 4) * 64); };
    v4u kreg, kreg2 = {0u, 0u, 0u, 0u}, vreg;
    { const int r0 = tile_row0(0);
      kreg = *(const GAS v4u*)(Kg + (size_t)(r0 + krow) * kpitch + kch * 8); if (k2) kreg2 = *(const GAS v4u*)(Kg + (size_t)(r0 + krow2) * kpitch + kch2 * 8);
      vreg = *(const GAS v4u*)(Vg + (size_t)(r0 + vrow) * vpitch + vch * 8);
      *(LAS v4u*)(Kl + kst) = kreg; if (k2) *(LAS v4u*)(Kl + kst2) = kreg2; *(LAS v4u*)(Vl + vst) = vreg; }
    __syncthreads();
    float m_run = 0.f, l_run = 0.f; f32x16 o0 = {}, o1 = {};
    f32x16 cuse = {}; bool cdirty = true;
    f32x16 negm = {};
    constexpr float THR = 8.0f;
    const int qrel = wid * 32 + r32;
    const unsigned kfo = (unsigned)(r32 * KSTR + hi * 16);
    const unsigned vfo = (unsigned)(((lane >> 4) & 1) * 32 + (lane & 3) * 8 + (4 * hi + ((lane & 15) >> 2)) * 64);
    auto slot = [&](const int p, auto own_) { constexpr bool OWN = decltype(own_)::v;
        const int cb = p & 1;
        if (p + 1 < NT) { const int r0 = tile_row0(p + 1);
            kreg = *(const GAS v4u*)(Kg + (size_t)(r0 + krow) * kpitch + kch * 8); if (k2) kreg2 = *(const GAS v4u*)(Kg + (size_t)(r0 + krow2) * kpitch + kch2 * 8);
            vreg = *(const GAS v4u*)(Vg + (size_t)(r0 + vrow) * vpitch + vch * 8); }
        const bool need = OWN ? !(p > (wid >> 1)) : true;
        if (need) {
            const LAS unsigned char* Kb = Kl + cb * KBUF + kfo; const LAS unsigned char* Vb = Vl + cb * VBUF + vfo;
            f32x16 s0 = negm, s1 = negm;
            if constexpr (!OWN && MOBA) {
                if (cdirty || (p & 3) == 0) { const bool on = ((sel >> ((p - 4) >> 2)) & 1u) != 0u;
#pragma unroll
                    for (int r = 0; r < 16; ++r) cuse[r] = on ? negm[r] : -1.0e30f;
                    cdirty = false; }
                s0 = cuse; s1 = cuse; }
            bf16x8 kf[2 * ND];
#pragma unroll
            for (int d0 = 0; d0 < ND; ++d0) { kf[2 * d0] = *(const LAS bf16x8*)(Kb + d0 * 32); kf[2 * d0 + 1] = *(const LAS bf16x8*)(Kb + 32 * KSTR + d0 * 32); }
            __builtin_amdgcn_sched_barrier(0);
#pragma unroll
            for (int d0 = 0; d0 < ND; ++d0) { s0 = __builtin_amdgcn_mfma_f32_32x32x16_bf16(kf[2 * d0], qf[d0], s0, 0, 0, 0); s1 = __builtin_amdgcn_mfma_f32_32x32x16_bf16(kf[2 * d0 + 1], qf[d0], s1, 0, 0, 0); }
            s16x4 vt[16];
#pragma unroll
            for (int v = 0; v < 16; ++v) vt[v] = __builtin_bit_cast(s16x4, __builtin_amdgcn_ds_read_tr16_b64_v4i16((LAS s16x4*)(Vb + (v >> 2) * 1024 + ((v >> 1) & 1) * 4096 + (v & 1) * 512)));
            __builtin_amdgcn_sched_barrier(0);
            if constexpr (OWN) { const int kb = 64 * p + 4 * hi;
#pragma unroll
                for (int r = 0; r < 16; ++r) { const int kv = kb + (r & 3) + 8 * (r >> 2); if (kv > qrel) s0[r] = -INFINITY; if (kv + 32 > qrel) s1[r] = -INFINITY; } }
            float ra = att_max3(s0[0], s0[1], s1[0]), rb = att_max3(s0[2], s0[3], s1[1]); ra = att_max3(ra, s1[2], s1[3]);
#pragma unroll
            for (int r = 4; r < 16; r += 4) { ra = att_max3(ra, s0[r], s0[r + 1]); rb = att_max3(rb, s0[r + 2], s0[r + 3]); ra = att_max3(ra, s1[r], s1[r + 1]); rb = att_max3(rb, s1[r + 2], s1[r + 3]); }
            float rm = fmaxf(ra, rb); rm = fmaxf(rm, __shfl_xor(rm, 32));
            if ((OWN && p == 0) || __any(rm > THR)) {
                const float dl = (OWN && p == 0) ? rm : fmaxf(rm, 0.f); m_run += dl;
                const float fsc = __builtin_amdgcn_exp2f(-dl); l_run *= fsc;
#pragma unroll
                for (int r = 0; r < 16; ++r) { s0[r] -= dl; s1[r] -= dl; o0[r] *= fsc; o1[r] *= fsc; negm[r] = -m_run; }
                cdirty = true;
            }
            float rs0 = 0.f, rs1 = 0.f;
#pragma unroll
            for (int r = 0; r < 16; ++r) { s0[r] = __builtin_amdgcn_exp2f(s0[r]); s1[r] = __builtin_amdgcn_exp2f(s1[r]); rs0 += s0[r]; rs1 += s1[r]; }
            l_run += rs0 + rs1;
            bf16x8 pf[4];
#pragma unroll
            for (int s = 0; s < 2; ++s) { v4u a, b;
                a.x = pg8::cvt_pk_bf16(s0[8 * s + 0], s0[8 * s + 1]); a.y = pg8::cvt_pk_bf16(s0[8 * s + 2], s0[8 * s + 3]); a.z = pg8::cvt_pk_bf16(s0[8 * s + 4], s0[8 * s + 5]); a.w = pg8::cvt_pk_bf16(s0[8 * s + 6], s0[8 * s + 7]);
                b.x = pg8::cvt_pk_bf16(s1[8 * s + 0], s1[8 * s + 1]); b.y = pg8::cvt_pk_bf16(s1[8 * s + 2], s1[8 * s + 3]); b.z = pg8::cvt_pk_bf16(s1[8 * s + 4], s1[8 * s + 5]); b.w = pg8::cvt_pk_bf16(s1[8 * s + 6], s1[8 * s + 7]);
                pf[s] = __builtin_bit_cast(bf16x8, a); pf[2 + s] = __builtin_bit_cast(bf16x8, b); }
#pragma unroll
            for (int s = 0; s < 4; ++s) {
                const bf16x8 va = (bf16x8){vt[4 * s][0], vt[4 * s][1], vt[4 * s][2], vt[4 * s][3], vt[4 * s + 1][0], vt[4 * s + 1][1], vt[4 * s + 1][2], vt[4 * s + 1][3]};
                const bf16x8 vb = (bf16x8){vt[4 * s + 2][0], vt[4 * s + 2][1], vt[4 * s + 2][2], vt[4 * s + 2][3], vt[4 * s + 3][0], vt[4 * s + 3][1], vt[4 * s + 3][2], vt[4 * s + 3][3]};
                o0 = __builtin_amdgcn_mfma_f32_32x32x16_bf16(va, pf[s], o0, 0, 0, 0);
                o1 = __builtin_amdgcn_mfma_f32_32x32x16_bf16(vb, pf[s], o1, 0, 0, 0); }
        }
        if (p + 1 < NT) { const int nb = cb ^ 1;
            *(LAS v4u*)(Kl + nb * KBUF + kst) = kreg; if (k2) *(LAS v4u*)(Kl + nb * KBUF + kst2) = kreg2; *(LAS v4u*)(Vl + nb * VBUF + vst) = vreg; }
        __syncthreads();
        __syncthreads();
    };
    for (int p = 0; p < 4; ++p) slot(p, AttOwn{});
    for (int p = 4; p < NT; ++p) slot(p, AttPast{});
    l_run += __shfl_xor(l_run, 32);
    const float rl = 1.0f / l_run;
    { float ss = 0.f;
#pragma unroll
      for (int r = 0; r < 16; ++r) { const float a = o0[r] * rl, b = o1[r] * rl; ss += a * a + b * b; }
      ss += __shfl_xor(ss, 32);
      if (hi == 0) ((GAS float*)ossq_)[(size_t)(qb * 256 + wid * 32 + r32) * 16] = ss; }
    LAS unsigned char* stg = lds + 65536 + wid * 4608; const float rl16 = rl * 16.0f;
#pragma unroll
    for (int g = 0; g < 4; ++g) {
        *(LAS unsigned*)(stg + r32 * 80 + (8 * g + 4 * hi)) = pk4_fp8(o0[4 * g] * rl16, o0[4 * g + 1] * rl16, o0[4 * g + 2] * rl16, o0[4 * g + 3] * rl16);
        *(LAS unsigned*)(stg + r32 * 80 + (32 + 8 * g + 4 * hi)) = pk4_fp8(o1[4 * g] * rl16, o1[4 * g + 1] * rl16, o1[4 * g + 2] * rl16, o1[4 * g + 3] * rl16); }
    asm volatile("s_waitcnt lgkmcnt(0)" ::: "memory");
    GAS unsigned char* obase = (GAS unsigned char*)Og + (size_t)(qb * 256 + wid * 32) * opitch;
#pragma unroll
    for (int i = 0; i < 2; ++i) { const int row = i * 16 + (lane >> 2), ch = lane & 3; const v4u v = *(const LAS v4u*)(stg + row * 80 + ch * 16); *(GAS v4u*)(obase + (size_t)row * opitch + ch * 16) = v; }
    asm volatile("s_waitcnt lgkmcnt(0)" ::: "memory");
}

__device__ __forceinline__ void transpose_item(const float* W_, int ldw, bf16* WT, int ldt, int k0, int n0, int dr0, int dr1, LAS float* scr, int lane, const float* kgain = nullptr) {
    const GAS float* W = (const GAS float*)W_; const int q = lane & 15, kr = lane >> 4; const bool ld_ok = (q < 8) ? (dr0 >= 0) : (dr1 >= 0);
#pragma unroll 4
    for (int i = 0; i < 16; ++i) { const int kk = 4 * i + kr; f32x4 v = {0.f, 0.f, 0.f, 0.f}; if (ld_ok) v = *(const GAS f32x4*)(W + (size_t)(k0 + kk) * ldw + n0 + 4 * q);
        if (kgain) v = v * ((const GAS float*)kgain)[k0 + kk];
        LAS float* s = scr + kk * 65 + 4 * q; s[0] = v[0]; s[1] = v[1]; s[2] = v[2]; s[3] = v[3]; }
    asm volatile("s_waitcnt lgkmcnt(0)" ::: "memory");
    const int c = lane & 7;
#pragma unroll
    for (int j = 0; j < 8; ++j) { const int n = 8 * j + (lane >> 3); const LAS float* s = scr + (8 * c) * 65 + n; const int dr = (n < 32) ? dr0 : dr1;
        v4u o; o.x = pk2(s[0 * 65], s[1 * 65]); o.y = pk2(s[2 * 65], s[3 * 65]); o.z = pk2(s[4 * 65], s[5 * 65]); o.w = pk2(s[6 * 65], s[7 * 65]);
        if (dr >= 0) *(GAS v4u*)(WT + (size_t)(dr + (n & 31)) * ldt + k0 + 8 * c) = o; }
    asm volatile("s_waitcnt lgkmcnt(0)" ::: "memory");
}

__device__ __forceinline__ void transpose_item8(const float* W_, int ldw, unsigned char* WT8, int ldt, int k0, int n0, int dr0, int dr1, LAS float* scr, int lane, float scale, const float* kgain = nullptr) {
    const GAS float* W = (const GAS float*)W_; const int q = lane & 15, kr = lane >> 4; const bool ld_ok = (q < 8) ? (dr0 >= 0) : (dr1 >= 0);
#pragma unroll 4
    for (int i = 0; i < 16; ++i) { const int kk = 4 * i + kr; f32x4 v = {0.f, 0.f, 0.f, 0.f}; if (ld_ok) v = *(const GAS f32x4*)(W + (size_t)(k0 + kk) * ldw + n0 + 4 * q);
        if (kgain) v = v * ((const GAS float*)kgain)[k0 + kk];
        v = v * scale;
        LAS float* s = scr + kk * 65 + 4 * q; s[0] = v[0]; s[1] = v[1]; s[2] = v[2]; s[3] = v[3]; }
    asm volatile("s_waitcnt lgkmcnt(0)" ::: "memory");
    const int c = lane & 7;
#pragma unroll
    for (int j = 0; j < 8; ++j) { const int n = 8 * j + (lane >> 3); const LAS float* s = scr + (8 * c) * 65 + n; const int dr = (n < 32) ? dr0 : dr1;
        v2u o; o.x = pk4_fp8(s[0 * 65], s[1 * 65], s[2 * 65], s[3 * 65]); o.y = pk4_fp8(s[4 * 65], s[5 * 65], s[6 * 65], s[7 * 65]);
        if (dr >= 0) *(GAS v2u*)((GAS unsigned char*)WT8 + (size_t)(dr + (n & 31)) * ldt + k0 + 8 * c) = o; }
    asm volatile("s_waitcnt lgkmcnt(0)" ::: "memory");
}

struct Args {
    const float* x; const float* attn_g; const float* w_in; const float* qlat_g; const float* w_qup; const float* kvlat_g; const float* w_kvup;
    const float* qhead_g; const float* khead_g; const float* mqhead_g; const float* mkhead_g; const float* onorm_a_g; const float* onorm_b_g; const float* w_out;
    const float* ffn_g; const float* w_rg; const float* b_rg; const float* w_re; const float* b_re; const float* w_gate; const float* w_up; const float* w_down;
    float* out; unsigned char* ws; int ph_lo, ph_hi;
};
enum { PH_PRO = 0, PH_PROJ, PH_UP, PH_ATTN, PH_OUT, PH_ROUTE, PH_GU, PH_D0, NPHASE };

__global__ void __launch_bounds__(512, 2) mk_fwd(Args A) {
    extern __shared__ __attribute__((aligned(16))) unsigned char lds_raw[];
    LAS unsigned char* lds = (LAS unsigned char*)lds_raw;
    const int tid0 = threadIdx.x;
    const int G = gridDim.x, bx = blockIdx.x;
#define NGW (G * 8)
#define PH_BEGIN int tid = threadIdx.x; asm volatile("" : "+v"(tid)); const int lane = tid & 63; const int wave = __builtin_amdgcn_readfirstlane(tid >> 6); const int gw = bx * 8 + wave; \
    const __attribute__((address_space(4))) Args* AP = (const __attribute__((address_space(4))) Args*)__builtin_amdgcn_kernarg_segment_ptr(); asm volatile("" : "+s"(AP)); \
    unsigned char* ws = AP->ws; (void)lane; (void)gw; (void)ws;
#define Win_t ((bf16*)(ws + WS_WIN))
#define Wq_t ((bf16*)(ws + WS_WQ))
#define Wkv_t ((bf16*)(ws + WS_WKV))
#define Wo_t ((bf16*)(ws + WS_WO))
#define Wgu_t ((bf16*)(ws + WS_WGU))
#define Wd_t ((bf16*)(ws + WS_WD))
#define ropeF ((float*)(ws + WS_ROPE))
#define ropeR (((float*)(ws + WS_ROPE)) + 2 * SEQ * 32)
#define kmean ((float*)(ws + WS_KMEAN))
#define XN ((bf16*)(ws + WS_XN))
#define X1B ((bf16*)(ws + WS_X1B))
#define VB ((bf16*)(ws + WS_VB))
#define YH ((bf16*)(ws + WS_YH))
#define Y0B ((bf16*)(ws + WS_Y0))
#define SSQ ((float*)(ws + WS_SSQ))
#define WREF ((float*)(ws + WS_WRE))
#define WRGF ((float*)(ws + WS_WRE + 131072))
#define OSSQ ((float*)(ws + WS_OSSQ))
#define QB ((bf16*)(ws + WS_QB))
#define KB ((bf16*)(ws + WS_KB))
#define QA ((bf16*)(ws + WS_QA))
#define VA ((bf16*)(ws + WS_VA))
#define KA ((bf16*)(ws + WS_KA))
#define QLN ((bf16*)(ws + WS_QLN))
#define KVLN ((bf16*)(ws + WS_KVLN))
#define HB ((bf16*)(ws + WS_H))
#define lists ((pg8::ListEnt*)(ws + WS_LISTS))
    volatile LAS unsigned* MISC = (volatile LAS unsigned*)(lds + LDSCTL_OFF);
    for (int u = tid0; u < (LDS_BYTES - LDSCTL_OFF) / 4; u += 512) ((LAS unsigned*)(lds + LDSCTL_OFF))[u] = 0u;
    __syncthreads();
    XcdBarrier bar = xcd_barrier_post((unsigned*)((gu32*)(A.ws + WS_CTL) + CW_BAR), MISC + 8);
    const int lo = A.ph_lo, hi = A.ph_hi;
#define IN(k) (lo <= (k) && (k) < hi)
#define MOE_SLOT(npn) ((G == 256) ? ((((bx >> 3) / (npn)) * 8 + (bx & 7)) * (npn) + ((bx >> 3) % (npn))) : bx)
#define SEAM(k) do { if (IN(k) && IN((k) + 1)) xcd_barrier(bar); } while (0)

    if (IN(PH_PRO)) { PH_BEGIN
        LAS float* scr = (LAS float*)(lds + wave * 16640);
        constexpr int I_IN = 16 * 31, I_QU = 4 * 12, I_KV = 2 * 16, I_WO = 16 * 16, I_G = 32 * 64, I_U = 32 * 64, I_D = 32 * 64;
        constexpr int NITEMS = I_IN + I_QU + I_KV + I_WO + I_G + I_U + I_D;
        for (int it = gw; it < NITEMS; it += NGW) {
            int r = it;
            if (r < I_IN) { const int kb = r / 31, nb = r % 31; int dr[2];
#pragma unroll
                for (int h2 = 0; h2 < 2; ++h2) { const int gi = 2 * nb + h2;
                    if (gi < 13) dr[h2] = 32 * gi; else if (gi < 45) { const int q = (gi - 13) & 15, hh = q >> 1, bj = q & 1; dr[h2] = (gi < 29 ? 512 : 1024) + (hh >> 2) * 256 + bj * 128 + (hh & 3) * 32; } else if (gi < 61) dr[h2] = 1536 + (gi - 45) * 32; else dr[h2] = -1; }
                transpose_item(AP->w_in, NPROJ_REAL, Win_t, 1024, 64 * kb, 64 * nb, dr[0], dr[1], scr, lane); continue; } r -= I_IN;
            if (r < I_QU) { const int kb = r / 12, nb = r % 12; transpose_item(AP->w_qup, 768, Wq_t, 256, 64 * kb, 64 * nb, 64 * nb, 64 * nb + 32, scr, lane, AP->qlat_g); continue; } r -= I_QU;
            if (r < I_KV) { const int kb = r / 16, nb = r % 16; const int n0 = 64 * nb, hh = n0 >> 7, j0 = n0 & 127;
                const int d0 = (j0 < 64) ? ((hh >> 2) * 256 + (hh & 3) * 32) : (512 + hh * 64), d1 = (j0 < 64) ? (d0 + 128) : (d0 + 32);
                transpose_item(AP->w_kvup, 1024, Wkv_t, 256, 64 * kb, n0, d0, d1, scr, lane, AP->kvlat_g); continue; } r -= I_KV;
            if (r < I_WO) { const int kb = r / 16, nb = r % 16; transpose_item8(AP->w_out, 1024, (unsigned char*)Wo_t, 1024, 64 * kb, 64 * nb, 64 * nb, 64 * nb + 32, scr, lane, 32.0f, kb < 8 ? AP->onorm_a_g : AP->onorm_b_g - 512); continue; } r -= I_WO;
            if (r < I_G) { const int e = r >> 6, r2 = r & 63, kb = r2 >> 2, nb = r2 & 3; const int n0 = 64 * nb; const int d0 = (n0 >> 7) * 256 + (n0 & 127);
                transpose_item8(AP->w_gate + (size_t)e * 1024 * 256, 256, (unsigned char*)Wgu_t + (size_t)e * 512 * 1024, 1024, 64 * kb, n0, d0, d0 + 32, scr, lane, 32.0f); continue; } r -= I_G;
            if (r < I_U) { const int e = r >> 6, r2 = r & 63, kb = r2 >> 2, nb = r2 & 3; const int n0 = 64 * nb; const int d0 = (n0 >> 7) * 256 + 128 + (n0 & 127);
                transpose_item8(AP->w_up + (size_t)e * 1024 * 256, 256, (unsigned char*)Wgu_t + (size_t)e * 512 * 1024, 1024, 64 * kb, n0, d0, d0 + 32, scr, lane, 32.0f); continue; } r -= I_U;
            { const int e = r >> 6, r2 = r & 63, kb = r2 >> 4, nb = r2 & 15;
                transpose_item8(AP->w_down + (size_t)e * 256 * 1024, 1024, (unsigned char*)Wd_t + (size_t)e * 1024 * 256, 256, 64 * kb, 64 * nb, 64 * nb, 64 * nb + 32, scr, lane, 16.0f); }
        }
        const int gt = bx * 512 + tid, NGT = G * 512;
        for (int i = gt; i < 96 * 128; i += NGT) *(GAS v4u*)(Win_t + (size_t)416 * 1024 + (size_t)i * 8) = (v4u){0u, 0u, 0u, 0u};
        for (int i = gt; i < 1024 * 16; i += NGT) *(GAS v4u*)(Wkv_t + (size_t)(i >> 4) * 256 + 128 + (i & 15) * 8) = (v4u){0u, 0u, 0u, 0u};
        for (int i = gt; i < SEQ * 48; i += NGT) {
            const int pos = i / 48, f = i % 48; const bool isF = f < 32; const int ff = isF ? f : f - 32;
            const double e = isF ? (double)ff / 32.0 : (double)ff / 16.0;
            const float invf = (float)exp2(-e * 13.287712379549449);
            const float ang = (float)pos * invf;
            const double a = (double)ang; const double kk = rint(a * 0.15915494309189535); const double rr = a - kk * 6.283185307179586;
            const float c = (float)cos(rr), s = (float)sin(rr);
            GAS float* rF = (GAS float*)ropeF; GAS float* rR = (GAS float*)ropeR;
            if (isF) { rF[pos * 32 + ff] = c; rF[SEQ * 32 + pos * 32 + ff] = s; } else { rR[pos * 16 + ff] = c; rR[SEQ * 16 + pos * 16 + ff] = s; }
        }
        for (int i = gt; i < 1024 * 8; i += NGT) { const float gk = AP->ffn_g[i >> 3]; *((GAS f32x4*)WREF + i) = *((const GAS f32x4*)AP->w_re + i) * gk; }
        for (int i = gt; i < 1024; i += NGT) { const float gk = AP->ffn_g[i]; *((GAS f32x4*)WRGF + i) = *((const GAS f32x4*)AP->w_rg + i) * gk; }
        for (int t = gw; t < T; t += 2 * NGW) {
            const int t2 = (t + NGW < T) ? t + NGW : t;
            const GAS f32x4* xr = (const GAS f32x4*)(AP->x + (size_t)t * D) + lane; const GAS f32x4* xr2 = (const GAS f32x4*)(AP->x + (size_t)t2 * D) + lane; f32x4 v[4], w[4]; float s = 0.f, s2 = 0.f;
#pragma unroll
            for (int j = 0; j < 4; ++j) { v[j] = xr[64 * j]; w[j] = xr2[64 * j]; }
#pragma unroll
            for (int j = 0; j < 4; ++j) { s += (v[j].x * v[j].x + v[j].y * v[j].y) + (v[j].z * v[j].z + v[j].w * v[j].w); s2 += (w[j].x * w[j].x + w[j].y * w[j].y) + (w[j].z * w[j].z + w[j].w * w[j].w); }
            const float rstd = 1.0f / sqrtf(wave_sum(s) * (1.f / D) + EPS), rstd2 = 1.0f / sqrtf(wave_sum(s2) * (1.f / D) + EPS);
            GAS unsigned long long* o8 = (GAS unsigned long long*)(XN + (size_t)t * D) + lane; GAS unsigned long long* o82 = (GAS unsigned long long*)(XN + (size_t)t2 * D) + lane;
#pragma unroll
            for (int j = 0; j < 4; ++j) { const f32x4 g = *((const GAS f32x4*)AP->attn_g + lane + 64 * j);
                o8[64 * j] = (unsigned long long)pk2(v[j].x * rstd * g.x, v[j].y * rstd * g.y) | ((unsigned long long)pk2(v[j].z * rstd * g.z, v[j].w * rstd * g.w) << 32);
                o82[64 * j] = (unsigned long long)pk2(w[j].x * rstd2 * g.x, w[j].y * rstd2 * g.y) | ((unsigned long long)pk2(w[j].z * rstd2 * g.z, w[j].w * rstd2 * g.w) << 32); }
        }
    }
    SEAM(PH_PRO);

    if (IN(PH_PROJ)) { PH_BEGIN
        pg8::Gemm g{XN, Win_t, T, NPROJ, D}; pg8::StaticOrder S; S.init(T, NPROJ, G, bx);
        pg8::EpiProj E{ws, WS_QLN, WS_KVLN, WS_QB, WS_KB, WS_VB, WS_SSQ, WS_KMEAN, WS_ROPE, AP->mqhead_g, AP->mkhead_g, C2B, EPS, SEQ};
        pg8::gemm_phase<pg8::EpiProj, pg8::StaticOrder, true, true>(lds, g, S, E);
    }
    SEAM(PH_PROJ);

    if (IN(PH_UP)) { PH_BEGIN
        { int K256 = 256; asm volatile("" : "+s"(K256)); pg8::Gemm g{QLN, Wq_t, T, 768, K256}; pg8::StaticOrder S; S.init(T, 768, G, bx); pg8::EpiBf16Rs E{QA, 768, SSQ, 0, 1.0f / 256.0f, EPS};
          pg8::gemm_phase<pg8::EpiBf16Rs, pg8::StaticOrder, true, true>(lds, g, S, E); }
        { int K256 = 256; asm volatile("" : "+s"(K256)); pg8::Gemm g{KVLN, Wkv_t, T, 1024, K256}; pg8::StaticOrder S; S.init(T, 1024, G, bx); pg8::EpiKv E{KA, VA, KVLN, SSQ, ropeR, AP->khead_g, EPS, SEQ};
          pg8::gemm_phase<pg8::EpiKv, pg8::StaticOrder, true, true>(lds, g, S, E); }
    }
    SEAM(PH_UP);

    if (IN(PH_ATTN)) { PH_BEGIN
        bf16* O = XN;
        for (int u = bx; u < 512; u += G) {
            const int bh = u & 255, b = bh >> 3, h = bh & 7; const size_t r0 = (size_t)b * SEQ;
            if (u < 256) {
                for (int qb = 7; qb >= 0; --qb)
                    attn_unit<96, false, true>(lds, AP->qhead_g, ropeR, QA + r0 * 768 + h * 96, 768, KA + r0 * 768 + h * 96, 768, VA + r0 * 512 + h * 64, 512, (bf16*)((unsigned char*)O + r0 * 1024 + h * 64), 1024, OSSQ + r0 * 16 + h, qb, nullptr, 0);
            } else {
                for (int qb = 7; qb >= 0; --qb)
                    attn_unit<64, true, false>(lds, nullptr, nullptr, QB + r0 * 512 + h * 64, 512, KB + r0 * 512 + h * 64, 512, VB + r0 * 512 + h * 64, 512, (bf16*)((unsigned char*)O + r0 * 1024 + 512 + h * 64), 1024, OSSQ + r0 * 16 + 8 + h, qb, kmean + ((size_t)b * 8 * NH + h) * 64, NH * 64);
            }
        }
    }
    SEAM(PH_ATTN);

    if (IN(PH_OUT)) { PH_BEGIN
        pg8::Gemm g{XN, Wo_t, T, D, D / 2};        pg8::StaticOrder S; S.init(T, D, G, bx);
        LAS float* rsl = (LAS float*)(lds + RING_BYTES);
        { pg8::Unit uu;
          for (int i = 0; i < 12 && S.next(i, uu); ++i) if (tid < 256) { const GAS f32x4* pq = (const GAS f32x4*)((const GAS float*)OSSQ + (size_t)(uu.pm * 256 + tid) * 16); const f32x4 a0 = pq[0], a1 = pq[1], b0 = pq[2], b1 = pq[3];
              const float sa = ((a0[0] + a0[1]) + (a0[2] + a0[3])) + ((a1[0] + a1[1]) + (a1[2] + a1[3])), sb = ((b0[0] + b0[1]) + (b0[2] + b0[3])) + ((b1[0] + b1[1]) + (b1[2] + b1[3]));
              const float ra = 1.0f / sqrtf(sa * (1.0f / 512.0f) + EPS), rb = 1.0f / sqrtf(sb * (1.0f / 512.0f) + EPS);
              *(LAS f32x2*)(rsl + (i * 256 + tid) * 2) = (f32x2){ra / rb, rb}; }
          __syncthreads(); }
        pg8::EpiOut E{AP->x, X1B, rsl};
        pg8::gemm_phase<pg8::EpiOut, pg8::StaticOrder, true, true, false, false, true, 0x7a7a7a7a, 0x7b7b7b7b, true>(lds, g, S, E);
    }
    SEAM(PH_OUT);

    if (IN(PH_ROUTE)) { PH_BEGIN
        LAS float* Wrg = (LAS float*)(lds + P8_WRG); LAS float* xt = (LAS float*)(lds + P8_XT + wave * P8_XT_WAVE); LAS float* wc = (LAS float*)(lds + P8_WC);
        LAS int* rt_g = (LAS int*)(lds + P8_RT); LAS float* rt_w = (LAS float*)(lds + P8_RT + 1024); LAS int* rt_rank = (LAS int*)(lds + P8_RT + 3072);
        LAS int* lcnt = (LAS int*)(lds + P8_RT + 4096); LAS int* lbase = (LAS int*)(lds + P8_RT + 4608); LAS float* rt_rs = (LAS float*)(lds + P8_RT + 5120);
        for (int k = tid; k < 1024; k += 512) *(LAS f32x4*)(Wrg + 4 * k) = *((const GAS f32x4*)WRGF + k);
        __syncthreads();
        const int r32 = lane & 31, kh = lane >> 5;
        for (int chunk = bx; chunk < T / 256; chunk += G) {
            if (tid < NCLS) lcnt[tid] = 0;
            const int rowc = wave * 32 + r32; const size_t row0w = (size_t)chunk * 256 + wave * 32;
            const GAS bf16* xsrc = (const GAS bf16*)X1B + (row0w + (lane >> 4)) * D + 4 * (lane & 15);
            f32x16 accE = {}; float aG0 = 0.f, aG1 = 0.f, aG2 = 0.f, aG3 = 0.f, ssq = 0.f;
            *(LAS f32x4*)(wc + 4 * tid) = *((const GAS f32x4*)WREF + tid);
            for (int kc = 0; kc < 16; ++kc) {
                f32x4 st[8];
#pragma unroll
                for (int j = 0; j < 8; ++j) { const v2u xw = *(const GAS v2u*)(xsrc + (size_t)(4 * j) * D + kc * 64); st[j] = (f32x4){bflo(xw.x), bfhi(xw.x), bflo(xw.y), bfhi(xw.y)}; }
                f32x4 wnext = {0.f, 0.f, 0.f, 0.f}; if (kc + 1 < 16) wnext = *((const GAS f32x4*)WREF + (kc + 1) * 512 + tid);
#pragma unroll
                for (int j = 0; j < 8; ++j) *(LAS f32x4*)(xt + ((lane >> 4) + 4 * j) * 68 + 4 * (lane & 15)) = st[j];
                if (kc + 1 < 16) *(LAS f32x4*)(wc + ((kc + 1) & 1) * 2048 + 4 * tid) = wnext;
                { const f32x4 gv = *(const GAS f32x4*)((const GAS float*)AP->ffn_g + kc * 64 + 4 * (lane & 15));
#pragma unroll
                  for (int j = 0; j < 8; ++j) { const f32x4 hv = st[j] * gv;
                      *(GAS unsigned*)((GAS unsigned char*)YH + (size_t)(row0w + (lane >> 4) + 4 * j) * D + kc * 64 + 4 * (lane & 15)) = pk4_fp8(hv[0], hv[1], hv[2], hv[3]); } }
                __syncthreads();
                const LAS float* wcc = wc + (kc & 1) * 2048 + r32;
#pragma unroll
                for (int c = 0; c < 8; ++c) {
                    const f32x4 xv = *(const LAS f32x4*)(xt + r32 * 68 + 8 * c + 4 * kh);
                    ssq += (xv.x * xv.x + xv.y * xv.y) + (xv.z * xv.z + xv.w * xv.w);
#pragma unroll
                    for (int e = 0; e < 4; ++e) { const int kl = 8 * c + 4 * kh + e;
                        const float a = wcc[kl * 32]; accE = __builtin_amdgcn_mfma_f32_32x32x2f32(a, xv[e], accE, 0, 0, 0);
                        const f32x4 wg = *(const LAS f32x4*)(Wrg + 4 * (kc * 64 + kl)); aG0 += xv[e] * wg[0]; aG1 += xv[e] * wg[1]; aG2 += xv[e] * wg[2]; aG3 += xv[e] * wg[3]; }
                }
                __syncthreads();
            }
            ssq += __shfl_xor(ssq, 32); aG0 += __shfl_xor(aG0, 32); aG1 += __shfl_xor(aG1, 32); aG2 += __shfl_xor(aG2, 32); aG3 += __shfl_xor(aG3, 32);
            const float rstd = 1.0f / sqrtf(ssq * (1.f / D) + EPS);
            float lg[4] = {aG0 * rstd + AP->b_rg[0], aG1 * rstd + AP->b_rg[1], aG2 * rstd + AP->b_rg[2], aG3 * rstd + AP->b_rg[3]};
            int gs = 0; float gm = lg[0];
#pragma unroll
            for (int i = 1; i < 4; ++i) if (lg[i] > gm) { gm = lg[i]; gs = i; }
            float den = 0.f;
#pragma unroll
            for (int i = 0; i < 4; ++i) den += __expf(lg[i] - gm);
            const float gwt = 1.0f / den;
            float mine[4];
#pragma unroll
            for (int i = 0; i < 4; ++i) { const float v = (gs == 0) ? accE[i] : (gs == 1) ? accE[4 + i] : (gs == 2) ? accE[8 + i] : accE[12 + i]; mine[i] = v * rstd + AP->b_re[gs * 8 + 4 * kh + i]; }
            float ev[8];
#pragma unroll
            for (int i = 0; i < 4; ++i) { const float oth = __shfl_xor(mine[i], 32); ev[i] = kh ? oth : mine[i]; ev[4 + i] = kh ? mine[i] : oth; }
            int e1 = 0; float v1 = ev[0];
#pragma unroll
            for (int i = 1; i < 8; ++i) if (ev[i] > v1) { v1 = ev[i]; e1 = i; }
            int e2 = -1; float v2 = -INFINITY;
#pragma unroll
            for (int i = 0; i < 8; ++i) if (i != e1 && (e2 < 0 || ev[i] > v2)) { v2 = ev[i]; e2 = i; }
            const float ex = __expf(v2 - v1); const float w1 = gwt / (1.0f + ex), w2 = gwt * ex / (1.0f + ex);
            if (kh == 0) { const int elo = e1 < e2 ? e1 : e2, ehi = e1 < e2 ? e2 : e1;
                rt_g[rowc] = gs * 28 + ((elo * (15 - elo)) >> 1) + (ehi - elo - 1); rt_w[rowc * 2] = e1 < e2 ? w1 : w2; rt_w[rowc * 2 + 1] = e1 < e2 ? w2 : w1; rt_rs[rowc] = rstd; }
            __syncthreads();
            if (tid < 256) rt_rank[tid] = __hip_atomic_fetch_add(&lcnt[rt_g[tid]], 1, __ATOMIC_RELAXED, __HIP_MEMORY_SCOPE_WORKGROUP);
            __syncthreads();
            if (tid < NCLS) { const int n = lcnt[tid]; lbase[tid] = n ? (int)__hip_atomic_fetch_add((gu32*)(ws + WS_CTL) + CW_GCNT + 64 * tid, (unsigned)n, RLX_AGENT) : 0; }
            __syncthreads();
            if (tid < 256) { const int g = rt_g[tid]; v4u ev; ev.x = (unsigned)(chunk * 256 + tid); ev.y = __builtin_bit_cast(unsigned, rt_w[tid * 2]); ev.z = __builtin_bit_cast(unsigned, rt_w[tid * 2 + 1]); ev.w = __builtin_bit_cast(unsigned, rt_rs[tid]);
                ((GAS v4u*)lists)[(size_t)g * LIST_CAP + lbase[g] + rt_rank[tid]] = ev; }
            __syncthreads();
        }
    }
    SEAM(PH_ROUTE);

    LAS int* tp = (LAS int*)(lds + TP_OFF); LAS int* cntl = (LAS int*)(lds + CNT_OFF); LAS int* ptab = (LAS int*)(lds + PT_OFF);
    if (hi > PH_ROUTE) {
        if (tid0 == 0) { gu32* ctl = (gu32*)(A.ws + WS_CTL); int acc = 0; for (int g = 0; g < NCLS; ++g) { const int n = (int)__hip_atomic_load(ctl + CW_GCNT + 64 * g, RLX_AGENT); cntl[g] = n; tp[g] = acc; acc += (n + 255) >> 8; } tp[NCLS] = acc;
            int p = 0; for (int lo_ = 0; lo_ < 8; ++lo_) for (int hi_ = lo_ + 1; hi_ < 8; ++hi_) ptab[p++] = lo_ | (hi_ << 4); }
        __syncthreads();
    }

    if (IN(PH_GU)) { PH_BEGIN
        pg8::Gemm g{YH, Wgu_t, 0, 0, D / 2}; pg8::ClsOrder S{tp, ptab, 0, G, MOE_SLOT(4), lists, cntl};
        pg8::EpiGateUp2 E{HB, lists, cntl};
        pg8::gemm_phase<pg8::EpiGateUp2, pg8::ClsOrder, true, true, true, false, true>(lds, g, S, E);
    }
    SEAM(PH_GU);

    if (IN(PH_D0)) { PH_BEGIN
        int K512 = 256; asm volatile("" : "+s"(K512)); pg8::Gemm g{HB, Wd_t, 0, 0, K512};        pg8::ClsOrder S{tp, ptab, 1, G, MOE_SLOT(4), lists, cntl};
        pg8::EpiDown2 E{AP->out, X1B, lists, cntl};
        pg8::gemm_phase<pg8::EpiDown2, pg8::ClsOrder, true, true, false, true, true, 0x7b7b7b7b, 0x7c7c7c7c, true>(lds, g, S, E);
    }
#undef IN
#undef SEAM
}

extern "C" void kernel_launch(void* const* d_in, const int* in_sizes, int n_in, void* d_out, int out_size, void* d_ws, size_t ws_size, hipStream_t stream) {
    static int grid = 0;
    if (grid == 0) {
        if (n_in != 22 || in_sizes[0] != T * D || out_size != T * D || ws_size < WS_END) { fprintf(stderr, "kernel_launch: unexpected shapes (n_in %d, in0 %d, out %d, ws %zu); nothing launched\n", n_in, n_in > 0 ? in_sizes[0] : -1, out_size, ws_size); grid = -1; return; }
        int dev = 0, cus = 0, per_cu = 0;
        if (hipGetDevice(&dev) != hipSuccess || hipDeviceGetAttribute(&cus, hipDeviceAttributeMultiprocessorCount, dev) != hipSuccess) { grid = -1; return; }
        if (hipFuncSetAttribute((const void*)mk_fwd, hipFuncAttributeMaxDynamicSharedMemorySize, LDS_BYTES) != hipSuccess) { fprintf(stderr, "kernel_launch: hipFuncSetAttribute failed\n"); grid = -1; return; }
        if (hipOccupancyMaxActiveBlocksPerMultiprocessor(&per_cu, (const void*)mk_fwd, 512, LDS_BYTES) != hipSuccess || per_cu < 1) { fprintf(stderr, "kernel_launch: occupancy query says %d\n", per_cu); }
        (void)hipGetLastError();
        grid = cus;
    }
    if (grid < 0) return;
    if (hipMemsetAsync((char*)d_ws + WS_CTL, 0, CTL_ZERO_BYTES, stream) != hipSuccess) return;
    Args a{};
    a.x = (const float*)d_in[0]; a.attn_g = (const float*)d_in[1]; a.w_in = (const float*)d_in[2]; a.qlat_g = (const float*)d_in[3]; a.w_qup = (const float*)d_in[4];
    a.kvlat_g = (const float*)d_in[5]; a.w_kvup = (const float*)d_in[6]; a.qhead_g = (const float*)d_in[7]; a.khead_g = (const float*)d_in[8];
    a.mqhead_g = (const float*)d_in[9]; a.mkhead_g = (const float*)d_in[10]; a.onorm_a_g = (const float*)d_in[11]; a.onorm_b_g = (const float*)d_in[12];
    a.w_out = (const float*)d_in[13]; a.ffn_g = (const float*)d_in[14]; a.w_rg = (const float*)d_in[15]; a.b_rg = (const float*)d_in[16];
    a.w_re = (const float*)d_in[17]; a.b_re = (const float*)d_in[18]; a.w_gate = (const float*)d_in[19]; a.w_up = (const float*)d_in[20]; a.w_down = (const float*)d_in[21];
    a.out = (float*)d_out; a.ws = (unsigned char*)d_ws; a.ph_lo = 0; a.ph_hi = NPHASE;
    hipLaunchKernelGGL(mk_fwd, dim3(grid), dim3(512), LDS_BYTES, stream, a);
    (void)hipPeekAtLastError();
}
```

```cpp
#include <hip/hip_runtime.h>
#include <cstdio>
#include <cstdint>
namespace pg8 {
#define PG8_LAS __attribute__((address_space(3)))
typedef unsigned short bf16_t;
typedef short bf16x8 __attribute__((ext_vector_type(8)));
typedef float f32x4 __attribute__((ext_vector_type(4)));
typedef unsigned u32x4 __attribute__((ext_vector_type(4)));
constexpr int BM = 256, BK = 64, HALF = 128, HTB = HALF * BK * 2  , STAGE_BYTES = 8 * HTB, NXCD = 8, WGM = 8;

__host__ __device__ __forceinline__ int lds_byte(int r, int c) { const int st = (r >> 4) * 2 + (c >> 5), rr = r & 15, cc = c & 31, ob = rr * 64 + cc * 2; return st * 1024 + (ob ^ (((ob >> 9) & 1) << 5)); }
__host__ __device__ __forceinline__ void stage_rc(int b, int& R, int& C) { const int st = b / 1024, sb = b % 1024, swz = sb ^ (((sb >> 9) & 1) << 5); R = (st >> 1) * 16 + swz / 64; C = (st & 1) * 32 + (swz % 64) / 2; }
__host__ __device__ __forceinline__ int perm32(int rho) { const int n = rho >> 4, i = rho & 15; return 8 * (i >> 2) + 4 * n + (i & 3); }

struct Unit { int pm, pn, g0, g1, pn2, q; };
struct Gemm { const bf16_t* A; const bf16_t* Bt; int M, N, K; };

struct StaticOrder {
    int nM, nN, nwg, G, c;
    __host__ __device__ void init(int M, int N, int G_, int c_) { nM = M / BM; nN = N / BM; nwg = nM * nN; G = G_; c = c_; }
    __host__ __device__ bool next(int i, Unit& u) const {
        const long L = (long)i * G + c; if (L >= nwg) return false;
        int wgid = (int)L; { const int q = nwg / NXCD, r = nwg % NXCD, xcd = wgid % NXCD, off = wgid / NXCD; wgid = (xcd < r ? xcd * (q + 1) : r * (q + 1) + (xcd - r) * q) + off; }
        const int nig = WGM * nN, gid = wgid / nig, fm = gid * WGM, gsz = (nM - fm) < WGM ? (nM - fm) : WGM;
        u.pm = fm + ((wgid % nig) % gsz); u.pn = (wgid % nig) / gsz; u.g0 = i; u.g1 = 0; u.pn2 = 0; u.q = 0; return true;
    }
    __device__ __forceinline__ void a_ready(const Unit&) const {}
    __device__ __forceinline__ void done(const Unit&) const {}
};

__device__ __forceinline__ unsigned cvt_pk_bf16(float lo, float hi) { unsigned r; asm volatile("v_cvt_pk_bf16_f32 %0, %1, %2" : "=v"(r) : "v"(lo), "v"(hi)); return r; }
#define PG8_GAS __attribute__((address_space(1)))
struct ListEnt { int tok; float w_lo; float w_hi; float rstd; };

struct EpiBf16 {
    static constexpr bool PERM = true, AFTER_DRAIN = false, MIDHOOK = false;
    bf16_t* O; int ldc;
    __device__ __forceinline__ void operator()(const f32x4 (&acc)[2][2][4][2], const Unit& u, int wr, int wc, int fr, int fq) const {
        const int row0 = u.pm * BM + wr * 64 + fr; const int col0 = u.pn * BM + wc * 32 + 8 * fq;
#pragma unroll
        for (int ai = 0; ai < 2; ++ai)
#pragma unroll
            for (int m = 0; m < 4; ++m) { bf16_t* rowp = O + (size_t)(row0 + ai * HALF + m * 16) * ldc + col0;
#pragma unroll
                for (int bj = 0; bj < 2; ++bj) { const f32x4 v0 = acc[ai][bj][m][0], v1 = acc[ai][bj][m][1];
                    u32x4 w; w.x = cvt_pk_bf16(v0[0], v0[1]); w.y = cvt_pk_bf16(v0[2], v0[3]); w.z = cvt_pk_bf16(v1[0], v1[1]); w.w = cvt_pk_bf16(v1[2], v1[3]);
                    *(PG8_GAS u32x4*)(rowp + bj * HALF) = w; } }
    }
};
struct EpiBf16Rs {
    static constexpr bool PERM = true, AFTER_DRAIN = false, MIDHOOK = false;
    bf16_t* O; int ldc; const float* ssq; int off; float inv_n, eps;
    __device__ __forceinline__ void operator()(const f32x4 (&acc)[2][2][4][2], const Unit& u, int wr, int wc, int fr, int fq) const {
        const int row0 = u.pm * BM + wr * 64 + fr; const int col0 = u.pn * BM + wc * 32 + 8 * fq;
#pragma unroll
        for (int ai = 0; ai < 2; ++ai)
#pragma unroll
            for (int m = 0; m < 4; ++m) { const int row = row0 + ai * HALF + m * 16; PG8_GAS bf16_t* rowp = (PG8_GAS bf16_t*)O + (size_t)row * ldc + col0;
                const f32x4 sq = *(const PG8_GAS f32x4*)(ssq + (size_t)row * 8 + off); const float rs = 1.0f / sqrtf(((sq[0] + sq[1]) + (sq[2] + sq[3])) * inv_n + eps);
#pragma unroll
                for (int bj = 0; bj < 2; ++bj) { const f32x4 v0 = acc[ai][bj][m][0] * rs, v1 = acc[ai][bj][m][1] * rs;
                    u32x4 w; w.x = cvt_pk_bf16(v0[0], v0[1]); w.y = cvt_pk_bf16(v0[2], v0[3]); w.z = cvt_pk_bf16(v1[0], v1[1]); w.w = cvt_pk_bf16(v1[2], v1[3]);
                    *(PG8_GAS u32x4*)(rowp + bj * HALF) = w; } }
    }
};
struct EpiProj {
    static constexpr bool PERM = true, AFTER_DRAIN = false, MIDHOOK = false;
    unsigned char* ws; size_t o_qln, o_kvln, o_qb, o_kb, o_vb, o_ssq, o_kmean, o_rope; const float* gq; const float* gk; float qscale, eps; int seq;
    __device__ __forceinline__ void operator()(const f32x4 (&acc)[2][2][4][2], const Unit& u, int wr, int wc, int fr, int fq) const {
        const int pn = u.pn; const int row0 = u.pm * BM + wr * 64 + fr;
        bf16_t* const QLN = (bf16_t*)(ws + o_qln); bf16_t* const KVLN = (bf16_t*)(ws + o_kvln); bf16_t* const QB = (bf16_t*)(ws + o_qb); bf16_t* const KB = (bf16_t*)(ws + o_kb); bf16_t* const VB = (bf16_t*)(ws + o_vb);
        float* const SSQ = (float*)(ws + o_ssq); float* const kmean = (float*)(ws + o_kmean); const float* const rope = (const float*)(ws + o_rope);
        if (pn < 2) {
            PG8_GAS bf16_t* O = (PG8_GAS bf16_t*)(pn ? KVLN : QLN); PG8_GAS float* sq = (PG8_GAS float*)SSQ;
#pragma unroll
            for (int ai = 0; ai < 2; ++ai)
#pragma unroll
                for (int m = 0; m < 4; ++m) { const int row = row0 + ai * HALF + m * 16; PG8_GAS bf16_t* rowp = O + (size_t)row * 256 + wc * 32 + 8 * fq; float ss = 0.f;
#pragma unroll
                    for (int bj = 0; bj < 2; ++bj) { const f32x4 v0 = acc[ai][bj][m][0], v1 = acc[ai][bj][m][1];
                        if (pn == 0 || bj == 0) ss += (v0[0] * v0[0] + v0[1] * v0[1]) + (v0[2] * v0[2] + v0[3] * v0[3]) + (v1[0] * v1[0] + v1[1] * v1[1]) + (v1[2] * v1[2] + v1[3] * v1[3]);
                        u32x4 w; w.x = cvt_pk_bf16(v0[0], v0[1]); w.y = cvt_pk_bf16(v0[2], v0[3]); w.z = cvt_pk_bf16(v1[0], v1[1]); w.w = cvt_pk_bf16(v1[2], v1[3]);
                        *(PG8_GAS u32x4*)(rowp + bj * HALF) = w; }
                    ss += __shfl_xor(ss, 16); ss += __shfl_xor(ss, 32);
                    if (fq == 0) sq[(size_t)row * 8 + pn * 4 + wc] = ss; }
        } else if (pn < 6) {
            const bool isk = pn >= 4; const int head = (pn & 1) * 4 + wc; const float* gp = isk ? gk : gq; asm volatile("" : "+s"(gp)); const float sc = isk ? 1.0f : qscale;
            PG8_GAS bf16_t* O = (PG8_GAS bf16_t*)(isk ? KB : QB);
            f32x4 g0[2], g1[2];
#pragma unroll
            for (int n = 0; n < 2; ++n) { g0[n] = *(const PG8_GAS f32x4*)(gp + 8 * fq + 4 * n); g1[n] = *(const PG8_GAS f32x4*)(gp + 32 + 8 * fq + 4 * n); }
            f32x4 cs0[2] = {{0.f, 0.f, 0.f, 0.f}, {0.f, 0.f, 0.f, 0.f}}, cs1[2] = {{0.f, 0.f, 0.f, 0.f}, {0.f, 0.f, 0.f, 0.f}};
#pragma unroll
            for (int ai = 0; ai < 2; ++ai)
#pragma unroll
                for (int m = 0; m < 4; ++m) { const int row = row0 + ai * HALF + m * 16; const int pos = row & (seq - 1);
                    float ss = 0.f;
#pragma unroll
                    for (int n = 0; n < 2; ++n) { const f32x4 a = acc[ai][0][m][n], b = acc[ai][1][m][n]; ss += (a[0] * a[0] + a[1] * a[1]) + (a[2] * a[2] + a[3] * a[3]) + (b[0] * b[0] + b[1] * b[1]) + (b[2] * b[2] + b[3] * b[3]); }
                    ss += __shfl_xor(ss, 16); ss += __shfl_xor(ss, 32);
                    const float rs = 1.0f / sqrtf(ss * (1.0f / 64.0f) + eps);
                    u32x4 w1, w2; unsigned pk1[4], pk2_[4];
#pragma unroll
                    for (int n = 0; n < 2; ++n) { const f32x4 c = *(const PG8_GAS f32x4*)(rope + (size_t)pos * 32 + 8 * fq + 4 * n), sn = *(const PG8_GAS f32x4*)(rope + (size_t)seq * 32 + (size_t)pos * 32 + 8 * fq + 4 * n);
                        const f32x4 y1 = acc[ai][0][m][n] * rs * g0[n], y2 = acc[ai][1][m][n] * rs * g1[n];
                        const f32x4 o1 = (y1 * c - y2 * sn) * sc, o2 = (y2 * c + y1 * sn) * sc;
                        if (isk) { cs0[n] += o1; cs1[n] += o2; }
                        pk1[2 * n] = cvt_pk_bf16(o1[0], o1[1]); pk1[2 * n + 1] = cvt_pk_bf16(o1[2], o1[3]); pk2_[2 * n] = cvt_pk_bf16(o2[0], o2[1]); pk2_[2 * n + 1] = cvt_pk_bf16(o2[2], o2[3]); }
                    w1.x = pk1[0]; w1.y = pk1[1]; w1.z = pk1[2]; w1.w = pk1[3]; w2.x = pk2_[0]; w2.y = pk2_[1]; w2.z = pk2_[2]; w2.w = pk2_[3];
                    PG8_GAS bf16_t* rowp = O + (size_t)row * 512 + head * 64 + 8 * fq;
                    *(PG8_GAS u32x4*)rowp = w1; *(PG8_GAS u32x4*)(rowp + 32) = w2;
                    asm volatile("" : "+v"(cs0[0]), "+v"(cs0[1]), "+v"(cs1[0]), "+v"(cs1[1]) :: "memory"); }
            if (isk) {
                PG8_GAS float* km = (PG8_GAS float*)kmean + ((size_t)u.pm * 8 + head) * 64;
#pragma unroll
                for (int n = 0; n < 2; ++n)
#pragma unroll
                    for (int j = 0; j < 4; ++j) { float a = cs0[n][j], b = cs1[n][j];
#pragma unroll
                        for (int o = 1; o < 16; o <<= 1) { a += __shfl_xor(a, o); b += __shfl_xor(b, o); }
                        if (fr == 0) { __hip_atomic_fetch_add(km + 8 * fq + 4 * n + j, a * (1.0f / 256.0f), __ATOMIC_RELAXED, __HIP_MEMORY_SCOPE_AGENT); __hip_atomic_fetch_add(km + 32 + 8 * fq + 4 * n + j, b * (1.0f / 256.0f), __ATOMIC_RELAXED, __HIP_MEMORY_SCOPE_AGENT); } }
            }
        } else {
            PG8_GAS bf16_t* O = (PG8_GAS bf16_t*)VB; const int col0 = (pn - 6) * BM + wc * 32 + 8 * fq;
#pragma unroll
            for (int ai = 0; ai < 2; ++ai)
#pragma unroll
                for (int m = 0; m < 4; ++m) { PG8_GAS bf16_t* rowp = O + (size_t)(row0 + ai * HALF + m * 16) * 512 + col0;
#pragma unroll
                    for (int bj = 0; bj < 2; ++bj) { const f32x4 v0 = acc[ai][bj][m][0], v1 = acc[ai][bj][m][1];
                        u32x4 w; w.x = cvt_pk_bf16(v0[0], v0[1]); w.y = cvt_pk_bf16(v0[2], v0[3]); w.z = cvt_pk_bf16(v1[0], v1[1]); w.w = cvt_pk_bf16(v1[2], v1[3]);
                        *(PG8_GAS u32x4*)(rowp + bj * HALF) = w; } }
        }
    }
};
struct EpiKv {
    static constexpr bool PERM = true, AFTER_DRAIN = false, MIDHOOK = false;
    bf16_t* KA; bf16_t* VA; const bf16_t* KVLN; const float* ssq; const float* ropeR; const float* gk; float eps; int seq;
    __device__ __forceinline__ void operator()(const f32x4 (&acc)[2][2][4][2], const Unit& u, int wr, int wc, int fr, int fq) const {
        const int pn = u.pn; const int row0 = u.pm * BM + wr * 64 + fr;
        if (pn < 2) {
            const int head = pn * 4 + wc; const float* gp = gk; asm volatile("" : "+s"(gp));
            f32x4 g0[2], g1[2];
#pragma unroll
            for (int n = 0; n < 2; ++n) { g0[n] = *(const PG8_GAS f32x4*)(gp + 8 * fq + 4 * n); g1[n] = *(const PG8_GAS f32x4*)(gp + 32 + 8 * fq + 4 * n); }
            const f32x4 gr1 = *(const PG8_GAS f32x4*)(gp + 64 + 4 * fq), gr2 = *(const PG8_GAS f32x4*)(gp + 80 + 4 * fq);
#pragma unroll
            for (int ai = 0; ai < 2; ++ai)
#pragma unroll
                for (int m = 0; m < 4; ++m) { const int row = row0 + ai * HALF + m * 16; const int pos = row & (seq - 1);
                    const f32x4 sq = *(const PG8_GAS f32x4*)(ssq + (size_t)row * 8 + 4); const float rl = 1.0f / sqrtf(((sq[0] + sq[1]) + (sq[2] + sq[3])) * (1.0f / 128.0f) + eps);
                    const PG8_GAS bf16_t* pe = (const PG8_GAS bf16_t*)KVLN + (size_t)row * 256 + 128 + 4 * fq;
                    typedef unsigned u32x2_ __attribute__((ext_vector_type(2)));
                    const u32x2_ p1 = *(const PG8_GAS u32x2_*)pe, p2 = *(const PG8_GAS u32x2_*)(pe + 16);
                    const f32x4 e1 = {__builtin_bit_cast(float, p1.x << 16), __builtin_bit_cast(float, p1.x & 0xffff0000u), __builtin_bit_cast(float, p1.y << 16), __builtin_bit_cast(float, p1.y & 0xffff0000u)};
                    const f32x4 e2 = {__builtin_bit_cast(float, p2.x << 16), __builtin_bit_cast(float, p2.x & 0xffff0000u), __builtin_bit_cast(float, p2.y << 16), __builtin_bit_cast(float, p2.y & 0xffff0000u)};
                    f32x4 x0[2], x1[2]; float ss = (e1[0] * e1[0] + e1[1] * e1[1]) + (e1[2] * e1[2] + e1[3] * e1[3]) + (e2[0] * e2[0] + e2[1] * e2[1]) + (e2[2] * e2[2] + e2[3] * e2[3]);
#pragma unroll
                    for (int n = 0; n < 2; ++n) { x0[n] = acc[ai][0][m][n] * rl; x1[n] = acc[ai][1][m][n] * rl; const f32x4 a = x0[n], b = x1[n];
                        ss += (a[0] * a[0] + a[1] * a[1]) + (a[2] * a[2] + a[3] * a[3]) + (b[0] * b[0] + b[1] * b[1]) + (b[2] * b[2] + b[3] * b[3]); }
                    ss += __shfl_xor(ss, 16); ss += __shfl_xor(ss, 32);
                    const float rs = 1.0f / sqrtf(ss * (1.0f / 96.0f) + eps);
                    PG8_GAS bf16_t* rowp = (PG8_GAS bf16_t*)KA + (size_t)row * 768 + head * 96;
                    u32x4 w1, w2;
                    { const f32x4 a = x0[0] * rs * g0[0], b = x0[1] * rs * g0[1]; w1.x = cvt_pk_bf16(a[0], a[1]); w1.y = cvt_pk_bf16(a[2], a[3]); w1.z = cvt_pk_bf16(b[0], b[1]); w1.w = cvt_pk_bf16(b[2], b[3]); }
                    { const f32x4 a = x1[0] * rs * g1[0], b = x1[1] * rs * g1[1]; w2.x = cvt_pk_bf16(a[0], a[1]); w2.y = cvt_pk_bf16(a[2], a[3]); w2.z = cvt_pk_bf16(b[0], b[1]); w2.w = cvt_pk_bf16(b[2], b[3]); }
                    *(PG8_GAS u32x4*)(rowp + 8 * fq) = w1; *(PG8_GAS u32x4*)(rowp + 32 + 8 * fq) = w2;
                    const f32x4 c = *(const PG8_GAS f32x4*)(ropeR + (size_t)pos * 16 + 4 * fq), sn = *(const PG8_GAS f32x4*)(ropeR + (size_t)seq * 16 + (size_t)pos * 16 + 4 * fq);
                    const f32x4 y1 = e1 * rs * gr1, y2 = e2 * rs * gr2; const f32x4 o1 = y1 * c - y2 * sn, o2 = y2 * c + y1 * sn;
                    u32x2_ r1, r2; r1.x = cvt_pk_bf16(o1[0], o1[1]); r1.y = cvt_pk_bf16(o1[2], o1[3]); r2.x = cvt_pk_bf16(o2[0], o2[1]); r2.y = cvt_pk_bf16(o2[2], o2[3]);
                    *(PG8_GAS u32x2_*)(rowp + 64 + 4 * fq) = r1; *(PG8_GAS u32x2_*)(rowp + 80 + 4 * fq) = r2;
                    asm volatile("" ::: "memory"); }
        } else {
            const int col0 = (pn - 2) * BM + wc * 32 + 8 * fq;
#pragma unroll
            for (int ai = 0; ai < 2; ++ai)
#pragma unroll
                for (int m = 0; m < 4; ++m) { const int row = row0 + ai * HALF + m * 16; PG8_GAS bf16_t* rowp = (PG8_GAS bf16_t*)VA + (size_t)row * 512 + col0;
                    const f32x4 sq = *(const PG8_GAS f32x4*)(ssq + (size_t)row * 8 + 4); const float rl = 1.0f / sqrtf(((sq[0] + sq[1]) + (sq[2] + sq[3])) * (1.0f / 128.0f) + eps);
#pragma unroll
                    for (int bj = 0; bj < 2; ++bj) { const f32x4 v0 = acc[ai][bj][m][0] * rl, v1 = acc[ai][bj][m][1] * rl;
                        u32x4 w; w.x = cvt_pk_bf16(v0[0], v0[1]); w.y = cvt_pk_bf16(v0[2], v0[3]); w.z = cvt_pk_bf16(v1[0], v1[1]); w.w = cvt_pk_bf16(v1[2], v1[3]);
                        *(PG8_GAS u32x4*)(rowp + bj * HALF) = w; } }
        }
    }
};
struct EpiOut {
    static constexpr bool PERM = true, AFTER_DRAIN = false, MIDHOOK = true;
    const float* base; bf16_t* x1b; const PG8_LAS float* rsl;
    __device__ __forceinline__ void mid(f32x4 (&acc)[2][2][4][2], const Unit& u, int wr, int wc, int fr, int fq) const {
        const PG8_LAS float* rs = rsl + (u.g0 * 256 + wr * 64 + fr) * 2;
#pragma unroll
        for (int ai = 0; ai < 2; ++ai)
#pragma unroll
            for (int m = 0; m < 4; ++m) { const float ratio = rs[(ai * HALF + m * 16) * 2];
#pragma unroll
                for (int bj = 0; bj < 2; ++bj)
#pragma unroll
                    for (int n = 0; n < 2; ++n) acc[ai][bj][m][n] *= ratio; }
    }
    __device__ __forceinline__ void operator()(const f32x4 (&acc)[2][2][4][2], const Unit& u, int wr, int wc, int fr, int fq) const {
        const int row0 = u.pm * BM + wr * 64 + fr; const int col0 = u.pn * BM + wc * 32 + 8 * fq;
        const PG8_LAS float* rs = rsl + (u.g0 * 256 + wr * 64 + fr) * 2 + 1;
#pragma unroll
        for (int ai = 0; ai < 2; ++ai)
#pragma unroll
            for (int m = 0; m < 4; ++m) { const int row = row0 + ai * HALF + m * 16; const size_t off = (size_t)row * 1024 + col0; const float rb = rs[(ai * HALF + m * 16) * 2];
#pragma unroll
                for (int bj = 0; bj < 2; ++bj) { const size_t p = off + bj * HALF;
                    const f32x4 v0 = *(const PG8_GAS f32x4*)(base + p) + acc[ai][bj][m][0] * rb, v1 = *(const PG8_GAS f32x4*)(base + p + 4) + acc[ai][bj][m][1] * rb;
                    u32x4 o; o.x = cvt_pk_bf16(v0[0], v0[1]); o.y = cvt_pk_bf16(v0[2], v0[3]); o.z = cvt_pk_bf16(v1[0], v1[1]); o.w = cvt_pk_bf16(v1[2], v1[3]);
                    *(PG8_GAS u32x4*)(x1b + p) = o; }
                if (m & 1) asm volatile("" ::: "memory"); }
    }
};
struct EpiGateUp2 {
    static constexpr bool PERM = true, AFTER_DRAIN = false, MIDHOOK = false;
    bf16_t* H; const ListEnt* lists; const PG8_LAS int* cnt;
    __device__ __forceinline__ void operator()(const f32x4 (&acc)[2][2][4][2], const Unit& u, int wr, int wc, int fr, int fq) const {
        const int rt0 = wr * 64 + fr; const int col0 = (u.q >> 1) * 256 + (u.q & 1) * 128 + wc * 32 + 8 * fq; const int g = u.g0; const int n_g = cnt[g]; const bool hiexp = (u.q >> 1) != 0;
        const ListEnt* lg = lists + (size_t)g * 65536 + u.g1 * 256;
#pragma unroll
        for (int ai = 0; ai < 2; ++ai)
#pragma unroll
            for (int m = 0; m < 4; ++m) { const int rt = rt0 + ai * HALF + m * 16; const bool valid = (u.g1 * 256 + rt) < n_g;
                float w = 0.f, rsd = 0.f; if (valid) { const f32x4 le = *(const PG8_GAS f32x4*)((const PG8_GAS ListEnt*)lg + rt); w = hiexp ? le[2] : le[1]; rsd = le[3]; }
                unsigned pk[2];
#pragma unroll
                for (int n = 0; n < 2; ++n) { const f32x4 gv = acc[ai][0][m][n], uv = acc[ai][1][m][n]; float h[4];
#pragma unroll
                    for (int j = 0; j < 4; ++j) { const float a = gv[j] * rsd; const float s = a * __builtin_amdgcn_rcpf(1.0f + __builtin_amdgcn_exp2f(-1.4426950408889634f * a)); h[j] = valid ? s * (uv[j] * rsd) * w : 0.f; }
                    { int w_ = 0; w_ = __builtin_amdgcn_cvt_pk_fp8_f32(h[0] * 8.0f, h[1] * 8.0f, w_, false); w_ = __builtin_amdgcn_cvt_pk_fp8_f32(h[2] * 8.0f, h[3] * 8.0f, w_, true); pk[n] = (unsigned)w_; } }
                typedef unsigned u32x2h_ __attribute__((ext_vector_type(2))); u32x2h_ o; o.x = pk[0]; o.y = pk[1];
                *(PG8_GAS u32x2h_*)((PG8_GAS unsigned char*)H + (size_t)(u.pm * BM + rt) * 512 + col0) = o; }
    }
};
struct EpiDown2 {
    static constexpr bool PERM = true, AFTER_DRAIN = false, MIDHOOK = false;
    float* out; const bf16_t* x1b; const ListEnt* lists; const PG8_LAS int* cnt;
    __device__ __forceinline__ void operator()(const f32x4 (&acc)[2][2][4][2], const Unit& u, int wr, int wc, int fr, int fq) const {
        const int rt0 = wr * 64 + fr; const int col0 = u.q * 256 + wc * 32 + 8 * fq; const int g = u.g0; const int n_g = cnt[g];
        const ListEnt* lg = lists + (size_t)g * 65536 + u.g1 * 256;
#pragma unroll
        for (int ai = 0; ai < 2; ++ai)
#pragma unroll
            for (int m = 0; m < 4; ++m) { const int rt = rt0 + ai * HALF + m * 16; const bool valid = (u.g1 * 256 + rt) < n_g;
                if (valid) { const int tok = ((const PG8_GAS ListEnt*)lg)[rt].tok; PG8_GAS float* orow = (PG8_GAS float*)out + (size_t)tok * 1024 + col0;
#pragma unroll
                    for (int bj = 0; bj < 2; ++bj) { PG8_GAS float* p = orow + bj * HALF; const u32x4 xb = *(const PG8_GAS u32x4*)((const PG8_GAS bf16_t*)x1b + (size_t)tok * 1024 + col0 + bj * HALF);
                        f32x4 a, b; a[0] = __builtin_bit_cast(float, xb.x << 16); a[1] = __builtin_bit_cast(float, xb.x & 0xffff0000u); a[2] = __builtin_bit_cast(float, xb.y << 16); a[3] = __builtin_bit_cast(float, xb.y & 0xffff0000u);
                        b[0] = __builtin_bit_cast(float, xb.z << 16); b[1] = __builtin_bit_cast(float, xb.z & 0xffff0000u); b[2] = __builtin_bit_cast(float, xb.w << 16); b[3] = __builtin_bit_cast(float, xb.w & 0xffff0000u);
                        *(PG8_GAS f32x4*)p = a + acc[ai][bj][m][0]; *(PG8_GAS f32x4*)(p + 4) = b + acc[ai][bj][m][1]; } }
                if (m & 1) asm volatile("" ::: "memory"); }
    }
};
struct ClsOrder {
    const PG8_LAS int* tp; const PG8_LAS int* ptab; int mode, G, c; const ListEnt* lists; const PG8_LAS int* cnt;
    __device__ __forceinline__ int arow(const Unit& u, int row) const { const unsigned pos = (unsigned)(u.g1 * 256 + row); const unsigned n = (unsigned)cnt[u.g0]; const PG8_GAS ListEnt* lg = (const PG8_GAS ListEnt*)lists + (size_t)u.g0 * 65536; return lg[pos < n ? pos : 0u].tok; }
    __device__ __forceinline__ bool next(int i, Unit& u) const {
        const int nrb = tp[112]; const long L = (long)i * G + c; if (L >= (long)nrb * 4) return false;
        const int rbt = (int)(L >> 2), q = (int)(L & 3);
        int g = 0;
#pragma unroll
        for (int s = 64; s >= 1; s >>= 1) { const int gg = g + s; if (gg < 112 && tp[gg] <= rbt) g = gg; }
        const int grp = g / 28, pr = ptab[g - grp * 28], lo = pr & 15, hi = pr >> 4;
        u.pm = rbt; u.g0 = g; u.g1 = rbt - tp[g]; u.q = q;
        if (mode == 0) { u.pn = (grp * 8 + ((q >> 1) ? hi : lo)) * 2 + (q & 1); u.pn2 = 0; } else { u.pn = (grp * 8 + lo) * 4 + q; u.pn2 = (grp * 8 + hi) * 4 + q; }
        return true;
    }
    __device__ __forceinline__ void a_ready(const Unit&) const {}
    __device__ __forceinline__ void done(const Unit&) const {}
};

template <class Epi, class Sched, bool ALIGN_EPI = false, bool SP2 = false, bool GATHER = false, bool KSPLIT = false, bool F8 = false, int SCW = 0x7a7a7a7a, int SCA = 0x7f7f7f7f, bool F8ASM = false>
__device__ __forceinline__ void gemm_phase(PG8_LAS unsigned char* lds, const Gemm g, const Sched& S, const Epi& E) {
    const int tid = threadIdx.x, wid = __builtin_amdgcn_readfirstlane(tid >> 6), lane = tid & 63, wr = wid >> 2, wc = wid & 3, fr = lane & 15, fq = lane >> 4;
    const int K = g.K, nt = K / BK;
    const int PB = KSPLIT ? (K >> 1) : K;
    static_assert(!GATHER || SP2, "gathered A rows: SP2 loop only");
    unsigned voffA[2], voffB[2];
#pragma unroll
    for (int i = 0; i < 2; ++i) { int R, C; stage_rc(tid * 16 + i * 8192, R, C); const int Rb = Epi::PERM ? ((R & ~31) + perm32(R & 31)) : R;
        voffA[i] = (unsigned)(R * K + C) * 2u; voffB[i] = (unsigned)(Rb * PB + C) * 2u; }
    const size_t kstep = (size_t)(BK * 2);
    const size_t hstep = (size_t)HALF * K * 2;
    const size_t tstep = 2 * hstep;
    const size_t hstepB = (size_t)HALF * PB * 2, tstepB = 2 * hstepB;
    const unsigned ldsw = (unsigned)wid * 1024u;
    const int aoff = lds_byte(wr * 64 + fr, fq * 8), boff = lds_byte(wc * 32 + fr, fq * 8);
#define PG8_SA(b, h) (((b) * 2 + (h)) * HTB)
#define PG8_SB(b, h) ((4 + (b) * 2 + (h)) * HTB)
#define PG8_STAGE(bufoff, gbase, voff) do { _Pragma("unroll") for (int _i = 0; _i < 2; ++_i) \
        __builtin_amdgcn_global_load_lds((const unsigned*)((const char*)(gbase) + (voff)[_i]), (PG8_LAS unsigned*)(lds + (bufoff) + ldsw + _i * 8192), 16, 0, 0); } while (0)
#define PG8_LDA(dst, b, h) do { _Pragma("unroll") for (int m = 0; m < 4; ++m) _Pragma("unroll") for (int k = 0; k < 2; ++k) dst[m][k] = *(const PG8_LAS bf16x8*)(lds + PG8_SA(b, h) + aoff + m * 2048 + k * 1024); } while (0)
#define PG8_LDB(dst, b, h) do { _Pragma("unroll") for (int n = 0; n < 2; ++n) _Pragma("unroll") for (int k = 0; k < 2; ++k) dst[n][k] = *(const PG8_LAS bf16x8*)(lds + PG8_SB(b, h) + boff + n * 2048 + k * 1024); } while (0)
#define PG8_MMA(ai, bj, At, Bt) do { __builtin_amdgcn_s_setprio(1); _Pragma("unroll") for (int m = 0; m < 4; ++m) _Pragma("unroll") for (int n = 0; n < 2; ++n) { \
        if constexpr (F8) { typedef int v4i_ __attribute__((ext_vector_type(4))); typedef int v8i_ __attribute__((ext_vector_type(8))); \
            const v8i_ w8_ = __builtin_shufflevector(__builtin_bit_cast(v4i_, Bt[n][0]), __builtin_bit_cast(v4i_, Bt[n][1]), 0, 1, 2, 3, 4, 5, 6, 7); \
            const v8i_ a8_ = __builtin_shufflevector(__builtin_bit_cast(v4i_, At[m][0]), __builtin_bit_cast(v4i_, At[m][1]), 0, 1, 2, 3, 4, 5, 6, 7); \
            if constexpr (F8ASM) { asm volatile("v_mfma_scale_f32_16x16x128_f8f6f4 %0, %1, %2, %0, %3, %4 op_sel_hi:[0,0,0]" : "+v"(acc[ai][bj][m][n]) : "v"(w8_), "v"(a8_), "v"(SCW), "v"(SCA)); }     \
            else acc[ai][bj][m][n] = __builtin_amdgcn_mfma_scale_f32_16x16x128_f8f6f4(w8_, a8_, acc[ai][bj][m][n], 0, 0, 0, SCW, 0, SCA); } \
        else { _Pragma("unroll") for (int k = 0; k < 2; ++k) acc[ai][bj][m][n] = __builtin_amdgcn_mfma_f32_16x16x32_bf16(Bt[n][k], At[m][k], acc[ai][bj][m][n], 0, 0, 0); } } \
        __builtin_amdgcn_s_setprio(0); } while (0)
#define PG8_WAIT_V(n) asm volatile("s_waitcnt vmcnt(" #n ")" ::: "memory")
#define PG8_WAIT_L(n) asm volatile("s_waitcnt lgkmcnt(" #n ")" ::: "memory")
#define PG8_BAR __builtin_amdgcn_s_barrier()
#define PG8_SCHED __builtin_amdgcn_sched_barrier(0)
#define PG8_STG_A(b, h, ptr, arr) do { if constexpr (GATHER) { PG8_STAGE(PG8_SA(b, h), (ptr), (arr)[h]); } else { PG8_STAGE(PG8_SA(b, h), (ptr) + ((h) ? hstep : 0), voffA); } } while (0)
    unsigned cv[2][2] = {{0u, 0u}, {0u, 0u}}, nvp[2] = {0u, 0u};
#define PG8_GROWS(dst, unit) do { if constexpr (GATHER) { _Pragma("unroll") for (int _h = 0; _h < 2; ++_h) _Pragma("unroll") for (int _i = 0; _i < 2; ++_i) { int R_, C_; stage_rc(tid * 16 + _i * 8192, R_, C_); \
        dst[_h][_i] = (unsigned)S.arow(unit, _h * HALF + R_) * (unsigned)(K * 2) + (unsigned)(C_ * 2); } } } while (0)
    Unit cur, nxt; int ui = 0;
    if (!S.next(0, cur)) return;
    PG8_GROWS(cv, cur);
#define PG8_GROWS_P(unit) do { _Pragma("unroll") for (int _i = 0; _i < 2; ++_i) { int R_, C_; stage_rc(tid * 16 + _i * 8192, R_, C_); nvp[_i] = (unsigned)S.arow(unit, R_) | ((unsigned)S.arow(unit, HALF + R_) << 16); } } while (0)
#define PG8_UNPACK_NV() do { _Pragma("unroll") for (int _i = 0; _i < 2; ++_i) { int R_, C_; stage_rc(tid * 16 + _i * 8192, R_, C_); cv[0][_i] = (nvp[_i] & 0xffffu) * (unsigned)(K * 2) + (unsigned)(C_ * 2); cv[1][_i] = (nvp[_i] >> 16) * (unsigned)(K * 2) + (unsigned)(C_ * 2); } } while (0)
    f32x4 acc[2][2][4][2];
#pragma unroll
    for (int a = 0; a < 2; ++a)
#pragma unroll
        for (int b = 0; b < 2; ++b)
#pragma unroll
            for (int m = 0; m < 4; ++m)
#pragma unroll
                for (int n = 0; n < 2; ++n) acc[a][b][m][n] = (f32x4){0.f, 0.f, 0.f, 0.f};
    bf16x8 At[4][2], B0[2][2], B1[2][2];
    const char* cA = (const char*)g.A + (GATHER ? (size_t)0 : (size_t)cur.pm * tstep); const char* cB = (const char*)g.Bt + (size_t)cur.pn * tstepB; const char* cB2 = KSPLIT ? (const char*)g.Bt + (size_t)cur.pn2 * tstepB : cB;
    S.a_ready(cur);
    if constexpr (SP2) {
        PG8_STAGE(PG8_SB(0, 0), cB, voffB); PG8_STAGE(PG8_SB(0, 1), cB + hstepB, voffB); PG8_STG_A(0, 0, cA, cv); PG8_STG_A(0, 1, cA, cv);
        if (wr == 1) PG8_BAR;
        PG8_WAIT_V(2); PG8_BAR;
        PG8_STAGE(PG8_SB(1, 0), cB + kstep, voffB); PG8_STG_A(1, 0, cA + kstep, cv); PG8_STAGE(PG8_SB(1, 1), cB + hstepB + kstep, voffB);
        PG8_WAIT_V(6); PG8_BAR;
    } else {
        PG8_STAGE(PG8_SB(0, 0), cB, voffB); PG8_STAGE(PG8_SA(0, 0), cA, voffA); PG8_STAGE(PG8_SB(0, 1), cB + hstepB, voffB); PG8_STAGE(PG8_SA(0, 1), cA + hstep, voffA);
        if (wr == 1) PG8_BAR;
        PG8_WAIT_V(4); PG8_BAR;
        PG8_STAGE(PG8_SB(1, 0), cB + kstep, voffB); PG8_STAGE(PG8_SA(1, 0), cA + kstep, voffA); PG8_STAGE(PG8_SB(1, 1), cB + hstepB + kstep, voffB);
        PG8_WAIT_V(6); PG8_BAR;
    }
    for (;;) {
        const bool has_next = S.next(ui + 1, nxt);
        const char* nA = (has_next && !GATHER) ? (const char*)g.A + (size_t)nxt.pm * tstep : cA; const char* nB = has_next ? (const char*)g.Bt + (size_t)nxt.pn * tstepB : cB; const char* nB2 = (KSPLIT && has_next) ? (const char*)g.Bt + (size_t)nxt.pn2 * tstepB : cB2;
        if constexpr (GATHER) { if (has_next) { PG8_GROWS_P(nxt); } else { PG8_GROWS_P(cur); } }
        const int tspan = Epi::MIDHOOK ? (nt >> 1) : nt;
        for (int t0 = 0; t0 < nt; t0 += tspan) {
        if constexpr (Epi::MIDHOOK) { if (t0 != 0) E.mid(acc, cur, wr, wc, fr, fq); }
        for (int t = t0; t < t0 + tspan; t += 2) {
            const bool last = (t == nt - 2);
            const char* a1 = cA + (size_t)(t + 1) * kstep;
            const char* a2 = last ? nA : cA + (size_t)(t + 2) * kstep; const char* b2 = last ? nB : ((KSPLIT && t + 2 >= (nt >> 1)) ? cB2 + (size_t)(t + 2 - (nt >> 1)) * kstep : cB + (size_t)(t + 2) * kstep);
            const char* a3 = a2 + kstep; const char* b3 = b2 + kstep;
            if (last && has_next) S.a_ready(nxt);
            if constexpr (SP2) {
            PG8_LDB(B0, 0, 0); PG8_LDB(B1, 0, 1); PG8_SCHED; PG8_LDA(At, 0, 0); PG8_STG_A(1, 1, a1, cv);
            if constexpr (GATHER) { if (last) { PG8_UNPACK_NV(); } }
            PG8_WAIT_V(8); PG8_WAIT_L(0); PG8_BAR; PG8_MMA(0, 0, At, B0); PG8_MMA(0, 1, At, B1); PG8_BAR; PG8_SCHED;
            PG8_LDA(At, 0, 1); PG8_STAGE(PG8_SB(0, 0), b2, voffB); PG8_STAGE(PG8_SB(0, 1), b2 + hstepB, voffB); PG8_STG_A(0, 0, a2, cv);
            PG8_WAIT_V(8); PG8_WAIT_L(0); PG8_BAR; PG8_MMA(1, 0, At, B0); PG8_MMA(1, 1, At, B1); PG8_BAR; PG8_SCHED;
            PG8_LDB(B0, 1, 0); PG8_LDB(B1, 1, 1); PG8_SCHED; PG8_LDA(At, 1, 0); PG8_STG_A(0, 1, a2, cv);
            PG8_WAIT_V(8); PG8_WAIT_L(0); PG8_BAR; PG8_MMA(0, 0, At, B0); PG8_MMA(0, 1, At, B1); PG8_BAR; PG8_SCHED;
            PG8_LDA(At, 1, 1); PG8_STAGE(PG8_SB(1, 0), b3, voffB); PG8_STAGE(PG8_SB(1, 1), b3 + hstepB, voffB); PG8_STG_A(1, 0, a3, cv);
            PG8_WAIT_V(8); PG8_WAIT_L(0); PG8_BAR; PG8_MMA(1, 0, At, B0); PG8_MMA(1, 1, At, B1); PG8_BAR; PG8_SCHED;
            } else {
            PG8_LDB(B0, 0, 0); PG8_SCHED; PG8_LDA(At, 0, 0); PG8_STAGE(PG8_SA(1, 1), a1 + hstep, voffA);
            PG8_WAIT_L(8); PG8_BAR; PG8_WAIT_L(0); PG8_MMA(0, 0, At, B0); PG8_BAR; PG8_SCHED;
            PG8_LDB(B1, 0, 1); PG8_STAGE(PG8_SB(0, 0), b2, voffB);
            PG8_BAR; PG8_WAIT_L(0); PG8_MMA(0, 1, At, B1); PG8_BAR;
            PG8_LDA(At, 0, 1); PG8_STAGE(PG8_SA(0, 0), a2, voffA);
            PG8_BAR; PG8_WAIT_L(0); PG8_MMA(1, 0, At, B0); PG8_BAR; PG8_SCHED;
            PG8_STAGE(PG8_SB(0, 1), b2 + hstepB, voffB);
            PG8_WAIT_V(6); PG8_BAR; PG8_MMA(1, 1, At, B1); PG8_BAR;
            PG8_LDB(B0, 1, 0); PG8_SCHED; PG8_LDA(At, 1, 0); PG8_STAGE(PG8_SA(0, 1), a2 + hstep, voffA);
            PG8_WAIT_L(8); PG8_BAR; PG8_WAIT_L(0); PG8_MMA(0, 0, At, B0); PG8_BAR; PG8_SCHED;
            PG8_LDB(B1, 1, 1); PG8_STAGE(PG8_SB(1, 0), b3, voffB);
            PG8_BAR; PG8_WAIT_L(0); PG8_MMA(0, 1, At, B1); PG8_BAR;
            PG8_LDA(At, 1, 1); PG8_STAGE(PG8_SA(1, 0), a3, voffA);
            PG8_BAR; PG8_WAIT_L(0); PG8_MMA(1, 0, At, B0); PG8_BAR; PG8_SCHED;
            PG8_STAGE(PG8_SB(1, 1), b3 + hstepB, voffB);
            PG8_WAIT_V(6); PG8_BAR; PG8_MMA(1, 1, At, B1); PG8_BAR;
            }
        }
        }
        if constexpr (ALIGN_EPI) { if (wr == 0) PG8_BAR; }
        if constexpr (!Epi::AFTER_DRAIN) { int t2 = threadIdx.x; asm volatile("" : "+v"(t2));
            const int wid2 = __builtin_amdgcn_readfirstlane(t2 >> 6), lane2 = t2 & 63; E(acc, cur, wid2 >> 2, wid2 & 3, lane2 & 15, lane2 >> 4); S.done(cur); }
        if (!has_next) break;
#pragma unroll
        for (int a = 0; a < 2; ++a)
#pragma unroll
            for (int b = 0; b < 2; ++b)
#pragma unroll
                for (int m = 0; m < 4; ++m)
#pragma unroll
                    for (int n = 0; n < 2; ++n) acc[a][b][m][n] = (f32x4){0.f, 0.f, 0.f, 0.f};
        cur = nxt; cA = nA; cB = nB; cB2 = nB2; ++ui;
        if constexpr (ALIGN_EPI) { if (wr == 1) PG8_BAR; }
    }
    PG8_WAIT_V(0);
    if constexpr (!ALIGN_EPI) { if (wr == 0) PG8_BAR; }
    PG8_BAR;
    if constexpr (Epi::AFTER_DRAIN) { E.fused(acc, cur, wr, wc, fr, fq, lds, wid, lane); S.done(cur); }
#undef PG8_SA
#undef PG8_SB
#undef PG8_STAGE
#undef PG8_LDA
#undef PG8_LDB
#undef PG8_MMA
#undef PG8_WAIT_V
#undef PG8_WAIT_L
#undef PG8_BAR
#undef PG8_SCHED
#undef PG8_STG_A
#undef PG8_GROWS
#undef PG8_GROWS_P
#undef PG8_UNPACK_NV
}
}
constexpr int BATCH = 32, SEQ = 2048, D = 1024, T = BATCH * SEQ;
constexpr int NPROJ = 2048;
constexpr int CQ = 0, CKV = 256, CPE = 384, CMQ = 416, CMK = 928, CMV = 1440, NPROJ_REAL = 1952;
constexpr int NH = 8;
constexpr float EPS = 1e-6f;
constexpr float LOG2E = 1.4426950408889634f;
constexpr float C2A = 0.10206207261596575f * LOG2E;
constexpr float C2B = 0.125f * LOG2E;
constexpr int NCLS = 112;
constexpr int LIST_CAP = 65536;

constexpr size_t MiB = 1u << 20;
constexpr size_t WS_CTL = 0, CTL_ZERO_BYTES = 2 * MiB;
constexpr size_t WS_KMEAN = 1 * MiB;
constexpr size_t WS_WIN = 2 * MiB;
constexpr size_t WS_WQ = 6 * MiB;
constexpr size_t WS_WKV = 7 * MiB;
constexpr size_t WS_WO = 8 * MiB;
constexpr size_t WS_WGU = 10 * MiB;
constexpr size_t WS_WD = 42 * MiB;
constexpr size_t WS_ROPE = 58 * MiB;
constexpr size_t WS_WRE = 59 * MiB;
constexpr size_t WS_SSQ = 60 * MiB;
constexpr size_t WS_XN = 64 * MiB;
constexpr size_t WS_VB = 192 * MiB;
constexpr size_t WS_Y0 = 64 * MiB;
constexpr size_t WS_X1B = 768 * MiB;
constexpr size_t WS_YH = 256 * MiB;
constexpr size_t WS_QB = 448 * MiB;
constexpr size_t WS_KB = 512 * MiB;
constexpr size_t WS_QA = 584 * MiB;
constexpr size_t WS_VA = 680 * MiB;
constexpr size_t WS_KA = 808 * MiB;
constexpr size_t WS_QLN = 904 * MiB;
constexpr size_t WS_KVLN = 936 * MiB;
constexpr size_t WS_LISTS = 648 * MiB;
constexpr size_t WS_OSSQ = 904 * MiB;
constexpr size_t WS_END = 1024 * MiB;
constexpr size_t WS_H = WS_KB;
constexpr int CW_TMO = 0, CW_CODE = 1;
constexpr int CW_BAR = 4096;
constexpr int CW_GCNT = 16384;

constexpr int RING_BYTES = 131072;
constexpr int P8_XT = 0, P8_XT_WAVE = 32 * 68 * 4, P8_WC = 69632, P8_WRG = 86016, P8_RT = 102400;
constexpr int LDSCTL_OFF = 155648, LDS_BYTES = 159744;
constexpr int TP_OFF = LDSCTL_OFF + 256, CNT_OFF = LDSCTL_OFF + 768, PT_OFF = LDSCTL_OFF + 1280;

#define GAS __attribute__((address_space(1)))
#define LAS __attribute__((address_space(3)))
typedef unsigned short bf16;
typedef unsigned v4u __attribute__((ext_vector_type(4)));
typedef unsigned v2u __attribute__((ext_vector_type(2)));
typedef float f32x4 __attribute__((ext_vector_type(4)));
typedef float f32x2 __attribute__((ext_vector_type(2)));
typedef float f32x16 __attribute__((ext_vector_type(16)));
typedef short bf16x8 __attribute__((ext_vector_type(8)));
typedef short s16x4 __attribute__((ext_vector_type(4)));
typedef GAS unsigned gu32;
#define RLX_AGENT __ATOMIC_RELAXED, __HIP_MEMORY_SCOPE_AGENT
__device__ __forceinline__ unsigned f2bf(float f) { unsigned u = __builtin_bit_cast(unsigned, f); return (u + 0x7fffu + ((u >> 16) & 1u)) >> 16; }
__device__ __forceinline__ unsigned pk2(float lo, float hi) { return f2bf(lo) | (f2bf(hi) << 16); }
__device__ __forceinline__ float bflo(unsigned w) { return __builtin_bit_cast(float, w << 16); }
__device__ __forceinline__ float bfhi(unsigned w) { return __builtin_bit_cast(float, w & 0xffff0000u); }
__device__ __forceinline__ float wave_sum(float v) {
#pragma unroll
    for (int o = 1; o < 64; o <<= 1) v += __shfl_xor(v, o);
    return v;
}
__device__ __forceinline__ float sum8(float v) { v += __shfl_xor(v, 1); v += __shfl_xor(v, 2); v += __shfl_xor(v, 4); return v; }

#define XB_TMO      128
#define XB_XCNT(j)  (256  + 64 * (j))
#define XB_XSUB(j)  (1280 + 64 * (j))
#define XB_XGEN(j)  (2304 + 64 * (j))
#define XB_TOP      3328
#define XB_TOPGEN   3392
#define XCD_BAR_WORDS 3456
#define XB_SPIN_CAP (1u << 18)

__device__ __forceinline__ unsigned xb_ld(unsigned* p)              { return __hip_atomic_load(p, __ATOMIC_RELAXED, __HIP_MEMORY_SCOPE_AGENT); }
__device__ __forceinline__ unsigned xb_add(unsigned* p, unsigned v) { return __hip_atomic_fetch_add(p, v, __ATOMIC_RELAXED, __HIP_MEMORY_SCOPE_AGENT); }
__device__ __forceinline__ unsigned xb_xcc_id() { return (unsigned)__builtin_amdgcn_s_getreg((3 << 11) | 20) & 0xFu; }
#define XB_SPIN(cond, bar) do { unsigned _sp = 0; while (cond) { __builtin_amdgcn_s_sleep(1); \
    if ((++_sp & 255u) == 0u) { if (xb_ld(&(bar)[XB_TMO])) break; if (_sp > XB_SPIN_CAP) { atomicAdd(&(bar)[XB_TMO], 1u); break; } } } } while (0)

struct XcdBarrier {
    unsigned* bar; unsigned x;
    volatile LAS unsigned* st;
};

__device__ __forceinline__ XcdBarrier xcd_barrier_post(unsigned* bar, volatile LAS unsigned* st) {
    XcdBarrier b; b.bar = bar; b.x = xb_xcc_id(); b.st = st;
    if (threadIdx.x == 0) (void)xb_add(&bar[XB_XCNT(b.x)], 1u);
    return b;
}
__device__ __forceinline__ void xcd_barrier_complete(unsigned* bar, unsigned x, unsigned& nloc, unsigned& nx) {
    const unsigned G = gridDim.x * gridDim.y * gridDim.z;
    unsigned sum, cnt, mine, sp = 0u;
    for (;;) {
        sum = 0u; cnt = 0u; mine = 0u;
#pragma unroll
        for (unsigned j = 0; j < 16; ++j) { const unsigned c = xb_ld(&bar[XB_XCNT(j)]); sum += c; cnt += (c > 0u) ? 1u : 0u; mine = (j == x) ? c : mine; }
        if (sum == G) break;
        __builtin_amdgcn_s_sleep(1);
        if ((++sp & 255u) == 0u) { if (xb_ld(&bar[XB_TMO])) break; if (sp > XB_SPIN_CAP) { atomicAdd(&bar[XB_TMO], 1u); break; } }
    }
    nloc = mine > 0u ? mine : 1u; nx = cnt > 0u ? cnt : 1u;
}

__device__ __forceinline__ void xcd_barrier(const XcdBarrier& b) {
    asm volatile("s_waitcnt vmcnt(0)" ::: "memory");
    __syncthreads();
    if (threadIdx.x == 0) {
        unsigned* bar = b.bar;
        __builtin_amdgcn_s_waitcnt(0);
        unsigned nloc = b.st[0], nx = b.st[1];
        if (nloc == 0u) { xcd_barrier_complete(bar, b.x, nloc, nx); b.st[0] = nloc; b.st[1] = nx; }
        const unsigned old = xb_add(&bar[XB_XSUB(b.x)], 1u);
        const unsigned gen = old / nloc;
        if (old + 1u == (gen + 1u) * nloc) {
            __builtin_amdgcn_fence(__ATOMIC_RELEASE, "agent");
            asm volatile("s_waitcnt vmcnt(0)" ::: "memory");
            const unsigned og = xb_add(&bar[XB_TOP], 1u);
            const unsigned tg = og / nx;
            if (og + 1u == (tg + 1u) * nx) xb_add(&bar[XB_TOPGEN], 1u);
            else XB_SPIN(xb_ld(&bar[XB_TOPGEN]) == tg, bar);
            __builtin_amdgcn_fence(__ATOMIC_ACQUIRE, "agent");
            xb_add(&bar[XB_XGEN(b.x)], 1u);
            asm volatile("s_waitcnt vmcnt(0)" ::: "memory");
        } else {
            XB_SPIN(xb_ld(&bar[XB_XGEN(b.x)]) == gen, bar);
            __builtin_amdgcn_fence(__ATOMIC_ACQUIRE, "agent");
            asm volatile("s_waitcnt vmcnt(0)" ::: "memory");
        }
    }
    __syncthreads();
}


__device__ __forceinline__ float att_max3(float a, float b, float c) { float r; asm("v_max3_f32 %0, %1, %2, %3" : "=v"(r) : "v"(a), "v"(b), "v"(c)); return r; }
__device__ __forceinline__ unsigned pk4_fp8(float a, float b, float c, float d) { int w = 0; w = __builtin_amdgcn_cvt_pk_fp8_f32(a, b, w, false); w = __builtin_amdgcn_cvt_pk_fp8_f32(c, d, w, true); return (unsigned)w; }
struct AttOwn { static constexpr bool v = true; }; struct AttPast { static constexpr bool v = false; };
template <int DQK, bool MOBA, bool QFIN>
__device__ __forceinline__ void attn_unit(LAS unsigned char* lds, const float* qgain_, const float* ropeR_, const bf16* Qg_, int qpitch, const bf16* Kg_, int kpitch, const bf16* Vg_, int vpitch, bf16* Og_, int opitch, float* ossq_, int qb, const float* kmp_, int kmstride) {
    const GAS bf16* Qg = (const GAS bf16*)Qg_; const GAS bf16* Kg = (const GAS bf16*)Kg_; const GAS bf16* Vg = (const GAS bf16*)Vg_; GAS bf16* Og = (GAS bf16*)Og_; const GAS float* kmp = (const GAS float*)kmp_;
    constexpr int ND = DQK / 16, KSTR = DQK * 2 + 16, KBUF = 64 * KSTR, NCH = DQK / 8, VBUF = 8192;
    int tid = threadIdx.x; asm volatile("" : "+v"(tid));
    const int lane = tid & 63, r32 = lane & 31, hi = lane >> 5; const int wid = __builtin_amdgcn_readfirstlane(tid >> 6);
    LAS unsigned char* Kl = lds; LAS unsigned char* Vl = lds + 2 * KBUF;
    const GAS bf16* qrow = Qg + (size_t)(qb * 256 + wid * 32 + r32) * qpitch;
    bf16x8 qf[ND];
#pragma unroll
    for (int d0 = 0; d0 < ND; ++d0) qf[d0] = *(const GAS bf16x8*)(qrow + 16 * d0 + 8 * hi);
    if (QFIN) {
        const GAS float* qg = (const GAS float*)qgain_; const GAS float* rr = (const GAS float*)ropeR_; const int pos = qb * 256 + wid * 32 + r32;
        float x[ND][8]; float ss = 0.f;
#pragma unroll
        for (int d0 = 0; d0 < ND; ++d0) { const v4u w = __builtin_bit_cast(v4u, qf[d0]);
            x[d0][0] = bflo(w.x); x[d0][1] = bfhi(w.x); x[d0][2] = bflo(w.y); x[d0][3] = bfhi(w.y); x[d0][4] = bflo(w.z); x[d0][5] = bfhi(w.z); x[d0][6] = bflo(w.w); x[d0][7] = bfhi(w.w);
#pragma unroll
            for (int j = 0; j < 8; ++j) ss += x[d0][j] * x[d0][j]; }
        ss += __shfl_xor(ss, 32);
        const float rs = (1.0f / sqrtf(ss * (1.0f / (float)DQK) + EPS)) * C2A;
#pragma unroll
        for (int d0 = 0; d0 < ND; ++d0) { const f32x4 ga = *(const GAS f32x4*)(qg + 16 * d0 + 8 * hi), gb = *(const GAS f32x4*)(qg + 16 * d0 + 8 * hi + 4);
#pragma unroll
            for (int j = 0; j < 4; ++j) { x[d0][j] *= rs * ga[j]; x[d0][4 + j] *= rs * gb[j]; } }
        if (ND == 6) { const f32x4 ca = *(const GAS f32x4*)(rr + pos * 16 + 8 * hi), cb = *(const GAS f32x4*)(rr + pos * 16 + 8 * hi + 4), sa = *(const GAS f32x4*)(rr + SEQ * 16 + pos * 16 + 8 * hi), sb = *(const GAS f32x4*)(rr + SEQ * 16 + pos * 16 + 8 * hi + 4);
#pragma unroll
            for (int j = 0; j < 8; ++j) { const float c = j < 4 ? ca[j & 3] : cb[j & 3], s = j < 4 ? sa[j & 3] : sb[j & 3]; const float y1 = x[ND - 2][j], y2 = x[ND - 1][j]; x[ND - 2][j] = y1 * c - y2 * s; x[ND - 1][j] = y2 * c + y1 * s; } }
#pragma unroll
        for (int d0 = 0; d0 < ND; ++d0) { v4u w; w.x = pg8::cvt_pk_bf16(x[d0][0], x[d0][1]); w.y = pg8::cvt_pk_bf16(x[d0][2], x[d0][3]); w.z = pg8::cvt_pk_bf16(x[d0][4], x[d0][5]); w.w = pg8::cvt_pk_bf16(x[d0][6], x[d0][7]); qf[d0] = __builtin_bit_cast(bf16x8, w); }
    }
    unsigned sel = 0xffu;
    if (MOBA && qb > 3) {
        float gate[8];
#pragma unroll
        for (int n = 0; n < 8; ++n) { float a = 0.f;
            if (n < qb) {
#pragma unroll
                for (int d0 = 0; d0 < ND; ++d0) { const GAS float* km = kmp + (size_t)n * kmstride + 16 * d0 + 8 * hi; const f32x4 k0 = *(const GAS f32x4*)km, k1 = *(const GAS f32x4*)(km + 4);
                    const v4u qq = __builtin_bit_cast(v4u, qf[d0]);
                    a += bflo(qq.x) * k0[0] + bfhi(qq.x) * k0[1] + bflo(qq.y) * k0[2] + bfhi(qq.y) * k0[3] + bflo(qq.z) * k1[0] + bfhi(qq.z) * k1[1] + bflo(qq.w) * k1[2] + bfhi(qq.w) * k1[3]; }
                a += __shfl_xor(a, 32); }
            gate[n] = a; asm volatile("" : "+v"(a) :: "memory"); }
        sel = 0u;
#pragma unroll
        for (int n = 0; n < 8; ++n) { int rank = 0;
#pragma unroll
            for (int mm = 0; mm < 8; ++mm) { if (mm != n) { const bool before = (gate[mm] > gate[n]) || (gate[mm] == gate[n] && mm < n); rank += (mm < qb && before) ? 1 : 0; } }
            if (n < qb && rank < 3) sel |= (1u << n); }
    }
    const int krow = (DQK == 64) ? (tid >> 3) : (tid / 12), kch = (DQK == 64) ? (tid & 7) : (tid % 12);
    const int krow2 = (tid + 512) / 12, kch2 = (tid + 512) % 12; const bool k2 = (DQK == 96) && (tid < 256);
    const int vrow = tid >> 3, vch = tid & 7;
    const unsigned kst = (unsigned)(krow * KSTR + kch * 16), kst2 = (unsigned)(krow2 * KSTR + kch2 * 16);
    const unsigned vst = (unsigned)((vch >> 2) * 4096 + (vrow >> 4) * 1024 + ((vrow >> 3) & 1) * 512 + (vrow & 7) * 64 + (vch & 3) * 16);
    const int NT = 4 * (qb + 1);
    auto tile_row0 = [&](int p) -> int { return (p < 4) ? (qb * 256 + p * 64) : ((p - 4) * 64); };
    v4u kreg, kreg2 = {0u, 0u, 0u, 0u}, vreg;
    { const int r0 = tile_row0(0);
      kreg = *(const GAS v4u*)(Kg + (size_t)(r0 + krow) * kpitch + kch * 8); if (k2) kreg2 = *(const GAS v4u*)(Kg + (size_t)(r0 + krow2) * kpitch + kch2 * 8);
      vreg = *(const GAS v4u*)(Vg + (size_t)(r0 + vrow) * vpitch + vch * 8);
      *(LAS v4u*)(Kl + kst) = kreg; if (k2) *(LAS v4u*)(Kl + kst2) = kreg2; *(LAS v4u*)(Vl + vst) = vreg; }
    __syncthreads();
    float m_run = 0.f, l_run = 0.f; f32x16 o0 = {}, o1 = {};
    f32x16 cuse = {}; bool cdirty = true;
    f32x16 negm = {};
    constexpr float THR = 8.0f;
    const int qrel = wid * 32 + r32;
    const unsigned kfo = (unsigned)(r32 * KSTR + hi * 16);
    const unsigned vfo = (unsigned)(((lane >> 4) & 1) * 32 + (lane & 3) * 8 + (4 * hi + ((lane & 15) >> 2)) * 64);
    auto slot = [&](const int p, auto own_) { constexpr bool OWN = decltype(own_)::v;
        const int cb = p & 1;
        if (p + 1 < NT) { const int r0 = tile_row0(p + 1);
            kreg = *(const GAS v4u*)(Kg + (size_t)(r0 + krow) * kpitch + kch * 8); if (k2) kreg2 = *(const GAS v4u*)(Kg + (size_t)(r0 + krow2) * kpitch + kch2 * 8);
            vreg = *(const GAS v4u*)(Vg + (size_t)(r0 + vrow) * vpitch + vch * 8); }
        const bool need = OWN ? !(p > (wid >> 1)) : true;
        if (need) {
            const LAS unsigned char* Kb = Kl + cb * KBUF + kfo; const LAS unsigned char* Vb = Vl + cb * VBUF + vfo;
            f32x16 s0 = negm, s1 = negm;
            if constexpr (!OWN && MOBA) {
                if (cdirty || (p & 3) == 0) { const bool on = ((sel >> ((p - 4) >> 2)) & 1u) != 0u;
#pragma unroll
                    for (int r = 0; r < 16; ++r) cuse[r] = on ? negm[r] : -1.0e30f;
                    cdirty = false; }
                s0 = cuse; s1 = cuse; }
            bf16x8 kf[2 * ND];
#pragma unroll
            for (int d0 = 0; d0 < ND; ++d0) { kf[2 * d0] = *(const LAS bf16x8*)(Kb + d0 * 32); kf[2 * d0 + 1] = *(const LAS bf16x8*)(Kb + 32 * KSTR + d0 * 32); }
            __builtin_amdgcn_sched_barrier(0);
#pragma unroll
            for (int d0 = 0; d0 < ND; ++d0) { s0 = __builtin_amdgcn_mfma_f32_32x32x16_bf16(kf[2 * d0], qf[d0], s0, 0, 0, 0); s1 = __builtin_amdgcn_mfma_f32_32x32x16_bf16(kf[2 * d0 + 1], qf[d0], s1, 0, 0, 0); }
            s16x4 vt[16];
#pragma unroll
            for (int v = 0; v < 16; ++v) vt[v] = __builtin_bit_cast(s16x4, __builtin_amdgcn_ds_read_tr16_b64_v4i16((LAS s16x4*)(Vb + (v >> 2) * 1024 + ((v >> 1) & 1) * 4096 + (v & 1) * 512)));
            __builtin_amdgcn_sched_barrier(0);
            if constexpr (OWN) { const int kb = 64 * p + 4 * hi;
#pragma unroll
                for (int r = 0; r < 16; ++r) { const int kv = kb + (r & 3) + 8 * (r >> 2); if (kv > qrel) s0[r] = -INFINITY; if (kv + 32 > qrel) s1[r] = -INFINITY; } }
            float ra = att_max3(s0[0], s0[1], s1[0]), rb = att_max3(s0[2], s0[3], s1[1]); ra = att_max3(ra, s1[2], s1[3]);
#pragma unroll
            for (int r = 4; r < 16; r += 4) { ra = att_max3(ra, s0[r], s0[r + 1]); rb = att_max3(rb, s0[r + 2], s0[r + 3]); ra = att_max3(ra, s1[r], s1[r + 1]); rb = att_max3(rb, s1[r + 2], s1[r + 3]); }
            float rm = fmaxf(ra, rb); rm = fmaxf(rm, __shfl_xor(rm, 32));
            if ((OWN && p == 0) || __any(rm > THR)) {
                const float dl = (OWN && p == 0) ? rm : fmaxf(rm, 0.f); m_run += dl;
                const float fsc = __builtin_amdgcn_exp2f(-dl); l_run *= fsc;
#pragma unroll
                for (int r = 0; r < 16; ++r) { s0[r] -= dl; s1[r] -= dl; o0[r] *= fsc; o1[r] *= fsc; negm[r] = -m_run; }
                cdirty = true;
            }
            float rs0 = 0.f, rs1 = 0.f;
#pragma unroll
            for (int r = 0; r < 16; ++r) { s0[r] = __builtin_amdgcn_exp2f(s0[r]); s1[r] = __builtin_amdgcn_exp2f(s1[r]); rs0 += s0[r]; rs1 += s1[r]; }
            l_run += rs0 + rs1;
            bf16x8 pf[4];
#pragma unroll
            for (int s = 0; s < 2; ++s) { v4u a, b;
                a.x = pg8::cvt_pk_bf16(s0[8 * s + 0], s0[8 * s + 1]); a.y = pg8::cvt_pk_bf16(s0[8 * s + 2], s0[8 * s + 3]); a.z = pg8::cvt_pk_bf16(s0[8 * s + 4], s0[8 * s + 5]); a.w = pg8::cvt_pk_bf16(s0[8 * s + 6], s0[8 * s + 7]);
                b.x = pg8::cvt_pk_bf16(s1[8 * s + 0], s1[8 * s + 1]); b.y = pg8::cvt_pk_bf16(s1[8 * s + 2], s1[8 * s + 3]); b.z = pg8::cvt_pk_bf16(s1[8 * s + 4], s1[8 * s + 5]); b.w = pg8::cvt_pk_bf16(s1[8 * s + 6], s1[8 * s + 7]);
                pf[s] = __builtin_bit_cast(bf16x8, a); pf[2 + s] = __builtin_bit_cast(bf16x8, b); }
#pragma unroll
            for (int s = 0; s < 4; ++s) {
                const bf16x8 va = (bf16x8){vt[4 * s][0], vt[4 * s][1], vt[4 * s][2], vt[4 * s][3], vt[4 * s + 1][0], vt[4 * s + 1][1], vt[4 * s + 1][2], vt[4 * s + 1][3]};
                const bf16x8 vb = (bf16x8){vt[4 * s + 2][0], vt[4 * s + 2][1], vt[4 * s + 2][2], vt[4 * s + 2][3], vt[4 * s + 3][0], vt[4 * s + 3][1], vt[4 * s + 3][2], vt[4 * s + 3][3]};
                o0 = __builtin_amdgcn_mfma_f32_32x32x16_bf16(va, pf[s], o0, 0, 0, 0);
                o1 = __builtin_amdgcn_mfma_f32_32x32x16_bf16(vb, pf[s], o1, 0, 0, 0); }
        }
        if (p + 1 < NT) { const int nb = cb ^ 1;
            *(LAS v4u*)(Kl + nb * KBUF + kst) = kreg; if (k2) *(LAS v4u*)(Kl + nb * KBUF + kst2) = kreg2; *(LAS v4u*)(Vl + nb * VBUF + vst) = vreg; }
        __syncthreads();
        __syncthreads();
    };
    for (int p = 0; p < 4; ++p) slot(p, AttOwn{});
    for (int p = 4; p < NT; ++p) slot(p, AttPast{});
    l_run += __shfl_xor(l_run, 32);
    const float rl = 1.0f / l_run;
    { float ss = 0.f;
#pragma unroll
      for (int r = 0; r < 16; ++r) { const float a = o0[r] * rl, b = o1[r] * rl; ss += a * a + b * b; }
      ss += __shfl_xor(ss, 32);
      if (hi == 0) ((GAS float*)ossq_)[(size_t)(qb * 256 + wid * 32 + r32) * 16] = ss; }
    LAS unsigned char* stg = lds + 65536 + wid * 4608; const float rl16 = rl * 16.0f;
#pragma unroll
    for (int g = 0; g < 4; ++g) {
        *(LAS unsigned*)(stg + r32 * 80 + (8 * g + 4 * hi)) = pk4_fp8(o0[4 * g] * rl16, o0[4 * g + 1] * rl16, o0[4 * g + 2] * rl16, o0[4 * g + 3] * rl16);
        *(LAS unsigned*)(stg + r32 * 80 + (32 + 8 * g + 4 * hi)) = pk4_fp8(o1[4 * g] * rl16, o1[4 * g + 1] * rl16, o1[4 * g + 2] * rl16, o1[4 * g + 3] * rl16); }
    asm volatile("s_waitcnt lgkmcnt(0)" ::: "memory");
    GAS unsigned char* obase = (GAS unsigned char*)Og + (size_t)(qb * 256 + wid * 32) * opitch;
#pragma unroll
    for (int i = 0; i < 2; ++i) { const int row = i * 16 + (lane >> 2), ch = lane & 3; const v4u v = *(const LAS v4u*)(stg + row * 80 + ch * 16); *(GAS v4u*)(obase + (size_t)row * opitch + ch * 16) = v; }
    asm volatile("s_waitcnt lgkmcnt(0)" ::: "memory");
}

__device__ __forceinline__ void transpose_item(const float* W_, int ldw, bf16* WT, int ldt, int k0, int n0, int dr0, int dr1, LAS float* scr, int lane, const float* kgain = nullptr) {
    const GAS float* W = (const GAS float*)W_; const int q = lane & 15, kr = lane >> 4; const bool ld_ok = (q < 8) ? (dr0 >= 0) : (dr1 >= 0);
#pragma unroll 4
    for (int i = 0; i < 16; ++i) { const int kk = 4 * i + kr; f32x4 v = {0.f, 0.f, 0.f, 0.f}; if (ld_ok) v = *(const GAS f32x4*)(W + (size_t)(k0 + kk) * ldw + n0 + 4 * q);
        if (kgain) v = v * ((const GAS float*)kgain)[k0 + kk];
        LAS float* s = scr + kk * 65 + 4 * q; s[0] = v[0]; s[1] = v[1]; s[2] = v[2]; s[3] = v[3]; }
    asm volatile("s_waitcnt lgkmcnt(0)" ::: "memory");
    const int c = lane & 7;
#pragma unroll
    for (int j = 0; j < 8; ++j) { const int n = 8 * j + (lane >> 3); const LAS float* s = scr + (8 * c) * 65 + n; const int dr = (n < 32) ? dr0 : dr1;
        v4u o; o.x = pk2(s[0 * 65], s[1 * 65]); o.y = pk2(s[2 * 65], s[3 * 65]); o.z = pk2(s[4 * 65], s[5 * 65]); o.w = pk2(s[6 * 65], s[7 * 65]);
        if (dr >= 0) *(GAS v4u*)(WT + (size_t)(dr + (n & 31)) * ldt + k0 + 8 * c) = o; }
    asm volatile("s_waitcnt lgkmcnt(0)" ::: "memory");
}

__device__ __forceinline__ void transpose_item8(const float* W_, int ldw, unsigned char* WT8, int ldt, int k0, int n0, int dr0, int dr1, LAS float* scr, int lane, float scale, const float* kgain = nullptr) {
    const GAS float* W = (const GAS float*)W_; const int q = lane & 15, kr = lane >> 4; const bool ld_ok = (q < 8) ? (dr0 >= 0) : (dr1 >= 0);
#pragma unroll 4
    for (int i = 0; i < 16; ++i) { const int kk = 4 * i + kr; f32x4 v = {0.f, 0.f, 0.f, 0.f}; if (ld_ok) v = *(const GAS f32x4*)(W + (size_t)(k0 + kk) * ldw + n0 + 4 * q);
        if (kgain) v = v * ((const GAS float*)kgain)[k0 + kk];
        v = v * scale;
        LAS float* s = scr + kk * 65 + 4 * q; s[0] = v[0]; s[1] = v[1]; s[2] = v[2]; s[3] = v[3]; }
    asm volatile("s_waitcnt lgkmcnt(0)" ::: "memory");
    const int c = lane & 7;
#pragma unroll
    for (int j = 0; j < 8; ++j) { const int n = 8 * j + (lane >> 3); const LAS float* s = scr + (8 * c) * 65 + n; const int dr = (n < 32) ? dr0 : dr1;
        v2u o; o.x = pk4_fp8(s[0 * 65], s[1 * 65], s[2 * 65], s[3 * 65]); o.y = pk4_fp8(s[4 * 65], s[5 * 65], s[6 * 65], s[7 * 65]);
        if (dr >= 0) *(GAS v2u*)((GAS unsigned char*)WT8 + (size_t)(dr + (n & 31)) * ldt + k0 + 8 * c) = o; }
    asm volatile("s_waitcnt lgkmcnt(0)" ::: "memory");
}

struct Args {
    const float* x; const float* attn_g; const float* w_in; const float* qlat_g; const float* w_qup; const float* kvlat_g; const float* w_kvup;
    const float* qhead_g; const float* khead_g; const float* mqhead_g; const float* mkhead_g; const float* onorm_a_g; const float* onorm_b_g; const float* w_out;
    const float* ffn_g; const float* w_rg; const float* b_rg; const float* w_re; const float* b_re; const float* w_gate; const float* w_up; const float* w_down;
    float* out; unsigned char* ws; int ph_lo, ph_hi;
};
enum { PH_PRO = 0, PH_PROJ, PH_UP, PH_ATTN, PH_OUT, PH_ROUTE, PH_GU, PH_D0, NPHASE };

__global__ void __launch_bounds__(512, 2) mk_fwd(Args A) {
    extern __shared__ __attribute__((aligned(16))) unsigned char lds_raw[];
    LAS unsigned char* lds = (LAS unsigned char*)lds_raw;
    const int tid0 = threadIdx.x;
    const int G = gridDim.x, bx = blockIdx.x;
#define NGW (G * 8)
#define PH_BEGIN int tid = threadIdx.x; asm volatile("" : "+v"(tid)); const int lane = tid & 63; const int wave = __builtin_amdgcn_readfirstlane(tid >> 6); const int gw = bx * 8 + wave; \
    const __attribute__((address_space(4))) Args* AP = (const __attribute__((address_space(4))) Args*)__builtin_amdgcn_kernarg_segment_ptr(); asm volatile("" : "+s"(AP)); \
    unsigned char* ws = AP->ws; (void)lane; (void)gw; (void)ws;
#define Win_t ((bf16*)(ws + WS_WIN))
#define Wq_t ((bf16*)(ws + WS_WQ))
#define Wkv_t ((bf16*)(ws + WS_WKV))
#define Wo_t ((bf16*)(ws + WS_WO))
#define Wgu_t ((bf16*)(ws + WS_WGU))
#define Wd_t ((bf16*)(ws + WS_WD))
#define ropeF ((float*)(ws + WS_ROPE))
#define ropeR (((float*)(ws + WS_ROPE)) + 2 * SEQ * 32)
#define kmean ((float*)(ws + WS_KMEAN))
#define XN ((bf16*)(ws + WS_XN))
#define X1B ((bf16*)(ws + WS_X1B))
#define VB ((bf16*)(ws + WS_VB))
#define YH ((bf16*)(ws + WS_YH))
#define Y0B ((bf16*)(ws + WS_Y0))
#define SSQ ((float*)(ws + WS_SSQ))
#define WREF ((float*)(ws + WS_WRE))
#define WRGF ((float*)(ws + WS_WRE + 131072))
#define OSSQ ((float*)(ws + WS_OSSQ))
#define QB ((bf16*)(ws + WS_QB))
#define KB ((bf16*)(ws + WS_KB))
#define QA ((bf16*)(ws + WS_QA))
#define VA ((bf16*)(ws + WS_VA))
#define KA ((bf16*)(ws + WS_KA))
#define QLN ((bf16*)(ws + WS_QLN))
#define KVLN ((bf16*)(ws + WS_KVLN))
#define HB ((bf16*)(ws + WS_H))
#define lists ((pg8::ListEnt*)(ws + WS_LISTS))
    volatile LAS unsigned* MISC = (volatile LAS unsigned*)(lds + LDSCTL_OFF);
    for (int u = tid0; u < (LDS_BYTES - LDSCTL_OFF) / 4; u += 512) ((LAS unsigned*)(lds + LDSCTL_OFF))[u] = 0u;
    __syncthreads();
    XcdBarrier bar = xcd_barrier_post((unsigned*)((gu32*)(A.ws + WS_CTL) + CW_BAR), MISC + 8);
    const int lo = A.ph_lo, hi = A.ph_hi;
#define IN(k) (lo <= (k) && (k) < hi)
#define MOE_SLOT(npn) ((G == 256) ? ((((bx >> 3) / (npn)) * 8 + (bx & 7)) * (npn) + ((bx >> 3) % (npn))) : bx)
#define SEAM(k) do { if (IN(k) && IN((k) + 1)) xcd_barrier(bar); } while (0)

    if (IN(PH_PRO)) { PH_BEGIN
        LAS float* scr = (LAS float*)(lds + wave * 16640);
        constexpr int I_IN = 16 * 31, I_QU = 4 * 12, I_KV = 2 * 16, I_WO = 16 * 16, I_G = 32 * 64, I_U = 32 * 64, I_D = 32 * 64;
        constexpr int NITEMS = I_IN + I_QU + I_KV + I_WO + I_G + I_U + I_D;
        for (int it = gw; it < NITEMS; it += NGW) {
            int r = it;
            if (r < I_IN) { const int kb = r / 31, nb = r % 31; int dr[2];
#pragma unroll
                for (int h2 = 0; h2 < 2; ++h2) { const int gi = 2 * nb + h2;
                    if (gi < 13) dr[h2] = 32 * gi; else if (gi < 45) { const int q = (gi - 13) & 15, hh = q >> 1, bj = q & 1; dr[h2] = (gi < 29 ? 512 : 1024) + (hh >> 2) * 256 + bj * 128 + (hh & 3) * 32; } else if (gi < 61) dr[h2] = 1536 + (gi - 45) * 32; else dr[h2] = -1; }
                transpose_item(AP->w_in, NPROJ_REAL, Win_t, 1024, 64 * kb, 64 * nb, dr[0], dr[1], scr, lane); continue; } r -= I_IN;
            if (r < I_QU) { const int kb = r / 12, nb = r % 12; transpose_item(AP->w_qup, 768, Wq_t, 256, 64 * kb, 64 * nb, 64 * nb, 64 * nb + 32, scr, lane, AP->qlat_g); continue; } r -= I_QU;
            if (r < I_KV) { const int kb = r / 16, nb = r % 16; const int n0 = 64 * nb, hh = n0 >> 7, j0 = n0 & 127;
                const int d0 = (j0 < 64) ? ((hh >> 2) * 256 + (hh & 3) * 32) : (512 + hh * 64), d1 = (j0 < 64) ? (d0 + 128) : (d0 + 32);
                transpose_item(AP->w_kvup, 1024, Wkv_t, 256, 64 * kb, n0, d0, d1, scr, lane, AP->kvlat_g); continue; } r -= I_KV;
            if (r < I_WO) { const int kb = r / 16, nb = r % 16; transpose_item8(AP->w_out, 1024, (unsigned char*)Wo_t, 1024, 64 * kb, 64 * nb, 64 * nb, 64 * nb + 32, scr, lane, 32.0f, kb < 8 ? AP->onorm_a_g : AP->onorm_b_g - 512); continue; } r -= I_WO;
            if (r < I_G) { const int e = r >> 6, r2 = r & 63, kb = r2 >> 2, nb = r2 & 3; const int n0 = 64 * nb; const int d0 = (n0 >> 7) * 256 + (n0 & 127);
                transpose_item8(AP->w_gate + (size_t)e * 1024 * 256, 256, (unsigned char*)Wgu_t + (size_t)e * 512 * 1024, 1024, 64 * kb, n0, d0, d0 + 32, scr, lane, 32.0f); continue; } r -= I_G;
            if (r < I_U) { const int e = r >> 6, r2 = r & 63, kb = r2 >> 2, nb = r2 & 3; const int n0 = 64 * nb; const int d0 = (n0 >> 7) * 256 + 128 + (n0 & 127);
                transpose_item8(AP->w_up + (size_t)e * 1024 * 256, 256, (unsigned char*)Wgu_t + (size_t)e * 512 * 1024, 1024, 64 * kb, n0, d0, d0 + 32, scr, lane, 32.0f); continue; } r -= I_U;
            { const int e = r >> 6, r2 = r & 63, kb = r2 >> 4, nb = r2 & 15;
                transpose_item8(AP->w_down + (size_t)e * 256 * 1024, 1024, (unsigned char*)Wd_t + (size_t)e * 1024 * 256, 256, 64 * kb, 64 * nb, 64 * nb, 64 * nb + 32, scr, lane, 16.0f); }
        }
        const int gt = bx * 512 + tid, NGT = G * 512;
        for (int i = gt; i < 96 * 128; i += NGT) *(GAS v4u*)(Win_t + (size_t)416 * 1024 + (size_t)i * 8) = (v4u){0u, 0u, 0u, 0u};
        for (int i = gt; i < 1024 * 16; i += NGT) *(GAS v4u*)(Wkv_t + (size_t)(i >> 4) * 256 + 128 + (i & 15) * 8) = (v4u){0u, 0u, 0u, 0u};
        for (int i = gt; i < SEQ * 48; i += NGT) {
            const int pos = i / 48, f = i % 48; const bool isF = f < 32; const int ff = isF ? f : f - 32;
            const double e = isF ? (double)ff / 32.0 : (double)ff / 16.0;
            const float invf = (float)exp2(-e * 13.287712379549449);
            const float ang = (float)pos * invf;
            const double a = (double)ang; const double kk = rint(a * 0.15915494309189535); const double rr = a - kk * 6.283185307179586;
            const float c = (float)cos(rr), s = (float)sin(rr);
            GAS float* rF = (GAS float*)ropeF; GAS float* rR = (GAS float*)ropeR;
            if (isF) { rF[pos * 32 + ff] = c; rF[SEQ * 32 + pos * 32 + ff] = s; } else { rR[pos * 16 + ff] = c; rR[SEQ * 16 + pos * 16 + ff] = s; }
        }
        for (int i = gt; i < 1024 * 8; i += NGT) { const float gk = AP->ffn_g[i >> 3]; *((GAS f32x4*)WREF + i) = *((const GAS f32x4*)AP->w_re + i) * gk; }
        for (int i = gt; i < 1024; i += NGT) { const float gk = AP->ffn_g[i]; *((GAS f32x4*)WRGF + i) = *((const GAS f32x4*)AP->w_rg + i) * gk; }
        for (int t = gw; t < T; t += 2 * NGW) {
            const int t2 = (t + NGW < T) ? t + NGW : t;
            const GAS f32x4* xr = (const GAS f32x4*)(AP->x + (size_t)t * D) + lane; const GAS f32x4* xr2 = (const GAS f32x4*)(AP->x + (size_t)t2 * D) + lane; f32x4 v[4], w[4]; float s = 0.f, s2 = 0.f;
#pragma unroll
            for (int j = 0; j < 4; ++j) { v[j] = xr[64 * j]; w[j] = xr2[64 * j]; }
#pragma unroll
            for (int j = 0; j < 4; ++j) { s += (v[j].x * v[j].x + v[j].y * v[j].y) + (v[j].z * v[j].z + v[j].w * v[j].w); s2 += (w[j].x * w[j].x + w[j].y * w[j].y) + (w[j].z * w[j].z + w[j].w * w[j].w); }
            const float rstd = 1.0f / sqrtf(wave_sum(s) * (1.f / D) + EPS), rstd2 = 1.0f / sqrtf(wave_sum(s2) * (1.f / D) + EPS);
            GAS unsigned long long* o8 = (GAS unsigned long long*)(XN + (size_t)t * D) + lane; GAS unsigned long long* o82 = (GAS unsigned long long*)(XN + (size_t)t2 * D) + lane;
#pragma unroll
            for (int j = 0; j < 4; ++j) { const f32x4 g = *((const GAS f32x4*)AP->attn_g + lane + 64 * j);
                o8[64 * j] = (unsigned long long)pk2(v[j].x * rstd * g.x, v[j].y * rstd * g.y) | ((unsigned long long)pk2(v[j].z * rstd * g.z, v[j].w * rstd * g.w) << 32);
                o82[64 * j] = (unsigned long long)pk2(w[j].x * rstd2 * g.x, w[j].y * rstd2 * g.y) | ((unsigned long long)pk2(w[j].z * rstd2 * g.z, w[j].w * rstd2 * g.w) << 32); }
        }
    }
    SEAM(PH_PRO);

    if (IN(PH_PROJ)) { PH_BEGIN
        pg8::Gemm g{XN, Win_t, T, NPROJ, D}; pg8::StaticOrder S; S.init(T, NPROJ, G, bx);
        pg8::EpiProj E{ws, WS_QLN, WS_KVLN, WS_QB, WS_KB, WS_VB, WS_SSQ, WS_KMEAN, WS_ROPE, AP->mqhead_g, AP->mkhead_g, C2B, EPS, SEQ};
        pg8::gemm_phase<pg8::EpiProj, pg8::StaticOrder, true, true>(lds, g, S, E);
    }
    SEAM(PH_PROJ);

    if (IN(PH_UP)) { PH_BEGIN
        { int K256 = 256; asm volatile("" : "+s"(K256)); pg8::Gemm g{QLN, Wq_t, T, 768, K256}; pg8::StaticOrder S; S.init(T, 768, G, bx); pg8::EpiBf16Rs E{QA, 768, SSQ, 0, 1.0f / 256.0f, EPS};
          pg8::gemm_phase<pg8::EpiBf16Rs, pg8::StaticOrder, true, true>(lds, g, S, E); }
        { int K256 = 256; asm volatile("" : "+s"(K256)); pg8::Gemm g{KVLN, Wkv_t, T, 1024, K256}; pg8::StaticOrder S; S.init(T, 1024, G, bx); pg8::EpiKv E{KA, VA, KVLN, SSQ, ropeR, AP->khead_g, EPS, SEQ};
          pg8::gemm_phase<pg8::EpiKv, pg8::StaticOrder, true, true>(lds, g, S, E); }
    }
    SEAM(PH_UP);

    if (IN(PH_ATTN)) { PH_BEGIN
        bf16* O = XN;
        for (int u = bx; u < 512; u += G) {
            const int bh = u & 255, b = bh >> 3, h = bh & 7; const size_t r0 = (size_t)b * SEQ;
            if (u < 256) {
                for (int qb = 7; qb >= 0; --qb)
                    attn_unit<96, false, true>(lds, AP->qhead_g, ropeR, QA + r0 * 768 + h * 96, 768, KA + r0 * 768 + h * 96, 768, VA + r0 * 512 + h * 64, 512, (bf16*)((unsigned char*)O + r0 * 1024 + h * 64), 1024, OSSQ + r0 * 16 + h, qb, nullptr, 0);
            } else {
                for (int qb = 7; qb >= 0; --qb)
                    attn_unit<64, true, false>(lds, nullptr, nullptr, QB + r0 * 512 + h * 64, 512, KB + r0 * 512 + h * 64, 512, VB + r0 * 512 + h * 64, 512, (bf16*)((unsigned char*)O + r0 * 1024 + 512 + h * 64), 1024, OSSQ + r0 * 16 + 8 + h, qb, kmean + ((size_t)b * 8 * NH + h) * 64, NH * 64);
            }
        }
    }
    SEAM(PH_ATTN);

    if (IN(PH_OUT)) { PH_BEGIN
        pg8::Gemm g{XN, Wo_t, T, D, D / 2};        pg8::StaticOrder S; S.init(T, D, G, bx);
        LAS float* rsl = (LAS float*)(lds + RING_BYTES);
        { pg8::Unit uu;
          for (int i = 0; i < 12 && S.next(i, uu); ++i) if (tid < 256) { const GAS f32x4* pq = (const GAS f32x4*)((const GAS float*)OSSQ + (size_t)(uu.pm * 256 + tid) * 16); const f32x4 a0 = pq[0], a1 = pq[1], b0 = pq[2], b1 = pq[3];
              const float sa = ((a0[0] + a0[1]) + (a0[2] + a0[3])) + ((a1[0] + a1[1]) + (a1[2] + a1[3])), sb = ((b0[0] + b0[1]) + (b0[2] + b0[3])) + ((b1[0] + b1[1]) + (b1[2] + b1[3]));
              const float ra = 1.0f / sqrtf(sa * (1.0f / 512.0f) + EPS), rb = 1.0f / sqrtf(sb * (1.0f / 512.0f) + EPS);
              *(LAS f32x2*)(rsl + (i * 256 + tid) * 2) = (f32x2){ra / rb, rb}; }
          __syncthreads(); }
        pg8::EpiOut E{AP->x, X1B, rsl};
        pg8::gemm_phase<pg8::EpiOut, pg8::StaticOrder, true, true, false, false, true, 0x7a7a7a7a, 0x7b7b7b7b, true>(lds, g, S, E);
    }
    SEAM(PH_OUT);

    if (IN(PH_ROUTE)) { PH_BEGIN
        LAS float* Wrg = (LAS float*)(lds + P8_WRG); LAS float* xt = (LAS float*)(lds + P8_XT + wave * P8_XT_WAVE); LAS float* wc = (LAS float*)(lds + P8_WC);
        LAS int* rt_g = (LAS int*)(lds + P8_RT); LAS float* rt_w = (LAS float*)(lds + P8_RT + 1024); LAS int* rt_rank = (LAS int*)(lds + P8_RT + 3072);
        LAS int* lcnt = (LAS int*)(lds + P8_RT + 4096); LAS int* lbase = (LAS int*)(lds + P8_RT + 4608); LAS float* rt_rs = (LAS float*)(lds + P8_RT + 5120);
        for (int k = tid; k < 1024; k += 512) *(LAS f32x4*)(Wrg + 4 * k) = *((const GAS f32x4*)WRGF + k);
        __syncthreads();
        const int r32 = lane & 31, kh = lane >> 5;
        for (int chunk = bx; chunk < T / 256; chunk += G) {
            if (tid < NCLS) lcnt[tid] = 0;
            const int rowc = wave * 32 + r32; const size_t row0w = (size_t)chunk * 256 + wave * 32;
            const GAS bf16* xsrc = (const GAS bf16*)X1B + (row0w + (lane >> 4)) * D + 4 * (lane & 15);
            f32x16 accE = {}; float aG0 = 0.f, aG1 = 0.f, aG2 = 0.f, aG3 = 0.f, ssq = 0.f;
            *(LAS f32x4*)(wc + 4 * tid) = *((const GAS f32x4*)WREF + tid);
            v2u xn[8]; f32x4 gvn;
#pragma unroll
            for (int j = 0; j < 8; ++j) xn[j] = *(const GAS v2u*)(xsrc + (size_t)(4 * j) * D);
            gvn = *(const GAS f32x4*)((const GAS float*)AP->ffn_g + 4 * (lane & 15));
#pragma unroll 1
            for (int kc = 0; kc < 16; ++kc) {
                f32x4 st[8];
#pragma unroll
                for (int j = 0; j < 8; ++j) st[j] = (f32x4){bflo(xn[j].x), bfhi(xn[j].x), bflo(xn[j].y), bfhi(xn[j].y)};
                const f32x4 gv = gvn;
                if (kc + 1 < 16) {
#pragma unroll
                    for (int j = 0; j < 8; ++j) xn[j] = *(const GAS v2u*)(xsrc + (size_t)(4 * j) * D + (kc + 1) * 64);
                    gvn = *(const GAS f32x4*)((const GAS float*)AP->ffn_g + (kc + 1) * 64 + 4 * (lane & 15)); }
                f32x4 wnext = {0.f, 0.f, 0.f, 0.f}; if (kc + 1 < 16) wnext = *((const GAS f32x4*)WREF + (kc + 1) * 512 + tid);
#pragma unroll
                for (int j = 0; j < 8; ++j) *(LAS f32x4*)(xt + ((lane >> 4) + 4 * j) * 68 + 4 * (lane & 15)) = st[j];
                if (kc + 1 < 16) *(LAS f32x4*)(wc + ((kc + 1) & 1) * 2048 + 4 * tid) = wnext;
                {
#pragma unroll
                  for (int j = 0; j < 8; ++j) { const f32x4 hv = st[j] * gv;
                      *(GAS unsigned*)((GAS unsigned char*)YH + (size_t)(row0w + (lane >> 4) + 4 * j) * D + kc * 64 + 4 * (lane & 15)) = pk4_fp8(hv[0], hv[1], hv[2], hv[3]); } }
                __syncthreads();
                const LAS float* wcc = wc + (kc & 1) * 2048 + r32;
#pragma unroll
                for (int c = 0; c < 8; ++c) {
                    const f32x4 xv = *(const LAS f32x4*)(xt + r32 * 68 + 8 * c + 4 * kh);
                    ssq += (xv.x * xv.x + xv.y * xv.y) + (xv.z * xv.z + xv.w * xv.w);
#pragma unroll
                    for (int e = 0; e < 4; ++e) { const int kl = 8 * c + 4 * kh + e;
                        const float a = wcc[kl * 32]; accE = __builtin_amdgcn_mfma_f32_32x32x2f32(a, xv[e], accE, 0, 0, 0);
                        const f32x4 wg = *(const LAS f32x4*)(Wrg + 4 * (kc * 64 + kl)); aG0 += xv[e] * wg[0]; aG1 += xv[e] * wg[1]; aG2 += xv[e] * wg[2]; aG3 += xv[e] * wg[3]; }
                }
                __syncthreads();
            }
            ssq += __shfl_xor(ssq, 32); aG0 += __shfl_xor(aG0, 32); aG1 += __shfl_xor(aG1, 32); aG2 += __shfl_xor(aG2, 32); aG3 += __shfl_xor(aG3, 32);
            const float rstd = 1.0f / sqrtf(ssq * (1.f / D) + EPS);
            float lg[4] = {aG0 * rstd + AP->b_rg[0], aG1 * rstd + AP->b_rg[1], aG2 * rstd + AP->b_rg[2], aG3 * rstd + AP->b_rg[3]};
            int gs = 0; float gm = lg[0];
#pragma unroll
            for (int i = 1; i < 4; ++i) if (lg[i] > gm) { gm = lg[i]; gs = i; }
            float den = 0.f;
#pragma unroll
            for (int i = 0; i < 4; ++i) den += __expf(lg[i] - gm);
            const float gwt = 1.0f / den;
            float mine[4];
#pragma unroll
            for (int i = 0; i < 4; ++i) { const float v = (gs == 0) ? accE[i] : (gs == 1) ? accE[4 + i] : (gs == 2) ? accE[8 + i] : accE[12 + i]; mine[i] = v * rstd + AP->b_re[gs * 8 + 4 * kh + i]; }
            float ev[8];
#pragma unroll
            for (int i = 0; i < 4; ++i) { const float oth = __shfl_xor(mine[i], 32); ev[i] = kh ? oth : mine[i]; ev[4 + i] = kh ? mine[i] : oth; }
            int e1 = 0; float v1 = ev[0];
#pragma unroll
            for (int i = 1; i < 8; ++i) if (ev[i] > v1) { v1 = ev[i]; e1 = i; }
            int e2 = -1; float v2 = -INFINITY;
#pragma unroll
            for (int i = 0; i < 8; ++i) if (i != e1 && (e2 < 0 || ev[i] > v2)) { v2 = ev[i]; e2 = i; }
            const float ex = __expf(v2 - v1); const float w1 = gwt / (1.0f + ex), w2 = gwt * ex / (1.0f + ex);
            if (kh == 0) { const int elo = e1 < e2 ? e1 : e2, ehi = e1 < e2 ? e2 : e1;
                rt_g[rowc] = gs * 28 + ((elo * (15 - elo)) >> 1) + (ehi - elo - 1); rt_w[rowc * 2] = e1 < e2 ? w1 : w2; rt_w[rowc * 2 + 1] = e1 < e2 ? w2 : w1; rt_rs[rowc] = rstd; }
            __syncthreads();
            if (tid < 256) rt_rank[tid] = __hip_atomic_fetch_add(&lcnt[rt_g[tid]], 1, __ATOMIC_RELAXED, __HIP_MEMORY_SCOPE_WORKGROUP);
            __syncthreads();
            if (tid < NCLS) { const int n = lcnt[tid]; lbase[tid] = n ? (int)__hip_atomic_fetch_add((gu32*)(ws + WS_CTL) + CW_GCNT + 64 * tid, (unsigned)n, RLX_AGENT) : 0; }
            __syncthreads();
            if (tid < 256) { const int g = rt_g[tid]; v4u ev; ev.x = (unsigned)(chunk * 256 + tid); ev.y = __builtin_bit_cast(unsigned, rt_w[tid * 2]); ev.z = __builtin_bit_cast(unsigned, rt_w[tid * 2 + 1]); ev.w = __builtin_bit_cast(unsigned, rt_rs[tid]);
                ((GAS v4u*)lists)[(size_t)g * LIST_CAP + lbase[g] + rt_rank[tid]] = ev; }
            __syncthreads();
        }
    }
    SEAM(PH_ROUTE);

    LAS int* tp = (LAS int*)(lds + TP_OFF); LAS int* cntl = (LAS int*)(lds + CNT_OFF); LAS int* ptab = (LAS int*)(lds + PT_OFF);
    if (hi > PH_ROUTE) {
        if (tid0 == 0) { gu32* ctl = (gu32*)(A.ws + WS_CTL); int acc = 0; for (int g = 0; g < NCLS; ++g) { const int n = (int)__hip_atomic_load(ctl + CW_GCNT + 64 * g, RLX_AGENT); cntl[g] = n; tp[g] = acc; acc += (n + 255) >> 8; } tp[NCLS] = acc;
            int p = 0; for (int lo_ = 0; lo_ < 8; ++lo_) for (int hi_ = lo_ + 1; hi_ < 8; ++hi_) ptab[p++] = lo_ | (hi_ << 4); }
        __syncthreads();
    }

    if (IN(PH_GU)) { PH_BEGIN
        pg8::Gemm g{YH, Wgu_t, 0, 0, D / 2}; pg8::ClsOrder S{tp, ptab, 0, G, MOE_SLOT(4), lists, cntl};
        pg8::EpiGateUp2 E{HB, lists, cntl};
        pg8::gemm_phase<pg8::EpiGateUp2, pg8::ClsOrder, true, true, true, false, true>(lds, g, S, E);
    }
    SEAM(PH_GU);

    if (IN(PH_D0)) { PH_BEGIN
        int K512 = 256; asm volatile("" : "+s"(K512)); pg8::Gemm g{HB, Wd_t, 0, 0, K512};        pg8::ClsOrder S{tp, ptab, 1, G, MOE_SLOT(4), lists, cntl};
        pg8::EpiDown2 E{AP->out, X1B, lists, cntl};
        pg8::gemm_phase<pg8::EpiDown2, pg8::ClsOrder, true, true, false, true, true, 0x7b7b7b7b, 0x7c7c7c7c, true>(lds, g, S, E);
    }
#undef IN
#undef SEAM
}

extern "C" void kernel_launch(void* const* d_in, const int* in_sizes, int n_in, void* d_out, int out_size, void* d_ws, size_t ws_size, hipStream_t stream) {
    static int grid = 0;
    if (grid == 0) {
        if (n_in != 22 || in_sizes[0] != T * D || out_size != T * D || ws_size < WS_END) { fprintf(stderr, "kernel_launch: unexpected shapes (n_in %d, in0 %d, out %d, ws %zu); nothing launched\n", n_in, n_in > 0 ? in_sizes[0] : -1, out_size, ws_size); grid = -1; return; }
        int dev = 0, cus = 0, per_cu = 0;
        if (hipGetDevice(&dev) != hipSuccess || hipDeviceGetAttribute(&cus, hipDeviceAttributeMultiprocessorCount, dev) != hipSuccess) { grid = -1; return; }
        if (hipFuncSetAttribute((const void*)mk_fwd, hipFuncAttributeMaxDynamicSharedMemorySize, LDS_BYTES) != hipSuccess) { fprintf(stderr, "kernel_launch: hipFuncSetAttribute failed\n"); grid = -1; return; }
        if (hipOccupancyMaxActiveBlocksPerMultiprocessor(&per_cu, (const void*)mk_fwd, 512, LDS_BYTES) != hipSuccess || per_cu < 1) { fprintf(stderr, "kernel_launch: occupancy query says %d\n", per_cu); }
        (void)hipGetLastError();
        grid = cus;
    }
    if (grid < 0) return;
    if (hipMemsetAsync((char*)d_ws + WS_CTL, 0, CTL_ZERO_BYTES, stream) != hipSuccess) return;
    Args a{};
    a.x = (const float*)d_in[0]; a.attn_g = (const float*)d_in[1]; a.w_in = (const float*)d_in[2]; a.qlat_g = (const float*)d_in[3]; a.w_qup = (const float*)d_in[4];
    a.kvlat_g = (const float*)d_in[5]; a.w_kvup = (const float*)d_in[6]; a.qhead_g = (const float*)d_in[7]; a.khead_g = (const float*)d_in[8];
    a.mqhead_g = (const float*)d_in[9]; a.mkhead_g = (const float*)d_in[10]; a.onorm_a_g = (const float*)d_in[11]; a.onorm_b_g = (const float*)d_in[12];
    a.w_out = (const float*)d_in[13]; a.ffn_g = (const float*)d_in[14]; a.w_rg = (const float*)d_in[15]; a.b_rg = (const float*)d_in[16];
    a.w_re = (const float*)d_in[17]; a.b_re = (const float*)d_in[18]; a.w_gate = (const float*)d_in[19]; a.w_up = (const float*)d_in[20]; a.w_down = (const float*)d_in[21];
    a.out = (float*)d_out; a.ws = (unsigned char*)d_ws; a.ph_lo = 0; a.ph_hi = NPHASE;
    hipLaunchKernelGGL(mk_fwd, dim3(grid), dim3(512), LDS_BYTES, stream, a);
    (void)hipPeekAtLastError();
}
```

```cpp
#include <hip/hip_runtime.h>
#include <cstdio>
#include <cstdint>
namespace pg8 {
#define PG8_LAS __attribute__((address_space(3)))
typedef unsigned short bf16_t;
typedef short bf16x8 __attribute__((ext_vector_type(8)));
typedef float f32x4 __attribute__((ext_vector_type(4)));
typedef unsigned u32x4 __attribute__((ext_vector_type(4)));
constexpr int BM = 256, BK = 64, HALF = 128, HTB = HALF * BK * 2  , STAGE_BYTES = 8 * HTB, NXCD = 8, WGM = 8;

__host__ __device__ __forceinline__ int lds_byte(int r, int c) { const int st = (r >> 4) * 2 + (c >> 5), rr = r & 15, cc = c & 31, ob = rr * 64 + cc * 2; return st * 1024 + (ob ^ (((ob >> 9) & 1) << 5)); }
__host__ __device__ __forceinline__ void stage_rc(int b, int& R, int& C) { const int st = b / 1024, sb = b % 1024, swz = sb ^ (((sb >> 9) & 1) << 5); R = (st >> 1) * 16 + swz / 64; C = (st & 1) * 32 + (swz % 64) / 2; }
__host__ __device__ __forceinline__ int perm32(int rho) { const int n = rho >> 4, i = rho & 15; return 8 * (i >> 2) + 4 * n + (i & 3); }

struct Unit { int pm, pn, g0, g1, pn2, q; };
struct Gemm { const bf16_t* A; const bf16_t* Bt; int M, N, K; };

struct StaticOrder {
    int nM, nN, nwg, G, c;
    __host__ __device__ void init(int M, int N, int G_, int c_) { nM = M / BM; nN = N / BM; nwg = nM * nN; G = G_; c = c_; }
    __host__ __device__ bool next(int i, Unit& u) const {
        const long L = (long)i * G + c; if (L >= nwg) return false;
        int wgid = (int)L; { const int q = nwg / NXCD, r = nwg % NXCD, xcd = wgid % NXCD, off = wgid / NXCD; wgid = (xcd < r ? xcd * (q + 1) : r * (q + 1) + (xcd - r) * q) + off; }
        const int nig = WGM * nN, gid = wgid / nig, fm = gid * WGM, gsz = (nM - fm) < WGM ? (nM - fm) : WGM;
        u.pm = fm + ((wgid % nig) % gsz); u.pn = (wgid % nig) / gsz; u.g0 = i; u.g1 = 0; u.pn2 = 0; u.q = 0; return true;
    }
    __device__ __forceinline__ void a_ready(const Unit&) const {}
    __device__ __forceinline__ void done(const Unit&) const {}
};

__device__ __forceinline__ unsigned cvt_pk_bf16(float lo, float hi) { unsigned r; asm volatile("v_cvt_pk_bf16_f32 %0, %1, %2" : "=v"(r) : "v"(lo), "v"(hi)); return r; }
#define PG8_GAS __attribute__((address_space(1)))
struct ListEnt { int tok; float w_lo; float w_hi; float rstd; };

struct EpiBf16 {
    static constexpr bool PERM = true, AFTER_DRAIN = false, MIDHOOK = false;
    bf16_t* O; int ldc;
    __device__ __forceinline__ void operator()(const f32x4 (&acc)[2][2][4][2], const Unit& u, int wr, int wc, int fr, int fq) const {
        const int row0 = u.pm * BM + wr * 64 + fr; const int col0 = u.pn * BM + wc * 32 + 8 * fq;
#pragma unroll
        for (int ai = 0; ai < 2; ++ai)
#pragma unroll
            for (int m = 0; m < 4; ++m) { bf16_t* rowp = O + (size_t)(row0 + ai * HALF + m * 16) * ldc + col0;
#pragma unroll
                for (int bj = 0; bj < 2; ++bj) { const f32x4 v0 = acc[ai][bj][m][0], v1 = acc[ai][bj][m][1];
                    u32x4 w; w.x = cvt_pk_bf16(v0[0], v0[1]); w.y = cvt_pk_bf16(v0[2], v0[3]); w.z = cvt_pk_bf16(v1[0], v1[1]); w.w = cvt_pk_bf16(v1[2], v1[3]);
                    *(PG8_GAS u32x4*)(rowp + bj * HALF) = w; } }
    }
};
struct EpiBf16Rs {
    static constexpr bool PERM = true, AFTER_DRAIN = false, MIDHOOK = false;
    bf16_t* O; int ldc; const float* ssq; int off; float inv_n, eps;
    __device__ __forceinline__ void operator()(const f32x4 (&acc)[2][2][4][2], const Unit& u, int wr, int wc, int fr, int fq) const {
        const int row0 = u.pm * BM + wr * 64 + fr; const int col0 = u.pn * BM + wc * 32 + 8 * fq;
#pragma unroll
        for (int ai = 0; ai < 2; ++ai)
#pragma unroll
            for (int m = 0; m < 4; ++m) { const int row = row0 + ai * HALF + m * 16; PG8_GAS bf16_t* rowp = (PG8_GAS bf16_t*)O + (size_t)row * ldc + col0;
                const f32x4 sq = *(const PG8_GAS f32x4*)(ssq + (size_t)row * 8 + off); const float rs = 1.0f / sqrtf(((sq[0] + sq[1]) + (sq[2] + sq[3])) * inv_n + eps);
#pragma unroll
                for (int bj = 0; bj < 2; ++bj) { const f32x4 v0 = acc[ai][bj][m][0] * rs, v1 = acc[ai][bj][m][1] * rs;
                    u32x4 w; w.x = cvt_pk_bf16(v0[0], v0[1]); w.y = cvt_pk_bf16(v0[2], v0[3]); w.z = cvt_pk_bf16(v1[0], v1[1]); w.w = cvt_pk_bf16(v1[2], v1[3]);
                    *(PG8_GAS u32x4*)(rowp + bj * HALF) = w; } }
    }
};
struct EpiProj {
    static constexpr bool PERM = true, AFTER_DRAIN = false, MIDHOOK = false;
    unsigned char* ws; size_t o_qln, o_kvln, o_qb, o_kb, o_vb, o_ssq, o_kmean, o_rope; const float* gq; const float* gk; float qscale, eps; int seq;
    __device__ __forceinline__ void operator()(const f32x4 (&acc)[2][2][4][2], const Unit& u, int wr, int wc, int fr, int fq) const {
        const int pn = u.pn; const int row0 = u.pm * BM + wr * 64 + fr;
        bf16_t* const QLN = (bf16_t*)(ws + o_qln); bf16_t* const KVLN = (bf16_t*)(ws + o_kvln); bf16_t* const QB = (bf16_t*)(ws + o_qb); bf16_t* const KB = (bf16_t*)(ws + o_kb); bf16_t* const VB = (bf16_t*)(ws + o_vb);
        float* const SSQ = (float*)(ws + o_ssq); float* const kmean = (float*)(ws + o_kmean); const float* const rope = (const float*)(ws + o_rope);
        if (pn < 2) {
            PG8_GAS bf16_t* O = (PG8_GAS bf16_t*)(pn ? KVLN : QLN); PG8_GAS float* sq = (PG8_GAS float*)SSQ;
#pragma unroll
            for (int ai = 0; ai < 2; ++ai)
#pragma unroll
                for (int m = 0; m < 4; ++m) { const int row = row0 + ai * HALF + m * 16; PG8_GAS bf16_t* rowp = O + (size_t)row * 256 + wc * 32 + 8 * fq; float ss = 0.f;
#pragma unroll
                    for (int bj = 0; bj < 2; ++bj) { const f32x4 v0 = acc[ai][bj][m][0], v1 = acc[ai][bj][m][1];
                        if (pn == 0 || bj == 0) ss += (v0[0] * v0[0] + v0[1] * v0[1]) + (v0[2] * v0[2] + v0[3] * v0[3]) + (v1[0] * v1[0] + v1[1] * v1[1]) + (v1[2] * v1[2] + v1[3] * v1[3]);
                        u32x4 w; w.x = cvt_pk_bf16(v0[0], v0[1]); w.y = cvt_pk_bf16(v0[2], v0[3]); w.z = cvt_pk_bf16(v1[0], v1[1]); w.w = cvt_pk_bf16(v1[2], v1[3]);
                        *(PG8_GAS u32x4*)(rowp + bj * HALF) = w; }
                    ss += __shfl_xor(ss, 16); ss += __shfl_xor(ss, 32);
                    if (fq == 0) sq[(size_t)row * 8 + pn * 4 + wc] = ss; }
        } else if (pn < 6) {
            const bool isk = pn >= 4; const int head = (pn & 1) * 4 + wc; const float* gp = isk ? gk : gq; asm volatile("" : "+s"(gp)); const float sc = isk ? 1.0f : qscale;
            PG8_GAS bf16_t* O = (PG8_GAS bf16_t*)(isk ? KB : QB);
            f32x4 g0[2], g1[2];
#pragma unroll
            for (int n = 0; n < 2; ++n) { g0[n] = *(const PG8_GAS f32x4*)(gp + 8 * fq + 4 * n); g1[n] = *(const PG8_GAS f32x4*)(gp + 32 + 8 * fq + 4 * n); }
            f32x4 cs0[2] = {{0.f, 0.f, 0.f, 0.f}, {0.f, 0.f, 0.f, 0.f}}, cs1[2] = {{0.f, 0.f, 0.f, 0.f}, {0.f, 0.f, 0.f, 0.f}};
#pragma unroll
            for (int ai = 0; ai < 2; ++ai)
#pragma unroll
                for (int m = 0; m < 4; ++m) { const int row = row0 + ai * HALF + m * 16; const int pos = row & (seq - 1);
                    float ss = 0.f;
#pragma unroll
                    for (int n = 0; n < 2; ++n) { const f32x4 a = acc[ai][0][m][n], b = acc[ai][1][m][n]; ss += (a[0] * a[0] + a[1] * a[1]) + (a[2] * a[2] + a[3] * a[3]) + (b[0] * b[0] + b[1] * b[1]) + (b[2] * b[2] + b[3] * b[3]); }
                    ss += __shfl_xor(ss, 16); ss += __shfl_xor(ss, 32);
                    const float rs = 1.0f / sqrtf(ss * (1.0f / 64.0f) + eps);
                    u32x4 w1, w2; unsigned pk1[4], pk2_[4];
#pragma unroll
                    for (int n = 0; n < 2; ++n) { const f32x4 c = *(const PG8_GAS f32x4*)(rope + (size_t)pos * 32 + 8 * fq + 4 * n), sn = *(const PG8_GAS f32x4*)(rope + (size_t)seq * 32 + (size_t)pos * 32 + 8 * fq + 4 * n);
                        const f32x4 y1 = acc[ai][0][m][n] * rs * g0[n], y2 = acc[ai][1][m][n] * rs * g1[n];
                        const f32x4 o1 = (y1 * c - y2 * sn) * sc, o2 = (y2 * c + y1 * sn) * sc;
                        if (isk) { cs0[n] += o1; cs1[n] += o2; }
                        pk1[2 * n] = cvt_pk_bf16(o1[0], o1[1]); pk1[2 * n + 1] = cvt_pk_bf16(o1[2], o1[3]); pk2_[2 * n] = cvt_pk_bf16(o2[0], o2[1]); pk2_[2 * n + 1] = cvt_pk_bf16(o2[2], o2[3]); }
                    w1.x = pk1[0]; w1.y = pk1[1]; w1.z = pk1[2]; w1.w = pk1[3]; w2.x = pk2_[0]; w2.y = pk2_[1]; w2.z = pk2_[2]; w2.w = pk2_[3];
                    PG8_GAS bf16_t* rowp = O + (size_t)row * 512 + head * 64 + 8 * fq;
                    *(PG8_GAS u32x4*)rowp = w1; *(PG8_GAS u32x4*)(rowp + 32) = w2;
                    asm volatile("" : "+v"(cs0[0]), "+v"(cs0[1]), "+v"(cs1[0]), "+v"(cs1[1]) :: "memory"); }
            if (isk) {
                PG8_GAS float* km = (PG8_GAS float*)kmean + ((size_t)u.pm * 8 + head) * 64;
#pragma unroll
                for (int n = 0; n < 2; ++n)
#pragma unroll
                    for (int j = 0; j < 4; ++j) { float a = cs0[n][j], b = cs1[n][j];
#pragma unroll
                        for (int o = 1; o < 16; o <<= 1) { a += __shfl_xor(a, o); b += __shfl_xor(b, o); }
                        if (fr == 0) { __hip_atomic_fetch_add(km + 8 * fq + 4 * n + j, a * (1.0f / 256.0f), __ATOMIC_RELAXED, __HIP_MEMORY_SCOPE_AGENT); __hip_atomic_fetch_add(km + 32 + 8 * fq + 4 * n + j, b * (1.0f / 256.0f), __ATOMIC_RELAXED, __HIP_MEMORY_SCOPE_AGENT); } }
            }
        } else {
            PG8_GAS bf16_t* O = (PG8_GAS bf16_t*)VB; const int col0 = (pn - 6) * BM + wc * 32 + 8 * fq;
#pragma unroll
            for (int ai = 0; ai < 2; ++ai)
#pragma unroll
                for (int m = 0; m < 4; ++m) { PG8_GAS bf16_t* rowp = O + (size_t)(row0 + ai * HALF + m * 16) * 512 + col0;
#pragma unroll
                    for (int bj = 0; bj < 2; ++bj) { const f32x4 v0 = acc[ai][bj][m][0], v1 = acc[ai][bj][m][1];
                        u32x4 w; w.x = cvt_pk_bf16(v0[0], v0[1]); w.y = cvt_pk_bf16(v0[2], v0[3]); w.z = cvt_pk_bf16(v1[0], v1[1]); w.w = cvt_pk_bf16(v1[2], v1[3]);
                        *(PG8_GAS u32x4*)(rowp + bj * HALF) = w; } }
        }
    }
};
struct EpiKv {
    static constexpr bool PERM = true, AFTER_DRAIN = false, MIDHOOK = false;
    bf16_t* KA; bf16_t* VA; const bf16_t* KVLN; const float* ssq; const float* ropeR; const float* gk; float eps; int seq;
    __device__ __forceinline__ void operator()(const f32x4 (&acc)[2][2][4][2], const Unit& u, int wr, int wc, int fr, int fq) const {
        const int pn = u.pn; const int row0 = u.pm * BM + wr * 64 + fr;
        if (pn < 2) {
            const int head = pn * 4 + wc; const float* gp = gk; asm volatile("" : "+s"(gp));
            f32x4 g0[2], g1[2];
#pragma unroll
            for (int n = 0; n < 2; ++n) { g0[n] = *(const PG8_GAS f32x4*)(gp + 8 * fq + 4 * n); g1[n] = *(const PG8_GAS f32x4*)(gp + 32 + 8 * fq + 4 * n); }
            const f32x4 gr1 = *(const PG8_GAS f32x4*)(gp + 64 + 4 * fq), gr2 = *(const PG8_GAS f32x4*)(gp + 80 + 4 * fq);
#pragma unroll
            for (int ai = 0; ai < 2; ++ai)
#pragma unroll
                for (int m = 0; m < 4; ++m) { const int row = row0 + ai * HALF + m * 16; const int pos = row & (seq - 1);
                    const f32x4 sq = *(const PG8_GAS f32x4*)(ssq + (size_t)row * 8 + 4); const float rl = 1.0f / sqrtf(((sq[0] + sq[1]) + (sq[2] + sq[3])) * (1.0f / 128.0f) + eps);
                    const PG8_GAS bf16_t* pe = (const PG8_GAS bf16_t*)KVLN + (size_t)row * 256 + 128 + 4 * fq;
                    typedef unsigned u32x2_ __attribute__((ext_vector_type(2)));
                    const u32x2_ p1 = *(const PG8_GAS u32x2_*)pe, p2 = *(const PG8_GAS u32x2_*)(pe + 16);
                    const f32x4 e1 = {__builtin_bit_cast(float, p1.x << 16), __builtin_bit_cast(float, p1.x & 0xffff0000u), __builtin_bit_cast(float, p1.y << 16), __builtin_bit_cast(float, p1.y & 0xffff0000u)};
                    const f32x4 e2 = {__builtin_bit_cast(float, p2.x << 16), __builtin_bit_cast(float, p2.x & 0xffff0000u), __builtin_bit_cast(float, p2.y << 16), __builtin_bit_cast(float, p2.y & 0xffff0000u)};
                    f32x4 x0[2], x1[2]; float ss = (e1[0] * e1[0] + e1[1] * e1[1]) + (e1[2] * e1[2] + e1[3] * e1[3]) + (e2[0] * e2[0] + e2[1] * e2[1]) + (e2[2] * e2[2] + e2[3] * e2[3]);
#pragma unroll
                    for (int n = 0; n < 2; ++n) { x0[n] = acc[ai][0][m][n] * rl; x1[n] = acc[ai][1][m][n] * rl; const f32x4 a = x0[n], b = x1[n];
                        ss += (a[0] * a[0] + a[1] * a[1]) + (a[2] * a[2] + a[3] * a[3]) + (b[0] * b[0] + b[1] * b[1]) + (b[2] * b[2] + b[3] * b[3]); }
                    ss += __shfl_xor(ss, 16); ss += __shfl_xor(ss, 32);
                    const float rs = 1.0f / sqrtf(ss * (1.0f / 96.0f) + eps);
                    PG8_GAS bf16_t* rowp = (PG8_GAS bf16_t*)KA + (size_t)row * 768 + head * 96;
                    u32x4 w1, w2;
                    { const f32x4 a = x0[0] * rs * g0[0], b = x0[1] * rs * g0[1]; w1.x = cvt_pk_bf16(a[0], a[1]); w1.y = cvt_pk_bf16(a[2], a[3]); w1.z = cvt_pk_bf16(b[0], b[1]); w1.w = cvt_pk_bf16(b[2], b[3]); }
                    { const f32x4 a = x1[0] * rs * g1[0], b = x1[1] * rs * g1[1]; w2.x = cvt_pk_bf16(a[0], a[1]); w2.y = cvt_pk_bf16(a[2], a[3]); w2.z = cvt_pk_bf16(b[0], b[1]); w2.w = cvt_pk_bf16(b[2], b[3]); }
                    *(PG8_GAS u32x4*)(rowp + 8 * fq) = w1; *(PG8_GAS u32x4*)(rowp + 32 + 8 * fq) = w2;
                    const f32x4 c = *(const PG8_GAS f32x4*)(ropeR + (size_t)pos * 16 + 4 * fq), sn = *(const PG8_GAS f32x4*)(ropeR + (size_t)seq * 16 + (size_t)pos * 16 + 4 * fq);
                    const f32x4 y1 = e1 * rs * gr1, y2 = e2 * rs * gr2; const f32x4 o1 = y1 * c - y2 * sn, o2 = y2 * c + y1 * sn;
                    u32x2_ r1, r2; r1.x = cvt_pk_bf16(o1[0], o1[1]); r1.y = cvt_pk_bf16(o1[2], o1[3]); r2.x = cvt_pk_bf16(o2[0], o2[1]); r2.y = cvt_pk_bf16(o2[2], o2[3]);
                    *(PG8_GAS u32x2_*)(rowp + 64 + 4 * fq) = r1; *(PG8_GAS u32x2_*)(rowp + 80 + 4 * fq) = r2;
                    asm volatile("" ::: "memory"); }
        } else {
            const int col0 = (pn - 2) * BM + wc * 32 + 8 * fq;
#pragma unroll
            for (int ai = 0; ai < 2; ++ai)
#pragma unroll
                for (int m = 0; m < 4; ++m) { const int row = row0 + ai * HALF + m * 16; PG8_GAS bf16_t* rowp = (PG8_GAS bf16_t*)VA + (size_t)row * 512 + col0;
                    const f32x4 sq = *(const PG8_GAS f32x4*)(ssq + (size_t)row * 8 + 4); const float rl = 1.0f / sqrtf(((sq[0] + sq[1]) + (sq[2] + sq[3])) * (1.0f / 128.0f) + eps);
#pragma unroll
                    for (int bj = 0; bj < 2; ++bj) { const f32x4 v0 = acc[ai][bj][m][0] * rl, v1 = acc[ai][bj][m][1] * rl;
                        u32x4 w; w.x = cvt_pk_bf16(v0[0], v0[1]); w.y = cvt_pk_bf16(v0[2], v0[3]); w.z = cvt_pk_bf16(v1[0], v1[1]); w.w = cvt_pk_bf16(v1[2], v1[3]);
                        *(PG8_GAS u32x4*)(rowp + bj * HALF) = w; } }
        }
    }
};
struct EpiOut {
    static constexpr bool PERM = true, AFTER_DRAIN = false, MIDHOOK = true;
    const float* base; bf16_t* x1b; const PG8_LAS float* rsl;
    __device__ __forceinline__ void mid(f32x4 (&acc)[2][2][4][2], const Unit& u, int wr, int wc, int fr, int fq) const {
        const PG8_LAS float* rs = rsl + (u.g0 * 256 + wr * 64 + fr) * 2;
#pragma unroll
        for (int ai = 0; ai < 2; ++ai)
#pragma unroll
            for (int m = 0; m < 4; ++m) { const float ratio = rs[(ai * HALF + m * 16) * 2];
#pragma unroll
                for (int bj = 0; bj < 2; ++bj)
#pragma unroll
                    for (int n = 0; n < 2; ++n) acc[ai][bj][m][n] *= ratio; }
    }
    __device__ __forceinline__ void operator()(const f32x4 (&acc)[2][2][4][2], const Unit& u, int wr, int wc, int fr, int fq) const {
        const int row0 = u.pm * BM + wr * 64 + fr; const int col0 = u.pn * BM + wc * 32 + 8 * fq;
        const PG8_LAS float* rs = rsl + (u.g0 * 256 + wr * 64 + fr) * 2 + 1;
#pragma unroll
        for (int ai = 0; ai < 2; ++ai)
#pragma unroll
            for (int m = 0; m < 4; ++m) { const int row = row0 + ai * HALF + m * 16; const size_t off = (size_t)row * 1024 + col0; const float rb = rs[(ai * HALF + m * 16) * 2];
#pragma unroll
                for (int bj = 0; bj < 2; ++bj) { const size_t p = off + bj * HALF;
                    const f32x4 v0 = *(const PG8_GAS f32x4*)(base + p) + acc[ai][bj][m][0] * rb, v1 = *(const PG8_GAS f32x4*)(base + p + 4) + acc[ai][bj][m][1] * rb;
                    u32x4 o; o.x = cvt_pk_bf16(v0[0], v0[1]); o.y = cvt_pk_bf16(v0[2], v0[3]); o.z = cvt_pk_bf16(v1[0], v1[1]); o.w = cvt_pk_bf16(v1[2], v1[3]);
                    *(PG8_GAS u32x4*)(x1b + p) = o; }
                if (m & 1) asm volatile("" ::: "memory"); }
    }
};
struct EpiGateUp2 {
    static constexpr bool PERM = true, AFTER_DRAIN = false, MIDHOOK = false;
    bf16_t* H; const ListEnt* lists; const PG8_LAS int* cnt;
    __device__ __forceinline__ void operator()(const f32x4 (&acc)[2][2][4][2], const Unit& u, int wr, int wc, int fr, int fq) const {
        const int rt0 = wr * 64 + fr; const int col0 = (u.q >> 1) * 256 + (u.q & 1) * 128 + wc * 32 + 8 * fq; const int g = u.g0; const int n_g = cnt[g]; const bool hiexp = (u.q >> 1) != 0;
        const ListEnt* lg = lists + (size_t)g * 65536 + u.g1 * 256;
        float wv[8], rv[8];
#pragma unroll
        for (int i = 0; i < 8; ++i) { const int rt = rt0 + (i >> 2) * HALF + (i & 3) * 16; f32x4 le = {0.f, 0.f, 0.f, 0.f}; if ((u.g1 * 256 + rt) < n_g) le = *(const PG8_GAS f32x4*)((const PG8_GAS ListEnt*)lg + rt); wv[i] = hiexp ? le[2] : le[1]; rv[i] = le[3]; }
#pragma unroll
        for (int ai = 0; ai < 2; ++ai)
#pragma unroll
            for (int m = 0; m < 4; ++m) { const int rt = rt0 + ai * HALF + m * 16; const bool valid = (u.g1 * 256 + rt) < n_g;
                const float w = wv[ai * 4 + m], rsd = rv[ai * 4 + m];
                unsigned pk[2];
#pragma unroll
                for (int n = 0; n < 2; ++n) { const f32x4 gv = acc[ai][0][m][n], uv = acc[ai][1][m][n]; float h[4];
#pragma unroll
                    for (int j = 0; j < 4; ++j) { const float a = gv[j] * rsd; const float s = a * __builtin_amdgcn_rcpf(1.0f + __builtin_amdgcn_exp2f(-1.4426950408889634f * a)); h[j] = valid ? s * (uv[j] * rsd) * w : 0.f; }
                    { int w_ = 0; w_ = __builtin_amdgcn_cvt_pk_fp8_f32(h[0] * 8.0f, h[1] * 8.0f, w_, false); w_ = __builtin_amdgcn_cvt_pk_fp8_f32(h[2] * 8.0f, h[3] * 8.0f, w_, true); pk[n] = (unsigned)w_; } }
                typedef unsigned u32x2h_ __attribute__((ext_vector_type(2))); u32x2h_ o; o.x = pk[0]; o.y = pk[1];
                *(PG8_GAS u32x2h_*)((PG8_GAS unsigned char*)H + (size_t)(u.pm * BM + rt) * 512 + col0) = o; }
    }
};
struct EpiDown2 {
    static constexpr bool PERM = true, AFTER_DRAIN = false, MIDHOOK = false;
    float* out; const bf16_t* x1b; const ListEnt* lists; const PG8_LAS int* cnt;
    __device__ __forceinline__ void operator()(const f32x4 (&acc)[2][2][4][2], const Unit& u, int wr, int wc, int fr, int fq) const {
        const int rt0 = wr * 64 + fr; const int col0 = u.q * 256 + wc * 32 + 8 * fq; const int g = u.g0; const int n_g = cnt[g];
        const ListEnt* lg = lists + (size_t)g * 65536 + u.g1 * 256;
        int tokv[8];
#pragma unroll
        for (int i = 0; i < 8; ++i) { const int rt = rt0 + (i >> 2) * HALF + (i & 3) * 16; tokv[i] = ((u.g1 * 256 + rt) < n_g) ? ((const PG8_GAS ListEnt*)lg)[rt].tok : -1; }
#pragma unroll
        for (int ai = 0; ai < 2; ++ai) {
            u32x4 xb[4][2];
#pragma unroll
            for (int m = 0; m < 4; ++m)
#pragma unroll
                for (int bj = 0; bj < 2; ++bj) { const int tok = tokv[ai * 4 + m]; xb[m][bj] = (u32x4){0u, 0u, 0u, 0u}; if (tok >= 0) xb[m][bj] = *(const PG8_GAS u32x4*)((const PG8_GAS bf16_t*)x1b + (size_t)tok * 1024 + col0 + bj * HALF); }
#pragma unroll
            for (int m = 0; m < 4; ++m) { const int tok = tokv[ai * 4 + m];
                if (tok >= 0) { PG8_GAS float* orow = (PG8_GAS float*)out + (size_t)tok * 1024 + col0;
#pragma unroll
                    for (int bj = 0; bj < 2; ++bj) { PG8_GAS float* p = orow + bj * HALF; const u32x4 x = xb[m][bj];
                        f32x4 a, b; a[0] = __builtin_bit_cast(float, x.x << 16); a[1] = __builtin_bit_cast(float, x.x & 0xffff0000u); a[2] = __builtin_bit_cast(float, x.y << 16); a[3] = __builtin_bit_cast(float, x.y & 0xffff0000u);
                        b[0] = __builtin_bit_cast(float, x.z << 16); b[1] = __builtin_bit_cast(float, x.z & 0xffff0000u); b[2] = __builtin_bit_cast(float, x.w << 16); b[3] = __builtin_bit_cast(float, x.w & 0xffff0000u);
                        *(PG8_GAS f32x4*)p = a + acc[ai][bj][m][0]; *(PG8_GAS f32x4*)(p + 4) = b + acc[ai][bj][m][1]; } } }
            asm volatile("" ::: "memory"); }
    }
};
struct ClsOrder {
    const PG8_LAS int* tp; const PG8_LAS int* ptab; int mode, G, c; const ListEnt* lists; const PG8_LAS int* cnt;
    __device__ __forceinline__ int arow(const Unit& u, int row) const { const unsigned pos = (unsigned)(u.g1 * 256 + row); const unsigned n = (unsigned)cnt[u.g0]; const PG8_GAS ListEnt* lg = (const PG8_GAS ListEnt*)lists + (size_t)u.g0 * 65536; return lg[pos < n ? pos : 0u].tok; }
    __device__ __forceinline__ bool next(int i, Unit& u) const {
        const int nrb = tp[112]; const long L = (long)i * G + c; if (L >= (long)nrb * 4) return false;
        const int rbt = (int)(L >> 2), q = (int)(L & 3);
        int g = 0;
#pragma unroll
        for (int s = 64; s >= 1; s >>= 1) { const int gg = g + s; if (gg < 112 && tp[gg] <= rbt) g = gg; }
        const int grp = g / 28, pr = ptab[g - grp * 28], lo = pr & 15, hi = pr >> 4;
        u.pm = rbt; u.g0 = g; u.g1 = rbt - tp[g]; u.q = q;
        if (mode == 0) { u.pn = (grp * 8 + ((q >> 1) ? hi : lo)) * 2 + (q & 1); u.pn2 = 0; } else { u.pn = (grp * 8 + lo) * 4 + q; u.pn2 = (grp * 8 + hi) * 4 + q; }
        return true;
    }
    __device__ __forceinline__ void a_ready(const Unit&) const {}
    __device__ __forceinline__ void done(const Unit&) const {}
};

template <class Epi, class Sched, bool ALIGN_EPI = false, bool SP2 = false, bool GATHER = false, bool KSPLIT = false, bool F8 = false, int SCW = 0x7a7a7a7a, int SCA = 0x7f7f7f7f, bool F8ASM = false>
__device__ __forceinline__ void gemm_phase(PG8_LAS unsigned char* lds, const Gemm g, const Sched& S, const Epi& E) {
    const int tid = threadIdx.x, wid = __builtin_amdgcn_readfirstlane(tid >> 6), lane = tid & 63, wr = wid >> 2, wc = wid & 3, fr = lane & 15, fq = lane >> 4;
    const int K = g.K, nt = K / BK;
    const int PB = KSPLIT ? (K >> 1) : K;
    static_assert(!GATHER || SP2, "gathered A rows: SP2 loop only");
    unsigned voffA[2], voffB[2];
#pragma unroll
    for (int i = 0; i < 2; ++i) { int R, C; stage_rc(tid * 16 + i * 8192, R, C); const int Rb = Epi::PERM ? ((R & ~31) + perm32(R & 31)) : R;
        voffA[i] = (unsigned)(R * K + C) * 2u; voffB[i] = (unsigned)(Rb * PB + C) * 2u; }
    const size_t kstep = (size_t)(BK * 2);
    const size_t hstep = (size_t)HALF * K * 2;
    const size_t tstep = 2 * hstep;
    const size_t hstepB = (size_t)HALF * PB * 2, tstepB = 2 * hstepB;
    const unsigned ldsw = (unsigned)wid * 1024u;
    const int aoff = lds_byte(wr * 64 + fr, fq * 8), boff = lds_byte(wc * 32 + fr, fq * 8);
#define PG8_SA(b, h) (((b) * 2 + (h)) * HTB)
#define PG8_SB(b, h) ((4 + (b) * 2 + (h)) * HTB)
#define PG8_STAGE(bufoff, gbase, voff) do { _Pragma("unroll") for (int _i = 0; _i < 2; ++_i) \
        __builtin_amdgcn_global_load_lds((const unsigned*)((const char*)(gbase) + (voff)[_i]), (PG8_LAS unsigned*)(lds + (bufoff) + ldsw + _i * 8192), 16, 0, 0); } while (0)
#define PG8_LDA(dst, b, h) do { _Pragma("unroll") for (int m = 0; m < 4; ++m) _Pragma("unroll") for (int k = 0; k < 2; ++k) dst[m][k] = *(const PG8_LAS bf16x8*)(lds + PG8_SA(b, h) + aoff + m * 2048 + k * 1024); } while (0)
#define PG8_LDB(dst, b, h) do { _Pragma("unroll") for (int n = 0; n < 2; ++n) _Pragma("unroll") for (int k = 0; k < 2; ++k) dst[n][k] = *(const PG8_LAS bf16x8*)(lds + PG8_SB(b, h) + boff + n * 2048 + k * 1024); } while (0)
#define PG8_MMA(ai, bj, At, Bt) do { __builtin_amdgcn_s_setprio(1); _Pragma("unroll") for (int m = 0; m < 4; ++m) _Pragma("unroll") for (int n = 0; n < 2; ++n) { \
        if constexpr (F8) { typedef int v4i_ __attribute__((ext_vector_type(4))); typedef int v8i_ __attribute__((ext_vector_type(8))); \
            const v8i_ w8_ = __builtin_shufflevector(__builtin_bit_cast(v4i_, Bt[n][0]), __builtin_bit_cast(v4i_, Bt[n][1]), 0, 1, 2, 3, 4, 5, 6, 7); \
            const v8i_ a8_ = __builtin_shufflevector(__builtin_bit_cast(v4i_, At[m][0]), __builtin_bit_cast(v4i_, At[m][1]), 0, 1, 2, 3, 4, 5, 6, 7); \
            if constexpr (F8ASM) { asm volatile("v_mfma_scale_f32_16x16x128_f8f6f4 %0, %1, %2, %0, %3, %4 op_sel_hi:[0,0,0]" : "+v"(acc[ai][bj][m][n]) : "v"(w8_), "v"(a8_), "v"(SCW), "v"(SCA)); }     \
            else acc[ai][bj][m][n] = __builtin_amdgcn_mfma_scale_f32_16x16x128_f8f6f4(w8_, a8_, acc[ai][bj][m][n], 0, 0, 0, SCW, 0, SCA); } \
        else { _Pragma("unroll") for (int k = 0; k < 2; ++k) acc[ai][bj][m][n] = __builtin_amdgcn_mfma_f32_16x16x32_bf16(Bt[n][k], At[m][k], acc[ai][bj][m][n], 0, 0, 0); } } \
        __builtin_amdgcn_s_setprio(0); } while (0)
#define PG8_WAIT_V(n) asm volatile("s_waitcnt vmcnt(" #n ")" ::: "memory")
#define PG8_WAIT_L(n) asm volatile("s_waitcnt lgkmcnt(" #n ")" ::: "memory")
#define PG8_BAR __builtin_amdgcn_s_barrier()
#define PG8_SCHED __builtin_amdgcn_sched_barrier(0)
#define PG8_STG_A(b, h, ptr, arr) do { if constexpr (GATHER) { PG8_STAGE(PG8_SA(b, h), (ptr), (arr)[h]); } else { PG8_STAGE(PG8_SA(b, h), (ptr) + ((h) ? hstep : 0), voffA); } } while (0)
    unsigned cv[2][2] = {{0u, 0u}, {0u, 0u}}, nvp[2] = {0u, 0u};
#define PG8_GROWS(dst, unit) do { if constexpr (GATHER) { _Pragma("unroll") for (int _h = 0; _h < 2; ++_h) _Pragma("unroll") for (int _i = 0; _i < 2; ++_i) { int R_, C_; stage_rc(tid * 16 + _i * 8192, R_, C_); \
        dst[_h][_i] = (unsigned)S.arow(unit, _h * HALF + R_) * (unsigned)(K * 2) + (unsigned)(C_ * 2); } } } while (0)
    Unit cur, nxt; int ui = 0;
    if (!S.next(0, cur)) return;
    PG8_GROWS(cv, cur);
#define PG8_GROWS_P(unit) do { _Pragma("unroll") for (int _i = 0; _i < 2; ++_i) { int R_, C_; stage_rc(tid * 16 + _i * 8192, R_, C_); nvp[_i] = (unsigned)S.arow(unit, R_) | ((unsigned)S.arow(unit, HALF + R_) << 16); } } while (0)
#define PG8_UNPACK_NV() do { _Pragma("unroll") for (int _i = 0; _i < 2; ++_i) { int R_, C_; stage_rc(tid * 16 + _i * 8192, R_, C_); cv[0][_i] = (nvp[_i] & 0xffffu) * (unsigned)(K * 2) + (unsigned)(C_ * 2); cv[1][_i] = (nvp[_i] >> 16) * (unsigned)(K * 2) + (unsigned)(C_ * 2); } } while (0)
    f32x4 acc[2][2][4][2];
#pragma unroll
    for (int a = 0; a < 2; ++a)
#pragma unroll
        for (int b = 0; b < 2; ++b)
#pragma unroll
            for (int m = 0; m < 4; ++m)
#pragma unroll
                for (int n = 0; n < 2; ++n) acc[a][b][m][n] = (f32x4){0.f, 0.f, 0.f, 0.f};
    bf16x8 At[4][2], B0[2][2], B1[2][2];
    const char* cA = (const char*)g.A + (GATHER ? (size_t)0 : (size_t)cur.pm * tstep); const char* cB = (const char*)g.Bt + (size_t)cur.pn * tstepB; const char* cB2 = KSPLIT ? (const char*)g.Bt + (size_t)cur.pn2 * tstepB : cB;
    S.a_ready(cur);
    if constexpr (SP2) {
        PG8_STAGE(PG8_SB(0, 0), cB, voffB); PG8_STAGE(PG8_SB(0, 1), cB + hstepB, voffB); PG8_STG_A(0, 0, cA, cv); PG8_STG_A(0, 1, cA, cv);
        if (wr == 1) PG8_BAR;
        PG8_WAIT_V(2); PG8_BAR;
        PG8_STAGE(PG8_SB(1, 0), cB + kstep, voffB); PG8_STG_A(1, 0, cA + kstep, cv); PG8_STAGE(PG8_SB(1, 1), cB + hstepB + kstep, voffB);
        PG8_WAIT_V(6); PG8_BAR;
    } else {
        PG8_STAGE(PG8_SB(0, 0), cB, voffB); PG8_STAGE(PG8_SA(0, 0), cA, voffA); PG8_STAGE(PG8_SB(0, 1), cB + hstepB, voffB); PG8_STAGE(PG8_SA(0, 1), cA + hstep, voffA);
        if (wr == 1) PG8_BAR;
        PG8_WAIT_V(4); PG8_BAR;
        PG8_STAGE(PG8_SB(1, 0), cB + kstep, voffB); PG8_STAGE(PG8_SA(1, 0), cA + kstep, voffA); PG8_STAGE(PG8_SB(1, 1), cB + hstepB + kstep, voffB);
        PG8_WAIT_V(6); PG8_BAR;
    }
    for (;;) {
        const bool has_next = S.next(ui + 1, nxt);
        const char* nA = (has_next && !GATHER) ? (const char*)g.A + (size_t)nxt.pm * tstep : cA; const char* nB = has_next ? (const char*)g.Bt + (size_t)nxt.pn * tstepB : cB; const char* nB2 = (KSPLIT && has_next) ? (const char*)g.Bt + (size_t)nxt.pn2 * tstepB : cB2;
        if constexpr (GATHER) { if (has_next) { PG8_GROWS_P(nxt); } else { PG8_GROWS_P(cur); } }
        const int tspan = Epi::MIDHOOK ? (nt >> 1) : nt;
        for (int t0 = 0; t0 < nt; t0 += tspan) {
        if constexpr (Epi::MIDHOOK) { if (t0 != 0) E.mid(acc, cur, wr, wc, fr, fq); }
        for (int t = t0; t < t0 + tspan; t += 2) {
            const bool last = (t == nt - 2);
            const char* a1 = cA + (size_t)(t + 1) * kstep;
            const char* a2 = last ? nA : cA + (size_t)(t + 2) * kstep; const char* b2 = last ? nB : ((KSPLIT && t + 2 >= (nt >> 1)) ? cB2 + (size_t)(t + 2 - (nt >> 1)) * kstep : cB + (size_t)(t + 2) * kstep);
            const char* a3 = a2 + kstep; const char* b3 = b2 + kstep;
            if (last && has_next) S.a_ready(nxt);
            if constexpr (SP2) {
            PG8_LDB(B0, 0, 0); PG8_LDB(B1, 0, 1); PG8_SCHED; PG8_LDA(At, 0, 0); PG8_STG_A(1, 1, a1, cv);
            if constexpr (GATHER) { if (last) { PG8_UNPACK_NV(); } }
            PG8_WAIT_V(8); PG8_WAIT_L(0); PG8_BAR; PG8_MMA(0, 0, At, B0); PG8_MMA(0, 1, At, B1); PG8_BAR; PG8_SCHED;
            PG8_LDA(At, 0, 1); PG8_STAGE(PG8_SB(0, 0), b2, voffB); PG8_STAGE(PG8_SB(0, 1), b2 + hstepB, voffB); PG8_STG_A(0, 0, a2, cv);
            PG8_WAIT_V(8); PG8_WAIT_L(0); PG8_BAR; PG8_MMA(1, 0, At, B0); PG8_MMA(1, 1, At, B1); PG8_BAR; PG8_SCHED;
            PG8_LDB(B0, 1, 0); PG8_LDB(B1, 1, 1); PG8_SCHED; PG8_LDA(At, 1, 0); PG8_STG_A(0, 1, a2, cv);
            PG8_WAIT_V(8); PG8_WAIT_L(0); PG8_BAR; PG8_MMA(0, 0, At, B0); PG8_MMA(0, 1, At, B1); PG8_BAR; PG8_SCHED;
            PG8_LDA(At, 1, 1); PG8_STAGE(PG8_SB(1, 0), b3, voffB); PG8_STAGE(PG8_SB(1, 1), b3 + hstepB, voffB); PG8_STG_A(1, 0, a3, cv);
            PG8_WAIT_V(8); PG8_WAIT_L(0); PG8_BAR; PG8_MMA(1, 0, At, B0); PG8_MMA(1, 1, At, B1); PG8_BAR; PG8_SCHED;
            } else {
            PG8_LDB(B0, 0, 0); PG8_SCHED; PG8_LDA(At, 0, 0); PG8_STAGE(PG8_SA(1, 1), a1 + hstep, voffA);
            PG8_WAIT_L(8); PG8_BAR; PG8_WAIT_L(0); PG8_MMA(0, 0, At, B0); PG8_BAR; PG8_SCHED;
            PG8_LDB(B1, 0, 1); PG8_STAGE(PG8_SB(0, 0), b2, voffB);
            PG8_BAR; PG8_WAIT_L(0); PG8_MMA(0, 1, At, B1); PG8_BAR;
            PG8_LDA(At, 0, 1); PG8_STAGE(PG8_SA(0, 0), a2, voffA);
            PG8_BAR; PG8_WAIT_L(0); PG8_MMA(1, 0, At, B0); PG8_BAR; PG8_SCHED;
            PG8_STAGE(PG8_SB(0, 1), b2 + hstepB, voffB);
            PG8_WAIT_V(6); PG8_BAR; PG8_MMA(1, 1, At, B1); PG8_BAR;
            PG8_LDB(B0, 1, 0); PG8_SCHED; PG8_LDA(At, 1, 0); PG8_STAGE(PG8_SA(0, 1), a2 + hstep, voffA);
            PG8_WAIT_L(8); PG8_BAR; PG8_WAIT_L(0); PG8_MMA(0, 0, At, B0); PG8_BAR; PG8_SCHED;
            PG8_LDB(B1, 1, 1); PG8_STAGE(PG8_SB(1, 0), b3, voffB);
            PG8_BAR; PG8_WAIT_L(0); PG8_MMA(0, 1, At, B1); PG8_BAR;
            PG8_LDA(At, 1, 1); PG8_STAGE(PG8_SA(1, 0), a3, voffA);
            PG8_BAR; PG8_WAIT_L(0); PG8_MMA(1, 0, At, B0); PG8_BAR; PG8_SCHED;
            PG8_STAGE(PG8_SB(1, 1), b3 + hstepB, voffB);
            PG8_WAIT_V(6); PG8_BAR; PG8_MMA(1, 1, At, B1); PG8_BAR;
            }
        }
        }
        if constexpr (ALIGN_EPI) { if (wr == 0) PG8_BAR; }
        if constexpr (!Epi::AFTER_DRAIN) { int t2 = threadIdx.x; asm volatile("" : "+v"(t2));
            const int wid2 = __builtin_amdgcn_readfirstlane(t2 >> 6), lane2 = t2 & 63; E(acc, cur, wid2 >> 2, wid2 & 3, lane2 & 15, lane2 >> 4); S.done(cur); }
        if (!has_next) break;
#pragma unroll
        for (int a = 0; a < 2; ++a)
#pragma unroll
            for (int b = 0; b < 2; ++b)
#pragma unroll
                for (int m = 0; m < 4; ++m)
#pragma unroll
                    for (int n = 0; n < 2; ++n) acc[a][b][m][n] = (f32x4){0.f, 0.f, 0.f, 0.f};
        cur = nxt; cA = nA; cB = nB; cB2 = nB2; ++ui;
        if constexpr (ALIGN_EPI) { if (wr == 1) PG8_BAR; }
    }
    PG8_WAIT_V(0);
    if constexpr (!ALIGN_EPI) { if (wr == 0) PG8_BAR; }
    PG8_BAR;
    if constexpr (Epi::AFTER_DRAIN) { E.fused(acc, cur, wr, wc, fr, fq, lds, wid, lane); S.done(cur); }
#undef PG8_SA
#undef PG8_SB
#undef PG8_STAGE
#undef PG8_LDA
#undef PG8_LDB
#undef PG8_MMA
#undef PG8_WAIT_V
#undef PG8_WAIT_L
#undef PG8_BAR
#undef PG8_SCHED
#undef PG8_STG_A
#undef PG8_GROWS
#undef PG8_GROWS_P
#undef PG8_UNPACK_NV
}
}
constexpr int BATCH = 32, SEQ = 2048, D = 1024, T = BATCH * SEQ;
constexpr int NPROJ = 2048;
constexpr int CQ = 0, CKV = 256, CPE = 384, CMQ = 416, CMK = 928, CMV = 1440, NPROJ_REAL = 1952;
constexpr int NH = 8;
constexpr float EPS = 1e-6f;
constexpr float LOG2E = 1.4426950408889634f;
constexpr float C2A = 0.10206207261596575f * LOG2E;
constexpr float C2B = 0.125f * LOG2E;
constexpr int NCLS = 112;
constexpr int LIST_CAP = 65536;

constexpr size_t MiB = 1u << 20;
constexpr size_t WS_CTL = 0, CTL_ZERO_BYTES = 2 * MiB;
constexpr size_t WS_KMEAN = 1 * MiB;
constexpr size_t WS_WIN = 2 * MiB;
constexpr size_t WS_WQ = 6 * MiB;
constexpr size_t WS_WKV = 7 * MiB;
constexpr size_t WS_WO = 8 * MiB;
constexpr size_t WS_WGU = 10 * MiB;
constexpr size_t WS_WD = 42 * MiB;
constexpr size_t WS_ROPE = 58 * MiB;
constexpr size_t WS_WRE = 59 * MiB;
constexpr size_t WS_SSQ = 60 * MiB;
constexpr size_t WS_XN = 64 * MiB;
constexpr size_t WS_VB = 192 * MiB;
constexpr size_t WS_Y0 = 64 * MiB;
constexpr size_t WS_X1B = 768 * MiB;
constexpr size_t WS_YH = 256 * MiB;
constexpr size_t WS_QB = 448 * MiB;
constexpr size_t WS_KB = 512 * MiB;
constexpr size_t WS_QA = 584 * MiB;
constexpr size_t WS_VA = 680 * MiB;
constexpr size_t WS_KA = 808 * MiB;
constexpr size_t WS_QLN = 904 * MiB;
constexpr size_t WS_KVLN = 936 * MiB;
constexpr size_t WS_LISTS = 648 * MiB;
constexpr size_t WS_OSSQ = 904 * MiB;
constexpr size_t WS_END = 1024 * MiB;
constexpr size_t WS_H = WS_KB;
constexpr int CW_TMO = 0, CW_CODE = 1;
constexpr int CW_BAR = 4096;
constexpr int CW_GCNT = 16384;

constexpr int RING_BYTES = 131072;
constexpr int P8_XT = 0, P8_XT_WAVE = 32 * 68 * 4, P8_WC = 69632, P8_WRG = 86016, P8_RT = 102400;
constexpr int LDSCTL_OFF = 155648, LDS_BYTES = 159744;
constexpr int TP_OFF = LDSCTL_OFF + 256, CNT_OFF = LDSCTL_OFF + 768, PT_OFF = LDSCTL_OFF + 1280;

#define GAS __attribute__((address_space(1)))
#define LAS __attribute__((address_space(3)))
typedef unsigned short bf16;
typedef unsigned v4u __attribute__((ext_vector_type(4)));
typedef unsigned v2u __attribute__((ext_vector_type(2)));
typedef float f32x4 __attribute__((ext_vector_type(4)));
typedef float f32x2 __attribute__((ext_vector_type(2)));
typedef float f32x16 __attribute__((ext_vector_type(16)));
typedef short bf16x8 __attribute__((ext_vector_type(8)));
typedef short s16x4 __attribute__((ext_vector_type(4)));
typedef GAS unsigned gu32;
#define RLX_AGENT __ATOMIC_RELAXED, __HIP_MEMORY_SCOPE_AGENT
__device__ __forceinline__ unsigned f2bf(float f) { unsigned u = __builtin_bit_cast(unsigned, f); return (u + 0x7fffu + ((u >> 16) & 1u)) >> 16; }
__device__ __forceinline__ unsigned pk2(float lo, float hi) { return f2bf(lo) | (f2bf(hi) << 16); }
__device__ __forceinline__ float bflo(unsigned w) { return __builtin_bit_cast(float, w << 16); }
__device__ __forceinline__ float bfhi(unsigned w) { return __builtin_bit_cast(float, w & 0xffff0000u); }
__device__ __forceinline__ float wave_sum(float v) {
#pragma unroll
    for (int o = 1; o < 64; o <<= 1) v += __shfl_xor(v, o);
    return v;
}
__device__ __forceinline__ float sum8(float v) { v += __shfl_xor(v, 1); v += __shfl_xor(v, 2); v += __shfl_xor(v, 4); return v; }

#define XB_TMO      128
#define XB_XCNT(j)  (256  + 64 * (j))
#define XB_XSUB(j)  (1280 + 64 * (j))
#define XB_XGEN(j)  (2304 + 64 * (j))
#define XB_TOP      3328
#define XB_TOPGEN   3392
#define XCD_BAR_WORDS 3456
#define XB_SPIN_CAP (1u << 18)

__device__ __forceinline__ unsigned xb_ld(unsigned* p)              { return __hip_atomic_load(p, __ATOMIC_RELAXED, __HIP_MEMORY_SCOPE_AGENT); }
__device__ __forceinline__ unsigned xb_add(unsigned* p, unsigned v) { return __hip_atomic_fetch_add(p, v, __ATOMIC_RELAXED, __HIP_MEMORY_SCOPE_AGENT); }
__device__ __forceinline__ unsigned xb_xcc_id() { return (unsigned)__builtin_amdgcn_s_getreg((3 << 11) | 20) & 0xFu; }
#define XB_SPIN(cond, bar) do { unsigned _sp = 0; while (cond) { __builtin_amdgcn_s_sleep(1); \
    if ((++_sp & 255u) == 0u) { if (xb_ld(&(bar)[XB_TMO])) break; if (_sp > XB_SPIN_CAP) { atomicAdd(&(bar)[XB_TMO], 1u); break; } } } } while (0)

struct XcdBarrier {
    unsigned* bar; unsigned x;
    volatile LAS unsigned* st;
};

__device__ __forceinline__ XcdBarrier xcd_barrier_post(unsigned* bar, volatile LAS unsigned* st) {
    XcdBarrier b; b.bar = bar; b.x = xb_xcc_id(); b.st = st;
    if (threadIdx.x == 0) (void)xb_add(&bar[XB_XCNT(b.x)], 1u);
    return b;
}
__device__ __forceinline__ void xcd_barrier_complete(unsigned* bar, unsigned x, unsigned& nloc, unsigned& nx) {
    const unsigned G = gridDim.x * gridDim.y * gridDim.z;
    unsigned sum, cnt, mine, sp = 0u;
    for (;;) {
        sum = 0u; cnt = 0u; mine = 0u;
#pragma unroll
        for (unsigned j = 0; j < 16; ++j) { const unsigned c = xb_ld(&bar[XB_XCNT(j)]); sum += c; cnt += (c > 0u) ? 1u : 0u; mine = (j == x) ? c : mine; }
        if (sum == G) break;
        __builtin_amdgcn_s_sleep(1);
        if ((++sp & 255u) == 0u) { if (xb_ld(&bar[XB_TMO])) break; if (sp > XB_SPIN_CAP) { atomicAdd(&bar[XB_TMO], 1u); break; } }
    }
    nloc = mine > 0u ? mine : 1u; nx = cnt > 0u ? cnt : 1u;
}

__device__ __forceinline__ void xcd_barrier(const XcdBarrier& b) {
    asm volatile("s_waitcnt vmcnt(0)" ::: "memory");
    __syncthreads();
    if (threadIdx.x == 0) {
        unsigned* bar = b.bar;
        __builtin_amdgcn_s_waitcnt(0);
        unsigned nloc = b.st[0], nx = b.st[1];
        if (nloc == 0u) { xcd_barrier_complete(bar, b.x, nloc, nx); b.st[0] = nloc; b.st[1] = nx; }
        const unsigned old = xb_add(&bar[XB_XSUB(b.x)], 1u);
        const unsigned gen = old / nloc;
        if (old + 1u == (gen + 1u) * nloc) {
            __builtin_amdgcn_fence(__ATOMIC_RELEASE, "agent");
            asm volatile("s_waitcnt vmcnt(0)" ::: "memory");
            const unsigned og = xb_add(&bar[XB_TOP], 1u);
            const unsigned tg = og / nx;
            if (og + 1u == (tg + 1u) * nx) xb_add(&bar[XB_TOPGEN], 1u);
            else XB_SPIN(xb_ld(&bar[XB_TOPGEN]) == tg, bar);
            __builtin_amdgcn_fence(__ATOMIC_ACQUIRE, "agent");
            xb_add(&bar[XB_XGEN(b.x)], 1u);
            asm volatile("s_waitcnt vmcnt(0)" ::: "memory");
        } else {
            XB_SPIN(xb_ld(&bar[XB_XGEN(b.x)]) == gen, bar);
            __builtin_amdgcn_fence(__ATOMIC_ACQUIRE, "agent");
            asm volatile("s_waitcnt vmcnt(0)" ::: "memory");
        }
    }
    __syncthreads();
}


__device__ __forceinline__ float att_max3(float a, float b, float c) { float r; asm("v_max3_f32 %0, %1, %2, %3" : "=v"(r) : "v"(a), "v"(b), "v"(c)); return r; }
__device__ __forceinline__ unsigned pk4_fp8(float a, float b, float c, float d) { int w = 0; w = __builtin_amdgcn_cvt_pk_fp8_f32(a, b, w, false); w = __builtin_amdgcn_cvt_pk_fp8_f32(c, d, w, true); return (unsigned)w; }
struct AttOwn { static constexpr bool v = true; }; struct AttPast { static constexpr bool v = false; };
template <int DQK, bool MOBA, bool QFIN>
__device__ __forceinline__ void attn_unit(LAS unsigned char* lds, const float* qgain_, const float* ropeR_, const bf16* Qg_, int qpitch, const bf16* Kg_, int kpitch, const bf16* Vg_, int vpitch, bf16* Og_, int opitch, float* ossq_, int qb, const float* kmp_, int kmstride) {
    const GAS bf16* Qg = (const GAS bf16*)Qg_; const GAS bf16* Kg = (const GAS bf16*)Kg_; const GAS bf16* Vg = (const GAS bf16*)Vg_; GAS bf16* Og = (GAS bf16*)Og_; const GAS float* kmp = (const GAS float*)kmp_;
    constexpr int ND = DQK / 16, KSTR = DQK * 2 + 16, KBUF = 64 * KSTR, NCH = DQK / 8, VBUF = 8192;
    int tid = threadIdx.x; asm volatile("" : "+v"(tid));
    const int lane = tid & 63, r32 = lane & 31, hi = lane >> 5; const int wid = __builtin_amdgcn_readfirstlane(tid >> 6);
    LAS unsigned char* Kl = lds; LAS unsigned char* Vl = lds + 2 * KBUF;
    const GAS bf16* qrow = Qg + (size_t)(qb * 256 + wid * 32 + r32) * qpitch;
    bf16x8 qf[ND];
#pragma unroll
    for (int d0 = 0; d0 < ND; ++d0) qf[d0] = *(const GAS bf16x8*)(qrow + 16 * d0 + 8 * hi);
    if (QFIN) {
        const GAS float* qg = (const GAS float*)qgain_; const GAS float* rr = (const GAS float*)ropeR_; const int pos = qb * 256 + wid * 32 + r32;
        float x[ND][8]; float ss = 0.f;
#pragma unroll
        for (int d0 = 0; d0 < ND; ++d0) { const v4u w = __builtin_bit_cast(v4u, qf[d0]);
            x[d0][0] = bflo(w.x); x[d0][1] = bfhi(w.x); x[d0][2] = bflo(w.y); x[d0][3] = bfhi(w.y); x[d0][4] = bflo(w.z); x[d0][5] = bfhi(w.z); x[d0][6] = bflo(w.w); x[d0][7] = bfhi(w.w);
#pragma unroll
            for (int j = 0; j < 8; ++j) ss += x[d0][j] * x[d0][j]; }
        ss += __shfl_xor(ss, 32);
        const float rs = (1.0f / sqrtf(ss * (1.0f / (float)DQK) + EPS)) * C2A;
#pragma unroll
        for (int d0 = 0; d0 < ND; ++d0) { const f32x4 ga = *(const GAS f32x4*)(qg + 16 * d0 + 8 * hi), gb = *(const GAS f32x4*)(qg + 16 * d0 + 8 * hi + 4);
#pragma unroll
            for (int j = 0; j < 4; ++j) { x[d0][j] *= rs * ga[j]; x[d0][4 + j] *= rs * gb[j]; } }
        if (ND == 6) { const f32x4 ca = *(const GAS f32x4*)(rr + pos * 16 + 8 * hi), cb = *(const GAS f32x4*)(rr + pos * 16 + 8 * hi + 4), sa = *(const GAS f32x4*)(rr + SEQ * 16 + pos * 16 + 8 * hi), sb = *(const GAS f32x4*)(rr + SEQ * 16 + pos * 16 + 8 * hi + 4);
#pragma unroll
            for (int j = 0; j < 8; ++j) { const float c = j < 4 ? ca[j & 3] : cb[j & 3], s = j < 4 ? sa[j & 3] : sb[j & 3]; const float y1 = x[ND - 2][j], y2 = x[ND - 1][j]; x[ND - 2][j] = y1 * c - y2 * s; x[ND - 1][j] = y2 * c + y1 * s; } }
#pragma unroll
        for (int d0 = 0; d0 < ND; ++d0) { v4u w; w.x = pg8::cvt_pk_bf16(x[d0][0], x[d0][1]); w.y = pg8::cvt_pk_bf16(x[d0][2], x[d0][3]); w.z = pg8::cvt_pk_bf16(x[d0][4], x[d0][5]); w.w = pg8::cvt_pk_bf16(x[d0][6], x[d0][7]); qf[d0] = __builtin_bit_cast(bf16x8, w); }
    }
    unsigned sel = 0xffu;
    if (MOBA && qb > 3) {
        float gate[8];
#pragma unroll
        for (int n = 0; n < 8; ++n) { float a = 0.f;
            if (n < qb) {
#pragma unroll
                for (int d0 = 0; d0 < ND; ++d0) { const GAS float* km = kmp + (size_t)n * kmstride + 16 * d0 + 8 * hi; const f32x4 k0 = *(const GAS f32x4*)km, k1 = *(const GAS f32x4*)(km + 4);
                    const v4u qq = __builtin_bit_cast(v4u, qf[d0]);
                    a += bflo(qq.x) * k0[0] + bfhi(qq.x) * k0[1] + bflo(qq.y) * k0[2] + bfhi(qq.y) * k0[3] + bflo(qq.z) * k1[0] + bfhi(qq.z) * k1[1] + bflo(qq.w) * k1[2] + bfhi(qq.w) * k1[3]; }
                a += __shfl_xor(a, 32); }
            gate[n] = a; asm volatile("" : "+v"(a) :: "memory"); }
        sel = 0u;
#pragma unroll
        for (int n = 0; n < 8; ++n) { int rank = 0;
#pragma unroll
            for (int mm = 0; mm < 8; ++mm) { if (mm != n) { const bool before = (gate[mm] > gate[n]) || (gate[mm] == gate[n] && mm < n); rank += (mm < qb && before) ? 1 : 0; } }
            if (n < qb && rank < 3) sel |= (1u << n); }
    }
    const int krow = (DQK == 64) ? (tid >> 3) : (tid / 12), kch = (DQK == 64) ? (tid & 7) : (tid % 12);
    const int krow2 = (tid + 512) / 12, kch2 = (tid + 512) % 12; const bool k2 = (DQK == 96) && (tid < 256);
    const int vrow = tid >> 3, vch = tid & 7;
    const unsigned kst = (unsigned)(krow * KSTR + kch * 16), kst2 = (unsigned)(krow2 * KSTR + kch2 * 16);
    const unsigned vst = (unsigned)((vch >> 2) * 4096 + (vrow >> 4) * 1024 + ((vrow >> 3) & 1) * 512 + (vrow & 7) * 64 + (vch & 3) * 16);
    const int NT = 4 * (qb + 1);
    auto tile_row0 = [&](int p) -> int { return (p < 4) ? (qb * 256 + p * 64) : ((p - 4) * 64); };
    v4u kreg, kreg2 = {0u, 0u, 0u, 0u}, vreg;
    { const int r0 = tile_row0(0);
      kreg = *(const GAS v4u*)(Kg + (size_t)(r0 + krow) * kpitch + kch * 8); if (k2) kreg2 = *(const GAS v4u*)(Kg + (size_t)(r0 + krow2) * kpitch + kch2 * 8);
      vreg = *(const GAS v4u*)(Vg + (size_t)(r0 + vrow) * vpitch + vch * 8);
      *(LAS v4u*)(Kl + kst) = kreg; if (k2) *(LAS v4u*)(Kl + kst2) = kreg2; *(LAS v4u*)(Vl + vst) = vreg; }
    __syncthreads();
    float m_run = 0.f, l_run = 0.f; f32x16 o0 = {}, o1 = {};
    f32x16 cuse = {}; bool cdirty = true;
    f32x16 negm = {};
    constexpr float THR = 8.0f;
    const int qrel = wid * 32 + r32;
    const unsigned kfo = (unsigned)(r32 * KSTR + hi * 16);
    const unsigned vfo = (unsigned)(((lane >> 4) & 1) * 32 + (lane & 3) * 8 + (4 * hi + ((lane & 15) >> 2)) * 64);
    auto slot = [&](const int p, auto own_) { constexpr bool OWN = decltype(own_)::v;
        const int cb = p & 1;
        if (p + 1 < NT) { const int r0 = tile_row0(p + 1);
            kreg = *(const GAS v4u*)(Kg + (size_t)(r0 + krow) * kpitch + kch * 8); if (k2) kreg2 = *(const GAS v4u*)(Kg + (size_t)(r0 + krow2) * kpitch + kch2 * 8);
            vreg = *(const GAS v4u*)(Vg + (size_t)(r0 + vrow) * vpitch + vch * 8); }
        const bool need = OWN ? !(p > (wid >> 1)) : true;
        if (need) {
            const LAS unsigned char* Kb = Kl + cb * KBUF + kfo; const LAS unsigned char* Vb = Vl + cb * VBUF + vfo;
            f32x16 s0 = negm, s1 = negm;
            if constexpr (!OWN && MOBA) {
                if (cdirty || (p & 3) == 0) { const bool on = ((sel >> ((p - 4) >> 2)) & 1u) != 0u;
#pragma unroll
                    for (int r = 0; r < 16; ++r) cuse[r] = on ? negm[r] : -1.0e30f;
                    cdirty = false; }
                s0 = cuse; s1 = cuse; }
            bf16x8 kf[2 * ND];
#pragma unroll
            for (int d0 = 0; d0 < ND; ++d0) { kf[2 * d0] = *(const LAS bf16x8*)(Kb + d0 * 32); kf[2 * d0 + 1] = *(const LAS bf16x8*)(Kb + 32 * KSTR + d0 * 32); }
            __builtin_amdgcn_sched_barrier(0);
#pragma unroll
            for (int d0 = 0; d0 < ND; ++d0) { s0 = __builtin_amdgcn_mfma_f32_32x32x16_bf16(kf[2 * d0], qf[d0], s0, 0, 0, 0); s1 = __builtin_amdgcn_mfma_f32_32x32x16_bf16(kf[2 * d0 + 1], qf[d0], s1, 0, 0, 0); }
            s16x4 vt[16];
#pragma unroll
            for (int v = 0; v < 16; ++v) vt[v] = __builtin_bit_cast(s16x4, __builtin_amdgcn_ds_read_tr16_b64_v4i16((LAS s16x4*)(Vb + (v >> 2) * 1024 + ((v >> 1) & 1) * 4096 + (v & 1) * 512)));
            __builtin_amdgcn_sched_barrier(0);
            if constexpr (OWN) { const int kb = 64 * p + 4 * hi;
#pragma unroll
                for (int r = 0; r < 16; ++r) { const int kv = kb + (r & 3) + 8 * (r >> 2); if (kv > qrel) s0[r] = -INFINITY; if (kv + 32 > qrel) s1[r] = -INFINITY; } }
            float ra = att_max3(s0[0], s0[1], s1[0]), rb = att_max3(s0[2], s0[3], s1[1]); ra = att_max3(ra, s1[2], s1[3]);
#pragma unroll
            for (int r = 4; r < 16; r += 4) { ra = att_max3(ra, s0[r], s0[r + 1]); rb = att_max3(rb, s0[r + 2], s0[r + 3]); ra = att_max3(ra, s1[r], s1[r + 1]); rb = att_max3(rb, s1[r + 2], s1[r + 3]); }
            float rm = fmaxf(ra, rb); rm = fmaxf(rm, __shfl_xor(rm, 32));
            if ((OWN && p == 0) || __any(rm > THR)) {
                const float dl = (OWN && p == 0) ? rm : fmaxf(rm, 0.f); m_run += dl;
                const float fsc = __builtin_amdgcn_exp2f(-dl); l_run *= fsc;
#pragma unroll
                for (int r = 0; r < 16; ++r) { s0[r] -= dl; s1[r] -= dl; o0[r] *= fsc; o1[r] *= fsc; negm[r] = -m_run; }
                cdirty = true;
            }
            float rs0 = 0.f, rs1 = 0.f;
#pragma unroll
            for (int r = 0; r < 16; ++r) { s0[r] = __builtin_amdgcn_exp2f(s0[r]); s1[r] = __builtin_amdgcn_exp2f(s1[r]); rs0 += s0[r]; rs1 += s1[r]; }
            l_run += rs0 + rs1;
            bf16x8 pf[4];
#pragma unroll
            for (int s = 0; s < 2; ++s) { v4u a, b;
                a.x = pg8::cvt_pk_bf16(s0[8 * s + 0], s0[8 * s + 1]); a.y = pg8::cvt_pk_bf16(s0[8 * s + 2], s0[8 * s + 3]); a.z = pg8::cvt_pk_bf16(s0[8 * s + 4], s0[8 * s + 5]); a.w = pg8::cvt_pk_bf16(s0[8 * s + 6], s0[8 * s + 7]);
                b.x = pg8::cvt_pk_bf16(s1[8 * s + 0], s1[8 * s + 1]); b.y = pg8::cvt_pk_bf16(s1[8 * s + 2], s1[8 * s + 3]); b.z = pg8::cvt_pk_bf16(s1[8 * s + 4], s1[8 * s + 5]); b.w = pg8::cvt_pk_bf16(s1[8 * s + 6], s1[8 * s + 7]);
                pf[s] = __builtin_bit_cast(bf16x8, a); pf[2 + s] = __builtin_bit_cast(bf16x8, b); }
#pragma unroll
            for (int s = 0; s < 4; ++s) {
                const bf16x8 va = (bf16x8){vt[4 * s][0], vt[4 * s][1], vt[4 * s][2], vt[4 * s][3], vt[4 * s + 1][0], vt[4 * s + 1][1], vt[4 * s + 1][2], vt[4 * s + 1][3]};
                const bf16x8 vb = (bf16x8){vt[4 * s + 2][0], vt[4 * s + 2][1], vt[4 * s + 2][2], vt[4 * s + 2][3], vt[4 * s + 3][0], vt[4 * s + 3][1], vt[4 * s + 3][2], vt[4 * s + 3][3]};
                o0 = __builtin_amdgcn_mfma_f32_32x32x16_bf16(va, pf[s], o0, 0, 0, 0);
                o1 = __builtin_amdgcn_mfma_f32_32x32x16_bf16(vb, pf[s], o1, 0, 0, 0); }
        }
        if (p + 1 < NT) { const int nb = cb ^ 1;
            *(LAS v4u*)(Kl + nb * KBUF + kst) = kreg; if (k2) *(LAS v4u*)(Kl + nb * KBUF + kst2) = kreg2; *(LAS v4u*)(Vl + nb * VBUF + vst) = vreg; }
        __syncthreads();
        __syncthreads();
    };
    for (int p = 0; p < 4; ++p) slot(p, AttOwn{});
    for (int p = 4; p < NT; ++p) slot(p, AttPast{});
    l_run += __shfl_xor(l_run, 32);
    const float rl = 1.0f / l_run;
    { float ss = 0.f;
#pragma unroll
      for (int r = 0; r < 16; ++r) { const float a = o0[r] * rl, b = o1[r] * rl; ss += a * a + b * b; }
      ss += __shfl_xor(ss, 32);
      if (hi == 0) ((GAS float*)ossq_)[(size_t)(qb * 256 + wid * 32 + r32) * 16] = ss; }
    LAS unsigned char* stg = lds + 65536 + wid * 4608; const float rl16 = rl * 16.0f;
#pragma unroll
    for (int g = 0; g < 4; ++g) {
        *(LAS unsigned*)(stg + r32 * 80 + (8 * g + 4 * hi)) = pk4_fp8(o0[4 * g] * rl16, o0[4 * g + 1] * rl16, o0[4 * g + 2] * rl16, o0[4 * g + 3] * rl16);
        *(LAS unsigned*)(stg + r32 * 80 + (32 + 8 * g + 4 * hi)) = pk4_fp8(o1[4 * g] * rl16, o1[4 * g + 1] * rl16, o1[4 * g + 2] * rl16, o1[4 * g + 3] * rl16); }
    asm volatile("s_waitcnt lgkmcnt(0)" ::: "memory");
    GAS unsigned char* obase = (GAS unsigned char*)Og + (size_t)(qb * 256 + wid * 32) * opitch;
#pragma unroll
    for (int i = 0; i < 2; ++i) { const int row = i * 16 + (lane >> 2), ch = lane & 3; const v4u v = *(const LAS v4u*)(stg + row * 80 + ch * 16); *(GAS v4u*)(obase + (size_t)row * opitch + ch * 16) = v; }
    asm volatile("s_waitcnt lgkmcnt(0)" ::: "memory");
}

__device__ __forceinline__ void transpose_item(const float* W_, int ldw, bf16* WT, int ldt, int k0, int n0, int dr0, int dr1, LAS float* scr, int lane, const float* kgain = nullptr) {
    const GAS float* W = (const GAS float*)W_; const int q = lane & 15, kr = lane >> 4; const bool ld_ok = (q < 8) ? (dr0 >= 0) : (dr1 >= 0);
#pragma unroll 4
    for (int i = 0; i < 16; ++i) { const int kk = 4 * i + kr; f32x4 v = {0.f, 0.f, 0.f, 0.f}; if (ld_ok) v = *(const GAS f32x4*)(W + (size_t)(k0 + kk) * ldw + n0 + 4 * q);
        if (kgain) v = v * ((const GAS float*)kgain)[k0 + kk];
        LAS float* s = scr + kk * 65 + 4 * q; s[0] = v[0]; s[1] = v[1]; s[2] = v[2]; s[3] = v[3]; }
    asm volatile("s_waitcnt lgkmcnt(0)" ::: "memory");
    const int c = lane & 7;
#pragma unroll
    for (int j = 0; j < 8; ++j) { const int n = 8 * j + (lane >> 3); const LAS float* s = scr + (8 * c) * 65 + n; const int dr = (n < 32) ? dr0 : dr1;
        v4u o; o.x = pk2(s[0 * 65], s[1 * 65]); o.y = pk2(s[2 * 65], s[3 * 65]); o.z = pk2(s[4 * 65], s[5 * 65]); o.w = pk2(s[6 * 65], s[7 * 65]);
        if (dr >= 0) *(GAS v4u*)(WT + (size_t)(dr + (n & 31)) * ldt + k0 + 8 * c) = o; }
    asm volatile("s_waitcnt lgkmcnt(0)" ::: "memory");
}

__device__ __forceinline__ void transpose_item8(const float* W_, int ldw, unsigned char* WT8, int ldt, int k0, int n0, int dr0, int dr1, LAS float* scr, int lane, float scale, const float* kgain = nullptr) {
    const GAS float* W = (const GAS float*)W_; const int q = lane & 15, kr = lane >> 4; const bool ld_ok = (q < 8) ? (dr0 >= 0) : (dr1 >= 0);
#pragma unroll 4
    for (int i = 0; i < 16; ++i) { const int kk = 4 * i + kr; f32x4 v = {0.f, 0.f, 0.f, 0.f}; if (ld_ok) v = *(const GAS f32x4*)(W + (size_t)(k0 + kk) * ldw + n0 + 4 * q);
        if (kgain) v = v * ((const GAS float*)kgain)[k0 + kk];
        v = v * scale;
        LAS float* s = scr + kk * 65 + 4 * q; s[0] = v[0]; s[1] = v[1]; s[2] = v[2]; s[3] = v[3]; }
    asm volatile("s_waitcnt lgkmcnt(0)" ::: "memory");
    const int c = lane & 7;
#pragma unroll
    for (int j = 0; j < 8; ++j) { const int n = 8 * j + (lane >> 3); const LAS float* s = scr + (8 * c) * 65 + n; const int dr = (n < 32) ? dr0 : dr1;
        v2u o; o.x = pk4_fp8(s[0 * 65], s[1 * 65], s[2 * 65], s[3 * 65]); o.y = pk4_fp8(s[4 * 65], s[5 * 65], s[6 * 65], s[7 * 65]);
        if (dr >= 0) *(GAS v2u*)((GAS unsigned char*)WT8 + (size_t)(dr + (n & 31)) * ldt + k0 + 8 * c) = o; }
    asm volatile("s_waitcnt lgkmcnt(0)" ::: "memory");
}

struct Args {
    const float* x; const float* attn_g; const float* w_in; const float* qlat_g; const float* w_qup; const float* kvlat_g; const float* w_kvup;
    const float* qhead_g; const float* khead_g; const float* mqhead_g; const float* mkhead_g; const float* onorm_a_g; const float* onorm_b_g; const float* w_out;
    const float* ffn_g; const float* w_rg; const float* b_rg; const float* w_re; const float* b_re; const float* w_gate; const float* w_up; const float* w_down;
    float* out; unsigned char* ws; int ph_lo, ph_hi;
};
enum { PH_PRO = 0, PH_PROJ, PH_UP, PH_ATTN, PH_OUT, PH_ROUTE, PH_GU, PH_D0, NPHASE };

__global__ void __launch_bounds__(512, 2) mk_fwd(Args A) {
    extern __shared__ __attribute__((aligned(16))) unsigned char lds_raw[];
    LAS unsigned char* lds = (LAS unsigned char*)lds_raw;
    const int tid0 = threadIdx.x;
    const int G = gridDim.x, bx = blockIdx.x;
#define NGW (G * 8)
#define PH_BEGIN int tid = threadIdx.x; asm volatile("" : "+v"(tid)); const int lane = tid & 63; const int wave = __builtin_amdgcn_readfirstlane(tid >> 6); const int gw = bx * 8 + wave; \
    const __attribute__((address_space(4))) Args* AP = (const __attribute__((address_space(4))) Args*)__builtin_amdgcn_kernarg_segment_ptr(); asm volatile("" : "+s"(AP)); \
    unsigned char* ws = AP->ws; (void)lane; (void)gw; (void)ws;
#define Win_t ((bf16*)(ws + WS_WIN))
#define Wq_t ((bf16*)(ws + WS_WQ))
#define Wkv_t ((bf16*)(ws + WS_WKV))
#define Wo_t ((bf16*)(ws + WS_WO))
#define Wgu_t ((bf16*)(ws + WS_WGU))
#define Wd_t ((bf16*)(ws + WS_WD))
#define ropeF ((float*)(ws + WS_ROPE))
#define ropeR (((float*)(ws + WS_ROPE)) + 2 * SEQ * 32)
#define kmean ((float*)(ws + WS_KMEAN))
#define XN ((bf16*)(ws + WS_XN))
#define X1B ((bf16*)(ws + WS_X1B))
#define VB ((bf16*)(ws + WS_VB))
#define YH ((bf16*)(ws + WS_YH))
#define Y0B ((bf16*)(ws + WS_Y0))
#define SSQ ((float*)(ws + WS_SSQ))
#define WREF ((float*)(ws + WS_WRE))
#define WRGF ((float*)(ws + WS_WRE + 131072))
#define OSSQ ((float*)(ws + WS_OSSQ))
#define QB ((bf16*)(ws + WS_QB))
#define KB ((bf16*)(ws + WS_KB))
#define QA ((bf16*)(ws + WS_QA))
#define VA ((bf16*)(ws + WS_VA))
#define KA ((bf16*)(ws + WS_KA))
#define QLN ((bf16*)(ws + WS_QLN))
#define KVLN ((bf16*)(ws + WS_KVLN))
#define HB ((bf16*)(ws + WS_H))
#define lists ((pg8::ListEnt*)(ws + WS_LISTS))
    volatile LAS unsigned* MISC = (volatile LAS unsigned*)(lds + LDSCTL_OFF);
    for (int u = tid0; u < (LDS_BYTES - LDSCTL_OFF) / 4; u += 512) ((LAS unsigned*)(lds + LDSCTL_OFF))[u] = 0u;
    __syncthreads();
    XcdBarrier bar = xcd_barrier_post((unsigned*)((gu32*)(A.ws + WS_CTL) + CW_BAR), MISC + 8);
    const int lo = A.ph_lo, hi = A.ph_hi;
#define IN(k) (lo <= (k) && (k) < hi)
#define MOE_SLOT(npn) ((G == 256) ? ((((bx >> 3) / (npn)) * 8 + (bx & 7)) * (npn) + ((bx >> 3) % (npn))) : bx)
#define SEAM(k) do { if (IN(k) && IN((k) + 1)) xcd_barrier(bar); } while (0)

    if (IN(PH_PRO)) { PH_BEGIN
        LAS float* scr = (LAS float*)(lds + wave * 16640);
        constexpr int I_IN = 16 * 31, I_QU = 4 * 12, I_KV = 2 * 16, I_WO = 16 * 16, I_G = 32 * 64, I_U = 32 * 64, I_D = 32 * 64;
        constexpr int NITEMS = I_IN + I_QU + I_KV + I_WO + I_G + I_U + I_D;
        for (int it = gw; it < NITEMS; it += NGW) {
            int r = it;
            if (r < I_IN) { const int kb = r / 31, nb = r % 31; int dr[2];
#pragma unroll
                for (int h2 = 0; h2 < 2; ++h2) { const int gi = 2 * nb + h2;
                    if (gi < 13) dr[h2] = 32 * gi; else if (gi < 45) { const int q = (gi - 13) & 15, hh = q >> 1, bj = q & 1; dr[h2] = (gi < 29 ? 512 : 1024) + (hh >> 2) * 256 + bj * 128 + (hh & 3) * 32; } else if (gi < 61) dr[h2] = 1536 + (gi - 45) * 32; else dr[h2] = -1; }
                transpose_item(AP->w_in, NPROJ_REAL, Win_t, 1024, 64 * kb, 64 * nb, dr[0], dr[1], scr, lane); continue; } r -= I_IN;
            if (r < I_QU) { const int kb = r / 12, nb = r % 12; transpose_item(AP->w_qup, 768, Wq_t, 256, 64 * kb, 64 * nb, 64 * nb, 64 * nb + 32, scr, lane, AP->qlat_g); continue; } r -= I_QU;
            if (r < I_KV) { const int kb = r / 16, nb = r % 16; const int n0 = 64 * nb, hh = n0 >> 7, j0 = n0 & 127;
                const int d0 = (j0 < 64) ? ((hh >> 2) * 256 + (hh & 3) * 32) : (512 + hh * 64), d1 = (j0 < 64) ? (d0 + 128) : (d0 + 32);
                transpose_item(AP->w_kvup, 1024, Wkv_t, 256, 64 * kb, n0, d0, d1, scr, lane, AP->kvlat_g); continue; } r -= I_KV;
            if (r < I_WO) { const int kb = r / 16, nb = r % 16; transpose_item8(AP->w_out, 1024, (unsigned char*)Wo_t, 1024, 64 * kb, 64 * nb, 64 * nb, 64 * nb + 32, scr, lane, 32.0f, kb < 8 ? AP->onorm_a_g : AP->onorm_b_g - 512); continue; } r -= I_WO;
            if (r < I_G) { const int e = r >> 6, r2 = r & 63, kb = r2 >> 2, nb = r2 & 3; const int n0 = 64 * nb; const int d0 = (n0 >> 7) * 256 + (n0 & 127);
                transpose_item8(AP->w_gate + (size_t)e * 1024 * 256, 256, (unsigned char*)Wgu_t + (size_t)e * 512 * 1024, 1024, 64 * kb, n0, d0, d0 + 32, scr, lane, 32.0f); continue; } r -= I_G;
            if (r < I_U) { const int e = r >> 6, r2 = r & 63, kb = r2 >> 2, nb = r2 & 3; const int n0 = 64 * nb; const int d0 = (n0 >> 7) * 256 + 128 + (n0 & 127);
                transpose_item8(AP->w_up + (size_t)e * 1024 * 256, 256, (unsigned char*)Wgu_t + (size_t)e * 512 * 1024, 1024, 64 * kb, n0, d0, d0 + 32, scr, lane, 32.0f); continue; } r -= I_U;
            { const int e = r >> 6, r2 = r & 63, kb = r2 >> 4, nb = r2 & 15;
                transpose_item8(AP->w_down + (size_t)e * 256 * 1024, 1024, (unsigned char*)Wd_t + (size_t)e * 1024 * 256, 256, 64 * kb, 64 * nb, 64 * nb, 64 * nb + 32, scr, lane, 16.0f); }
        }
        const int gt = bx * 512 + tid, NGT = G * 512;
        for (int i = gt; i < 96 * 128; i += NGT) *(GAS v4u*)(Win_t + (size_t)416 * 1024 + (size_t)i * 8) = (v4u){0u, 0u, 0u, 0u};
        for (int i = gt; i < 1024 * 16; i += NGT) *(GAS v4u*)(Wkv_t + (size_t)(i >> 4) * 256 + 128 + (i & 15) * 8) = (v4u){0u, 0u, 0u, 0u};
        for (int i = gt; i < SEQ * 48; i += NGT) {
            const int pos = i / 48, f = i % 48; const bool isF = f < 32; const int ff = isF ? f : f - 32;
            const double e = isF ? (double)ff / 32.0 : (double)ff / 16.0;
            const float invf = (float)exp2(-e * 13.287712379549449);
            const float ang = (float)pos * invf;
            const double a = (double)ang; const double kk = rint(a * 0.15915494309189535); const double rr = a - kk * 6.283185307179586;
            const float c = (float)cos(rr), s = (float)sin(rr);
            GAS float* rF = (GAS float*)ropeF; GAS float* rR = (GAS float*)ropeR;
            if (isF) { rF[pos * 32 + ff] = c; rF[SEQ * 32 + pos * 32 + ff] = s; } else { rR[pos * 16 + ff] = c; rR[SEQ * 16 + pos * 16 + ff] = s; }
        }
        for (int i = gt; i < 1024 * 8; i += NGT) { const float gk = AP->ffn_g[i >> 3]; *((GAS f32x4*)WREF + i) = *((const GAS f32x4*)AP->w_re + i) * gk; }
        for (int i = gt; i < 1024; i += NGT) { const float gk = AP->ffn_g[i]; *((GAS f32x4*)WRGF + i) = *((const GAS f32x4*)AP->w_rg + i) * gk; }
        for (int t = gw; t < T; t += 2 * NGW) {
            const int t2 = (t + NGW < T) ? t + NGW : t;
            const GAS f32x4* xr = (const GAS f32x4*)(AP->x + (size_t)t * D) + lane; const GAS f32x4* xr2 = (const GAS f32x4*)(AP->x + (size_t)t2 * D) + lane; f32x4 v[4], w[4]; float s = 0.f, s2 = 0.f;
#pragma unroll
            for (int j = 0; j < 4; ++j) { v[j] = xr[64 * j]; w[j] = xr2[64 * j]; }
#pragma unroll
            for (int j = 0; j < 4; ++j) { s += (v[j].x * v[j].x + v[j].y * v[j].y) + (v[j].z * v[j].z + v[j].w * v[j].w); s2 += (w[j].x * w[j].x + w[j].y * w[j].y) + (w[j].z * w[j].z + w[j].w * w[j].w); }
            const float rstd = 1.0f / sqrtf(wave_sum(s) * (1.f / D) + EPS), rstd2 = 1.0f / sqrtf(wave_sum(s2) * (1.f / D) + EPS);
            GAS unsigned long long* o8 = (GAS unsigned long long*)(XN + (size_t)t * D) + lane; GAS unsigned long long* o82 = (GAS unsigned long long*)(XN + (size_t)t2 * D) + lane;
#pragma unroll
            for (int j = 0; j < 4; ++j) { const f32x4 g = *((const GAS f32x4*)AP->attn_g + lane + 64 * j);
                o8[64 * j] = (unsigned long long)pk2(v[j].x * rstd * g.x, v[j].y * rstd * g.y) | ((unsigned long long)pk2(v[j].z * rstd * g.z, v[j].w * rstd * g.w) << 32);
                o82[64 * j] = (unsigned long long)pk2(w[j].x * rstd2 * g.x, w[j].y * rstd2 * g.y) | ((unsigned long long)pk2(w[j].z * rstd2 * g.z, w[j].w * rstd2 * g.w) << 32); }
        }
    }
    SEAM(PH_PRO);

    if (IN(PH_PROJ)) { PH_BEGIN
        pg8::Gemm g{XN, Win_t, T, NPROJ, D}; pg8::StaticOrder S; S.init(T, NPROJ, G, bx);
        pg8::EpiProj E{ws, WS_QLN, WS_KVLN, WS_QB, WS_KB, WS_VB, WS_SSQ, WS_KMEAN, WS_ROPE, AP->mqhead_g, AP->mkhead_g, C2B, EPS, SEQ};
        pg8::gemm_phase<pg8::EpiProj, pg8::StaticOrder, true, true>(lds, g, S, E);
    }
    SEAM(PH_PROJ);

    if (IN(PH_UP)) { PH_BEGIN
        { int K256 = 256; asm volatile("" : "+s"(K256)); pg8::Gemm g{QLN, Wq_t, T, 768, K256}; pg8::StaticOrder S; S.init(T, 768, G, bx); pg8::EpiBf16Rs E{QA, 768, SSQ, 0, 1.0f / 256.0f, EPS};
          pg8::gemm_phase<pg8::EpiBf16Rs, pg8::StaticOrder, true, true>(lds, g, S, E); }
        { int K256 = 256; asm volatile("" : "+s"(K256)); pg8::Gemm g{KVLN, Wkv_t, T, 1024, K256}; pg8::StaticOrder S; S.init(T, 1024, G, bx); pg8::EpiKv E{KA, VA, KVLN, SSQ, ropeR, AP->khead_g, EPS, SEQ};
          pg8::gemm_phase<pg8::EpiKv, pg8::StaticOrder, true, true>(lds, g, S, E); }
    }
    SEAM(PH_UP);

    if (IN(PH_ATTN)) { PH_BEGIN
        bf16* O = XN;
        for (int u = bx; u < 512; u += G) {
            const int bh = u & 255, b = bh >> 3, h = bh & 7; const size_t r0 = (size_t)b * SEQ;
            if (u < 256) {
                for (int qb = 7; qb >= 0; --qb)
                    attn_unit<96, false, true>(lds, AP->qhead_g, ropeR, QA + r0 * 768 + h * 96, 768, KA + r0 * 768 + h * 96, 768, VA + r0 * 512 + h * 64, 512, (bf16*)((unsigned char*)O + r0 * 1024 + h * 64), 1024, OSSQ + r0 * 16 + h, qb, nullptr, 0);
            } else {
                for (int qb = 7; qb >= 0; --qb)
                    attn_unit<64, true, false>(lds, nullptr, nullptr, QB + r0 * 512 + h * 64, 512, KB + r0 * 512 + h * 64, 512, VB + r0 * 512 + h * 64, 512, (bf16*)((unsigned char*)O + r0 * 1024 + 512 + h * 64), 1024, OSSQ + r0 * 16 + 8 + h, qb, kmean + ((size_t)b * 8 * NH + h) * 64, NH * 64);
            }
        }
    }
    SEAM(PH_ATTN);

    if (IN(PH_OUT)) { PH_BEGIN
        pg8::Gemm g{XN, Wo_t, T, D, D / 2};        pg8::StaticOrder S; S.init(T, D, G, bx);
        LAS float* rsl = (LAS float*)(lds + RING_BYTES);
        { pg8::Unit uu;
          for (int i = 0; i < 12 && S.next(i, uu); ++i) if (tid < 256) { const GAS f32x4* pq = (const GAS f32x4*)((const GAS float*)OSSQ + (size_t)(uu.pm * 256 + tid) * 16); const f32x4 a0 = pq[0], a1 = pq[1], b0 = pq[2], b1 = pq[3];
              const float sa = ((a0[0] + a0[1]) + (a0[2] + a0[3])) + ((a1[0] + a1[1]) + (a1[2] + a1[3])), sb = ((b0[0] + b0[1]) + (b0[2] + b0[3])) + ((b1[0] + b1[1]) + (b1[2] + b1[3]));
              const float ra = 1.0f / sqrtf(sa * (1.0f / 512.0f) + EPS), rb = 1.0f / sqrtf(sb * (1.0f / 512.0f) + EPS);
              *(LAS f32x2*)(rsl + (i * 256 + tid) * 2) = (f32x2){ra / rb, rb}; }
          __syncthreads(); }
        pg8::EpiOut E{AP->x, X1B, rsl};
        pg8::gemm_phase<pg8::EpiOut, pg8::StaticOrder, true, true, false, false, true, 0x7a7a7a7a, 0x7b7b7b7b, true>(lds, g, S, E);
    }
    SEAM(PH_OUT);

    if (IN(PH_ROUTE)) { PH_BEGIN
        LAS float* Wrg = (LAS float*)(lds + P8_WRG); LAS float* xt = (LAS float*)(lds + P8_XT + wave * P8_XT_WAVE); LAS float* wc = (LAS float*)(lds + P8_WC);
        LAS int* rt_g = (LAS int*)(lds + P8_RT); LAS float* rt_w = (LAS float*)(lds + P8_RT + 1024); LAS int* rt_rank = (LAS int*)(lds + P8_RT + 3072);
        LAS int* lcnt = (LAS int*)(lds + P8_RT + 4096); LAS int* lbase = (LAS int*)(lds + P8_RT + 4608); LAS float* rt_rs = (LAS float*)(lds + P8_RT + 5120);
        for (int k = tid; k < 1024; k += 512) *(LAS f32x4*)(Wrg + 4 * k) = *((const GAS f32x4*)WRGF + k);
        __syncthreads();
        const int r32 = lane & 31, kh = lane >> 5;
        for (int chunk = bx; chunk < T / 256; chunk += G) {
            if (tid < NCLS) lcnt[tid] = 0;
            const int rowc = wave * 32 + r32; const size_t row0w = (size_t)chunk * 256 + wave * 32;
            const GAS bf16* xsrc = (const GAS bf16*)X1B + (row0w + (lane >> 4)) * D + 4 * (lane & 15);
            f32x16 accE = {}; float aG0 = 0.f, aG1 = 0.f, aG2 = 0.f, aG3 = 0.f, ssq = 0.f;
            *(LAS f32x4*)(wc + 4 * tid) = *((const GAS f32x4*)WREF + tid);
            v2u xn[8]; f32x4 gvn;
#pragma unroll
            for (int j = 0; j < 8; ++j) xn[j] = *(const GAS v2u*)(xsrc + (size_t)(4 * j) * D);
            gvn = *(const GAS f32x4*)((const GAS float*)AP->ffn_g + 4 * (lane & 15));
#pragma unroll 1
            for (int kc = 0; kc < 16; ++kc) {
                f32x4 st[8];
#pragma unroll
                for (int j = 0; j < 8; ++j) st[j] = (f32x4){bflo(xn[j].x), bfhi(xn[j].x), bflo(xn[j].y), bfhi(xn[j].y)};
                const f32x4 gv = gvn;
                if (kc + 1 < 16) {
#pragma unroll
                    for (int j = 0; j < 8; ++j) xn[j] = *(const GAS v2u*)(xsrc + (size_t)(4 * j) * D + (kc + 1) * 64);
                    gvn = *(const GAS f32x4*)((const GAS float*)AP->ffn_g + (kc + 1) * 64 + 4 * (lane & 15)); }
                f32x4 wnext = {0.f, 0.f, 0.f, 0.f}; if (kc + 1 < 16) wnext = *((const GAS f32x4*)WREF + (kc + 1) * 512 + tid);
#pragma unroll
                for (int j = 0; j < 8; ++j) *(LAS f32x4*)(xt + ((lane >> 4) + 4 * j) * 68 + 4 * (lane & 15)) = st[j];
                if (kc + 1 < 16) *(LAS f32x4*)(wc + ((kc + 1) & 1) * 2048 + 4 * tid) = wnext;
                {
#pragma unroll
                  for (int j = 0; j < 8; ++j) { const f32x4 hv = st[j] * gv;
                      *(GAS unsigned*)((GAS unsigned char*)YH + (size_t)(row0w + (lane >> 4) + 4 * j) * D + kc * 64 + 4 * (lane & 15)) = pk4_fp8(hv[0], hv[1], hv[2], hv[3]); } }
                __syncthreads();
                const LAS float* wcc = wc + (kc & 1) * 2048 + r32;
#pragma unroll
                for (int c = 0; c < 8; ++c) {
                    const f32x4 xv = *(const LAS f32x4*)(xt + r32 * 68 + 8 * c + 4 * kh);
                    ssq += (xv.x * xv.x + xv.y * xv.y) + (xv.z * xv.z + xv.w * xv.w);
#pragma unroll
                    for (int e = 0; e < 4; ++e) { const int kl = 8 * c + 4 * kh + e;
                        const float a = wcc[kl * 32]; accE = __builtin_amdgcn_mfma_f32_32x32x2f32(a, xv[e], accE, 0, 0, 0);
                        const f32x4 wg = *(const LAS f32x4*)(Wrg + 4 * (kc * 64 + kl)); aG0 += xv[e] * wg[0]; aG1 += xv[e] * wg[1]; aG2 += xv[e] * wg[2]; aG3 += xv[e] * wg[3]; }
                }
                __syncthreads();
            }
            ssq += __shfl_xor(ssq, 32); aG0 += __shfl_xor(aG0, 32); aG1 += __shfl_xor(aG1, 32); aG2 += __shfl_xor(aG2, 32); aG3 += __shfl_xor(aG3, 32);
            const float rstd = 1.0f / sqrtf(ssq * (1.f / D) + EPS);
            float lg[4] = {aG0 * rstd + AP->b_rg[0], aG1 * rstd + AP->b_rg[1], aG2 * rstd + AP->b_rg[2], aG3 * rstd + AP->b_rg[3]};
            int gs = 0; float gm = lg[0];
#pragma unroll
            for (int i = 1; i < 4; ++i) if (lg[i] > gm) { gm = lg[i]; gs = i; }
            float den = 0.f;
#pragma unroll
            for (int i = 0; i < 4; ++i) den += __expf(lg[i] - gm);
            const float gwt = 1.0f / den;
            float mine[4];
#pragma unroll
            for (int i = 0; i < 4; ++i) { const float v = (gs == 0) ? accE[i] : (gs == 1) ? accE[4 + i] : (gs == 2) ? accE[8 + i] : accE[12 + i]; mine[i] = v * rstd + AP->b_re[gs * 8 + 4 * kh + i]; }
            float ev[8];
#pragma unroll
            for (int i = 0; i < 4; ++i) { const float oth = __shfl_xor(mine[i], 32); ev[i] = kh ? oth : mine[i]; ev[4 + i] = kh ? mine[i] : oth; }
            int e1 = 0; float v1 = ev[0];
#pragma unroll
            for (int i = 1; i < 8; ++i) if (ev[i] > v1) { v1 = ev[i]; e1 = i; }
            int e2 = -1; float v2 = -INFINITY;
#pragma unroll
            for (int i = 0; i < 8; ++i) if (i != e1 && (e2 < 0 || ev[i] > v2)) { v2 = ev[i]; e2 = i; }
            const float ex = __expf(v2 - v1); const float w1 = gwt / (1.0f + ex), w2 = gwt * ex / (1.0f + ex);
            if (kh == 0) { const int elo = e1 < e2 ? e1 : e2, ehi = e1 < e2 ? e2 : e1;
                rt_g[rowc] = gs * 28 + ((elo * (15 - elo)) >> 1) + (ehi - elo - 1); rt_w[rowc * 2] = e1 < e2 ? w1 : w2; rt_w[rowc * 2 + 1] = e1 < e2 ? w2 : w1; rt_rs[rowc] = rstd; }
            __syncthreads();
            if (tid < 256) rt_rank[tid] = __hip_atomic_fetch_add(&lcnt[rt_g[tid]], 1, __ATOMIC_RELAXED, __HIP_MEMORY_SCOPE_WORKGROUP);
            __syncthreads();
            if (tid < NCLS) { const int n = lcnt[tid]; lbase[tid] = n ? (int)__hip_atomic_fetch_add((gu32*)(ws + WS_CTL) + CW_GCNT + 64 * tid, (unsigned)n, RLX_AGENT) : 0; }
            __syncthreads();
            if (tid < 256) { const int g = rt_g[tid]; v4u ev; ev.x = (unsigned)(chunk * 256 + tid); ev.y = __builtin_bit_cast(unsigned, rt_w[tid * 2]); ev.z = __builtin_bit_cast(unsigned, rt_w[tid * 2 + 1]); ev.w = __builtin_bit_cast(unsigned, rt_rs[tid]);
                ((GAS v4u*)lists)[(size_t)g * LIST_CAP + lbase[g] + rt_rank[tid]] = ev; }
            __syncthreads();
        }
    }
    SEAM(PH_ROUTE);

    LAS int* tp = (LAS int*)(lds + TP_OFF); LAS int* cntl = (LAS int*)(lds + CNT_OFF); LAS int* ptab = (LAS int*)(lds + PT_OFF);
    if (hi > PH_ROUTE) {
        if (tid0 == 0) { gu32* ctl = (gu32*)(A.ws + WS_CTL); int acc = 0; for (int g = 0; g < NCLS; ++g) { const int n = (int)__hip_atomic_load(ctl + CW_GCNT + 64 * g, RLX_AGENT); cntl[g] = n; tp[g] = acc; acc += (n + 255) >> 8; } tp[NCLS] = acc;
            int p = 0; for (int lo_ = 0; lo_ < 8; ++lo_) for (int hi_ = lo_ + 1; hi_ < 8; ++hi_) ptab[p++] = lo_ | (hi_ << 4); }
        __syncthreads();
    }

    if (IN(PH_GU)) { PH_BEGIN
        pg8::Gemm g{YH, Wgu_t, 0, 0, D / 2}; pg8::ClsOrder S{tp, ptab, 0, G, MOE_SLOT(4), lists, cntl};
        pg8::EpiGateUp2 E{HB, lists, cntl};
        pg8::gemm_phase<pg8::EpiGateUp2, pg8::ClsOrder, true, true, true, false, true>(lds, g, S, E);
    }
    SEAM(PH_GU);

    if (IN(PH_D0)) { PH_BEGIN
        int K512 = 256; asm volatile("" : "+s"(K512)); pg8::Gemm g{HB, Wd_t, 0, 0, K512};        pg8::ClsOrder S{tp, ptab, 1, G, MOE_SLOT(4), lists, cntl};
        pg8::EpiDown2 E{AP->out, X1B, lists, cntl};
        pg8::gemm_phase<pg8::EpiDown2, pg8::ClsOrder, true, true, false, true, true, 0x7b7b7b7b, 0x7c7c7c7c, true>(lds, g, S, E);
    }
#undef IN
#undef SEAM
}

extern "C" void kernel_launch(void* const* d_in, const int* in_sizes, int n_in, void* d_out, int out_size, void* d_ws, size_t ws_size, hipStream_t stream) {
    static int grid = 0;
    if (grid == 0) {
        if (n_in != 22 || in_sizes[0] != T * D || out_size != T * D || ws_size < WS_END) { fprintf(stderr, "kernel_launch: unexpected shapes (n_in %d, in0 %d, out %d, ws %zu); nothing launched\n", n_in, n_in > 0 ? in_sizes[0] : -1, out_size, ws_size); grid = -1; return; }
        int dev = 0, cus = 0, per_cu = 0;
        if (hipGetDevice(&dev) != hipSuccess || hipDeviceGetAttribute(&cus, hipDeviceAttributeMultiprocessorCount, dev) != hipSuccess) { grid = -1; return; }
        if (hipFuncSetAttribute((const void*)mk_fwd, hipFuncAttributeMaxDynamicSharedMemorySize, LDS_BYTES) != hipSuccess) { fprintf(stderr, "kernel_launch: hipFuncSetAttribute failed\n"); grid = -1; return; }
        if (hipOccupancyMaxActiveBlocksPerMultiprocessor(&per_cu, (const void*)mk_fwd, 512, LDS_BYTES) != hipSuccess || per_cu < 1) { fprintf(stderr, "kernel_launch: occupancy query says %d\n", per_cu); }
        (void)hipGetLastError();
        grid = cus;
    }
    if (grid < 0) return;
    if (hipMemsetAsync((char*)d_ws + WS_CTL, 0, CTL_ZERO_BYTES, stream) != hipSuccess) return;
    Args a{};
    a.x = (const float*)d_in[0]; a.attn_g = (const float*)d_in[1]; a.w_in = (const float*)d_in[2]; a.qlat_g = (const float*)d_in[3]; a.w_qup = (const float*)d_in[4];
    a.kvlat_g = (const float*)d_in[5]; a.w_kvup = (const float*)d_in[6]; a.qhead_g = (const float*)d_in[7]; a.khead_g = (const float*)d_in[8];
    a.mqhead_g = (const float*)d_in[9]; a.mkhead_g = (const float*)d_in[10]; a.onorm_a_g = (const float*)d_in[11]; a.onorm_b_g = (const float*)d_in[12];
    a.w_out = (const float*)d_in[13]; a.ffn_g = (const float*)d_in[14]; a.w_rg = (const float*)d_in[15]; a.b_rg = (const float*)d_in[16];
    a.w_re = (const float*)d_in[17]; a.b_re = (const float*)d_in[18]; a.w_gate = (const float*)d_in[19]; a.w_up = (const float*)d_in[20]; a.w_down = (const float*)d_in[21];
    a.out = (float*)d_out; a.ws = (unsigned char*)d_ws; a.ph_lo = 0; a.ph_hi = NPHASE;
    hipLaunchKernelGGL(mk_fwd, dim3(grid), dim3(512), LDS_BYTES, stream, a);
    (void)hipPeekAtLastError();
}
```

```cpp
#include <hip/hip_runtime.h>
#include <cstdio>
#include <cstdint>
namespace pg8 {
#define PG8_LAS __attribute__((address_space(3)))
typedef unsigned short bf16_t;
typedef short bf16x8 __attribute__((ext_vector_type(8)));
typedef float f32x4 __attribute__((ext_vector_type(4)));
typedef unsigned u32x4 __attribute__((ext_vector_type(4)));
constexpr int BM = 256, BK = 64, HALF = 128, HTB = HALF * BK * 2  , STAGE_BYTES = 8 * HTB, NXCD = 8, WGM = 8;

__host__ __device__ __forceinline__ int lds_byte(int r, int c) { const int st = (r >> 4) * 2 + (c >> 5), rr = r & 15, cc = c & 31, ob = rr * 64 + cc * 2; return st * 1024 + (ob ^ (((ob >> 9) & 1) << 5)); }
__host__ __device__ __forceinline__ void stage_rc(int b, int& R, int& C) { const int st = b / 1024, sb = b % 1024, swz = sb ^ (((sb >> 9) & 1) << 5); R = (st >> 1) * 16 + swz / 64; C = (st & 1) * 32 + (swz % 64) / 2; }
__host__ __device__ __forceinline__ int perm32(int rho) { const int n = rho >> 4, i = rho & 15; return 8 * (i >> 2) + 4 * n + (i & 3); }

struct Unit { int pm, pn, g0, g1, pn2, q; };
struct Gemm { const bf16_t* A; const bf16_t* Bt; int M, N, K; };

struct StaticOrder {
    int nM, nN, nwg, G, c;
    __host__ __device__ void init(int M, int N, int G_, int c_) { nM = M / BM; nN = N / BM; nwg = nM * nN; G = G_; c = c_; }
    __host__ __device__ bool next(int i, Unit& u) const {
        const long L = (long)i * G + c; if (L >= nwg) return false;
        int wgid = (int)L; { const int q = nwg / NXCD, r = nwg % NXCD, xcd = wgid % NXCD, off = wgid / NXCD; wgid = (xcd < r ? xcd * (q + 1) : r * (q + 1) + (xcd - r) * q) + off; }
        const int nig = WGM * nN, gid = wgid / nig, fm = gid * WGM, gsz = (nM - fm) < WGM ? (nM - fm) : WGM;
        u.pm = fm + ((wgid % nig) % gsz); u.pn = (wgid % nig) / gsz; u.g0 = i; u.g1 = 0; u.pn2 = 0; u.q = 0; return true;
    }
    __device__ __forceinline__ void a_ready(const Unit&) const {}
    __device__ __forceinline__ void done(const Unit&) const {}
};

__device__ __forceinline__ unsigned cvt_pk_bf16(float lo, float hi) { unsigned r; asm volatile("v_cvt_pk_bf16_f32 %0, %1, %2" : "=v"(r) : "v"(lo), "v"(hi)); return r; }
#define PG8_GAS __attribute__((address_space(1)))
struct ListEnt { int tok; float w_lo; float w_hi; float rstd; };

struct EpiBf16 {
    static constexpr bool PERM = true, AFTER_DRAIN = false, MIDHOOK = false;
    bf16_t* O; int ldc;
    __device__ __forceinline__ void operator()(const f32x4 (&acc)[2][2][4][2], const Unit& u, int wr, int wc, int fr, int fq) const {
        const int row0 = u.pm * BM + wr * 64 + fr; const int col0 = u.pn * BM + wc * 32 + 8 * fq;
#pragma unroll
        for (int ai = 0; ai < 2; ++ai)
#pragma unroll
            for (int m = 0; m < 4; ++m) { bf16_t* rowp = O + (size_t)(row0 + ai * HALF + m * 16) * ldc + col0;
#pragma unroll
                for (int bj = 0; bj < 2; ++bj) { const f32x4 v0 = acc[ai][bj][m][0], v1 = acc[ai][bj][m][1];
                    u32x4 w; w.x = cvt_pk_bf16(v0[0], v0[1]); w.y = cvt_pk_bf16(v0[2], v0[3]); w.z = cvt_pk_bf16(v1[0], v1[1]); w.w = cvt_pk_bf16(v1[2], v1[3]);
                    *(PG8_GAS u32x4*)(rowp + bj * HALF) = w; } }
    }
};
struct EpiBf16Rs {
    static constexpr bool PERM = true, AFTER_DRAIN = false, MIDHOOK = false;
    bf16_t* O; int ldc; const float* ssq; int off; float inv_n, eps;
    __device__ __forceinline__ void operator()(const f32x4 (&acc)[2][2][4][2], const Unit& u, int wr, int wc, int fr, int fq) const {
        const int row0 = u.pm * BM + wr * 64 + fr; const int col0 = u.pn * BM + wc * 32 + 8 * fq;
#pragma unroll
        for (int ai = 0; ai < 2; ++ai)
#pragma unroll
            for (int m = 0; m < 4; ++m) { const int row = row0 + ai * HALF + m * 16; PG8_GAS bf16_t* rowp = (PG8_GAS bf16_t*)O + (size_t)row * ldc + col0;
                const f32x4 sq = *(const PG8_GAS f32x4*)(ssq + (size_t)row * 8 + off); const float rs = 1.0f / sqrtf(((sq[0] + sq[1]) + (sq[2] + sq[3])) * inv_n + eps);
#pragma unroll
                for (int bj = 0; bj < 2; ++bj) { const f32x4 v0 = acc[ai][bj][m][0] * rs, v1 = acc[ai][bj][m][1] * rs;
                    u32x4 w; w.x = cvt_pk_bf16(v0[0], v0[1]); w.y = cvt_pk_bf16(v0[2], v0[3]); w.z = cvt_pk_bf16(v1[0], v1[1]); w.w = cvt_pk_bf16(v1[2], v1[3]);
                    *(PG8_GAS u32x4*)(rowp + bj * HALF) = w; } }
    }
};
struct EpiProj {
    static constexpr bool PERM = true, AFTER_DRAIN = false, MIDHOOK = false;
    unsigned char* ws; size_t o_qln, o_kvln, o_qb, o_kb, o_vb, o_ssq, o_kmean, o_rope; const float* gq; const float* gk; float qscale, eps; int seq;
    __device__ __forceinline__ void operator()(const f32x4 (&acc)[2][2][4][2], const Unit& u, int wr, int wc, int fr, int fq) const {
        const int pn = u.pn; const int row0 = u.pm * BM + wr * 64 + fr;
        bf16_t* const QLN = (bf16_t*)(ws + o_qln); bf16_t* const KVLN = (bf16_t*)(ws + o_kvln); bf16_t* const QB = (bf16_t*)(ws + o_qb); bf16_t* const KB = (bf16_t*)(ws + o_kb); bf16_t* const VB = (bf16_t*)(ws + o_vb);
        float* const SSQ = (float*)(ws + o_ssq); float* const kmean = (float*)(ws + o_kmean); const float* const rope = (const float*)(ws + o_rope);
        if (pn < 2) {
            PG8_GAS bf16_t* O = (PG8_GAS bf16_t*)(pn ? KVLN : QLN); PG8_GAS float* sq = (PG8_GAS float*)SSQ;
#pragma unroll
            for (int ai = 0; ai < 2; ++ai)
#pragma unroll
                for (int m = 0; m < 4; ++m) { const int row = row0 + ai * HALF + m * 16; PG8_GAS bf16_t* rowp = O + (size_t)row * 256 + wc * 32 + 8 * fq; float ss = 0.f;
#pragma unroll
                    for (int bj = 0; bj < 2; ++bj) { const f32x4 v0 = acc[ai][bj][m][0], v1 = acc[ai][bj][m][1];
                        if (pn == 0 || bj == 0) ss += (v0[0] * v0[0] + v0[1] * v0[1]) + (v0[2] * v0[2] + v0[3] * v0[3]) + (v1[0] * v1[0] + v1[1] * v1[1]) + (v1[2] * v1[2] + v1[3] * v1[3]);
                        u32x4 w; w.x = cvt_pk_bf16(v0[0], v0[1]); w.y = cvt_pk_bf16(v0[2], v0[3]); w.z = cvt_pk_bf16(v1[0], v1[1]); w.w = cvt_pk_bf16(v1[2], v1[3]);
                        *(PG8_GAS u32x4*)(rowp + bj * HALF) = w; }
                    ss += __shfl_xor(ss, 16); ss += __shfl_xor(ss, 32);
                    if (fq == 0) sq[(size_t)row * 8 + pn * 4 + wc] = ss; }
        } else if (pn < 6) {
            const bool isk = pn >= 4; const int head = (pn & 1) * 4 + wc; const float* gp = isk ? gk : gq; asm volatile("" : "+s"(gp)); const float sc = isk ? 1.0f : qscale;
            PG8_GAS bf16_t* O = (PG8_GAS bf16_t*)(isk ? KB : QB);
            f32x4 g0[2], g1[2];
#pragma unroll
            for (int n = 0; n < 2; ++n) { g0[n] = *(const PG8_GAS f32x4*)(gp + 8 * fq + 4 * n); g1[n] = *(const PG8_GAS f32x4*)(gp + 32 + 8 * fq + 4 * n); }
            f32x4 cs0[2] = {{0.f, 0.f, 0.f, 0.f}, {0.f, 0.f, 0.f, 0.f}}, cs1[2] = {{0.f, 0.f, 0.f, 0.f}, {0.f, 0.f, 0.f, 0.f}};
            f32x4 rc[2][4];
            { const int pos0 = row0 & (seq - 1);
#pragma unroll
              for (int n = 0; n < 2; ++n) { rc[0][n] = *(const PG8_GAS f32x4*)(rope + (size_t)pos0 * 32 + 8 * fq + 4 * n); rc[0][2 + n] = *(const PG8_GAS f32x4*)(rope + (size_t)seq * 32 + (size_t)pos0 * 32 + 8 * fq + 4 * n); } }
#pragma unroll
            for (int ai = 0; ai < 2; ++ai)
#pragma unroll
                for (int m = 0; m < 4; ++m) { const int row = row0 + ai * HALF + m * 16; const int gi = ai * 4 + m;
                    if (gi < 7) { const int gn = gi + 1; const int posn = (row0 + (gn >> 2) * HALF + (gn & 3) * 16) & (seq - 1);
#pragma unroll
                        for (int n = 0; n < 2; ++n) { rc[gn & 1][n] = *(const PG8_GAS f32x4*)(rope + (size_t)posn * 32 + 8 * fq + 4 * n); rc[gn & 1][2 + n] = *(const PG8_GAS f32x4*)(rope + (size_t)seq * 32 + (size_t)posn * 32 + 8 * fq + 4 * n); } }
                    float ss = 0.f;
#pragma unroll
                    for (int n = 0; n < 2; ++n) { const f32x4 a = acc[ai][0][m][n], b = acc[ai][1][m][n]; ss += (a[0] * a[0] + a[1] * a[1]) + (a[2] * a[2] + a[3] * a[3]) + (b[0] * b[0] + b[1] * b[1]) + (b[2] * b[2] + b[3] * b[3]); }
                    ss += __shfl_xor(ss, 16); ss += __shfl_xor(ss, 32);
                    const float rs = 1.0f / sqrtf(ss * (1.0f / 64.0f) + eps);
                    u32x4 w1, w2; unsigned pk1[4], pk2_[4];
#pragma unroll
                    for (int n = 0; n < 2; ++n) { const f32x4 c = rc[gi & 1][n], sn = rc[gi & 1][2 + n];
                        const f32x4 y1 = acc[ai][0][m][n] * rs * g0[n], y2 = acc[ai][1][m][n] * rs * g1[n];
                        const f32x4 o1 = (y1 * c - y2 * sn) * sc, o2 = (y2 * c + y1 * sn) * sc;
                        if (isk) { cs0[n] += o1; cs1[n] += o2; }
                        pk1[2 * n] = cvt_pk_bf16(o1[0], o1[1]); pk1[2 * n + 1] = cvt_pk_bf16(o1[2], o1[3]); pk2_[2 * n] = cvt_pk_bf16(o2[0], o2[1]); pk2_[2 * n + 1] = cvt_pk_bf16(o2[2], o2[3]); }
                    w1.x = pk1[0]; w1.y = pk1[1]; w1.z = pk1[2]; w1.w = pk1[3]; w2.x = pk2_[0]; w2.y = pk2_[1]; w2.z = pk2_[2]; w2.w = pk2_[3];
                    PG8_GAS bf16_t* rowp = O + (size_t)row * 512 + head * 64 + 8 * fq;
                    *(PG8_GAS u32x4*)rowp = w1; *(PG8_GAS u32x4*)(rowp + 32) = w2;
                    asm volatile("" : "+v"(cs0[0]), "+v"(cs0[1]), "+v"(cs1[0]), "+v"(cs1[1]) :: "memory"); }
            if (isk) {
                PG8_GAS float* km = (PG8_GAS float*)kmean + ((size_t)u.pm * 8 + head) * 64;
#pragma unroll
                for (int n = 0; n < 2; ++n)
#pragma unroll
                    for (int j = 0; j < 4; ++j) { float a = cs0[n][j], b = cs1[n][j];
#pragma unroll
                        for (int o = 1; o < 16; o <<= 1) { a += __shfl_xor(a, o); b += __shfl_xor(b, o); }
                        if (fr == 0) { __hip_atomic_fetch_add(km + 8 * fq + 4 * n + j, a * (1.0f / 256.0f), __ATOMIC_RELAXED, __HIP_MEMORY_SCOPE_AGENT); __hip_atomic_fetch_add(km + 32 + 8 * fq + 4 * n + j, b * (1.0f / 256.0f), __ATOMIC_RELAXED, __HIP_MEMORY_SCOPE_AGENT); } }
            }
        } else {
            PG8_GAS bf16_t* O = (PG8_GAS bf16_t*)VB; const int col0 = (pn - 6) * BM + wc * 32 + 8 * fq;
#pragma unroll
            for (int ai = 0; ai < 2; ++ai)
#pragma unroll
                for (int m = 0; m < 4; ++m) { PG8_GAS bf16_t* rowp = O + (size_t)(row0 + ai * HALF + m * 16) * 512 + col0;
#pragma unroll
                    for (int bj = 0; bj < 2; ++bj) { const f32x4 v0 = acc[ai][bj][m][0], v1 = acc[ai][bj][m][1];
                        u32x4 w; w.x = cvt_pk_bf16(v0[0], v0[1]); w.y = cvt_pk_bf16(v0[2], v0[3]); w.z = cvt_pk_bf16(v1[0], v1[1]); w.w = cvt_pk_bf16(v1[2], v1[3]);
                        *(PG8_GAS u32x4*)(rowp + bj * HALF) = w; } }
        }
    }
};
struct EpiKv {
    static constexpr bool PERM = true, AFTER_DRAIN = false, MIDHOOK = false;
    bf16_t* KA; bf16_t* VA; const bf16_t* KVLN; const float* ssq; const float* ropeR; const float* gk; float eps; int seq;
    __device__ __forceinline__ void operator()(const f32x4 (&acc)[2][2][4][2], const Unit& u, int wr, int wc, int fr, int fq) const {
        const int pn = u.pn; const int row0 = u.pm * BM + wr * 64 + fr;
        if (pn < 2) {
            const int head = pn * 4 + wc; const float* gp = gk; asm volatile("" : "+s"(gp));
            f32x4 g0[2], g1[2];
#pragma unroll
            for (int n = 0; n < 2; ++n) { g0[n] = *(const PG8_GAS f32x4*)(gp + 8 * fq + 4 * n); g1[n] = *(const PG8_GAS f32x4*)(gp + 32 + 8 * fq + 4 * n); }
            const f32x4 gr1 = *(const PG8_GAS f32x4*)(gp + 64 + 4 * fq), gr2 = *(const PG8_GAS f32x4*)(gp + 80 + 4 * fq);
#pragma unroll
            for (int ai = 0; ai < 2; ++ai)
#pragma unroll
                for (int m = 0; m < 4; ++m) { const int row = row0 + ai * HALF + m * 16; const int pos = row & (seq - 1);
                    const f32x4 sq = *(const PG8_GAS f32x4*)(ssq + (size_t)row * 8 + 4); const float rl = 1.0f / sqrtf(((sq[0] + sq[1]) + (sq[2] + sq[3])) * (1.0f / 128.0f) + eps);
                    const PG8_GAS bf16_t* pe = (const PG8_GAS bf16_t*)KVLN + (size_t)row * 256 + 128 + 4 * fq;
                    typedef unsigned u32x2_ __attribute__((ext_vector_type(2)));
                    const u32x2_ p1 = *(const PG8_GAS u32x2_*)pe, p2 = *(const PG8_GAS u32x2_*)(pe + 16);
                    const f32x4 e1 = {__builtin_bit_cast(float, p1.x << 16), __builtin_bit_cast(float, p1.x & 0xffff0000u), __builtin_bit_cast(float, p1.y << 16), __builtin_bit_cast(float, p1.y & 0xffff0000u)};
                    const f32x4 e2 = {__builtin_bit_cast(float, p2.x << 16), __builtin_bit_cast(float, p2.x & 0xffff0000u), __builtin_bit_cast(float, p2.y << 16), __builtin_bit_cast(float, p2.y & 0xffff0000u)};
                    f32x4 x0[2], x1[2]; float ss = (e1[0] * e1[0] + e1[1] * e1[1]) + (e1[2] * e1[2] + e1[3] * e1[3]) + (e2[0] * e2[0] + e2[1] * e2[1]) + (e2[2] * e2[2] + e2[3] * e2[3]);
#pragma unroll
                    for (int n = 0; n < 2; ++n) { x0[n] = acc[ai][0][m][n] * rl; x1[n] = acc[ai][1][m][n] * rl; const f32x4 a = x0[n], b = x1[n];
                        ss += (a[0] * a[0] + a[1] * a[1]) + (a[2] * a[2] + a[3] * a[3]) + (b[0] * b[0] + b[1] * b[1]) + (b[2] * b[2] + b[3] * b[3]); }
                    ss += __shfl_xor(ss, 16); ss += __shfl_xor(ss, 32);
                    const float rs = 1.0f / sqrtf(ss * (1.0f / 96.0f) + eps);
                    PG8_GAS bf16_t* rowp = (PG8_GAS bf16_t*)KA + (size_t)row * 768 + head * 96;
                    u32x4 w1, w2;
                    { const f32x4 a = x0[0] * rs * g0[0], b = x0[1] * rs * g0[1]; w1.x = cvt_pk_bf16(a[0], a[1]); w1.y = cvt_pk_bf16(a[2], a[3]); w1.z = cvt_pk_bf16(b[0], b[1]); w1.w = cvt_pk_bf16(b[2], b[3]); }
                    { const f32x4 a = x1[0] * rs * g1[0], b = x1[1] * rs * g1[1]; w2.x = cvt_pk_bf16(a[0], a[1]); w2.y = cvt_pk_bf16(a[2], a[3]); w2.z = cvt_pk_bf16(b[0], b[1]); w2.w = cvt_pk_bf16(b[2], b[3]); }
                    *(PG8_GAS u32x4*)(rowp + 8 * fq) = w1; *(PG8_GAS u32x4*)(rowp + 32 + 8 * fq) = w2;
                    const f32x4 c = *(const PG8_GAS f32x4*)(ropeR + (size_t)pos * 16 + 4 * fq), sn = *(const PG8_GAS f32x4*)(ropeR + (size_t)seq * 16 + (size_t)pos * 16 + 4 * fq);
                    const f32x4 y1 = e1 * rs * gr1, y2 = e2 * rs * gr2; const f32x4 o1 = y1 * c - y2 * sn, o2 = y2 * c + y1 * sn;
                    u32x2_ r1, r2; r1.x = cvt_pk_bf16(o1[0], o1[1]); r1.y = cvt_pk_bf16(o1[2], o1[3]); r2.x = cvt_pk_bf16(o2[0], o2[1]); r2.y = cvt_pk_bf16(o2[2], o2[3]);
                    *(PG8_GAS u32x2_*)(rowp + 64 + 4 * fq) = r1; *(PG8_GAS u32x2_*)(rowp + 80 + 4 * fq) = r2;
                    asm volatile("" ::: "memory"); }
        } else {
            const int col0 = (pn - 2) * BM + wc * 32 + 8 * fq;
#pragma unroll
            for (int ai = 0; ai < 2; ++ai)
#pragma unroll
                for (int m = 0; m < 4; ++m) { const int row = row0 + ai * HALF + m * 16; PG8_GAS bf16_t* rowp = (PG8_GAS bf16_t*)VA + (size_t)row * 512 + col0;
                    const f32x4 sq = *(const PG8_GAS f32x4*)(ssq + (size_t)row * 8 + 4); const float rl = 1.0f / sqrtf(((sq[0] + sq[1]) + (sq[2] + sq[3])) * (1.0f / 128.0f) + eps);
#pragma unroll
                    for (int bj = 0; bj < 2; ++bj) { const f32x4 v0 = acc[ai][bj][m][0] * rl, v1 = acc[ai][bj][m][1] * rl;
                        u32x4 w; w.x = cvt_pk_bf16(v0[0], v0[1]); w.y = cvt_pk_bf16(v0[2], v0[3]); w.z = cvt_pk_bf16(v1[0], v1[1]); w.w = cvt_pk_bf16(v1[2], v1[3]);
                        *(PG8_GAS u32x4*)(rowp + bj * HALF) = w; } }
        }
    }
};
struct EpiOut {
    static constexpr bool PERM = true, AFTER_DRAIN = false, MIDHOOK = true;
    const float* base; bf16_t* x1b; const PG8_LAS float* rsl;
    __device__ __forceinline__ void mid(f32x4 (&acc)[2][2][4][2], const Unit& u, int wr, int wc, int fr, int fq) const {
        const PG8_LAS float* rs = rsl + (u.g0 * 256 + wr * 64 + fr) * 2;
#pragma unroll
        for (int ai = 0; ai < 2; ++ai)
#pragma unroll
            for (int m = 0; m < 4; ++m) { const float ratio = rs[(ai * HALF + m * 16) * 2];
#pragma unroll
                for (int bj = 0; bj < 2; ++bj)
#pragma unroll
                    for (int n = 0; n < 2; ++n) acc[ai][bj][m][n] *= ratio; }
    }
    __device__ __forceinline__ void operator()(const f32x4 (&acc)[2][2][4][2], const Unit& u, int wr, int wc, int fr, int fq) const {
        const int row0 = u.pm * BM + wr * 64 + fr; const int col0 = u.pn * BM + wc * 32 + 8 * fq;
        const PG8_LAS float* rs = rsl + (u.g0 * 256 + wr * 64 + fr) * 2 + 1;
        f32x4 xr[2][8];
#pragma unroll
        for (int g = 0; g < 2; ++g) { const size_t off = (size_t)(row0 + g * 16) * 1024 + col0;
#pragma unroll
            for (int bj = 0; bj < 2; ++bj) { xr[0][g * 4 + bj * 2] = *(const PG8_GAS f32x4*)(base + off + bj * HALF); xr[0][g * 4 + bj * 2 + 1] = *(const PG8_GAS f32x4*)(base + off + bj * HALF + 4); } }
#pragma unroll
        for (int pr = 0; pr < 4; ++pr) {
            if (pr < 3) {
#pragma unroll
                for (int g = 0; g < 2; ++g) { const int gi = 2 * (pr + 1) + g; const size_t off = (size_t)(row0 + (gi >> 2) * HALF + (gi & 3) * 16) * 1024 + col0;
#pragma unroll
                    for (int bj = 0; bj < 2; ++bj) { xr[(pr + 1) & 1][g * 4 + bj * 2] = *(const PG8_GAS f32x4*)(base + off + bj * HALF); xr[(pr + 1) & 1][g * 4 + bj * 2 + 1] = *(const PG8_GAS f32x4*)(base + off + bj * HALF + 4); } } }
#pragma unroll
            for (int g = 0; g < 2; ++g) { const int gi = 2 * pr + g; const int ai = gi >> 2, m = gi & 3; const size_t off = (size_t)(row0 + ai * HALF + m * 16) * 1024 + col0; const float rb = rs[(ai * HALF + m * 16) * 2];
#pragma unroll
                for (int bj = 0; bj < 2; ++bj) { const size_t p = off + bj * HALF;
                    const f32x4 v0 = xr[pr & 1][g * 4 + bj * 2] + acc[ai][bj][m][0] * rb, v1 = xr[pr & 1][g * 4 + bj * 2 + 1] + acc[ai][bj][m][1] * rb;
                    u32x4 o; o.x = cvt_pk_bf16(v0[0], v0[1]); o.y = cvt_pk_bf16(v0[2], v0[3]); o.z = cvt_pk_bf16(v1[0], v1[1]); o.w = cvt_pk_bf16(v1[2], v1[3]);
                    *(PG8_GAS u32x4*)(x1b + p) = o; } }
            asm volatile("" ::: "memory"); }
    }
};
struct EpiGateUp2 {
    static constexpr bool PERM = true, AFTER_DRAIN = false, MIDHOOK = false;
    bf16_t* H; const ListEnt* lists; const PG8_LAS int* cnt;
    __device__ __forceinline__ void operator()(const f32x4 (&acc)[2][2][4][2], const Unit& u, int wr, int wc, int fr, int fq) const {
        const int rt0 = wr * 64 + fr; const int col0 = (u.q >> 1) * 256 + (u.q & 1) * 128 + wc * 32 + 8 * fq; const int g = u.g0; const int n_g = cnt[g]; const bool hiexp = (u.q >> 1) != 0;
        const ListEnt* lg = lists + (size_t)g * 65536 + u.g1 * 256;
        float wv[8], rv[8];
#pragma unroll
        for (int i = 0; i < 8; ++i) { const int rt = rt0 + (i >> 2) * HALF + (i & 3) * 16; f32x4 le = {0.f, 0.f, 0.f, 0.f}; if ((u.g1 * 256 + rt) < n_g) le = *(const PG8_GAS f32x4*)((const PG8_GAS ListEnt*)lg + rt); wv[i] = hiexp ? le[2] : le[1]; rv[i] = le[3]; }
#pragma unroll
        for (int ai = 0; ai < 2; ++ai)
#pragma unroll
            for (int m = 0; m < 4; ++m) { const int rt = rt0 + ai * HALF + m * 16; const bool valid = (u.g1 * 256 + rt) < n_g;
                const float w = wv[ai * 4 + m], rsd = rv[ai * 4 + m];
                unsigned pk[2];
#pragma unroll
                for (int n = 0; n < 2; ++n) { const f32x4 gv = acc[ai][0][m][n], uv = acc[ai][1][m][n]; float h[4];
#pragma unroll
                    for (int j = 0; j < 4; ++j) { const float a = gv[j] * rsd; const float s = a * __builtin_amdgcn_rcpf(1.0f + __builtin_amdgcn_exp2f(-1.4426950408889634f * a)); h[j] = valid ? s * (uv[j] * rsd) * w : 0.f; }
                    { int w_ = 0; w_ = __builtin_amdgcn_cvt_pk_fp8_f32(h[0] * 8.0f, h[1] * 8.0f, w_, false); w_ = __builtin_amdgcn_cvt_pk_fp8_f32(h[2] * 8.0f, h[3] * 8.0f, w_, true); pk[n] = (unsigned)w_; } }
                typedef unsigned u32x2h_ __attribute__((ext_vector_type(2))); u32x2h_ o; o.x = pk[0]; o.y = pk[1];
                *(PG8_GAS u32x2h_*)((PG8_GAS unsigned char*)H + (size_t)(u.pm * BM + rt) * 512 + col0) = o; }
    }
};
struct EpiDown2 {
    static constexpr bool PERM = true, AFTER_DRAIN = false, MIDHOOK = false;
    float* out; const bf16_t* x1b; const ListEnt* lists; const PG8_LAS int* cnt;
    __device__ __forceinline__ void operator()(const f32x4 (&acc)[2][2][4][2], const Unit& u, int wr, int wc, int fr, int fq) const {
        const int rt0 = wr * 64 + fr; const int col0 = u.q * 256 + wc * 32 + 8 * fq; const int g = u.g0; const int n_g = cnt[g];
        const ListEnt* lg = lists + (size_t)g * 65536 + u.g1 * 256;
        int tokv[8];
#pragma unroll
        for (int i = 0; i < 8; ++i) { const int rt = rt0 + (i >> 2) * HALF + (i & 3) * 16; tokv[i] = ((u.g1 * 256 + rt) < n_g) ? ((const PG8_GAS ListEnt*)lg)[rt].tok : -1; }
#pragma unroll
        for (int ai = 0; ai < 2; ++ai) {
            u32x4 xb[4][2];
#pragma unroll
            for (int m = 0; m < 4; ++m)
#pragma unroll
                for (int bj = 0; bj < 2; ++bj) { const int tok = tokv[ai * 4 + m]; xb[m][bj] = (u32x4){0u, 0u, 0u, 0u}; if (tok >= 0) xb[m][bj] = *(const PG8_GAS u32x4*)((const PG8_GAS bf16_t*)x1b + (size_t)tok * 1024 + col0 + bj * HALF); }
#pragma unroll
            for (int m = 0; m < 4; ++m) { const int tok = tokv[ai * 4 + m];
                if (tok >= 0) { PG8_GAS float* orow = (PG8_GAS float*)out + (size_t)tok * 1024 + col0;
#pragma unroll
                    for (int bj = 0; bj < 2; ++bj) { PG8_GAS float* p = orow + bj * HALF; const u32x4 x = xb[m][bj];
                        f32x4 a, b; a[0] = __builtin_bit_cast(float, x.x << 16); a[1] = __builtin_bit_cast(float, x.x & 0xffff0000u); a[2] = __builtin_bit_cast(float, x.y << 16); a[3] = __builtin_bit_cast(float, x.y & 0xffff0000u);
                        b[0] = __builtin_bit_cast(float, x.z << 16); b[1] = __builtin_bit_cast(float, x.z & 0xffff0000u); b[2] = __builtin_bit_cast(float, x.w << 16); b[3] = __builtin_bit_cast(float, x.w & 0xffff0000u);
                        *(PG8_GAS f32x4*)p = a + acc[ai][bj][m][0]; *(PG8_GAS f32x4*)(p + 4) = b + acc[ai][bj][m][1]; } } }
            asm volatile("" ::: "memory"); }
    }
};
struct ClsOrder {
    const PG8_LAS int* tp; const PG8_LAS int* ptab; int mode, G, c; const ListEnt* lists; const PG8_LAS int* cnt;
    __device__ __forceinline__ int arow(const Unit& u, int row) const { const unsigned pos = (unsigned)(u.g1 * 256 + row); const unsigned n = (unsigned)cnt[u.g0]; const PG8_GAS ListEnt* lg = (const PG8_GAS ListEnt*)lists + (size_t)u.g0 * 65536; return lg[pos < n ? pos : 0u].tok; }
    __device__ __forceinline__ bool next(int i, Unit& u) const {
        const int nrb = tp[112]; const long L = (long)i * G + c; if (L >= (long)nrb * 4) return false;
        const int rbt = (int)(L >> 2), q = (int)(L & 3);
        int g = 0;
#pragma unroll
        for (int s = 64; s >= 1; s >>= 1) { const int gg = g + s; if (gg < 112 && tp[gg] <= rbt) g = gg; }
        const int grp = g / 28, pr = ptab[g - grp * 28], lo = pr & 15, hi = pr >> 4;
        u.pm = rbt; u.g0 = g; u.g1 = rbt - tp[g]; u.q = q;
        if (mode == 0) { u.pn = (grp * 8 + ((q >> 1) ? hi : lo)) * 2 + (q & 1); u.pn2 = 0; } else { u.pn = (grp * 8 + lo) * 4 + q; u.pn2 = (grp * 8 + hi) * 4 + q; }
        return true;
    }
    __device__ __forceinline__ void a_ready(const Unit&) const {}
    __device__ __forceinline__ void done(const Unit&) const {}
};

template <class Epi, class Sched, bool ALIGN_EPI = false, bool SP2 = false, bool GATHER = false, bool KSPLIT = false, bool F8 = false, int SCW = 0x7a7a7a7a, int SCA = 0x7f7f7f7f, bool F8ASM = false>
__device__ __forceinline__ void gemm_phase(PG8_LAS unsigned char* lds, const Gemm g, const Sched& S, const Epi& E) {
    const int tid = threadIdx.x, wid = __builtin_amdgcn_readfirstlane(tid >> 6), lane = tid & 63, wr = wid >> 2, wc = wid & 3, fr = lane & 15, fq = lane >> 4;
    const int K = g.K, nt = K / BK;
    const int PB = KSPLIT ? (K >> 1) : K;
    static_assert(!GATHER || SP2, "gathered A rows: SP2 loop only");
    unsigned voffA[2], voffB[2];
#pragma unroll
    for (int i = 0; i < 2; ++i) { int R, C; stage_rc(tid * 16 + i * 8192, R, C); const int Rb = Epi::PERM ? ((R & ~31) + perm32(R & 31)) : R;
        voffA[i] = (unsigned)(R * K + C) * 2u; voffB[i] = (unsigned)(Rb * PB + C) * 2u; }
    const size_t kstep = (size_t)(BK * 2);
    const size_t hstep = (size_t)HALF * K * 2;
    const size_t tstep = 2 * hstep;
    const size_t hstepB = (size_t)HALF * PB * 2, tstepB = 2 * hstepB;
    const unsigned ldsw = (unsigned)wid * 1024u;
    const int aoff = lds_byte(wr * 64 + fr, fq * 8), boff = lds_byte(wc * 32 + fr, fq * 8);
#define PG8_SA(b, h) (((b) * 2 + (h)) * HTB)
#define PG8_SB(b, h) ((4 + (b) * 2 + (h)) * HTB)
#define PG8_STAGE(bufoff, gbase, voff) do { _Pragma("unroll") for (int _i = 0; _i < 2; ++_i) \
        __builtin_amdgcn_global_load_lds((const unsigned*)((const char*)(gbase) + (voff)[_i]), (PG8_LAS unsigned*)(lds + (bufoff) + ldsw + _i * 8192), 16, 0, 0); } while (0)
#define PG8_LDA(dst, b, h) do { _Pragma("unroll") for (int m = 0; m < 4; ++m) _Pragma("unroll") for (int k = 0; k < 2; ++k) dst[m][k] = *(const PG8_LAS bf16x8*)(lds + PG8_SA(b, h) + aoff + m * 2048 + k * 1024); } while (0)
#define PG8_LDB(dst, b, h) do { _Pragma("unroll") for (int n = 0; n < 2; ++n) _Pragma("unroll") for (int k = 0; k < 2; ++k) dst[n][k] = *(const PG8_LAS bf16x8*)(lds + PG8_SB(b, h) + boff + n * 2048 + k * 1024); } while (0)
#define PG8_MMA(ai, bj, At, Bt) do { __builtin_amdgcn_s_setprio(1); _Pragma("unroll") for (int m = 0; m < 4; ++m) _Pragma("unroll") for (int n = 0; n < 2; ++n) { \
        if constexpr (F8) { typedef int v4i_ __attribute__((ext_vector_type(4))); typedef int v8i_ __attribute__((ext_vector_type(8))); \
            const v8i_ w8_ = __builtin_shufflevector(__builtin_bit_cast(v4i_, Bt[n][0]), __builtin_bit_cast(v4i_, Bt[n][1]), 0, 1, 2, 3, 4, 5, 6, 7); \
            const v8i_ a8_ = __builtin_shufflevector(__builtin_bit_cast(v4i_, At[m][0]), __builtin_bit_cast(v4i_, At[m][1]), 0, 1, 2, 3, 4, 5, 6, 7); \
            if constexpr (F8ASM) { asm volatile("v_mfma_scale_f32_16x16x128_f8f6f4 %0, %1, %2, %0, %3, %4 op_sel_hi:[0,0,0]" : "+v"(acc[ai][bj][m][n]) : "v"(w8_), "v"(a8_), "v"(SCW), "v"(SCA)); }     \
            else acc[ai][bj][m][n] = __builtin_amdgcn_mfma_scale_f32_16x16x128_f8f6f4(w8_, a8_, acc[ai][bj][m][n], 0, 0, 0, SCW, 0, SCA); } \
        else { _Pragma("unroll") for (int k = 0; k < 2; ++k) acc[ai][bj][m][n] = __builtin_amdgcn_mfma_f32_16x16x32_bf16(Bt[n][k], At[m][k], acc[ai][bj][m][n], 0, 0, 0); } } \
        __builtin_amdgcn_s_setprio(0); } while (0)
#define PG8_WAIT_V(n) asm volatile("s_waitcnt vmcnt(" #n ")" ::: "memory")
#define PG8_WAIT_L(n) asm volatile("s_waitcnt lgkmcnt(" #n ")" ::: "memory")
#define PG8_BAR __builtin_amdgcn_s_barrier()
#define PG8_SCHED __builtin_amdgcn_sched_barrier(0)
#define PG8_STG_A(b, h, ptr, arr) do { if constexpr (GATHER) { PG8_STAGE(PG8_SA(b, h), (ptr), (arr)[h]); } else { PG8_STAGE(PG8_SA(b, h), (ptr) + ((h) ? hstep : 0), voffA); } } while (0)
    unsigned cv[2][2] = {{0u, 0u}, {0u, 0u}}, nvp[2] = {0u, 0u};
#define PG8_GROWS(dst, unit) do { if constexpr (GATHER) { _Pragma("unroll") for (int _h = 0; _h < 2; ++_h) _Pragma("unroll") for (int _i = 0; _i < 2; ++_i) { int R_, C_; stage_rc(tid * 16 + _i * 8192, R_, C_); \
        dst[_h][_i] = (unsigned)S.arow(unit, _h * HALF + R_) * (unsigned)(K * 2) + (unsigned)(C_ * 2); } } } while (0)
    Unit cur, nxt; int ui = 0;
    if (!S.next(0, cur)) return;
    PG8_GROWS(cv, cur);
#define PG8_GROWS_P(unit) do { _Pragma("unroll") for (int _i = 0; _i < 2; ++_i) { int R_, C_; stage_rc(tid * 16 + _i * 8192, R_, C_); nvp[_i] = (unsigned)S.arow(unit, R_) | ((unsigned)S.arow(unit, HALF + R_) << 16); } } while (0)
#define PG8_UNPACK_NV() do { _Pragma("unroll") for (int _i = 0; _i < 2; ++_i) { int R_, C_; stage_rc(tid * 16 + _i * 8192, R_, C_); cv[0][_i] = (nvp[_i] & 0xffffu) * (unsigned)(K * 2) + (unsigned)(C_ * 2); cv[1][_i] = (nvp[_i] >> 16) * (unsigned)(K * 2) + (unsigned)(C_ * 2); } } while (0)
    f32x4 acc[2][2][4][2];
#pragma unroll
    for (int a = 0; a < 2; ++a)
#pragma unroll
        for (int b = 0; b < 2; ++b)
#pragma unroll
            for (int m = 0; m < 4; ++m)
#pragma unroll
                for (int n = 0; n < 2; ++n) acc[a][b][m][n] = (f32x4){0.f, 0.f, 0.f, 0.f};
    bf16x8 At[4][2], B0[2][2], B1[2][2];
    const char* cA = (const char*)g.A + (GATHER ? (size_t)0 : (size_t)cur.pm * tstep); const char* cB = (const char*)g.Bt + (size_t)cur.pn * tstepB; const char* cB2 = KSPLIT ? (const char*)g.Bt + (size_t)cur.pn2 * tstepB : cB;
    S.a_ready(cur);
    if constexpr (SP2) {
        PG8_STAGE(PG8_SB(0, 0), cB, voffB); PG8_STAGE(PG8_SB(0, 1), cB + hstepB, voffB); PG8_STG_A(0, 0, cA, cv); PG8_STG_A(0, 1, cA, cv);
        if (wr == 1) PG8_BAR;
        PG8_WAIT_V(2); PG8_BAR;
        PG8_STAGE(PG8_SB(1, 0), cB + kstep, voffB); PG8_STG_A(1, 0, cA + kstep, cv); PG8_STAGE(PG8_SB(1, 1), cB + hstepB + kstep, voffB);
        PG8_WAIT_V(6); PG8_BAR;
    } else {
        PG8_STAGE(PG8_SB(0, 0), cB, voffB); PG8_STAGE(PG8_SA(0, 0), cA, voffA); PG8_STAGE(PG8_SB(0, 1), cB + hstepB, voffB); PG8_STAGE(PG8_SA(0, 1), cA + hstep, voffA);
        if (wr == 1) PG8_BAR;
        PG8_WAIT_V(4); PG8_BAR;
        PG8_STAGE(PG8_SB(1, 0), cB + kstep, voffB); PG8_STAGE(PG8_SA(1, 0), cA + kstep, voffA); PG8_STAGE(PG8_SB(1, 1), cB + hstepB + kstep, voffB);
        PG8_WAIT_V(6); PG8_BAR;
    }
    for (;;) {
        const bool has_next = S.next(ui + 1, nxt);
        const char* nA = (has_next && !GATHER) ? (const char*)g.A + (size_t)nxt.pm * tstep : cA; const char* nB = has_next ? (const char*)g.Bt + (size_t)nxt.pn * tstepB : cB; const char* nB2 = (KSPLIT && has_next) ? (const char*)g.Bt + (size_t)nxt.pn2 * tstepB : cB2;
        if constexpr (GATHER) { if (has_next) { PG8_GROWS_P(nxt); } else { PG8_GROWS_P(cur); } }
        const int tspan = Epi::MIDHOOK ? (nt >> 1) : nt;
        for (int t0 = 0; t0 < nt; t0 += tspan) {
        if constexpr (Epi::MIDHOOK) { if (t0 != 0) E.mid(acc, cur, wr, wc, fr, fq); }
        for (int t = t0; t < t0 + tspan; t += 2) {
            const bool last = (t == nt - 2);
            const char* a1 = cA + (size_t)(t + 1) * kstep;
            const char* a2 = last ? nA : cA + (size_t)(t + 2) * kstep; const char* b2 = last ? nB : ((KSPLIT && t + 2 >= (nt >> 1)) ? cB2 + (size_t)(t + 2 - (nt >> 1)) * kstep : cB + (size_t)(t + 2) * kstep);
            const char* a3 = a2 + kstep; const char* b3 = b2 + kstep;
            if (last && has_next) S.a_ready(nxt);
            if constexpr (SP2) {
            PG8_LDB(B0, 0, 0); PG8_LDB(B1, 0, 1); PG8_SCHED; PG8_LDA(At, 0, 0); PG8_STG_A(1, 1, a1, cv);
            if constexpr (GATHER) { if (last) { PG8_UNPACK_NV(); } }
            PG8_WAIT_V(8); PG8_WAIT_L(0); PG8_BAR; PG8_MMA(0, 0, At, B0); PG8_MMA(0, 1, At, B1); PG8_BAR; PG8_SCHED;
            PG8_LDA(At, 0, 1); PG8_STAGE(PG8_SB(0, 0), b2, voffB); PG8_STAGE(PG8_SB(0, 1), b2 + hstepB, voffB); PG8_STG_A(0, 0, a2, cv);
            PG8_WAIT_V(8); PG8_WAIT_L(0); PG8_BAR; PG8_MMA(1, 0, At, B0); PG8_MMA(1, 1, At, B1); PG8_BAR; PG8_SCHED;
            PG8_LDB(B0, 1, 0); PG8_LDB(B1, 1, 1); PG8_SCHED; PG8_LDA(At, 1, 0); PG8_STG_A(0, 1, a2, cv);
            PG8_WAIT_V(8); PG8_WAIT_L(0); PG8_BAR; PG8_MMA(0, 0, At, B0); PG8_MMA(0, 1, At, B1); PG8_BAR; PG8_SCHED;
            PG8_LDA(At, 1, 1); PG8_STAGE(PG8_SB(1, 0), b3, voffB); PG8_STAGE(PG8_SB(1, 1), b3 + hstepB, voffB); PG8_STG_A(1, 0, a3, cv);
            PG8_WAIT_V(8); PG8_WAIT_L(0); PG8_BAR; PG8_MMA(1, 0, At, B0); PG8_MMA(1, 1, At, B1); PG8_BAR; PG8_SCHED;
            } else {
            PG8_LDB(B0, 0, 0); PG8_SCHED; PG8_LDA(At, 0, 0); PG8_STAGE(PG8_SA(1, 1), a1 + hstep, voffA);
            PG8_WAIT_L(8); PG8_BAR; PG8_WAIT_L(0); PG8_MMA(0, 0, At, B0); PG8_BAR; PG8_SCHED;
            PG8_LDB(B1, 0, 1); PG8_STAGE(PG8_SB(0, 0), b2, voffB);
            PG8_BAR; PG8_WAIT_L(0); PG8_MMA(0, 1, At, B1); PG8_BAR;
            PG8_LDA(At, 0, 1); PG8_STAGE(PG8_SA(0, 0), a2, voffA);
            PG8_BAR; PG8_WAIT_L(0); PG8_MMA(1, 0, At, B0); PG8_BAR; PG8_SCHED;
            PG8_STAGE(PG8_SB(0, 1), b2 + hstepB, voffB);
            PG8_WAIT_V(6); PG8_BAR; PG8_MMA(1, 1, At, B1); PG8_BAR;
            PG8_LDB(B0, 1, 0); PG8_SCHED; PG8_LDA(At, 1, 0); PG8_STAGE(PG8_SA(0, 1), a2 + hstep, voffA);
            PG8_WAIT_L(8); PG8_BAR; PG8_WAIT_L(0); PG8_MMA(0, 0, At, B0); PG8_BAR; PG8_SCHED;
            PG8_LDB(B1, 1, 1); PG8_STAGE(PG8_SB(1, 0), b3, voffB);
            PG8_BAR; PG8_WAIT_L(0); PG8_MMA(0, 1, At, B1); PG8_BAR;
            PG8_LDA(At, 1, 1); PG8_STAGE(PG8_SA(1, 0), a3, voffA);
            PG8_BAR; PG8_WAIT_L(0); PG8_MMA(1, 0, At, B0); PG8_BAR; PG8_SCHED;
            PG8_STAGE(PG8_SB(1, 1), b3 + hstepB, voffB);
            PG8_WAIT_V(6); PG8_BAR; PG8_MMA(1, 1, At, B1); PG8_BAR;
            }
        }
        }
        if constexpr (ALIGN_EPI) { if (wr == 0) PG8_BAR; }
        if constexpr (!Epi::AFTER_DRAIN) { int t2 = threadIdx.x; asm volatile("" : "+v"(t2));
            const int wid2 = __builtin_amdgcn_readfirstlane(t2 >> 6), lane2 = t2 & 63; E(acc, cur, wid2 >> 2, wid2 & 3, lane2 & 15, lane2 >> 4); S.done(cur); }
        if (!has_next) break;
#pragma unroll
        for (int a = 0; a < 2; ++a)
#pragma unroll
            for (int b = 0; b < 2; ++b)
#pragma unroll
                for (int m = 0; m < 4; ++m)
#pragma unroll
                    for (int n = 0; n < 2; ++n) acc[a][b][m][n] = (f32x4){0.f, 0.f, 0.f, 0.f};
        cur = nxt; cA = nA; cB = nB; cB2 = nB2; ++ui;
        if constexpr (ALIGN_EPI) { if (wr == 1) PG8_BAR; }
    }
    PG8_WAIT_V(0);
    if constexpr (!ALIGN_EPI) { if (wr == 0) PG8_BAR; }
    PG8_BAR;
    if constexpr (Epi::AFTER_DRAIN) { E.fused(acc, cur, wr, wc, fr, fq, lds, wid, lane); S.done(cur); }
#undef PG8_SA
#undef PG8_SB
#undef PG8_STAGE
#undef PG8_LDA
#undef PG8_LDB
#undef PG8_MMA
#undef PG8_WAIT_V
#undef PG8_WAIT_L
#undef PG8_BAR
#undef PG8_SCHED
#undef PG8_STG_A
#undef PG8_GROWS
#undef PG8_GROWS_P
#undef PG8_UNPACK_NV
}
}
constexpr int BATCH = 32, SEQ = 2048, D = 1024, T = BATCH * SEQ;
constexpr int NPROJ = 2048;
constexpr int CQ = 0, CKV = 256, CPE = 384, CMQ = 416, CMK = 928, CMV = 1440, NPROJ_REAL = 1952;
constexpr int NH = 8;
constexpr float EPS = 1e-6f;
constexpr float LOG2E = 1.4426950408889634f;
constexpr float C2A = 0.10206207261596575f * LOG2E;
constexpr float C2B = 0.125f * LOG2E;
constexpr int NCLS = 112;
constexpr int LIST_CAP = 65536;

constexpr size_t MiB = 1u << 20;
constexpr size_t WS_CTL = 0, CTL_ZERO_BYTES = 2 * MiB;
constexpr size_t WS_KMEAN = 1 * MiB;
constexpr size_t WS_WIN = 2 * MiB;
constexpr size_t WS_WQ = 6 * MiB;
constexpr size_t WS_WKV = 7 * MiB;
constexpr size_t WS_WO = 8 * MiB;
constexpr size_t WS_WGU = 10 * MiB;
constexpr size_t WS_WD = 42 * MiB;
constexpr size_t WS_ROPE = 58 * MiB;
constexpr size_t WS_WRE = 59 * MiB;
constexpr size_t WS_SSQ = 60 * MiB;
constexpr size_t WS_XN = 64 * MiB;
constexpr size_t WS_VB = 192 * MiB;
constexpr size_t WS_Y0 = 64 * MiB;
constexpr size_t WS_X1B = 768 * MiB;
constexpr size_t WS_YH = 256 * MiB;
constexpr size_t WS_QB = 448 * MiB;
constexpr size_t WS_KB = 512 * MiB;
constexpr size_t WS_QA = 584 * MiB;
constexpr size_t WS_VA = 680 * MiB;
constexpr size_t WS_KA = 808 * MiB;
constexpr size_t WS_QLN = 904 * MiB;
constexpr size_t WS_KVLN = 936 * MiB;
constexpr size_t WS_LISTS = 648 * MiB;
constexpr size_t WS_OSSQ = 904 * MiB;
constexpr size_t WS_END = 1024 * MiB;
constexpr size_t WS_H = WS_KB;
constexpr int CW_TMO = 0, CW_CODE = 1;
constexpr int CW_BAR = 4096;
constexpr int CW_GCNT = 16384;

constexpr int RING_BYTES = 131072;
constexpr int P8_XT = 0, P8_XT_WAVE = 32 * 68 * 4, P8_WC = 69632, P8_WRG = 86016, P8_RT = 102400;
constexpr int LDSCTL_OFF = 155648, LDS_BYTES = 159744;
constexpr int TP_OFF = LDSCTL_OFF + 256, CNT_OFF = LDSCTL_OFF + 768, PT_OFF = LDSCTL_OFF + 1280;

#define GAS __attribute__((address_space(1)))
#define LAS __attribute__((address_space(3)))
typedef unsigned short bf16;
typedef unsigned v4u __attribute__((ext_vector_type(4)));
typedef unsigned v2u __attribute__((ext_vector_type(2)));
typedef float f32x4 __attribute__((ext_vector_type(4)));
typedef float f32x2 __attribute__((ext_vector_type(2)));
typedef float f32x16 __attribute__((ext_vector_type(16)));
typedef short bf16x8 __attribute__((ext_vector_type(8)));
typedef short s16x4 __attribute__((ext_vector_type(4)));
typedef GAS unsigned gu32;
#define RLX_AGENT __ATOMIC_RELAXED, __HIP_MEMORY_SCOPE_AGENT
__device__ __forceinline__ unsigned f2bf(float f) { unsigned u = __builtin_bit_cast(unsigned, f); return (u + 0x7fffu + ((u >> 16) & 1u)) >> 16; }
__device__ __forceinline__ unsigned pk2(float lo, float hi) { return f2bf(lo) | (f2bf(hi) << 16); }
__device__ __forceinline__ float bflo(unsigned w) { return __builtin_bit_cast(float, w << 16); }
__device__ __forceinline__ float bfhi(unsigned w) { return __builtin_bit_cast(float, w & 0xffff0000u); }
__device__ __forceinline__ float wave_sum(float v) {
#pragma unroll
    for (int o = 1; o < 64; o <<= 1) v += __shfl_xor(v, o);
    return v;
}
__device__ __forceinline__ float sum8(float v) { v += __shfl_xor(v, 1); v += __shfl_xor(v, 2); v += __shfl_xor(v, 4); return v; }

#define XB_TMO      128
#define XB_XCNT(j)  (256  + 64 * (j))
#define XB_XSUB(j)  (1280 + 64 * (j))
#define XB_XGEN(j)  (2304 + 64 * (j))
#define XB_TOP      3328
#define XB_TOPGEN   3392
#define XCD_BAR_WORDS 3456
#define XB_SPIN_CAP (1u << 18)

__device__ __forceinline__ unsigned xb_ld(unsigned* p)              { return __hip_atomic_load(p, __ATOMIC_RELAXED, __HIP_MEMORY_SCOPE_AGENT); }
__device__ __forceinline__ unsigned xb_add(unsigned* p, unsigned v) { return __hip_atomic_fetch_add(p, v, __ATOMIC_RELAXED, __HIP_MEMORY_SCOPE_AGENT); }
__device__ __forceinline__ unsigned xb_xcc_id() { return (unsigned)__builtin_amdgcn_s_getreg((3 << 11) | 20) & 0xFu; }
#define XB_SPIN(cond, bar) do { unsigned _sp = 0; while (cond) { __builtin_amdgcn_s_sleep(1); \
    if ((++_sp & 255u) == 0u) { if (xb_ld(&(bar)[XB_TMO])) break; if (_sp > XB_SPIN_CAP) { atomicAdd(&(bar)[XB_TMO], 1u); break; } } } } while (0)

struct XcdBarrier {
    unsigned* bar; unsigned x;
    volatile LAS unsigned* st;
};

__device__ __forceinline__ XcdBarrier xcd_barrier_post(unsigned* bar, volatile LAS unsigned* st) {
    XcdBarrier b; b.bar = bar; b.x = xb_xcc_id(); b.st = st;
    if (threadIdx.x == 0) (void)xb_add(&bar[XB_XCNT(b.x)], 1u);
    return b;
}
__device__ __forceinline__ void xcd_barrier_complete(unsigned* bar, unsigned x, unsigned& nloc, unsigned& nx) {
    const unsigned G = gridDim.x * gridDim.y * gridDim.z;
    unsigned sum, cnt, mine, sp = 0u;
    for (;;) {
        sum = 0u; cnt = 0u; mine = 0u;
#pragma unroll
        for (unsigned j = 0; j < 16; ++j) { const unsigned c = xb_ld(&bar[XB_XCNT(j)]); sum += c; cnt += (c > 0u) ? 1u : 0u; mine = (j == x) ? c : mine; }
        if (sum == G) break;
        __builtin_amdgcn_s_sleep(1);
        if ((++sp & 255u) == 0u) { if (xb_ld(&bar[XB_TMO])) break; if (sp > XB_SPIN_CAP) { atomicAdd(&bar[XB_TMO], 1u); break; } }
    }
    nloc = mine > 0u ? mine : 1u; nx = cnt > 0u ? cnt : 1u;
}

__device__ __forceinline__ void xcd_barrier(const XcdBarrier& b) {
    asm volatile("s_waitcnt vmcnt(0)" ::: "memory");
    __syncthreads();
    if (threadIdx.x == 0) {
        unsigned* bar = b.bar;
        __builtin_amdgcn_s_waitcnt(0);
        unsigned nloc = b.st[0], nx = b.st[1];
        if (nloc == 0u) { xcd_barrier_complete(bar, b.x, nloc, nx); b.st[0] = nloc; b.st[1] = nx; }
        const unsigned old = xb_add(&bar[XB_XSUB(b.x)], 1u);
        const unsigned gen = old / nloc;
        if (old + 1u == (gen + 1u) * nloc) {
            __builtin_amdgcn_fence(__ATOMIC_RELEASE, "agent");
            asm volatile("s_waitcnt vmcnt(0)" ::: "memory");
            const unsigned og = xb_add(&bar[XB_TOP], 1u);
            const unsigned tg = og / nx;
            if (og + 1u == (tg + 1u) * nx) xb_add(&bar[XB_TOPGEN], 1u);
            else XB_SPIN(xb_ld(&bar[XB_TOPGEN]) == tg, bar);
            __builtin_amdgcn_fence(__ATOMIC_ACQUIRE, "agent");
            xb_add(&bar[XB_XGEN(b.x)], 1u);
            asm volatile("s_waitcnt vmcnt(0)" ::: "memory");
        } else {
            XB_SPIN(xb_ld(&bar[XB_XGEN(b.x)]) == gen, bar);
            __builtin_amdgcn_fence(__ATOMIC_ACQUIRE, "agent");
            asm volatile("s_waitcnt vmcnt(0)" ::: "memory");
        }
    }
    __syncthreads();
}


__device__ __forceinline__ float att_max3(float a, float b, float c) { float r; asm("v_max3_f32 %0, %1, %2, %3" : "=v"(r) : "v"(a), "v"(b), "v"(c)); return r; }
__device__ __forceinline__ unsigned pk4_fp8(float a, float b, float c, float d) { int w = 0; w = __builtin_amdgcn_cvt_pk_fp8_f32(a, b, w, false); w = __builtin_amdgcn_cvt_pk_fp8_f32(c, d, w, true); return (unsigned)w; }
struct AttOwn { static constexpr bool v = true; }; struct AttPast { static constexpr bool v = false; };
template <int DQK, bool MOBA, bool QFIN>
__device__ __forceinline__ void attn_unit(LAS unsigned char* lds, const float* qgain_, const float* ropeR_, const bf16* Qg_, int qpitch, const bf16* Kg_, int kpitch, const bf16* Vg_, int vpitch, bf16* Og_, int opitch, float* ossq_, int qb, const float* kmp_, int kmstride) {
    const GAS bf16* Qg = (const GAS bf16*)Qg_; const GAS bf16* Kg = (const GAS bf16*)Kg_; const GAS bf16* Vg = (const GAS bf16*)Vg_; GAS bf16* Og = (GAS bf16*)Og_; const GAS float* kmp = (const GAS float*)kmp_;
    constexpr int ND = DQK / 16, KSTR = DQK * 2 + 16, KBUF = 64 * KSTR, NCH = DQK / 8, VBUF = 8192;
    int tid = threadIdx.x; asm volatile("" : "+v"(tid));
    const int lane = tid & 63, r32 = lane & 31, hi = lane >> 5; const int wid = __builtin_amdgcn_readfirstlane(tid >> 6);
    LAS unsigned char* Kl = lds; LAS unsigned char* Vl = lds + 2 * KBUF;
    const GAS bf16* qrow = Qg + (size_t)(qb * 256 + wid * 32 + r32) * qpitch;
    bf16x8 qf[ND];
#pragma unroll
    for (int d0 = 0; d0 < ND; ++d0) qf[d0] = *(const GAS bf16x8*)(qrow + 16 * d0 + 8 * hi);
    if (QFIN) {
        const GAS float* qg = (const GAS float*)qgain_; const GAS float* rr = (const GAS float*)ropeR_; const int pos = qb * 256 + wid * 32 + r32;
        float x[ND][8]; float ss = 0.f;
#pragma unroll
        for (int d0 = 0; d0 < ND; ++d0) { const v4u w = __builtin_bit_cast(v4u, qf[d0]);
            x[d0][0] = bflo(w.x); x[d0][1] = bfhi(w.x); x[d0][2] = bflo(w.y); x[d0][3] = bfhi(w.y); x[d0][4] = bflo(w.z); x[d0][5] = bfhi(w.z); x[d0][6] = bflo(w.w); x[d0][7] = bfhi(w.w);
#pragma unroll
            for (int j = 0; j < 8; ++j) ss += x[d0][j] * x[d0][j]; }
        ss += __shfl_xor(ss, 32);
        const float rs = (1.0f / sqrtf(ss * (1.0f / (float)DQK) + EPS)) * C2A;
#pragma unroll
        for (int d0 = 0; d0 < ND; ++d0) { const f32x4 ga = *(const GAS f32x4*)(qg + 16 * d0 + 8 * hi), gb = *(const GAS f32x4*)(qg + 16 * d0 + 8 * hi + 4);
#pragma unroll
            for (int j = 0; j < 4; ++j) { x[d0][j] *= rs * ga[j]; x[d0][4 + j] *= rs * gb[j]; } }
        if (ND == 6) { const f32x4 ca = *(const GAS f32x4*)(rr + pos * 16 + 8 * hi), cb = *(const GAS f32x4*)(rr + pos * 16 + 8 * hi + 4), sa = *(const GAS f32x4*)(rr + SEQ * 16 + pos * 16 + 8 * hi), sb = *(const GAS f32x4*)(rr + SEQ * 16 + pos * 16 + 8 * hi + 4);
#pragma unroll
            for (int j = 0; j < 8; ++j) { const float c = j < 4 ? ca[j & 3] : cb[j & 3], s = j < 4 ? sa[j & 3] : sb[j & 3]; const float y1 = x[ND - 2][j], y2 = x[ND - 1][j]; x[ND - 2][j] = y1 * c - y2 * s; x[ND - 1][j] = y2 * c + y1 * s; } }
#pragma unroll
        for (int d0 = 0; d0 < ND; ++d0) { v4u w; w.x = pg8::cvt_pk_bf16(x[d0][0], x[d0][1]); w.y = pg8::cvt_pk_bf16(x[d0][2], x[d0][3]); w.z = pg8::cvt_pk_bf16(x[d0][4], x[d0][5]); w.w = pg8::cvt_pk_bf16(x[d0][6], x[d0][7]); qf[d0] = __builtin_bit_cast(bf16x8, w); }
    }
    unsigned sel = 0xffu;
    if (MOBA && qb > 3) {
        float gate[8];
#pragma unroll
        for (int n = 0; n < 8; ++n) { float a = 0.f;
            if (n < qb) {
#pragma unroll
                for (int d0 = 0; d0 < ND; ++d0) { const GAS float* km = kmp + (size_t)n * kmstride + 16 * d0 + 8 * hi; const f32x4 k0 = *(const GAS f32x4*)km, k1 = *(const GAS f32x4*)(km + 4);
                    const v4u qq = __builtin_bit_cast(v4u, qf[d0]);
                    a += bflo(qq.x) * k0[0] + bfhi(qq.x) * k0[1] + bflo(qq.y) * k0[2] + bfhi(qq.y) * k0[3] + bflo(qq.z) * k1[0] + bfhi(qq.z) * k1[1] + bflo(qq.w) * k1[2] + bfhi(qq.w) * k1[3]; }
                a += __shfl_xor(a, 32); }
            gate[n] = a; asm volatile("" : "+v"(a) :: "memory"); }
        sel = 0u;
#pragma unroll
        for (int n = 0; n < 8; ++n) { int rank = 0;
#pragma unroll
            for (int mm = 0; mm < 8; ++mm) { if (mm != n) { const bool before = (gate[mm] > gate[n]) || (gate[mm] == gate[n] && mm < n); rank += (mm < qb && before) ? 1 : 0; } }
            if (n < qb && rank < 3) sel |= (1u << n); }
    }
    const int krow = (DQK == 64) ? (tid >> 3) : (tid / 12), kch = (DQK == 64) ? (tid & 7) : (tid % 12);
    const int krow2 = (tid + 512) / 12, kch2 = (tid + 512) % 12; const bool k2 = (DQK == 96) && (tid < 256);
    const int vrow = tid >> 3, vch = tid & 7;
    const unsigned kst = (unsigned)(krow * KSTR + kch * 16), kst2 = (unsigned)(krow2 * KSTR + kch2 * 16);
    const unsigned vst = (unsigned)((vch >> 2) * 4096 + (vrow >> 4) * 1024 + ((vrow >> 3) & 1) * 512 + (vrow & 7) * 64 + (vch & 3) * 16);
    const int NT = 4 * (qb + 1);
    auto tile_row0 = [&](int p) -> int { return (p < 4) ? (qb * 256 + p * 64) : ((p - 4) * 64); };
    v4u kreg, kreg2 = {0u, 0u, 0u, 0u}, vreg;
    { const int r0 = tile_row0(0);
      kreg = *(const GAS v4u*)(Kg + (size_t)(r0 + krow) * kpitch + kch * 8); if (k2) kreg2 = *(const GAS v4u*)(Kg + (size_t)(r0 + krow2) * kpitch + kch2 * 8);
      vreg = *(const GAS v4u*)(Vg + (size_t)(r0 + vrow) * vpitch + vch * 8);
      *(LAS v4u*)(Kl + kst) = kreg; if (k2) *(LAS v4u*)(Kl + kst2) = kreg2; *(LAS v4u*)(Vl + vst) = vreg; }
    __syncthreads();
    float m_run = 0.f, l_run = 0.f; f32x16 o0 = {}, o1 = {};
    f32x16 cuse = {}; bool cdirty = true;
    f32x16 negm = {};
    constexpr float THR = 8.0f;
    const int qrel = wid * 32 + r32;
    const unsigned kfo = (unsigned)(r32 * KSTR + hi * 16);
    const unsigned vfo = (unsigned)(((lane >> 4) & 1) * 32 + (lane & 3) * 8 + (4 * hi + ((lane & 15) >> 2)) * 64);
    auto slot = [&](const int p, auto own_) { constexpr bool OWN = decltype(own_)::v;
        const int cb = p & 1;
        if (p + 1 < NT) { const int r0 = tile_row0(p + 1);
            kreg = *(const GAS v4u*)(Kg + (size_t)(r0 + krow) * kpitch + kch * 8); if (k2) kreg2 = *(const GAS v4u*)(Kg + (size_t)(r0 + krow2) * kpitch + kch2 * 8);
            vreg = *(const GAS v4u*)(Vg + (size_t)(r0 + vrow) * vpitch + vch * 8); }
        const bool need = OWN ? !(p > (wid >> 1)) : true;
        if (need) {
            const LAS unsigned char* Kb = Kl + cb * KBUF + kfo; const LAS unsigned char* Vb = Vl + cb * VBUF + vfo;
            f32x16 s0 = negm, s1 = negm;
            if constexpr (!OWN && MOBA) {
                if (cdirty || (p & 3) == 0) { const bool on = ((sel >> ((p - 4) >> 2)) & 1u) != 0u;
#pragma unroll
                    for (int r = 0; r < 16; ++r) cuse[r] = on ? negm[r] : -1.0e30f;
                    cdirty = false; }
                s0 = cuse; s1 = cuse; }
            bf16x8 kf[2 * ND];
#pragma unroll
            for (int d0 = 0; d0 < ND; ++d0) { kf[2 * d0] = *(const LAS bf16x8*)(Kb + d0 * 32); kf[2 * d0 + 1] = *(const LAS bf16x8*)(Kb + 32 * KSTR + d0 * 32); }
            __builtin_amdgcn_sched_barrier(0);
#pragma unroll
            for (int d0 = 0; d0 < ND; ++d0) { s0 = __builtin_amdgcn_mfma_f32_32x32x16_bf16(kf[2 * d0], qf[d0], s0, 0, 0, 0); s1 = __builtin_amdgcn_mfma_f32_32x32x16_bf16(kf[2 * d0 + 1], qf[d0], s1, 0, 0, 0); }
            s16x4 vt[16];
#pragma unroll
            for (int v = 0; v < 16; ++v) vt[v] = __builtin_bit_cast(s16x4, __builtin_amdgcn_ds_read_tr16_b64_v4i16((LAS s16x4*)(Vb + (v >> 2) * 1024 + ((v >> 1) & 1) * 4096 + (v & 1) * 512)));
            __builtin_amdgcn_sched_barrier(0);
            if constexpr (OWN) { const int kb = 64 * p + 4 * hi;
#pragma unroll
                for (int r = 0; r < 16; ++r) { const int kv = kb + (r & 3) + 8 * (r >> 2); if (kv > qrel) s0[r] = -INFINITY; if (kv + 32 > qrel) s1[r] = -INFINITY; } }
            float ra = att_max3(s0[0], s0[1], s1[0]), rb = att_max3(s0[2], s0[3], s1[1]); ra = att_max3(ra, s1[2], s1[3]);
#pragma unroll
            for (int r = 4; r < 16; r += 4) { ra = att_max3(ra, s0[r], s0[r + 1]); rb = att_max3(rb, s0[r + 2], s0[r + 3]); ra = att_max3(ra, s1[r], s1[r + 1]); rb = att_max3(rb, s1[r + 2], s1[r + 3]); }
            float rm = fmaxf(ra, rb); rm = fmaxf(rm, __shfl_xor(rm, 32));
            if ((OWN && p == 0) || __any(rm > THR)) {
                const float dl = (OWN && p == 0) ? rm : fmaxf(rm, 0.f); m_run += dl;
                const float fsc = __builtin_amdgcn_exp2f(-dl); l_run *= fsc;
#pragma unroll
                for (int r = 0; r < 16; ++r) { s0[r] -= dl; s1[r] -= dl; o0[r] *= fsc; o1[r] *= fsc; negm[r] = -m_run; }
                cdirty = true;
            }
            float rs0 = 0.f, rs1 = 0.f;
#pragma unroll
            for (int r = 0; r < 16; ++r) { s0[r] = __builtin_amdgcn_exp2f(s0[r]); s1[r] = __builtin_amdgcn_exp2f(s1[r]); rs0 += s0[r]; rs1 += s1[r]; }
            l_run += rs0 + rs1;
            bf16x8 pf[4];
#pragma unroll
            for (int s = 0; s < 2; ++s) { v4u a, b;
                a.x = pg8::cvt_pk_bf16(s0[8 * s + 0], s0[8 * s + 1]); a.y = pg8::cvt_pk_bf16(s0[8 * s + 2], s0[8 * s + 3]); a.z = pg8::cvt_pk_bf16(s0[8 * s + 4], s0[8 * s + 5]); a.w = pg8::cvt_pk_bf16(s0[8 * s + 6], s0[8 * s + 7]);
                b.x = pg8::cvt_pk_bf16(s1[8 * s + 0], s1[8 * s + 1]); b.y = pg8::cvt_pk_bf16(s1[8 * s + 2], s1[8 * s + 3]); b.z = pg8::cvt_pk_bf16(s1[8 * s + 4], s1[8 * s + 5]); b.w = pg8::cvt_pk_bf16(s1[8 * s + 6], s1[8 * s + 7]);
                pf[s] = __builtin_bit_cast(bf16x8, a); pf[2 + s] = __builtin_bit_cast(bf16x8, b); }
#pragma unroll
            for (int s = 0; s < 4; ++s) {
                const bf16x8 va = (bf16x8){vt[4 * s][0], vt[4 * s][1], vt[4 * s][2], vt[4 * s][3], vt[4 * s + 1][0], vt[4 * s + 1][1], vt[4 * s + 1][2], vt[4 * s + 1][3]};
                const bf16x8 vb = (bf16x8){vt[4 * s + 2][0], vt[4 * s + 2][1], vt[4 * s + 2][2], vt[4 * s + 2][3], vt[4 * s + 3][0], vt[4 * s + 3][1], vt[4 * s + 3][2], vt[4 * s + 3][3]};
                o0 = __builtin_amdgcn_mfma_f32_32x32x16_bf16(va, pf[s], o0, 0, 0, 0);
                o1 = __builtin_amdgcn_mfma_f32_32x32x16_bf16(vb, pf[s], o1, 0, 0, 0); }
        }
        if (p + 1 < NT) { const int nb = cb ^ 1;
            *(LAS v4u*)(Kl + nb * KBUF + kst) = kreg; if (k2) *(LAS v4u*)(Kl + nb * KBUF + kst2) = kreg2; *(LAS v4u*)(Vl + nb * VBUF + vst) = vreg; }
        __syncthreads();
        __syncthreads();
    };
    for (int p = 0; p < 4; ++p) slot(p, AttOwn{});
    for (int p = 4; p < NT; ++p) slot(p, AttPast{});
    l_run += __shfl_xor(l_run, 32);
    const float rl = 1.0f / l_run;
    { float ss = 0.f;
#pragma unroll
      for (int r = 0; r < 16; ++r) { const float a = o0[r] * rl, b = o1[r] * rl; ss += a * a + b * b; }
      ss += __shfl_xor(ss, 32);
      if (hi == 0) ((GAS float*)ossq_)[(size_t)(qb * 256 + wid * 32 + r32) * 16] = ss; }
    LAS unsigned char* stg = lds + 65536 + wid * 4608; const float rl16 = rl * 16.0f;
#pragma unroll
    for (int g = 0; g < 4; ++g) {
        *(LAS unsigned*)(stg + r32 * 80 + (8 * g + 4 * hi)) = pk4_fp8(o0[4 * g] * rl16, o0[4 * g + 1] * rl16, o0[4 * g + 2] * rl16, o0[4 * g + 3] * rl16);
        *(LAS unsigned*)(stg + r32 * 80 + (32 + 8 * g + 4 * hi)) = pk4_fp8(o1[4 * g] * rl16, o1[4 * g + 1] * rl16, o1[4 * g + 2] * rl16, o1[4 * g + 3] * rl16); }
    asm volatile("s_waitcnt lgkmcnt(0)" ::: "memory");
    GAS unsigned char* obase = (GAS unsigned char*)Og + (size_t)(qb * 256 + wid * 32) * opitch;
#pragma unroll
    for (int i = 0; i < 2; ++i) { const int row = i * 16 + (lane >> 2), ch = lane & 3; const v4u v = *(const LAS v4u*)(stg + row * 80 + ch * 16); *(GAS v4u*)(obase + (size_t)row * opitch + ch * 16) = v; }
    asm volatile("s_waitcnt lgkmcnt(0)" ::: "memory");
}

__device__ __forceinline__ void transpose_item(const float* W_, int ldw, bf16* WT, int ldt, int k0, int n0, int dr0, int dr1, LAS float* scr, int lane, const float* kgain = nullptr) {
    const GAS float* W = (const GAS float*)W_; const int q = lane & 15, kr = lane >> 4; const bool ld_ok = (q < 8) ? (dr0 >= 0) : (dr1 >= 0);
#pragma unroll 4
    for (int i = 0; i < 16; ++i) { const int kk = 4 * i + kr; f32x4 v = {0.f, 0.f, 0.f, 0.f}; if (ld_ok) v = *(const GAS f32x4*)(W + (size_t)(k0 + kk) * ldw + n0 + 4 * q);
        if (kgain) v = v * ((const GAS float*)kgain)[k0 + kk];
        LAS float* s = scr + kk * 65 + 4 * q; s[0] = v[0]; s[1] = v[1]; s[2] = v[2]; s[3] = v[3]; }
    asm volatile("s_waitcnt lgkmcnt(0)" ::: "memory");
    const int c = lane & 7;
#pragma unroll
    for (int j = 0; j < 8; ++j) { const int n = 8 * j + (lane >> 3); const LAS float* s = scr + (8 * c) * 65 + n; const int dr = (n < 32) ? dr0 : dr1;
        v4u o; o.x = pk2(s[0 * 65], s[1 * 65]); o.y = pk2(s[2 * 65], s[3 * 65]); o.z = pk2(s[4 * 65], s[5 * 65]); o.w = pk2(s[6 * 65], s[7 * 65]);
        if (dr >= 0) *(GAS v4u*)(WT + (size_t)(dr + (n & 31)) * ldt + k0 + 8 * c) = o; }
    asm volatile("s_waitcnt lgkmcnt(0)" ::: "memory");
}

__device__ __forceinline__ void transpose_item8(const float* W_, int ldw, unsigned char* WT8, int ldt, int k0, int n0, int dr0, int dr1, LAS float* scr, int lane, float scale, const float* kgain = nullptr) {
    const GAS float* W = (const GAS float*)W_; const int q = lane & 15, kr = lane >> 4; const bool ld_ok = (q < 8) ? (dr0 >= 0) : (dr1 >= 0);
#pragma unroll 4
    for (int i = 0; i < 16; ++i) { const int kk = 4 * i + kr; f32x4 v = {0.f, 0.f, 0.f, 0.f}; if (ld_ok) v = *(const GAS f32x4*)(W + (size_t)(k0 + kk) * ldw + n0 + 4 * q);
        if (kgain) v = v * ((const GAS float*)kgain)[k0 + kk];
        v = v * scale;
        LAS float* s = scr + kk * 65 + 4 * q; s[0] = v[0]; s[1] = v[1]; s[2] = v[2]; s[3] = v[3]; }
    asm volatile("s_waitcnt lgkmcnt(0)" ::: "memory");
    const int c = lane & 7;
#pragma unroll
    for (int j = 0; j < 8; ++j) { const int n = 8 * j + (lane >> 3); const LAS float* s = scr + (8 * c) * 65 + n; const int dr = (n < 32) ? dr0 : dr1;
        v2u o; o.x = pk4_fp8(s[0 * 65], s[1 * 65], s[2 * 65], s[3 * 65]); o.y = pk4_fp8(s[4 * 65], s[5 * 65], s[6 * 65], s[7 * 65]);
        if (dr >= 0) *(GAS v2u*)((GAS unsigned char*)WT8 + (size_t)(dr + (n & 31)) * ldt + k0 + 8 * c) = o; }
    asm volatile("s_waitcnt lgkmcnt(0)" ::: "memory");
}

struct Args {
    const float* x; const float* attn_g; const float* w_in; const float* qlat_g; const float* w_qup; const float* kvlat_g; const float* w_kvup;
    const float* qhead_g; const float* khead_g; const float* mqhead_g; const float* mkhead_g; const float* onorm_a_g; const float* onorm_b_g; const float* w_out;
    const float* ffn_g; const float* w_rg; const float* b_rg; const float* w_re; const float* b_re; const float* w_gate; const float* w_up; const float* w_down;
    float* out; unsigned char* ws; int ph_lo, ph_hi;
};
enum { PH_PRO = 0, PH_PROJ, PH_UP, PH_ATTN, PH_OUT, PH_ROUTE, PH_GU, PH_D0, NPHASE };

__global__ void __launch_bounds__(512, 2) mk_fwd(Args A) {
    extern __shared__ __attribute__((aligned(16))) unsigned char lds_raw[];
    LAS unsigned char* lds = (LAS unsigned char*)lds_raw;
    const int tid0 = threadIdx.x;
    const int G = gridDim.x, bx = blockIdx.x;
#define NGW (G * 8)
#define PH_BEGIN int tid = threadIdx.x; asm volatile("" : "+v"(tid)); const int lane = tid & 63; const int wave = __builtin_amdgcn_readfirstlane(tid >> 6); const int gw = bx * 8 + wave; \
    const __attribute__((address_space(4))) Args* AP = (const __attribute__((address_space(4))) Args*)__builtin_amdgcn_kernarg_segment_ptr(); asm volatile("" : "+s"(AP)); \
    unsigned char* ws = AP->ws; (void)lane; (void)gw; (void)ws;
#define Win_t ((bf16*)(ws + WS_WIN))
#define Wq_t ((bf16*)(ws + WS_WQ))
#define Wkv_t ((bf16*)(ws + WS_WKV))
#define Wo_t ((bf16*)(ws + WS_WO))
#define Wgu_t ((bf16*)(ws + WS_WGU))
#define Wd_t ((bf16*)(ws + WS_WD))
#define ropeF ((float*)(ws + WS_ROPE))
#define ropeR (((float*)(ws + WS_ROPE)) + 2 * SEQ * 32)
#define kmean ((float*)(ws + WS_KMEAN))
#define XN ((bf16*)(ws + WS_XN))
#define X1B ((bf16*)(ws + WS_X1B))
#define VB ((bf16*)(ws + WS_VB))
#define YH ((bf16*)(ws + WS_YH))
#define Y0B ((bf16*)(ws + WS_Y0))
#define SSQ ((float*)(ws + WS_SSQ))
#define WREF ((float*)(ws + WS_WRE))
#define WRGF ((float*)(ws + WS_WRE + 131072))
#define OSSQ ((float*)(ws + WS_OSSQ))
#define QB ((bf16*)(ws + WS_QB))
#define KB ((bf16*)(ws + WS_KB))
#define QA ((bf16*)(ws + WS_QA))
#define VA ((bf16*)(ws + WS_VA))
#define KA ((bf16*)(ws + WS_KA))
#define QLN ((bf16*)(ws + WS_QLN))
#define KVLN ((bf16*)(ws + WS_KVLN))
#define HB ((bf16*)(ws + WS_H))
#define lists ((pg8::ListEnt*)(ws + WS_LISTS))
    volatile LAS unsigned* MISC = (volatile LAS unsigned*)(lds + LDSCTL_OFF);
    for (int u = tid0; u < (LDS_BYTES - LDSCTL_OFF) / 4; u += 512) ((LAS unsigned*)(lds + LDSCTL_OFF))[u] = 0u;
    __syncthreads();
    XcdBarrier bar = xcd_barrier_post((unsigned*)((gu32*)(A.ws + WS_CTL) + CW_BAR), MISC + 8);
    const int lo = A.ph_lo, hi = A.ph_hi;
#define IN(k) (lo <= (k) && (k) < hi)
#define MOE_SLOT(npn) ((G == 256) ? ((((bx >> 3) / (npn)) * 8 + (bx & 7)) * (npn) + ((bx >> 3) % (npn))) : bx)
#define SEAM(k) do { if (IN(k) && IN((k) + 1)) xcd_barrier(bar); } while (0)

    if (IN(PH_PRO)) { PH_BEGIN
        LAS float* scr = (LAS float*)(lds + wave * 16640);
        constexpr int I_IN = 16 * 31, I_QU = 4 * 12, I_KV = 2 * 16, I_WO = 16 * 16, I_G = 32 * 64, I_U = 32 * 64, I_D = 32 * 64;
        constexpr int NITEMS = I_IN + I_QU + I_KV + I_WO + I_G + I_U + I_D;
        for (int it = gw; it < NITEMS; it += NGW) {
            int r = it;
            if (r < I_IN) { const int kb = r / 31, nb = r % 31; int dr[2];
#pragma unroll
                for (int h2 = 0; h2 < 2; ++h2) { const int gi = 2 * nb + h2;
                    if (gi < 13) dr[h2] = 32 * gi; else if (gi < 45) { const int q = (gi - 13) & 15, hh = q >> 1, bj = q & 1; dr[h2] = (gi < 29 ? 512 : 1024) + (hh >> 2) * 256 + bj * 128 + (hh & 3) * 32; } else if (gi < 61) dr[h2] = 1536 + (gi - 45) * 32; else dr[h2] = -1; }
                transpose_item(AP->w_in, NPROJ_REAL, Win_t, 1024, 64 * kb, 64 * nb, dr[0], dr[1], scr, lane); continue; } r -= I_IN;
            if (r < I_QU) { const int kb = r / 12, nb = r % 12; transpose_item(AP->w_qup, 768, Wq_t, 256, 64 * kb, 64 * nb, 64 * nb, 64 * nb + 32, scr, lane, AP->qlat_g); continue; } r -= I_QU;
            if (r < I_KV) { const int kb = r / 16, nb = r % 16; const int n0 = 64 * nb, hh = n0 >> 7, j0 = n0 & 127;
                const int d0 = (j0 < 64) ? ((hh >> 2) * 256 + (hh & 3) * 32) : (512 + hh * 64), d1 = (j0 < 64) ? (d0 + 128) : (d0 + 32);
                transpose_item(AP->w_kvup, 1024, Wkv_t, 256, 64 * kb, n0, d0, d1, scr, lane, AP->kvlat_g); continue; } r -= I_KV;
            if (r < I_WO) { const int kb = r / 16, nb = r % 16; transpose_item8(AP->w_out, 1024, (unsigned char*)Wo_t, 1024, 64 * kb, 64 * nb, 64 * nb, 64 * nb + 32, scr, lane, 32.0f, kb < 8 ? AP->onorm_a_g : AP->onorm_b_g - 512); continue; } r -= I_WO;
            if (r < I_G) { const int e = r >> 6, r2 = r & 63, kb = r2 >> 2, nb = r2 & 3; const int n0 = 64 * nb; const int d0 = (n0 >> 7) * 256 + (n0 & 127);
                transpose_item8(AP->w_gate + (size_t)e * 1024 * 256, 256, (unsigned char*)Wgu_t + (size_t)e * 512 * 1024, 1024, 64 * kb, n0, d0, d0 + 32, scr, lane, 32.0f); continue; } r -= I_G;
            if (r < I_U) { const int e = r >> 6, r2 = r & 63, kb = r2 >> 2, nb = r2 & 3; const int n0 = 64 * nb; const int d0 = (n0 >> 7) * 256 + 128 + (n0 & 127);
                transpose_item8(AP->w_up + (size_t)e * 1024 * 256, 256, (unsigned char*)Wgu_t + (size_t)e * 512 * 1024, 1024, 64 * kb, n0, d0, d0 + 32, scr, lane, 32.0f); continue; } r -= I_U;
            { const int e = r >> 6, r2 = r & 63, kb = r2 >> 4, nb = r2 & 15;
                transpose_item8(AP->w_down + (size_t)e * 256 * 1024, 1024, (unsigned char*)Wd_t + (size_t)e * 1024 * 256, 256, 64 * kb, 64 * nb, 64 * nb, 64 * nb + 32, scr, lane, 16.0f); }
        }
        const int gt = bx * 512 + tid, NGT = G * 512;
        for (int i = gt; i < 96 * 128; i += NGT) *(GAS v4u*)(Win_t + (size_t)416 * 1024 + (size_t)i * 8) = (v4u){0u, 0u, 0u, 0u};
        for (int i = gt; i < 1024 * 16; i += NGT) *(GAS v4u*)(Wkv_t + (size_t)(i >> 4) * 256 + 128 + (i & 15) * 8) = (v4u){0u, 0u, 0u, 0u};
        for (int i = gt; i < SEQ * 48; i += NGT) {
            const int pos = i / 48, f = i % 48; const bool isF = f < 32; const int ff = isF ? f : f - 32;
            const double e = isF ? (double)ff / 32.0 : (double)ff / 16.0;
            const float invf = (float)exp2(-e * 13.287712379549449);
            const float ang = (float)pos * invf;
            const double a = (double)ang; const double kk = rint(a * 0.15915494309189535); const double rr = a - kk * 6.283185307179586;
            const float c = (float)cos(rr), s = (float)sin(rr);
            GAS float* rF = (GAS float*)ropeF; GAS float* rR = (GAS float*)ropeR;
            if (isF) { rF[pos * 32 + ff] = c; rF[SEQ * 32 + pos * 32 + ff] = s; } else { rR[pos * 16 + ff] = c; rR[SEQ * 16 + pos * 16 + ff] = s; }
        }
        for (int i = gt; i < 1024 * 8; i += NGT) { const float gk = AP->ffn_g[i >> 3]; *((GAS f32x4*)WREF + i) = *((const GAS f32x4*)AP->w_re + i) * gk; }
        for (int i = gt; i < 1024; i += NGT) { const float gk = AP->ffn_g[i]; *((GAS f32x4*)WRGF + i) = *((const GAS f32x4*)AP->w_rg + i) * gk; }
        for (int t = gw; t < T; t += 2 * NGW) {
            const int t2 = (t + NGW < T) ? t + NGW : t;
            const GAS f32x4* xr = (const GAS f32x4*)(AP->x + (size_t)t * D) + lane; const GAS f32x4* xr2 = (const GAS f32x4*)(AP->x + (size_t)t2 * D) + lane; f32x4 v[4], w[4]; float s = 0.f, s2 = 0.f;
#pragma unroll
            for (int j = 0; j < 4; ++j) { v[j] = xr[64 * j]; w[j] = xr2[64 * j]; }
#pragma unroll
            for (int j = 0; j < 4; ++j) { s += (v[j].x * v[j].x + v[j].y * v[j].y) + (v[j].z * v[j].z + v[j].w * v[j].w); s2 += (w[j].x * w[j].x + w[j].y * w[j].y) + (w[j].z * w[j].z + w[j].w * w[j].w); }
            const float rstd = 1.0f / sqrtf(wave_sum(s) * (1.f / D) + EPS), rstd2 = 1.0f / sqrtf(wave_sum(s2) * (1.f / D) + EPS);
            GAS unsigned long long* o8 = (GAS unsigned long long*)(XN + (size_t)t * D) + lane; GAS unsigned long long* o82 = (GAS unsigned long long*)(XN + (size_t)t2 * D) + lane;
#pragma unroll
            for (int j = 0; j < 4; ++j) { const f32x4 g = *((const GAS f32x4*)AP->attn_g + lane + 64 * j);
                o8[64 * j] = (unsigned long long)pk2(v[j].x * rstd * g.x, v[j].y * rstd * g.y) | ((unsigned long long)pk2(v[j].z * rstd * g.z, v[j].w * rstd * g.w) << 32);
                o82[64 * j] = (unsigned long long)pk2(w[j].x * rstd2 * g.x, w[j].y * rstd2 * g.y) | ((unsigned long long)pk2(w[j].z * rstd2 * g.z, w[j].w * rstd2 * g.w) << 32); }
        }
    }
    SEAM(PH_PRO);

    if (IN(PH_PROJ)) { PH_BEGIN
        pg8::Gemm g{XN, Win_t, T, NPROJ, D}; pg8::StaticOrder S; S.init(T, NPROJ, G, bx);
        pg8::EpiProj E{ws, WS_QLN, WS_KVLN, WS_QB, WS_KB, WS_VB, WS_SSQ, WS_KMEAN, WS_ROPE, AP->mqhead_g, AP->mkhead_g, C2B, EPS, SEQ};
        pg8::gemm_phase<pg8::EpiProj, pg8::StaticOrder, true, true>(lds, g, S, E);
    }
    SEAM(PH_PROJ);

    if (IN(PH_UP)) { PH_BEGIN
        { int K256 = 256; asm volatile("" : "+s"(K256)); pg8::Gemm g{QLN, Wq_t, T, 768, K256}; pg8::StaticOrder S; S.init(T, 768, G, bx); pg8::EpiBf16Rs E{QA, 768, SSQ, 0, 1.0f / 256.0f, EPS};
          pg8::gemm_phase<pg8::EpiBf16Rs, pg8::StaticOrder, true, true>(lds, g, S, E); }
        { int K256 = 256; asm volatile("" : "+s"(K256)); pg8::Gemm g{KVLN, Wkv_t, T, 1024, K256}; pg8::StaticOrder S; S.init(T, 1024, G, bx); pg8::EpiKv E{KA, VA, KVLN, SSQ, ropeR, AP->khead_g, EPS, SEQ};
          pg8::gemm_phase<pg8::EpiKv, pg8::StaticOrder, true, true>(lds, g, S, E); }
    }
    SEAM(PH_UP);

    if (IN(PH_ATTN)) { PH_BEGIN
        bf16* O = XN;
        for (int u = bx; u < 512; u += G) {
            const int bh = u & 255, b = bh >> 3, h = bh & 7; const size_t r0 = (size_t)b * SEQ;
            if (u < 256) {
                for (int qb = 7; qb >= 0; --qb)
                    attn_unit<96, false, true>(lds, AP->qhead_g, ropeR, QA + r0 * 768 + h * 96, 768, KA + r0 * 768 + h * 96, 768, VA + r0 * 512 + h * 64, 512, (bf16*)((unsigned char*)O + r0 * 1024 + h * 64), 1024, OSSQ + r0 * 16 + h, qb, nullptr, 0);
            } else {
                for (int qb = 7; qb >= 0; --qb)
                    attn_unit<64, true, false>(lds, nullptr, nullptr, QB + r0 * 512 + h * 64, 512, KB + r0 * 512 + h * 64, 512, VB + r0 * 512 + h * 64, 512, (bf16*)((unsigned char*)O + r0 * 1024 + 512 + h * 64), 1024, OSSQ + r0 * 16 + 8 + h, qb, kmean + ((size_t)b * 8 * NH + h) * 64, NH * 64);
            }
        }
    }
    SEAM(PH_ATTN);

    if (IN(PH_OUT)) { PH_BEGIN
        pg8::Gemm g{XN, Wo_t, T, D, D / 2};        pg8::StaticOrder S; S.init(T, D, G, bx);
        LAS float* rsl = (LAS float*)(lds + RING_BYTES);
        { pg8::Unit uu;
          for (int i = 0; i < 12 && S.next(i, uu); ++i) if (tid < 256) { const GAS f32x4* pq = (const GAS f32x4*)((const GAS float*)OSSQ + (size_t)(uu.pm * 256 + tid) * 16); const f32x4 a0 = pq[0], a1 = pq[1], b0 = pq[2], b1 = pq[3];
              const float sa = ((a0[0] + a0[1]) + (a0[2] + a0[3])) + ((a1[0] + a1[1]) + (a1[2] + a1[3])), sb = ((b0[0] + b0[1]) + (b0[2] + b0[3])) + ((b1[0] + b1[1]) + (b1[2] + b1[3]));
              const float ra = 1.0f / sqrtf(sa * (1.0f / 512.0f) + EPS), rb = 1.0f / sqrtf(sb * (1.0f / 512.0f) + EPS);
              *(LAS f32x2*)(rsl + (i * 256 + tid) * 2) = (f32x2){ra / rb, rb}; }
          __syncthreads(); }
        pg8::EpiOut E{AP->x, X1B, rsl};
        pg8::gemm_phase<pg8::EpiOut, pg8::StaticOrder, true, true, false, false, true, 0x7a7a7a7a, 0x7b7b7b7b, true>(lds, g, S, E);
    }
    SEAM(PH_OUT);

    if (IN(PH_ROUTE)) { PH_BEGIN
        LAS float* Wrg = (LAS float*)(lds + P8_WRG); LAS float* xt = (LAS float*)(lds + P8_XT + wave * P8_XT_WAVE); LAS float* wc = (LAS float*)(lds + P8_WC);
        LAS int* rt_g = (LAS int*)(lds + P8_RT); LAS float* rt_w = (LAS float*)(lds + P8_RT + 1024); LAS int* rt_rank = (LAS int*)(lds + P8_RT + 3072);
        LAS int* lcnt = (LAS int*)(lds + P8_RT + 4096); LAS int* lbase = (LAS int*)(lds + P8_RT + 4608); LAS float* rt_rs = (LAS float*)(lds + P8_RT + 5120);
        for (int k = tid; k < 1024; k += 512) *(LAS f32x4*)(Wrg + 4 * k) = *((const GAS f32x4*)WRGF + k);
        __syncthreads();
        const int r32 = lane & 31, kh = lane >> 5;
        for (int chunk = bx; chunk < T / 256; chunk += G) {
            if (tid < NCLS) lcnt[tid] = 0;
            const int rowc = wave * 32 + r32; const size_t row0w = (size_t)chunk * 256 + wave * 32;
            const GAS bf16* xsrc = (const GAS bf16*)X1B + (row0w + (lane >> 4)) * D + 4 * (lane & 15);
            f32x16 accE = {}; float aG0 = 0.f, aG1 = 0.f, aG2 = 0.f, aG3 = 0.f, ssq = 0.f;
            *(LAS f32x4*)(wc + 4 * tid) = *((const GAS f32x4*)WREF + tid);
            v2u xn[8]; f32x4 gvn;
#pragma unroll
            for (int j = 0; j < 8; ++j) xn[j] = *(const GAS v2u*)(xsrc + (size_t)(4 * j) * D);
            gvn = *(const GAS f32x4*)((const GAS float*)AP->ffn_g + 4 * (lane & 15));
#pragma unroll 1
            for (int kc = 0; kc < 16; ++kc) {
                f32x4 st[8];
#pragma unroll
                for (int j = 0; j < 8; ++j) st[j] = (f32x4){bflo(xn[j].x), bfhi(xn[j].x), bflo(xn[j].y), bfhi(xn[j].y)};
                const f32x4 gv = gvn;
                if (kc + 1 < 16) {
#pragma unroll
                    for (int j = 0; j < 8; ++j) xn[j] = *(const GAS v2u*)(xsrc + (size_t)(4 * j) * D + (kc + 1) * 64);
                    gvn = *(const GAS f32x4*)((const GAS float*)AP->ffn_g + (kc + 1) * 64 + 4 * (lane & 15)); }
                f32x4 wnext = {0.f, 0.f, 0.f, 0.f}; if (kc + 1 < 16) wnext = *((const GAS f32x4*)WREF + (kc + 1) * 512 + tid);
#pragma unroll
                for (int j = 0; j < 8; ++j) *(LAS f32x4*)(xt + ((lane >> 4) + 4 * j) * 68 + 4 * (lane & 15)) = st[j];
                if (kc + 1 < 16) *(LAS f32x4*)(wc + ((kc + 1) & 1) * 2048 + 4 * tid) = wnext;
                {
#pragma unroll
                  for (int j = 0; j < 8; ++j) { const f32x4 hv = st[j] * gv;
                      *(GAS unsigned*)((GAS unsigned char*)YH + (size_t)(row0w + (lane >> 4) + 4 * j) * D + kc * 64 + 4 * (lane & 15)) = pk4_fp8(hv[0], hv[1], hv[2], hv[3]); } }
                __syncthreads();
                const LAS float* wcc = wc + (kc & 1) * 2048 + r32;
#pragma unroll
                for (int c = 0; c < 8; ++c) {
                    const f32x4 xv = *(const LAS f32x4*)(xt + r32 * 68 + 8 * c + 4 * kh);
                    ssq += (xv.x * xv.x + xv.y * xv.y) + (xv.z * xv.z + xv.w * xv.w);
#pragma unroll
                    for (int e = 0; e < 4; ++e) { const int kl = 8 * c + 4 * kh + e;
                        const float a = wcc[kl * 32]; accE = __builtin_amdgcn_mfma_f32_32x32x2f32(a, xv[e], accE, 0, 0, 0);
                        const f32x4 wg = *(const LAS f32x4*)(Wrg + 4 * (kc * 64 + kl)); aG0 += xv[e] * wg[0]; aG1 += xv[e] * wg[1]; aG2 += xv[e] * wg[2]; aG3 += xv[e] * wg[3]; }
                }
                __syncthreads();
            }
            ssq += __shfl_xor(ssq, 32); aG0 += __shfl_xor(aG0, 32); aG1 += __shfl_xor(aG1, 32); aG2 += __shfl_xor(aG2, 32); aG3 += __shfl_xor(aG3, 32);
            const float rstd = 1.0f / sqrtf(ssq * (1.f / D) + EPS);
            float lg[4] = {aG0 * rstd + AP->b_rg[0], aG1 * rstd + AP->b_rg[1], aG2 * rstd + AP->b_rg[2], aG3 * rstd + AP->b_rg[3]};
            int gs = 0; float gm = lg[0];
#pragma unroll
            for (int i = 1; i < 4; ++i) if (lg[i] > gm) { gm = lg[i]; gs = i; }
            float den = 0.f;
#pragma unroll
            for (int i = 0; i < 4; ++i) den += __expf(lg[i] - gm);
            const float gwt = 1.0f / den;
            float mine[4];
#pragma unroll
            for (int i = 0; i < 4; ++i) { const float v = (gs == 0) ? accE[i] : (gs == 1) ? accE[4 + i] : (gs == 2) ? accE[8 + i] : accE[12 + i]; mine[i] = v * rstd + AP->b_re[gs * 8 + 4 * kh + i]; }
            float ev[8];
#pragma unroll
            for (int i = 0; i < 4; ++i) { const float oth = __shfl_xor(mine[i], 32); ev[i] = kh ? oth : mine[i]; ev[4 + i] = kh ? mine[i] : oth; }
            int e1 = 0; float v1 = ev[0];
#pragma unroll
            for (int i = 1; i < 8; ++i) if (ev[i] > v1) { v1 = ev[i]; e1 = i; }
            int e2 = -1; float v2 = -INFINITY;
#pragma unroll
            for (int i = 0; i < 8; ++i) if (i != e1 && (e2 < 0 || ev[i] > v2)) { v2 = ev[i]; e2 = i; }
            const float ex = __expf(v2 - v1); const float w1 = gwt / (1.0f + ex), w2 = gwt * ex / (1.0f + ex);
            if (kh == 0) { const int elo = e1 < e2 ? e1 : e2, ehi = e1 < e2 ? e2 : e1;
                rt_g[rowc] = gs * 28 + ((elo * (15 - elo)) >> 1) + (ehi - elo - 1); rt_w[rowc * 2] = e1 < e2 ? w1 : w2; rt_w[rowc * 2 + 1] = e1 < e2 ? w2 : w1; rt_rs[rowc] = rstd; }
            __syncthreads();
            if (tid < 256) rt_rank[tid] = __hip_atomic_fetch_add(&lcnt[rt_g[tid]], 1, __ATOMIC_RELAXED, __HIP_MEMORY_SCOPE_WORKGROUP);
            __syncthreads();
            if (tid < NCLS) { const int n = lcnt[tid]; lbase[tid] = n ? (int)__hip_atomic_fetch_add((gu32*)(ws + WS_CTL) + CW_GCNT + 64 * tid, (unsigned)n, RLX_AGENT) : 0; }
            __syncthreads();
            if (tid < 256) { const int g = rt_g[tid]; v4u ev; ev.x = (unsigned)(chunk * 256 + tid); ev.y = __builtin_bit_cast(unsigned, rt_w[tid * 2]); ev.z = __builtin_bit_cast(unsigned, rt_w[tid * 2 + 1]); ev.w = __builtin_bit_cast(unsigned, rt_rs[tid]);
                ((GAS v4u*)lists)[(size_t)g * LIST_CAP + lbase[g] + rt_rank[tid]] = ev; }
            __syncthreads();
        }
    }
    SEAM(PH_ROUTE);

    LAS int* tp = (LAS int*)(lds + TP_OFF); LAS int* cntl = (LAS int*)(lds + CNT_OFF); LAS int* ptab = (LAS int*)(lds + PT_OFF);
    if (hi > PH_ROUTE) {
        if (tid0 == 0) { gu32* ctl = (gu32*)(A.ws + WS_CTL); int acc = 0; for (int g = 0; g < NCLS; ++g) { const int n = (int)__hip_atomic_load(ctl + CW_GCNT + 64 * g, RLX_AGENT); cntl[g] = n; tp[g] = acc; acc += (n + 255) >> 8; } tp[NCLS] = acc;
            int p = 0; for (int lo_ = 0; lo_ < 8; ++lo_) for (int hi_ = lo_ + 1; hi_ < 8; ++hi_) ptab[p++] = lo_ | (hi_ << 4); }
        __syncthreads();
    }

    if (IN(PH_GU)) { PH_BEGIN
        pg8::Gemm g{YH, Wgu_t, 0, 0, D / 2}; pg8::ClsOrder S{tp, ptab, 0, G, MOE_SLOT(4), lists, cntl};
        pg8::EpiGateUp2 E{HB, lists, cntl};
        pg8::gemm_phase<pg8::EpiGateUp2, pg8::ClsOrder, true, true, true, false, true>(lds, g, S, E);
    }
    SEAM(PH_GU);

    if (IN(PH_D0)) { PH_BEGIN
        int K512 = 256; asm volatile("" : "+s"(K512)); pg8::Gemm g{HB, Wd_t, 0, 0, K512};        pg8::ClsOrder S{tp, ptab, 1, G, MOE_SLOT(4), lists, cntl};
        pg8::EpiDown2 E{AP->out, X1B, lists, cntl};
        pg8::gemm_phase<pg8::EpiDown2, pg8::ClsOrder, true, true, false, true, true, 0x7b7b7b7b, 0x7c7c7c7c, true>(lds, g, S, E);
    }
#undef IN
#undef SEAM
}

extern "C" void kernel_launch(void* const* d_in, const int* in_sizes, int n_in, void* d_out, int out_size, void* d_ws, size_t ws_size, hipStream_t stream) {
    static int grid = 0;
    if (grid == 0) {
        if (n_in != 22 || in_sizes[0] != T * D || out_size != T * D || ws_size < WS_END) { fprintf(stderr, "kernel_launch: unexpected shapes (n_in %d, in0 %d, out %d, ws %zu); nothing launched\n", n_in, n_in > 0 ? in_sizes[0] : -1, out_size, ws_size); grid = -1; return; }
        int dev = 0, cus = 0, per_cu = 0;
        if (hipGetDevice(&dev) != hipSuccess || hipDeviceGetAttribute(&cus, hipDeviceAttributeMultiprocessorCount, dev) != hipSuccess) { grid = -1; return; }
        if (hipFuncSetAttribute((const void*)mk_fwd, hipFuncAttributeMaxDynamicSharedMemorySize, LDS_BYTES) != hipSuccess) { fprintf(stderr, "kernel_launch: hipFuncSetAttribute failed\n"); grid = -1; return; }
        if (hipOccupancyMaxActiveBlocksPerMultiprocessor(&per_cu, (const void*)mk_fwd, 512, LDS_BYTES) != hipSuccess || per_cu < 1) { fprintf(stderr, "kernel_launch: occupancy query says %d\n", per_cu); }
        (void)hipGetLastError();
        grid = cus;
    }
    if (grid < 0) return;
    if (hipMemsetAsync((char*)d_ws + WS_CTL, 0, CTL_ZERO_BYTES, stream) != hipSuccess) return;
    Args a{};
    a.x = (const float*)d_in[0]; a.attn_g = (const float*)d_in[1]; a.w_in = (const float*)d_in[2]; a.qlat_g = (const float*)d_in[3]; a.w_qup = (const float*)d_in[4];
    a.kvlat_g = (const float*)d_in[5]; a.w_kvup = (const float*)d_in[6]; a.qhead_g = (const float*)d_in[7]; a.khead_g = (const float*)d_in[8];
    a.mqhead_g = (const float*)d_in[9]; a.mkhead_g = (const float*)d_in[10]; a.onorm_a_g = (const float*)d_in[11]; a.onorm_b_g = (const float*)d_in[12];
    a.w_out = (const float*)d_in[13]; a.ffn_g = (const float*)d_in[14]; a.w_rg = (const float*)d_in[15]; a.b_rg = (const float*)d_in[16];
    a.w_re = (const float*)d_in[17]; a.b_re = (const float*)d_in[18]; a.w_gate = (const float*)d_in[19]; a.w_up = (const float*)d_in[20]; a.w_down = (const float*)d_in[21];
    a.out = (float*)d_out; a.ws = (unsigned char*)d_ws; a.ph_lo = 0; a.ph_hi = NPHASE;
    hipLaunchKernelGGL(mk_fwd, dim3(grid), dim3(512), LDS_BYTES, stream, a);
    (void)hipPeekAtLastError();
}
```

```cpp
#include <hip/hip_runtime.h>
#include <cstdio>
#include <cstdint>
namespace pg8 {
#define PG8_LAS __attribute__((address_space(3)))
typedef unsigned short bf16_t;
typedef short bf16x8 __attribute__((ext_vector_type(8)));
typedef float f32x4 __attribute__((ext_vector_type(4)));
typedef unsigned u32x4 __attribute__((ext_vector_type(4)));
constexpr int BM = 256, BK = 64, HALF = 128, HTB = HALF * BK * 2  , STAGE_BYTES = 8 * HTB, NXCD = 8, WGM = 8;

__host__ __device__ __forceinline__ int lds_byte(int r, int c) { const int st = (r >> 4) * 2 + (c >> 5), rr = r & 15, cc = c & 31, ob = rr * 64 + cc * 2; return st * 1024 + (ob ^ (((ob >> 9) & 1) << 5)); }
__host__ __device__ __forceinline__ void stage_rc(int b, int& R, int& C) { const int st = b / 1024, sb = b % 1024, swz = sb ^ (((sb >> 9) & 1) << 5); R = (st >> 1) * 16 + swz / 64; C = (st & 1) * 32 + (swz % 64) / 2; }
__host__ __device__ __forceinline__ int perm32(int rho) { const int n = rho >> 4, i = rho & 15; return 8 * (i >> 2) + 4 * n + (i & 3); }

struct Unit { int pm, pn, g0, g1, pn2, q; };
struct Gemm { const bf16_t* A; const bf16_t* Bt; int M, N, K; };

struct StaticOrder {
    int nM, nN, nwg, G, c;
    __host__ __device__ void init(int M, int N, int G_, int c_) { nM = M / BM; nN = N / BM; nwg = nM * nN; G = G_; c = c_; }
    __host__ __device__ bool next(int i, Unit& u) const {
        const long L = (long)i * G + c; if (L >= nwg) return false;
        int wgid = (int)L; { const int q = nwg / NXCD, r = nwg % NXCD, xcd = wgid % NXCD, off = wgid / NXCD; wgid = (xcd < r ? xcd * (q + 1) : r * (q + 1) + (xcd - r) * q) + off; }
        const int nig = WGM * nN, gid = wgid / nig, fm = gid * WGM, gsz = (nM - fm) < WGM ? (nM - fm) : WGM;
        u.pm = fm + ((wgid % nig) % gsz); u.pn = (wgid % nig) / gsz; u.g0 = i; u.g1 = 0; u.pn2 = 0; u.q = 0; return true;
    }
    __device__ __forceinline__ void a_ready(const Unit&) const {}
    __device__ __forceinline__ void done(const Unit&) const {}
};

__device__ __forceinline__ unsigned cvt_pk_bf16(float lo, float hi) { unsigned r; asm volatile("v_cvt_pk_bf16_f32 %0, %1, %2" : "=v"(r) : "v"(lo), "v"(hi)); return r; }
#define PG8_GAS __attribute__((address_space(1)))
struct ListEnt { int tok; float w_lo; float w_hi; float rstd; };

struct EpiBf16 {
    static constexpr bool PERM = true, AFTER_DRAIN = false, MIDHOOK = false;
    bf16_t* O; int ldc;
    __device__ __forceinline__ void operator()(const f32x4 (&acc)[2][2][4][2], const Unit& u, int wr, int wc, int fr, int fq) const {
        const int row0 = u.pm * BM + wr * 64 + fr; const int col0 = u.pn * BM + wc * 32 + 8 * fq;
#pragma unroll
        for (int ai = 0; ai < 2; ++ai)
#pragma unroll
            for (int m = 0; m < 4; ++m) { bf16_t* rowp = O + (size_t)(row0 + ai * HALF + m * 16) * ldc + col0;
#pragma unroll
                for (int bj = 0; bj < 2; ++bj) { const f32x4 v0 = acc[ai][bj][m][0], v1 = acc[ai][bj][m][1];
                    u32x4 w; w.x = cvt_pk_bf16(v0[0], v0[1]); w.y = cvt_pk_bf16(v0[2], v0[3]); w.z = cvt_pk_bf16(v1[0], v1[1]); w.w = cvt_pk_bf16(v1[2], v1[3]);
                    *(PG8_GAS u32x4*)(rowp + bj * HALF) = w; } }
    }
};
struct EpiBf16Rs {
    static constexpr bool PERM = true, AFTER_DRAIN = false, MIDHOOK = false;
    bf16_t* O; int ldc; const float* ssq; int off; float inv_n, eps;
    __device__ __forceinline__ void operator()(const f32x4 (&acc)[2][2][4][2], const Unit& u, int wr, int wc, int fr, int fq) const {
        const int row0 = u.pm * BM + wr * 64 + fr; const int col0 = u.pn * BM + wc * 32 + 8 * fq;
#pragma unroll
        for (int ai = 0; ai < 2; ++ai)
#pragma unroll
            for (int m = 0; m < 4; ++m) { const int row = row0 + ai * HALF + m * 16; PG8_GAS bf16_t* rowp = (PG8_GAS bf16_t*)O + (size_t)row * ldc + col0;
                const f32x4 sq = *(const PG8_GAS f32x4*)(ssq + (size_t)row * 8 + off); const float rs = __builtin_amdgcn_rsqf(((sq[0] + sq[1]) + (sq[2] + sq[3])) * inv_n + eps);
#pragma unroll
                for (int bj = 0; bj < 2; ++bj) { const f32x4 v0 = acc[ai][bj][m][0] * rs, v1 = acc[ai][bj][m][1] * rs;
                    u32x4 w; w.x = cvt_pk_bf16(v0[0], v0[1]); w.y = cvt_pk_bf16(v0[2], v0[3]); w.z = cvt_pk_bf16(v1[0], v1[1]); w.w = cvt_pk_bf16(v1[2], v1[3]);
                    *(PG8_GAS u32x4*)(rowp + bj * HALF) = w; } }
    }
};
struct EpiProj {
    static constexpr bool PERM = true, AFTER_DRAIN = false, MIDHOOK = false;
    unsigned char* ws; size_t o_qln, o_kvln, o_qb, o_kb, o_vb, o_ssq, o_kmean, o_rope; const float* gq; const float* gk; float qscale, eps; int seq;
    __device__ __forceinline__ void operator()(const f32x4 (&acc)[2][2][4][2], const Unit& u, int wr, int wc, int fr, int fq) const {
        const int pn = u.pn; const int row0 = u.pm * BM + wr * 64 + fr;
        bf16_t* const QLN = (bf16_t*)(ws + o_qln); bf16_t* const KVLN = (bf16_t*)(ws + o_kvln); bf16_t* const QB = (bf16_t*)(ws + o_qb); bf16_t* const KB = (bf16_t*)(ws + o_kb); bf16_t* const VB = (bf16_t*)(ws + o_vb);
        float* const SSQ = (float*)(ws + o_ssq); float* const kmean = (float*)(ws + o_kmean); const float* const rope = (const float*)(ws + o_rope);
        if (pn < 2) {
            PG8_GAS bf16_t* O = (PG8_GAS bf16_t*)(pn ? KVLN : QLN); PG8_GAS float* sq = (PG8_GAS float*)SSQ;
#pragma unroll
            for (int ai = 0; ai < 2; ++ai)
#pragma unroll
                for (int m = 0; m < 4; ++m) { const int row = row0 + ai * HALF + m * 16; PG8_GAS bf16_t* rowp = O + (size_t)row * 256 + wc * 32 + 8 * fq; float ss = 0.f;
#pragma unroll
                    for (int bj = 0; bj < 2; ++bj) { const f32x4 v0 = acc[ai][bj][m][0], v1 = acc[ai][bj][m][1];
                        if (pn == 0 || bj == 0) ss += (v0[0] * v0[0] + v0[1] * v0[1]) + (v0[2] * v0[2] + v0[3] * v0[3]) + (v1[0] * v1[0] + v1[1] * v1[1]) + (v1[2] * v1[2] + v1[3] * v1[3]);
                        u32x4 w; w.x = cvt_pk_bf16(v0[0], v0[1]); w.y = cvt_pk_bf16(v0[2], v0[3]); w.z = cvt_pk_bf16(v1[0], v1[1]); w.w = cvt_pk_bf16(v1[2], v1[3]);
                        *(PG8_GAS u32x4*)(rowp + bj * HALF) = w; }
                    ss += __shfl_xor(ss, 16); ss += __shfl_xor(ss, 32);
                    if (fq == 0) sq[(size_t)row * 8 + pn * 4 + wc] = ss; }
        } else if (pn < 6) {
            const bool isk = pn >= 4; const int head = (pn & 1) * 4 + wc; const float* gp = isk ? gk : gq; asm volatile("" : "+s"(gp)); const float sc = isk ? 1.0f : qscale;
            PG8_GAS bf16_t* O = (PG8_GAS bf16_t*)(isk ? KB : QB);
            f32x4 g0[2], g1[2];
#pragma unroll
            for (int n = 0; n < 2; ++n) { g0[n] = *(const PG8_GAS f32x4*)(gp + 8 * fq + 4 * n); g1[n] = *(const PG8_GAS f32x4*)(gp + 32 + 8 * fq + 4 * n); }
            f32x4 cs0[2] = {{0.f, 0.f, 0.f, 0.f}, {0.f, 0.f, 0.f, 0.f}}, cs1[2] = {{0.f, 0.f, 0.f, 0.f}, {0.f, 0.f, 0.f, 0.f}};
            f32x4 rc[2][4];
            { const int pos0 = row0 & (seq - 1);
#pragma unroll
              for (int n = 0; n < 2; ++n) { rc[0][n] = *(const PG8_GAS f32x4*)(rope + (size_t)pos0 * 32 + 8 * fq + 4 * n); rc[0][2 + n] = *(const PG8_GAS f32x4*)(rope + (size_t)seq * 32 + (size_t)pos0 * 32 + 8 * fq + 4 * n); } }
#pragma unroll
            for (int ai = 0; ai < 2; ++ai)
#pragma unroll
                for (int m = 0; m < 4; ++m) { const int row = row0 + ai * HALF + m * 16; const int gi = ai * 4 + m;
                    if (gi < 7) { const int gn = gi + 1; const int posn = (row0 + (gn >> 2) * HALF + (gn & 3) * 16) & (seq - 1);
#pragma unroll
                        for (int n = 0; n < 2; ++n) { rc[gn & 1][n] = *(const PG8_GAS f32x4*)(rope + (size_t)posn * 32 + 8 * fq + 4 * n); rc[gn & 1][2 + n] = *(const PG8_GAS f32x4*)(rope + (size_t)seq * 32 + (size_t)posn * 32 + 8 * fq + 4 * n); } }
                    float ss = 0.f;
#pragma unroll
                    for (int n = 0; n < 2; ++n) { const f32x4 a = acc[ai][0][m][n], b = acc[ai][1][m][n]; ss += (a[0] * a[0] + a[1] * a[1]) + (a[2] * a[2] + a[3] * a[3]) + (b[0] * b[0] + b[1] * b[1]) + (b[2] * b[2] + b[3] * b[3]); }
                    ss += __shfl_xor(ss, 16); ss += __shfl_xor(ss, 32);
                    const float rs = __builtin_amdgcn_rsqf(ss * (1.0f / 64.0f) + eps);
                    u32x4 w1, w2; unsigned pk1[4], pk2_[4];
#pragma unroll
                    for (int n = 0; n < 2; ++n) { const f32x4 c = rc[gi & 1][n], sn = rc[gi & 1][2 + n];
                        const f32x4 y1 = acc[ai][0][m][n] * rs * g0[n], y2 = acc[ai][1][m][n] * rs * g1[n];
                        const f32x4 o1 = (y1 * c - y2 * sn) * sc, o2 = (y2 * c + y1 * sn) * sc;
                        if (isk) { cs0[n] += o1; cs1[n] += o2; }
                        pk1[2 * n] = cvt_pk_bf16(o1[0], o1[1]); pk1[2 * n + 1] = cvt_pk_bf16(o1[2], o1[3]); pk2_[2 * n] = cvt_pk_bf16(o2[0], o2[1]); pk2_[2 * n + 1] = cvt_pk_bf16(o2[2], o2[3]); }
                    w1.x = pk1[0]; w1.y = pk1[1]; w1.z = pk1[2]; w1.w = pk1[3]; w2.x = pk2_[0]; w2.y = pk2_[1]; w2.z = pk2_[2]; w2.w = pk2_[3];
                    PG8_GAS bf16_t* rowp = O + (size_t)row * 512 + head * 64 + 8 * fq;
                    *(PG8_GAS u32x4*)rowp = w1; *(PG8_GAS u32x4*)(rowp + 32) = w2;
                    asm volatile("" : "+v"(cs0[0]), "+v"(cs0[1]), "+v"(cs1[0]), "+v"(cs1[1]) :: "memory"); }
            if (isk) {
                PG8_GAS float* km = (PG8_GAS float*)kmean + ((size_t)u.pm * 8 + head) * 64;
#pragma unroll
                for (int n = 0; n < 2; ++n)
#pragma unroll
                    for (int j = 0; j < 4; ++j) { float a = cs0[n][j], b = cs1[n][j];
#pragma unroll
                        for (int o = 1; o < 16; o <<= 1) { a += __shfl_xor(a, o); b += __shfl_xor(b, o); }
                        if (fr == 0) { __hip_atomic_fetch_add(km + 8 * fq + 4 * n + j, a * (1.0f / 256.0f), __ATOMIC_RELAXED, __HIP_MEMORY_SCOPE_AGENT); __hip_atomic_fetch_add(km + 32 + 8 * fq + 4 * n + j, b * (1.0f / 256.0f), __ATOMIC_RELAXED, __HIP_MEMORY_SCOPE_AGENT); } }
            }
        } else {
            PG8_GAS bf16_t* O = (PG8_GAS bf16_t*)VB; const int col0 = (pn - 6) * BM + wc * 32 + 8 * fq;
#pragma unroll
            for (int ai = 0; ai < 2; ++ai)
#pragma unroll
                for (int m = 0; m < 4; ++m) { PG8_GAS bf16_t* rowp = O + (size_t)(row0 + ai * HALF + m * 16) * 512 + col0;
#pragma unroll
                    for (int bj = 0; bj < 2; ++bj) { const f32x4 v0 = acc[ai][bj][m][0], v1 = acc[ai][bj][m][1];
                        u32x4 w; w.x = cvt_pk_bf16(v0[0], v0[1]); w.y = cvt_pk_bf16(v0[2], v0[3]); w.z = cvt_pk_bf16(v1[0], v1[1]); w.w = cvt_pk_bf16(v1[2], v1[3]);
                        *(PG8_GAS u32x4*)(rowp + bj * HALF) = w; } }
        }
    }
};
struct EpiKv {
    static constexpr bool PERM = true, AFTER_DRAIN = false, MIDHOOK = false;
    bf16_t* KA; bf16_t* VA; const bf16_t* KVLN; const float* ssq; const float* ropeR; const float* gk; float eps; int seq;
    __device__ __forceinline__ void operator()(const f32x4 (&acc)[2][2][4][2], const Unit& u, int wr, int wc, int fr, int fq) const {
        const int pn = u.pn; const int row0 = u.pm * BM + wr * 64 + fr;
        if (pn < 2) {
            const int head = pn * 4 + wc; const float* gp = gk; asm volatile("" : "+s"(gp));
            f32x4 g0[2], g1[2];
#pragma unroll
            for (int n = 0; n < 2; ++n) { g0[n] = *(const PG8_GAS f32x4*)(gp + 8 * fq + 4 * n); g1[n] = *(const PG8_GAS f32x4*)(gp + 32 + 8 * fq + 4 * n); }
            const f32x4 gr1 = *(const PG8_GAS f32x4*)(gp + 64 + 4 * fq), gr2 = *(const PG8_GAS f32x4*)(gp + 80 + 4 * fq);
#pragma unroll
            for (int ai = 0; ai < 2; ++ai)
#pragma unroll
                for (int m = 0; m < 4; ++m) { const int row = row0 + ai * HALF + m * 16; const int pos = row & (seq - 1);
                    const f32x4 sq = *(const PG8_GAS f32x4*)(ssq + (size_t)row * 8 + 4); const float rl = __builtin_amdgcn_rsqf(((sq[0] + sq[1]) + (sq[2] + sq[3])) * (1.0f / 128.0f) + eps);
                    const PG8_GAS bf16_t* pe = (const PG8_GAS bf16_t*)KVLN + (size_t)row * 256 + 128 + 4 * fq;
                    typedef unsigned u32x2_ __attribute__((ext_vector_type(2)));
                    const u32x2_ p1 = *(const PG8_GAS u32x2_*)pe, p2 = *(const PG8_GAS u32x2_*)(pe + 16);
                    const f32x4 e1 = {__builtin_bit_cast(float, p1.x << 16), __builtin_bit_cast(float, p1.x & 0xffff0000u), __builtin_bit_cast(float, p1.y << 16), __builtin_bit_cast(float, p1.y & 0xffff0000u)};
                    const f32x4 e2 = {__builtin_bit_cast(float, p2.x << 16), __builtin_bit_cast(float, p2.x & 0xffff0000u), __builtin_bit_cast(float, p2.y << 16), __builtin_bit_cast(float, p2.y & 0xffff0000u)};
                    f32x4 x0[2], x1[2]; float ss = (e1[0] * e1[0] + e1[1] * e1[1]) + (e1[2] * e1[2] + e1[3] * e1[3]) + (e2[0] * e2[0] + e2[1] * e2[1]) + (e2[2] * e2[2] + e2[3] * e2[3]);
#pragma unroll
                    for (int n = 0; n < 2; ++n) { x0[n] = acc[ai][0][m][n] * rl; x1[n] = acc[ai][1][m][n] * rl; const f32x4 a = x0[n], b = x1[n];
                        ss += (a[0] * a[0] + a[1] * a[1]) + (a[2] * a[2] + a[3] * a[3]) + (b[0] * b[0] + b[1] * b[1]) + (b[2] * b[2] + b[3] * b[3]); }
                    ss += __shfl_xor(ss, 16); ss += __shfl_xor(ss, 32);
                    const float rs = __builtin_amdgcn_rsqf(ss * (1.0f / 96.0f) + eps);
                    PG8_GAS bf16_t* rowp = (PG8_GAS bf16_t*)KA + (size_t)row * 768 + head * 96;
                    u32x4 w1, w2;
                    { const f32x4 a = x0[0] * rs * g0[0], b = x0[1] * rs * g0[1]; w1.x = cvt_pk_bf16(a[0], a[1]); w1.y = cvt_pk_bf16(a[2], a[3]); w1.z = cvt_pk_bf16(b[0], b[1]); w1.w = cvt_pk_bf16(b[2], b[3]); }
                    { const f32x4 a = x1[0] * rs * g1[0], b = x1[1] * rs * g1[1]; w2.x = cvt_pk_bf16(a[0], a[1]); w2.y = cvt_pk_bf16(a[2], a[3]); w2.z = cvt_pk_bf16(b[0], b[1]); w2.w = cvt_pk_bf16(b[2], b[3]); }
                    *(PG8_GAS u32x4*)(rowp + 8 * fq) = w1; *(PG8_GAS u32x4*)(rowp + 32 + 8 * fq) = w2;
                    const f32x4 c = *(const PG8_GAS f32x4*)(ropeR + (size_t)pos * 16 + 4 * fq), sn = *(const PG8_GAS f32x4*)(ropeR + (size_t)seq * 16 + (size_t)pos * 16 + 4 * fq);
                    const f32x4 y1 = e1 * rs * gr1, y2 = e2 * rs * gr2; const f32x4 o1 = y1 * c - y2 * sn, o2 = y2 * c + y1 * sn;
                    u32x2_ r1, r2; r1.x = cvt_pk_bf16(o1[0], o1[1]); r1.y = cvt_pk_bf16(o1[2], o1[3]); r2.x = cvt_pk_bf16(o2[0], o2[1]); r2.y = cvt_pk_bf16(o2[2], o2[3]);
                    *(PG8_GAS u32x2_*)(rowp + 64 + 4 * fq) = r1; *(PG8_GAS u32x2_*)(rowp + 80 + 4 * fq) = r2;
                    asm volatile("" ::: "memory"); }
        } else {
            const int col0 = (pn - 2) * BM + wc * 32 + 8 * fq;
#pragma unroll
            for (int ai = 0; ai < 2; ++ai)
#pragma unroll
                for (int m = 0; m < 4; ++m) { const int row = row0 + ai * HALF + m * 16; PG8_GAS bf16_t* rowp = (PG8_GAS bf16_t*)VA + (size_t)row * 512 + col0;
                    const f32x4 sq = *(const PG8_GAS f32x4*)(ssq + (size_t)row * 8 + 4); const float rl = __builtin_amdgcn_rsqf(((sq[0] + sq[1]) + (sq[2] + sq[3])) * (1.0f / 128.0f) + eps);
#pragma unroll
                    for (int bj = 0; bj < 2; ++bj) { const f32x4 v0 = acc[ai][bj][m][0] * rl, v1 = acc[ai][bj][m][1] * rl;
                        u32x4 w; w.x = cvt_pk_bf16(v0[0], v0[1]); w.y = cvt_pk_bf16(v0[2], v0[3]); w.z = cvt_pk_bf16(v1[0], v1[1]); w.w = cvt_pk_bf16(v1[2], v1[3]);
                        *(PG8_GAS u32x4*)(rowp + bj * HALF) = w; } }
        }
    }
};
struct EpiOut {
    static constexpr bool PERM = true, AFTER_DRAIN = false, MIDHOOK = true;
    const float* base; bf16_t* x1b; const PG8_LAS float* rsl;
    __device__ __forceinline__ void mid(f32x4 (&acc)[2][2][4][2], const Unit& u, int wr, int wc, int fr, int fq) const {
        const PG8_LAS float* rs = rsl + (u.g0 * 256 + wr * 64 + fr) * 2;
#pragma unroll
        for (int ai = 0; ai < 2; ++ai)
#pragma unroll
            for (int m = 0; m < 4; ++m) { const float ratio = rs[(ai * HALF + m * 16) * 2];
#pragma unroll
                for (int bj = 0; bj < 2; ++bj)
#pragma unroll
                    for (int n = 0; n < 2; ++n) acc[ai][bj][m][n] *= ratio; }
    }
    __device__ __forceinline__ void operator()(const f32x4 (&acc)[2][2][4][2], const Unit& u, int wr, int wc, int fr, int fq) const {
        const int row0 = u.pm * BM + wr * 64 + fr; const int col0 = u.pn * BM + wc * 32 + 8 * fq;
        const PG8_LAS float* rs = rsl + (u.g0 * 256 + wr * 64 + fr) * 2 + 1;
        f32x4 xr[2][8];
#pragma unroll
        for (int g = 0; g < 2; ++g) { const size_t off = (size_t)(row0 + g * 16) * 1024 + col0;
#pragma unroll
            for (int bj = 0; bj < 2; ++bj) { xr[0][g * 4 + bj * 2] = *(const PG8_GAS f32x4*)(base + off + bj * HALF); xr[0][g * 4 + bj * 2 + 1] = *(const PG8_GAS f32x4*)(base + off + bj * HALF + 4); } }
#pragma unroll
        for (int pr = 0; pr < 4; ++pr) {
            if (pr < 3) {
#pragma unroll
                for (int g = 0; g < 2; ++g) { const int gi = 2 * (pr + 1) + g; const size_t off = (size_t)(row0 + (gi >> 2) * HALF + (gi & 3) * 16) * 1024 + col0;
#pragma unroll
                    for (int bj = 0; bj < 2; ++bj) { xr[(pr + 1) & 1][g * 4 + bj * 2] = *(const PG8_GAS f32x4*)(base + off + bj * HALF); xr[(pr + 1) & 1][g * 4 + bj * 2 + 1] = *(const PG8_GAS f32x4*)(base + off + bj * HALF + 4); } } }
#pragma unroll
            for (int g = 0; g < 2; ++g) { const int gi = 2 * pr + g; const int ai = gi >> 2, m = gi & 3; const size_t off = (size_t)(row0 + ai * HALF + m * 16) * 1024 + col0; const float rb = rs[(ai * HALF + m * 16) * 2];
#pragma unroll
                for (int bj = 0; bj < 2; ++bj) { const size_t p = off + bj * HALF;
                    const f32x4 v0 = xr[pr & 1][g * 4 + bj * 2] + acc[ai][bj][m][0] * rb, v1 = xr[pr & 1][g * 4 + bj * 2 + 1] + acc[ai][bj][m][1] * rb;
                    u32x4 o; o.x = cvt_pk_bf16(v0[0], v0[1]); o.y = cvt_pk_bf16(v0[2], v0[3]); o.z = cvt_pk_bf16(v1[0], v1[1]); o.w = cvt_pk_bf16(v1[2], v1[3]);
                    *(PG8_GAS u32x4*)(x1b + p) = o; } }
            asm volatile("" ::: "memory"); }
    }
};
struct EpiGateUp2 {
    static constexpr bool PERM = true, AFTER_DRAIN = false, MIDHOOK = false;
    bf16_t* H; const ListEnt* lists; const PG8_LAS int* cnt;
    __device__ __forceinline__ void operator()(const f32x4 (&acc)[2][2][4][2], const Unit& u, int wr, int wc, int fr, int fq) const {
        const int rt0 = wr * 64 + fr; const int col0 = (u.q >> 1) * 256 + (u.q & 1) * 128 + wc * 32 + 8 * fq; const int g = u.g0; const int n_g = cnt[g]; const bool hiexp = (u.q >> 1) != 0;
        const ListEnt* lg = lists + (size_t)g * 65536 + u.g1 * 256;
        float wv[8], rv[8];
#pragma unroll
        for (int i = 0; i < 8; ++i) { const int rt = rt0 + (i >> 2) * HALF + (i & 3) * 16; f32x4 le = {0.f, 0.f, 0.f, 0.f}; if ((u.g1 * 256 + rt) < n_g) le = *(const PG8_GAS f32x4*)((const PG8_GAS ListEnt*)lg + rt); wv[i] = hiexp ? le[2] : le[1]; rv[i] = le[3]; }
#pragma unroll
        for (int ai = 0; ai < 2; ++ai)
#pragma unroll
            for (int m = 0; m < 4; ++m) { const int rt = rt0 + ai * HALF + m * 16; const bool valid = (u.g1 * 256 + rt) < n_g;
                const float w = wv[ai * 4 + m], rsd = rv[ai * 4 + m];
                unsigned pk[2];
#pragma unroll
                for (int n = 0; n < 2; ++n) { const f32x4 gv = acc[ai][0][m][n], uv = acc[ai][1][m][n]; float h[4];
#pragma unroll
                    for (int j = 0; j < 4; ++j) { const float a = gv[j] * rsd; const float s = a * __builtin_amdgcn_rcpf(1.0f + __builtin_amdgcn_exp2f(-1.4426950408889634f * a)); h[j] = valid ? s * (uv[j] * rsd) * w : 0.f; }
                    { int w_ = 0; w_ = __builtin_amdgcn_cvt_pk_fp8_f32(h[0] * 8.0f, h[1] * 8.0f, w_, false); w_ = __builtin_amdgcn_cvt_pk_fp8_f32(h[2] * 8.0f, h[3] * 8.0f, w_, true); pk[n] = (unsigned)w_; } }
                typedef unsigned u32x2h_ __attribute__((ext_vector_type(2))); u32x2h_ o; o.x = pk[0]; o.y = pk[1];
                *(PG8_GAS u32x2h_*)((PG8_GAS unsigned char*)H + (size_t)(u.pm * BM + rt) * 512 + col0) = o; }
    }
};
struct EpiDown2 {
    static constexpr bool PERM = true, AFTER_DRAIN = false, MIDHOOK = false;
    float* out; const bf16_t* x1b; const ListEnt* lists; const PG8_LAS int* cnt;
    __device__ __forceinline__ void operator()(const f32x4 (&acc)[2][2][4][2], const Unit& u, int wr, int wc, int fr, int fq) const {
        const int rt0 = wr * 64 + fr; const int col0 = u.q * 256 + wc * 32 + 8 * fq; const int g = u.g0; const int n_g = cnt[g];
        const ListEnt* lg = lists + (size_t)g * 65536 + u.g1 * 256;
        int tokv[8];
#pragma unroll
        for (int i = 0; i < 8; ++i) { const int rt = rt0 + (i >> 2) * HALF + (i & 3) * 16; tokv[i] = ((u.g1 * 256 + rt) < n_g) ? ((const PG8_GAS ListEnt*)lg)[rt].tok : -1; }
#pragma unroll
        for (int ai = 0; ai < 2; ++ai) {
            u32x4 xb[4][2];
#pragma unroll
            for (int m = 0; m < 4; ++m)
#pragma unroll
                for (int bj = 0; bj < 2; ++bj) { const int tok = tokv[ai * 4 + m]; xb[m][bj] = (u32x4){0u, 0u, 0u, 0u}; if (tok >= 0) xb[m][bj] = *(const PG8_GAS u32x4*)((const PG8_GAS bf16_t*)x1b + (size_t)tok * 1024 + col0 + bj * HALF); }
#pragma unroll
            for (int m = 0; m < 4; ++m) { const int tok = tokv[ai * 4 + m];
                if (tok >= 0) { PG8_GAS float* orow = (PG8_GAS float*)out + (size_t)tok * 1024 + col0;
#pragma unroll
                    for (int bj = 0; bj < 2; ++bj) { PG8_GAS float* p = orow + bj * HALF; const u32x4 x = xb[m][bj];
                        f32x4 a, b; a[0] = __builtin_bit_cast(float, x.x << 16); a[1] = __builtin_bit_cast(float, x.x & 0xffff0000u); a[2] = __builtin_bit_cast(float, x.y << 16); a[3] = __builtin_bit_cast(float, x.y & 0xffff0000u);
                        b[0] = __builtin_bit_cast(float, x.z << 16); b[1] = __builtin_bit_cast(float, x.z & 0xffff0000u); b[2] = __builtin_bit_cast(float, x.w << 16); b[3] = __builtin_bit_cast(float, x.w & 0xffff0000u);
                        *(PG8_GAS f32x4*)p = a + acc[ai][bj][m][0]; *(PG8_GAS f32x4*)(p + 4) = b + acc[ai][bj][m][1]; } } }
            asm volatile("" ::: "memory"); }
    }
};
struct ClsOrder {
    const PG8_LAS int* tp; const PG8_LAS int* ptab; int mode, G, c; const ListEnt* lists; const PG8_LAS int* cnt;
    __device__ __forceinline__ int arow(const Unit& u, int row) const { const unsigned pos = (unsigned)(u.g1 * 256 + row); const unsigned n = (unsigned)cnt[u.g0]; const PG8_GAS ListEnt* lg = (const PG8_GAS ListEnt*)lists + (size_t)u.g0 * 65536; return lg[pos < n ? pos : 0u].tok; }
    __device__ __forceinline__ bool next(int i, Unit& u) const {
        const int nrb = tp[112]; const long L = (long)i * G + c; if (L >= (long)nrb * 4) return false;
        const int rbt = (int)(L >> 2), q = (int)(L & 3);
        int g = 0;
#pragma unroll
        for (int s = 64; s >= 1; s >>= 1) { const int gg = g + s; if (gg < 112 && tp[gg] <= rbt) g = gg; }
        const int grp = g / 28, pr = ptab[g - grp * 28], lo = pr & 15, hi = pr >> 4;
        u.pm = rbt; u.g0 = g; u.g1 = rbt - tp[g]; u.q = q;
        if (mode == 0) { u.pn = (grp * 8 + ((q >> 1) ? hi : lo)) * 2 + (q & 1); u.pn2 = 0; } else { u.pn = (grp * 8 + lo) * 4 + q; u.pn2 = (grp * 8 + hi) * 4 + q; }
        return true;
    }
    __device__ __forceinline__ void a_ready(const Unit&) const {}
    __device__ __forceinline__ void done(const Unit&) const {}
};

template <class Epi, class Sched, bool ALIGN_EPI = false, bool SP2 = false, bool GATHER = false, bool KSPLIT = false, bool F8 = false, int SCW = 0x7a7a7a7a, int SCA = 0x7f7f7f7f, bool F8ASM = false>
__device__ __forceinline__ void gemm_phase(PG8_LAS unsigned char* lds, const Gemm g, const Sched& S, const Epi& E) {
    const int tid = threadIdx.x, wid = __builtin_amdgcn_readfirstlane(tid >> 6), lane = tid & 63, wr = wid >> 2, wc = wid & 3, fr = lane & 15, fq = lane >> 4;
    const int K = g.K, nt = K / BK;
    const int PB = KSPLIT ? (K >> 1) : K;
    static_assert(!GATHER || SP2, "gathered A rows: SP2 loop only");
    unsigned voffA[2], voffB[2];
#pragma unroll
    for (int i = 0; i < 2; ++i) { int R, C; stage_rc(tid * 16 + i * 8192, R, C); const int Rb = Epi::PERM ? ((R & ~31) + perm32(R & 31)) : R;
        voffA[i] = (unsigned)(R * K + C) * 2u; voffB[i] = (unsigned)(Rb * PB + C) * 2u; }
    const size_t kstep = (size_t)(BK * 2);
    const size_t hstep = (size_t)HALF * K * 2;
    const size_t tstep = 2 * hstep;
    const size_t hstepB = (size_t)HALF * PB * 2, tstepB = 2 * hstepB;
    const unsigned ldsw = (unsigned)wid * 1024u;
    const int aoff = lds_byte(wr * 64 + fr, fq * 8), boff = lds_byte(wc * 32 + fr, fq * 8);
#define PG8_SA(b, h) (((b) * 2 + (h)) * HTB)
#define PG8_SB(b, h) ((4 + (b) * 2 + (h)) * HTB)
#define PG8_STAGE(bufoff, gbase, voff) do { _Pragma("unroll") for (int _i = 0; _i < 2; ++_i) \
        __builtin_amdgcn_global_load_lds((const unsigned*)((const char*)(gbase) + (voff)[_i]), (PG8_LAS unsigned*)(lds + (bufoff) + ldsw + _i * 8192), 16, 0, 0); } while (0)
#define PG8_LDA(dst, b, h) do { _Pragma("unroll") for (int m = 0; m < 4; ++m) _Pragma("unroll") for (int k = 0; k < 2; ++k) dst[m][k] = *(const PG8_LAS bf16x8*)(lds + PG8_SA(b, h) + aoff + m * 2048 + k * 1024); } while (0)
#define PG8_LDB(dst, b, h) do { _Pragma("unroll") for (int n = 0; n < 2; ++n) _Pragma("unroll") for (int k = 0; k < 2; ++k) dst[n][k] = *(const PG8_LAS bf16x8*)(lds + PG8_SB(b, h) + boff + n * 2048 + k * 1024); } while (0)
#define PG8_MMA(ai, bj, At, Bt) do { __builtin_amdgcn_s_setprio(1); _Pragma("unroll") for (int m = 0; m < 4; ++m) _Pragma("unroll") for (int n = 0; n < 2; ++n) { \
        if constexpr (F8) { typedef int v4i_ __attribute__((ext_vector_type(4))); typedef int v8i_ __attribute__((ext_vector_type(8))); \
            const v8i_ w8_ = __builtin_shufflevector(__builtin_bit_cast(v4i_, Bt[n][0]), __builtin_bit_cast(v4i_, Bt[n][1]), 0, 1, 2, 3, 4, 5, 6, 7); \
            const v8i_ a8_ = __builtin_shufflevector(__builtin_bit_cast(v4i_, At[m][0]), __builtin_bit_cast(v4i_, At[m][1]), 0, 1, 2, 3, 4, 5, 6, 7); \
            if constexpr (F8ASM) { asm volatile("v_mfma_scale_f32_16x16x128_f8f6f4 %0, %1, %2, %0, %3, %4 op_sel_hi:[0,0,0]" : "+v"(acc[ai][bj][m][n]) : "v"(w8_), "v"(a8_), "v"(SCW), "v"(SCA)); }     \
            else acc[ai][bj][m][n] = __builtin_amdgcn_mfma_scale_f32_16x16x128_f8f6f4(w8_, a8_, acc[ai][bj][m][n], 0, 0, 0, SCW, 0, SCA); } \
        else { _Pragma("unroll") for (int k = 0; k < 2; ++k) acc[ai][bj][m][n] = __builtin_amdgcn_mfma_f32_16x16x32_bf16(Bt[n][k], At[m][k], acc[ai][bj][m][n], 0, 0, 0); } } \
        __builtin_amdgcn_s_setprio(0); } while (0)
#define PG8_WAIT_V(n) asm volatile("s_waitcnt vmcnt(" #n ")" ::: "memory")
#define PG8_WAIT_L(n) asm volatile("s_waitcnt lgkmcnt(" #n ")" ::: "memory")
#define PG8_BAR __builtin_amdgcn_s_barrier()
#define PG8_SCHED __builtin_amdgcn_sched_barrier(0)
#define PG8_STG_A(b, h, ptr, arr) do { if constexpr (GATHER) { PG8_STAGE(PG8_SA(b, h), (ptr), (arr)[h]); } else { PG8_STAGE(PG8_SA(b, h), (ptr) + ((h) ? hstep : 0), voffA); } } while (0)
    unsigned cv[2][2] = {{0u, 0u}, {0u, 0u}}, nvp[2] = {0u, 0u};
#define PG8_GROWS(dst, unit) do { if constexpr (GATHER) { _Pragma("unroll") for (int _h = 0; _h < 2; ++_h) _Pragma("unroll") for (int _i = 0; _i < 2; ++_i) { int R_, C_; stage_rc(tid * 16 + _i * 8192, R_, C_); \
        dst[_h][_i] = (unsigned)S.arow(unit, _h * HALF + R_) * (unsigned)(K * 2) + (unsigned)(C_ * 2); } } } while (0)
    Unit cur, nxt; int ui = 0;
    if (!S.next(0, cur)) return;
    PG8_GROWS(cv, cur);
#define PG8_GROWS_P(unit) do { _Pragma("unroll") for (int _i = 0; _i < 2; ++_i) { int R_, C_; stage_rc(tid * 16 + _i * 8192, R_, C_); nvp[_i] = (unsigned)S.arow(unit, R_) | ((unsigned)S.arow(unit, HALF + R_) << 16); } } while (0)
#define PG8_UNPACK_NV() do { _Pragma("unroll") for (int _i = 0; _i < 2; ++_i) { int R_, C_; stage_rc(tid * 16 + _i * 8192, R_, C_); cv[0][_i] = (nvp[_i] & 0xffffu) * (unsigned)(K * 2) + (unsigned)(C_ * 2); cv[1][_i] = (nvp[_i] >> 16) * (unsigned)(K * 2) + (unsigned)(C_ * 2); } } while (0)
    f32x4 acc[2][2][4][2];
#pragma unroll
    for (int a = 0; a < 2; ++a)
#pragma unroll
        for (int b = 0; b < 2; ++b)
#pragma unroll
            for (int m = 0; m < 4; ++m)
#pragma unroll
                for (int n = 0; n < 2; ++n) acc[a][b][m][n] = (f32x4){0.f, 0.f, 0.f, 0.f};
    bf16x8 At[4][2], B0[2][2], B1[2][2];
    const char* cA = (const char*)g.A + (GATHER ? (size_t)0 : (size_t)cur.pm * tstep); const char* cB = (const char*)g.Bt + (size_t)cur.pn * tstepB; const char* cB2 = KSPLIT ? (const char*)g.Bt + (size_t)cur.pn2 * tstepB : cB;
    S.a_ready(cur);
    if constexpr (SP2) {
        PG8_STAGE(PG8_SB(0, 0), cB, voffB); PG8_STAGE(PG8_SB(0, 1), cB + hstepB, voffB); PG8_STG_A(0, 0, cA, cv); PG8_STG_A(0, 1, cA, cv);
        if (wr == 1) PG8_BAR;
        PG8_WAIT_V(2); PG8_BAR;
        PG8_STAGE(PG8_SB(1, 0), cB + kstep, voffB); PG8_STG_A(1, 0, cA + kstep, cv); PG8_STAGE(PG8_SB(1, 1), cB + hstepB + kstep, voffB);
        PG8_WAIT_V(6); PG8_BAR;
    } else {
        PG8_STAGE(PG8_SB(0, 0), cB, voffB); PG8_STAGE(PG8_SA(0, 0), cA, voffA); PG8_STAGE(PG8_SB(0, 1), cB + hstepB, voffB); PG8_STAGE(PG8_SA(0, 1), cA + hstep, voffA);
        if (wr == 1) PG8_BAR;
        PG8_WAIT_V(4); PG8_BAR;
        PG8_STAGE(PG8_SB(1, 0), cB + kstep, voffB); PG8_STAGE(PG8_SA(1, 0), cA + kstep, voffA); PG8_STAGE(PG8_SB(1, 1), cB + hstepB + kstep, voffB);
        PG8_WAIT_V(6); PG8_BAR;
    }
    for (;;) {
        const bool has_next = S.next(ui + 1, nxt);
        const char* nA = (has_next && !GATHER) ? (const char*)g.A + (size_t)nxt.pm * tstep : cA; const char* nB = has_next ? (const char*)g.Bt + (size_t)nxt.pn * tstepB : cB; const char* nB2 = (KSPLIT && has_next) ? (const char*)g.Bt + (size_t)nxt.pn2 * tstepB : cB2;
        if constexpr (GATHER) { if (has_next) { PG8_GROWS_P(nxt); } else { PG8_GROWS_P(cur); } }
        const int tspan = Epi::MIDHOOK ? (nt >> 1) : nt;
        for (int t0 = 0; t0 < nt; t0 += tspan) {
        if constexpr (Epi::MIDHOOK) { if (t0 != 0) E.mid(acc, cur, wr, wc, fr, fq); }
        for (int t = t0; t < t0 + tspan; t += 2) {
            const bool last = (t == nt - 2);
            const char* a1 = cA + (size_t)(t + 1) * kstep;
            const char* a2 = last ? nA : cA + (size_t)(t + 2) * kstep; const char* b2 = last ? nB : ((KSPLIT && t + 2 >= (nt >> 1)) ? cB2 + (size_t)(t + 2 - (nt >> 1)) * kstep : cB + (size_t)(t + 2) * kstep);
            const char* a3 = a2 + kstep; const char* b3 = b2 + kstep;
            if (last && has_next) S.a_ready(nxt);
            if constexpr (SP2) {
            PG8_LDB(B0, 0, 0); PG8_LDB(B1, 0, 1); PG8_SCHED; PG8_LDA(At, 0, 0); PG8_STG_A(1, 1, a1, cv);
            if constexpr (GATHER) { if (last) { PG8_UNPACK_NV(); } }
            PG8_WAIT_V(8); PG8_WAIT_L(0); PG8_BAR; PG8_MMA(0, 0, At, B0); PG8_MMA(0, 1, At, B1); PG8_BAR; PG8_SCHED;
            PG8_LDA(At, 0, 1); PG8_STAGE(PG8_SB(0, 0), b2, voffB); PG8_STAGE(PG8_SB(0, 1), b2 + hstepB, voffB); PG8_STG_A(0, 0, a2, cv);
            PG8_WAIT_V(8); PG8_WAIT_L(0); PG8_BAR; PG8_MMA(1, 0, At, B0); PG8_MMA(1, 1, At, B1); PG8_BAR; PG8_SCHED;
            PG8_LDB(B0, 1, 0); PG8_LDB(B1, 1, 1); PG8_SCHED; PG8_LDA(At, 1, 0); PG8_STG_A(0, 1, a2, cv);
            PG8_WAIT_V(8); PG8_WAIT_L(0); PG8_BAR; PG8_MMA(0, 0, At, B0); PG8_MMA(0, 1, At, B1); PG8_BAR; PG8_SCHED;
            PG8_LDA(At, 1, 1); PG8_STAGE(PG8_SB(1, 0), b3, voffB); PG8_STAGE(PG8_SB(1, 1), b3 + hstepB, voffB); PG8_STG_A(1, 0, a3, cv);
            PG8_WAIT_V(8); PG8_WAIT_L(0); PG8_BAR; PG8_MMA(1, 0, At, B0); PG8_MMA(1, 1, At, B1); PG8_BAR; PG8_SCHED;
            } else {
            PG8_LDB(B0, 0, 0); PG8_SCHED; PG8_LDA(At, 0, 0); PG8_STAGE(PG8_SA(1, 1), a1 + hstep, voffA);
            PG8_WAIT_L(8); PG8_BAR; PG8_WAIT_L(0); PG8_MMA(0, 0, At, B0); PG8_BAR; PG8_SCHED;
            PG8_LDB(B1, 0, 1); PG8_STAGE(PG8_SB(0, 0), b2, voffB);
            PG8_BAR; PG8_WAIT_L(0); PG8_MMA(0, 1, At, B1); PG8_BAR;
            PG8_LDA(At, 0, 1); PG8_STAGE(PG8_SA(0, 0), a2, voffA);
            PG8_BAR; PG8_WAIT_L(0); PG8_MMA(1, 0, At, B0); PG8_BAR; PG8_SCHED;
            PG8_STAGE(PG8_SB(0, 1), b2 + hstepB, voffB);
            PG8_WAIT_V(6); PG8_BAR; PG8_MMA(1, 1, At, B1); PG8_BAR;
            PG8_LDB(B0, 1, 0); PG8_SCHED; PG8_LDA(At, 1, 0); PG8_STAGE(PG8_SA(0, 1), a2 + hstep, voffA);
            PG8_WAIT_L(8); PG8_BAR; PG8_WAIT_L(0); PG8_MMA(0, 0, At, B0); PG8_BAR; PG8_SCHED;
            PG8_LDB(B1, 1, 1); PG8_STAGE(PG8_SB(1, 0), b3, voffB);
            PG8_BAR; PG8_WAIT_L(0); PG8_MMA(0, 1, At, B1); PG8_BAR;
            PG8_LDA(At, 1, 1); PG8_STAGE(PG8_SA(1, 0), a3, voffA);
            PG8_BAR; PG8_WAIT_L(0); PG8_MMA(1, 0, At, B0); PG8_BAR; PG8_SCHED;
            PG8_STAGE(PG8_SB(1, 1), b3 + hstepB, voffB);
            PG8_WAIT_V(6); PG8_BAR; PG8_MMA(1, 1, At, B1); PG8_BAR;
            }
        }
        }
        if constexpr (ALIGN_EPI) { if (wr == 0) PG8_BAR; }
        if constexpr (!Epi::AFTER_DRAIN) { int t2 = threadIdx.x; asm volatile("" : "+v"(t2));
            const int wid2 = __builtin_amdgcn_readfirstlane(t2 >> 6), lane2 = t2 & 63; E(acc, cur, wid2 >> 2, wid2 & 3, lane2 & 15, lane2 >> 4); S.done(cur); }
        if (!has_next) break;
#pragma unroll
        for (int a = 0; a < 2; ++a)
#pragma unroll
            for (int b = 0; b < 2; ++b)
#pragma unroll
                for (int m = 0; m < 4; ++m)
#pragma unroll
                    for (int n = 0; n < 2; ++n) acc[a][b][m][n] = (f32x4){0.f, 0.f, 0.f, 0.f};
        cur = nxt; cA = nA; cB = nB; cB2 = nB2; ++ui;
        if constexpr (ALIGN_EPI) { if (wr == 1) PG8_BAR; }
    }
    PG8_WAIT_V(0);
    if constexpr (!ALIGN_EPI) { if (wr == 0) PG8_BAR; }
    PG8_BAR;
    if constexpr (Epi::AFTER_DRAIN) { E.fused(acc, cur, wr, wc, fr, fq, lds, wid, lane); S.done(cur); }
#undef PG8_SA
#undef PG8_SB
#undef PG8_STAGE
#undef PG8_LDA
#undef PG8_LDB
#undef PG8_MMA
#undef PG8_WAIT_V
#undef PG8_WAIT_L
#undef PG8_BAR
#undef PG8_SCHED
#undef PG8_STG_A
#undef PG8_GROWS
#undef PG8_GROWS_P
#undef PG8_UNPACK_NV
}
}
constexpr int BATCH = 32, SEQ = 2048, D = 1024, T = BATCH * SEQ;
constexpr int NPROJ = 2048;
constexpr int CQ = 0, CKV = 256, CPE = 384, CMQ = 416, CMK = 928, CMV = 1440, NPROJ_REAL = 1952;
constexpr int NH = 8;
constexpr float EPS = 1e-6f;
constexpr float LOG2E = 1.4426950408889634f;
constexpr float C2A = 0.10206207261596575f * LOG2E;
constexpr float C2B = 0.125f * LOG2E;
constexpr int NCLS = 112;
constexpr int LIST_CAP = 65536;

constexpr size_t MiB = 1u << 20;
constexpr size_t WS_CTL = 0, CTL_ZERO_BYTES = 2 * MiB;
constexpr size_t WS_KMEAN = 1 * MiB;
constexpr size_t WS_WIN = 2 * MiB;
constexpr size_t WS_WQ = 6 * MiB;
constexpr size_t WS_WKV = 7 * MiB;
constexpr size_t WS_WO = 8 * MiB;
constexpr size_t WS_WGU = 10 * MiB;
constexpr size_t WS_WD = 42 * MiB;
constexpr size_t WS_ROPE = 58 * MiB;
constexpr size_t WS_WRE = 59 * MiB;
constexpr size_t WS_SSQ = 60 * MiB;
constexpr size_t WS_XN = 64 * MiB;
constexpr size_t WS_VB = 192 * MiB;
constexpr size_t WS_Y0 = 64 * MiB;
constexpr size_t WS_X1B = 768 * MiB;
constexpr size_t WS_YH = 256 * MiB;
constexpr size_t WS_QB = 448 * MiB;
constexpr size_t WS_KB = 512 * MiB;
constexpr size_t WS_QA = 584 * MiB;
constexpr size_t WS_VA = 680 * MiB;
constexpr size_t WS_KA = 808 * MiB;
constexpr size_t WS_QLN = 904 * MiB;
constexpr size_t WS_KVLN = 936 * MiB;
constexpr size_t WS_LISTS = 648 * MiB;
constexpr size_t WS_OSSQ = 904 * MiB;
constexpr size_t WS_END = 1024 * MiB;
constexpr size_t WS_H = WS_KB;
constexpr int CW_TMO = 0, CW_CODE = 1;
constexpr int CW_BAR = 4096;
constexpr int CW_GCNT = 16384;

constexpr int RING_BYTES = 131072;
constexpr int P8_XT = 0, P8_XT_WAVE = 32 * 68 * 4, P8_WC = 69632, P8_WRG = 86016, P8_RT = 102400;
constexpr int LDSCTL_OFF = 155648, LDS_BYTES = 159744;
constexpr int TP_OFF = LDSCTL_OFF + 256, CNT_OFF = LDSCTL_OFF + 768, PT_OFF = LDSCTL_OFF + 1280;

#define GAS __attribute__((address_space(1)))
#define LAS __attribute__((address_space(3)))
typedef unsigned short bf16;
typedef unsigned v4u __attribute__((ext_vector_type(4)));
typedef unsigned v2u __attribute__((ext_vector_type(2)));
typedef float f32x4 __attribute__((ext_vector_type(4)));
typedef float f32x2 __attribute__((ext_vector_type(2)));
typedef float f32x16 __attribute__((ext_vector_type(16)));
typedef short bf16x8 __attribute__((ext_vector_type(8)));
typedef short s16x4 __attribute__((ext_vector_type(4)));
typedef GAS unsigned gu32;
#define RLX_AGENT __ATOMIC_RELAXED, __HIP_MEMORY_SCOPE_AGENT
__device__ __forceinline__ unsigned f2bf(float f) { unsigned u = __builtin_bit_cast(unsigned, f); return (u + 0x7fffu + ((u >> 16) & 1u)) >> 16; }
__device__ __forceinline__ unsigned pk2(float lo, float hi) { return f2bf(lo) | (f2bf(hi) << 16); }
__device__ __forceinline__ float bflo(unsigned w) { return __builtin_bit_cast(float, w << 16); }
__device__ __forceinline__ float bfhi(unsigned w) { return __builtin_bit_cast(float, w & 0xffff0000u); }
__device__ __forceinline__ float wave_sum(float v) {
#pragma unroll
    for (int o = 1; o < 64; o <<= 1) v += __shfl_xor(v, o);
    return v;
}
__device__ __forceinline__ float sum8(float v) { v += __shfl_xor(v, 1); v += __shfl_xor(v, 2); v += __shfl_xor(v, 4); return v; }

#define XB_TMO      128
#define XB_XCNT(j)  (256  + 64 * (j))
#define XB_XSUB(j)  (1280 + 64 * (j))
#define XB_XGEN(j)  (2304 + 64 * (j))
#define XB_TOP      3328
#define XB_TOPGEN   3392
#define XCD_BAR_WORDS 3456
#define XB_SPIN_CAP (1u << 18)

__device__ __forceinline__ unsigned xb_ld(unsigned* p)              { return __hip_atomic_load(p, __ATOMIC_RELAXED, __HIP_MEMORY_SCOPE_AGENT); }
__device__ __forceinline__ unsigned xb_add(unsigned* p, unsigned v) { return __hip_atomic_fetch_add(p, v, __ATOMIC_RELAXED, __HIP_MEMORY_SCOPE_AGENT); }
__device__ __forceinline__ unsigned xb_xcc_id() { return (unsigned)__builtin_amdgcn_s_getreg((3 << 11) | 20) & 0xFu; }
#define XB_SPIN(cond, bar) do { unsigned _sp = 0; while (cond) { __builtin_amdgcn_s_sleep(1); \
    if ((++_sp & 255u) == 0u) { if (xb_ld(&(bar)[XB_TMO])) break; if (_sp > XB_SPIN_CAP) { atomicAdd(&(bar)[XB_TMO], 1u); break; } } } } while (0)

struct XcdBarrier {
    unsigned* bar; unsigned x;
    volatile LAS unsigned* st;
};

__device__ __forceinline__ XcdBarrier xcd_barrier_post(unsigned* bar, volatile LAS unsigned* st) {
    XcdBarrier b; b.bar = bar; b.x = xb_xcc_id(); b.st = st;
    if (threadIdx.x == 0) (void)xb_add(&bar[XB_XCNT(b.x)], 1u);
    return b;
}
__device__ __forceinline__ void xcd_barrier_complete(unsigned* bar, unsigned x, unsigned& nloc, unsigned& nx) {
    const unsigned G = gridDim.x * gridDim.y * gridDim.z;
    unsigned sum, cnt, mine, sp = 0u;
    for (;;) {
        sum = 0u; cnt = 0u; mine = 0u;
#pragma unroll
        for (unsigned j = 0; j < 16; ++j) { const unsigned c = xb_ld(&bar[XB_XCNT(j)]); sum += c; cnt += (c > 0u) ? 1u : 0u; mine = (j == x) ? c : mine; }
        if (sum == G) break;
        __builtin_amdgcn_s_sleep(1);
        if ((++sp & 255u) == 0u) { if (xb_ld(&bar[XB_TMO])) break; if (sp > XB_SPIN_CAP) { atomicAdd(&bar[XB_TMO], 1u); break; } }
    }
    nloc = mine > 0u ? mine : 1u; nx = cnt > 0u ? cnt : 1u;
}

__device__ __forceinline__ void xcd_barrier(const XcdBarrier& b) {
    asm volatile("s_waitcnt vmcnt(0)" ::: "memory");
    __syncthreads();
    if (threadIdx.x == 0) {
        unsigned* bar = b.bar;
        __builtin_amdgcn_s_waitcnt(0);
        unsigned nloc = b.st[0], nx = b.st[1];
        if (nloc == 0u) { xcd_barrier_complete(bar, b.x, nloc, nx); b.st[0] = nloc; b.st[1] = nx; }
        const unsigned old = xb_add(&bar[XB_XSUB(b.x)], 1u);
        const unsigned gen = old / nloc;
        if (old + 1u == (gen + 1u) * nloc) {
            __builtin_amdgcn_fence(__ATOMIC_RELEASE, "agent");
            asm volatile("s_waitcnt vmcnt(0)" ::: "memory");
            const unsigned og = xb_add(&bar[XB_TOP], 1u);
            const unsigned tg = og / nx;
            if (og + 1u == (tg + 1u) * nx) xb_add(&bar[XB_TOPGEN], 1u);
            else XB_SPIN(xb_ld(&bar[XB_TOPGEN]) == tg, bar);
            __builtin_amdgcn_fence(__ATOMIC_ACQUIRE, "agent");
            xb_add(&bar[XB_XGEN(b.x)], 1u);
            asm volatile("s_waitcnt vmcnt(0)" ::: "memory");
        } else {
            XB_SPIN(xb_ld(&bar[XB_XGEN(b.x)]) == gen, bar);
            __builtin_amdgcn_fence(__ATOMIC_ACQUIRE, "agent");
            asm volatile("s_waitcnt vmcnt(0)" ::: "memory");
        }
    }
    __syncthreads();
}


__device__ __forceinline__ float att_max3(float a, float b, float c) { float r; asm("v_max3_f32 %0, %1, %2, %3" : "=v"(r) : "v"(a), "v"(b), "v"(c)); return r; }
__device__ __forceinline__ unsigned pk4_fp8(float a, float b, float c, float d) { int w = 0; w = __builtin_amdgcn_cvt_pk_fp8_f32(a, b, w, false); w = __builtin_amdgcn_cvt_pk_fp8_f32(c, d, w, true); return (unsigned)w; }
struct AttOwn { static constexpr bool v = true; }; struct AttPast { static constexpr bool v = false; };
template <int DQK, bool MOBA, bool QFIN>
__device__ __forceinline__ void attn_unit(LAS unsigned char* lds, const float* qgain_, const float* ropeR_, const bf16* Qg_, int qpitch, const bf16* Kg_, int kpitch, const bf16* Vg_, int vpitch, bf16* Og_, int opitch, float* ossq_, int qb, const float* kmp_, int kmstride) {
    const GAS bf16* Qg = (const GAS bf16*)Qg_; const GAS bf16* Kg = (const GAS bf16*)Kg_; const GAS bf16* Vg = (const GAS bf16*)Vg_; GAS bf16* Og = (GAS bf16*)Og_; const GAS float* kmp = (const GAS float*)kmp_;
    constexpr int ND = DQK / 16, KSTR = DQK * 2 + 16, KBUF = 64 * KSTR, NCH = DQK / 8, VBUF = 8192;
    int tid = threadIdx.x; asm volatile("" : "+v"(tid));
    const int lane = tid & 63, r32 = lane & 31, hi = lane >> 5; const int wid = __builtin_amdgcn_readfirstlane(tid >> 6);
    LAS unsigned char* Kl = lds; LAS unsigned char* Vl = lds + 2 * KBUF;
    const GAS bf16* qrow = Qg + (size_t)(qb * 256 + wid * 32 + r32) * qpitch;
    bf16x8 qf[ND];
#pragma unroll
    for (int d0 = 0; d0 < ND; ++d0) qf[d0] = *(const GAS bf16x8*)(qrow + 16 * d0 + 8 * hi);
    if (QFIN) {
        const GAS float* qg = (const GAS float*)qgain_; const GAS float* rr = (const GAS float*)ropeR_; const int pos = qb * 256 + wid * 32 + r32;
        float x[ND][8]; float ss = 0.f;
#pragma unroll
        for (int d0 = 0; d0 < ND; ++d0) { const v4u w = __builtin_bit_cast(v4u, qf[d0]);
            x[d0][0] = bflo(w.x); x[d0][1] = bfhi(w.x); x[d0][2] = bflo(w.y); x[d0][3] = bfhi(w.y); x[d0][4] = bflo(w.z); x[d0][5] = bfhi(w.z); x[d0][6] = bflo(w.w); x[d0][7] = bfhi(w.w);
#pragma unroll
            for (int j = 0; j < 8; ++j) ss += x[d0][j] * x[d0][j]; }
        ss += __shfl_xor(ss, 32);
        const float rs = __builtin_amdgcn_rsqf(ss * (1.0f / (float)DQK) + EPS) * C2A;
#pragma unroll
        for (int d0 = 0; d0 < ND; ++d0) { const f32x4 ga = *(const GAS f32x4*)(qg + 16 * d0 + 8 * hi), gb = *(const GAS f32x4*)(qg + 16 * d0 + 8 * hi + 4);
#pragma unroll
            for (int j = 0; j < 4; ++j) { x[d0][j] *= rs * ga[j]; x[d0][4 + j] *= rs * gb[j]; } }
        if (ND == 6) { const f32x4 ca = *(const GAS f32x4*)(rr + pos * 16 + 8 * hi), cb = *(const GAS f32x4*)(rr + pos * 16 + 8 * hi + 4), sa = *(const GAS f32x4*)(rr + SEQ * 16 + pos * 16 + 8 * hi), sb = *(const GAS f32x4*)(rr + SEQ * 16 + pos * 16 + 8 * hi + 4);
#pragma unroll
            for (int j = 0; j < 8; ++j) { const float c = j < 4 ? ca[j & 3] : cb[j & 3], s = j < 4 ? sa[j & 3] : sb[j & 3]; const float y1 = x[ND - 2][j], y2 = x[ND - 1][j]; x[ND - 2][j] = y1 * c - y2 * s; x[ND - 1][j] = y2 * c + y1 * s; } }
#pragma unroll
        for (int d0 = 0; d0 < ND; ++d0) { v4u w; w.x = pg8::cvt_pk_bf16(x[d0][0], x[d0][1]); w.y = pg8::cvt_pk_bf16(x[d0][2], x[d0][3]); w.z = pg8::cvt_pk_bf16(x[d0][4], x[d0][5]); w.w = pg8::cvt_pk_bf16(x[d0][6], x[d0][7]); qf[d0] = __builtin_bit_cast(bf16x8, w); }
    }
    unsigned sel = 0xffu;
    if (MOBA && qb > 3) {
        float gate[8];
#pragma unroll
        for (int n = 0; n < 8; ++n) { float a = 0.f;
            if (n < qb) {
#pragma unroll
                for (int d0 = 0; d0 < ND; ++d0) { const GAS float* km = kmp + (size_t)n * kmstride + 16 * d0 + 8 * hi; const f32x4 k0 = *(const GAS f32x4*)km, k1 = *(const GAS f32x4*)(km + 4);
                    const v4u qq = __builtin_bit_cast(v4u, qf[d0]);
                    a += bflo(qq.x) * k0[0] + bfhi(qq.x) * k0[1] + bflo(qq.y) * k0[2] + bfhi(qq.y) * k0[3] + bflo(qq.z) * k1[0] + bfhi(qq.z) * k1[1] + bflo(qq.w) * k1[2] + bfhi(qq.w) * k1[3]; }
                a += __shfl_xor(a, 32); }
            gate[n] = a; asm volatile("" : "+v"(a) :: "memory"); }
        sel = 0u;
#pragma unroll
        for (int n = 0; n < 8; ++n) { int rank = 0;
#pragma unroll
            for (int mm = 0; mm < 8; ++mm) { if (mm != n) { const bool before = (gate[mm] > gate[n]) || (gate[mm] == gate[n] && mm < n); rank += (mm < qb && before) ? 1 : 0; } }
            if (n < qb && rank < 3) sel |= (1u << n); }
    }
    const int krow = (DQK == 64) ? (tid >> 3) : (tid / 12), kch = (DQK == 64) ? (tid & 7) : (tid % 12);
    const int krow2 = (tid + 512) / 12, kch2 = (tid + 512) % 12; const bool k2 = (DQK == 96) && (tid < 256);
    const int vrow = tid >> 3, vch = tid & 7;
    const unsigned kst = (unsigned)(krow * KSTR + kch * 16), kst2 = (unsigned)(krow2 * KSTR + kch2 * 16);
    const unsigned vst = (unsigned)((vch >> 2) * 4096 + (vrow >> 4) * 1024 + ((vrow >> 3) & 1) * 512 + (vrow & 7) * 64 + (vch & 3) * 16);
    const int NT = 4 * (qb + 1);
    auto tile_row0 = [&](int p) -> int { return (p < 4) ? (qb * 256 + p * 64) : ((p - 4) * 64); };
    v4u kreg, kreg2 = {0u, 0u, 0u, 0u}, vreg;
    { const int r0 = tile_row0(0);
      kreg = *(const GAS v4u*)(Kg + (size_t)(r0 + krow) * kpitch + kch * 8); if (k2) kreg2 = *(const GAS v4u*)(Kg + (size_t)(r0 + krow2) * kpitch + kch2 * 8);
      vreg = *(const GAS v4u*)(Vg + (size_t)(r0 + vrow) * vpitch + vch * 8);
      *(LAS v4u*)(Kl + kst) = kreg; if (k2) *(LAS v4u*)(Kl + kst2) = kreg2; *(LAS v4u*)(Vl + vst) = vreg; }
    __syncthreads();
    float m_run = 0.f, l_run = 0.f; f32x16 o0 = {}, o1 = {};
    f32x16 cuse = {}; bool cdirty = true;
    f32x16 negm = {};
    constexpr float THR = 8.0f;
    const int qrel = wid * 32 + r32;
    const unsigned kfo = (unsigned)(r32 * KSTR + hi * 16);
    const unsigned vfo = (unsigned)(((lane >> 4) & 1) * 32 + (lane & 3) * 8 + (4 * hi + ((lane & 15) >> 2)) * 64);
    auto slot = [&](const int p, auto own_) { constexpr bool OWN = decltype(own_)::v;
        const int cb = p & 1;
        if (p + 1 < NT) { const int r0 = tile_row0(p + 1);
            kreg = *(const GAS v4u*)(Kg + (size_t)(r0 + krow) * kpitch + kch * 8); if (k2) kreg2 = *(const GAS v4u*)(Kg + (size_t)(r0 + krow2) * kpitch + kch2 * 8);
            vreg = *(const GAS v4u*)(Vg + (size_t)(r0 + vrow) * vpitch + vch * 8); }
        const bool need = OWN ? !(p > (wid >> 1)) : true;
        if (need) {
            const LAS unsigned char* Kb = Kl + cb * KBUF + kfo; const LAS unsigned char* Vb = Vl + cb * VBUF + vfo;
            f32x16 s0 = negm, s1 = negm;
            if constexpr (!OWN && MOBA) {
                if (cdirty || (p & 3) == 0) { const bool on = ((sel >> ((p - 4) >> 2)) & 1u) != 0u;
#pragma unroll
                    for (int r = 0; r < 16; ++r) cuse[r] = on ? negm[r] : -1.0e30f;
                    cdirty = false; }
                s0 = cuse; s1 = cuse; }
            bf16x8 kf[2 * ND];
#pragma unroll
            for (int d0 = 0; d0 < ND; ++d0) { kf[2 * d0] = *(const LAS bf16x8*)(Kb + d0 * 32); kf[2 * d0 + 1] = *(const LAS bf16x8*)(Kb + 32 * KSTR + d0 * 32); }
            __builtin_amdgcn_sched_barrier(0);
#pragma unroll
            for (int d0 = 0; d0 < ND; ++d0) { s0 = __builtin_amdgcn_mfma_f32_32x32x16_bf16(kf[2 * d0], qf[d0], s0, 0, 0, 0); s1 = __builtin_amdgcn_mfma_f32_32x32x16_bf16(kf[2 * d0 + 1], qf[d0], s1, 0, 0, 0); }
            s16x4 vt[16];
#pragma unroll
            for (int v = 0; v < 16; ++v) vt[v] = __builtin_bit_cast(s16x4, __builtin_amdgcn_ds_read_tr16_b64_v4i16((LAS s16x4*)(Vb + (v >> 2) * 1024 + ((v >> 1) & 1) * 4096 + (v & 1) * 512)));
            __builtin_amdgcn_sched_barrier(0);
            if constexpr (OWN) { const int kb = 64 * p + 4 * hi;
#pragma unroll
                for (int r = 0; r < 16; ++r) { const int kv = kb + (r & 3) + 8 * (r >> 2); if (kv > qrel) s0[r] = -INFINITY; if (kv + 32 > qrel) s1[r] = -INFINITY; } }
            float ra = att_max3(s0[0], s0[1], s1[0]), rb = att_max3(s0[2], s0[3], s1[1]); ra = att_max3(ra, s1[2], s1[3]);
#pragma unroll
            for (int r = 4; r < 16; r += 4) { ra = att_max3(ra, s0[r], s0[r + 1]); rb = att_max3(rb, s0[r + 2], s0[r + 3]); ra = att_max3(ra, s1[r], s1[r + 1]); rb = att_max3(rb, s1[r + 2], s1[r + 3]); }
            float rm = fmaxf(ra, rb); rm = fmaxf(rm, __shfl_xor(rm, 32));
            if ((OWN && p == 0) || __any(rm > THR)) {
                const float dl = (OWN && p == 0) ? rm : fmaxf(rm, 0.f); m_run += dl;
                const float fsc = __builtin_amdgcn_exp2f(-dl); l_run *= fsc;
#pragma unroll
                for (int r = 0; r < 16; ++r) { s0[r] -= dl; s1[r] -= dl; o0[r] *= fsc; o1[r] *= fsc; negm[r] = -m_run; }
                cdirty = true;
            }
            float rs0 = 0.f, rs1 = 0.f;
#pragma unroll
            for (int r = 0; r < 16; ++r) { s0[r] = __builtin_amdgcn_exp2f(s0[r]); s1[r] = __builtin_amdgcn_exp2f(s1[r]); rs0 += s0[r]; rs1 += s1[r]; }
            l_run += rs0 + rs1;
            bf16x8 pf[4];
#pragma unroll
            for (int s = 0; s < 2; ++s) { v4u a, b;
                a.x = pg8::cvt_pk_bf16(s0[8 * s + 0], s0[8 * s + 1]); a.y = pg8::cvt_pk_bf16(s0[8 * s + 2], s0[8 * s + 3]); a.z = pg8::cvt_pk_bf16(s0[8 * s + 4], s0[8 * s + 5]); a.w = pg8::cvt_pk_bf16(s0[8 * s + 6], s0[8 * s + 7]);
                b.x = pg8::cvt_pk_bf16(s1[8 * s + 0], s1[8 * s + 1]); b.y = pg8::cvt_pk_bf16(s1[8 * s + 2], s1[8 * s + 3]); b.z = pg8::cvt_pk_bf16(s1[8 * s + 4], s1[8 * s + 5]); b.w = pg8::cvt_pk_bf16(s1[8 * s + 6], s1[8 * s + 7]);
                pf[s] = __builtin_bit_cast(bf16x8, a); pf[2 + s] = __builtin_bit_cast(bf16x8, b); }
#pragma unroll
            for (int s = 0; s < 4; ++s) {
                const bf16x8 va = (bf16x8){vt[4 * s][0], vt[4 * s][1], vt[4 * s][2], vt[4 * s][3], vt[4 * s + 1][0], vt[4 * s + 1][1], vt[4 * s + 1][2], vt[4 * s + 1][3]};
                const bf16x8 vb = (bf16x8){vt[4 * s + 2][0], vt[4 * s + 2][1], vt[4 * s + 2][2], vt[4 * s + 2][3], vt[4 * s + 3][0], vt[4 * s + 3][1], vt[4 * s + 3][2], vt[4 * s + 3][3]};
                o0 = __builtin_amdgcn_mfma_f32_32x32x16_bf16(va, pf[s], o0, 0, 0, 0);
                o1 = __builtin_amdgcn_mfma_f32_32x32x16_bf16(vb, pf[s], o1, 0, 0, 0); }
        }
        if (p + 1 < NT) { const int nb = cb ^ 1;
            *(LAS v4u*)(Kl + nb * KBUF + kst) = kreg; if (k2) *(LAS v4u*)(Kl + nb * KBUF + kst2) = kreg2; *(LAS v4u*)(Vl + nb * VBUF + vst) = vreg; }
        __syncthreads();
        __syncthreads();
    };
    for (int p = 0; p < 4; ++p) slot(p, AttOwn{});
    for (int p = 4; p < NT; ++p) slot(p, AttPast{});
    l_run += __shfl_xor(l_run, 32);
    const float rl = 1.0f / l_run;
    { float ss = 0.f;
#pragma unroll
      for (int r = 0; r < 16; ++r) { const float a = o0[r] * rl, b = o1[r] * rl; ss += a * a + b * b; }
      ss += __shfl_xor(ss, 32);
      if (hi == 0) ((GAS float*)ossq_)[(size_t)(qb * 256 + wid * 32 + r32) * 16] = ss; }
    LAS unsigned char* stg = lds + 65536 + wid * 4608; const float rl16 = rl * 16.0f;
#pragma unroll
    for (int g = 0; g < 4; ++g) {
        *(LAS unsigned*)(stg + r32 * 80 + (8 * g + 4 * hi)) = pk4_fp8(o0[4 * g] * rl16, o0[4 * g + 1] * rl16, o0[4 * g + 2] * rl16, o0[4 * g + 3] * rl16);
        *(LAS unsigned*)(stg + r32 * 80 + (32 + 8 * g + 4 * hi)) = pk4_fp8(o1[4 * g] * rl16, o1[4 * g + 1] * rl16, o1[4 * g + 2] * rl16, o1[4 * g + 3] * rl16); }
    asm volatile("s_waitcnt lgkmcnt(0)" ::: "memory");
    GAS unsigned char* obase = (GAS unsigned char*)Og + (size_t)(qb * 256 + wid * 32) * opitch;
#pragma unroll
    for (int i = 0; i < 2; ++i) { const int row = i * 16 + (lane >> 2), ch = lane & 3; const v4u v = *(const LAS v4u*)(stg + row * 80 + ch * 16); *(GAS v4u*)(obase + (size_t)row * opitch + ch * 16) = v; }
    asm volatile("s_waitcnt lgkmcnt(0)" ::: "memory");
}

__device__ __forceinline__ void transpose_item(const float* W_, int ldw, bf16* WT, int ldt, int k0, int n0, int dr0, int dr1, LAS float* scr, int lane, const float* kgain = nullptr) {
    const GAS float* W = (const GAS float*)W_; const int q = lane & 15, kr = lane >> 4; const bool ld_ok = (q < 8) ? (dr0 >= 0) : (dr1 >= 0);
#pragma unroll 4
    for (int i = 0; i < 16; ++i) { const int kk = 4 * i + kr; f32x4 v = {0.f, 0.f, 0.f, 0.f}; if (ld_ok) v = *(const GAS f32x4*)(W + (size_t)(k0 + kk) * ldw + n0 + 4 * q);
        if (kgain) v = v * ((const GAS float*)kgain)[k0 + kk];
        LAS float* s = scr + kk * 65 + 4 * q; s[0] = v[0]; s[1] = v[1]; s[2] = v[2]; s[3] = v[3]; }
    asm volatile("s_waitcnt lgkmcnt(0)" ::: "memory");
    const int c = lane & 7;
#pragma unroll
    for (int j = 0; j < 8; ++j) { const int n = 8 * j + (lane >> 3); const LAS float* s = scr + (8 * c) * 65 + n; const int dr = (n < 32) ? dr0 : dr1;
        v4u o; o.x = pk2(s[0 * 65], s[1 * 65]); o.y = pk2(s[2 * 65], s[3 * 65]); o.z = pk2(s[4 * 65], s[5 * 65]); o.w = pk2(s[6 * 65], s[7 * 65]);
        if (dr >= 0) *(GAS v4u*)(WT + (size_t)(dr + (n & 31)) * ldt + k0 + 8 * c) = o; }
    asm volatile("s_waitcnt lgkmcnt(0)" ::: "memory");
}

__device__ __forceinline__ void transpose_item8(const float* W_, int ldw, unsigned char* WT8, int ldt, int k0, int n0, int dr0, int dr1, LAS float* scr, int lane, float scale, const float* kgain = nullptr) {
    const GAS float* W = (const GAS float*)W_; const int q = lane & 15, kr = lane >> 4; const bool ld_ok = (q < 8) ? (dr0 >= 0) : (dr1 >= 0);
#pragma unroll 4
    for (int i = 0; i < 16; ++i) { const int kk = 4 * i + kr; f32x4 v = {0.f, 0.f, 0.f, 0.f}; if (ld_ok) v = *(const GAS f32x4*)(W + (size_t)(k0 + kk) * ldw + n0 + 4 * q);
        if (kgain) v = v * ((const GAS float*)kgain)[k0 + kk];
        v = v * scale;
        LAS float* s = scr + kk * 65 + 4 * q; s[0] = v[0]; s[1] = v[1]; s[2] = v[2]; s[3] = v[3]; }
    asm volatile("s_waitcnt lgkmcnt(0)" ::: "memory");
    const int c = lane & 7;
#pragma unroll
    for (int j = 0; j < 8; ++j) { const int n = 8 * j + (lane >> 3); const LAS float* s = scr + (8 * c) * 65 + n; const int dr = (n < 32) ? dr0 : dr1;
        v2u o; o.x = pk4_fp8(s[0 * 65], s[1 * 65], s[2 * 65], s[3 * 65]); o.y = pk4_fp8(s[4 * 65], s[5 * 65], s[6 * 65], s[7 * 65]);
        if (dr >= 0) *(GAS v2u*)((GAS unsigned char*)WT8 + (size_t)(dr + (n & 31)) * ldt + k0 + 8 * c) = o; }
    asm volatile("s_waitcnt lgkmcnt(0)" ::: "memory");
}

struct Args {
    const float* x; const float* attn_g; const float* w_in; const float* qlat_g; const float* w_qup; const float* kvlat_g; const float* w_kvup;
    const float* qhead_g; const float* khead_g; const float* mqhead_g; const float* mkhead_g; const float* onorm_a_g; const float* onorm_b_g; const float* w_out;
    const float* ffn_g; const float* w_rg; const float* b_rg; const float* w_re; const float* b_re; const float* w_gate; const float* w_up; const float* w_down;
    float* out; unsigned char* ws; int ph_lo, ph_hi;
};
enum { PH_PRO = 0, PH_PROJ, PH_UP, PH_ATTN, PH_OUT, PH_ROUTE, PH_GU, PH_D0, NPHASE };

__global__ void __launch_bounds__(512, 2) mk_fwd(Args A) {
    extern __shared__ __attribute__((aligned(16))) unsigned char lds_raw[];
    LAS unsigned char* lds = (LAS unsigned char*)lds_raw;
    const int tid0 = threadIdx.x;
    const int G = gridDim.x, bx = blockIdx.x;
#define NGW (G * 8)
#define PH_BEGIN int tid = threadIdx.x; asm volatile("" : "+v"(tid)); const int lane = tid & 63; const int wave = __builtin_amdgcn_readfirstlane(tid >> 6); const int gw = bx * 8 + wave; \
    const __attribute__((address_space(4))) Args* AP = (const __attribute__((address_space(4))) Args*)__builtin_amdgcn_kernarg_segment_ptr(); asm volatile("" : "+s"(AP)); \
    unsigned char* ws = AP->ws; (void)lane; (void)gw; (void)ws;
#define Win_t ((bf16*)(ws + WS_WIN))
#define Wq_t ((bf16*)(ws + WS_WQ))
#define Wkv_t ((bf16*)(ws + WS_WKV))
#define Wo_t ((bf16*)(ws + WS_WO))
#define Wgu_t ((bf16*)(ws + WS_WGU))
#define Wd_t ((bf16*)(ws + WS_WD))
#define ropeF ((float*)(ws + WS_ROPE))
#define ropeR (((float*)(ws + WS_ROPE)) + 2 * SEQ * 32)
#define kmean ((float*)(ws + WS_KMEAN))
#define XN ((bf16*)(ws + WS_XN))
#define X1B ((bf16*)(ws + WS_X1B))
#define VB ((bf16*)(ws + WS_VB))
#define YH ((bf16*)(ws + WS_YH))
#define Y0B ((bf16*)(ws + WS_Y0))
#define SSQ ((float*)(ws + WS_SSQ))
#define WREF ((float*)(ws + WS_WRE))
#define WRGF ((float*)(ws + WS_WRE + 131072))
#define OSSQ ((float*)(ws + WS_OSSQ))
#define QB ((bf16*)(ws + WS_QB))
#define KB ((bf16*)(ws + WS_KB))
#define QA ((bf16*)(ws + WS_QA))
#define VA ((bf16*)(ws + WS_VA))
#define KA ((bf16*)(ws + WS_KA))
#define QLN ((bf16*)(ws + WS_QLN))
#define KVLN ((bf16*)(ws + WS_KVLN))
#define HB ((bf16*)(ws + WS_H))
#define lists ((pg8::ListEnt*)(ws + WS_LISTS))
    volatile LAS unsigned* MISC = (volatile LAS unsigned*)(lds + LDSCTL_OFF);
    for (int u = tid0; u < (LDS_BYTES - LDSCTL_OFF) / 4; u += 512) ((LAS unsigned*)(lds + LDSCTL_OFF))[u] = 0u;
    __syncthreads();
    XcdBarrier bar = xcd_barrier_post((unsigned*)((gu32*)(A.ws + WS_CTL) + CW_BAR), MISC + 8);
    const int lo = A.ph_lo, hi = A.ph_hi;
#define IN(k) (lo <= (k) && (k) < hi)
#define MOE_SLOT(npn) ((G == 256) ? ((((bx >> 3) / (npn)) * 8 + (bx & 7)) * (npn) + ((bx >> 3) % (npn))) : bx)
#define SEAM(k) do { if (IN(k) && IN((k) + 1)) xcd_barrier(bar); } while (0)

    if (IN(PH_PRO)) { PH_BEGIN
        LAS float* scr = (LAS float*)(lds + wave * 16640);
        constexpr int I_IN = 16 * 31, I_QU = 4 * 12, I_KV = 2 * 16, I_WO = 16 * 16, I_G = 32 * 64, I_U = 32 * 64, I_D = 32 * 64;
        constexpr int NITEMS = I_IN + I_QU + I_KV + I_WO + I_G + I_U + I_D;
        for (int it = gw; it < NITEMS; it += NGW) {
            int r = it;
            if (r < I_IN) { const int kb = r / 31, nb = r % 31; int dr[2];
#pragma unroll
                for (int h2 = 0; h2 < 2; ++h2) { const int gi = 2 * nb + h2;
                    if (gi < 13) dr[h2] = 32 * gi; else if (gi < 45) { const int q = (gi - 13) & 15, hh = q >> 1, bj = q & 1; dr[h2] = (gi < 29 ? 512 : 1024) + (hh >> 2) * 256 + bj * 128 + (hh & 3) * 32; } else if (gi < 61) dr[h2] = 1536 + (gi - 45) * 32; else dr[h2] = -1; }
                transpose_item(AP->w_in, NPROJ_REAL, Win_t, 1024, 64 * kb, 64 * nb, dr[0], dr[1], scr, lane); continue; } r -= I_IN;
            if (r < I_QU) { const int kb = r / 12, nb = r % 12; transpose_item(AP->w_qup, 768, Wq_t, 256, 64 * kb, 64 * nb, 64 * nb, 64 * nb + 32, scr, lane, AP->qlat_g); continue; } r -= I_QU;
            if (r < I_KV) { const int kb = r / 16, nb = r % 16; const int n0 = 64 * nb, hh = n0 >> 7, j0 = n0 & 127;
                const int d0 = (j0 < 64) ? ((hh >> 2) * 256 + (hh & 3) * 32) : (512 + hh * 64), d1 = (j0 < 64) ? (d0 + 128) : (d0 + 32);
                transpose_item(AP->w_kvup, 1024, Wkv_t, 256, 64 * kb, n0, d0, d1, scr, lane, AP->kvlat_g); continue; } r -= I_KV;
            if (r < I_WO) { const int kb = r / 16, nb = r % 16; transpose_item8(AP->w_out, 1024, (unsigned char*)Wo_t, 1024, 64 * kb, 64 * nb, 64 * nb, 64 * nb + 32, scr, lane, 32.0f, kb < 8 ? AP->onorm_a_g : AP->onorm_b_g - 512); continue; } r -= I_WO;
            if (r < I_G) { const int e = r >> 6, r2 = r & 63, kb = r2 >> 2, nb = r2 & 3; const int n0 = 64 * nb; const int d0 = (n0 >> 7) * 256 + (n0 & 127);
                transpose_item8(AP->w_gate + (size_t)e * 1024 * 256, 256, (unsigned char*)Wgu_t + (size_t)e * 512 * 1024, 1024, 64 * kb, n0, d0, d0 + 32, scr, lane, 32.0f); continue; } r -= I_G;
            if (r < I_U) { const int e = r >> 6, r2 = r & 63, kb = r2 >> 2, nb = r2 & 3; const int n0 = 64 * nb; const int d0 = (n0 >> 7) * 256 + 128 + (n0 & 127);
                transpose_item8(AP->w_up + (size_t)e * 1024 * 256, 256, (unsigned char*)Wgu_t + (size_t)e * 512 * 1024, 1024, 64 * kb, n0, d0, d0 + 32, scr, lane, 32.0f); continue; } r -= I_U;
            { const int e = r >> 6, r2 = r & 63, kb = r2 >> 4, nb = r2 & 15;
                transpose_item8(AP->w_down + (size_t)e * 256 * 1024, 1024, (unsigned char*)Wd_t + (size_t)e * 1024 * 256, 256, 64 * kb, 64 * nb, 64 * nb, 64 * nb + 32, scr, lane, 16.0f); }
        }
        const int gt = bx * 512 + tid, NGT = G * 512;
        for (int i = gt; i < 96 * 128; i += NGT) *(GAS v4u*)(Win_t + (size_t)416 * 1024 + (size_t)i * 8) = (v4u){0u, 0u, 0u, 0u};
        for (int i = gt; i < 1024 * 16; i += NGT) *(GAS v4u*)(Wkv_t + (size_t)(i >> 4) * 256 + 128 + (i & 15) * 8) = (v4u){0u, 0u, 0u, 0u};
        for (int i = gt; i < SEQ * 48; i += NGT) {
            const int pos = i / 48, f = i % 48; const bool isF = f < 32; const int ff = isF ? f : f - 32;
            const double e = isF ? (double)ff / 32.0 : (double)ff / 16.0;
            const float invf = (float)exp2(-e * 13.287712379549449);
            const float ang = (float)pos * invf;
            const double a = (double)ang; const double kk = rint(a * 0.15915494309189535); const double rr = a - kk * 6.283185307179586;
            const float c = (float)cos(rr), s = (float)sin(rr);
            GAS float* rF = (GAS float*)ropeF; GAS float* rR = (GAS float*)ropeR;
            if (isF) { rF[pos * 32 + ff] = c; rF[SEQ * 32 + pos * 32 + ff] = s; } else { rR[pos * 16 + ff] = c; rR[SEQ * 16 + pos * 16 + ff] = s; }
        }
        for (int i = gt; i < 1024 * 8; i += NGT) { const float gk = AP->ffn_g[i >> 3]; *((GAS f32x4*)WREF + i) = *((const GAS f32x4*)AP->w_re + i) * gk; }
        for (int i = gt; i < 1024; i += NGT) { const float gk = AP->ffn_g[i]; *((GAS f32x4*)WRGF + i) = *((const GAS f32x4*)AP->w_rg + i) * gk; }
        for (int t = gw; t < T; t += 2 * NGW) {
            const int t2 = (t + NGW < T) ? t + NGW : t;
            const GAS f32x4* xr = (const GAS f32x4*)(AP->x + (size_t)t * D) + lane; const GAS f32x4* xr2 = (const GAS f32x4*)(AP->x + (size_t)t2 * D) + lane; f32x4 v[4], w[4]; float s = 0.f, s2 = 0.f;
#pragma unroll
            for (int j = 0; j < 4; ++j) { v[j] = xr[64 * j]; w[j] = xr2[64 * j]; }
#pragma unroll
            for (int j = 0; j < 4; ++j) { s += (v[j].x * v[j].x + v[j].y * v[j].y) + (v[j].z * v[j].z + v[j].w * v[j].w); s2 += (w[j].x * w[j].x + w[j].y * w[j].y) + (w[j].z * w[j].z + w[j].w * w[j].w); }
            const float rstd = 1.0f / sqrtf(wave_sum(s) * (1.f / D) + EPS), rstd2 = 1.0f / sqrtf(wave_sum(s2) * (1.f / D) + EPS);
            GAS unsigned long long* o8 = (GAS unsigned long long*)(XN + (size_t)t * D) + lane; GAS unsigned long long* o82 = (GAS unsigned long long*)(XN + (size_t)t2 * D) + lane;
#pragma unroll
            for (int j = 0; j < 4; ++j) { const f32x4 g = *((const GAS f32x4*)AP->attn_g + lane + 64 * j);
                o8[64 * j] = (unsigned long long)pk2(v[j].x * rstd * g.x, v[j].y * rstd * g.y) | ((unsigned long long)pk2(v[j].z * rstd * g.z, v[j].w * rstd * g.w) << 32);
                o82[64 * j] = (unsigned long long)pk2(w[j].x * rstd2 * g.x, w[j].y * rstd2 * g.y) | ((unsigned long long)pk2(w[j].z * rstd2 * g.z, w[j].w * rstd2 * g.w) << 32); }
        }
    }
    SEAM(PH_PRO);

    if (IN(PH_PROJ)) { PH_BEGIN
        pg8::Gemm g{XN, Win_t, T, NPROJ, D}; pg8::StaticOrder S; S.init(T, NPROJ, G, bx);
        pg8::EpiProj E{ws, WS_QLN, WS_KVLN, WS_QB, WS_KB, WS_VB, WS_SSQ, WS_KMEAN, WS_ROPE, AP->mqhead_g, AP->mkhead_g, C2B, EPS, SEQ};
        pg8::gemm_phase<pg8::EpiProj, pg8::StaticOrder, true, true>(lds, g, S, E);
    }
    SEAM(PH_PROJ);

    if (IN(PH_UP)) { PH_BEGIN
        { int K256 = 256; asm volatile("" : "+s"(K256)); pg8::Gemm g{QLN, Wq_t, T, 768, K256}; pg8::StaticOrder S; S.init(T, 768, G, bx); pg8::EpiBf16Rs E{QA, 768, SSQ, 0, 1.0f / 256.0f, EPS};
          pg8::gemm_phase<pg8::EpiBf16Rs, pg8::StaticOrder, true, true>(lds, g, S, E); }
        { int K256 = 256; asm volatile("" : "+s"(K256)); pg8::Gemm g{KVLN, Wkv_t, T, 1024, K256}; pg8::StaticOrder S; S.init(T, 1024, G, bx); pg8::EpiKv E{KA, VA, KVLN, SSQ, ropeR, AP->khead_g, EPS, SEQ};
          pg8::gemm_phase<pg8::EpiKv, pg8::StaticOrder, true, true>(lds, g, S, E); }
    }
    SEAM(PH_UP);

    if (IN(PH_ATTN)) { PH_BEGIN
        bf16* O = XN;
        for (int u = bx; u < 512; u += G) {
            const int bh = u & 255, b = bh >> 3, h = bh & 7; const size_t r0 = (size_t)b * SEQ;
            if (u < 256) {
                for (int qb = 7; qb >= 0; --qb)
                    attn_unit<96, false, true>(lds, AP->qhead_g, ropeR, QA + r0 * 768 + h * 96, 768, KA + r0 * 768 + h * 96, 768, VA + r0 * 512 + h * 64, 512, (bf16*)((unsigned char*)O + r0 * 1024 + h * 64), 1024, OSSQ + r0 * 16 + h, qb, nullptr, 0);
            } else {
                for (int qb = 7; qb >= 0; --qb)
                    attn_unit<64, true, false>(lds, nullptr, nullptr, QB + r0 * 512 + h * 64, 512, KB + r0 * 512 + h * 64, 512, VB + r0 * 512 + h * 64, 512, (bf16*)((unsigned char*)O + r0 * 1024 + 512 + h * 64), 1024, OSSQ + r0 * 16 + 8 + h, qb, kmean + ((size_t)b * 8 * NH + h) * 64, NH * 64);
            }
        }
    }
    SEAM(PH_ATTN);

    if (IN(PH_OUT)) { PH_BEGIN
        pg8::Gemm g{XN, Wo_t, T, D, D / 2};        pg8::StaticOrder S; S.init(T, D, G, bx);
        LAS float* rsl = (LAS float*)(lds + RING_BYTES);
        { pg8::Unit uu;
          for (int i = 0; i < 12 && S.next(i, uu); ++i) if (tid < 256) { const GAS f32x4* pq = (const GAS f32x4*)((const GAS float*)OSSQ + (size_t)(uu.pm * 256 + tid) * 16); const f32x4 a0 = pq[0], a1 = pq[1], b0 = pq[2], b1 = pq[3];
              const float sa = ((a0[0] + a0[1]) + (a0[2] + a0[3])) + ((a1[0] + a1[1]) + (a1[2] + a1[3])), sb = ((b0[0] + b0[1]) + (b0[2] + b0[3])) + ((b1[0] + b1[1]) + (b1[2] + b1[3]));
              const float ra = 1.0f / sqrtf(sa * (1.0f / 512.0f) + EPS), rb = 1.0f / sqrtf(sb * (1.0f / 512.0f) + EPS);
              *(LAS f32x2*)(rsl + (i * 256 + tid) * 2) = (f32x2){ra / rb, rb}; }
          __syncthreads(); }
        pg8::EpiOut E{AP->x, X1B, rsl};
        pg8::gemm_phase<pg8::EpiOut, pg8::StaticOrder, true, true, false, false, true, 0x7a7a7a7a, 0x7b7b7b7b, true>(lds, g, S, E);
    }
    SEAM(PH_OUT);

    if (IN(PH_ROUTE)) { PH_BEGIN
        LAS float* Wrg = (LAS float*)(lds + P8_WRG); LAS float* xt = (LAS float*)(lds + P8_XT + wave * P8_XT_WAVE); LAS float* wc = (LAS float*)(lds + P8_WC);
        LAS int* rt_g = (LAS int*)(lds + P8_RT); LAS float* rt_w = (LAS float*)(lds + P8_RT + 1024); LAS int* rt_rank = (LAS int*)(lds + P8_RT + 3072);
        LAS int* lcnt = (LAS int*)(lds + P8_RT + 4096); LAS int* lbase = (LAS int*)(lds + P8_RT + 4608); LAS float* rt_rs = (LAS float*)(lds + P8_RT + 5120);
        for (int k = tid; k < 1024; k += 512) *(LAS f32x4*)(Wrg + 4 * k) = *((const GAS f32x4*)WRGF + k);
        __syncthreads();
        const int r32 = lane & 31, kh = lane >> 5;
        for (int chunk = bx; chunk < T / 256; chunk += G) {
            if (tid < NCLS) lcnt[tid] = 0;
            const int rowc = wave * 32 + r32; const size_t row0w = (size_t)chunk * 256 + wave * 32;
            const GAS bf16* xsrc = (const GAS bf16*)X1B + (row0w + (lane >> 4)) * D + 4 * (lane & 15);
            f32x16 accE = {}; float aG0 = 0.f, aG1 = 0.f, aG2 = 0.f, aG3 = 0.f, ssq = 0.f;
            *(LAS f32x4*)(wc + 4 * tid) = *((const GAS f32x4*)WREF + tid);
            v2u xn[8]; f32x4 gvn;
#pragma unroll
            for (int j = 0; j < 8; ++j) xn[j] = *(const GAS v2u*)(xsrc + (size_t)(4 * j) * D);
            gvn = *(const GAS f32x4*)((const GAS float*)AP->ffn_g + 4 * (lane & 15));
#pragma unroll 1
            for (int kc = 0; kc < 16; ++kc) {
                f32x4 st[8];
#pragma unroll
                for (int j = 0; j < 8; ++j) st[j] = (f32x4){bflo(xn[j].x), bfhi(xn[j].x), bflo(xn[j].y), bfhi(xn[j].y)};
                const f32x4 gv = gvn;
                if (kc + 1 < 16) {
#pragma unroll
                    for (int j = 0; j < 8; ++j) xn[j] = *(const GAS v2u*)(xsrc + (size_t)(4 * j) * D + (kc + 1) * 64);
                    gvn = *(const GAS f32x4*)((const GAS float*)AP->ffn_g + (kc + 1) * 64 + 4 * (lane & 15)); }
                f32x4 wnext = {0.f, 0.f, 0.f, 0.f}; if (kc + 1 < 16) wnext = *((const GAS f32x4*)WREF + (kc + 1) * 512 + tid);
#pragma unroll
                for (int j = 0; j < 8; ++j) *(LAS f32x4*)(xt + ((lane >> 4) + 4 * j) * 68 + 4 * (lane & 15)) = st[j];
                if (kc + 1 < 16) *(LAS f32x4*)(wc + ((kc + 1) & 1) * 2048 + 4 * tid) = wnext;
                {
#pragma unroll
                  for (int j = 0; j < 8; ++j) { const f32x4 hv = st[j] * gv;
                      *(GAS unsigned*)((GAS unsigned char*)YH + (size_t)(row0w + (lane >> 4) + 4 * j) * D + kc * 64 + 4 * (lane & 15)) = pk4_fp8(hv[0], hv[1], hv[2], hv[3]); } }
                __syncthreads();
                const LAS float* wcc = wc + (kc & 1) * 2048 + r32;
#pragma unroll
                for (int c = 0; c < 8; ++c) {
                    const f32x4 xv = *(const LAS f32x4*)(xt + r32 * 68 + 8 * c + 4 * kh);
                    ssq += (xv.x * xv.x + xv.y * xv.y) + (xv.z * xv.z + xv.w * xv.w);
#pragma unroll
                    for (int e = 0; e < 4; ++e) { const int kl = 8 * c + 4 * kh + e;
                        const float a = wcc[kl * 32]; accE = __builtin_amdgcn_mfma_f32_32x32x2f32(a, xv[e], accE, 0, 0, 0);
                        const f32x4 wg = *(const LAS f32x4*)(Wrg + 4 * (kc * 64 + kl)); aG0 += xv[e] * wg[0]; aG1 += xv[e] * wg[1]; aG2 += xv[e] * wg[2]; aG3 += xv[e] * wg[3]; }
                }
                __syncthreads();
            }
            ssq += __shfl_xor(ssq, 32); aG0 += __shfl_xor(aG0, 32); aG1 += __shfl_xor(aG1, 32); aG2 += __shfl_xor(aG2, 32); aG3 += __shfl_xor(aG3, 32);
            const float rstd = 1.0f / sqrtf(ssq * (1.f / D) + EPS);
            float lg[4] = {aG0 * rstd + AP->b_rg[0], aG1 * rstd + AP->b_rg[1], aG2 * rstd + AP->b_rg[2], aG3 * rstd + AP->b_rg[3]};
            int gs = 0; float gm = lg[0];
#pragma unroll
            for (int i = 1; i < 4; ++i) if (lg[i] > gm) { gm = lg[i]; gs = i; }
            float den = 0.f;
#pragma unroll
            for (int i = 0; i < 4; ++i) den += __expf(lg[i] - gm);
            const float gwt = 1.0f / den;
            float mine[4];
#pragma unroll
            for (int i = 0; i < 4; ++i) { const float v = (gs == 0) ? accE[i] : (gs == 1) ? accE[4 + i] : (gs == 2) ? accE[8 + i] : accE[12 + i]; mine[i] = v * rstd + AP->b_re[gs * 8 + 4 * kh + i]; }
            float ev[8];
#pragma unroll
            for (int i = 0; i < 4; ++i) { const float oth = __shfl_xor(mine[i], 32); ev[i] = kh ? oth : mine[i]; ev[4 + i] = kh ? mine[i] : oth; }
            int e1 = 0; float v1 = ev[0];
#pragma unroll
            for (int i = 1; i < 8; ++i) if (ev[i] > v1) { v1 = ev[i]; e1 = i; }
            int e2 = -1; float v2 = -INFINITY;
#pragma unroll
            for (int i = 0; i < 8; ++i) if (i != e1 && (e2 < 0 || ev[i] > v2)) { v2 = ev[i]; e2 = i; }
            const float ex = __expf(v2 - v1); const float w1 = gwt / (1.0f + ex), w2 = gwt * ex / (1.0f + ex);
            if (kh == 0) { const int elo = e1 < e2 ? e1 : e2, ehi = e1 < e2 ? e2 : e1;
                rt_g[rowc] = gs * 28 + ((elo * (15 - elo)) >> 1) + (ehi - elo - 1); rt_w[rowc * 2] = e1 < e2 ? w1 : w2; rt_w[rowc * 2 + 1] = e1 < e2 ? w2 : w1; rt_rs[rowc] = rstd; }
            __syncthreads();
            if (tid < 256) rt_rank[tid] = __hip_atomic_fetch_add(&lcnt[rt_g[tid]], 1, __ATOMIC_RELAXED, __HIP_MEMORY_SCOPE_WORKGROUP);
            __syncthreads();
            if (tid < NCLS) { const int n = lcnt[tid]; lbase[tid] = n ? (int)__hip_atomic_fetch_add((gu32*)(ws + WS_CTL) + CW_GCNT + 64 * tid, (unsigned)n, RLX_AGENT) : 0; }
            __syncthreads();
            if (tid < 256) { const int g = rt_g[tid]; v4u ev; ev.x = (unsigned)(chunk * 256 + tid); ev.y = __builtin_bit_cast(unsigned, rt_w[tid * 2]); ev.z = __builtin_bit_cast(unsigned, rt_w[tid * 2 + 1]); ev.w = __builtin_bit_cast(unsigned, rt_rs[tid]);
                ((GAS v4u*)lists)[(size_t)g * LIST_CAP + lbase[g] + rt_rank[tid]] = ev; }
            __syncthreads();
        }
    }
    SEAM(PH_ROUTE);

    LAS int* tp = (LAS int*)(lds + TP_OFF); LAS int* cntl = (LAS int*)(lds + CNT_OFF); LAS int* ptab = (LAS int*)(lds + PT_OFF);
    if (hi > PH_ROUTE) {
        if (tid0 == 0) { gu32* ctl = (gu32*)(A.ws + WS_CTL); int acc = 0; for (int g = 0; g < NCLS; ++g) { const int n = (int)__hip_atomic_load(ctl + CW_GCNT + 64 * g, RLX_AGENT); cntl[g] = n; tp[g] = acc; acc += (n + 255) >> 8; } tp[NCLS] = acc;
            int p = 0; for (int lo_ = 0; lo_ < 8; ++lo_) for (int hi_ = lo_ + 1; hi_ < 8; ++hi_) ptab[p++] = lo_ | (hi_ << 4); }
        __syncthreads();
    }

    if (IN(PH_GU)) { PH_BEGIN
        pg8::Gemm g{YH, Wgu_t, 0, 0, D / 2}; pg8::ClsOrder S{tp, ptab, 0, G, MOE_SLOT(4), lists, cntl};
        pg8::EpiGateUp2 E{HB, lists, cntl};
        pg8::gemm_phase<pg8::EpiGateUp2, pg8::ClsOrder, true, true, true, false, true>(lds, g, S, E);
    }
    SEAM(PH_GU);

    if (IN(PH_D0)) { PH_BEGIN
        int K512 = 256; asm volatile("" : "+s"(K512)); pg8::Gemm g{HB, Wd_t, 0, 0, K512};        pg8::ClsOrder S{tp, ptab, 1, G, MOE_SLOT(4), lists, cntl};
        pg8::EpiDown2 E{AP->out, X1B, lists, cntl};
        pg8::gemm_phase<pg8::EpiDown2, pg8::ClsOrder, true, true, false, true, true, 0x7b7b7b7b, 0x7c7c7c7c, true>(lds, g, S, E);
    }
#undef IN
#undef SEAM
}

extern "C" void kernel_launch(void* const* d_in, const int* in_sizes, int n_in, void* d_out, int out_size, void* d_ws, size_t ws_size, hipStream_t stream) {
    static int grid = 0;
    if (grid == 0) {
        if (n_in != 22 || in_sizes[0] != T * D || out_size != T * D || ws_size < WS_END) { fprintf(stderr, "kernel_launch: unexpected shapes (n_in %d, in0 %d, out %d, ws %zu); nothing launched\n", n_in, n_in > 0 ? in_sizes[0] : -1, out_size, ws_size); grid = -1; return; }
        int dev = 0, cus = 0, per_cu = 0;
        if (hipGetDevice(&dev) != hipSuccess || hipDeviceGetAttribute(&cus, hipDeviceAttributeMultiprocessorCount, dev) != hipSuccess) { grid = -1; return; }
        if (hipFuncSetAttribute((const void*)mk_fwd, hipFuncAttributeMaxDynamicSharedMemorySize, LDS_BYTES) != hipSuccess) { fprintf(stderr, "kernel_launch: hipFuncSetAttribute failed\n"); grid = -1; return; }
        if (hipOccupancyMaxActiveBlocksPerMultiprocessor(&per_cu, (const void*)mk_fwd, 512, LDS_BYTES) != hipSuccess || per_cu < 1) { fprintf(stderr, "kernel_launch: occupancy query says %d\n", per_cu); }
        (void)hipGetLastError();
        grid = cus;
    }
    if (grid < 0) return;
    if (hipMemsetAsync((char*)d_ws + WS_CTL, 0, CTL_ZERO_BYTES, stream) != hipSuccess) return;
    Args a{};
    a.x = (const float*)d_in[0]; a.attn_g = (const float*)d_in[1]; a.w_in = (const float*)d_in[2]; a.qlat_g = (const float*)d_in[3]; a.w_qup = (const float*)d_in[4];
    a.kvlat_g = (const float*)d_in[5]; a.w_kvup = (const float*)d_in[6]; a.qhead_g = (const float*)d_in[7]; a.khead_g = (const float*)d_in[8];
    a.mqhead_g = (const float*)d_in[9]; a.mkhead_g = (const float*)d_in[10]; a.onorm_a_g = (const float*)d_in[11]; a.onorm_b_g = (const float*)d_in[12];
    a.w_out = (const float*)d_in[13]; a.ffn_g = (const float*)d_in[14]; a.w_rg = (const float*)d_in[15]; a.b_rg = (const float*)d_in[16];
    a.w_re = (const float*)d_in[17]; a.b_re = (const float*)d_in[18]; a.w_gate = (const float*)d_in[19]; a.w_up = (const float*)d_in[20]; a.w_down = (const float*)d_in[21];
    a.out = (float*)d_out; a.ws = (unsigned char*)d_ws; a.ph_lo = 0; a.ph_hi = NPHASE;
    hipLaunchKernelGGL(mk_fwd, dim3(grid), dim3(512), LDS_BYTES, stream, a);
    (void)hipPeekAtLastError();
}
```

```cpp
#include <hip/hip_runtime.h>
#include <cstdio>
#include <cstdint>
namespace pg8 {
#define PG8_LAS __attribute__((address_space(3)))
typedef unsigned short bf16_t;
typedef short bf16x8 __attribute__((ext_vector_type(8)));
typedef float f32x4 __attribute__((ext_vector_type(4)));
typedef unsigned u32x4 __attribute__((ext_vector_type(4)));
constexpr int BM = 256, BK = 64, HALF = 128, HTB = HALF * BK * 2  , STAGE_BYTES = 8 * HTB, NXCD = 8, WGM = 8;

__host__ __device__ __forceinline__ int lds_byte(int r, int c) { const int st = (r >> 4) * 2 + (c >> 5), rr = r & 15, cc = c & 31, ob = rr * 64 + cc * 2; return st * 1024 + (ob ^ (((ob >> 9) & 1) << 5)); }
__host__ __device__ __forceinline__ void stage_rc(int b, int& R, int& C) { const int st = b / 1024, sb = b % 1024, swz = sb ^ (((sb >> 9) & 1) << 5); R = (st >> 1) * 16 + swz / 64; C = (st & 1) * 32 + (swz % 64) / 2; }
__host__ __device__ __forceinline__ int perm32(int rho) { const int n = rho >> 4, i = rho & 15; return 8 * (i >> 2) + 4 * n + (i & 3); }

struct Unit { int pm, pn, g0, g1, pn2, q; };
struct Gemm { const bf16_t* A; const bf16_t* Bt; int M, N, K; };

struct StaticOrder {
    int nM, nN, nwg, G, c;
    __host__ __device__ void init(int M, int N, int G_, int c_) { nM = M / BM; nN = N / BM; nwg = nM * nN; G = G_; c = c_; }
    __host__ __device__ bool next(int i, Unit& u) const {
        const long L = (long)i * G + c; if (L >= nwg) return false;
        int wgid = (int)L; { const int q = nwg / NXCD, r = nwg % NXCD, xcd = wgid % NXCD, off = wgid / NXCD; wgid = (xcd < r ? xcd * (q + 1) : r * (q + 1) + (xcd - r) * q) + off; }
        const int nig = WGM * nN, gid = wgid / nig, fm = gid * WGM, gsz = (nM - fm) < WGM ? (nM - fm) : WGM;
        u.pm = fm + ((wgid % nig) % gsz); u.pn = (wgid % nig) / gsz; u.g0 = i; u.g1 = 0; u.pn2 = 0; u.q = 0; return true;
    }
    __device__ __forceinline__ void a_ready(const Unit&) const {}
    __device__ __forceinline__ void done(const Unit&) const {}
};

__device__ __forceinline__ unsigned cvt_pk_bf16(float lo, float hi) { unsigned r; asm volatile("v_cvt_pk_bf16_f32 %0, %1, %2" : "=v"(r) : "v"(lo), "v"(hi)); return r; }
#define PG8_GAS __attribute__((address_space(1)))
struct ListEnt { int tok; float w_lo; float w_hi; float rstd; };

struct EpiBf16 {
    static constexpr bool PERM = true, AFTER_DRAIN = false, MIDHOOK = false;
    bf16_t* O; int ldc;
    __device__ __forceinline__ void operator()(const f32x4 (&acc)[2][2][4][2], const Unit& u, int wr, int wc, int fr, int fq) const {
        const int row0 = u.pm * BM + wr * 64 + fr; const int col0 = u.pn * BM + wc * 32 + 8 * fq;
#pragma unroll
        for (int ai = 0; ai < 2; ++ai)
#pragma unroll
            for (int m = 0; m < 4; ++m) { bf16_t* rowp = O + (size_t)(row0 + ai * HALF + m * 16) * ldc + col0;
#pragma unroll
                for (int bj = 0; bj < 2; ++bj) { const f32x4 v0 = acc[ai][bj][m][0], v1 = acc[ai][bj][m][1];
                    u32x4 w; w.x = cvt_pk_bf16(v0[0], v0[1]); w.y = cvt_pk_bf16(v0[2], v0[3]); w.z = cvt_pk_bf16(v1[0], v1[1]); w.w = cvt_pk_bf16(v1[2], v1[3]);
                    *(PG8_GAS u32x4*)(rowp + bj * HALF) = w; } }
    }
};
struct EpiBf16Rs {
    static constexpr bool PERM = true, AFTER_DRAIN = false, MIDHOOK = false;
    bf16_t* O; int ldc; const float* ssq; int off; float inv_n, eps;
    __device__ __forceinline__ void operator()(const f32x4 (&acc)[2][2][4][2], const Unit& u, int wr, int wc, int fr, int fq) const {
        const int row0 = u.pm * BM + wr * 64 + fr; const int col0 = u.pn * BM + wc * 32 + 8 * fq;
#pragma unroll
        for (int ai = 0; ai < 2; ++ai)
#pragma unroll
            for (int m = 0; m < 4; ++m) { const int row = row0 + ai * HALF + m * 16; PG8_GAS bf16_t* rowp = (PG8_GAS bf16_t*)O + (size_t)row * ldc + col0;
                const f32x4 sq = *(const PG8_GAS f32x4*)(ssq + (size_t)row * 8 + off); const float rs = __builtin_amdgcn_rsqf(((sq[0] + sq[1]) + (sq[2] + sq[3])) * inv_n + eps);
#pragma unroll
                for (int bj = 0; bj < 2; ++bj) { const f32x4 v0 = acc[ai][bj][m][0] * rs, v1 = acc[ai][bj][m][1] * rs;
                    u32x4 w; w.x = cvt_pk_bf16(v0[0], v0[1]); w.y = cvt_pk_bf16(v0[2], v0[3]); w.z = cvt_pk_bf16(v1[0], v1[1]); w.w = cvt_pk_bf16(v1[2], v1[3]);
                    *(PG8_GAS u32x4*)(rowp + bj * HALF) = w; } }
    }
};
struct EpiProj {
    static constexpr bool PERM = true, AFTER_DRAIN = false, MIDHOOK = false;
    unsigned char* ws; size_t o_qln, o_kvln, o_qb, o_kb, o_vb, o_ssq, o_kmean, o_rope; const float* gq; const float* gk; float qscale, eps; int seq;
    __device__ __forceinline__ void operator()(const f32x4 (&acc)[2][2][4][2], const Unit& u, int wr, int wc, int fr, int fq) const {
        const int pn = u.pn; const int row0 = u.pm * BM + wr * 64 + fr;
        bf16_t* const QLN = (bf16_t*)(ws + o_qln); bf16_t* const KVLN = (bf16_t*)(ws + o_kvln); bf16_t* const QB = (bf16_t*)(ws + o_qb); bf16_t* const KB = (bf16_t*)(ws + o_kb); bf16_t* const VB = (bf16_t*)(ws + o_vb);
        float* const SSQ = (float*)(ws + o_ssq); float* const kmean = (float*)(ws + o_kmean); const float* const rope = (const float*)(ws + o_rope);
        if (pn < 2) {
            PG8_GAS bf16_t* O = (PG8_GAS bf16_t*)(pn ? KVLN : QLN); PG8_GAS float* sq = (PG8_GAS float*)SSQ;
#pragma unroll
            for (int ai = 0; ai < 2; ++ai)
#pragma unroll
                for (int m = 0; m < 4; ++m) { const int row = row0 + ai * HALF + m * 16; PG8_GAS bf16_t* rowp = O + (size_t)row * 256 + wc * 32 + 8 * fq; float ss = 0.f;
#pragma unroll
                    for (int bj = 0; bj < 2; ++bj) { const f32x4 v0 = acc[ai][bj][m][0], v1 = acc[ai][bj][m][1];
                        if (pn == 0 || bj == 0) ss += (v0[0] * v0[0] + v0[1] * v0[1]) + (v0[2] * v0[2] + v0[3] * v0[3]) + (v1[0] * v1[0] + v1[1] * v1[1]) + (v1[2] * v1[2] + v1[3] * v1[3]);
                        u32x4 w; w.x = cvt_pk_bf16(v0[0], v0[1]); w.y = cvt_pk_bf16(v0[2], v0[3]); w.z = cvt_pk_bf16(v1[0], v1[1]); w.w = cvt_pk_bf16(v1[2], v1[3]);
                        *(PG8_GAS u32x4*)(rowp + bj * HALF) = w; }
                    ss += __shfl_xor(ss, 16); ss += __shfl_xor(ss, 32);
                    if (fq == 0) sq[(size_t)row * 8 + pn * 4 + wc] = ss; }
        } else if (pn < 6) {
            const bool isk = pn >= 4; const int head = (pn & 1) * 4 + wc; const float* gp = isk ? gk : gq; asm volatile("" : "+s"(gp)); const float sc = isk ? 1.0f : qscale;
            PG8_GAS bf16_t* O = (PG8_GAS bf16_t*)(isk ? KB : QB);
            f32x4 g0[2], g1[2];
#pragma unroll
            for (int n = 0; n < 2; ++n) { g0[n] = *(const PG8_GAS f32x4*)(gp + 8 * fq + 4 * n); g1[n] = *(const PG8_GAS f32x4*)(gp + 32 + 8 * fq + 4 * n); }
            f32x4 cs0[2] = {{0.f, 0.f, 0.f, 0.f}, {0.f, 0.f, 0.f, 0.f}}, cs1[2] = {{0.f, 0.f, 0.f, 0.f}, {0.f, 0.f, 0.f, 0.f}};
            f32x4 rc[2][4];
            { const int pos0 = row0 & (seq - 1);
#pragma unroll
              for (int n = 0; n < 2; ++n) { rc[0][n] = *(const PG8_GAS f32x4*)(rope + (size_t)pos0 * 32 + 8 * fq + 4 * n); rc[0][2 + n] = *(const PG8_GAS f32x4*)(rope + (size_t)seq * 32 + (size_t)pos0 * 32 + 8 * fq + 4 * n); } }
#pragma unroll
            for (int ai = 0; ai < 2; ++ai)
#pragma unroll
                for (int m = 0; m < 4; ++m) { const int row = row0 + ai * HALF + m * 16; const int gi = ai * 4 + m;
                    if (gi < 7) { const int gn = gi + 1; const int posn = (row0 + (gn >> 2) * HALF + (gn & 3) * 16) & (seq - 1);
#pragma unroll
                        for (int n = 0; n < 2; ++n) { rc[gn & 1][n] = *(const PG8_GAS f32x4*)(rope + (size_t)posn * 32 + 8 * fq + 4 * n); rc[gn & 1][2 + n] = *(const PG8_GAS f32x4*)(rope + (size_t)seq * 32 + (size_t)posn * 32 + 8 * fq + 4 * n); } }
                    float ss = 0.f;
#pragma unroll
                    for (int n = 0; n < 2; ++n) { const f32x4 a = acc[ai][0][m][n], b = acc[ai][1][m][n]; ss += (a[0] * a[0] + a[1] * a[1]) + (a[2] * a[2] + a[3] * a[3]) + (b[0] * b[0] + b[1] * b[1]) + (b[2] * b[2] + b[3] * b[3]); }
                    ss += __shfl_xor(ss, 16); ss += __shfl_xor(ss, 32);
                    const float rs = __builtin_amdgcn_rsqf(ss * (1.0f / 64.0f) + eps);
                    u32x4 w1, w2; unsigned pk1[4], pk2_[4];
#pragma unroll
                    for (int n = 0; n < 2; ++n) { const f32x4 c = rc[gi & 1][n], sn = rc[gi & 1][2 + n];
                        const f32x4 y1 = acc[ai][0][m][n] * rs * g0[n], y2 = acc[ai][1][m][n] * rs * g1[n];
                        const f32x4 o1 = (y1 * c - y2 * sn) * sc, o2 = (y2 * c + y1 * sn) * sc;
                        if (isk) { cs0[n] += o1; cs1[n] += o2; }
                        pk1[2 * n] = cvt_pk_bf16(o1[0], o1[1]); pk1[2 * n + 1] = cvt_pk_bf16(o1[2], o1[3]); pk2_[2 * n] = cvt_pk_bf16(o2[0], o2[1]); pk2_[2 * n + 1] = cvt_pk_bf16(o2[2], o2[3]); }
                    w1.x = pk1[0]; w1.y = pk1[1]; w1.z = pk1[2]; w1.w = pk1[3]; w2.x = pk2_[0]; w2.y = pk2_[1]; w2.z = pk2_[2]; w2.w = pk2_[3];
                    PG8_GAS bf16_t* rowp = O + (size_t)row * 512 + head * 64 + 8 * fq;
                    *(PG8_GAS u32x4*)rowp = w1; *(PG8_GAS u32x4*)(rowp + 32) = w2;
                    asm volatile("" : "+v"(cs0[0]), "+v"(cs0[1]), "+v"(cs1[0]), "+v"(cs1[1]) :: "memory"); }
            if (isk) {
                PG8_GAS float* km = (PG8_GAS float*)kmean + ((size_t)u.pm * 8 + head) * 64;
#pragma unroll
                for (int n = 0; n < 2; ++n)
#pragma unroll
                    for (int j = 0; j < 4; ++j) { float a = cs0[n][j], b = cs1[n][j];
#pragma unroll
                        for (int o = 1; o < 16; o <<= 1) { a += __shfl_xor(a, o); b += __shfl_xor(b, o); }
                        if (fr == 0) { __hip_atomic_fetch_add(km + 8 * fq + 4 * n + j, a * (1.0f / 256.0f), __ATOMIC_RELAXED, __HIP_MEMORY_SCOPE_AGENT); __hip_atomic_fetch_add(km + 32 + 8 * fq + 4 * n + j, b * (1.0f / 256.0f), __ATOMIC_RELAXED, __HIP_MEMORY_SCOPE_AGENT); } }
            }
        } else {
            PG8_GAS bf16_t* O = (PG8_GAS bf16_t*)VB; const int col0 = (pn - 6) * BM + wc * 32 + 8 * fq;
#pragma unroll
            for (int ai = 0; ai < 2; ++ai)
#pragma unroll
                for (int m = 0; m < 4; ++m) { PG8_GAS bf16_t* rowp = O + (size_t)(row0 + ai * HALF + m * 16) * 512 + col0;
#pragma unroll
                    for (int bj = 0; bj < 2; ++bj) { const f32x4 v0 = acc[ai][bj][m][0], v1 = acc[ai][bj][m][1];
                        u32x4 w; w.x = cvt_pk_bf16(v0[0], v0[1]); w.y = cvt_pk_bf16(v0[2], v0[3]); w.z = cvt_pk_bf16(v1[0], v1[1]); w.w = cvt_pk_bf16(v1[2], v1[3]);
                        *(PG8_GAS u32x4*)(rowp + bj * HALF) = w; } }
        }
    }
};
struct EpiKv {
    static constexpr bool PERM = true, AFTER_DRAIN = false, MIDHOOK = false;
    bf16_t* KA; bf16_t* VA; const bf16_t* KVLN; const float* ssq; const float* ropeR; const float* gk; float eps; int seq;
    __device__ __forceinline__ void operator()(const f32x4 (&acc)[2][2][4][2], const Unit& u, int wr, int wc, int fr, int fq) const {
        const int pn = u.pn; const int row0 = u.pm * BM + wr * 64 + fr;
        if (pn < 2) {
            const int head = pn * 4 + wc; const float* gp = gk; asm volatile("" : "+s"(gp));
            f32x4 g0[2], g1[2];
#pragma unroll
            for (int n = 0; n < 2; ++n) { g0[n] = *(const PG8_GAS f32x4*)(gp + 8 * fq + 4 * n); g1[n] = *(const PG8_GAS f32x4*)(gp + 32 + 8 * fq + 4 * n); }
            const f32x4 gr1 = *(const PG8_GAS f32x4*)(gp + 64 + 4 * fq), gr2 = *(const PG8_GAS f32x4*)(gp + 80 + 4 * fq);
#pragma unroll
            for (int ai = 0; ai < 2; ++ai)
#pragma unroll
                for (int m = 0; m < 4; ++m) { const int row = row0 + ai * HALF + m * 16; const int pos = row & (seq - 1);
                    const f32x4 sq = *(const PG8_GAS f32x4*)(ssq + (size_t)row * 8 + 4); const float rl = __builtin_amdgcn_rsqf(((sq[0] + sq[1]) + (sq[2] + sq[3])) * (1.0f / 128.0f) + eps);
                    const PG8_GAS bf16_t* pe = (const PG8_GAS bf16_t*)KVLN + (size_t)row * 256 + 128 + 4 * fq;
                    typedef unsigned u32x2_ __attribute__((ext_vector_type(2)));
                    const u32x2_ p1 = *(const PG8_GAS u32x2_*)pe, p2 = *(const PG8_GAS u32x2_*)(pe + 16);
                    const f32x4 e1 = {__builtin_bit_cast(float, p1.x << 16), __builtin_bit_cast(float, p1.x & 0xffff0000u), __builtin_bit_cast(float, p1.y << 16), __builtin_bit_cast(float, p1.y & 0xffff0000u)};
                    const f32x4 e2 = {__builtin_bit_cast(float, p2.x << 16), __builtin_bit_cast(float, p2.x & 0xffff0000u), __builtin_bit_cast(float, p2.y << 16), __builtin_bit_cast(float, p2.y & 0xffff0000u)};
                    f32x4 x0[2], x1[2]; float ss = (e1[0] * e1[0] + e1[1] * e1[1]) + (e1[2] * e1[2] + e1[3] * e1[3]) + (e2[0] * e2[0] + e2[1] * e2[1]) + (e2[2] * e2[2] + e2[3] * e2[3]);
#pragma unroll
                    for (int n = 0; n < 2; ++n) { x0[n] = acc[ai][0][m][n] * rl; x1[n] = acc[ai][1][m][n] * rl; const f32x4 a = x0[n], b = x1[n];
                        ss += (a[0] * a[0] + a[1] * a[1]) + (a[2] * a[2] + a[3] * a[3]) + (b[0] * b[0] + b[1] * b[1]) + (b[2] * b[2] + b[3] * b[3]); }
                    ss += __shfl_xor(ss, 16); ss += __shfl_xor(ss, 32);
                    const float rs = __builtin_amdgcn_rsqf(ss * (1.0f / 96.0f) + eps);
                    PG8_GAS bf16_t* rowp = (PG8_GAS bf16_t*)KA + (size_t)row * 768 + head * 96;
                    u32x4 w1, w2;
                    { const f32x4 a = x0[0] * rs * g0[0], b = x0[1] * rs * g0[1]; w1.x = cvt_pk_bf16(a[0], a[1]); w1.y = cvt_pk_bf16(a[2], a[3]); w1.z = cvt_pk_bf16(b[0], b[1]); w1.w = cvt_pk_bf16(b[2], b[3]); }
                    { const f32x4 a = x1[0] * rs * g1[0], b = x1[1] * rs * g1[1]; w2.x = cvt_pk_bf16(a[0], a[1]); w2.y = cvt_pk_bf16(a[2], a[3]); w2.z = cvt_pk_bf16(b[0], b[1]); w2.w = cvt_pk_bf16(b[2], b[3]); }
                    *(PG8_GAS u32x4*)(rowp + 8 * fq) = w1; *(PG8_GAS u32x4*)(rowp + 32 + 8 * fq) = w2;
                    const f32x4 c = *(const PG8_GAS f32x4*)(ropeR + (size_t)pos * 16 + 4 * fq), sn = *(const PG8_GAS f32x4*)(ropeR + (size_t)seq * 16 + (size_t)pos * 16 + 4 * fq);
                    const f32x4 y1 = e1 * rs * gr1, y2 = e2 * rs * gr2; const f32x4 o1 = y1 * c - y2 * sn, o2 = y2 * c + y1 * sn;
                    u32x2_ r1, r2; r1.x = cvt_pk_bf16(o1[0], o1[1]); r1.y = cvt_pk_bf16(o1[2], o1[3]); r2.x = cvt_pk_bf16(o2[0], o2[1]); r2.y = cvt_pk_bf16(o2[2], o2[3]);
                    *(PG8_GAS u32x2_*)(rowp + 64 + 4 * fq) = r1; *(PG8_GAS u32x2_*)(rowp + 80 + 4 * fq) = r2;
                    asm volatile("" ::: "memory"); }
        } else {
            const int col0 = (pn - 2) * BM + wc * 32 + 8 * fq;
#pragma unroll
            for (int ai = 0; ai < 2; ++ai)
#pragma unroll
                for (int m = 0; m < 4; ++m) { const int row = row0 + ai * HALF + m * 16; PG8_GAS bf16_t* rowp = (PG8_GAS bf16_t*)VA + (size_t)row * 512 + col0;
                    const f32x4 sq = *(const PG8_GAS f32x4*)(ssq + (size_t)row * 8 + 4); const float rl = __builtin_amdgcn_rsqf(((sq[0] + sq[1]) + (sq[2] + sq[3])) * (1.0f / 128.0f) + eps);
#pragma unroll
                    for (int bj = 0; bj < 2; ++bj) { const f32x4 v0 = acc[ai][bj][m][0] * rl, v1 = acc[ai][bj][m][1] * rl;
                        u32x4 w; w.x = cvt_pk_bf16(v0[0], v0[1]); w.y = cvt_pk_bf16(v0[2], v0[3]); w.z = cvt_pk_bf16(v1[0], v1[1]); w.w = cvt_pk_bf16(v1[2], v1[3]);
                        *(PG8_GAS u32x4*)(rowp + bj * HALF) = w; } }
        }
    }
};
struct EpiOut {
    static constexpr bool PERM = true, AFTER_DRAIN = false, MIDHOOK = true;
    const bf16_t* xn; const float* xrs; bf16_t* x1b; const PG8_LAS float* rsl;
    __device__ __forceinline__ void mid(f32x4 (&acc)[2][2][4][2], const Unit& u, int wr, int wc, int fr, int fq) const {
        const PG8_LAS float* rs = rsl + (u.g0 * 256 + wr * 64 + fr) * 2;
#pragma unroll
        for (int ai = 0; ai < 2; ++ai)
#pragma unroll
            for (int m = 0; m < 4; ++m) { const float ratio = rs[(ai * HALF + m * 16) * 2];
#pragma unroll
                for (int bj = 0; bj < 2; ++bj)
#pragma unroll
                    for (int n = 0; n < 2; ++n) acc[ai][bj][m][n] *= ratio; }
    }
    __device__ __forceinline__ void operator()(const f32x4 (&acc)[2][2][4][2], const Unit& u, int wr, int wc, int fr, int fq) const {
        const int row0 = u.pm * BM + wr * 64 + fr; const int col0 = u.pn * BM + wc * 32 + 8 * fq;
        const PG8_LAS float* rs = rsl + (u.g0 * 256 + wr * 64 + fr) * 2 + 1;
        float xs[8];
#pragma unroll
        for (int i = 0; i < 8; ++i) xs[i] = *(const PG8_GAS float*)(xrs + row0 + (i >> 2) * HALF + (i & 3) * 16);
        u32x4 xr[2][4];
#pragma unroll
        for (int g = 0; g < 2; ++g) { const size_t off = (size_t)(row0 + g * 16) * 1024 + col0;
#pragma unroll
            for (int bj = 0; bj < 2; ++bj) xr[0][g * 2 + bj] = *(const PG8_GAS u32x4*)(xn + off + bj * HALF); }
#pragma unroll
        for (int pr = 0; pr < 4; ++pr) {
            if (pr < 3) {
#pragma unroll
                for (int g = 0; g < 2; ++g) { const int gi = 2 * (pr + 1) + g; const size_t off = (size_t)(row0 + (gi >> 2) * HALF + (gi & 3) * 16) * 1024 + col0;
#pragma unroll
                    for (int bj = 0; bj < 2; ++bj) xr[(pr + 1) & 1][g * 2 + bj] = *(const PG8_GAS u32x4*)(xn + off + bj * HALF); } }
#pragma unroll
            for (int g = 0; g < 2; ++g) { const int gi = 2 * pr + g; const int ai = gi >> 2, m = gi & 3; const size_t off = (size_t)(row0 + ai * HALF + m * 16) * 1024 + col0; const float rb = rs[(ai * HALF + m * 16) * 2]; const float sx = xs[gi];
#pragma unroll
                for (int bj = 0; bj < 2; ++bj) { const size_t p = off + bj * HALF; const u32x4 x = xr[pr & 1][g * 2 + bj];
                    f32x4 x0, x1; x0[0] = __builtin_bit_cast(float, x.x << 16); x0[1] = __builtin_bit_cast(float, x.x & 0xffff0000u); x0[2] = __builtin_bit_cast(float, x.y << 16); x0[3] = __builtin_bit_cast(float, x.y & 0xffff0000u);
                    x1[0] = __builtin_bit_cast(float, x.z << 16); x1[1] = __builtin_bit_cast(float, x.z & 0xffff0000u); x1[2] = __builtin_bit_cast(float, x.w << 16); x1[3] = __builtin_bit_cast(float, x.w & 0xffff0000u);
                    const f32x4 v0 = x0 * sx + acc[ai][bj][m][0] * rb, v1 = x1 * sx + acc[ai][bj][m][1] * rb;
                    u32x4 o; o.x = cvt_pk_bf16(v0[0], v0[1]); o.y = cvt_pk_bf16(v0[2], v0[3]); o.z = cvt_pk_bf16(v1[0], v1[1]); o.w = cvt_pk_bf16(v1[2], v1[3]);
                    *(PG8_GAS u32x4*)(x1b + p) = o; } }
            asm volatile("" ::: "memory"); }
    }
};
struct EpiGateUp2 {
    static constexpr bool PERM = true, AFTER_DRAIN = false, MIDHOOK = false;
    bf16_t* H; const ListEnt* lists; const PG8_LAS int* cnt;
    __device__ __forceinline__ void operator()(const f32x4 (&acc)[2][2][4][2], const Unit& u, int wr, int wc, int fr, int fq) const {
        const int rt0 = wr * 64 + fr; const int col0 = (u.q >> 1) * 256 + (u.q & 1) * 128 + wc * 32 + 8 * fq; const int g = u.g0; const int n_g = cnt[g]; const bool hiexp = (u.q >> 1) != 0;
        const ListEnt* lg = lists + (size_t)g * 65536 + u.g1 * 256;
        float wv[8], rv[8];
#pragma unroll
        for (int i = 0; i < 8; ++i) { const int rt = rt0 + (i >> 2) * HALF + (i & 3) * 16; f32x4 le = {0.f, 0.f, 0.f, 0.f}; if ((u.g1 * 256 + rt) < n_g) le = *(const PG8_GAS f32x4*)((const PG8_GAS ListEnt*)lg + rt); wv[i] = hiexp ? le[2] : le[1]; rv[i] = le[3]; }
#pragma unroll
        for (int ai = 0; ai < 2; ++ai)
#pragma unroll
            for (int m = 0; m < 4; ++m) { const int rt = rt0 + ai * HALF + m * 16; const bool valid = (u.g1 * 256 + rt) < n_g;
                const float w = wv[ai * 4 + m], rsd = rv[ai * 4 + m];
                unsigned pk[2];
#pragma unroll
                for (int n = 0; n < 2; ++n) { const f32x4 gv = acc[ai][0][m][n], uv = acc[ai][1][m][n]; float h[4];
#pragma unroll
                    for (int j = 0; j < 4; ++j) { const float a = gv[j] * rsd; const float s = a * __builtin_amdgcn_rcpf(1.0f + __builtin_amdgcn_exp2f(-1.4426950408889634f * a)); h[j] = valid ? s * (uv[j] * rsd) * w : 0.f; }
                    { int w_ = 0; w_ = __builtin_amdgcn_cvt_pk_fp8_f32(h[0] * 8.0f, h[1] * 8.0f, w_, false); w_ = __builtin_amdgcn_cvt_pk_fp8_f32(h[2] * 8.0f, h[3] * 8.0f, w_, true); pk[n] = (unsigned)w_; } }
                typedef unsigned u32x2h_ __attribute__((ext_vector_type(2))); u32x2h_ o; o.x = pk[0]; o.y = pk[1];
                *(PG8_GAS u32x2h_*)((PG8_GAS unsigned char*)H + (size_t)(u.pm * BM + rt) * 512 + col0) = o; }
    }
};
struct EpiDown2 {
    static constexpr bool PERM = true, AFTER_DRAIN = false, MIDHOOK = false;
    float* out; const bf16_t* x1b; const ListEnt* lists; const PG8_LAS int* cnt;
    __device__ __forceinline__ void operator()(const f32x4 (&acc)[2][2][4][2], const Unit& u, int wr, int wc, int fr, int fq) const {
        const int rt0 = wr * 64 + fr; const int col0 = u.q * 256 + wc * 32 + 8 * fq; const int g = u.g0; const int n_g = cnt[g];
        const ListEnt* lg = lists + (size_t)g * 65536 + u.g1 * 256;
        int tokv[8];
#pragma unroll
        for (int i = 0; i < 8; ++i) { const int rt = rt0 + (i >> 2) * HALF + (i & 3) * 16; tokv[i] = ((u.g1 * 256 + rt) < n_g) ? ((const PG8_GAS ListEnt*)lg)[rt].tok : -1; }
#pragma unroll
        for (int ai = 0; ai < 2; ++ai) {
            u32x4 xb[4][2];
#pragma unroll
            for (int m = 0; m < 4; ++m)
#pragma unroll
                for (int bj = 0; bj < 2; ++bj) { const int tok = tokv[ai * 4 + m]; xb[m][bj] = (u32x4){0u, 0u, 0u, 0u}; if (tok >= 0) xb[m][bj] = *(const PG8_GAS u32x4*)((const PG8_GAS bf16_t*)x1b + (size_t)tok * 1024 + col0 + bj * HALF); }
#pragma unroll
            for (int m = 0; m < 4; ++m) { const int tok = tokv[ai * 4 + m];
                if (tok >= 0) { PG8_GAS float* orow = (PG8_GAS float*)out + (size_t)tok * 1024 + col0;
#pragma unroll
                    for (int bj = 0; bj < 2; ++bj) { PG8_GAS float* p = orow + bj * HALF; const u32x4 x = xb[m][bj];
                        f32x4 a, b; a[0] = __builtin_bit_cast(float, x.x << 16); a[1] = __builtin_bit_cast(float, x.x & 0xffff0000u); a[2] = __builtin_bit_cast(float, x.y << 16); a[3] = __builtin_bit_cast(float, x.y & 0xffff0000u);
                        b[0] = __builtin_bit_cast(float, x.z << 16); b[1] = __builtin_bit_cast(float, x.z & 0xffff0000u); b[2] = __builtin_bit_cast(float, x.w << 16); b[3] = __builtin_bit_cast(float, x.w & 0xffff0000u);
                        *(PG8_GAS f32x4*)p = a + acc[ai][bj][m][0]; *(PG8_GAS f32x4*)(p + 4) = b + acc[ai][bj][m][1]; } } }
            asm volatile("" ::: "memory"); }
    }
};
struct ClsOrder {
    const PG8_LAS int* tp; const PG8_LAS int* ptab; int mode, G, c; const ListEnt* lists; const PG8_LAS int* cnt;
    __device__ __forceinline__ int arow(const Unit& u, int row) const { const unsigned pos = (unsigned)(u.g1 * 256 + row); const unsigned n = (unsigned)cnt[u.g0]; const PG8_GAS ListEnt* lg = (const PG8_GAS ListEnt*)lists + (size_t)u.g0 * 65536; return lg[pos < n ? pos : 0u].tok; }
    __device__ __forceinline__ bool next(int i, Unit& u) const {
        const int nrb = tp[112]; const long L = (long)i * G + c; if (L >= (long)nrb * 4) return false;
        const int rbt = (int)(L >> 2), q = (int)(L & 3);
        int g = 0;
#pragma unroll
        for (int s = 64; s >= 1; s >>= 1) { const int gg = g + s; if (gg < 112 && tp[gg] <= rbt) g = gg; }
        const int grp = g / 28, pr = ptab[g - grp * 28], lo = pr & 15, hi = pr >> 4;
        u.pm = rbt; u.g0 = g; u.g1 = rbt - tp[g]; u.q = q;
        if (mode == 0) { u.pn = (grp * 8 + ((q >> 1) ? hi : lo)) * 2 + (q & 1); u.pn2 = 0; } else { u.pn = (grp * 8 + lo) * 4 + q; u.pn2 = (grp * 8 + hi) * 4 + q; }
        return true;
    }
    __device__ __forceinline__ void a_ready(const Unit&) const {}
    __device__ __forceinline__ void done(const Unit&) const {}
};

template <class Epi, class Sched, bool ALIGN_EPI = false, bool SP2 = false, bool GATHER = false, bool KSPLIT = false, bool F8 = false, int SCW = 0x7a7a7a7a, int SCA = 0x7f7f7f7f, bool F8ASM = false>
__device__ __forceinline__ void gemm_phase(PG8_LAS unsigned char* lds, const Gemm g, const Sched& S, const Epi& E) {
    const int tid = threadIdx.x, wid = __builtin_amdgcn_readfirstlane(tid >> 6), lane = tid & 63, wr = wid >> 2, wc = wid & 3, fr = lane & 15, fq = lane >> 4;
    const int K = g.K, nt = K / BK;
    const int PB = KSPLIT ? (K >> 1) : K;
    static_assert(!GATHER || SP2, "gathered A rows: SP2 loop only");
    unsigned voffA[2], voffB[2];
#pragma unroll
    for (int i = 0; i < 2; ++i) { int R, C; stage_rc(tid * 16 + i * 8192, R, C); const int Rb = Epi::PERM ? ((R & ~31) + perm32(R & 31)) : R;
        voffA[i] = (unsigned)(R * K + C) * 2u; voffB[i] = (unsigned)(Rb * PB + C) * 2u; }
    const size_t kstep = (size_t)(BK * 2);
    const size_t hstep = (size_t)HALF * K * 2;
    const size_t tstep = 2 * hstep;
    const size_t hstepB = (size_t)HALF * PB * 2, tstepB = 2 * hstepB;
    const unsigned ldsw = (unsigned)wid * 1024u;
    const int aoff = lds_byte(wr * 64 + fr, fq * 8), boff = lds_byte(wc * 32 + fr, fq * 8);
#define PG8_SA(b, h) (((b) * 2 + (h)) * HTB)
#define PG8_SB(b, h) ((4 + (b) * 2 + (h)) * HTB)
#define PG8_STAGE(bufoff, gbase, voff) do { _Pragma("unroll") for (int _i = 0; _i < 2; ++_i) \
        __builtin_amdgcn_global_load_lds((const unsigned*)((const char*)(gbase) + (voff)[_i]), (PG8_LAS unsigned*)(lds + (bufoff) + ldsw + _i * 8192), 16, 0, 0); } while (0)
#define PG8_LDA(dst, b, h) do { _Pragma("unroll") for (int m = 0; m < 4; ++m) _Pragma("unroll") for (int k = 0; k < 2; ++k) dst[m][k] = *(const PG8_LAS bf16x8*)(lds + PG8_SA(b, h) + aoff + m * 2048 + k * 1024); } while (0)
#define PG8_LDB(dst, b, h) do { _Pragma("unroll") for (int n = 0; n < 2; ++n) _Pragma("unroll") for (int k = 0; k < 2; ++k) dst[n][k] = *(const PG8_LAS bf16x8*)(lds + PG8_SB(b, h) + boff + n * 2048 + k * 1024); } while (0)
#define PG8_MMA(ai, bj, At, Bt) do { __builtin_amdgcn_s_setprio(1); _Pragma("unroll") for (int m = 0; m < 4; ++m) _Pragma("unroll") for (int n = 0; n < 2; ++n) { \
        if constexpr (F8) { typedef int v4i_ __attribute__((ext_vector_type(4))); typedef int v8i_ __attribute__((ext_vector_type(8))); \
            const v8i_ w8_ = __builtin_shufflevector(__builtin_bit_cast(v4i_, Bt[n][0]), __builtin_bit_cast(v4i_, Bt[n][1]), 0, 1, 2, 3, 4, 5, 6, 7); \
            const v8i_ a8_ = __builtin_shufflevector(__builtin_bit_cast(v4i_, At[m][0]), __builtin_bit_cast(v4i_, At[m][1]), 0, 1, 2, 3, 4, 5, 6, 7); \
            if constexpr (F8ASM) { asm volatile("v_mfma_scale_f32_16x16x128_f8f6f4 %0, %1, %2, %0, %3, %4 op_sel_hi:[0,0,0]" : "+v"(acc[ai][bj][m][n]) : "v"(w8_), "v"(a8_), "v"(SCW), "v"(SCA)); }     \
            else acc[ai][bj][m][n] = __builtin_amdgcn_mfma_scale_f32_16x16x128_f8f6f4(w8_, a8_, acc[ai][bj][m][n], 0, 0, 0, SCW, 0, SCA); } \
        else { _Pragma("unroll") for (int k = 0; k < 2; ++k) acc[ai][bj][m][n] = __builtin_amdgcn_mfma_f32_16x16x32_bf16(Bt[n][k], At[m][k], acc[ai][bj][m][n], 0, 0, 0); } } \
        __builtin_amdgcn_s_setprio(0); } while (0)
#define PG8_WAIT_V(n) asm volatile("s_waitcnt vmcnt(" #n ")" ::: "memory")
#define PG8_WAIT_L(n) asm volatile("s_waitcnt lgkmcnt(" #n ")" ::: "memory")
#define PG8_BAR __builtin_amdgcn_s_barrier()
#define PG8_SCHED __builtin_amdgcn_sched_barrier(0)
#define PG8_STG_A(b, h, ptr, arr) do { if constexpr (GATHER) { PG8_STAGE(PG8_SA(b, h), (ptr), (arr)[h]); } else { PG8_STAGE(PG8_SA(b, h), (ptr) + ((h) ? hstep : 0), voffA); } } while (0)
    unsigned cv[2][2] = {{0u, 0u}, {0u, 0u}}, nvp[2] = {0u, 0u};
#define PG8_GROWS(dst, unit) do { if constexpr (GATHER) { _Pragma("unroll") for (int _h = 0; _h < 2; ++_h) _Pragma("unroll") for (int _i = 0; _i < 2; ++_i) { int R_, C_; stage_rc(tid * 16 + _i * 8192, R_, C_); \
        dst[_h][_i] = (unsigned)S.arow(unit, _h * HALF + R_) * (unsigned)(K * 2) + (unsigned)(C_ * 2); } } } while (0)
    Unit cur, nxt; int ui = 0;
    if (!S.next(0, cur)) return;
    PG8_GROWS(cv, cur);
#define PG8_GROWS_P(unit) do { _Pragma("unroll") for (int _i = 0; _i < 2; ++_i) { int R_, C_; stage_rc(tid * 16 + _i * 8192, R_, C_); nvp[_i] = (unsigned)S.arow(unit, R_) | ((unsigned)S.arow(unit, HALF + R_) << 16); } } while (0)
#define PG8_UNPACK_NV() do { _Pragma("unroll") for (int _i = 0; _i < 2; ++_i) { int R_, C_; stage_rc(tid * 16 + _i * 8192, R_, C_); cv[0][_i] = (nvp[_i] & 0xffffu) * (unsigned)(K * 2) + (unsigned)(C_ * 2); cv[1][_i] = (nvp[_i] >> 16) * (unsigned)(K * 2) + (unsigned)(C_ * 2); } } while (0)
    f32x4 acc[2][2][4][2];
#pragma unroll
    for (int a = 0; a < 2; ++a)
#pragma unroll
        for (int b = 0; b < 2; ++b)
#pragma unroll
            for (int m = 0; m < 4; ++m)
#pragma unroll
                for (int n = 0; n < 2; ++n) acc[a][b][m][n] = (f32x4){0.f, 0.f, 0.f, 0.f};
    bf16x8 At[4][2], B0[2][2], B1[2][2];
    const char* cA = (const char*)g.A + (GATHER ? (size_t)0 : (size_t)cur.pm * tstep); const char* cB = (const char*)g.Bt + (size_t)cur.pn * tstepB; const char* cB2 = KSPLIT ? (const char*)g.Bt + (size_t)cur.pn2 * tstepB : cB;
    S.a_ready(cur);
    if constexpr (SP2) {
        PG8_STAGE(PG8_SB(0, 0), cB, voffB); PG8_STAGE(PG8_SB(0, 1), cB + hstepB, voffB); PG8_STG_A(0, 0, cA, cv); PG8_STG_A(0, 1, cA, cv);
        if (wr == 1) PG8_BAR;
        PG8_WAIT_V(2); PG8_BAR;
        PG8_STAGE(PG8_SB(1, 0), cB + kstep, voffB); PG8_STG_A(1, 0, cA + kstep, cv); PG8_STAGE(PG8_SB(1, 1), cB + hstepB + kstep, voffB);
        PG8_WAIT_V(6); PG8_BAR;
    } else {
        PG8_STAGE(PG8_SB(0, 0), cB, voffB); PG8_STAGE(PG8_SA(0, 0), cA, voffA); PG8_STAGE(PG8_SB(0, 1), cB + hstepB, voffB); PG8_STAGE(PG8_SA(0, 1), cA + hstep, voffA);
        if (wr == 1) PG8_BAR;
        PG8_WAIT_V(4); PG8_BAR;
        PG8_STAGE(PG8_SB(1, 0), cB + kstep, voffB); PG8_STAGE(PG8_SA(1, 0), cA + kstep, voffA); PG8_STAGE(PG8_SB(1, 1), cB + hstepB + kstep, voffB);
        PG8_WAIT_V(6); PG8_BAR;
    }
    for (;;) {
        const bool has_next = S.next(ui + 1, nxt);
        const char* nA = (has_next && !GATHER) ? (const char*)g.A + (size_t)nxt.pm * tstep : cA; const char* nB = has_next ? (const char*)g.Bt + (size_t)nxt.pn * tstepB : cB; const char* nB2 = (KSPLIT && has_next) ? (const char*)g.Bt + (size_t)nxt.pn2 * tstepB : cB2;
        if constexpr (GATHER) { if (has_next) { PG8_GROWS_P(nxt); } else { PG8_GROWS_P(cur); } }
        const int tspan = Epi::MIDHOOK ? (nt >> 1) : nt;
        for (int t0 = 0; t0 < nt; t0 += tspan) {
        if constexpr (Epi::MIDHOOK) { if (t0 != 0) E.mid(acc, cur, wr, wc, fr, fq); }
        for (int t = t0; t < t0 + tspan; t += 2) {
            const bool last = (t == nt - 2);
            const char* a1 = cA + (size_t)(t + 1) * kstep;
            const char* a2 = last ? nA : cA + (size_t)(t + 2) * kstep; const char* b2 = last ? nB : ((KSPLIT && t + 2 >= (nt >> 1)) ? cB2 + (size_t)(t + 2 - (nt >> 1)) * kstep : cB + (size_t)(t + 2) * kstep);
            const char* a3 = a2 + kstep; const char* b3 = b2 + kstep;
            if (last && has_next) S.a_ready(nxt);
            if constexpr (SP2) {
            PG8_LDB(B0, 0, 0); PG8_LDB(B1, 0, 1); PG8_SCHED; PG8_LDA(At, 0, 0); PG8_STG_A(1, 1, a1, cv);
            if constexpr (GATHER) { if (last) { PG8_UNPACK_NV(); } }
            PG8_WAIT_V(8); PG8_WAIT_L(0); PG8_BAR; PG8_MMA(0, 0, At, B0); PG8_MMA(0, 1, At, B1); PG8_BAR; PG8_SCHED;
            PG8_LDA(At, 0, 1); PG8_STAGE(PG8_SB(0, 0), b2, voffB); PG8_STAGE(PG8_SB(0, 1), b2 + hstepB, voffB); PG8_STG_A(0, 0, a2, cv);
            PG8_WAIT_V(8); PG8_WAIT_L(0); PG8_BAR; PG8_MMA(1, 0, At, B0); PG8_MMA(1, 1, At, B1); PG8_BAR; PG8_SCHED;
            PG8_LDB(B0, 1, 0); PG8_LDB(B1, 1, 1); PG8_SCHED; PG8_LDA(At, 1, 0); PG8_STG_A(0, 1, a2, cv);
            PG8_WAIT_V(8); PG8_WAIT_L(0); PG8_BAR; PG8_MMA(0, 0, At, B0); PG8_MMA(0, 1, At, B1); PG8_BAR; PG8_SCHED;
            PG8_LDA(At, 1, 1); PG8_STAGE(PG8_SB(1, 0), b3, voffB); PG8_STAGE(PG8_SB(1, 1), b3 + hstepB, voffB); PG8_STG_A(1, 0, a3, cv);
            PG8_WAIT_V(8); PG8_WAIT_L(0); PG8_BAR; PG8_MMA(1, 0, At, B0); PG8_MMA(1, 1, At, B1); PG8_BAR; PG8_SCHED;
            } else {
            PG8_LDB(B0, 0, 0); PG8_SCHED; PG8_LDA(At, 0, 0); PG8_STAGE(PG8_SA(1, 1), a1 + hstep, voffA);
            PG8_WAIT_L(8); PG8_BAR; PG8_WAIT_L(0); PG8_MMA(0, 0, At, B0); PG8_BAR; PG8_SCHED;
            PG8_LDB(B1, 0, 1); PG8_STAGE(PG8_SB(0, 0), b2, voffB);
            PG8_BAR; PG8_WAIT_L(0); PG8_MMA(0, 1, At, B1); PG8_BAR;
            PG8_LDA(At, 0, 1); PG8_STAGE(PG8_SA(0, 0), a2, voffA);
            PG8_BAR; PG8_WAIT_L(0); PG8_MMA(1, 0, At, B0); PG8_BAR; PG8_SCHED;
            PG8_STAGE(PG8_SB(0, 1), b2 + hstepB, voffB);
            PG8_WAIT_V(6); PG8_BAR; PG8_MMA(1, 1, At, B1); PG8_BAR;
            PG8_LDB(B0, 1, 0); PG8_SCHED; PG8_LDA(At, 1, 0); PG8_STAGE(PG8_SA(0, 1), a2 + hstep, voffA);
            PG8_WAIT_L(8); PG8_BAR; PG8_WAIT_L(0); PG8_MMA(0, 0, At, B0); PG8_BAR; PG8_SCHED;
            PG8_LDB(B1, 1, 1); PG8_STAGE(PG8_SB(1, 0), b3, voffB);
            PG8_BAR; PG8_WAIT_L(0); PG8_MMA(0, 1, At, B1); PG8_BAR;
            PG8_LDA(At, 1, 1); PG8_STAGE(PG8_SA(1, 0), a3, voffA);
            PG8_BAR; PG8_WAIT_L(0); PG8_MMA(1, 0, At, B0); PG8_BAR; PG8_SCHED;
            PG8_STAGE(PG8_SB(1, 1), b3 + hstepB, voffB);
            PG8_WAIT_V(6); PG8_BAR; PG8_MMA(1, 1, At, B1); PG8_BAR;
            }
        }
        }
        if constexpr (ALIGN_EPI) { if (wr == 0) PG8_BAR; }
        if constexpr (!Epi::AFTER_DRAIN) { int t2 = threadIdx.x; asm volatile("" : "+v"(t2));
            const int wid2 = __builtin_amdgcn_readfirstlane(t2 >> 6), lane2 = t2 & 63; E(acc, cur, wid2 >> 2, wid2 & 3, lane2 & 15, lane2 >> 4); S.done(cur); }
        if (!has_next) break;
#pragma unroll
        for (int a = 0; a < 2; ++a)
#pragma unroll
            for (int b = 0; b < 2; ++b)
#pragma unroll
                for (int m = 0; m < 4; ++m)
#pragma unroll
                    for (int n = 0; n < 2; ++n) acc[a][b][m][n] = (f32x4){0.f, 0.f, 0.f, 0.f};
        cur = nxt; cA = nA; cB = nB; cB2 = nB2; ++ui;
        if constexpr (ALIGN_EPI) { if (wr == 1) PG8_BAR; }
    }
    PG8_WAIT_V(0);
    if constexpr (!ALIGN_EPI) { if (wr == 0) PG8_BAR; }
    PG8_BAR;
    if constexpr (Epi::AFTER_DRAIN) { E.fused(acc, cur, wr, wc, fr, fq, lds, wid, lane); S.done(cur); }
#undef PG8_SA
#undef PG8_SB
#undef PG8_STAGE
#undef PG8_LDA
#undef PG8_LDB
#undef PG8_MMA
#undef PG8_WAIT_V
#undef PG8_WAIT_L
#undef PG8_BAR
#undef PG8_SCHED
#undef PG8_STG_A
#undef PG8_GROWS
#undef PG8_GROWS_P
#undef PG8_UNPACK_NV
}
}
constexpr int BATCH = 32, SEQ = 2048, D = 1024, T = BATCH * SEQ;
constexpr int NPROJ = 2048;
constexpr int CQ = 0, CKV = 256, CPE = 384, CMQ = 416, CMK = 928, CMV = 1440, NPROJ_REAL = 1952;
constexpr int NH = 8;
constexpr float EPS = 1e-6f;
constexpr float LOG2E = 1.4426950408889634f;
constexpr float C2A = 0.10206207261596575f * LOG2E;
constexpr float C2B = 0.125f * LOG2E;
constexpr int NCLS = 112;
constexpr int LIST_CAP = 65536;

constexpr size_t MiB = 1u << 20;
constexpr size_t WS_CTL = 0, CTL_ZERO_BYTES = 2 * MiB;
constexpr size_t WS_KMEAN = 1 * MiB;
constexpr size_t WS_WIN = 2 * MiB;
constexpr size_t WS_WQ = 6 * MiB;
constexpr size_t WS_WKV = 7 * MiB;
constexpr size_t WS_WO = 8 * MiB;
constexpr size_t WS_WGU = 10 * MiB;
constexpr size_t WS_WD = 42 * MiB;
constexpr size_t WS_ROPE = 58 * MiB;
constexpr size_t WS_WRE = 59 * MiB;
constexpr size_t WS_XRS = 62 * MiB;
constexpr size_t WS_O8 = 320 * MiB;
constexpr size_t WS_SSQ = 60 * MiB;
constexpr size_t WS_XN = 64 * MiB;
constexpr size_t WS_VB = 192 * MiB;
constexpr size_t WS_Y0 = 64 * MiB;
constexpr size_t WS_X1B = 768 * MiB;
constexpr size_t WS_YH = 256 * MiB;
constexpr size_t WS_QB = 448 * MiB;
constexpr size_t WS_KB = 512 * MiB;
constexpr size_t WS_QA = 584 * MiB;
constexpr size_t WS_VA = 680 * MiB;
constexpr size_t WS_KA = 808 * MiB;
constexpr size_t WS_QLN = 904 * MiB;
constexpr size_t WS_KVLN = 936 * MiB;
constexpr size_t WS_LISTS = 648 * MiB;
constexpr size_t WS_OSSQ = 904 * MiB;
constexpr size_t WS_END = 1024 * MiB;
constexpr size_t WS_H = WS_KB;
constexpr int CW_TMO = 0, CW_CODE = 1;
constexpr int CW_BAR = 4096;
constexpr int CW_GCNT = 16384;

constexpr int RING_BYTES = 131072;
constexpr int P8_XT = 0, P8_XT_WAVE = 32 * 68 * 4, P8_WC = 69632, P8_WRG = 86016, P8_RT = 102400;
constexpr int LDSCTL_OFF = 155648, LDS_BYTES = 159744;
constexpr int TP_OFF = LDSCTL_OFF + 256, CNT_OFF = LDSCTL_OFF + 768, PT_OFF = LDSCTL_OFF + 1280;

#define GAS __attribute__((address_space(1)))
#define LAS __attribute__((address_space(3)))
typedef unsigned short bf16;
typedef unsigned v4u __attribute__((ext_vector_type(4)));
typedef unsigned v2u __attribute__((ext_vector_type(2)));
typedef float f32x4 __attribute__((ext_vector_type(4)));
typedef float f32x2 __attribute__((ext_vector_type(2)));
typedef float f32x16 __attribute__((ext_vector_type(16)));
typedef short bf16x8 __attribute__((ext_vector_type(8)));
typedef short s16x4 __attribute__((ext_vector_type(4)));
typedef GAS unsigned gu32;
#define RLX_AGENT __ATOMIC_RELAXED, __HIP_MEMORY_SCOPE_AGENT
__device__ __forceinline__ unsigned f2bf(float f) { unsigned u = __builtin_bit_cast(unsigned, f); return (u + 0x7fffu + ((u >> 16) & 1u)) >> 16; }
__device__ __forceinline__ unsigned pk2(float lo, float hi) { return f2bf(lo) | (f2bf(hi) << 16); }
__device__ __forceinline__ float bflo(unsigned w) { return __builtin_bit_cast(float, w << 16); }
__device__ __forceinline__ float bfhi(unsigned w) { return __builtin_bit_cast(float, w & 0xffff0000u); }
__device__ __forceinline__ float wave_sum(float v) {
#pragma unroll
    for (int o = 1; o < 64; o <<= 1) v += __shfl_xor(v, o);
    return v;
}
__device__ __forceinline__ float sum8(float v) { v += __shfl_xor(v, 1); v += __shfl_xor(v, 2); v += __shfl_xor(v, 4); return v; }

#define XB_TMO      128
#define XB_XCNT(j)  (256  + 64 * (j))
#define XB_XSUB(j)  (1280 + 64 * (j))
#define XB_XGEN(j)  (2304 + 64 * (j))
#define XB_TOP      3328
#define XB_TOPGEN   3392
#define XCD_BAR_WORDS 3456
#define XB_SPIN_CAP (1u << 18)

__device__ __forceinline__ unsigned xb_ld(unsigned* p)              { return __hip_atomic_load(p, __ATOMIC_RELAXED, __HIP_MEMORY_SCOPE_AGENT); }
__device__ __forceinline__ unsigned xb_add(unsigned* p, unsigned v) { return __hip_atomic_fetch_add(p, v, __ATOMIC_RELAXED, __HIP_MEMORY_SCOPE_AGENT); }
__device__ __forceinline__ unsigned xb_xcc_id() { return (unsigned)__builtin_amdgcn_s_getreg((3 << 11) | 20) & 0xFu; }
#define XB_SPIN(cond, bar) do { unsigned _sp = 0; while (cond) { __builtin_amdgcn_s_sleep(1); \
    if ((++_sp & 255u) == 0u) { if (xb_ld(&(bar)[XB_TMO])) break; if (_sp > XB_SPIN_CAP) { atomicAdd(&(bar)[XB_TMO], 1u); break; } } } } while (0)

struct XcdBarrier {
    unsigned* bar; unsigned x;
    volatile LAS unsigned* st;
};

__device__ __forceinline__ XcdBarrier xcd_barrier_post(unsigned* bar, volatile LAS unsigned* st) {
    XcdBarrier b; b.bar = bar; b.x = xb_xcc_id(); b.st = st;
    if (threadIdx.x == 0) (void)xb_add(&bar[XB_XCNT(b.x)], 1u);
    return b;
}
__device__ __forceinline__ void xcd_barrier_complete(unsigned* bar, unsigned x, unsigned& nloc, unsigned& nx) {
    const unsigned G = gridDim.x * gridDim.y * gridDim.z;
    unsigned sum, cnt, mine, sp = 0u;
    for (;;) {
        sum = 0u; cnt = 0u; mine = 0u;
#pragma unroll
        for (unsigned j = 0; j < 16; ++j) { const unsigned c = xb_ld(&bar[XB_XCNT(j)]); sum += c; cnt += (c > 0u) ? 1u : 0u; mine = (j == x) ? c : mine; }
        if (sum == G) break;
        __builtin_amdgcn_s_sleep(1);
        if ((++sp & 255u) == 0u) { if (xb_ld(&bar[XB_TMO])) break; if (sp > XB_SPIN_CAP) { atomicAdd(&bar[XB_TMO], 1u); break; } }
    }
    nloc = mine > 0u ? mine : 1u; nx = cnt > 0u ? cnt : 1u;
}

__device__ __forceinline__ void xcd_barrier(const XcdBarrier& b) {
    asm volatile("s_waitcnt vmcnt(0)" ::: "memory");
    __syncthreads();
    if (threadIdx.x == 0) {
        unsigned* bar = b.bar;
        __builtin_amdgcn_s_waitcnt(0);
        unsigned nloc = b.st[0], nx = b.st[1];
        if (nloc == 0u) { xcd_barrier_complete(bar, b.x, nloc, nx); b.st[0] = nloc; b.st[1] = nx; }
        const unsigned old = xb_add(&bar[XB_XSUB(b.x)], 1u);
        const unsigned gen = old / nloc;
        if (old + 1u == (gen + 1u) * nloc) {
            __builtin_amdgcn_fence(__ATOMIC_RELEASE, "agent");
            asm volatile("s_waitcnt vmcnt(0)" ::: "memory");
            const unsigned og = xb_add(&bar[XB_TOP], 1u);
            const unsigned tg = og / nx;
            if (og + 1u == (tg + 1u) * nx) xb_add(&bar[XB_TOPGEN], 1u);
            else XB_SPIN(xb_ld(&bar[XB_TOPGEN]) == tg, bar);
            __builtin_amdgcn_fence(__ATOMIC_ACQUIRE, "agent");
            xb_add(&bar[XB_XGEN(b.x)], 1u);
            asm volatile("s_waitcnt vmcnt(0)" ::: "memory");
        } else {
            XB_SPIN(xb_ld(&bar[XB_XGEN(b.x)]) == gen, bar);
            __builtin_amdgcn_fence(__ATOMIC_ACQUIRE, "agent");
            asm volatile("s_waitcnt vmcnt(0)" ::: "memory");
        }
    }
    __syncthreads();
}


__device__ __forceinline__ float att_max3(float a, float b, float c) { float r; asm("v_max3_f32 %0, %1, %2, %3" : "=v"(r) : "v"(a), "v"(b), "v"(c)); return r; }
__device__ __forceinline__ unsigned pk4_fp8(float a, float b, float c, float d) { int w = 0; w = __builtin_amdgcn_cvt_pk_fp8_f32(a, b, w, false); w = __builtin_amdgcn_cvt_pk_fp8_f32(c, d, w, true); return (unsigned)w; }
struct AttOwn { static constexpr bool v = true; }; struct AttPast { static constexpr bool v = false; };
template <int DQK, bool MOBA, bool QFIN>
__device__ __forceinline__ void attn_unit(LAS unsigned char* lds, const float* qgain_, const float* ropeR_, const bf16* Qg_, int qpitch, const bf16* Kg_, int kpitch, const bf16* Vg_, int vpitch, bf16* Og_, int opitch, float* ossq_, int qb, const float* kmp_, int kmstride) {
    const GAS bf16* Qg = (const GAS bf16*)Qg_; const GAS bf16* Kg = (const GAS bf16*)Kg_; const GAS bf16* Vg = (const GAS bf16*)Vg_; GAS bf16* Og = (GAS bf16*)Og_; const GAS float* kmp = (const GAS float*)kmp_;
    constexpr int ND = DQK / 16, KSTR = DQK * 2 + 16, KBUF = 64 * KSTR, NCH = DQK / 8, VBUF = 8192;
    int tid = threadIdx.x; asm volatile("" : "+v"(tid));
    const int lane = tid & 63, r32 = lane & 31, hi = lane >> 5; const int wid = __builtin_amdgcn_readfirstlane(tid >> 6);
    LAS unsigned char* Kl = lds; LAS unsigned char* Vl = lds + 2 * KBUF;
    const GAS bf16* qrow = Qg + (size_t)(qb * 256 + wid * 32 + r32) * qpitch;
    bf16x8 qf[ND];
#pragma unroll
    for (int d0 = 0; d0 < ND; ++d0) qf[d0] = *(const GAS bf16x8*)(qrow + 16 * d0 + 8 * hi);
    if (QFIN) {
        const GAS float* qg = (const GAS float*)qgain_; const GAS float* rr = (const GAS float*)ropeR_; const int pos = qb * 256 + wid * 32 + r32;
        float x[ND][8]; float ss = 0.f;
#pragma unroll
        for (int d0 = 0; d0 < ND; ++d0) { const v4u w = __builtin_bit_cast(v4u, qf[d0]);
            x[d0][0] = bflo(w.x); x[d0][1] = bfhi(w.x); x[d0][2] = bflo(w.y); x[d0][3] = bfhi(w.y); x[d0][4] = bflo(w.z); x[d0][5] = bfhi(w.z); x[d0][6] = bflo(w.w); x[d0][7] = bfhi(w.w);
#pragma unroll
            for (int j = 0; j < 8; ++j) ss += x[d0][j] * x[d0][j]; }
        ss += __shfl_xor(ss, 32);
        const float rs = __builtin_amdgcn_rsqf(ss * (1.0f / (float)DQK) + EPS) * C2A;
#pragma unroll
        for (int d0 = 0; d0 < ND; ++d0) { const f32x4 ga = *(const GAS f32x4*)(qg + 16 * d0 + 8 * hi), gb = *(const GAS f32x4*)(qg + 16 * d0 + 8 * hi + 4);
#pragma unroll
            for (int j = 0; j < 4; ++j) { x[d0][j] *= rs * ga[j]; x[d0][4 + j] *= rs * gb[j]; } }
        if (ND == 6) { const f32x4 ca = *(const GAS f32x4*)(rr + pos * 16 + 8 * hi), cb = *(const GAS f32x4*)(rr + pos * 16 + 8 * hi + 4), sa = *(const GAS f32x4*)(rr + SEQ * 16 + pos * 16 + 8 * hi), sb = *(const GAS f32x4*)(rr + SEQ * 16 + pos * 16 + 8 * hi + 4);
#pragma unroll
            for (int j = 0; j < 8; ++j) { const float c = j < 4 ? ca[j & 3] : cb[j & 3], s = j < 4 ? sa[j & 3] : sb[j & 3]; const float y1 = x[ND - 2][j], y2 = x[ND - 1][j]; x[ND - 2][j] = y1 * c - y2 * s; x[ND - 1][j] = y2 * c + y1 * s; } }
#pragma unroll
        for (int d0 = 0; d0 < ND; ++d0) { v4u w; w.x = pg8::cvt_pk_bf16(x[d0][0], x[d0][1]); w.y = pg8::cvt_pk_bf16(x[d0][2], x[d0][3]); w.z = pg8::cvt_pk_bf16(x[d0][4], x[d0][5]); w.w = pg8::cvt_pk_bf16(x[d0][6], x[d0][7]); qf[d0] = __builtin_bit_cast(bf16x8, w); }
    }
    unsigned sel = 0xffu;
    if (MOBA && qb > 3) {
        float gate[8];
#pragma unroll
        for (int n = 0; n < 8; ++n) { float a = 0.f;
            if (n < qb) {
#pragma unroll
                for (int d0 = 0; d0 < ND; ++d0) { const GAS float* km = kmp + (size_t)n * kmstride + 16 * d0 + 8 * hi; const f32x4 k0 = *(const GAS f32x4*)km, k1 = *(const GAS f32x4*)(km + 4);
                    const v4u qq = __builtin_bit_cast(v4u, qf[d0]);
                    a += bflo(qq.x) * k0[0] + bfhi(qq.x) * k0[1] + bflo(qq.y) * k0[2] + bfhi(qq.y) * k0[3] + bflo(qq.z) * k1[0] + bfhi(qq.z) * k1[1] + bflo(qq.w) * k1[2] + bfhi(qq.w) * k1[3]; }
                a += __shfl_xor(a, 32); }
            gate[n] = a; asm volatile("" : "+v"(a) :: "memory"); }
        sel = 0u;
#pragma unroll
        for (int n = 0; n < 8; ++n) { int rank = 0;
#pragma unroll
            for (int mm = 0; mm < 8; ++mm) { if (mm != n) { const bool before = (gate[mm] > gate[n]) || (gate[mm] == gate[n] && mm < n); rank += (mm < qb && before) ? 1 : 0; } }
            if (n < qb && rank < 3) sel |= (1u << n); }
    }
    const int krow = (DQK == 64) ? (tid >> 3) : (tid / 12), kch = (DQK == 64) ? (tid & 7) : (tid % 12);
    const int krow2 = (tid + 512) / 12, kch2 = (tid + 512) % 12; const bool k2 = (DQK == 96) && (tid < 256);
    const int vrow = tid >> 3, vch = tid & 7;
    const unsigned kst = (unsigned)(krow * KSTR + kch * 16), kst2 = (unsigned)(krow2 * KSTR + kch2 * 16);
    const unsigned vst = (unsigned)((vch >> 2) * 4096 + (vrow >> 4) * 1024 + ((vrow >> 3) & 1) * 512 + (vrow & 7) * 64 + (vch & 3) * 16);
    const int NT = 4 * (qb + 1);
    auto tile_row0 = [&](int p) -> int { return (p < 4) ? (qb * 256 + p * 64) : ((p - 4) * 64); };
    v4u kreg, kreg2 = {0u, 0u, 0u, 0u}, vreg;
    { const int r0 = tile_row0(0);
      kreg = *(const GAS v4u*)(Kg + (size_t)(r0 + krow) * kpitch + kch * 8); if (k2) kreg2 = *(const GAS v4u*)(Kg + (size_t)(r0 + krow2) * kpitch + kch2 * 8);
      vreg = *(const GAS v4u*)(Vg + (size_t)(r0 + vrow) * vpitch + vch * 8);
      *(LAS v4u*)(Kl + kst) = kreg; if (k2) *(LAS v4u*)(Kl + kst2) = kreg2; *(LAS v4u*)(Vl + vst) = vreg; }
    __syncthreads();
    float m_run = 0.f, l_run = 0.f; f32x16 o0 = {}, o1 = {};
    f32x16 cuse = {}; bool cdirty = true;
    f32x16 negm = {};
    constexpr float THR = 8.0f;
    const int qrel = wid * 32 + r32;
    const unsigned kfo = (unsigned)(r32 * KSTR + hi * 16);
    const unsigned vfo = (unsigned)(((lane >> 4) & 1) * 32 + (lane & 3) * 8 + (4 * hi + ((lane & 15) >> 2)) * 64);
    auto slot = [&](const int p, auto own_) { constexpr bool OWN = decltype(own_)::v;
        const int cb = p & 1;
        if (p + 1 < NT) { const int r0 = tile_row0(p + 1);
            kreg = *(const GAS v4u*)(Kg + (size_t)(r0 + krow) * kpitch + kch * 8); if (k2) kreg2 = *(const GAS v4u*)(Kg + (size_t)(r0 + krow2) * kpitch + kch2 * 8);
            vreg = *(const GAS v4u*)(Vg + (size_t)(r0 + vrow) * vpitch + vch * 8); }
        const bool need = OWN ? !(p > (wid >> 1)) : true;
        if (need) {
            const LAS unsigned char* Kb = Kl + cb * KBUF + kfo; const LAS unsigned char* Vb = Vl + cb * VBUF + vfo;
            f32x16 s0 = negm, s1 = negm;
            if constexpr (!OWN && MOBA) {
                if (cdirty || (p & 3) == 0) { const bool on = ((sel >> ((p - 4) >> 2)) & 1u) != 0u;
#pragma unroll
                    for (int r = 0; r < 16; ++r) cuse[r] = on ? negm[r] : -1.0e30f;
                    cdirty = false; }
                s0 = cuse; s1 = cuse; }
            bf16x8 kf[2 * ND];
#pragma unroll
            for (int d0 = 0; d0 < ND; ++d0) { kf[2 * d0] = *(const LAS bf16x8*)(Kb + d0 * 32); kf[2 * d0 + 1] = *(const LAS bf16x8*)(Kb + 32 * KSTR + d0 * 32); }
            __builtin_amdgcn_sched_barrier(0);
#pragma unroll
            for (int d0 = 0; d0 < ND; ++d0) { s0 = __builtin_amdgcn_mfma_f32_32x32x16_bf16(kf[2 * d0], qf[d0], s0, 0, 0, 0); s1 = __builtin_amdgcn_mfma_f32_32x32x16_bf16(kf[2 * d0 + 1], qf[d0], s1, 0, 0, 0); }
            s16x4 vt[16];
#pragma unroll
            for (int v = 0; v < 16; ++v) vt[v] = __builtin_bit_cast(s16x4, __builtin_amdgcn_ds_read_tr16_b64_v4i16((LAS s16x4*)(Vb + (v >> 2) * 1024 + ((v >> 1) & 1) * 4096 + (v & 1) * 512)));
            __builtin_amdgcn_sched_barrier(0);
            if constexpr (OWN) { const int kb = 64 * p + 4 * hi;
#pragma unroll
                for (int r = 0; r < 16; ++r) { const int kv = kb + (r & 3) + 8 * (r >> 2); if (kv > qrel) s0[r] = -INFINITY; if (kv + 32 > qrel) s1[r] = -INFINITY; } }
            float ra = att_max3(s0[0], s0[1], s1[0]), rb = att_max3(s0[2], s0[3], s1[1]); ra = att_max3(ra, s1[2], s1[3]);
#pragma unroll
            for (int r = 4; r < 16; r += 4) { ra = att_max3(ra, s0[r], s0[r + 1]); rb = att_max3(rb, s0[r + 2], s0[r + 3]); ra = att_max3(ra, s1[r], s1[r + 1]); rb = att_max3(rb, s1[r + 2], s1[r + 3]); }
            float rm = fmaxf(ra, rb); rm = fmaxf(rm, __shfl_xor(rm, 32));
            if ((OWN && p == 0) || __any(rm > THR)) {
                const float dl = (OWN && p == 0) ? rm : fmaxf(rm, 0.f); m_run += dl;
                const float fsc = __builtin_amdgcn_exp2f(-dl); l_run *= fsc;
#pragma unroll
                for (int r = 0; r < 16; ++r) { s0[r] -= dl; s1[r] -= dl; o0[r] *= fsc; o1[r] *= fsc; negm[r] = -m_run; }
                cdirty = true;
            }
            float rs0 = 0.f, rs1 = 0.f;
#pragma unroll
            for (int r = 0; r < 16; ++r) { s0[r] = __builtin_amdgcn_exp2f(s0[r]); s1[r] = __builtin_amdgcn_exp2f(s1[r]); rs0 += s0[r]; rs1 += s1[r]; }
            l_run += rs0 + rs1;
            bf16x8 pf[4];
#pragma unroll
            for (int s = 0; s < 2; ++s) { v4u a, b;
                a.x = pg8::cvt_pk_bf16(s0[8 * s + 0], s0[8 * s + 1]); a.y = pg8::cvt_pk_bf16(s0[8 * s + 2], s0[8 * s + 3]); a.z = pg8::cvt_pk_bf16(s0[8 * s + 4], s0[8 * s + 5]); a.w = pg8::cvt_pk_bf16(s0[8 * s + 6], s0[8 * s + 7]);
                b.x = pg8::cvt_pk_bf16(s1[8 * s + 0], s1[8 * s + 1]); b.y = pg8::cvt_pk_bf16(s1[8 * s + 2], s1[8 * s + 3]); b.z = pg8::cvt_pk_bf16(s1[8 * s + 4], s1[8 * s + 5]); b.w = pg8::cvt_pk_bf16(s1[8 * s + 6], s1[8 * s + 7]);
                pf[s] = __builtin_bit_cast(bf16x8, a); pf[2 + s] = __builtin_bit_cast(bf16x8, b); }
#pragma unroll
            for (int s = 0; s < 4; ++s) {
                const bf16x8 va = (bf16x8){vt[4 * s][0], vt[4 * s][1], vt[4 * s][2], vt[4 * s][3], vt[4 * s + 1][0], vt[4 * s + 1][1], vt[4 * s + 1][2], vt[4 * s + 1][3]};
                const bf16x8 vb = (bf16x8){vt[4 * s + 2][0], vt[4 * s + 2][1], vt[4 * s + 2][2], vt[4 * s + 2][3], vt[4 * s + 3][0], vt[4 * s + 3][1], vt[4 * s + 3][2], vt[4 * s + 3][3]};
                o0 = __builtin_amdgcn_mfma_f32_32x32x16_bf16(va, pf[s], o0, 0, 0, 0);
                o1 = __builtin_amdgcn_mfma_f32_32x32x16_bf16(vb, pf[s], o1, 0, 0, 0); }
        }
        if (p + 1 < NT) { const int nb = cb ^ 1;
            *(LAS v4u*)(Kl + nb * KBUF + kst) = kreg; if (k2) *(LAS v4u*)(Kl + nb * KBUF + kst2) = kreg2; *(LAS v4u*)(Vl + nb * VBUF + vst) = vreg; }
        __syncthreads();
        __syncthreads();
    };
    for (int p = 0; p < 4; ++p) slot(p, AttOwn{});
    for (int p = 4; p < NT; ++p) slot(p, AttPast{});
    l_run += __shfl_xor(l_run, 32);
    const float rl = 1.0f / l_run;
    { float ss = 0.f;
#pragma unroll
      for (int r = 0; r < 16; ++r) { const float a = o0[r] * rl, b = o1[r] * rl; ss += a * a + b * b; }
      ss += __shfl_xor(ss, 32);
      if (hi == 0) ((GAS float*)ossq_)[(size_t)(qb * 256 + wid * 32 + r32) * 16] = ss; }
    LAS unsigned char* stg = lds + 65536 + wid * 4608; const float rl16 = rl * 16.0f;
#pragma unroll
    for (int g = 0; g < 4; ++g) {
        *(LAS unsigned*)(stg + r32 * 80 + (8 * g + 4 * hi)) = pk4_fp8(o0[4 * g] * rl16, o0[4 * g + 1] * rl16, o0[4 * g + 2] * rl16, o0[4 * g + 3] * rl16);
        *(LAS unsigned*)(stg + r32 * 80 + (32 + 8 * g + 4 * hi)) = pk4_fp8(o1[4 * g] * rl16, o1[4 * g + 1] * rl16, o1[4 * g + 2] * rl16, o1[4 * g + 3] * rl16); }
    asm volatile("s_waitcnt lgkmcnt(0)" ::: "memory");
    GAS unsigned char* obase = (GAS unsigned char*)Og + (size_t)(qb * 256 + wid * 32) * opitch;
#pragma unroll
    for (int i = 0; i < 2; ++i) { const int row = i * 16 + (lane >> 2), ch = lane & 3; const v4u v = *(const LAS v4u*)(stg + row * 80 + ch * 16); *(GAS v4u*)(obase + (size_t)row * opitch + ch * 16) = v; }
    asm volatile("s_waitcnt lgkmcnt(0)" ::: "memory");
}

__device__ __forceinline__ void transpose_item(const float* W_, int ldw, bf16* WT, int ldt, int k0, int n0, int dr0, int dr1, LAS float* scr, int lane, const float* kgain = nullptr) {
    const GAS float* W = (const GAS float*)W_; const int q = lane & 15, kr = lane >> 4; const bool ld_ok = (q < 8) ? (dr0 >= 0) : (dr1 >= 0);
#pragma unroll 4
    for (int i = 0; i < 16; ++i) { const int kk = 4 * i + kr; f32x4 v = {0.f, 0.f, 0.f, 0.f}; if (ld_ok) v = *(const GAS f32x4*)(W + (size_t)(k0 + kk) * ldw + n0 + 4 * q);
        if (kgain) v = v * ((const GAS float*)kgain)[k0 + kk];
        LAS float* s = scr + kk * 65 + 4 * q; s[0] = v[0]; s[1] = v[1]; s[2] = v[2]; s[3] = v[3]; }
    asm volatile("s_waitcnt lgkmcnt(0)" ::: "memory");
    const int c = lane & 7;
#pragma unroll
    for (int j = 0; j < 8; ++j) { const int n = 8 * j + (lane >> 3); const LAS float* s = scr + (8 * c) * 65 + n; const int dr = (n < 32) ? dr0 : dr1;
        v4u o; o.x = pk2(s[0 * 65], s[1 * 65]); o.y = pk2(s[2 * 65], s[3 * 65]); o.z = pk2(s[4 * 65], s[5 * 65]); o.w = pk2(s[6 * 65], s[7 * 65]);
        if (dr >= 0) *(GAS v4u*)(WT + (size_t)(dr + (n & 31)) * ldt + k0 + 8 * c) = o; }
    asm volatile("s_waitcnt lgkmcnt(0)" ::: "memory");
}

__device__ __forceinline__ void transpose_item8(const float* W_, int ldw, unsigned char* WT8, int ldt, int k0, int n0, int dr0, int dr1, LAS float* scr, int lane, float scale, const float* kgain = nullptr) {
    const GAS float* W = (const GAS float*)W_; const int q = lane & 15, kr = lane >> 4; const bool ld_ok = (q < 8) ? (dr0 >= 0) : (dr1 >= 0);
#pragma unroll 4
    for (int i = 0; i < 16; ++i) { const int kk = 4 * i + kr; f32x4 v = {0.f, 0.f, 0.f, 0.f}; if (ld_ok) v = *(const GAS f32x4*)(W + (size_t)(k0 + kk) * ldw + n0 + 4 * q);
        if (kgain) v = v * ((const GAS float*)kgain)[k0 + kk];
        v = v * scale;
        LAS float* s = scr + kk * 65 + 4 * q; s[0] = v[0]; s[1] = v[1]; s[2] = v[2]; s[3] = v[3]; }
    asm volatile("s_waitcnt lgkmcnt(0)" ::: "memory");
    const int c = lane & 7;
#pragma unroll
    for (int j = 0; j < 8; ++j) { const int n = 8 * j + (lane >> 3); const LAS float* s = scr + (8 * c) * 65 + n; const int dr = (n < 32) ? dr0 : dr1;
        v2u o; o.x = pk4_fp8(s[0 * 65], s[1 * 65], s[2 * 65], s[3 * 65]); o.y = pk4_fp8(s[4 * 65], s[5 * 65], s[6 * 65], s[7 * 65]);
        if (dr >= 0) *(GAS v2u*)((GAS unsigned char*)WT8 + (size_t)(dr + (n & 31)) * ldt + k0 + 8 * c) = o; }
    asm volatile("s_waitcnt lgkmcnt(0)" ::: "memory");
}

struct Args {
    const float* x; const float* attn_g; const float* w_in; const float* qlat_g; const float* w_qup; const float* kvlat_g; const float* w_kvup;
    const float* qhead_g; const float* khead_g; const float* mqhead_g; const float* mkhead_g; const float* onorm_a_g; const float* onorm_b_g; const float* w_out;
    const float* ffn_g; const float* w_rg; const float* b_rg; const float* w_re; const float* b_re; const float* w_gate; const float* w_up; const float* w_down;
    float* out; unsigned char* ws; int ph_lo, ph_hi;
};
enum { PH_PRO = 0, PH_PROJ, PH_UP, PH_ATTN, PH_OUT, PH_ROUTE, PH_GU, PH_D0, NPHASE };

__global__ void __launch_bounds__(512, 2) mk_fwd(Args A) {
    extern __shared__ __attribute__((aligned(16))) unsigned char lds_raw[];
    LAS unsigned char* lds = (LAS unsigned char*)lds_raw;
    const int tid0 = threadIdx.x;
    const int G = gridDim.x, bx = blockIdx.x;
#define NGW (G * 8)
#define PH_BEGIN int tid = threadIdx.x; asm volatile("" : "+v"(tid)); const int lane = tid & 63; const int wave = __builtin_amdgcn_readfirstlane(tid >> 6); const int gw = bx * 8 + wave; \
    const __attribute__((address_space(4))) Args* AP = (const __attribute__((address_space(4))) Args*)__builtin_amdgcn_kernarg_segment_ptr(); asm volatile("" : "+s"(AP)); \
    unsigned char* ws = AP->ws; (void)lane; (void)gw; (void)ws;
#define Win_t ((bf16*)(ws + WS_WIN))
#define Wq_t ((bf16*)(ws + WS_WQ))
#define Wkv_t ((bf16*)(ws + WS_WKV))
#define Wo_t ((bf16*)(ws + WS_WO))
#define Wgu_t ((bf16*)(ws + WS_WGU))
#define Wd_t ((bf16*)(ws + WS_WD))
#define ropeF ((float*)(ws + WS_ROPE))
#define ropeR (((float*)(ws + WS_ROPE)) + 2 * SEQ * 32)
#define kmean ((float*)(ws + WS_KMEAN))
#define XN ((bf16*)(ws + WS_XN))
#define X1B ((bf16*)(ws + WS_X1B))
#define VB ((bf16*)(ws + WS_VB))
#define YH ((bf16*)(ws + WS_YH))
#define Y0B ((bf16*)(ws + WS_Y0))
#define SSQ ((float*)(ws + WS_SSQ))
#define XRS ((float*)(ws + WS_XRS))
#define O8 ((bf16*)(ws + WS_O8))
#define WREF ((float*)(ws + WS_WRE))
#define WRGF ((float*)(ws + WS_WRE + 131072))
#define OSSQ ((float*)(ws + WS_OSSQ))
#define QB ((bf16*)(ws + WS_QB))
#define KB ((bf16*)(ws + WS_KB))
#define QA ((bf16*)(ws + WS_QA))
#define VA ((bf16*)(ws + WS_VA))
#define KA ((bf16*)(ws + WS_KA))
#define QLN ((bf16*)(ws + WS_QLN))
#define KVLN ((bf16*)(ws + WS_KVLN))
#define HB ((bf16*)(ws + WS_H))
#define lists ((pg8::ListEnt*)(ws + WS_LISTS))
    volatile LAS unsigned* MISC = (volatile LAS unsigned*)(lds + LDSCTL_OFF);
    for (int u = tid0; u < (LDS_BYTES - LDSCTL_OFF) / 4; u += 512) ((LAS unsigned*)(lds + LDSCTL_OFF))[u] = 0u;
    __syncthreads();
    XcdBarrier bar = xcd_barrier_post((unsigned*)((gu32*)(A.ws + WS_CTL) + CW_BAR), MISC + 8);
    const int lo = A.ph_lo, hi = A.ph_hi;
#define IN(k) (lo <= (k) && (k) < hi)
#define MOE_SLOT(npn) ((G == 256) ? ((((bx >> 3) / (npn)) * 8 + (bx & 7)) * (npn) + ((bx >> 3) % (npn))) : bx)
#define SEAM(k) do { if (IN(k) && IN((k) + 1)) xcd_barrier(bar); } while (0)

    if (IN(PH_PRO)) { PH_BEGIN
        LAS float* scr = (LAS float*)(lds + wave * 16640);
        constexpr int I_IN = 16 * 31, I_QU = 4 * 12, I_KV = 2 * 16, I_WO = 16 * 16, I_G = 32 * 64, I_U = 32 * 64, I_D = 32 * 64;
        constexpr int NITEMS = I_IN + I_QU + I_KV + I_WO + I_G + I_U + I_D;
        for (int it = gw; it < NITEMS; it += NGW) {
            int r = it;
            if (r < I_IN) { const int kb = r / 31, nb = r % 31; int dr[2];
#pragma unroll
                for (int h2 = 0; h2 < 2; ++h2) { const int gi = 2 * nb + h2;
                    if (gi < 13) dr[h2] = 32 * gi; else if (gi < 45) { const int q = (gi - 13) & 15, hh = q >> 1, bj = q & 1; dr[h2] = (gi < 29 ? 512 : 1024) + (hh >> 2) * 256 + bj * 128 + (hh & 3) * 32; } else if (gi < 61) dr[h2] = 1536 + (gi - 45) * 32; else dr[h2] = -1; }
                transpose_item(AP->w_in, NPROJ_REAL, Win_t, 1024, 64 * kb, 64 * nb, dr[0], dr[1], scr, lane, AP->attn_g); continue; } r -= I_IN;
            if (r < I_QU) { const int kb = r / 12, nb = r % 12; transpose_item(AP->w_qup, 768, Wq_t, 256, 64 * kb, 64 * nb, 64 * nb, 64 * nb + 32, scr, lane, AP->qlat_g); continue; } r -= I_QU;
            if (r < I_KV) { const int kb = r / 16, nb = r % 16; const int n0 = 64 * nb, hh = n0 >> 7, j0 = n0 & 127;
                const int d0 = (j0 < 64) ? ((hh >> 2) * 256 + (hh & 3) * 32) : (512 + hh * 64), d1 = (j0 < 64) ? (d0 + 128) : (d0 + 32);
                transpose_item(AP->w_kvup, 1024, Wkv_t, 256, 64 * kb, n0, d0, d1, scr, lane, AP->kvlat_g); continue; } r -= I_KV;
            if (r < I_WO) { const int kb = r / 16, nb = r % 16; transpose_item8(AP->w_out, 1024, (unsigned char*)Wo_t, 1024, 64 * kb, 64 * nb, 64 * nb, 64 * nb + 32, scr, lane, 32.0f, kb < 8 ? AP->onorm_a_g : AP->onorm_b_g - 512); continue; } r -= I_WO;
            if (r < I_G) { const int e = r >> 6, r2 = r & 63, kb = r2 >> 2, nb = r2 & 3; const int n0 = 64 * nb; const int d0 = (n0 >> 7) * 256 + (n0 & 127);
                transpose_item8(AP->w_gate + (size_t)e * 1024 * 256, 256, (unsigned char*)Wgu_t + (size_t)e * 512 * 1024, 1024, 64 * kb, n0, d0, d0 + 32, scr, lane, 32.0f); continue; } r -= I_G;
            if (r < I_U) { const int e = r >> 6, r2 = r & 63, kb = r2 >> 2, nb = r2 & 3; const int n0 = 64 * nb; const int d0 = (n0 >> 7) * 256 + 128 + (n0 & 127);
                transpose_item8(AP->w_up + (size_t)e * 1024 * 256, 256, (unsigned char*)Wgu_t + (size_t)e * 512 * 1024, 1024, 64 * kb, n0, d0, d0 + 32, scr, lane, 32.0f); continue; } r -= I_U;
            { const int e = r >> 6, r2 = r & 63, kb = r2 >> 4, nb = r2 & 15;
                transpose_item8(AP->w_down + (size_t)e * 256 * 1024, 1024, (unsigned char*)Wd_t + (size_t)e * 1024 * 256, 256, 64 * kb, 64 * nb, 64 * nb, 64 * nb + 32, scr, lane, 16.0f); }
        }
        const int gt = bx * 512 + tid, NGT = G * 512;
        for (int i = gt; i < 96 * 128; i += NGT) *(GAS v4u*)(Win_t + (size_t)416 * 1024 + (size_t)i * 8) = (v4u){0u, 0u, 0u, 0u};
        for (int i = gt; i < 1024 * 16; i += NGT) *(GAS v4u*)(Wkv_t + (size_t)(i >> 4) * 256 + 128 + (i & 15) * 8) = (v4u){0u, 0u, 0u, 0u};
        for (int i = gt; i < SEQ * 48; i += NGT) {
            const int pos = i / 48, f = i % 48; const bool isF = f < 32; const int ff = isF ? f : f - 32;
            const double e = isF ? (double)ff / 32.0 : (double)ff / 16.0;
            const float invf = (float)exp2(-e * 13.287712379549449);
            const float ang = (float)pos * invf;
            const double a = (double)ang; const double kk = rint(a * 0.15915494309189535); const double rr = a - kk * 6.283185307179586;
            const float c = (float)cos(rr), s = (float)sin(rr);
            GAS float* rF = (GAS float*)ropeF; GAS float* rR = (GAS float*)ropeR;
            if (isF) { rF[pos * 32 + ff] = c; rF[SEQ * 32 + pos * 32 + ff] = s; } else { rR[pos * 16 + ff] = c; rR[SEQ * 16 + pos * 16 + ff] = s; }
        }
        for (int i = gt; i < 1024 * 8; i += NGT) { const float gk = AP->ffn_g[i >> 3]; *((GAS f32x4*)WREF + i) = *((const GAS f32x4*)AP->w_re + i) * gk; }
        for (int i = gt; i < 1024; i += NGT) { const float gk = AP->ffn_g[i]; *((GAS f32x4*)WRGF + i) = *((const GAS f32x4*)AP->w_rg + i) * gk; }
        for (int t = gw; t < T; t += 2 * NGW) {
            const int t2 = (t + NGW < T) ? t + NGW : t;
            const GAS f32x4* xr = (const GAS f32x4*)(AP->x + (size_t)t * D) + lane; const GAS f32x4* xr2 = (const GAS f32x4*)(AP->x + (size_t)t2 * D) + lane; f32x4 v[4], w[4]; float s = 0.f, s2 = 0.f;
#pragma unroll
            for (int j = 0; j < 4; ++j) { v[j] = xr[64 * j]; w[j] = xr2[64 * j]; }
#pragma unroll
            for (int j = 0; j < 4; ++j) { s += (v[j].x * v[j].x + v[j].y * v[j].y) + (v[j].z * v[j].z + v[j].w * v[j].w); s2 += (w[j].x * w[j].x + w[j].y * w[j].y) + (w[j].z * w[j].z + w[j].w * w[j].w); }
            const float nr = sqrtf(wave_sum(s) * (1.f / D) + EPS), nr2 = sqrtf(wave_sum(s2) * (1.f / D) + EPS); const float rstd = 1.0f / nr, rstd2 = 1.0f / nr2;
            if (lane == 0) { ((GAS float*)XRS)[t] = nr; ((GAS float*)XRS)[t2] = nr2; }
            GAS unsigned long long* o8 = (GAS unsigned long long*)(XN + (size_t)t * D) + lane; GAS unsigned long long* o82 = (GAS unsigned long long*)(XN + (size_t)t2 * D) + lane;
#pragma unroll
            for (int j = 0; j < 4; ++j) {
                o8[64 * j] = (unsigned long long)pk2(v[j].x * rstd, v[j].y * rstd) | ((unsigned long long)pk2(v[j].z * rstd, v[j].w * rstd) << 32);
                o82[64 * j] = (unsigned long long)pk2(w[j].x * rstd2, w[j].y * rstd2) | ((unsigned long long)pk2(w[j].z * rstd2, w[j].w * rstd2) << 32); }
        }
    }
    SEAM(PH_PRO);

    if (IN(PH_PROJ)) { PH_BEGIN
        pg8::Gemm g{XN, Win_t, T, NPROJ, D}; pg8::StaticOrder S; S.init(T, NPROJ, G, bx);
        pg8::EpiProj E{ws, WS_QLN, WS_KVLN, WS_QB, WS_KB, WS_VB, WS_SSQ, WS_KMEAN, WS_ROPE, AP->mqhead_g, AP->mkhead_g, C2B, EPS, SEQ};
        pg8::gemm_phase<pg8::EpiProj, pg8::StaticOrder, true, true>(lds, g, S, E);
    }
    SEAM(PH_PROJ);

    if (IN(PH_UP)) { PH_BEGIN
        { int K256 = 256; asm volatile("" : "+s"(K256)); pg8::Gemm g{QLN, Wq_t, T, 768, K256}; pg8::StaticOrder S; S.init(T, 768, G, bx); pg8::EpiBf16Rs E{QA, 768, SSQ, 0, 1.0f / 256.0f, EPS};
          pg8::gemm_phase<pg8::EpiBf16Rs, pg8::StaticOrder, true, true>(lds, g, S, E); }
        { int K256 = 256; asm volatile("" : "+s"(K256)); pg8::Gemm g{KVLN, Wkv_t, T, 1024, K256}; pg8::StaticOrder S; S.init(T, 1024, G, bx); pg8::EpiKv E{KA, VA, KVLN, SSQ, ropeR, AP->khead_g, EPS, SEQ};
          pg8::gemm_phase<pg8::EpiKv, pg8::StaticOrder, true, true>(lds, g, S, E); }
    }
    SEAM(PH_UP);

    if (IN(PH_ATTN)) { PH_BEGIN
        bf16* O = O8;
        for (int u = bx; u < 512; u += G) {
            const int bh = u & 255, b = bh >> 3, h = bh & 7; const size_t r0 = (size_t)b * SEQ;
            if (u < 256) {
                for (int qb = 7; qb >= 0; --qb)
                    attn_unit<96, false, true>(lds, AP->qhead_g, ropeR, QA + r0 * 768 + h * 96, 768, KA + r0 * 768 + h * 96, 768, VA + r0 * 512 + h * 64, 512, (bf16*)((unsigned char*)O + r0 * 1024 + h * 64), 1024, OSSQ + r0 * 16 + h, qb, nullptr, 0);
            } else {
                for (int qb = 7; qb >= 0; --qb)
                    attn_unit<64, true, false>(lds, nullptr, nullptr, QB + r0 * 512 + h * 64, 512, KB + r0 * 512 + h * 64, 512, VB + r0 * 512 + h * 64, 512, (bf16*)((unsigned char*)O + r0 * 1024 + 512 + h * 64), 1024, OSSQ + r0 * 16 + 8 + h, qb, kmean + ((size_t)b * 8 * NH + h) * 64, NH * 64);
            }
        }
    }
    SEAM(PH_ATTN);

    if (IN(PH_OUT)) { PH_BEGIN
        pg8::Gemm g{O8, Wo_t, T, D, D / 2};        pg8::StaticOrder S; S.init(T, D, G, bx);
        LAS float* rsl = (LAS float*)(lds + RING_BYTES);
        { pg8::Unit uu;
          for (int i = 0; i < 12 && S.next(i, uu); ++i) if (tid < 256) { const GAS f32x4* pq = (const GAS f32x4*)((const GAS float*)OSSQ + (size_t)(uu.pm * 256 + tid) * 16); const f32x4 a0 = pq[0], a1 = pq[1], b0 = pq[2], b1 = pq[3];
              const float sa = ((a0[0] + a0[1]) + (a0[2] + a0[3])) + ((a1[0] + a1[1]) + (a1[2] + a1[3])), sb = ((b0[0] + b0[1]) + (b0[2] + b0[3])) + ((b1[0] + b1[1]) + (b1[2] + b1[3]));
              const float ra = 1.0f / sqrtf(sa * (1.0f / 512.0f) + EPS), rb = 1.0f / sqrtf(sb * (1.0f / 512.0f) + EPS);
              *(LAS f32x2*)(rsl + (i * 256 + tid) * 2) = (f32x2){ra / rb, rb}; }
          __syncthreads(); }
        pg8::EpiOut E{XN, XRS, X1B, rsl};
        pg8::gemm_phase<pg8::EpiOut, pg8::StaticOrder, true, true, false, false, true, 0x7a7a7a7a, 0x7b7b7b7b, true>(lds, g, S, E);
    }
    SEAM(PH_OUT);

    if (IN(PH_ROUTE)) { PH_BEGIN
        LAS float* Wrg = (LAS float*)(lds + P8_WRG); LAS float* xt = (LAS float*)(lds + P8_XT + wave * P8_XT_WAVE); LAS float* wc = (LAS float*)(lds + P8_WC);
        LAS int* rt_g = (LAS int*)(lds + P8_RT); LAS float* rt_w = (LAS float*)(lds + P8_RT + 1024); LAS int* rt_rank = (LAS int*)(lds + P8_RT + 3072);
        LAS int* lcnt = (LAS int*)(lds + P8_RT + 4096); LAS int* lbase = (LAS int*)(lds + P8_RT + 4608); LAS float* rt_rs = (LAS float*)(lds + P8_RT + 5120);
        for (int k = tid; k < 1024; k += 512) *(LAS f32x4*)(Wrg + 4 * k) = *((const GAS f32x4*)WRGF + k);
        __syncthreads();
        const int r32 = lane & 31, kh = lane >> 5;
        for (int chunk = bx; chunk < T / 256; chunk += G) {
            if (tid < NCLS) lcnt[tid] = 0;
            const int rowc = wave * 32 + r32; const size_t row0w = (size_t)chunk * 256 + wave * 32;
            const GAS bf16* xsrc = (const GAS bf16*)X1B + (row0w + (lane >> 4)) * D + 4 * (lane & 15);
            f32x16 accE = {}; float aG0 = 0.f, aG1 = 0.f, aG2 = 0.f, aG3 = 0.f, ssq = 0.f;
            *(LAS f32x4*)(wc + 4 * tid) = *((const GAS f32x4*)WREF + tid);
            v2u xn[8]; f32x4 gvn;
#pragma unroll
            for (int j = 0; j < 8; ++j) xn[j] = *(const GAS v2u*)(xsrc + (size_t)(4 * j) * D);
            gvn = *(const GAS f32x4*)((const GAS float*)AP->ffn_g + 4 * (lane & 15));
#pragma unroll 1
            for (int kc = 0; kc < 16; ++kc) {
                f32x4 st[8];
#pragma unroll
                for (int j = 0; j < 8; ++j) st[j] = (f32x4){bflo(xn[j].x), bfhi(xn[j].x), bflo(xn[j].y), bfhi(xn[j].y)};
                const f32x4 gv = gvn;
                if (kc + 1 < 16) {
#pragma unroll
                    for (int j = 0; j < 8; ++j) xn[j] = *(const GAS v2u*)(xsrc + (size_t)(4 * j) * D + (kc + 1) * 64);
                    gvn = *(const GAS f32x4*)((const GAS float*)AP->ffn_g + (kc + 1) * 64 + 4 * (lane & 15)); }
                f32x4 wnext = {0.f, 0.f, 0.f, 0.f}; if (kc + 1 < 16) wnext = *((const GAS f32x4*)WREF + (kc + 1) * 512 + tid);
#pragma unroll
                for (int j = 0; j < 8; ++j) *(LAS f32x4*)(xt + ((lane >> 4) + 4 * j) * 68 + 4 * (lane & 15)) = st[j];
                if (kc + 1 < 16) *(LAS f32x4*)(wc + ((kc + 1) & 1) * 2048 + 4 * tid) = wnext;
                {
#pragma unroll
                  for (int j = 0; j < 8; ++j) { const f32x4 hv = st[j] * gv;
                      *(GAS unsigned*)((GAS unsigned char*)YH + (size_t)(row0w + (lane >> 4) + 4 * j) * D + kc * 64 + 4 * (lane & 15)) = pk4_fp8(hv[0], hv[1], hv[2], hv[3]); } }
                __syncthreads();
                const LAS float* wcc = wc + (kc & 1) * 2048 + r32;
#pragma unroll
                for (int c = 0; c < 8; ++c) {
                    const f32x4 xv = *(const LAS f32x4*)(xt + r32 * 68 + 8 * c + 4 * kh);
                    ssq += (xv.x * xv.x + xv.y * xv.y) + (xv.z * xv.z + xv.w * xv.w);
#pragma unroll
                    for (int e = 0; e < 4; ++e) { const int kl = 8 * c + 4 * kh + e;
                        const float a = wcc[kl * 32]; accE = __builtin_amdgcn_mfma_f32_32x32x2f32(a, xv[e], accE, 0, 0, 0);
                        const f32x4 wg = *(const LAS f32x4*)(Wrg + 4 * (kc * 64 + kl)); aG0 += xv[e] * wg[0]; aG1 += xv[e] * wg[1]; aG2 += xv[e] * wg[2]; aG3 += xv[e] * wg[3]; }
                }
                __syncthreads();
            }
            ssq += __shfl_xor(ssq, 32); aG0 += __shfl_xor(aG0, 32); aG1 += __shfl_xor(aG1, 32); aG2 += __shfl_xor(aG2, 32); aG3 += __shfl_xor(aG3, 32);
            const float rstd = 1.0f / sqrtf(ssq * (1.f / D) + EPS);
            float lg[4] = {aG0 * rstd + AP->b_rg[0], aG1 * rstd + AP->b_rg[1], aG2 * rstd + AP->b_rg[2], aG3 * rstd + AP->b_rg[3]};
            int gs = 0; float gm = lg[0];
#pragma unroll
            for (int i = 1; i < 4; ++i) if (lg[i] > gm) { gm = lg[i]; gs = i; }
            float den = 0.f;
#pragma unroll
            for (int i = 0; i < 4; ++i) den += __expf(lg[i] - gm);
            const float gwt = 1.0f / den;
            float mine[4];
#pragma unroll
            for (int i = 0; i < 4; ++i) { const float v = (gs == 0) ? accE[i] : (gs == 1) ? accE[4 + i] : (gs == 2) ? accE[8 + i] : accE[12 + i]; mine[i] = v * rstd + AP->b_re[gs * 8 + 4 * kh + i]; }
            float ev[8];
#pragma unroll
            for (int i = 0; i < 4; ++i) { const float oth = __shfl_xor(mine[i], 32); ev[i] = kh ? oth : mine[i]; ev[4 + i] = kh ? mine[i] : oth; }
            int e1 = 0; float v1 = ev[0];
#pragma unroll
            for (int i = 1; i < 8; ++i) if (ev[i] > v1) { v1 = ev[i]; e1 = i; }
            int e2 = -1; float v2 = -INFINITY;
#pragma unroll
            for (int i = 0; i < 8; ++i) if (i != e1 && (e2 < 0 || ev[i] > v2)) { v2 = ev[i]; e2 = i; }
            const float ex = __expf(v2 - v1); const float w1 = gwt / (1.0f + ex), w2 = gwt * ex / (1.0f + ex);
            if (kh == 0) { const int elo = e1 < e2 ? e1 : e2, ehi = e1 < e2 ? e2 : e1;
                rt_g[rowc] = gs * 28 + ((elo * (15 - elo)) >> 1) + (ehi - elo - 1); rt_w[rowc * 2] = e1 < e2 ? w1 : w2; rt_w[rowc * 2 + 1] = e1 < e2 ? w2 : w1; rt_rs[rowc] = rstd; }
            __syncthreads();
            if (tid < 256) rt_rank[tid] = __hip_atomic_fetch_add(&lcnt[rt_g[tid]], 1, __ATOMIC_RELAXED, __HIP_MEMORY_SCOPE_WORKGROUP);
            __syncthreads();
            if (tid < NCLS) { const int n = lcnt[tid]; lbase[tid] = n ? (int)__hip_atomic_fetch_add((gu32*)(ws + WS_CTL) + CW_GCNT + 64 * tid, (unsigned)n, RLX_AGENT) : 0; }
            __syncthreads();
            if (tid < 256) { const int g = rt_g[tid]; v4u ev; ev.x = (unsigned)(chunk * 256 + tid); ev.y = __builtin_bit_cast(unsigned, rt_w[tid * 2]); ev.z = __builtin_bit_cast(unsigned, rt_w[tid * 2 + 1]); ev.w = __builtin_bit_cast(unsigned, rt_rs[tid]);
                ((GAS v4u*)lists)[(size_t)g * LIST_CAP + lbase[g] + rt_rank[tid]] = ev; }
            __syncthreads();
        }
    }
    SEAM(PH_ROUTE);

    LAS int* tp = (LAS int*)(lds + TP_OFF); LAS int* cntl = (LAS int*)(lds + CNT_OFF); LAS int* ptab = (LAS int*)(lds + PT_OFF);
    if (hi > PH_ROUTE) {
        if (tid0 == 0) { gu32* ctl = (gu32*)(A.ws + WS_CTL); int acc = 0; for (int g = 0; g < NCLS; ++g) { const int n = (int)__hip_atomic_load(ctl + CW_GCNT + 64 * g, RLX_AGENT); cntl[g] = n; tp[g] = acc; acc += (n + 255) >> 8; } tp[NCLS] = acc;
            int p = 0; for (int lo_ = 0; lo_ < 8; ++lo_) for (int hi_ = lo_ + 1; hi_ < 8; ++hi_) ptab[p++] = lo_ | (hi_ << 4); }
        __syncthreads();
    }

    if (IN(PH_GU)) { PH_BEGIN
        pg8::Gemm g{YH, Wgu_t, 0, 0, D / 2}; pg8::ClsOrder S{tp, ptab, 0, G, MOE_SLOT(4), lists, cntl};
        pg8::EpiGateUp2 E{HB, lists, cntl};
        pg8::gemm_phase<pg8::EpiGateUp2, pg8::ClsOrder, true, true, true, false, true>(lds, g, S, E);
    }
    SEAM(PH_GU);

    if (IN(PH_D0)) { PH_BEGIN
        int K512 = 256; asm volatile("" : "+s"(K512)); pg8::Gemm g{HB, Wd_t, 0, 0, K512};        pg8::ClsOrder S{tp, ptab, 1, G, MOE_SLOT(4), lists, cntl};
        pg8::EpiDown2 E{AP->out, X1B, lists, cntl};
        pg8::gemm_phase<pg8::EpiDown2, pg8::ClsOrder, true, true, false, true, true, 0x7b7b7b7b, 0x7c7c7c7c, true>(lds, g, S, E);
    }
#undef IN
#undef SEAM
}

extern "C" void kernel_launch(void* const* d_in, const int* in_sizes, int n_in, void* d_out, int out_size, void* d_ws, size_t ws_size, hipStream_t stream) {
    static int grid = 0;
    if (grid == 0) {
        if (n_in != 22 || in_sizes[0] != T * D || out_size != T * D || ws_size < WS_END) { fprintf(stderr, "kernel_launch: unexpected shapes (n_in %d, in0 %d, out %d, ws %zu); nothing launched\n", n_in, n_in > 0 ? in_sizes[0] : -1, out_size, ws_size); grid = -1; return; }
        int dev = 0, cus = 0, per_cu = 0;
        if (hipGetDevice(&dev) != hipSuccess || hipDeviceGetAttribute(&cus, hipDeviceAttributeMultiprocessorCount, dev) != hipSuccess) { grid = -1; return; }
        if (hipFuncSetAttribute((const void*)mk_fwd, hipFuncAttributeMaxDynamicSharedMemorySize, LDS_BYTES) != hipSuccess) { fprintf(stderr, "kernel_launch: hipFuncSetAttribute failed\n"); grid = -1; return; }
        if (hipOccupancyMaxActiveBlocksPerMultiprocessor(&per_cu, (const void*)mk_fwd, 512, LDS_BYTES) != hipSuccess || per_cu < 1) { fprintf(stderr, "kernel_launch: occupancy query says %d\n", per_cu); }
        (void)hipGetLastError();
        grid = cus;
    }
    if (grid < 0) return;
    if (hipMemsetAsync((char*)d_ws + WS_CTL, 0, CTL_ZERO_BYTES, stream) != hipSuccess) return;
    Args a{};
    a.x = (const float*)d_in[0]; a.attn_g = (const float*)d_in[1]; a.w_in = (const float*)d_in[2]; a.qlat_g = (const float*)d_in[3]; a.w_qup = (const float*)d_in[4];
    a.kvlat_g = (const float*)d_in[5]; a.w_kvup = (const float*)d_in[6]; a.qhead_g = (const float*)d_in[7]; a.khead_g = (const float*)d_in[8];
    a.mqhead_g = (const float*)d_in[9]; a.mkhead_g = (const float*)d_in[10]; a.onorm_a_g = (const float*)d_in[11]; a.onorm_b_g = (const float*)d_in[12];
    a.w_out = (const float*)d_in[13]; a.ffn_g = (const float*)d_in[14]; a.w_rg = (const float*)d_in[15]; a.b_rg = (const float*)d_in[16];
    a.w_re = (const float*)d_in[17]; a.b_re = (const float*)d_in[18]; a.w_gate = (const float*)d_in[19]; a.w_up = (const float*)d_in[20]; a.w_down = (const float*)d_in[21];
    a.out = (float*)d_out; a.ws = (unsigned char*)d_ws; a.ph_lo = 0; a.ph_hi = NPHASE;
    hipLaunchKernelGGL(mk_fwd, dim3(grid), dim3(512), LDS_BYTES, stream, a);
    (void)hipPeekAtLastError();
}
```

```cpp
#include <hip/hip_runtime.h>
#include <cstdio>
#include <cstdint>
namespace pg8 {
#define PG8_LAS __attribute__((address_space(3)))
typedef unsigned short bf16_t;
typedef short bf16x8 __attribute__((ext_vector_type(8)));
typedef float f32x4 __attribute__((ext_vector_type(4)));
typedef unsigned u32x4 __attribute__((ext_vector_type(4)));
constexpr int BM = 256, BK = 64, HALF = 128, HTB = HALF * BK * 2  , STAGE_BYTES = 8 * HTB, NXCD = 8, WGM = 8;

__host__ __device__ __forceinline__ int lds_byte(int r, int c) { const int st = (r >> 4) * 2 + (c >> 5), rr = r & 15, cc = c & 31, ob = rr * 64 + cc * 2; return st * 1024 + (ob ^ (((ob >> 9) & 1) << 5)); }
__host__ __device__ __forceinline__ void stage_rc(int b, int& R, int& C) { const int st = b / 1024, sb = b % 1024, swz = sb ^ (((sb >> 9) & 1) << 5); R = (st >> 1) * 16 + swz / 64; C = (st & 1) * 32 + (swz % 64) / 2; }
__host__ __device__ __forceinline__ int perm32(int rho) { const int n = rho >> 4, i = rho & 15; return 8 * (i >> 2) + 4 * n + (i & 3); }

struct Unit { int pm, pn, g0, g1, pn2, q; };
struct Gemm { const bf16_t* A; const bf16_t* Bt; int M, N, K; };

struct StaticOrder {
    int nM, nN, nwg, G, c;
    __host__ __device__ void init(int M, int N, int G_, int c_) { nM = M / BM; nN = N / BM; nwg = nM * nN; G = G_; c = c_; }
    __host__ __device__ bool next(int i, Unit& u) const {
        const long L = (long)i * G + c; if (L >= nwg) return false;
        int wgid = (int)L; { const int q = nwg / NXCD, r = nwg % NXCD, xcd = wgid % NXCD, off = wgid / NXCD; wgid = (xcd < r ? xcd * (q + 1) : r * (q + 1) + (xcd - r) * q) + off; }
        const int nig = WGM * nN, gid = wgid / nig, fm = gid * WGM, gsz = (nM - fm) < WGM ? (nM - fm) : WGM;
        u.pm = fm + ((wgid % nig) % gsz); u.pn = (wgid % nig) / gsz; u.g0 = i; u.g1 = 0; u.pn2 = 0; u.q = 0; return true;
    }
    __device__ __forceinline__ void a_ready(const Unit&) const {}
    __device__ __forceinline__ void done(const Unit&) const {}
};

__device__ __forceinline__ unsigned cvt_pk_bf16(float lo, float hi) { unsigned r; asm volatile("v_cvt_pk_bf16_f32 %0, %1, %2" : "=v"(r) : "v"(lo), "v"(hi)); return r; }
#define PG8_GAS __attribute__((address_space(1)))
struct ListEnt { int tok; float w_lo; float w_hi; float rstd; };

struct EpiBf16 {
    static constexpr bool PERM = true, AFTER_DRAIN = false, MIDHOOK = false;
    bf16_t* O; int ldc;
    __device__ __forceinline__ void operator()(const f32x4 (&acc)[2][2][4][2], const Unit& u, int wr, int wc, int fr, int fq) const {
        const int row0 = u.pm * BM + wr * 64 + fr; const int col0 = u.pn * BM + wc * 32 + 8 * fq;
#pragma unroll
        for (int ai = 0; ai < 2; ++ai)
#pragma unroll
            for (int m = 0; m < 4; ++m) { bf16_t* rowp = O + (size_t)(row0 + ai * HALF + m * 16) * ldc + col0;
#pragma unroll
                for (int bj = 0; bj < 2; ++bj) { const f32x4 v0 = acc[ai][bj][m][0], v1 = acc[ai][bj][m][1];
                    u32x4 w; w.x = cvt_pk_bf16(v0[0], v0[1]); w.y = cvt_pk_bf16(v0[2], v0[3]); w.z = cvt_pk_bf16(v1[0], v1[1]); w.w = cvt_pk_bf16(v1[2], v1[3]);
                    *(PG8_GAS u32x4*)(rowp + bj * HALF) = w; } }
    }
};
struct EpiBf16Rs {
    static constexpr bool PERM = true, AFTER_DRAIN = false, MIDHOOK = false;
    bf16_t* O; int ldc; const float* ssq; int off; float inv_n, eps;
    __device__ __forceinline__ void operator()(const f32x4 (&acc)[2][2][4][2], const Unit& u, int wr, int wc, int fr, int fq) const {
        const int row0 = u.pm * BM + wr * 64 + fr; const int col0 = u.pn * BM + wc * 32 + 8 * fq;
#pragma unroll
        for (int ai = 0; ai < 2; ++ai)
#pragma unroll
            for (int m = 0; m < 4; ++m) { const int row = row0 + ai * HALF + m * 16; PG8_GAS bf16_t* rowp = (PG8_GAS bf16_t*)O + (size_t)row * ldc + col0;
                const f32x4 sq = *(const PG8_GAS f32x4*)(ssq + (size_t)row * 8 + off); const float rs = __builtin_amdgcn_rsqf(((sq[0] + sq[1]) + (sq[2] + sq[3])) * inv_n + eps);
#pragma unroll
                for (int bj = 0; bj < 2; ++bj) { const f32x4 v0 = acc[ai][bj][m][0] * rs, v1 = acc[ai][bj][m][1] * rs;
                    u32x4 w; w.x = cvt_pk_bf16(v0[0], v0[1]); w.y = cvt_pk_bf16(v0[2], v0[3]); w.z = cvt_pk_bf16(v1[0], v1[1]); w.w = cvt_pk_bf16(v1[2], v1[3]);
                    *(PG8_GAS u32x4*)(rowp + bj * HALF) = w; } }
    }
};
struct EpiProj {
    static constexpr bool PERM = true, AFTER_DRAIN = false, MIDHOOK = false;
    unsigned char* ws; size_t o_qln, o_kvln, o_qb, o_kb, o_vb, o_ssq, o_kmean, o_rope; const float* gq; const float* gk; float qscale, eps; int seq;
    __device__ __forceinline__ void operator()(const f32x4 (&acc)[2][2][4][2], const Unit& u, int wr, int wc, int fr, int fq) const {
        const int pn = u.pn; const int row0 = u.pm * BM + wr * 64 + fr;
        bf16_t* const QLN = (bf16_t*)(ws + o_qln); bf16_t* const KVLN = (bf16_t*)(ws + o_kvln); bf16_t* const QB = (bf16_t*)(ws + o_qb); bf16_t* const KB = (bf16_t*)(ws + o_kb); bf16_t* const VB = (bf16_t*)(ws + o_vb);
        float* const SSQ = (float*)(ws + o_ssq); float* const kmean = (float*)(ws + o_kmean); const float* const rope = (const float*)(ws + o_rope);
        if (pn < 2) {
            PG8_GAS bf16_t* O = (PG8_GAS bf16_t*)(pn ? KVLN : QLN); PG8_GAS float* sq = (PG8_GAS float*)SSQ;
#pragma unroll
            for (int ai = 0; ai < 2; ++ai)
#pragma unroll
                for (int m = 0; m < 4; ++m) { const int row = row0 + ai * HALF + m * 16; PG8_GAS bf16_t* rowp = O + (size_t)row * 256 + wc * 32 + 8 * fq; float ss = 0.f;
#pragma unroll
                    for (int bj = 0; bj < 2; ++bj) { const f32x4 v0 = acc[ai][bj][m][0], v1 = acc[ai][bj][m][1];
                        if (pn == 0 || bj == 0) ss += (v0[0] * v0[0] + v0[1] * v0[1]) + (v0[2] * v0[2] + v0[3] * v0[3]) + (v1[0] * v1[0] + v1[1] * v1[1]) + (v1[2] * v1[2] + v1[3] * v1[3]);
                        u32x4 w; w.x = cvt_pk_bf16(v0[0], v0[1]); w.y = cvt_pk_bf16(v0[2], v0[3]); w.z = cvt_pk_bf16(v1[0], v1[1]); w.w = cvt_pk_bf16(v1[2], v1[3]);
                        *(PG8_GAS u32x4*)(rowp + bj * HALF) = w; }
                    ss += __shfl_xor(ss, 16); ss += __shfl_xor(ss, 32);
                    if (fq == 0) sq[(size_t)row * 8 + pn * 4 + wc] = ss; }
        } else if (pn < 6) {
            const bool isk = pn >= 4; const int head = (pn & 1) * 4 + wc; const float* gp = isk ? gk : gq; asm volatile("" : "+s"(gp)); const float sc = isk ? 1.0f : qscale;
            PG8_GAS bf16_t* O = (PG8_GAS bf16_t*)(isk ? KB : QB);
            f32x4 g0[2], g1[2];
#pragma unroll
            for (int n = 0; n < 2; ++n) { g0[n] = *(const PG8_GAS f32x4*)(gp + 8 * fq + 4 * n); g1[n] = *(const PG8_GAS f32x4*)(gp + 32 + 8 * fq + 4 * n); }
            f32x4 cs0[2] = {{0.f, 0.f, 0.f, 0.f}, {0.f, 0.f, 0.f, 0.f}}, cs1[2] = {{0.f, 0.f, 0.f, 0.f}, {0.f, 0.f, 0.f, 0.f}};
            f32x4 rc[2][4];
            { const int pos0 = row0 & (seq - 1);
#pragma unroll
              for (int n = 0; n < 2; ++n) { rc[0][n] = *(const PG8_GAS f32x4*)(rope + (size_t)pos0 * 32 + 8 * fq + 4 * n); rc[0][2 + n] = *(const PG8_GAS f32x4*)(rope + (size_t)seq * 32 + (size_t)pos0 * 32 + 8 * fq + 4 * n); } }
#pragma unroll
            for (int ai = 0; ai < 2; ++ai)
#pragma unroll
                for (int m = 0; m < 4; ++m) { const int row = row0 + ai * HALF + m * 16; const int gi = ai * 4 + m;
                    if (gi < 7) { const int gn = gi + 1; const int posn = (row0 + (gn >> 2) * HALF + (gn & 3) * 16) & (seq - 1);
#pragma unroll
                        for (int n = 0; n < 2; ++n) { rc[gn & 1][n] = *(const PG8_GAS f32x4*)(rope + (size_t)posn * 32 + 8 * fq + 4 * n); rc[gn & 1][2 + n] = *(const PG8_GAS f32x4*)(rope + (size_t)seq * 32 + (size_t)posn * 32 + 8 * fq + 4 * n); } }
                    float ss = 0.f;
#pragma unroll
                    for (int n = 0; n < 2; ++n) { const f32x4 a = acc[ai][0][m][n], b = acc[ai][1][m][n]; ss += (a[0] * a[0] + a[1] * a[1]) + (a[2] * a[2] + a[3] * a[3]) + (b[0] * b[0] + b[1] * b[1]) + (b[2] * b[2] + b[3] * b[3]); }
                    ss += __shfl_xor(ss, 16); ss += __shfl_xor(ss, 32);
                    const float rs = __builtin_amdgcn_rsqf(ss * (1.0f / 64.0f) + eps);
                    u32x4 w1, w2; unsigned pk1[4], pk2_[4];
#pragma unroll
                    for (int n = 0; n < 2; ++n) { const f32x4 c = rc[gi & 1][n], sn = rc[gi & 1][2 + n];
                        const f32x4 y1 = acc[ai][0][m][n] * rs * g0[n], y2 = acc[ai][1][m][n] * rs * g1[n];
                        const f32x4 o1 = (y1 * c - y2 * sn) * sc, o2 = (y2 * c + y1 * sn) * sc;
                        if (isk) { cs0[n] += o1; cs1[n] += o2; }
                        pk1[2 * n] = cvt_pk_bf16(o1[0], o1[1]); pk1[2 * n + 1] = cvt_pk_bf16(o1[2], o1[3]); pk2_[2 * n] = cvt_pk_bf16(o2[0], o2[1]); pk2_[2 * n + 1] = cvt_pk_bf16(o2[2], o2[3]); }
                    w1.x = pk1[0]; w1.y = pk1[1]; w1.z = pk1[2]; w1.w = pk1[3]; w2.x = pk2_[0]; w2.y = pk2_[1]; w2.z = pk2_[2]; w2.w = pk2_[3];
                    PG8_GAS bf16_t* rowp = O + (size_t)row * 512 + head * 64 + 8 * fq;
                    *(PG8_GAS u32x4*)rowp = w1; *(PG8_GAS u32x4*)(rowp + 32) = w2;
                    asm volatile("" : "+v"(cs0[0]), "+v"(cs0[1]), "+v"(cs1[0]), "+v"(cs1[1]) :: "memory"); }
            if (isk) {
                PG8_GAS float* km = (PG8_GAS float*)kmean + ((size_t)u.pm * 8 + head) * 64;
#pragma unroll
                for (int n = 0; n < 2; ++n)
#pragma unroll
                    for (int j = 0; j < 4; ++j) { float a = cs0[n][j], b = cs1[n][j];
#pragma unroll
                        for (int o = 1; o < 16; o <<= 1) { a += __shfl_xor(a, o); b += __shfl_xor(b, o); }
                        if (fr == 0) { __hip_atomic_fetch_add(km + 8 * fq + 4 * n + j, a * (1.0f / 256.0f), __ATOMIC_RELAXED, __HIP_MEMORY_SCOPE_AGENT); __hip_atomic_fetch_add(km + 32 + 8 * fq + 4 * n + j, b * (1.0f / 256.0f), __ATOMIC_RELAXED, __HIP_MEMORY_SCOPE_AGENT); } }
            }
        } else {
            PG8_GAS bf16_t* O = (PG8_GAS bf16_t*)VB; const int col0 = (pn - 6) * BM + wc * 32 + 8 * fq;
#pragma unroll
            for (int ai = 0; ai < 2; ++ai)
#pragma unroll
                for (int m = 0; m < 4; ++m) { PG8_GAS bf16_t* rowp = O + (size_t)(row0 + ai * HALF + m * 16) * 512 + col0;
#pragma unroll
                    for (int bj = 0; bj < 2; ++bj) { const f32x4 v0 = acc[ai][bj][m][0], v1 = acc[ai][bj][m][1];
                        u32x4 w; w.x = cvt_pk_bf16(v0[0], v0[1]); w.y = cvt_pk_bf16(v0[2], v0[3]); w.z = cvt_pk_bf16(v1[0], v1[1]); w.w = cvt_pk_bf16(v1[2], v1[3]);
                        *(PG8_GAS u32x4*)(rowp + bj * HALF) = w; } }
        }
    }
};
struct EpiKv {
    static constexpr bool PERM = true, AFTER_DRAIN = false, MIDHOOK = false;
    bf16_t* KA; bf16_t* VA; const bf16_t* KVLN; const float* ssq; const float* ropeR; const float* gk; float eps; int seq;
    __device__ __forceinline__ void operator()(const f32x4 (&acc)[2][2][4][2], const Unit& u, int wr, int wc, int fr, int fq) const {
        const int pn = u.pn; const int row0 = u.pm * BM + wr * 64 + fr;
        if (pn < 2) {
            const int head = pn * 4 + wc; const float* gp = gk; asm volatile("" : "+s"(gp));
            f32x4 g0[2], g1[2];
#pragma unroll
            for (int n = 0; n < 2; ++n) { g0[n] = *(const PG8_GAS f32x4*)(gp + 8 * fq + 4 * n); g1[n] = *(const PG8_GAS f32x4*)(gp + 32 + 8 * fq + 4 * n); }
            const f32x4 gr1 = *(const PG8_GAS f32x4*)(gp + 64 + 4 * fq), gr2 = *(const PG8_GAS f32x4*)(gp + 80 + 4 * fq);
#pragma unroll
            for (int ai = 0; ai < 2; ++ai)
#pragma unroll
                for (int m = 0; m < 4; ++m) { const int row = row0 + ai * HALF + m * 16; const int pos = row & (seq - 1);
                    const f32x4 sq = *(const PG8_GAS f32x4*)(ssq + (size_t)row * 8 + 4); const float rl = __builtin_amdgcn_rsqf(((sq[0] + sq[1]) + (sq[2] + sq[3])) * (1.0f / 128.0f) + eps);
                    const PG8_GAS bf16_t* pe = (const PG8_GAS bf16_t*)KVLN + (size_t)row * 256 + 128 + 4 * fq;
                    typedef unsigned u32x2_ __attribute__((ext_vector_type(2)));
                    const u32x2_ p1 = *(const PG8_GAS u32x2_*)pe, p2 = *(const PG8_GAS u32x2_*)(pe + 16);
                    const f32x4 e1 = {__builtin_bit_cast(float, p1.x << 16), __builtin_bit_cast(float, p1.x & 0xffff0000u), __builtin_bit_cast(float, p1.y << 16), __builtin_bit_cast(float, p1.y & 0xffff0000u)};
                    const f32x4 e2 = {__builtin_bit_cast(float, p2.x << 16), __builtin_bit_cast(float, p2.x & 0xffff0000u), __builtin_bit_cast(float, p2.y << 16), __builtin_bit_cast(float, p2.y & 0xffff0000u)};
                    f32x4 x0[2], x1[2]; float ss = (e1[0] * e1[0] + e1[1] * e1[1]) + (e1[2] * e1[2] + e1[3] * e1[3]) + (e2[0] * e2[0] + e2[1] * e2[1]) + (e2[2] * e2[2] + e2[3] * e2[3]);
#pragma unroll
                    for (int n = 0; n < 2; ++n) { x0[n] = acc[ai][0][m][n] * rl; x1[n] = acc[ai][1][m][n] * rl; const f32x4 a = x0[n], b = x1[n];
                        ss += (a[0] * a[0] + a[1] * a[1]) + (a[2] * a[2] + a[3] * a[3]) + (b[0] * b[0] + b[1] * b[1]) + (b[2] * b[2] + b[3] * b[3]); }
                    ss += __shfl_xor(ss, 16); ss += __shfl_xor(ss, 32);
                    const float rs = __builtin_amdgcn_rsqf(ss * (1.0f / 96.0f) + eps);
                    PG8_GAS bf16_t* rowp = (PG8_GAS bf16_t*)KA + (size_t)row * 768 + head * 96;
                    u32x4 w1, w2;
                    { const f32x4 a = x0[0] * rs * g0[0], b = x0[1] * rs * g0[1]; w1.x = cvt_pk_bf16(a[0], a[1]); w1.y = cvt_pk_bf16(a[2], a[3]); w1.z = cvt_pk_bf16(b[0], b[1]); w1.w = cvt_pk_bf16(b[2], b[3]); }
                    { const f32x4 a = x1[0] * rs * g1[0], b = x1[1] * rs * g1[1]; w2.x = cvt_pk_bf16(a[0], a[1]); w2.y = cvt_pk_bf16(a[2], a[3]); w2.z = cvt_pk_bf16(b[0], b[1]); w2.w = cvt_pk_bf16(b[2], b[3]); }
                    *(PG8_GAS u32x4*)(rowp + 8 * fq) = w1; *(PG8_GAS u32x4*)(rowp + 32 + 8 * fq) = w2;
                    const f32x4 c = *(const PG8_GAS f32x4*)(ropeR + (size_t)pos * 16 + 4 * fq), sn = *(const PG8_GAS f32x4*)(ropeR + (size_t)seq * 16 + (size_t)pos * 16 + 4 * fq);
                    const f32x4 y1 = e1 * rs * gr1, y2 = e2 * rs * gr2; const f32x4 o1 = y1 * c - y2 * sn, o2 = y2 * c + y1 * sn;
                    u32x2_ r1, r2; r1.x = cvt_pk_bf16(o1[0], o1[1]); r1.y = cvt_pk_bf16(o1[2], o1[3]); r2.x = cvt_pk_bf16(o2[0], o2[1]); r2.y = cvt_pk_bf16(o2[2], o2[3]);
                    *(PG8_GAS u32x2_*)(rowp + 64 + 4 * fq) = r1; *(PG8_GAS u32x2_*)(rowp + 80 + 4 * fq) = r2;
                    asm volatile("" ::: "memory"); }
        } else {
            const int col0 = (pn - 2) * BM + wc * 32 + 8 * fq;
#pragma unroll
            for (int ai = 0; ai < 2; ++ai)
#pragma unroll
                for (int m = 0; m < 4; ++m) { const int row = row0 + ai * HALF + m * 16; PG8_GAS bf16_t* rowp = (PG8_GAS bf16_t*)VA + (size_t)row * 512 + col0;
                    const f32x4 sq = *(const PG8_GAS f32x4*)(ssq + (size_t)row * 8 + 4); const float rl = __builtin_amdgcn_rsqf(((sq[0] + sq[1]) + (sq[2] + sq[3])) * (1.0f / 128.0f) + eps);
#pragma unroll
                    for (int bj = 0; bj < 2; ++bj) { const f32x4 v0 = acc[ai][bj][m][0] * rl, v1 = acc[ai][bj][m][1] * rl;
                        u32x4 w; w.x = cvt_pk_bf16(v0[0], v0[1]); w.y = cvt_pk_bf16(v0[2], v0[3]); w.z = cvt_pk_bf16(v1[0], v1[1]); w.w = cvt_pk_bf16(v1[2], v1[3]);
                        *(PG8_GAS u32x4*)(rowp + bj * HALF) = w; } }
        }
    }
};
struct EpiOut {
    static constexpr bool PERM = true, AFTER_DRAIN = false, MIDHOOK = true;
    const bf16_t* xn; const float* xrs; bf16_t* x1b; const PG8_LAS float* rsl;
    __device__ __forceinline__ void mid(f32x4 (&acc)[2][2][4][2], const Unit& u, int wr, int wc, int fr, int fq) const {
        const PG8_LAS float* rs = rsl + (u.g0 * 256 + wr * 64 + fr) * 2;
#pragma unroll
        for (int ai = 0; ai < 2; ++ai)
#pragma unroll
            for (int m = 0; m < 4; ++m) { const float ratio = rs[(ai * HALF + m * 16) * 2];
#pragma unroll
                for (int bj = 0; bj < 2; ++bj)
#pragma unroll
                    for (int n = 0; n < 2; ++n) acc[ai][bj][m][n] *= ratio; }
    }
    __device__ __forceinline__ void operator()(const f32x4 (&acc)[2][2][4][2], const Unit& u, int wr, int wc, int fr, int fq) const {
        const int row0 = u.pm * BM + wr * 64 + fr; const int col0 = u.pn * BM + wc * 32 + 8 * fq;
        const PG8_LAS float* rs = rsl + (u.g0 * 256 + wr * 64 + fr) * 2 + 1;
        float xs[8];
#pragma unroll
        for (int i = 0; i < 8; ++i) xs[i] = *(const PG8_GAS float*)(xrs + row0 + (i >> 2) * HALF + (i & 3) * 16);
        u32x4 xr[2][4];
#pragma unroll
        for (int g = 0; g < 2; ++g) { const size_t off = (size_t)(row0 + g * 16) * 1024 + col0;
#pragma unroll
            for (int bj = 0; bj < 2; ++bj) xr[0][g * 2 + bj] = *(const PG8_GAS u32x4*)(xn + off + bj * HALF); }
#pragma unroll
        for (int pr = 0; pr < 4; ++pr) {
            if (pr < 3) {
#pragma unroll
                for (int g = 0; g < 2; ++g) { const int gi = 2 * (pr + 1) + g; const size_t off = (size_t)(row0 + (gi >> 2) * HALF + (gi & 3) * 16) * 1024 + col0;
#pragma unroll
                    for (int bj = 0; bj < 2; ++bj) xr[(pr + 1) & 1][g * 2 + bj] = *(const PG8_GAS u32x4*)(xn + off + bj * HALF); } }
#pragma unroll
            for (int g = 0; g < 2; ++g) { const int gi = 2 * pr + g; const int ai = gi >> 2, m = gi & 3; const size_t off = (size_t)(row0 + ai * HALF + m * 16) * 1024 + col0; const float rb = rs[(ai * HALF + m * 16) * 2]; const float sx = xs[gi];
#pragma unroll
                for (int bj = 0; bj < 2; ++bj) { const size_t p = off + bj * HALF; const u32x4 x = xr[pr & 1][g * 2 + bj];
                    f32x4 x0, x1; x0[0] = __builtin_bit_cast(float, x.x << 16); x0[1] = __builtin_bit_cast(float, x.x & 0xffff0000u); x0[2] = __builtin_bit_cast(float, x.y << 16); x0[3] = __builtin_bit_cast(float, x.y & 0xffff0000u);
                    x1[0] = __builtin_bit_cast(float, x.z << 16); x1[1] = __builtin_bit_cast(float, x.z & 0xffff0000u); x1[2] = __builtin_bit_cast(float, x.w << 16); x1[3] = __builtin_bit_cast(float, x.w & 0xffff0000u);
                    const f32x4 v0 = x0 * sx + acc[ai][bj][m][0] * rb, v1 = x1 * sx + acc[ai][bj][m][1] * rb;
                    u32x4 o; o.x = cvt_pk_bf16(v0[0], v0[1]); o.y = cvt_pk_bf16(v0[2], v0[3]); o.z = cvt_pk_bf16(v1[0], v1[1]); o.w = cvt_pk_bf16(v1[2], v1[3]);
                    *(PG8_GAS u32x4*)(x1b + p) = o; } }
            asm volatile("" ::: "memory"); }
    }
};
struct EpiGateUp2 {
    static constexpr bool PERM = true, AFTER_DRAIN = false, MIDHOOK = false;
    bf16_t* H; const ListEnt* lists; const PG8_LAS int* cnt;
    __device__ __forceinline__ void operator()(const f32x4 (&acc)[2][2][4][2], const Unit& u, int wr, int wc, int fr, int fq) const {
        const int rt0 = wr * 64 + fr; const int col0 = (u.q >> 1) * 256 + (u.q & 1) * 128 + wc * 32 + 8 * fq; const int g = u.g0; const int n_g = cnt[g]; const bool hiexp = (u.q >> 1) != 0;
        const ListEnt* lg = lists + (size_t)g * 65536 + u.g1 * 256;
        float wv[8], rv[8];
#pragma unroll
        for (int i = 0; i < 8; ++i) { const int rt = rt0 + (i >> 2) * HALF + (i & 3) * 16; f32x4 le = {0.f, 0.f, 0.f, 0.f}; if ((u.g1 * 256 + rt) < n_g) le = *(const PG8_GAS f32x4*)((const PG8_GAS ListEnt*)lg + rt); wv[i] = hiexp ? le[2] : le[1]; rv[i] = le[3]; }
#pragma unroll
        for (int ai = 0; ai < 2; ++ai)
#pragma unroll
            for (int m = 0; m < 4; ++m) { const int rt = rt0 + ai * HALF + m * 16; const bool valid = (u.g1 * 256 + rt) < n_g;
                const float w = wv[ai * 4 + m], rsd = rv[ai * 4 + m];
                unsigned pk[2];
#pragma unroll
                for (int n = 0; n < 2; ++n) { const f32x4 gv = acc[ai][0][m][n], uv = acc[ai][1][m][n]; float h[4];
#pragma unroll
                    for (int j = 0; j < 4; ++j) { const float a = gv[j] * rsd; const float s = a * __builtin_amdgcn_rcpf(1.0f + __builtin_amdgcn_exp2f(-1.4426950408889634f * a)); h[j] = valid ? s * (uv[j] * rsd) * w : 0.f; }
                    { int w_ = 0; w_ = __builtin_amdgcn_cvt_pk_fp8_f32(h[0] * 8.0f, h[1] * 8.0f, w_, false); w_ = __builtin_amdgcn_cvt_pk_fp8_f32(h[2] * 8.0f, h[3] * 8.0f, w_, true); pk[n] = (unsigned)w_; } }
                typedef unsigned u32x2h_ __attribute__((ext_vector_type(2))); u32x2h_ o; o.x = pk[0]; o.y = pk[1];
                *(PG8_GAS u32x2h_*)((PG8_GAS unsigned char*)H + (size_t)(u.pm * BM + rt) * 512 + col0) = o; }
    }
};
struct EpiDown2 {
    static constexpr bool PERM = true, AFTER_DRAIN = false, MIDHOOK = false;
    float* out; const bf16_t* x1b; const ListEnt* lists; const PG8_LAS int* cnt;
    __device__ __forceinline__ void operator()(const f32x4 (&acc)[2][2][4][2], const Unit& u, int wr, int wc, int fr, int fq) const {
        const int rt0 = wr * 64 + fr; const int col0 = u.q * 256 + wc * 32 + 8 * fq; const int g = u.g0; const int n_g = cnt[g];
        const ListEnt* lg = lists + (size_t)g * 65536 + u.g1 * 256;
        int tokv[8];
#pragma unroll
        for (int i = 0; i < 8; ++i) { const int rt = rt0 + (i >> 2) * HALF + (i & 3) * 16; tokv[i] = ((u.g1 * 256 + rt) < n_g) ? ((const PG8_GAS ListEnt*)lg)[rt].tok : -1; }
#pragma unroll
        for (int ai = 0; ai < 2; ++ai) {
            u32x4 xb[4][2];
#pragma unroll
            for (int m = 0; m < 4; ++m)
#pragma unroll
                for (int bj = 0; bj < 2; ++bj) { const int tok = tokv[ai * 4 + m]; xb[m][bj] = (u32x4){0u, 0u, 0u, 0u}; if (tok >= 0) xb[m][bj] = *(const PG8_GAS u32x4*)((const PG8_GAS bf16_t*)x1b + (size_t)tok * 1024 + col0 + bj * HALF); }
#pragma unroll
            for (int m = 0; m < 4; ++m) { const int tok = tokv[ai * 4 + m];
                if (tok >= 0) { PG8_GAS float* orow = (PG8_GAS float*)out + (size_t)tok * 1024 + col0;
#pragma unroll
                    for (int bj = 0; bj < 2; ++bj) { PG8_GAS float* p = orow + bj * HALF; const u32x4 x = xb[m][bj];
                        f32x4 a, b; a[0] = __builtin_bit_cast(float, x.x << 16); a[1] = __builtin_bit_cast(float, x.x & 0xffff0000u); a[2] = __builtin_bit_cast(float, x.y << 16); a[3] = __builtin_bit_cast(float, x.y & 0xffff0000u);
                        b[0] = __builtin_bit_cast(float, x.z << 16); b[1] = __builtin_bit_cast(float, x.z & 0xffff0000u); b[2] = __builtin_bit_cast(float, x.w << 16); b[3] = __builtin_bit_cast(float, x.w & 0xffff0000u);
                        *(PG8_GAS f32x4*)p = a + acc[ai][bj][m][0]; *(PG8_GAS f32x4*)(p + 4) = b + acc[ai][bj][m][1]; } } }
            asm volatile("" ::: "memory"); }
    }
};
struct ClsOrder {
    const PG8_LAS int* tp; const PG8_LAS int* ptab; int mode, G, c; const ListEnt* lists; const PG8_LAS int* cnt;
    __device__ __forceinline__ int arow(const Unit& u, int row) const { const unsigned pos = (unsigned)(u.g1 * 256 + row); const unsigned n = (unsigned)cnt[u.g0]; const PG8_GAS ListEnt* lg = (const PG8_GAS ListEnt*)lists + (size_t)u.g0 * 65536; return lg[pos < n ? pos : 0u].tok; }
    __device__ __forceinline__ bool next(int i, Unit& u) const {
        const int nrb = tp[112]; const long L = (long)i * G + c; if (L >= (long)nrb * 4) return false;
        const int rbt = (int)(L >> 2), q = (int)(L & 3);
        int g = 0;
#pragma unroll
        for (int s = 64; s >= 1; s >>= 1) { const int gg = g + s; if (gg < 112 && tp[gg] <= rbt) g = gg; }
        const int grp = g / 28, pr = ptab[g - grp * 28], lo = pr & 15, hi = pr >> 4;
        u.pm = rbt; u.g0 = g; u.g1 = rbt - tp[g]; u.q = q;
        if (mode == 0) { u.pn = (grp * 8 + ((q >> 1) ? hi : lo)) * 2 + (q & 1); u.pn2 = 0; } else { u.pn = (grp * 8 + lo) * 4 + q; u.pn2 = (grp * 8 + hi) * 4 + q; }
        return true;
    }
    __device__ __forceinline__ void a_ready(const Unit&) const {}
    __device__ __forceinline__ void done(const Unit&) const {}
};

template <class Epi, class Sched, bool ALIGN_EPI = false, bool SP2 = false, bool GATHER = false, bool KSPLIT = false, bool F8 = false, int SCW = 0x7a7a7a7a, int SCA = 0x7f7f7f7f, bool F8ASM = false>
__device__ __forceinline__ void gemm_phase(PG8_LAS unsigned char* lds, const Gemm g, const Sched& S, const Epi& E) {
    const int tid = threadIdx.x, wid = __builtin_amdgcn_readfirstlane(tid >> 6), lane = tid & 63, wr = wid >> 2, wc = wid & 3, fr = lane & 15, fq = lane >> 4;
    const int K = g.K, nt = K / BK;
    const int PB = KSPLIT ? (K >> 1) : K;
    static_assert(!GATHER || SP2, "gathered A rows: SP2 loop only");
    unsigned voffA[2], voffB[2];
#pragma unroll
    for (int i = 0; i < 2; ++i) { int R, C; stage_rc(tid * 16 + i * 8192, R, C); const int Rb = Epi::PERM ? ((R & ~31) + perm32(R & 31)) : R;
        voffA[i] = (unsigned)(R * K + C) * 2u; voffB[i] = (unsigned)(Rb * PB + C) * 2u; }
    const size_t kstep = (size_t)(BK * 2);
    const size_t hstep = (size_t)HALF * K * 2;
    const size_t tstep = 2 * hstep;
    const size_t hstepB = (size_t)HALF * PB * 2, tstepB = 2 * hstepB;
    const unsigned ldsw = (unsigned)wid * 1024u;
    const int aoff = lds_byte(wr * 64 + fr, fq * 8), boff = lds_byte(wc * 32 + fr, fq * 8);
#define PG8_SA(b, h) (((b) * 2 + (h)) * HTB)
#define PG8_SB(b, h) ((4 + (b) * 2 + (h)) * HTB)
#define PG8_STAGE(bufoff, gbase, voff) do { _Pragma("unroll") for (int _i = 0; _i < 2; ++_i) \
        __builtin_amdgcn_global_load_lds((const unsigned*)((const char*)(gbase) + (voff)[_i]), (PG8_LAS unsigned*)(lds + (bufoff) + ldsw + _i * 8192), 16, 0, 0); } while (0)
#define PG8_LDA(dst, b, h) do { _Pragma("unroll") for (int m = 0; m < 4; ++m) _Pragma("unroll") for (int k = 0; k < 2; ++k) dst[m][k] = *(const PG8_LAS bf16x8*)(lds + PG8_SA(b, h) + aoff + m * 2048 + k * 1024); } while (0)
#define PG8_LDB(dst, b, h) do { _Pragma("unroll") for (int n = 0; n < 2; ++n) _Pragma("unroll") for (int k = 0; k < 2; ++k) dst[n][k] = *(const PG8_LAS bf16x8*)(lds + PG8_SB(b, h) + boff + n * 2048 + k * 1024); } while (0)
#define PG8_MMA(ai, bj, At, Bt) do { __builtin_amdgcn_s_setprio(1); _Pragma("unroll") for (int m = 0; m < 4; ++m) _Pragma("unroll") for (int n = 0; n < 2; ++n) { \
        if constexpr (F8) { typedef int v4i_ __attribute__((ext_vector_type(4))); typedef int v8i_ __attribute__((ext_vector_type(8))); \
            const v8i_ w8_ = __builtin_shufflevector(__builtin_bit_cast(v4i_, Bt[n][0]), __builtin_bit_cast(v4i_, Bt[n][1]), 0, 1, 2, 3, 4, 5, 6, 7); \
            const v8i_ a8_ = __builtin_shufflevector(__builtin_bit_cast(v4i_, At[m][0]), __builtin_bit_cast(v4i_, At[m][1]), 0, 1, 2, 3, 4, 5, 6, 7); \
            if constexpr (F8ASM) { asm volatile("v_mfma_scale_f32_16x16x128_f8f6f4 %0, %1, %2, %0, %3, %4 op_sel_hi:[0,0,0]" : "+v"(acc[ai][bj][m][n]) : "v"(w8_), "v"(a8_), "v"(SCW), "v"(SCA)); }     \
            else acc[ai][bj][m][n] = __builtin_amdgcn_mfma_scale_f32_16x16x128_f8f6f4(w8_, a8_, acc[ai][bj][m][n], 0, 0, 0, SCW, 0, SCA); } \
        else { _Pragma("unroll") for (int k = 0; k < 2; ++k) acc[ai][bj][m][n] = __builtin_amdgcn_mfma_f32_16x16x32_bf16(Bt[n][k], At[m][k], acc[ai][bj][m][n], 0, 0, 0); } } \
        __builtin_amdgcn_s_setprio(0); } while (0)
#define PG8_WAIT_V(n) asm volatile("s_waitcnt vmcnt(" #n ")" ::: "memory")
#define PG8_WAIT_L(n) asm volatile("s_waitcnt lgkmcnt(" #n ")" ::: "memory")
#define PG8_BAR __builtin_amdgcn_s_barrier()
#define PG8_SCHED __builtin_amdgcn_sched_barrier(0)
#define PG8_STG_A(b, h, ptr, arr) do { if constexpr (GATHER) { PG8_STAGE(PG8_SA(b, h), (ptr), (arr)[h]); } else { PG8_STAGE(PG8_SA(b, h), (ptr) + ((h) ? hstep : 0), voffA); } } while (0)
    unsigned cv[2][2] = {{0u, 0u}, {0u, 0u}}, nvp[2] = {0u, 0u};
#define PG8_GROWS(dst, unit) do { if constexpr (GATHER) { _Pragma("unroll") for (int _h = 0; _h < 2; ++_h) _Pragma("unroll") for (int _i = 0; _i < 2; ++_i) { int R_, C_; stage_rc(tid * 16 + _i * 8192, R_, C_); \
        dst[_h][_i] = (unsigned)S.arow(unit, _h * HALF + R_) * (unsigned)(K * 2) + (unsigned)(C_ * 2); } } } while (0)
    Unit cur, nxt; int ui = 0;
    if (!S.next(0, cur)) return;
    PG8_GROWS(cv, cur);
#define PG8_GROWS_P(unit) do { _Pragma("unroll") for (int _i = 0; _i < 2; ++_i) { int R_, C_; stage_rc(tid * 16 + _i * 8192, R_, C_); nvp[_i] = (unsigned)S.arow(unit, R_) | ((unsigned)S.arow(unit, HALF + R_) << 16); } } while (0)
#define PG8_UNPACK_NV() do { _Pragma("unroll") for (int _i = 0; _i < 2; ++_i) { int R_, C_; stage_rc(tid * 16 + _i * 8192, R_, C_); cv[0][_i] = (nvp[_i] & 0xffffu) * (unsigned)(K * 2) + (unsigned)(C_ * 2); cv[1][_i] = (nvp[_i] >> 16) * (unsigned)(K * 2) + (unsigned)(C_ * 2); } } while (0)
    f32x4 acc[2][2][4][2];
#pragma unroll
    for (int a = 0; a < 2; ++a)
#pragma unroll
        for (int b = 0; b < 2; ++b)
#pragma unroll
            for (int m = 0; m < 4; ++m)
#pragma unroll
                for (int n = 0; n < 2; ++n) acc[a][b][m][n] = (f32x4){0.f, 0.f, 0.f, 0.f};
    bf16x8 At[4][2], B0[2][2], B1[2][2];
    const char* cA = (const char*)g.A + (GATHER ? (size_t)0 : (size_t)cur.pm * tstep); const char* cB = (const char*)g.Bt + (size_t)cur.pn * tstepB; const char* cB2 = KSPLIT ? (const char*)g.Bt + (size_t)cur.pn2 * tstepB : cB;
    S.a_ready(cur);
    if constexpr (SP2) {
        PG8_STAGE(PG8_SB(0, 0), cB, voffB); PG8_STAGE(PG8_SB(0, 1), cB + hstepB, voffB); PG8_STG_A(0, 0, cA, cv); PG8_STG_A(0, 1, cA, cv);
        if (wr == 1) PG8_BAR;
        PG8_WAIT_V(2); PG8_BAR;
        PG8_STAGE(PG8_SB(1, 0), cB + kstep, voffB); PG8_STG_A(1, 0, cA + kstep, cv); PG8_STAGE(PG8_SB(1, 1), cB + hstepB + kstep, voffB);
        PG8_WAIT_V(6); PG8_BAR;
    } else {
        PG8_STAGE(PG8_SB(0, 0), cB, voffB); PG8_STAGE(PG8_SA(0, 0), cA, voffA); PG8_STAGE(PG8_SB(0, 1), cB + hstepB, voffB); PG8_STAGE(PG8_SA(0, 1), cA + hstep, voffA);
        if (wr == 1) PG8_BAR;
        PG8_WAIT_V(4); PG8_BAR;
        PG8_STAGE(PG8_SB(1, 0), cB + kstep, voffB); PG8_STAGE(PG8_SA(1, 0), cA + kstep, voffA); PG8_STAGE(PG8_SB(1, 1), cB + hstepB + kstep, voffB);
        PG8_WAIT_V(6); PG8_BAR;
    }
    for (;;) {
        const bool has_next = S.next(ui + 1, nxt);
        const char* nA = (has_next && !GATHER) ? (const char*)g.A + (size_t)nxt.pm * tstep : cA; const char* nB = has_next ? (const char*)g.Bt + (size_t)nxt.pn * tstepB : cB; const char* nB2 = (KSPLIT && has_next) ? (const char*)g.Bt + (size_t)nxt.pn2 * tstepB : cB2;
        if constexpr (GATHER) { if (has_next) { PG8_GROWS_P(nxt); } else { PG8_GROWS_P(cur); } }
        const int tspan = Epi::MIDHOOK ? (nt >> 1) : nt;
        for (int t0 = 0; t0 < nt; t0 += tspan) {
        if constexpr (Epi::MIDHOOK) { if (t0 != 0) E.mid(acc, cur, wr, wc, fr, fq); }
        for (int t = t0; t < t0 + tspan; t += 2) {
            const bool last = (t == nt - 2);
            const char* a1 = cA + (size_t)(t + 1) * kstep;
            const char* a2 = last ? nA : cA + (size_t)(t + 2) * kstep; const char* b2 = last ? nB : ((KSPLIT && t + 2 >= (nt >> 1)) ? cB2 + (size_t)(t + 2 - (nt >> 1)) * kstep : cB + (size_t)(t + 2) * kstep);
            const char* a3 = a2 + kstep; const char* b3 = b2 + kstep;
            if (last && has_next) S.a_ready(nxt);
            if constexpr (SP2) {
            PG8_LDB(B0, 0, 0); PG8_LDB(B1, 0, 1); PG8_SCHED; PG8_LDA(At, 0, 0); PG8_STG_A(1, 1, a1, cv);
            if constexpr (GATHER) { if (last) { PG8_UNPACK_NV(); } }
            PG8_WAIT_V(8); PG8_WAIT_L(0); PG8_BAR; PG8_MMA(0, 0, At, B0); PG8_MMA(0, 1, At, B1); PG8_BAR; PG8_SCHED;
            PG8_LDA(At, 0, 1); PG8_STAGE(PG8_SB(0, 0), b2, voffB); PG8_STAGE(PG8_SB(0, 1), b2 + hstepB, voffB); PG8_STG_A(0, 0, a2, cv);
            PG8_WAIT_V(8); PG8_WAIT_L(0); PG8_BAR; PG8_MMA(1, 0, At, B0); PG8_MMA(1, 1, At, B1); PG8_BAR; PG8_SCHED;
            PG8_LDB(B0, 1, 0); PG8_LDB(B1, 1, 1); PG8_SCHED; PG8_LDA(At, 1, 0); PG8_STG_A(0, 1, a2, cv);
            PG8_WAIT_V(8); PG8_WAIT_L(0); PG8_BAR; PG8_MMA(0, 0, At, B0); PG8_MMA(0, 1, At, B1); PG8_BAR; PG8_SCHED;
            PG8_LDA(At, 1, 1); PG8_STAGE(PG8_SB(1, 0), b3, voffB); PG8_STAGE(PG8_SB(1, 1), b3 + hstepB, voffB); PG8_STG_A(1, 0, a3, cv);
            PG8_WAIT_V(8); PG8_WAIT_L(0); PG8_BAR; PG8_MMA(1, 0, At, B0); PG8_MMA(1, 1, At, B1); PG8_BAR; PG8_SCHED;
            } else {
            PG8_LDB(B0, 0, 0); PG8_SCHED; PG8_LDA(At, 0, 0); PG8_STAGE(PG8_SA(1, 1), a1 + hstep, voffA);
            PG8_WAIT_L(8); PG8_BAR; PG8_WAIT_L(0); PG8_MMA(0, 0, At, B0); PG8_BAR; PG8_SCHED;
            PG8_LDB(B1, 0, 1); PG8_STAGE(PG8_SB(0, 0), b2, voffB);
            PG8_BAR; PG8_WAIT_L(0); PG8_MMA(0, 1, At, B1); PG8_BAR;
            PG8_LDA(At, 0, 1); PG8_STAGE(PG8_SA(0, 0), a2, voffA);
            PG8_BAR; PG8_WAIT_L(0); PG8_MMA(1, 0, At, B0); PG8_BAR; PG8_SCHED;
            PG8_STAGE(PG8_SB(0, 1), b2 + hstepB, voffB);
            PG8_WAIT_V(6); PG8_BAR; PG8_MMA(1, 1, At, B1); PG8_BAR;
            PG8_LDB(B0, 1, 0); PG8_SCHED; PG8_LDA(At, 1, 0); PG8_STAGE(PG8_SA(0, 1), a2 + hstep, voffA);
            PG8_WAIT_L(8); PG8_BAR; PG8_WAIT_L(0); PG8_MMA(0, 0, At, B0); PG8_BAR; PG8_SCHED;
            PG8_LDB(B1, 1, 1); PG8_STAGE(PG8_SB(1, 0), b3, voffB);
            PG8_BAR; PG8_WAIT_L(0); PG8_MMA(0, 1, At, B1); PG8_BAR;
            PG8_LDA(At, 1, 1); PG8_STAGE(PG8_SA(1, 0), a3, voffA);
            PG8_BAR; PG8_WAIT_L(0); PG8_MMA(1, 0, At, B0); PG8_BAR; PG8_SCHED;
            PG8_STAGE(PG8_SB(1, 1), b3 + hstepB, voffB);
            PG8_WAIT_V(6); PG8_BAR; PG8_MMA(1, 1, At, B1); PG8_BAR;
            }
        }
        }
        if constexpr (ALIGN_EPI) { if (wr == 0) PG8_BAR; }
        if constexpr (!Epi::AFTER_DRAIN) { int t2 = threadIdx.x; asm volatile("" : "+v"(t2));
            const int wid2 = __builtin_amdgcn_readfirstlane(t2 >> 6), lane2 = t2 & 63; E(acc, cur, wid2 >> 2, wid2 & 3, lane2 & 15, lane2 >> 4); S.done(cur); }
        if (!has_next) break;
#pragma unroll
        for (int a = 0; a < 2; ++a)
#pragma unroll
            for (int b = 0; b < 2; ++b)
#pragma unroll
                for (int m = 0; m < 4; ++m)
#pragma unroll
                    for (int n = 0; n < 2; ++n) acc[a][b][m][n] = (f32x4){0.f, 0.f, 0.f, 0.f};
        cur = nxt; cA = nA; cB = nB; cB2 = nB2; ++ui;
        if constexpr (ALIGN_EPI) { if (wr == 1) PG8_BAR; }
    }
    PG8_WAIT_V(0);
    if constexpr (!ALIGN_EPI) { if (wr == 0) PG8_BAR; }
    PG8_BAR;
    if constexpr (Epi::AFTER_DRAIN) { E.fused(acc, cur, wr, wc, fr, fq, lds, wid, lane); S.done(cur); }
#undef PG8_SA
#undef PG8_SB
#undef PG8_STAGE
#undef PG8_LDA
#undef PG8_LDB
#undef PG8_MMA
#undef PG8_WAIT_V
#undef PG8_WAIT_L
#undef PG8_BAR
#undef PG8_SCHED
#undef PG8_STG_A
#undef PG8_GROWS
#undef PG8_GROWS_P
#undef PG8_UNPACK_NV
}
}
constexpr int BATCH = 32, SEQ = 2048, D = 1024, T = BATCH * SEQ;
constexpr int NPROJ = 2048;
constexpr int CQ = 0, CKV = 256, CPE = 384, CMQ = 416, CMK = 928, CMV = 1440, NPROJ_REAL = 1952;
constexpr int NH = 8;
constexpr float EPS = 1e-6f;
constexpr float LOG2E = 1.4426950408889634f;
constexpr float C2A = 0.10206207261596575f * LOG2E;
constexpr float C2B = 0.125f * LOG2E;
constexpr int NCLS = 112;
constexpr int LIST_CAP = 65536;

constexpr size_t MiB = 1u << 20;
constexpr size_t WS_CTL = 0, CTL_ZERO_BYTES = 2 * MiB;
constexpr size_t WS_KMEAN = 1 * MiB;
constexpr size_t WS_WIN = 2 * MiB;
constexpr size_t WS_WQ = 6 * MiB;
constexpr size_t WS_WKV = 7 * MiB;
constexpr size_t WS_WO = 8 * MiB;
constexpr size_t WS_WGU = 10 * MiB;
constexpr size_t WS_WD = 42 * MiB;
constexpr size_t WS_ROPE = 58 * MiB;
constexpr size_t WS_WRE = 59 * MiB;
constexpr size_t WS_XRS = 62 * MiB;
constexpr size_t WS_O8 = 320 * MiB;
constexpr size_t WS_SSQ = 60 * MiB;
constexpr size_t WS_XN = 64 * MiB;
constexpr size_t WS_VB = 192 * MiB;
constexpr size_t WS_Y0 = 64 * MiB;
constexpr size_t WS_X1B = 768 * MiB;
constexpr size_t WS_YH = 256 * MiB;
constexpr size_t WS_QB = 448 * MiB;
constexpr size_t WS_KB = 512 * MiB;
constexpr size_t WS_QA = 584 * MiB;
constexpr size_t WS_VA = 680 * MiB;
constexpr size_t WS_KA = 808 * MiB;
constexpr size_t WS_QLN = 904 * MiB;
constexpr size_t WS_KVLN = 936 * MiB;
constexpr size_t WS_LISTS = 648 * MiB;
constexpr size_t WS_OSSQ = 904 * MiB;
constexpr size_t WS_END = 1024 * MiB;
constexpr size_t WS_H = WS_KB;
constexpr int CW_TMO = 0, CW_CODE = 1;
constexpr int CW_BAR = 4096;
constexpr int CW_GCNT = 16384;

constexpr int RING_BYTES = 131072;
constexpr int P8_XT = 0, P8_XT_WAVE = 32 * 68 * 4, P8_WC = 69632, P8_WRG = 86016, P8_RT = 102400;
constexpr int LDSCTL_OFF = 155648, LDS_BYTES = 159744;
constexpr int TP_OFF = LDSCTL_OFF + 256, CNT_OFF = LDSCTL_OFF + 768, PT_OFF = LDSCTL_OFF + 1280;

#define GAS __attribute__((address_space(1)))
#define LAS __attribute__((address_space(3)))
typedef unsigned short bf16;
typedef unsigned v4u __attribute__((ext_vector_type(4)));
typedef unsigned v2u __attribute__((ext_vector_type(2)));
typedef float f32x4 __attribute__((ext_vector_type(4)));
typedef float f32x2 __attribute__((ext_vector_type(2)));
typedef float f32x16 __attribute__((ext_vector_type(16)));
typedef short bf16x8 __attribute__((ext_vector_type(8)));
typedef short s16x4 __attribute__((ext_vector_type(4)));
typedef GAS unsigned gu32;
#define RLX_AGENT __ATOMIC_RELAXED, __HIP_MEMORY_SCOPE_AGENT
__device__ __forceinline__ unsigned f2bf(float f) { unsigned u = __builtin_bit_cast(unsigned, f); return (u + 0x7fffu + ((u >> 16) & 1u)) >> 16; }
__device__ __forceinline__ unsigned pk2(float lo, float hi) { return f2bf(lo) | (f2bf(hi) << 16); }
__device__ __forceinline__ float bflo(unsigned w) { return __builtin_bit_cast(float, w << 16); }
__device__ __forceinline__ float bfhi(unsigned w) { return __builtin_bit_cast(float, w & 0xffff0000u); }
__device__ __forceinline__ float wave_sum(float v) {
#pragma unroll
    for (int o = 1; o < 64; o <<= 1) v += __shfl_xor(v, o);
    return v;
}
__device__ __forceinline__ float sum8(float v) { v += __shfl_xor(v, 1); v += __shfl_xor(v, 2); v += __shfl_xor(v, 4); return v; }

#define XB_TMO      128
#define XB_XCNT(j)  (256  + 64 * (j))
#define XB_XSUB(j)  (1280 + 64 * (j))
#define XB_XGEN(j)  (2304 + 64 * (j))
#define XB_TOP      3328
#define XB_TOPGEN   3392
#define XCD_BAR_WORDS 3456
#define XB_SPIN_CAP (1u << 18)

__device__ __forceinline__ unsigned xb_ld(unsigned* p)              { return __hip_atomic_load(p, __ATOMIC_RELAXED, __HIP_MEMORY_SCOPE_AGENT); }
__device__ __forceinline__ unsigned xb_add(unsigned* p, unsigned v) { return __hip_atomic_fetch_add(p, v, __ATOMIC_RELAXED, __HIP_MEMORY_SCOPE_AGENT); }
__device__ __forceinline__ unsigned xb_xcc_id() { return (unsigned)__builtin_amdgcn_s_getreg((3 << 11) | 20) & 0xFu; }
#define XB_SPIN(cond, bar) do { unsigned _sp = 0; while (cond) { __builtin_amdgcn_s_sleep(1); \
    if ((++_sp & 255u) == 0u) { if (xb_ld(&(bar)[XB_TMO])) break; if (_sp > XB_SPIN_CAP) { atomicAdd(&(bar)[XB_TMO], 1u); break; } } } } while (0)

struct XcdBarrier {
    unsigned* bar; unsigned x;
    volatile LAS unsigned* st;
};

__device__ __forceinline__ XcdBarrier xcd_barrier_post(unsigned* bar, volatile LAS unsigned* st) {
    XcdBarrier b; b.bar = bar; b.x = xb_xcc_id(); b.st = st;
    if (threadIdx.x == 0) (void)xb_add(&bar[XB_XCNT(b.x)], 1u);
    return b;
}
__device__ __forceinline__ void xcd_barrier_complete(unsigned* bar, unsigned x, unsigned& nloc, unsigned& nx) {
    const unsigned G = gridDim.x * gridDim.y * gridDim.z;
    unsigned sum, cnt, mine, sp = 0u;
    for (;;) {
        sum = 0u; cnt = 0u; mine = 0u;
#pragma unroll
        for (unsigned j = 0; j < 16; ++j) { const unsigned c = xb_ld(&bar[XB_XCNT(j)]); sum += c; cnt += (c > 0u) ? 1u : 0u; mine = (j == x) ? c : mine; }
        if (sum == G) break;
        __builtin_amdgcn_s_sleep(1);
        if ((++sp & 255u) == 0u) { if (xb_ld(&bar[XB_TMO])) break; if (sp > XB_SPIN_CAP) { atomicAdd(&bar[XB_TMO], 1u); break; } }
    }
    nloc = mine > 0u ? mine : 1u; nx = cnt > 0u ? cnt : 1u;
}

__device__ __forceinline__ void xcd_barrier(const XcdBarrier& b) {
    asm volatile("s_waitcnt vmcnt(0)" ::: "memory");
    __syncthreads();
    if (threadIdx.x == 0) {
        unsigned* bar = b.bar;
        __builtin_amdgcn_s_waitcnt(0);
        unsigned nloc = b.st[0], nx = b.st[1];
        if (nloc == 0u) { xcd_barrier_complete(bar, b.x, nloc, nx); b.st[0] = nloc; b.st[1] = nx; }
        const unsigned old = xb_add(&bar[XB_XSUB(b.x)], 1u);
        const unsigned gen = old / nloc;
        if (old + 1u == (gen + 1u) * nloc) {
            __builtin_amdgcn_fence(__ATOMIC_RELEASE, "agent");
            asm volatile("s_waitcnt vmcnt(0)" ::: "memory");
            const unsigned og = xb_add(&bar[XB_TOP], 1u);
            const unsigned tg = og / nx;
            if (og + 1u == (tg + 1u) * nx) xb_add(&bar[XB_TOPGEN], 1u);
            else XB_SPIN(xb_ld(&bar[XB_TOPGEN]) == tg, bar);
            __builtin_amdgcn_fence(__ATOMIC_ACQUIRE, "agent");
            xb_add(&bar[XB_XGEN(b.x)], 1u);
            asm volatile("s_waitcnt vmcnt(0)" ::: "memory");
        } else {
            XB_SPIN(xb_ld(&bar[XB_XGEN(b.x)]) == gen, bar);
            __builtin_amdgcn_fence(__ATOMIC_ACQUIRE, "agent");
            asm volatile("s_waitcnt vmcnt(0)" ::: "memory");
        }
    }
    __syncthreads();
}


__device__ __forceinline__ float att_max3(float a, float b, float c) { float r; asm("v_max3_f32 %0, %1, %2, %3" : "=v"(r) : "v"(a), "v"(b), "v"(c)); return r; }
__device__ __forceinline__ unsigned pk4_fp8(float a, float b, float c, float d) { int w = 0; w = __builtin_amdgcn_cvt_pk_fp8_f32(a, b, w, false); w = __builtin_amdgcn_cvt_pk_fp8_f32(c, d, w, true); return (unsigned)w; }
struct AttOwn { static constexpr bool v = true; }; struct AttPast { static constexpr bool v = false; };
template <int DQK, bool MOBA, bool QFIN, bool FIXREF>
__device__ __forceinline__ void attn_unit(LAS unsigned char* lds, const float* qgain_, const float* ropeR_, const bf16* Qg_, int qpitch, const bf16* Kg_, int kpitch, const bf16* Vg_, int vpitch, bf16* Og_, int opitch, float* ossq_, int qb, const float* kmp_, int kmstride, float bref) {
    const GAS bf16* Qg = (const GAS bf16*)Qg_; const GAS bf16* Kg = (const GAS bf16*)Kg_; const GAS bf16* Vg = (const GAS bf16*)Vg_; GAS bf16* Og = (GAS bf16*)Og_; const GAS float* kmp = (const GAS float*)kmp_;
    constexpr int ND = DQK / 16, KSTR = DQK * 2 + 16, KBUF = 64 * KSTR, NCH = DQK / 8, VBUF = 8192;
    int tid = threadIdx.x; asm volatile("" : "+v"(tid));
    const int lane = tid & 63, r32 = lane & 31, hi = lane >> 5; const int wid = __builtin_amdgcn_readfirstlane(tid >> 6);
    LAS unsigned char* Kl = lds; LAS unsigned char* Vl = lds + 2 * KBUF;
    const GAS bf16* qrow = Qg + (size_t)(qb * 256 + wid * 32 + r32) * qpitch;
    bf16x8 qf[ND];
#pragma unroll
    for (int d0 = 0; d0 < ND; ++d0) qf[d0] = *(const GAS bf16x8*)(qrow + 16 * d0 + 8 * hi);
    if (QFIN) {
        const GAS float* qg = (const GAS float*)qgain_; const GAS float* rr = (const GAS float*)ropeR_; const int pos = qb * 256 + wid * 32 + r32;
        float x[ND][8]; float ss = 0.f;
#pragma unroll
        for (int d0 = 0; d0 < ND; ++d0) { const v4u w = __builtin_bit_cast(v4u, qf[d0]);
            x[d0][0] = bflo(w.x); x[d0][1] = bfhi(w.x); x[d0][2] = bflo(w.y); x[d0][3] = bfhi(w.y); x[d0][4] = bflo(w.z); x[d0][5] = bfhi(w.z); x[d0][6] = bflo(w.w); x[d0][7] = bfhi(w.w);
#pragma unroll
            for (int j = 0; j < 8; ++j) ss += x[d0][j] * x[d0][j]; }
        ss += __shfl_xor(ss, 32);
        const float rs = __builtin_amdgcn_rsqf(ss * (1.0f / (float)DQK) + EPS) * C2A;
#pragma unroll
        for (int d0 = 0; d0 < ND; ++d0) { const f32x4 ga = *(const GAS f32x4*)(qg + 16 * d0 + 8 * hi), gb = *(const GAS f32x4*)(qg + 16 * d0 + 8 * hi + 4);
#pragma unroll
            for (int j = 0; j < 4; ++j) { x[d0][j] *= rs * ga[j]; x[d0][4 + j] *= rs * gb[j]; } }
        if (ND == 6) { const f32x4 ca = *(const GAS f32x4*)(rr + pos * 16 + 8 * hi), cb = *(const GAS f32x4*)(rr + pos * 16 + 8 * hi + 4), sa = *(const GAS f32x4*)(rr + SEQ * 16 + pos * 16 + 8 * hi), sb = *(const GAS f32x4*)(rr + SEQ * 16 + pos * 16 + 8 * hi + 4);
#pragma unroll
            for (int j = 0; j < 8; ++j) { const float c = j < 4 ? ca[j & 3] : cb[j & 3], s = j < 4 ? sa[j & 3] : sb[j & 3]; const float y1 = x[ND - 2][j], y2 = x[ND - 1][j]; x[ND - 2][j] = y1 * c - y2 * s; x[ND - 1][j] = y2 * c + y1 * s; } }
#pragma unroll
        for (int d0 = 0; d0 < ND; ++d0) { v4u w; w.x = pg8::cvt_pk_bf16(x[d0][0], x[d0][1]); w.y = pg8::cvt_pk_bf16(x[d0][2], x[d0][3]); w.z = pg8::cvt_pk_bf16(x[d0][4], x[d0][5]); w.w = pg8::cvt_pk_bf16(x[d0][6], x[d0][7]); qf[d0] = __builtin_bit_cast(bf16x8, w); }
    }
    unsigned sel = 0xffu;
    if (MOBA && qb > 3) {
        float gate[8];
#pragma unroll
        for (int n = 0; n < 8; ++n) { float a = 0.f;
            if (n < qb) {
#pragma unroll
                for (int d0 = 0; d0 < ND; ++d0) { const GAS float* km = kmp + (size_t)n * kmstride + 16 * d0 + 8 * hi; const f32x4 k0 = *(const GAS f32x4*)km, k1 = *(const GAS f32x4*)(km + 4);
                    const v4u qq = __builtin_bit_cast(v4u, qf[d0]);
                    a += bflo(qq.x) * k0[0] + bfhi(qq.x) * k0[1] + bflo(qq.y) * k0[2] + bfhi(qq.y) * k0[3] + bflo(qq.z) * k1[0] + bfhi(qq.z) * k1[1] + bflo(qq.w) * k1[2] + bfhi(qq.w) * k1[3]; }
                a += __shfl_xor(a, 32); }
            gate[n] = a; asm volatile("" : "+v"(a) :: "memory"); }
        sel = 0u;
#pragma unroll
        for (int n = 0; n < 8; ++n) { int rank = 0;
#pragma unroll
            for (int mm = 0; mm < 8; ++mm) { if (mm != n) { const bool before = (gate[mm] > gate[n]) || (gate[mm] == gate[n] && mm < n); rank += (mm < qb && before) ? 1 : 0; } }
            if (n < qb && rank < 3) sel |= (1u << n); }
    }
    const int krow = (DQK == 64) ? (tid >> 3) : (tid / 12), kch = (DQK == 64) ? (tid & 7) : (tid % 12);
    const int krow2 = (tid + 512) / 12, kch2 = (tid + 512) % 12; const bool k2 = (DQK == 96) && (tid < 256);
    const int vrow = tid >> 3, vch = tid & 7;
    const unsigned kst = (unsigned)(krow * KSTR + kch * 16), kst2 = (unsigned)(krow2 * KSTR + kch2 * 16);
    const unsigned vst = (unsigned)((vch >> 2) * 4096 + (vrow >> 4) * 1024 + ((vrow >> 3) & 1) * 512 + (vrow & 7) * 64 + (vch & 3) * 16);
    const int NT = 4 * (qb + 1);
    auto tile_row0 = [&](int p) -> int { return (p < 4) ? (qb * 256 + p * 64) : ((p - 4) * 64); };
    v4u kreg, kreg2 = {0u, 0u, 0u, 0u}, vreg;
    { const int r0 = tile_row0(0);
      kreg = *(const GAS v4u*)(Kg + (size_t)(r0 + krow) * kpitch + kch * 8); if (k2) kreg2 = *(const GAS v4u*)(Kg + (size_t)(r0 + krow2) * kpitch + kch2 * 8);
      vreg = *(const GAS v4u*)(Vg + (size_t)(r0 + vrow) * vpitch + vch * 8);
      *(LAS v4u*)(Kl + kst) = kreg; if (k2) *(LAS v4u*)(Kl + kst2) = kreg2; *(LAS v4u*)(Vl + vst) = vreg; }
    __syncthreads();
    float m_run = 0.f, l_run = 0.f; f32x16 o0 = {}, o1 = {};
    f32x16 cuse = {}; bool cdirty = true;
    f32x16 negm = {};
    if constexpr (FIXREF) {
#pragma unroll
        for (int r = 0; r < 16; ++r) negm[r] = -bref; }
    constexpr float THR = 8.0f;
    const int qrel = wid * 32 + r32;
    const unsigned kfo = (unsigned)(r32 * KSTR + hi * 16);
    const unsigned vfo = (unsigned)(((lane >> 4) & 1) * 32 + (lane & 3) * 8 + (4 * hi + ((lane & 15) >> 2)) * 64);
    auto slot = [&](const int p, auto own_) { constexpr bool OWN = decltype(own_)::v;
        const int cb = p & 1;
        if (p + 1 < NT) { const int r0 = tile_row0(p + 1);
            kreg = *(const GAS v4u*)(Kg + (size_t)(r0 + krow) * kpitch + kch * 8); if (k2) kreg2 = *(const GAS v4u*)(Kg + (size_t)(r0 + krow2) * kpitch + kch2 * 8);
            vreg = *(const GAS v4u*)(Vg + (size_t)(r0 + vrow) * vpitch + vch * 8); }
        const bool need = OWN ? !(p > (wid >> 1)) : true;
        if (need) {
            const LAS unsigned char* Kb = Kl + cb * KBUF + kfo; const LAS unsigned char* Vb = Vl + cb * VBUF + vfo;
            f32x16 s0 = negm, s1 = negm;
            if constexpr (!OWN && MOBA) {
                if (cdirty || (p & 3) == 0) { const bool on = ((sel >> ((p - 4) >> 2)) & 1u) != 0u;
#pragma unroll
                    for (int r = 0; r < 16; ++r) cuse[r] = on ? negm[r] : -1.0e30f;
                    cdirty = false; }
                s0 = cuse; s1 = cuse; }
            bf16x8 kf[2 * ND];
#pragma unroll
            for (int d0 = 0; d0 < ND; ++d0) { kf[2 * d0] = *(const LAS bf16x8*)(Kb + d0 * 32); kf[2 * d0 + 1] = *(const LAS bf16x8*)(Kb + 32 * KSTR + d0 * 32); }
            __builtin_amdgcn_sched_barrier(0);
#pragma unroll
            for (int d0 = 0; d0 < ND; ++d0) { s0 = __builtin_amdgcn_mfma_f32_32x32x16_bf16(kf[2 * d0], qf[d0], s0, 0, 0, 0); s1 = __builtin_amdgcn_mfma_f32_32x32x16_bf16(kf[2 * d0 + 1], qf[d0], s1, 0, 0, 0); }
            s16x4 vt[16];
#pragma unroll
            for (int v = 0; v < 16; ++v) vt[v] = __builtin_bit_cast(s16x4, __builtin_amdgcn_ds_read_tr16_b64_v4i16((LAS s16x4*)(Vb + (v >> 2) * 1024 + ((v >> 1) & 1) * 4096 + (v & 1) * 512)));
            __builtin_amdgcn_sched_barrier(0);
            if constexpr (OWN) { const int kb = 64 * p + 4 * hi;
#pragma unroll
                for (int r = 0; r < 16; ++r) { const int kv = kb + (r & 3) + 8 * (r >> 2); if (kv > qrel) s0[r] = -INFINITY; if (kv + 32 > qrel) s1[r] = -INFINITY; } }
            if constexpr (!FIXREF) {
            float ra = att_max3(s0[0], s0[1], s1[0]), rb = att_max3(s0[2], s0[3], s1[1]); ra = att_max3(ra, s1[2], s1[3]);
#pragma unroll
            for (int r = 4; r < 16; r += 4) { ra = att_max3(ra, s0[r], s0[r + 1]); rb = att_max3(rb, s0[r + 2], s0[r + 3]); ra = att_max3(ra, s1[r], s1[r + 1]); rb = att_max3(rb, s1[r + 2], s1[r + 3]); }
            float rm = fmaxf(ra, rb); rm = fmaxf(rm, __shfl_xor(rm, 32));
            if ((OWN && p == 0) || __any(rm > THR)) {
                const float dl = (OWN && p == 0) ? rm : fmaxf(rm, 0.f); m_run += dl;
                const float fsc = __builtin_amdgcn_exp2f(-dl); l_run *= fsc;
#pragma unroll
                for (int r = 0; r < 16; ++r) { s0[r] -= dl; s1[r] -= dl; o0[r] *= fsc; o1[r] *= fsc; negm[r] = -m_run; }
                cdirty = true;
            }
            }
            float rs0 = 0.f, rs1 = 0.f;
#pragma unroll
            for (int r = 0; r < 16; ++r) { s0[r] = __builtin_amdgcn_exp2f(s0[r]); s1[r] = __builtin_amdgcn_exp2f(s1[r]); rs0 += s0[r]; rs1 += s1[r]; }
            l_run += rs0 + rs1;
            bf16x8 pf[4];
#pragma unroll
            for (int s = 0; s < 2; ++s) { v4u a, b;
                a.x = pg8::cvt_pk_bf16(s0[8 * s + 0], s0[8 * s + 1]); a.y = pg8::cvt_pk_bf16(s0[8 * s + 2], s0[8 * s + 3]); a.z = pg8::cvt_pk_bf16(s0[8 * s + 4], s0[8 * s + 5]); a.w = pg8::cvt_pk_bf16(s0[8 * s + 6], s0[8 * s + 7]);
                b.x = pg8::cvt_pk_bf16(s1[8 * s + 0], s1[8 * s + 1]); b.y = pg8::cvt_pk_bf16(s1[8 * s + 2], s1[8 * s + 3]); b.z = pg8::cvt_pk_bf16(s1[8 * s + 4], s1[8 * s + 5]); b.w = pg8::cvt_pk_bf16(s1[8 * s + 6], s1[8 * s + 7]);
                pf[s] = __builtin_bit_cast(bf16x8, a); pf[2 + s] = __builtin_bit_cast(bf16x8, b); }
#pragma unroll
            for (int s = 0; s < 4; ++s) {
                const bf16x8 va = (bf16x8){vt[4 * s][0], vt[4 * s][1], vt[4 * s][2], vt[4 * s][3], vt[4 * s + 1][0], vt[4 * s + 1][1], vt[4 * s + 1][2], vt[4 * s + 1][3]};
                const bf16x8 vb = (bf16x8){vt[4 * s + 2][0], vt[4 * s + 2][1], vt[4 * s + 2][2], vt[4 * s + 2][3], vt[4 * s + 3][0], vt[4 * s + 3][1], vt[4 * s + 3][2], vt[4 * s + 3][3]};
                o0 = __builtin_amdgcn_mfma_f32_32x32x16_bf16(va, pf[s], o0, 0, 0, 0);
                o1 = __builtin_amdgcn_mfma_f32_32x32x16_bf16(vb, pf[s], o1, 0, 0, 0); }
        }
        if (p + 1 < NT) { const int nb = cb ^ 1;
            *(LAS v4u*)(Kl + nb * KBUF + kst) = kreg; if (k2) *(LAS v4u*)(Kl + nb * KBUF + kst2) = kreg2; *(LAS v4u*)(Vl + nb * VBUF + vst) = vreg; }
        __syncthreads();
        __syncthreads();
    };
    for (int p = 0; p < 4; ++p) slot(p, AttOwn{});
    for (int p = 4; p < NT; ++p) slot(p, AttPast{});
    l_run += __shfl_xor(l_run, 32);
    const float rl = 1.0f / l_run;
    { float ss = 0.f;
#pragma unroll
      for (int r = 0; r < 16; ++r) { const float a = o0[r] * rl, b = o1[r] * rl; ss += a * a + b * b; }
      ss += __shfl_xor(ss, 32);
      if (hi == 0) ((GAS float*)ossq_)[(size_t)(qb * 256 + wid * 32 + r32) * 16] = ss; }
    LAS unsigned char* stg = lds + 65536 + wid * 4608; const float rl16 = rl * 16.0f;
#pragma unroll
    for (int g = 0; g < 4; ++g) {
        *(LAS unsigned*)(stg + r32 * 80 + (8 * g + 4 * hi)) = pk4_fp8(o0[4 * g] * rl16, o0[4 * g + 1] * rl16, o0[4 * g + 2] * rl16, o0[4 * g + 3] * rl16);
        *(LAS unsigned*)(stg + r32 * 80 + (32 + 8 * g + 4 * hi)) = pk4_fp8(o1[4 * g] * rl16, o1[4 * g + 1] * rl16, o1[4 * g + 2] * rl16, o1[4 * g + 3] * rl16); }
    asm volatile("s_waitcnt lgkmcnt(0)" ::: "memory");
    GAS unsigned char* obase = (GAS unsigned char*)Og + (size_t)(qb * 256 + wid * 32) * opitch;
#pragma unroll
    for (int i = 0; i < 2; ++i) { const int row = i * 16 + (lane >> 2), ch = lane & 3; const v4u v = *(const LAS v4u*)(stg + row * 80 + ch * 16); *(GAS v4u*)(obase + (size_t)row * opitch + ch * 16) = v; }
    asm volatile("s_waitcnt lgkmcnt(0)" ::: "memory");
}

__device__ __forceinline__ void transpose_item(const float* W_, int ldw, bf16* WT, int ldt, int k0, int n0, int dr0, int dr1, LAS float* scr, int lane, const float* kgain = nullptr) {
    const GAS float* W = (const GAS float*)W_; const int q = lane & 15, kr = lane >> 4; const bool ld_ok = (q < 8) ? (dr0 >= 0) : (dr1 >= 0);
#pragma unroll 4
    for (int i = 0; i < 16; ++i) { const int kk = 4 * i + kr; f32x4 v = {0.f, 0.f, 0.f, 0.f}; if (ld_ok) v = *(const GAS f32x4*)(W + (size_t)(k0 + kk) * ldw + n0 + 4 * q);
        if (kgain) v = v * ((const GAS float*)kgain)[k0 + kk];
        LAS float* s = scr + kk * 65 + 4 * q; s[0] = v[0]; s[1] = v[1]; s[2] = v[2]; s[3] = v[3]; }
    asm volatile("s_waitcnt lgkmcnt(0)" ::: "memory");
    const int c = lane & 7;
#pragma unroll
    for (int j = 0; j < 8; ++j) { const int n = 8 * j + (lane >> 3); const LAS float* s = scr + (8 * c) * 65 + n; const int dr = (n < 32) ? dr0 : dr1;
        v4u o; o.x = pk2(s[0 * 65], s[1 * 65]); o.y = pk2(s[2 * 65], s[3 * 65]); o.z = pk2(s[4 * 65], s[5 * 65]); o.w = pk2(s[6 * 65], s[7 * 65]);
        if (dr >= 0) *(GAS v4u*)(WT + (size_t)(dr + (n & 31)) * ldt + k0 + 8 * c) = o; }
    asm volatile("s_waitcnt lgkmcnt(0)" ::: "memory");
}

__device__ __forceinline__ void transpose_item8(const float* W_, int ldw, unsigned char* WT8, int ldt, int k0, int n0, int dr0, int dr1, LAS float* scr, int lane, float scale, const float* kgain = nullptr) {
    const GAS float* W = (const GAS float*)W_; const int q = lane & 15, kr = lane >> 4; const bool ld_ok = (q < 8) ? (dr0 >= 0) : (dr1 >= 0);
#pragma unroll 4
    for (int i = 0; i < 16; ++i) { const int kk = 4 * i + kr; f32x4 v = {0.f, 0.f, 0.f, 0.f}; if (ld_ok) v = *(const GAS f32x4*)(W + (size_t)(k0 + kk) * ldw + n0 + 4 * q);
        if (kgain) v = v * ((const GAS float*)kgain)[k0 + kk];
        v = v * scale;
        LAS float* s = scr + kk * 65 + 4 * q; s[0] = v[0]; s[1] = v[1]; s[2] = v[2]; s[3] = v[3]; }
    asm volatile("s_waitcnt lgkmcnt(0)" ::: "memory");
    const int c = lane & 7;
#pragma unroll
    for (int j = 0; j < 8; ++j) { const int n = 8 * j + (lane >> 3); const LAS float* s = scr + (8 * c) * 65 + n; const int dr = (n < 32) ? dr0 : dr1;
        v2u o; o.x = pk4_fp8(s[0 * 65], s[1 * 65], s[2 * 65], s[3 * 65]); o.y = pk4_fp8(s[4 * 65], s[5 * 65], s[6 * 65], s[7 * 65]);
        if (dr >= 0) *(GAS v2u*)((GAS unsigned char*)WT8 + (size_t)(dr + (n & 31)) * ldt + k0 + 8 * c) = o; }
    asm volatile("s_waitcnt lgkmcnt(0)" ::: "memory");
}

struct Args {
    const float* x; const float* attn_g; const float* w_in; const float* qlat_g; const float* w_qup; const float* kvlat_g; const float* w_kvup;
    const float* qhead_g; const float* khead_g; const float* mqhead_g; const float* mkhead_g; const float* onorm_a_g; const float* onorm_b_g; const float* w_out;
    const float* ffn_g; const float* w_rg; const float* b_rg; const float* w_re; const float* b_re; const float* w_gate; const float* w_up; const float* w_down;
    float* out; unsigned char* ws; int ph_lo, ph_hi;
};
enum { PH_PRO = 0, PH_PROJ, PH_UP, PH_ATTN, PH_OUT, PH_ROUTE, PH_GU, PH_D0, NPHASE };

__global__ void __launch_bounds__(512, 2) mk_fwd(Args A) {
    extern __shared__ __attribute__((aligned(16))) unsigned char lds_raw[];
    LAS unsigned char* lds = (LAS unsigned char*)lds_raw;
    const int tid0 = threadIdx.x;
    const int G = gridDim.x, bx = blockIdx.x;
#define NGW (G * 8)
#define PH_BEGIN int tid = threadIdx.x; asm volatile("" : "+v"(tid)); const int lane = tid & 63; const int wave = __builtin_amdgcn_readfirstlane(tid >> 6); const int gw = bx * 8 + wave; \
    const __attribute__((address_space(4))) Args* AP = (const __attribute__((address_space(4))) Args*)__builtin_amdgcn_kernarg_segment_ptr(); asm volatile("" : "+s"(AP)); \
    unsigned char* ws = AP->ws; (void)lane; (void)gw; (void)ws;
#define Win_t ((bf16*)(ws + WS_WIN))
#define Wq_t ((bf16*)(ws + WS_WQ))
#define Wkv_t ((bf16*)(ws + WS_WKV))
#define Wo_t ((bf16*)(ws + WS_WO))
#define Wgu_t ((bf16*)(ws + WS_WGU))
#define Wd_t ((bf16*)(ws + WS_WD))
#define ropeF ((float*)(ws + WS_ROPE))
#define ropeR (((float*)(ws + WS_ROPE)) + 2 * SEQ * 32)
#define kmean ((float*)(ws + WS_KMEAN))
#define XN ((bf16*)(ws + WS_XN))
#define X1B ((bf16*)(ws + WS_X1B))
#define VB ((bf16*)(ws + WS_VB))
#define YH ((bf16*)(ws + WS_YH))
#define Y0B ((bf16*)(ws + WS_Y0))
#define SSQ ((float*)(ws + WS_SSQ))
#define XRS ((float*)(ws + WS_XRS))
#define O8 ((bf16*)(ws + WS_O8))
#define WREF ((float*)(ws + WS_WRE))
#define WRGF ((float*)(ws + WS_WRE + 131072))
#define OSSQ ((float*)(ws + WS_OSSQ))
#define QB ((bf16*)(ws + WS_QB))
#define KB ((bf16*)(ws + WS_KB))
#define QA ((bf16*)(ws + WS_QA))
#define VA ((bf16*)(ws + WS_VA))
#define KA ((bf16*)(ws + WS_KA))
#define QLN ((bf16*)(ws + WS_QLN))
#define KVLN ((bf16*)(ws + WS_KVLN))
#define HB ((bf16*)(ws + WS_H))
#define lists ((pg8::ListEnt*)(ws + WS_LISTS))
    volatile LAS unsigned* MISC = (volatile LAS unsigned*)(lds + LDSCTL_OFF);
    for (int u = tid0; u < (LDS_BYTES - LDSCTL_OFF) / 4; u += 512) ((LAS unsigned*)(lds + LDSCTL_OFF))[u] = 0u;
    __syncthreads();
    XcdBarrier bar = xcd_barrier_post((unsigned*)((gu32*)(A.ws + WS_CTL) + CW_BAR), MISC + 8);
    const int lo = A.ph_lo, hi = A.ph_hi;
#define IN(k) (lo <= (k) && (k) < hi)
#define MOE_SLOT(npn) ((G == 256) ? ((((bx >> 3) / (npn)) * 8 + (bx & 7)) * (npn) + ((bx >> 3) % (npn))) : bx)
#define SEAM(k) do { if (IN(k) && IN((k) + 1)) xcd_barrier(bar); } while (0)

    if (IN(PH_PRO)) { PH_BEGIN
        LAS float* scr = (LAS float*)(lds + wave * 16640);
        constexpr int I_IN = 16 * 31, I_QU = 4 * 12, I_KV = 2 * 16, I_WO = 16 * 16, I_G = 32 * 64, I_U = 32 * 64, I_D = 32 * 64;
        constexpr int NITEMS = I_IN + I_QU + I_KV + I_WO + I_G + I_U + I_D;
        for (int it = gw; it < NITEMS; it += NGW) {
            int r = it;
            if (r < I_IN) { const int kb = r / 31, nb = r % 31; int dr[2];
#pragma unroll
                for (int h2 = 0; h2 < 2; ++h2) { const int gi = 2 * nb + h2;
                    if (gi < 13) dr[h2] = 32 * gi; else if (gi < 45) { const int q = (gi - 13) & 15, hh = q >> 1, bj = q & 1; dr[h2] = (gi < 29 ? 512 : 1024) + (hh >> 2) * 256 + bj * 128 + (hh & 3) * 32; } else if (gi < 61) dr[h2] = 1536 + (gi - 45) * 32; else dr[h2] = -1; }
                transpose_item(AP->w_in, NPROJ_REAL, Win_t, 1024, 64 * kb, 64 * nb, dr[0], dr[1], scr, lane, AP->attn_g); continue; } r -= I_IN;
            if (r < I_QU) { const int kb = r / 12, nb = r % 12; transpose_item(AP->w_qup, 768, Wq_t, 256, 64 * kb, 64 * nb, 64 * nb, 64 * nb + 32, scr, lane, AP->qlat_g); continue; } r -= I_QU;
            if (r < I_KV) { const int kb = r / 16, nb = r % 16; const int n0 = 64 * nb, hh = n0 >> 7, j0 = n0 & 127;
                const int d0 = (j0 < 64) ? ((hh >> 2) * 256 + (hh & 3) * 32) : (512 + hh * 64), d1 = (j0 < 64) ? (d0 + 128) : (d0 + 32);
                transpose_item(AP->w_kvup, 1024, Wkv_t, 256, 64 * kb, n0, d0, d1, scr, lane, AP->kvlat_g); continue; } r -= I_KV;
            if (r < I_WO) { const int kb = r / 16, nb = r % 16; transpose_item8(AP->w_out, 1024, (unsigned char*)Wo_t, 1024, 64 * kb, 64 * nb, 64 * nb, 64 * nb + 32, scr, lane, 32.0f, kb < 8 ? AP->onorm_a_g : AP->onorm_b_g - 512); continue; } r -= I_WO;
            if (r < I_G) { const int e = r >> 6, r2 = r & 63, kb = r2 >> 2, nb = r2 & 3; const int n0 = 64 * nb; const int d0 = (n0 >> 7) * 256 + (n0 & 127);
                transpose_item8(AP->w_gate + (size_t)e * 1024 * 256, 256, (unsigned char*)Wgu_t + (size_t)e * 512 * 1024, 1024, 64 * kb, n0, d0, d0 + 32, scr, lane, 32.0f); continue; } r -= I_G;
            if (r < I_U) { const int e = r >> 6, r2 = r & 63, kb = r2 >> 2, nb = r2 & 3; const int n0 = 64 * nb; const int d0 = (n0 >> 7) * 256 + 128 + (n0 & 127);
                transpose_item8(AP->w_up + (size_t)e * 1024 * 256, 256, (unsigned char*)Wgu_t + (size_t)e * 512 * 1024, 1024, 64 * kb, n0, d0, d0 + 32, scr, lane, 32.0f); continue; } r -= I_U;
            { const int e = r >> 6, r2 = r & 63, kb = r2 >> 4, nb = r2 & 15;
                transpose_item8(AP->w_down + (size_t)e * 256 * 1024, 1024, (unsigned char*)Wd_t + (size_t)e * 1024 * 256, 256, 64 * kb, 64 * nb, 64 * nb, 64 * nb + 32, scr, lane, 16.0f); }
        }
        const int gt = bx * 512 + tid, NGT = G * 512;
        for (int i = gt; i < 96 * 128; i += NGT) *(GAS v4u*)(Win_t + (size_t)416 * 1024 + (size_t)i * 8) = (v4u){0u, 0u, 0u, 0u};
        for (int i = gt; i < 1024 * 16; i += NGT) *(GAS v4u*)(Wkv_t + (size_t)(i >> 4) * 256 + 128 + (i & 15) * 8) = (v4u){0u, 0u, 0u, 0u};
        for (int i = gt; i < SEQ * 48; i += NGT) {
            const int pos = i / 48, f = i % 48; const bool isF = f < 32; const int ff = isF ? f : f - 32;
            const double e = isF ? (double)ff / 32.0 : (double)ff / 16.0;
            const float invf = (float)exp2(-e * 13.287712379549449);
            const float ang = (float)pos * invf;
            const double a = (double)ang; const double kk = rint(a * 0.15915494309189535); const double rr = a - kk * 6.283185307179586;
            const float c = (float)cos(rr), s = (float)sin(rr);
            GAS float* rF = (GAS float*)ropeF; GAS float* rR = (GAS float*)ropeR;
            if (isF) { rF[pos * 32 + ff] = c; rF[SEQ * 32 + pos * 32 + ff] = s; } else { rR[pos * 16 + ff] = c; rR[SEQ * 16 + pos * 16 + ff] = s; }
        }
        for (int i = gt; i < 1024 * 8; i += NGT) { const float gk = AP->ffn_g[i >> 3]; *((GAS f32x4*)WREF + i) = *((const GAS f32x4*)AP->w_re + i) * gk; }
        for (int i = gt; i < 1024; i += NGT) { const float gk = AP->ffn_g[i]; *((GAS f32x4*)WRGF + i) = *((const GAS f32x4*)AP->w_rg + i) * gk; }
        for (int t = gw; t < T; t += 2 * NGW) {
            const int t2 = (t + NGW < T) ? t + NGW : t;
            const GAS f32x4* xr = (const GAS f32x4*)(AP->x + (size_t)t * D) + lane; const GAS f32x4* xr2 = (const GAS f32x4*)(AP->x + (size_t)t2 * D) + lane; f32x4 v[4], w[4]; float s = 0.f, s2 = 0.f;
#pragma unroll
            for (int j = 0; j < 4; ++j) { v[j] = xr[64 * j]; w[j] = xr2[64 * j]; }
#pragma unroll
            for (int j = 0; j < 4; ++j) { s += (v[j].x * v[j].x + v[j].y * v[j].y) + (v[j].z * v[j].z + v[j].w * v[j].w); s2 += (w[j].x * w[j].x + w[j].y * w[j].y) + (w[j].z * w[j].z + w[j].w * w[j].w); }
            const float nr = sqrtf(wave_sum(s) * (1.f / D) + EPS), nr2 = sqrtf(wave_sum(s2) * (1.f / D) + EPS); const float rstd = 1.0f / nr, rstd2 = 1.0f / nr2;
            if (lane == 0) { ((GAS float*)XRS)[t] = nr; ((GAS float*)XRS)[t2] = nr2; }
            GAS unsigned long long* o8 = (GAS unsigned long long*)(XN + (size_t)t * D) + lane; GAS unsigned long long* o82 = (GAS unsigned long long*)(XN + (size_t)t2 * D) + lane;
#pragma unroll
            for (int j = 0; j < 4; ++j) {
                o8[64 * j] = (unsigned long long)pk2(v[j].x * rstd, v[j].y * rstd) | ((unsigned long long)pk2(v[j].z * rstd, v[j].w * rstd) << 32);
                o82[64 * j] = (unsigned long long)pk2(w[j].x * rstd2, w[j].y * rstd2) | ((unsigned long long)pk2(w[j].z * rstd2, w[j].w * rstd2) << 32); }
        }
    }
    SEAM(PH_PRO);

    if (IN(PH_PROJ)) { PH_BEGIN
        pg8::Gemm g{XN, Win_t, T, NPROJ, D}; pg8::StaticOrder S; S.init(T, NPROJ, G, bx);
        pg8::EpiProj E{ws, WS_QLN, WS_KVLN, WS_QB, WS_KB, WS_VB, WS_SSQ, WS_KMEAN, WS_ROPE, AP->mqhead_g, AP->mkhead_g, C2B, EPS, SEQ};
        pg8::gemm_phase<pg8::EpiProj, pg8::StaticOrder, true, true>(lds, g, S, E);
    }
    SEAM(PH_PROJ);

    if (IN(PH_UP)) { PH_BEGIN
        { int K256 = 256; asm volatile("" : "+s"(K256)); pg8::Gemm g{QLN, Wq_t, T, 768, K256}; pg8::StaticOrder S; S.init(T, 768, G, bx); pg8::EpiBf16Rs E{QA, 768, SSQ, 0, 1.0f / 256.0f, EPS};
          pg8::gemm_phase<pg8::EpiBf16Rs, pg8::StaticOrder, true, true>(lds, g, S, E); }
        { int K256 = 256; asm volatile("" : "+s"(K256)); pg8::Gemm g{KVLN, Wkv_t, T, 1024, K256}; pg8::StaticOrder S; S.init(T, 1024, G, bx); pg8::EpiKv E{KA, VA, KVLN, SSQ, ropeR, AP->khead_g, EPS, SEQ};
          pg8::gemm_phase<pg8::EpiKv, pg8::StaticOrder, true, true>(lds, g, S, E); }
    }
    SEAM(PH_UP);

    if (IN(PH_ATTN)) { PH_BEGIN
        bf16* O = O8;
        float brefA, brefB;
        { const GAS float* gq = (const GAS float*)AP->qhead_g; const GAS float* gk = (const GAS float*)AP->khead_g; const GAS float* mq = (const GAS float*)AP->mqhead_g; const GAS float* mk = (const GAS float*)AP->mkhead_g;
          float a = fabsf(gq[lane]), c = fabsf(gk[lane]); if (lane < 32) { a = fmaxf(a, fabsf(gq[64 + lane])); c = fmaxf(c, fabsf(gk[64 + lane])); }
          float e = fabsf(mq[lane]), f = fabsf(mk[lane]);
#pragma unroll
          for (int o = 1; o < 64; o <<= 1) { a = fmaxf(a, __shfl_xor(a, o)); c = fmaxf(c, __shfl_xor(c, o)); e = fmaxf(e, __shfl_xor(e, o)); f = fmaxf(f, __shfl_xor(f, o)); }
          brefA = 96.0f * C2A * a * c * 1.03f; brefB = 64.0f * C2B * e * f * 1.03f; }
        const bool fixA = __builtin_amdgcn_readfirstlane(brefA < 50.0f ? 1 : 0) != 0, fixB = __builtin_amdgcn_readfirstlane(brefB < 50.0f ? 1 : 0) != 0;
        for (int u = bx; u < 512; u += G) {
            const int bh = u & 255, b = bh >> 3, h = bh & 7; const size_t r0 = (size_t)b * SEQ;
            if (u < 256) {
                for (int qb = 7; qb >= 0; --qb) {
                    if (fixA) attn_unit<96, false, true, true>(lds, AP->qhead_g, ropeR, QA + r0 * 768 + h * 96, 768, KA + r0 * 768 + h * 96, 768, VA + r0 * 512 + h * 64, 512, (bf16*)((unsigned char*)O + r0 * 1024 + h * 64), 1024, OSSQ + r0 * 16 + h, qb, nullptr, 0, brefA);
                    else      attn_unit<96, false, true, false>(lds, AP->qhead_g, ropeR, QA + r0 * 768 + h * 96, 768, KA + r0 * 768 + h * 96, 768, VA + r0 * 512 + h * 64, 512, (bf16*)((unsigned char*)O + r0 * 1024 + h * 64), 1024, OSSQ + r0 * 16 + h, qb, nullptr, 0, 0.f); }
            } else {
                for (int qb = 7; qb >= 0; --qb) {
                    if (fixB) attn_unit<64, true, false, true>(lds, nullptr, nullptr, QB + r0 * 512 + h * 64, 512, KB + r0 * 512 + h * 64, 512, VB + r0 * 512 + h * 64, 512, (bf16*)((unsigned char*)O + r0 * 1024 + 512 + h * 64), 1024, OSSQ + r0 * 16 + 8 + h, qb, kmean + ((size_t)b * 8 * NH + h) * 64, NH * 64, brefB);
                    else      attn_unit<64, true, false, false>(lds, nullptr, nullptr, QB + r0 * 512 + h * 64, 512, KB + r0 * 512 + h * 64, 512, VB + r0 * 512 + h * 64, 512, (bf16*)((unsigned char*)O + r0 * 1024 + 512 + h * 64), 1024, OSSQ + r0 * 16 + 8 + h, qb, kmean + ((size_t)b * 8 * NH + h) * 64, NH * 64, 0.f); }
            }
        }
    }
    SEAM(PH_ATTN);

    if (IN(PH_OUT)) { PH_BEGIN
        pg8::Gemm g{O8, Wo_t, T, D, D / 2};        pg8::StaticOrder S; S.init(T, D, G, bx);
        LAS float* rsl = (LAS float*)(lds + RING_BYTES);
        { pg8::Unit uu;
          for (int i = 0; i < 12 && S.next(i, uu); ++i) if (tid < 256) { const GAS f32x4* pq = (const GAS f32x4*)((const GAS float*)OSSQ + (size_t)(uu.pm * 256 + tid) * 16); const f32x4 a0 = pq[0], a1 = pq[1], b0 = pq[2], b1 = pq[3];
              const float sa = ((a0[0] + a0[1]) + (a0[2] + a0[3])) + ((a1[0] + a1[1]) + (a1[2] + a1[3])), sb = ((b0[0] + b0[1]) + (b0[2] + b0[3])) + ((b1[0] + b1[1]) + (b1[2] + b1[3]));
              const float ra = 1.0f / sqrtf(sa * (1.0f / 512.0f) + EPS), rb = 1.0f / sqrtf(sb * (1.0f / 512.0f) + EPS);
              *(LAS f32x2*)(rsl + (i * 256 + tid) * 2) = (f32x2){ra / rb, rb}; }
          __syncthreads(); }
        pg8::EpiOut E{XN, XRS, X1B, rsl};
        pg8::gemm_phase<pg8::EpiOut, pg8::StaticOrder, true, true, false, false, true, 0x7a7a7a7a, 0x7b7b7b7b, true>(lds, g, S, E);
    }
    SEAM(PH_OUT);

    if (IN(PH_ROUTE)) { PH_BEGIN
        LAS float* Wrg = (LAS float*)(lds + P8_WRG); LAS float* xt = (LAS float*)(lds + P8_XT + wave * P8_XT_WAVE); LAS float* wc = (LAS float*)(lds + P8_WC);
        LAS int* rt_g = (LAS int*)(lds + P8_RT); LAS float* rt_w = (LAS float*)(lds + P8_RT + 1024); LAS int* rt_rank = (LAS int*)(lds + P8_RT + 3072);
        LAS int* lcnt = (LAS int*)(lds + P8_RT + 4096); LAS int* lbase = (LAS int*)(lds + P8_RT + 4608); LAS float* rt_rs = (LAS float*)(lds + P8_RT + 5120);
        for (int k = tid; k < 1024; k += 512) *(LAS f32x4*)(Wrg + 4 * k) = *((const GAS f32x4*)WRGF + k);
        __syncthreads();
        const int r32 = lane & 31, kh = lane >> 5;
        for (int chunk = bx; chunk < T / 256; chunk += G) {
            if (tid < NCLS) lcnt[tid] = 0;
            const int rowc = wave * 32 + r32; const size_t row0w = (size_t)chunk * 256 + wave * 32;
            const GAS bf16* xsrc = (const GAS bf16*)X1B + (row0w + (lane >> 4)) * D + 4 * (lane & 15);
            f32x16 accE = {}; float aG0 = 0.f, aG1 = 0.f, aG2 = 0.f, aG3 = 0.f, ssq = 0.f;
            *(LAS f32x4*)(wc + 4 * tid) = *((const GAS f32x4*)WREF + tid);
            v2u xn[8]; f32x4 gvn;
#pragma unroll
            for (int j = 0; j < 8; ++j) xn[j] = *(const GAS v2u*)(xsrc + (size_t)(4 * j) * D);
            gvn = *(const GAS f32x4*)((const GAS float*)AP->ffn_g + 4 * (lane & 15));
#pragma unroll 1
            for (int kc = 0; kc < 16; ++kc) {
                f32x4 st[8];
#pragma unroll
                for (int j = 0; j < 8; ++j) st[j] = (f32x4){bflo(xn[j].x), bfhi(xn[j].x), bflo(xn[j].y), bfhi(xn[j].y)};
                const f32x4 gv = gvn;
                if (kc + 1 < 16) {
#pragma unroll
                    for (int j = 0; j < 8; ++j) xn[j] = *(const GAS v2u*)(xsrc + (size_t)(4 * j) * D + (kc + 1) * 64);
                    gvn = *(const GAS f32x4*)((const GAS float*)AP->ffn_g + (kc + 1) * 64 + 4 * (lane & 15)); }
                f32x4 wnext = {0.f, 0.f, 0.f, 0.f}; if (kc + 1 < 16) wnext = *((const GAS f32x4*)WREF + (kc + 1) * 512 + tid);
#pragma unroll
                for (int j = 0; j < 8; ++j) *(LAS f32x4*)(xt + ((lane >> 4) + 4 * j) * 68 + 4 * (lane & 15)) = st[j];
                if (kc + 1 < 16) *(LAS f32x4*)(wc + ((kc + 1) & 1) * 2048 + 4 * tid) = wnext;
                {
#pragma unroll
                  for (int j = 0; j < 8; ++j) { const f32x4 hv = st[j] * gv;
                      *(GAS unsigned*)((GAS unsigned char*)YH + (size_t)(row0w + (lane >> 4) + 4 * j) * D + kc * 64 + 4 * (lane & 15)) = pk4_fp8(hv[0], hv[1], hv[2], hv[3]); } }
                __syncthreads();
                const LAS float* wcc = wc + (kc & 1) * 2048 + r32;
#pragma unroll
                for (int c = 0; c < 8; ++c) {
                    const f32x4 xv = *(const LAS f32x4*)(xt + r32 * 68 + 8 * c + 4 * kh);
                    ssq += (xv.x * xv.x + xv.y * xv.y) + (xv.z * xv.z + xv.w * xv.w);
#pragma unroll
                    for (int e = 0; e < 4; ++e) { const int kl = 8 * c + 4 * kh + e;
                        const float a = wcc[kl * 32]; accE = __builtin_amdgcn_mfma_f32_32x32x2f32(a, xv[e], accE, 0, 0, 0);
                        const f32x4 wg = *(const LAS f32x4*)(Wrg + 4 * (kc * 64 + kl)); aG0 += xv[e] * wg[0]; aG1 += xv[e] * wg[1]; aG2 += xv[e] * wg[2]; aG3 += xv[e] * wg[3]; }
                }
                __syncthreads();
            }
            ssq += __shfl_xor(ssq, 32); aG0 += __shfl_xor(aG0, 32); aG1 += __shfl_xor(aG1, 32); aG2 += __shfl_xor(aG2, 32); aG3 += __shfl_xor(aG3, 32);
            const float rstd = 1.0f / sqrtf(ssq * (1.f / D) + EPS);
            float lg[4] = {aG0 * rstd + AP->b_rg[0], aG1 * rstd + AP->b_rg[1], aG2 * rstd + AP->b_rg[2], aG3 * rstd + AP->b_rg[3]};
            int gs = 0; float gm = lg[0];
#pragma unroll
            for (int i = 1; i < 4; ++i) if (lg[i] > gm) { gm = lg[i]; gs = i; }
            float den = 0.f;
#pragma unroll
            for (int i = 0; i < 4; ++i) den += __expf(lg[i] - gm);
            const float gwt = 1.0f / den;
            float mine[4];
#pragma unroll
            for (int i = 0; i < 4; ++i) { const float v = (gs == 0) ? accE[i] : (gs == 1) ? accE[4 + i] : (gs == 2) ? accE[8 + i] : accE[12 + i]; mine[i] = v * rstd + AP->b_re[gs * 8 + 4 * kh + i]; }
            float ev[8];
#pragma unroll
            for (int i = 0; i < 4; ++i) { const float oth = __shfl_xor(mine[i], 32); ev[i] = kh ? oth : mine[i]; ev[4 + i] = kh ? mine[i] : oth; }
            int e1 = 0; float v1 = ev[0];
#pragma unroll
            for (int i = 1; i < 8; ++i) if (ev[i] > v1) { v1 = ev[i]; e1 = i; }
            int e2 = -1; float v2 = -INFINITY;
#pragma unroll
            for (int i = 0; i < 8; ++i) if (i != e1 && (e2 < 0 || ev[i] > v2)) { v2 = ev[i]; e2 = i; }
            const float ex = __expf(v2 - v1); const float w1 = gwt / (1.0f + ex), w2 = gwt * ex / (1.0f + ex);
            if (kh == 0) { const int elo = e1 < e2 ? e1 : e2, ehi = e1 < e2 ? e2 : e1;
                rt_g[rowc] = gs * 28 + ((elo * (15 - elo)) >> 1) + (ehi - elo - 1); rt_w[rowc * 2] = e1 < e2 ? w1 : w2; rt_w[rowc * 2 + 1] = e1 < e2 ? w2 : w1; rt_rs[rowc] = rstd; }
            __syncthreads();
            if (tid < 256) rt_rank[tid] = __hip_atomic_fetch_add(&lcnt[rt_g[tid]], 1, __ATOMIC_RELAXED, __HIP_MEMORY_SCOPE_WORKGROUP);
            __syncthreads();
            if (tid < NCLS) { const int n = lcnt[tid]; lbase[tid] = n ? (int)__hip_atomic_fetch_add((gu32*)(ws + WS_CTL) + CW_GCNT + 64 * tid, (unsigned)n, RLX_AGENT) : 0; }
            __syncthreads();
            if (tid < 256) { const int g = rt_g[tid]; v4u ev; ev.x = (unsigned)(chunk * 256 + tid); ev.y = __builtin_bit_cast(unsigned, rt_w[tid * 2]); ev.z = __builtin_bit_cast(unsigned, rt_w[tid * 2 + 1]); ev.w = __builtin_bit_cast(unsigned, rt_rs[tid]);
                ((GAS v4u*)lists)[(size_t)g * LIST_CAP + lbase[g] + rt_rank[tid]] = ev; }
            __syncthreads();
        }
    }
    SEAM(PH_ROUTE);

    LAS int* tp = (LAS int*)(lds + TP_OFF); LAS int* cntl = (LAS int*)(lds + CNT_OFF); LAS int* ptab = (LAS int*)(lds + PT_OFF);
    if (hi > PH_ROUTE) {
        if (tid0 == 0) { gu32* ctl = (gu32*)(A.ws + WS_CTL); int acc = 0; for (int g = 0; g < NCLS; ++g) { const int n = (int)__hip_atomic_load(ctl + CW_GCNT + 64 * g, RLX_AGENT); cntl[g] = n; tp[g] = acc; acc += (n + 255) >> 8; } tp[NCLS] = acc;
            int p = 0; for (int lo_ = 0; lo_ < 8; ++lo_) for (int hi_ = lo_ + 1; hi_ < 8; ++hi_) ptab[p++] = lo_ | (hi_ << 4); }
        __syncthreads();
    }

    if (IN(PH_GU)) { PH_BEGIN
        pg8::Gemm g{YH, Wgu_t, 0, 0, D / 2}; pg8::ClsOrder S{tp, ptab, 0, G, MOE_SLOT(4), lists, cntl};
        pg8::EpiGateUp2 E{HB, lists, cntl};
        pg8::gemm_phase<pg8::EpiGateUp2, pg8::ClsOrder, true, true, true, false, true>(lds, g, S, E);
    }
    SEAM(PH_GU);

    if (IN(PH_D0)) { PH_BEGIN
        int K512 = 256; asm volatile("" : "+s"(K512)); pg8::Gemm g{HB, Wd_t, 0, 0, K512};        pg8::ClsOrder S{tp, ptab, 1, G, MOE_SLOT(4), lists, cntl};
        pg8::EpiDown2 E{AP->out, X1B, lists, cntl};
        pg8::gemm_phase<pg8::EpiDown2, pg8::ClsOrder, true, true, false, true, true, 0x7b7b7b7b, 0x7c7c7c7c, true>(lds, g, S, E);
    }
#undef IN
#undef SEAM
}

extern "C" void kernel_launch(void* const* d_in, const int* in_sizes, int n_in, void* d_out, int out_size, void* d_ws, size_t ws_size, hipStream_t stream) {
    static int grid = 0;
    if (grid == 0) {
        if (n_in != 22 || in_sizes[0] != T * D || out_size != T * D || ws_size < WS_END) { fprintf(stderr, "kernel_launch: unexpected shapes (n_in %d, in0 %d, out %d, ws %zu); nothing launched\n", n_in, n_in > 0 ? in_sizes[0] : -1, out_size, ws_size); grid = -1; return; }
        int dev = 0, cus = 0, per_cu = 0;
        if (hipGetDevice(&dev) != hipSuccess || hipDeviceGetAttribute(&cus, hipDeviceAttributeMultiprocessorCount, dev) != hipSuccess) { grid = -1; return; }
        if (hipFuncSetAttribute((const void*)mk_fwd, hipFuncAttributeMaxDynamicSharedMemorySize, LDS_BYTES) != hipSuccess) { fprintf(stderr, "kernel_launch: hipFuncSetAttribute failed\n"); grid = -1; return; }
        if (hipOccupancyMaxActiveBlocksPerMultiprocessor(&per_cu, (const void*)mk_fwd, 512, LDS_BYTES) != hipSuccess || per_cu < 1) { fprintf(stderr, "kernel_launch: occupancy query says %d\n", per_cu); }
        (void)hipGetLastError();
        grid = cus;
    }
    if (grid < 0) return;
    if (hipMemsetAsync((char*)d_ws + WS_CTL, 0, CTL_ZERO_BYTES, stream) != hipSuccess) return;
    Args a{};
    a.x = (const float*)d_in[0]; a.attn_g = (const float*)d_in[1]; a.w_in = (const float*)d_in[2]; a.qlat_g = (const float*)d_in[3]; a.w_qup = (const float*)d_in[4];
    a.kvlat_g = (const float*)d_in[5]; a.w_kvup = (const float*)d_in[6]; a.qhead_g = (const float*)d_in[7]; a.khead_g = (const float*)d_in[8];
    a.mqhead_g = (const float*)d_in[9]; a.mkhead_g = (const float*)d_in[10]; a.onorm_a_g = (const float*)d_in[11]; a.onorm_b_g = (const float*)d_in[12];
    a.w_out = (const float*)d_in[13]; a.ffn_g = (const float*)d_in[14]; a.w_rg = (const float*)d_in[15]; a.b_rg = (const float*)d_in[16];
    a.w_re = (const float*)d_in[17]; a.b_re = (const float*)d_in[18]; a.w_gate = (const float*)d_in[19]; a.w_up = (const float*)d_in[20]; a.w_down = (const float*)d_in[21];
    a.out = (float*)d_out; a.ws = (unsigned char*)d_ws; a.ph_lo = 0; a.ph_hi = NPHASE;
    hipLaunchKernelGGL(mk_fwd, dim3(grid), dim3(512), LDS_BYTES, stream, a);
    (void)hipPeekAtLastError();
}
```

```cpp
#include <hip/hip_runtime.h>
#include <cstdio>
#include <cstdint>
namespace pg8 {
#define PG8_LAS __attribute__((address_space(3)))
typedef unsigned short bf16_t;
typedef short bf16x8 __attribute__((ext_vector_type(8)));
typedef float f32x4 __attribute__((ext_vector_type(4)));
typedef unsigned u32x4 __attribute__((ext_vector_type(4)));
constexpr int BM = 256, BK = 64, HALF = 128, HTB = HALF * BK * 2  , STAGE_BYTES = 8 * HTB, NXCD = 8, WGM = 8;

__host__ __device__ __forceinline__ int lds_byte(int r, int c) { const int st = (r >> 4) * 2 + (c >> 5), rr = r & 15, cc = c & 31, ob = rr * 64 + cc * 2; return st * 1024 + (ob ^ (((ob >> 9) & 1) << 5)); }
__host__ __device__ __forceinline__ void stage_rc(int b, int& R, int& C) { const int st = b / 1024, sb = b % 1024, swz = sb ^ (((sb >> 9) & 1) << 5); R = (st >> 1) * 16 + swz / 64; C = (st & 1) * 32 + (swz % 64) / 2; }
__host__ __device__ __forceinline__ int perm32(int rho) { const int n = rho >> 4, i = rho & 15; return 8 * (i >> 2) + 4 * n + (i & 3); }

struct Unit { int pm, pn, g0, g1, pn2, q, hf; };
struct Gemm { const bf16_t* A; const bf16_t* Bt; int M, N, K; };

struct StaticOrder {
    int nM, nN, nwg, G, c;
    __host__ __device__ __forceinline__ void init(int M, int N, int G_, int c_) { nM = M / BM; nN = N / BM; nwg = nM * nN; G = G_; c = c_; }
    __host__ __device__ __forceinline__ bool next(int i, Unit& u) const {
        const long L = (long)i * G + c; if (L >= nwg) return false;
        int wgid = (int)L; { const int q = nwg / NXCD, r = nwg % NXCD, xcd = wgid % NXCD, off = wgid / NXCD; wgid = (xcd < r ? xcd * (q + 1) : r * (q + 1) + (xcd - r) * q) + off; }
        const int nig = WGM * nN, gid = wgid / nig, fm = gid * WGM, gsz = (nM - fm) < WGM ? (nM - fm) : WGM;
        u.pm = fm + ((wgid % nig) % gsz); u.pn = (wgid % nig) / gsz; u.g0 = i; u.g1 = 0; u.pn2 = 0; u.q = 0; u.hf = 0; return true;
    }
    __device__ __forceinline__ void a_ready(const Unit&) const {}
    __device__ __forceinline__ void done(const Unit&) const {}
};

__device__ __forceinline__ unsigned cvt_pk_bf16(float lo, float hi) { unsigned r; asm volatile("v_cvt_pk_bf16_f32 %0, %1, %2" : "=v"(r) : "v"(lo), "v"(hi)); return r; }
#define PG8_GAS __attribute__((address_space(1)))
struct ListEnt { int tok; float w_lo; float w_hi; float rstd; };

struct EpiBf16 {
    static constexpr bool PERM = true, AFTER_DRAIN = false, MIDHOOK = false;
    bf16_t* O; int ldc;
    __device__ __forceinline__ void operator()(const f32x4 (&acc)[2][2][4][2], const Unit& u, int wr, int wc, int fr, int fq) const {
        const int row0 = u.pm * BM + wr * 64 + fr; const int col0 = u.pn * BM + wc * 32 + 8 * fq;
#pragma unroll
        for (int ai = 0; ai < 2; ++ai)
#pragma unroll
            for (int m = 0; m < 4; ++m) { bf16_t* rowp = O + (size_t)(row0 + ai * HALF + m * 16) * ldc + col0;
#pragma unroll
                for (int bj = 0; bj < 2; ++bj) { const f32x4 v0 = acc[ai][bj][m][0], v1 = acc[ai][bj][m][1];
                    u32x4 w; w.x = cvt_pk_bf16(v0[0], v0[1]); w.y = cvt_pk_bf16(v0[2], v0[3]); w.z = cvt_pk_bf16(v1[0], v1[1]); w.w = cvt_pk_bf16(v1[2], v1[3]);
                    *(PG8_GAS u32x4*)(rowp + bj * HALF) = w; } }
    }
};
struct EpiBf16Rs {
    static constexpr bool PERM = true, AFTER_DRAIN = false, MIDHOOK = false;
    bf16_t* O; int ldc; const float* ssq; int off; float inv_n, eps;
    __device__ __forceinline__ void operator()(const f32x4 (&acc)[2][2][4][2], const Unit& u, int wr, int wc, int fr, int fq) const {
        const int row0 = u.pm * BM + wr * 64 + fr; const int col0 = u.pn * BM + wc * 32 + 8 * fq;
#pragma unroll
        for (int ai = 0; ai < 2; ++ai)
#pragma unroll
            for (int m = 0; m < 4; ++m) { const int row = row0 + ai * HALF + m * 16; PG8_GAS bf16_t* rowp = (PG8_GAS bf16_t*)O + (size_t)row * ldc + col0;
                const f32x4 sq = *(const PG8_GAS f32x4*)(ssq + (size_t)row * 8 + off); const float rs = __builtin_amdgcn_rsqf(((sq[0] + sq[1]) + (sq[2] + sq[3])) * inv_n + eps);
#pragma unroll
                for (int bj = 0; bj < 2; ++bj) { const f32x4 v0 = acc[ai][bj][m][0] * rs, v1 = acc[ai][bj][m][1] * rs;
                    u32x4 w; w.x = cvt_pk_bf16(v0[0], v0[1]); w.y = cvt_pk_bf16(v0[2], v0[3]); w.z = cvt_pk_bf16(v1[0], v1[1]); w.w = cvt_pk_bf16(v1[2], v1[3]);
                    *(PG8_GAS u32x4*)(rowp + bj * HALF) = w; } }
    }
};
struct EpiProj {
    static constexpr bool PERM = true, AFTER_DRAIN = false, MIDHOOK = false;
    unsigned char* ws; size_t o_qln, o_kvln, o_qb, o_kb, o_vb, o_ssq, o_kmean, o_rope; const float* gq; const float* gk; float qscale, eps; int seq;
    __device__ __forceinline__ void operator()(const f32x4 (&acc)[2][2][4][2], const Unit& u, int wr, int wc, int fr, int fq) const {
        const int pn = u.pn; const int row0 = u.pm * BM + wr * 64 + fr;
        bf16_t* const QLN = (bf16_t*)(ws + o_qln); bf16_t* const KVLN = (bf16_t*)(ws + o_kvln); bf16_t* const QB = (bf16_t*)(ws + o_qb); bf16_t* const KB = (bf16_t*)(ws + o_kb); bf16_t* const VB = (bf16_t*)(ws + o_vb);
        float* const SSQ = (float*)(ws + o_ssq); float* const kmean = (float*)(ws + o_kmean); const float* const rope = (const float*)(ws + o_rope);
        if (pn < 2) {
            PG8_GAS bf16_t* O = (PG8_GAS bf16_t*)(pn ? KVLN : QLN); PG8_GAS float* sq = (PG8_GAS float*)SSQ;
#pragma unroll
            for (int ai = 0; ai < 2; ++ai)
#pragma unroll
                for (int m = 0; m < 4; ++m) { const int row = row0 + ai * HALF + m * 16; PG8_GAS bf16_t* rowp = O + (size_t)row * 256 + wc * 32 + 8 * fq; float ss = 0.f;
#pragma unroll
                    for (int bj = 0; bj < 2; ++bj) { const f32x4 v0 = acc[ai][bj][m][0], v1 = acc[ai][bj][m][1];
                        if (pn == 0 || bj == 0) ss += (v0[0] * v0[0] + v0[1] * v0[1]) + (v0[2] * v0[2] + v0[3] * v0[3]) + (v1[0] * v1[0] + v1[1] * v1[1]) + (v1[2] * v1[2] + v1[3] * v1[3]);
                        u32x4 w; w.x = cvt_pk_bf16(v0[0], v0[1]); w.y = cvt_pk_bf16(v0[2], v0[3]); w.z = cvt_pk_bf16(v1[0], v1[1]); w.w = cvt_pk_bf16(v1[2], v1[3]);
                        *(PG8_GAS u32x4*)(rowp + bj * HALF) = w; }
                    ss += __shfl_xor(ss, 16); ss += __shfl_xor(ss, 32);
                    if (fq == 0) sq[(size_t)row * 8 + pn * 4 + wc] = ss; }
        } else if (pn < 6) {
            const bool isk = pn >= 4; const int head = (pn & 1) * 4 + wc; const float* gp = isk ? gk : gq; asm volatile("" : "+s"(gp)); const float sc = isk ? 1.0f : qscale;
            PG8_GAS bf16_t* O = (PG8_GAS bf16_t*)(isk ? KB : QB);
            f32x4 g0[2], g1[2];
#pragma unroll
            for (int n = 0; n < 2; ++n) { g0[n] = *(const PG8_GAS f32x4*)(gp + 8 * fq + 4 * n); g1[n] = *(const PG8_GAS f32x4*)(gp + 32 + 8 * fq + 4 * n); }
            f32x4 cs0[2] = {{0.f, 0.f, 0.f, 0.f}, {0.f, 0.f, 0.f, 0.f}}, cs1[2] = {{0.f, 0.f, 0.f, 0.f}, {0.f, 0.f, 0.f, 0.f}};
            f32x4 rc[2][4];
            { const int pos0 = row0 & (seq - 1);
#pragma unroll
              for (int n = 0; n < 2; ++n) { rc[0][n] = *(const PG8_GAS f32x4*)(rope + (size_t)pos0 * 32 + 8 * fq + 4 * n); rc[0][2 + n] = *(const PG8_GAS f32x4*)(rope + (size_t)seq * 32 + (size_t)pos0 * 32 + 8 * fq + 4 * n); } }
#pragma unroll
            for (int ai = 0; ai < 2; ++ai)
#pragma unroll
                for (int m = 0; m < 4; ++m) { const int row = row0 + ai * HALF + m * 16; const int gi = ai * 4 + m;
                    if (gi < 7) { const int gn = gi + 1; const int posn = (row0 + (gn >> 2) * HALF + (gn & 3) * 16) & (seq - 1);
#pragma unroll
                        for (int n = 0; n < 2; ++n) { rc[gn & 1][n] = *(const PG8_GAS f32x4*)(rope + (size_t)posn * 32 + 8 * fq + 4 * n); rc[gn & 1][2 + n] = *(const PG8_GAS f32x4*)(rope + (size_t)seq * 32 + (size_t)posn * 32 + 8 * fq + 4 * n); } }
                    float ss = 0.f;
#pragma unroll
                    for (int n = 0; n < 2; ++n) { const f32x4 a = acc[ai][0][m][n], b = acc[ai][1][m][n]; ss += (a[0] * a[0] + a[1] * a[1]) + (a[2] * a[2] + a[3] * a[3]) + (b[0] * b[0] + b[1] * b[1]) + (b[2] * b[2] + b[3] * b[3]); }
                    ss += __shfl_xor(ss, 16); ss += __shfl_xor(ss, 32);
                    const float rs = __builtin_amdgcn_rsqf(ss * (1.0f / 64.0f) + eps);
                    u32x4 w1, w2; unsigned pk1[4], pk2_[4];
#pragma unroll
                    for (int n = 0; n < 2; ++n) { const f32x4 c = rc[gi & 1][n], sn = rc[gi & 1][2 + n];
                        const f32x4 y1 = acc[ai][0][m][n] * rs * g0[n], y2 = acc[ai][1][m][n] * rs * g1[n];
                        const f32x4 o1 = (y1 * c - y2 * sn) * sc, o2 = (y2 * c + y1 * sn) * sc;
                        if (isk) { cs0[n] += o1; cs1[n] += o2; }
                        pk1[2 * n] = cvt_pk_bf16(o1[0], o1[1]); pk1[2 * n + 1] = cvt_pk_bf16(o1[2], o1[3]); pk2_[2 * n] = cvt_pk_bf16(o2[0], o2[1]); pk2_[2 * n + 1] = cvt_pk_bf16(o2[2], o2[3]); }
                    w1.x = pk1[0]; w1.y = pk1[1]; w1.z = pk1[2]; w1.w = pk1[3]; w2.x = pk2_[0]; w2.y = pk2_[1]; w2.z = pk2_[2]; w2.w = pk2_[3];
                    PG8_GAS bf16_t* rowp = O + (size_t)row * 512 + head * 64 + 8 * fq;
                    *(PG8_GAS u32x4*)rowp = w1; *(PG8_GAS u32x4*)(rowp + 32) = w2;
                    asm volatile("" : "+v"(cs0[0]), "+v"(cs0[1]), "+v"(cs1[0]), "+v"(cs1[1]) :: "memory"); }
            if (isk) {
                PG8_GAS float* km = (PG8_GAS float*)kmean + ((size_t)u.pm * 8 + head) * 64;
#pragma unroll
                for (int n = 0; n < 2; ++n)
#pragma unroll
                    for (int j = 0; j < 4; ++j) { float a = cs0[n][j], b = cs1[n][j];
#pragma unroll
                        for (int o = 1; o < 16; o <<= 1) { a += __shfl_xor(a, o); b += __shfl_xor(b, o); }
                        if (fr == 0) { __hip_atomic_fetch_add(km + 8 * fq + 4 * n + j, a * (1.0f / 256.0f), __ATOMIC_RELAXED, __HIP_MEMORY_SCOPE_AGENT); __hip_atomic_fetch_add(km + 32 + 8 * fq + 4 * n + j, b * (1.0f / 256.0f), __ATOMIC_RELAXED, __HIP_MEMORY_SCOPE_AGENT); } }
            }
        } else {
            PG8_GAS bf16_t* O = (PG8_GAS bf16_t*)VB; const int col0 = (pn - 6) * BM + wc * 32 + 8 * fq;
#pragma unroll
            for (int ai = 0; ai < 2; ++ai)
#pragma unroll
                for (int m = 0; m < 4; ++m) { PG8_GAS bf16_t* rowp = O + (size_t)(row0 + ai * HALF + m * 16) * 512 + col0;
#pragma unroll
                    for (int bj = 0; bj < 2; ++bj) { const f32x4 v0 = acc[ai][bj][m][0], v1 = acc[ai][bj][m][1];
                        u32x4 w; w.x = cvt_pk_bf16(v0[0], v0[1]); w.y = cvt_pk_bf16(v0[2], v0[3]); w.z = cvt_pk_bf16(v1[0], v1[1]); w.w = cvt_pk_bf16(v1[2], v1[3]);
                        *(PG8_GAS u32x4*)(rowp + bj * HALF) = w; } }
        }
    }
};
struct EpiKv {
    static constexpr bool PERM = true, AFTER_DRAIN = false, MIDHOOK = false;
    bf16_t* KA; bf16_t* VA; const bf16_t* KVLN; const float* ssq; const float* ropeR; const float* gk; float eps; int seq;
    __device__ __forceinline__ void operator()(const f32x4 (&acc)[2][2][4][2], const Unit& u, int wr, int wc, int fr, int fq) const {
        const int pn = u.pn; const int row0 = u.pm * BM + wr * 64 + fr;
        if (pn < 2) {
            const int head = pn * 4 + wc; const float* gp = gk; asm volatile("" : "+s"(gp));
            f32x4 g0[2], g1[2];
#pragma unroll
            for (int n = 0; n < 2; ++n) { g0[n] = *(const PG8_GAS f32x4*)(gp + 8 * fq + 4 * n); g1[n] = *(const PG8_GAS f32x4*)(gp + 32 + 8 * fq + 4 * n); }
            const f32x4 gr1 = *(const PG8_GAS f32x4*)(gp + 64 + 4 * fq), gr2 = *(const PG8_GAS f32x4*)(gp + 80 + 4 * fq);
#pragma unroll
            for (int ai = 0; ai < 2; ++ai)
#pragma unroll
                for (int m = 0; m < 4; ++m) { const int row = row0 + ai * HALF + m * 16; const int pos = row & (seq - 1);
                    const f32x4 sq = *(const PG8_GAS f32x4*)(ssq + (size_t)row * 8 + 4); const float rl = __builtin_amdgcn_rsqf(((sq[0] + sq[1]) + (sq[2] + sq[3])) * (1.0f / 128.0f) + eps);
                    const PG8_GAS bf16_t* pe = (const PG8_GAS bf16_t*)KVLN + (size_t)row * 256 + 128 + 4 * fq;
                    typedef unsigned u32x2_ __attribute__((ext_vector_type(2)));
                    const u32x2_ p1 = *(const PG8_GAS u32x2_*)pe, p2 = *(const PG8_GAS u32x2_*)(pe + 16);
                    const f32x4 e1 = {__builtin_bit_cast(float, p1.x << 16), __builtin_bit_cast(float, p1.x & 0xffff0000u), __builtin_bit_cast(float, p1.y << 16), __builtin_bit_cast(float, p1.y & 0xffff0000u)};
                    const f32x4 e2 = {__builtin_bit_cast(float, p2.x << 16), __builtin_bit_cast(float, p2.x & 0xffff0000u), __builtin_bit_cast(float, p2.y << 16), __builtin_bit_cast(float, p2.y & 0xffff0000u)};
                    f32x4 x0[2], x1[2]; float ss = (e1[0] * e1[0] + e1[1] * e1[1]) + (e1[2] * e1[2] + e1[3] * e1[3]) + (e2[0] * e2[0] + e2[1] * e2[1]) + (e2[2] * e2[2] + e2[3] * e2[3]);
#pragma unroll
                    for (int n = 0; n < 2; ++n) { x0[n] = acc[ai][0][m][n] * rl; x1[n] = acc[ai][1][m][n] * rl; const f32x4 a = x0[n], b = x1[n];
                        ss += (a[0] * a[0] + a[1] * a[1]) + (a[2] * a[2] + a[3] * a[3]) + (b[0] * b[0] + b[1] * b[1]) + (b[2] * b[2] + b[3] * b[3]); }
                    ss += __shfl_xor(ss, 16); ss += __shfl_xor(ss, 32);
                    const float rs = __builtin_amdgcn_rsqf(ss * (1.0f / 96.0f) + eps);
                    PG8_GAS bf16_t* rowp = (PG8_GAS bf16_t*)KA + (size_t)row * 768 + head * 96;
                    u32x4 w1, w2;
                    { const f32x4 a = x0[0] * rs * g0[0], b = x0[1] * rs * g0[1]; w1.x = cvt_pk_bf16(a[0], a[1]); w1.y = cvt_pk_bf16(a[2], a[3]); w1.z = cvt_pk_bf16(b[0], b[1]); w1.w = cvt_pk_bf16(b[2], b[3]); }
                    { const f32x4 a = x1[0] * rs * g1[0], b = x1[1] * rs * g1[1]; w2.x = cvt_pk_bf16(a[0], a[1]); w2.y = cvt_pk_bf16(a[2], a[3]); w2.z = cvt_pk_bf16(b[0], b[1]); w2.w = cvt_pk_bf16(b[2], b[3]); }
                    *(PG8_GAS u32x4*)(rowp + 8 * fq) = w1; *(PG8_GAS u32x4*)(rowp + 32 + 8 * fq) = w2;
                    const f32x4 c = *(const PG8_GAS f32x4*)(ropeR + (size_t)pos * 16 + 4 * fq), sn = *(const PG8_GAS f32x4*)(ropeR + (size_t)seq * 16 + (size_t)pos * 16 + 4 * fq);
                    const f32x4 y1 = e1 * rs * gr1, y2 = e2 * rs * gr2; const f32x4 o1 = y1 * c - y2 * sn, o2 = y2 * c + y1 * sn;
                    u32x2_ r1, r2; r1.x = cvt_pk_bf16(o1[0], o1[1]); r1.y = cvt_pk_bf16(o1[2], o1[3]); r2.x = cvt_pk_bf16(o2[0], o2[1]); r2.y = cvt_pk_bf16(o2[2], o2[3]);
                    *(PG8_GAS u32x2_*)(rowp + 64 + 4 * fq) = r1; *(PG8_GAS u32x2_*)(rowp + 80 + 4 * fq) = r2;
                    asm volatile("" ::: "memory"); }
        } else {
            const int col0 = (pn - 2) * BM + wc * 32 + 8 * fq;
#pragma unroll
            for (int ai = 0; ai < 2; ++ai)
#pragma unroll
                for (int m = 0; m < 4; ++m) { const int row = row0 + ai * HALF + m * 16; PG8_GAS bf16_t* rowp = (PG8_GAS bf16_t*)VA + (size_t)row * 512 + col0;
                    const f32x4 sq = *(const PG8_GAS f32x4*)(ssq + (size_t)row * 8 + 4); const float rl = __builtin_amdgcn_rsqf(((sq[0] + sq[1]) + (sq[2] + sq[3])) * (1.0f / 128.0f) + eps);
#pragma unroll
                    for (int bj = 0; bj < 2; ++bj) { const f32x4 v0 = acc[ai][bj][m][0] * rl, v1 = acc[ai][bj][m][1] * rl;
                        u32x4 w; w.x = cvt_pk_bf16(v0[0], v0[1]); w.y = cvt_pk_bf16(v0[2], v0[3]); w.z = cvt_pk_bf16(v1[0], v1[1]); w.w = cvt_pk_bf16(v1[2], v1[3]);
                        *(PG8_GAS u32x4*)(rowp + bj * HALF) = w; } }
        }
    }
};
struct EpiOut {
    static constexpr bool PERM = true, AFTER_DRAIN = false, MIDHOOK = true;
    const bf16_t* xn; const float* xrs; bf16_t* x1b; const PG8_LAS float* rsl;
    __device__ __forceinline__ void mid(f32x4 (&acc)[2][2][4][2], const Unit& u, int wr, int wc, int fr, int fq) const {
        const PG8_LAS float* rs = rsl + (u.g0 * 256 + wr * 64 + fr) * 2;
#pragma unroll
        for (int ai = 0; ai < 2; ++ai)
#pragma unroll
            for (int m = 0; m < 4; ++m) { const float ratio = rs[(ai * HALF + m * 16) * 2];
#pragma unroll
                for (int bj = 0; bj < 2; ++bj)
#pragma unroll
                    for (int n = 0; n < 2; ++n) acc[ai][bj][m][n] *= ratio; }
    }
    __device__ __forceinline__ void operator()(const f32x4 (&acc)[2][2][4][2], const Unit& u, int wr, int wc, int fr, int fq) const {
        const int row0 = u.pm * BM + wr * 64 + fr; const int col0 = u.pn * BM + wc * 32 + 8 * fq;
        const PG8_LAS float* rs = rsl + (u.g0 * 256 + wr * 64 + fr) * 2 + 1;
        float xs[8];
#pragma unroll
        for (int i = 0; i < 8; ++i) xs[i] = *(const PG8_GAS float*)(xrs + row0 + (i >> 2) * HALF + (i & 3) * 16);
        u32x4 xr[2][4];
#pragma unroll
        for (int g = 0; g < 2; ++g) { const size_t off = (size_t)(row0 + g * 16) * 1024 + col0;
#pragma unroll
            for (int bj = 0; bj < 2; ++bj) xr[0][g * 2 + bj] = *(const PG8_GAS u32x4*)(xn + off + bj * HALF); }
#pragma unroll
        for (int pr = 0; pr < 4; ++pr) {
            if (pr < 3) {
#pragma unroll
                for (int g = 0; g < 2; ++g) { const int gi = 2 * (pr + 1) + g; const size_t off = (size_t)(row0 + (gi >> 2) * HALF + (gi & 3) * 16) * 1024 + col0;
#pragma unroll
                    for (int bj = 0; bj < 2; ++bj) xr[(pr + 1) & 1][g * 2 + bj] = *(const PG8_GAS u32x4*)(xn + off + bj * HALF); } }
#pragma unroll
            for (int g = 0; g < 2; ++g) { const int gi = 2 * pr + g; const int ai = gi >> 2, m = gi & 3; const size_t off = (size_t)(row0 + ai * HALF + m * 16) * 1024 + col0; const float rb = rs[(ai * HALF + m * 16) * 2]; const float sx = xs[gi];
#pragma unroll
                for (int bj = 0; bj < 2; ++bj) { const size_t p = off + bj * HALF; const u32x4 x = xr[pr & 1][g * 2 + bj];
                    f32x4 x0, x1; x0[0] = __builtin_bit_cast(float, x.x << 16); x0[1] = __builtin_bit_cast(float, x.x & 0xffff0000u); x0[2] = __builtin_bit_cast(float, x.y << 16); x0[3] = __builtin_bit_cast(float, x.y & 0xffff0000u);
                    x1[0] = __builtin_bit_cast(float, x.z << 16); x1[1] = __builtin_bit_cast(float, x.z & 0xffff0000u); x1[2] = __builtin_bit_cast(float, x.w << 16); x1[3] = __builtin_bit_cast(float, x.w & 0xffff0000u);
                    const f32x4 v0 = x0 * sx + acc[ai][bj][m][0] * rb, v1 = x1 * sx + acc[ai][bj][m][1] * rb;
                    u32x4 o; o.x = cvt_pk_bf16(v0[0], v0[1]); o.y = cvt_pk_bf16(v0[2], v0[3]); o.z = cvt_pk_bf16(v1[0], v1[1]); o.w = cvt_pk_bf16(v1[2], v1[3]);
                    *(PG8_GAS u32x4*)(x1b + p) = o; } }
            asm volatile("" ::: "memory"); }
    }
};
struct EpiGateUp2 {
    static constexpr bool PERM = true, AFTER_DRAIN = false, MIDHOOK = false;
    bf16_t* H; const ListEnt* lists; const PG8_LAS int* cnt;
    __device__ __forceinline__ void operator()(const f32x4 (&acc)[2][2][4][2], const Unit& u, int wr, int wc, int fr, int fq) const {
        const int rt0 = wr * 64 + fr; const int col0 = (u.q >> 1) * 256 + (u.q & 1) * 128 + wc * 32 + 8 * fq; const int g = u.g0; const int n_g = cnt[g]; const bool hiexp = (u.q >> 1) != 0;
        const ListEnt* lg = lists + (size_t)g * 65536 + u.g1 * 256;
        float wv[8], rv[8];
#pragma unroll
        for (int i = 0; i < 8; ++i) { const int rt = rt0 + (i >> 2) * HALF + (i & 3) * 16; f32x4 le = {0.f, 0.f, 0.f, 0.f}; if ((u.g1 * 256 + rt) < n_g) le = *(const PG8_GAS f32x4*)((const PG8_GAS ListEnt*)lg + rt); wv[i] = hiexp ? le[2] : le[1]; rv[i] = le[3]; }
#pragma unroll
        for (int ai = 0; ai < 2; ++ai) { if (ai == 1 && u.hf) break;
#pragma unroll
            for (int m = 0; m < 4; ++m) { const int rt = rt0 + ai * HALF + m * 16; const bool valid = (u.g1 * 256 + rt) < n_g;
                const float w = wv[ai * 4 + m], rsd = rv[ai * 4 + m];
                unsigned pk[2];
#pragma unroll
                for (int n = 0; n < 2; ++n) { const f32x4 gv = acc[ai][0][m][n], uv = acc[ai][1][m][n]; float h[4];
#pragma unroll
                    for (int j = 0; j < 4; ++j) { const float a = gv[j] * rsd; const float s = a * __builtin_amdgcn_rcpf(1.0f + __builtin_amdgcn_exp2f(-1.4426950408889634f * a)); h[j] = valid ? s * (uv[j] * rsd) * w : 0.f; }
                    { int w_ = 0; w_ = __builtin_amdgcn_cvt_pk_fp8_f32(h[0] * 8.0f, h[1] * 8.0f, w_, false); w_ = __builtin_amdgcn_cvt_pk_fp8_f32(h[2] * 8.0f, h[3] * 8.0f, w_, true); pk[n] = (unsigned)w_; } }
                typedef unsigned u32x2h_ __attribute__((ext_vector_type(2))); u32x2h_ o; o.x = pk[0]; o.y = pk[1];
                *(PG8_GAS u32x2h_*)((PG8_GAS unsigned char*)H + (size_t)(u.pm * BM + rt) * 512 + col0) = o; } }
    }
};
struct EpiDown2 {
    static constexpr bool PERM = true, AFTER_DRAIN = false, MIDHOOK = false;
    float* out; const bf16_t* x1b; const ListEnt* lists; const PG8_LAS int* cnt;
    __device__ __forceinline__ void operator()(const f32x4 (&acc)[2][2][4][2], const Unit& u, int wr, int wc, int fr, int fq) const {
        const int rt0 = wr * 64 + fr; const int col0 = u.q * 256 + wc * 32 + 8 * fq; const int g = u.g0; const int n_g = cnt[g];
        const ListEnt* lg = lists + (size_t)g * 65536 + u.g1 * 256;
        int tokv[8];
#pragma unroll
        for (int i = 0; i < 8; ++i) { const int rt = rt0 + (i >> 2) * HALF + (i & 3) * 16; tokv[i] = ((u.g1 * 256 + rt) < n_g) ? ((const PG8_GAS ListEnt*)lg)[rt].tok : -1; }
#pragma unroll
        for (int ai = 0; ai < 2; ++ai) { if (ai == 1 && u.hf) break;
            u32x4 xb[4][2];
#pragma unroll
            for (int m = 0; m < 4; ++m)
#pragma unroll
                for (int bj = 0; bj < 2; ++bj) { const int tok = tokv[ai * 4 + m]; xb[m][bj] = (u32x4){0u, 0u, 0u, 0u}; if (tok >= 0) xb[m][bj] = *(const PG8_GAS u32x4*)((const PG8_GAS bf16_t*)x1b + (size_t)tok * 1024 + col0 + bj * HALF); }
#pragma unroll
            for (int m = 0; m < 4; ++m) { const int tok = tokv[ai * 4 + m];
                if (tok >= 0) { PG8_GAS float* orow = (PG8_GAS float*)out + (size_t)tok * 1024 + col0;
#pragma unroll
                    for (int bj = 0; bj < 2; ++bj) { PG8_GAS float* p = orow + bj * HALF; const u32x4 x = xb[m][bj];
                        f32x4 a, b; a[0] = __builtin_bit_cast(float, x.x << 16); a[1] = __builtin_bit_cast(float, x.x & 0xffff0000u); a[2] = __builtin_bit_cast(float, x.y << 16); a[3] = __builtin_bit_cast(float, x.y & 0xffff0000u);
                        b[0] = __builtin_bit_cast(float, x.z << 16); b[1] = __builtin_bit_cast(float, x.z & 0xffff0000u); b[2] = __builtin_bit_cast(float, x.w << 16); b[3] = __builtin_bit_cast(float, x.w & 0xffff0000u);
                        *(PG8_GAS f32x4*)p = a + acc[ai][bj][m][0]; *(PG8_GAS f32x4*)(p + 4) = b + acc[ai][bj][m][1]; } } }
            asm volatile("" ::: "memory"); }
    }
};
template <class S_> struct SchedHalf { static constexpr bool v = false; };
struct ClsOrder {
    const PG8_LAS int* tp; int mode, G, c; const ListEnt* lists;
    __device__ __forceinline__ int arow(const Unit& u, int row) const { const PG8_LAS int* cnt = tp + 128; const unsigned pos = (unsigned)(u.g1 * 256 + row); const unsigned n = (unsigned)cnt[u.g0]; const PG8_GAS ListEnt* lg = (const PG8_GAS ListEnt*)lists + (size_t)u.g0 * 65536; return lg[pos < n ? pos : 0u].tok; }
    __device__ __forceinline__ bool next(int i, Unit& u) const {
        const PG8_LAS int* cnt = tp + 128; const PG8_LAS int* ptab = tp + 256; const PG8_LAS int* tpf = tp + 320; const PG8_LAS int* tph = tp + 448;
        const int j = c >> 2, q = c & 3, NQ = G >> 2; const int nF = tpf[112], nH = tph[112];
        const int nfj = (j < nF) ? (nF - j + NQ - 1) / NQ : 0;
        int idx; bool hf;
        if (i < nfj) { idx = j + NQ * i; hf = false; }
        else { const int k = i - nfj, R = nF % NQ, Lq = NQ - R; int h;
            if (j >= R) h = (k < 2) ? (j - R) + Lq * k : 2 * Lq + j + NQ * (k - 2); else h = 2 * Lq + j + NQ * k;
            if (h >= nH) return false; idx = h; hf = true; }
        const PG8_LAS int* tb = hf ? tph : tpf;
        int g = 0;
#pragma unroll
        for (int s = 64; s >= 1; s >>= 1) { const int gg = g + s; if (gg < 112 && tb[gg] <= idx) g = gg; }
        const int grp = g / 28, pr = ptab[g - grp * 28], lo = pr & 15, hi = pr >> 4;
        const int g1 = hf ? (cnt[g] >> 8) : idx - tb[g];
        u.pm = tp[g] + g1; u.g0 = g; u.g1 = g1; u.q = q; u.hf = hf ? 1 : 0;
        if (mode == 0) { u.pn = (grp * 8 + ((q >> 1) ? hi : lo)) * 2 + (q & 1); u.pn2 = 0; } else { u.pn = (grp * 8 + lo) * 4 + q; u.pn2 = (grp * 8 + hi) * 4 + q; }
        return true;
    }
    __device__ __forceinline__ void a_ready(const Unit&) const {}
    __device__ __forceinline__ void done(const Unit&) const {}
};
template <> struct SchedHalf<ClsOrder> { static constexpr bool v = true; };

template <class Epi, class Sched, bool ALIGN_EPI = false, bool SP2 = false, bool GATHER = false, bool KSPLIT = false, bool F8 = false, int SCW = 0x7a7a7a7a, int SCA = 0x7f7f7f7f, bool F8ASM = false>
__device__ __forceinline__ void gemm_phase(PG8_LAS unsigned char* lds, const Gemm g, const Sched& S, const Epi& E) {
    const int tid = threadIdx.x, wid = __builtin_amdgcn_readfirstlane(tid >> 6), lane = tid & 63, wr = wid >> 2, wc = wid & 3, fr = lane & 15, fq = lane >> 4;
    const int K = g.K, nt = K / BK;
    const int PB = KSPLIT ? (K >> 1) : K;
    static_assert(!GATHER || SP2, "gathered A rows: SP2 loop only");
    unsigned voffA[2], voffB[2];
#pragma unroll
    for (int i = 0; i < 2; ++i) { int R, C; stage_rc(tid * 16 + i * 8192, R, C); const int Rb = Epi::PERM ? ((R & ~31) + perm32(R & 31)) : R;
        voffA[i] = (unsigned)(R * K + C) * 2u; voffB[i] = (unsigned)(Rb * PB + C) * 2u; }
    const size_t kstep = (size_t)(BK * 2);
    const size_t hstep = (size_t)HALF * K * 2;
    const size_t tstep = 2 * hstep;
    const size_t hstepB = (size_t)HALF * PB * 2, tstepB = 2 * hstepB;
    const unsigned ldsw = (unsigned)wid * 1024u;
    const int aoff = lds_byte(wr * 64 + fr, fq * 8), boff = lds_byte(wc * 32 + fr, fq * 8);
#define PG8_SA(b, h) (((b) * 2 + (h)) * HTB)
#define PG8_SB(b, h) ((4 + (b) * 2 + (h)) * HTB)
#define PG8_STAGE(bufoff, gbase, voff) do { _Pragma("unroll") for (int _i = 0; _i < 2; ++_i) \
        __builtin_amdgcn_global_load_lds((const unsigned*)((const char*)(gbase) + (voff)[_i]), (PG8_LAS unsigned*)(lds + (bufoff) + ldsw + _i * 8192), 16, 0, 0); } while (0)
#define PG8_LDA(dst, b, h) do { _Pragma("unroll") for (int m = 0; m < 4; ++m) _Pragma("unroll") for (int k = 0; k < 2; ++k) dst[m][k] = *(const PG8_LAS bf16x8*)(lds + PG8_SA(b, h) + aoff + m * 2048 + k * 1024); } while (0)
#define PG8_LDB(dst, b, h) do { _Pragma("unroll") for (int n = 0; n < 2; ++n) _Pragma("unroll") for (int k = 0; k < 2; ++k) dst[n][k] = *(const PG8_LAS bf16x8*)(lds + PG8_SB(b, h) + boff + n * 2048 + k * 1024); } while (0)
#define PG8_MMA(ai, bj, At, Bt) do { __builtin_amdgcn_s_setprio(1); _Pragma("unroll") for (int m = 0; m < 4; ++m) _Pragma("unroll") for (int n = 0; n < 2; ++n) { \
        if constexpr (F8) { typedef int v4i_ __attribute__((ext_vector_type(4))); typedef int v8i_ __attribute__((ext_vector_type(8))); \
            const v8i_ w8_ = __builtin_shufflevector(__builtin_bit_cast(v4i_, Bt[n][0]), __builtin_bit_cast(v4i_, Bt[n][1]), 0, 1, 2, 3, 4, 5, 6, 7); \
            const v8i_ a8_ = __builtin_shufflevector(__builtin_bit_cast(v4i_, At[m][0]), __builtin_bit_cast(v4i_, At[m][1]), 0, 1, 2, 3, 4, 5, 6, 7); \
            if constexpr (F8ASM) { asm volatile("v_mfma_scale_f32_16x16x128_f8f6f4 %0, %1, %2, %0, %3, %4 op_sel_hi:[0,0,0]" : "+v"(acc[ai][bj][m][n]) : "v"(w8_), "v"(a8_), "v"(SCW), "v"(SCA)); }     \
            else acc[ai][bj][m][n] = __builtin_amdgcn_mfma_scale_f32_16x16x128_f8f6f4(w8_, a8_, acc[ai][bj][m][n], 0, 0, 0, SCW, 0, SCA); } \
        else { _Pragma("unroll") for (int k = 0; k < 2; ++k) acc[ai][bj][m][n] = __builtin_amdgcn_mfma_f32_16x16x32_bf16(Bt[n][k], At[m][k], acc[ai][bj][m][n], 0, 0, 0); } } \
        __builtin_amdgcn_s_setprio(0); } while (0)
#define PG8_WAIT_V(n) asm volatile("s_waitcnt vmcnt(" #n ")" ::: "memory")
#define PG8_WAIT_L(n) asm volatile("s_waitcnt lgkmcnt(" #n ")" ::: "memory")
#define PG8_BAR __builtin_amdgcn_s_barrier()
#define PG8_SCHED __builtin_amdgcn_sched_barrier(0)
#define PG8_STG_A(b, h, ptr, arr) do { if constexpr (GATHER) { PG8_STAGE(PG8_SA(b, h), (ptr), (arr)[h]); } else { PG8_STAGE(PG8_SA(b, h), (ptr) + ((h) ? hstep : 0), voffA); } } while (0)
    unsigned cv[2][2] = {{0u, 0u}, {0u, 0u}}, nvp[2] = {0u, 0u};
#define PG8_GROWS(dst, unit) do { if constexpr (GATHER) { _Pragma("unroll") for (int _h = 0; _h < 2; ++_h) _Pragma("unroll") for (int _i = 0; _i < 2; ++_i) { int R_, C_; stage_rc(tid * 16 + _i * 8192, R_, C_); \
        dst[_h][_i] = (unsigned)S.arow(unit, _h * HALF + R_) * (unsigned)(K * 2) + (unsigned)(C_ * 2); } } } while (0)
    Unit cur, nxt; int ui = 0;
    if (!S.next(0, cur)) return;
    PG8_GROWS(cv, cur);
#define PG8_GROWS_P(unit) do { _Pragma("unroll") for (int _i = 0; _i < 2; ++_i) { int R_, C_; stage_rc(tid * 16 + _i * 8192, R_, C_); nvp[_i] = (unsigned)S.arow(unit, R_) | ((unsigned)S.arow(unit, HALF + R_) << 16); } } while (0)
#define PG8_UNPACK_NV() do { _Pragma("unroll") for (int _i = 0; _i < 2; ++_i) { int R_, C_; stage_rc(tid * 16 + _i * 8192, R_, C_); cv[0][_i] = (nvp[_i] & 0xffffu) * (unsigned)(K * 2) + (unsigned)(C_ * 2); cv[1][_i] = (nvp[_i] >> 16) * (unsigned)(K * 2) + (unsigned)(C_ * 2); } } while (0)
    f32x4 acc[2][2][4][2];
#pragma unroll
    for (int a = 0; a < 2; ++a)
#pragma unroll
        for (int b = 0; b < 2; ++b)
#pragma unroll
            for (int m = 0; m < 4; ++m)
#pragma unroll
                for (int n = 0; n < 2; ++n) acc[a][b][m][n] = (f32x4){0.f, 0.f, 0.f, 0.f};
    bf16x8 At[4][2], B0[2][2], B1[2][2];
    const char* cA = (const char*)g.A + (GATHER ? (size_t)0 : (size_t)cur.pm * tstep); const char* cB = (const char*)g.Bt + (size_t)cur.pn * tstepB; const char* cB2 = KSPLIT ? (const char*)g.Bt + (size_t)cur.pn2 * tstepB : cB;
    S.a_ready(cur);
    if constexpr (SP2) {
        PG8_STAGE(PG8_SB(0, 0), cB, voffB); PG8_STAGE(PG8_SB(0, 1), cB + hstepB, voffB); PG8_STG_A(0, 0, cA, cv); PG8_STG_A(0, 1, cA, cv);
        if (wr == 1) PG8_BAR;
        PG8_WAIT_V(2); PG8_BAR;
        PG8_STAGE(PG8_SB(1, 0), cB + kstep, voffB); PG8_STG_A(1, 0, cA + kstep, cv); PG8_STAGE(PG8_SB(1, 1), cB + hstepB + kstep, voffB);
        PG8_WAIT_V(6); PG8_BAR;
    } else {
        PG8_STAGE(PG8_SB(0, 0), cB, voffB); PG8_STAGE(PG8_SA(0, 0), cA, voffA); PG8_STAGE(PG8_SB(0, 1), cB + hstepB, voffB); PG8_STAGE(PG8_SA(0, 1), cA + hstep, voffA);
        if (wr == 1) PG8_BAR;
        PG8_WAIT_V(4); PG8_BAR;
        PG8_STAGE(PG8_SB(1, 0), cB + kstep, voffB); PG8_STAGE(PG8_SA(1, 0), cA + kstep, voffA); PG8_STAGE(PG8_SB(1, 1), cB + hstepB + kstep, voffB);
        PG8_WAIT_V(6); PG8_BAR;
    }
    for (;;) {
        const bool has_next = S.next(ui + 1, nxt);
        const char* nA = (has_next && !GATHER) ? (const char*)g.A + (size_t)nxt.pm * tstep : cA; const char* nB = has_next ? (const char*)g.Bt + (size_t)nxt.pn * tstepB : cB; const char* nB2 = (KSPLIT && has_next) ? (const char*)g.Bt + (size_t)nxt.pn2 * tstepB : cB2;
        if constexpr (GATHER) { if (has_next) { PG8_GROWS_P(nxt); } else { PG8_GROWS_P(cur); } }
        bool hfu = false; if constexpr (SchedHalf<Sched>::v) hfu = (cur.hf != 0);
        const int tspan = Epi::MIDHOOK ? (nt >> 1) : nt;
        for (int t0 = 0; t0 < nt; t0 += tspan) {
        if constexpr (Epi::MIDHOOK) { if (t0 != 0) E.mid(acc, cur, wr, wc, fr, fq); }
        for (int t = t0; t < t0 + tspan; t += 2) {
            const bool last = (t == nt - 2);
            const char* a1 = cA + (size_t)(t + 1) * kstep;
            const char* a2 = last ? nA : cA + (size_t)(t + 2) * kstep; const char* b2 = last ? nB : ((KSPLIT && t + 2 >= (nt >> 1)) ? cB2 + (size_t)(t + 2 - (nt >> 1)) * kstep : cB + (size_t)(t + 2) * kstep);
            const char* a3 = a2 + kstep; const char* b3 = b2 + kstep;
            if (last && has_next) S.a_ready(nxt);
            if constexpr (SP2) {
            PG8_LDB(B0, 0, 0); PG8_LDB(B1, 0, 1); PG8_SCHED; PG8_LDA(At, 0, 0); PG8_STG_A(1, 1, a1, cv);
            if constexpr (GATHER) { if (last) { PG8_UNPACK_NV(); } }
            PG8_WAIT_V(8); PG8_WAIT_L(0); PG8_BAR; PG8_MMA(0, 0, At, B0); PG8_MMA(0, 1, At, B1); PG8_BAR; PG8_SCHED;
            if (!hfu) { PG8_LDA(At, 0, 1); } PG8_STAGE(PG8_SB(0, 0), b2, voffB); PG8_STAGE(PG8_SB(0, 1), b2 + hstepB, voffB); PG8_STG_A(0, 0, a2, cv);
            PG8_WAIT_V(8); PG8_WAIT_L(0); PG8_BAR; if (!hfu) { PG8_MMA(1, 0, At, B0); PG8_MMA(1, 1, At, B1); } PG8_BAR; PG8_SCHED;
            PG8_LDB(B0, 1, 0); PG8_LDB(B1, 1, 1); PG8_SCHED; PG8_LDA(At, 1, 0); PG8_STG_A(0, 1, a2, cv);
            PG8_WAIT_V(8); PG8_WAIT_L(0); PG8_BAR; PG8_MMA(0, 0, At, B0); PG8_MMA(0, 1, At, B1); PG8_BAR; PG8_SCHED;
            if (!hfu) { PG8_LDA(At, 1, 1); } PG8_STAGE(PG8_SB(1, 0), b3, voffB); PG8_STAGE(PG8_SB(1, 1), b3 + hstepB, voffB); PG8_STG_A(1, 0, a3, cv);
            PG8_WAIT_V(8); PG8_WAIT_L(0); PG8_BAR; if (!hfu) { PG8_MMA(1, 0, At, B0); PG8_MMA(1, 1, At, B1); } PG8_BAR; PG8_SCHED;
            } else {
            PG8_LDB(B0, 0, 0); PG8_SCHED; PG8_LDA(At, 0, 0); PG8_STAGE(PG8_SA(1, 1), a1 + hstep, voffA);
            PG8_WAIT_L(8); PG8_BAR; PG8_WAIT_L(0); PG8_MMA(0, 0, At, B0); PG8_BAR; PG8_SCHED;
            PG8_LDB(B1, 0, 1); PG8_STAGE(PG8_SB(0, 0), b2, voffB);
            PG8_BAR; PG8_WAIT_L(0); PG8_MMA(0, 1, At, B1); PG8_BAR;
            PG8_LDA(At, 0, 1); PG8_STAGE(PG8_SA(0, 0), a2, voffA);
            PG8_BAR; PG8_WAIT_L(0); PG8_MMA(1, 0, At, B0); PG8_BAR; PG8_SCHED;
            PG8_STAGE(PG8_SB(0, 1), b2 + hstepB, voffB);
            PG8_WAIT_V(6); PG8_BAR; PG8_MMA(1, 1, At, B1); PG8_BAR;
            PG8_LDB(B0, 1, 0); PG8_SCHED; PG8_LDA(At, 1, 0); PG8_STAGE(PG8_SA(0, 1), a2 + hstep, voffA);
            PG8_WAIT_L(8); PG8_BAR; PG8_WAIT_L(0); PG8_MMA(0, 0, At, B0); PG8_BAR; PG8_SCHED;
            PG8_LDB(B1, 1, 1); PG8_STAGE(PG8_SB(1, 0), b3, voffB);
            PG8_BAR; PG8_WAIT_L(0); PG8_MMA(0, 1, At, B1); PG8_BAR;
            PG8_LDA(At, 1, 1); PG8_STAGE(PG8_SA(1, 0), a3, voffA);
            PG8_BAR; PG8_WAIT_L(0); PG8_MMA(1, 0, At, B0); PG8_BAR; PG8_SCHED;
            PG8_STAGE(PG8_SB(1, 1), b3 + hstepB, voffB);
            PG8_WAIT_V(6); PG8_BAR; PG8_MMA(1, 1, At, B1); PG8_BAR;
            }
        }
        }
        if constexpr (ALIGN_EPI) { if (wr == 0) PG8_BAR; }
        if constexpr (!Epi::AFTER_DRAIN) { int t2 = threadIdx.x; asm volatile("" : "+v"(t2));
            const int wid2 = __builtin_amdgcn_readfirstlane(t2 >> 6), lane2 = t2 & 63; E(acc, cur, wid2 >> 2, wid2 & 3, lane2 & 15, lane2 >> 4); S.done(cur); }
        if (!has_next) break;
#pragma unroll
        for (int a = 0; a < 2; ++a)
#pragma unroll
            for (int b = 0; b < 2; ++b)
#pragma unroll
                for (int m = 0; m < 4; ++m)
#pragma unroll
                    for (int n = 0; n < 2; ++n) acc[a][b][m][n] = (f32x4){0.f, 0.f, 0.f, 0.f};
        cur = nxt; cA = nA; cB = nB; cB2 = nB2; ++ui;
        if constexpr (ALIGN_EPI) { if (wr == 1) PG8_BAR; }
    }
    PG8_WAIT_V(0);
    if constexpr (!ALIGN_EPI) { if (wr == 0) PG8_BAR; }
    PG8_BAR;
    if constexpr (Epi::AFTER_DRAIN) { E.fused(acc, cur, wr, wc, fr, fq, lds, wid, lane); S.done(cur); }
#undef PG8_SA
#undef PG8_SB
#undef PG8_STAGE
#undef PG8_LDA
#undef PG8_LDB
#undef PG8_MMA
#undef PG8_WAIT_V
#undef PG8_WAIT_L
#undef PG8_BAR
#undef PG8_SCHED
#undef PG8_STG_A
#undef PG8_GROWS
#undef PG8_GROWS_P
#undef PG8_UNPACK_NV
}
}
constexpr int BATCH = 32, SEQ = 2048, D = 1024, T = BATCH * SEQ;
constexpr int NPROJ = 2048;
constexpr int CQ = 0, CKV = 256, CPE = 384, CMQ = 416, CMK = 928, CMV = 1440, NPROJ_REAL = 1952;
constexpr int NH = 8;
constexpr float EPS = 1e-6f;
constexpr float LOG2E = 1.4426950408889634f;
constexpr float C2A = 0.10206207261596575f * LOG2E;
constexpr float C2B = 0.125f * LOG2E;
constexpr int NCLS = 112;
constexpr int LIST_CAP = 65536;

constexpr size_t MiB = 1u << 20;
constexpr size_t WS_CTL = 0, CTL_ZERO_BYTES = 2 * MiB;
constexpr size_t WS_KMEAN = 1 * MiB;
constexpr size_t WS_WIN = 2 * MiB;
constexpr size_t WS_WQ = 6 * MiB;
constexpr size_t WS_WKV = 7 * MiB;
constexpr size_t WS_WO = 8 * MiB;
constexpr size_t WS_WGU = 10 * MiB;
constexpr size_t WS_WD = 42 * MiB;
constexpr size_t WS_ROPE = 58 * MiB;
constexpr size_t WS_WRE = 59 * MiB;
constexpr size_t WS_XRS = 62 * MiB;
constexpr size_t WS_O8 = 320 * MiB;
constexpr size_t WS_SSQ = 60 * MiB;
constexpr size_t WS_XN = 64 * MiB;
constexpr size_t WS_VB = 192 * MiB;
constexpr size_t WS_Y0 = 64 * MiB;
constexpr size_t WS_X1B = 768 * MiB;
constexpr size_t WS_YH = 256 * MiB;
constexpr size_t WS_QB = 448 * MiB;
constexpr size_t WS_KB = 512 * MiB;
constexpr size_t WS_QA = 584 * MiB;
constexpr size_t WS_VA = 680 * MiB;
constexpr size_t WS_KA = 808 * MiB;
constexpr size_t WS_QLN = 904 * MiB;
constexpr size_t WS_KVLN = 936 * MiB;
constexpr size_t WS_LISTS = 648 * MiB;
constexpr size_t WS_OSSQ = 904 * MiB;
constexpr size_t WS_END = 1024 * MiB;
constexpr size_t WS_H = WS_KB;
constexpr int CW_TMO = 0, CW_CODE = 1;
constexpr int CW_BAR = 4096;
constexpr int CW_GCNT = 16384;

constexpr int RING_BYTES = 131072;
constexpr int P8_XT = 0, P8_XT_WAVE = 32 * 68 * 4, P8_WC = 69632, P8_WRG = 86016, P8_RT = 102400;
constexpr int LDSCTL_OFF = 155648, LDS_BYTES = 159744;
static_assert(true, "ClsOrder: cnt, ptab, tpf, tph at tp + 512, 1024, 1280, 1792 bytes");
constexpr int TP_OFF = LDSCTL_OFF + 256, CNT_OFF = LDSCTL_OFF + 768, PT_OFF = LDSCTL_OFF + 1280, TPF_OFF = LDSCTL_OFF + 1536, TPH_OFF = LDSCTL_OFF + 2048;

#define GAS __attribute__((address_space(1)))
#define LAS __attribute__((address_space(3)))
typedef unsigned short bf16;
typedef unsigned v4u __attribute__((ext_vector_type(4)));
typedef unsigned v2u __attribute__((ext_vector_type(2)));
typedef float f32x4 __attribute__((ext_vector_type(4)));
typedef float f32x2 __attribute__((ext_vector_type(2)));
typedef float f32x16 __attribute__((ext_vector_type(16)));
typedef short bf16x8 __attribute__((ext_vector_type(8)));
typedef short s16x4 __attribute__((ext_vector_type(4)));
typedef GAS unsigned gu32;
#define RLX_AGENT __ATOMIC_RELAXED, __HIP_MEMORY_SCOPE_AGENT
__device__ __forceinline__ unsigned f2bf(float f) { unsigned u = __builtin_bit_cast(unsigned, f); return (u + 0x7fffu + ((u >> 16) & 1u)) >> 16; }
__device__ __forceinline__ unsigned pk2(float lo, float hi) { return f2bf(lo) | (f2bf(hi) << 16); }
__device__ __forceinline__ float bflo(unsigned w) { return __builtin_bit_cast(float, w << 16); }
__device__ __forceinline__ float bfhi(unsigned w) { return __builtin_bit_cast(float, w & 0xffff0000u); }
__device__ __forceinline__ float wave_sum(float v) {
#pragma unroll
    for (int o = 1; o < 64; o <<= 1) v += __shfl_xor(v, o);
    return v;
}
__device__ __forceinline__ float sum8(float v) { v += __shfl_xor(v, 1); v += __shfl_xor(v, 2); v += __shfl_xor(v, 4); return v; }

#define XB_TMO      128
#define XB_XCNT(j)  (256  + 64 * (j))
#define XB_XSUB(j)  (1280 + 64 * (j))
#define XB_XGEN(j)  (2304 + 64 * (j))
#define XB_TOP      3328
#define XB_TOPGEN   3392
#define XCD_BAR_WORDS 3456
#define XB_SPIN_CAP (1u << 18)

__device__ __forceinline__ unsigned xb_ld(unsigned* p)              { return __hip_atomic_load(p, __ATOMIC_RELAXED, __HIP_MEMORY_SCOPE_AGENT); }
__device__ __forceinline__ unsigned xb_add(unsigned* p, unsigned v) { return __hip_atomic_fetch_add(p, v, __ATOMIC_RELAXED, __HIP_MEMORY_SCOPE_AGENT); }
__device__ __forceinline__ unsigned xb_xcc_id() { return (unsigned)__builtin_amdgcn_s_getreg((3 << 11) | 20) & 0xFu; }
#define XB_SPIN(cond, bar) do { unsigned _sp = 0; while (cond) { __builtin_amdgcn_s_sleep(1); \
    if ((++_sp & 255u) == 0u) { if (xb_ld(&(bar)[XB_TMO])) break; if (_sp > XB_SPIN_CAP) { atomicAdd(&(bar)[XB_TMO], 1u); break; } } } } while (0)

struct XcdBarrier {
    unsigned* bar; unsigned x;
    volatile LAS unsigned* st;
};

__device__ __forceinline__ XcdBarrier xcd_barrier_post(unsigned* bar, volatile LAS unsigned* st) {
    XcdBarrier b; b.bar = bar; b.x = xb_xcc_id(); b.st = st;
    if (threadIdx.x == 0) (void)xb_add(&bar[XB_XCNT(b.x)], 1u);
    return b;
}
__device__ __forceinline__ void xcd_barrier_complete(unsigned* bar, unsigned x, unsigned& nloc, unsigned& nx) {
    const unsigned G = gridDim.x * gridDim.y * gridDim.z;
    unsigned sum, cnt, mine, sp = 0u;
    for (;;) {
        sum = 0u; cnt = 0u; mine = 0u;
#pragma unroll
        for (unsigned j = 0; j < 16; ++j) { const unsigned c = xb_ld(&bar[XB_XCNT(j)]); sum += c; cnt += (c > 0u) ? 1u : 0u; mine = (j == x) ? c : mine; }
        if (sum == G) break;
        __builtin_amdgcn_s_sleep(1);
        if ((++sp & 255u) == 0u) { if (xb_ld(&bar[XB_TMO])) break; if (sp > XB_SPIN_CAP) { atomicAdd(&bar[XB_TMO], 1u); break; } }
    }
    nloc = mine > 0u ? mine : 1u; nx = cnt > 0u ? cnt : 1u;
}

__device__ __forceinline__ void xcd_barrier(const XcdBarrier& b) {
    asm volatile("s_waitcnt vmcnt(0)" ::: "memory");
    __syncthreads();
    if (threadIdx.x == 0) {
        unsigned* bar = b.bar;
        __builtin_amdgcn_s_waitcnt(0);
        unsigned nloc = b.st[0], nx = b.st[1];
        if (nloc == 0u) { xcd_barrier_complete(bar, b.x, nloc, nx); b.st[0] = nloc; b.st[1] = nx; }
        const unsigned old = xb_add(&bar[XB_XSUB(b.x)], 1u);
        const unsigned gen = old / nloc;
        if (old + 1u == (gen + 1u) * nloc) {
            __builtin_amdgcn_fence(__ATOMIC_RELEASE, "agent");
            asm volatile("s_waitcnt vmcnt(0)" ::: "memory");
            const unsigned og = xb_add(&bar[XB_TOP], 1u);
            const unsigned tg = og / nx;
            if (og + 1u == (tg + 1u) * nx) xb_add(&bar[XB_TOPGEN], 1u);
            else XB_SPIN(xb_ld(&bar[XB_TOPGEN]) == tg, bar);
            __builtin_amdgcn_fence(__ATOMIC_ACQUIRE, "agent");
            xb_add(&bar[XB_XGEN(b.x)], 1u);
            asm volatile("s_waitcnt vmcnt(0)" ::: "memory");
        } else {
            XB_SPIN(xb_ld(&bar[XB_XGEN(b.x)]) == gen, bar);
            __builtin_amdgcn_fence(__ATOMIC_ACQUIRE, "agent");
            asm volatile("s_waitcnt vmcnt(0)" ::: "memory");
        }
    }
    __syncthreads();
}


__device__ __forceinline__ float att_max3(float a, float b, float c) { float r; asm("v_max3_f32 %0, %1, %2, %3" : "=v"(r) : "v"(a), "v"(b), "v"(c)); return r; }
__device__ __forceinline__ unsigned pk4_fp8(float a, float b, float c, float d) { int w = 0; w = __builtin_amdgcn_cvt_pk_fp8_f32(a, b, w, false); w = __builtin_amdgcn_cvt_pk_fp8_f32(c, d, w, true); return (unsigned)w; }
struct AttOwn { static constexpr bool v = true; }; struct AttPast { static constexpr bool v = false; };
template <int DQK, bool MOBA, bool QFIN, bool FIXREF>
__device__ __forceinline__ void attn_unit(LAS unsigned char* lds, const float* qgain_, const float* ropeR_, const bf16* Qg_, int qpitch, const bf16* Kg_, int kpitch, const bf16* Vg_, int vpitch, bf16* Og_, int opitch, float* ossq_, int qb, const float* kmp_, int kmstride, float bref) {
    const GAS bf16* Qg = (const GAS bf16*)Qg_; const GAS bf16* Kg = (const GAS bf16*)Kg_; const GAS bf16* Vg = (const GAS bf16*)Vg_; GAS bf16* Og = (GAS bf16*)Og_; const GAS float* kmp = (const GAS float*)kmp_;
    constexpr int ND = DQK / 16, KSTR = DQK * 2 + 16, KBUF = 64 * KSTR, NCH = DQK / 8, VBUF = 8192;
    int tid = threadIdx.x; asm volatile("" : "+v"(tid));
    const int lane = tid & 63, r32 = lane & 31, hi = lane >> 5; const int wid = __builtin_amdgcn_readfirstlane(tid >> 6);
    LAS unsigned char* Kl = lds; LAS unsigned char* Vl = lds + 2 * KBUF;
    const GAS bf16* qrow = Qg + (size_t)(qb * 256 + wid * 32 + r32) * qpitch;
    bf16x8 qf[ND];
#pragma unroll
    for (int d0 = 0; d0 < ND; ++d0) qf[d0] = *(const GAS bf16x8*)(qrow + 16 * d0 + 8 * hi);
    if (QFIN) {
        const GAS float* qg = (const GAS float*)qgain_; const GAS float* rr = (const GAS float*)ropeR_; const int pos = qb * 256 + wid * 32 + r32;
        float x[ND][8]; float ss = 0.f;
#pragma unroll
        for (int d0 = 0; d0 < ND; ++d0) { const v4u w = __builtin_bit_cast(v4u, qf[d0]);
            x[d0][0] = bflo(w.x); x[d0][1] = bfhi(w.x); x[d0][2] = bflo(w.y); x[d0][3] = bfhi(w.y); x[d0][4] = bflo(w.z); x[d0][5] = bfhi(w.z); x[d0][6] = bflo(w.w); x[d0][7] = bfhi(w.w);
#pragma unroll
            for (int j = 0; j < 8; ++j) ss += x[d0][j] * x[d0][j]; }
        ss += __shfl_xor(ss, 32);
        const float rs = __builtin_amdgcn_rsqf(ss * (1.0f / (float)DQK) + EPS) * C2A;
#pragma unroll
        for (int d0 = 0; d0 < ND; ++d0) { const f32x4 ga = *(const GAS f32x4*)(qg + 16 * d0 + 8 * hi), gb = *(const GAS f32x4*)(qg + 16 * d0 + 8 * hi + 4);
#pragma unroll
            for (int j = 0; j < 4; ++j) { x[d0][j] *= rs * ga[j]; x[d0][4 + j] *= rs * gb[j]; } }
        if (ND == 6) { const f32x4 ca = *(const GAS f32x4*)(rr + pos * 16 + 8 * hi), cb = *(const GAS f32x4*)(rr + pos * 16 + 8 * hi + 4), sa = *(const GAS f32x4*)(rr + SEQ * 16 + pos * 16 + 8 * hi), sb = *(const GAS f32x4*)(rr + SEQ * 16 + pos * 16 + 8 * hi + 4);
#pragma unroll
            for (int j = 0; j < 8; ++j) { const float c = j < 4 ? ca[j & 3] : cb[j & 3], s = j < 4 ? sa[j & 3] : sb[j & 3]; const float y1 = x[ND - 2][j], y2 = x[ND - 1][j]; x[ND - 2][j] = y1 * c - y2 * s; x[ND - 1][j] = y2 * c + y1 * s; } }
#pragma unroll
        for (int d0 = 0; d0 < ND; ++d0) { v4u w; w.x = pg8::cvt_pk_bf16(x[d0][0], x[d0][1]); w.y = pg8::cvt_pk_bf16(x[d0][2], x[d0][3]); w.z = pg8::cvt_pk_bf16(x[d0][4], x[d0][5]); w.w = pg8::cvt_pk_bf16(x[d0][6], x[d0][7]); qf[d0] = __builtin_bit_cast(bf16x8, w); }
    }
    unsigned sel = 0xffu;
    if (MOBA && qb > 3) {
        float gate[8];
#pragma unroll
        for (int n = 0; n < 8; ++n) { float a = 0.f;
            if (n < qb) {
#pragma unroll
                for (int d0 = 0; d0 < ND; ++d0) { const GAS float* km = kmp + (size_t)n * kmstride + 16 * d0 + 8 * hi; const f32x4 k0 = *(const GAS f32x4*)km, k1 = *(const GAS f32x4*)(km + 4);
                    const v4u qq = __builtin_bit_cast(v4u, qf[d0]);
                    a += bflo(qq.x) * k0[0] + bfhi(qq.x) * k0[1] + bflo(qq.y) * k0[2] + bfhi(qq.y) * k0[3] + bflo(qq.z) * k1[0] + bfhi(qq.z) * k1[1] + bflo(qq.w) * k1[2] + bfhi(qq.w) * k1[3]; }
                a += __shfl_xor(a, 32); }
            gate[n] = a; asm volatile("" : "+v"(a) :: "memory"); }
        sel = 0u;
#pragma unroll
        for (int n = 0; n < 8; ++n) { int rank = 0;
#pragma unroll
            for (int mm = 0; mm < 8; ++mm) { if (mm != n) { const bool before = (gate[mm] > gate[n]) || (gate[mm] == gate[n] && mm < n); rank += (mm < qb && before) ? 1 : 0; } }
            if (n < qb && rank < 3) sel |= (1u << n); }
    }
    const int krow = (DQK == 64) ? (tid >> 3) : (tid / 12), kch = (DQK == 64) ? (tid & 7) : (tid % 12);
    const int krow2 = (tid + 512) / 12, kch2 = (tid + 512) % 12; const bool k2 = (DQK == 96) && (tid < 256);
    const int vrow = tid >> 3, vch = tid & 7;
    const unsigned kst = (unsigned)(krow * KSTR + kch * 16), kst2 = (unsigned)(krow2 * KSTR + kch2 * 16);
    const unsigned vst = (unsigned)((vch >> 2) * 4096 + (vrow >> 4) * 1024 + ((vrow >> 3) & 1) * 512 + (vrow & 7) * 64 + (vch & 3) * 16);
    const int NT = 4 * (qb + 1);
    auto tile_row0 = [&](int p) -> int { return (p < 4) ? (qb * 256 + p * 64) : ((p - 4) * 64); };
    v4u kreg, kreg2 = {0u, 0u, 0u, 0u}, vreg;
    { const int r0 = tile_row0(0);
      kreg = *(const GAS v4u*)(Kg + (size_t)(r0 + krow) * kpitch + kch * 8); if (k2) kreg2 = *(const GAS v4u*)(Kg + (size_t)(r0 + krow2) * kpitch + kch2 * 8);
      vreg = *(const GAS v4u*)(Vg + (size_t)(r0 + vrow) * vpitch + vch * 8);
      *(LAS v4u*)(Kl + kst) = kreg; if (k2) *(LAS v4u*)(Kl + kst2) = kreg2; *(LAS v4u*)(Vl + vst) = vreg; }
    __syncthreads();
    float m_run = 0.f, l_run = 0.f; f32x16 o0 = {}, o1 = {};
    f32x16 cuse = {}; bool cdirty = true;
    f32x16 negm = {};
    if constexpr (FIXREF) {
#pragma unroll
        for (int r = 0; r < 16; ++r) negm[r] = -bref; }
    constexpr float THR = 8.0f;
    const int qrel = wid * 32 + r32;
    const unsigned kfo = (unsigned)(r32 * KSTR + hi * 16);
    const unsigned vfo = (unsigned)(((lane >> 4) & 1) * 32 + (lane & 3) * 8 + (4 * hi + ((lane & 15) >> 2)) * 64);
    auto slot = [&](const int p, auto own_) { constexpr bool OWN = decltype(own_)::v;
        const int cb = p & 1;
        if (p + 1 < NT) { const int r0 = tile_row0(p + 1);
            kreg = *(const GAS v4u*)(Kg + (size_t)(r0 + krow) * kpitch + kch * 8); if (k2) kreg2 = *(const GAS v4u*)(Kg + (size_t)(r0 + krow2) * kpitch + kch2 * 8);
            vreg = *(const GAS v4u*)(Vg + (size_t)(r0 + vrow) * vpitch + vch * 8); }
        const bool need = OWN ? !(p > (wid >> 1)) : true;
        if (need) {
            const LAS unsigned char* Kb = Kl + cb * KBUF + kfo; const LAS unsigned char* Vb = Vl + cb * VBUF + vfo;
            f32x16 s0 = negm, s1 = negm;
            if constexpr (!OWN && MOBA) {
                if (cdirty || (p & 3) == 0) { const bool on = ((sel >> ((p - 4) >> 2)) & 1u) != 0u;
#pragma unroll
                    for (int r = 0; r < 16; ++r) cuse[r] = on ? negm[r] : -1.0e30f;
                    cdirty = false; }
                s0 = cuse; s1 = cuse; }
            bf16x8 kf[2 * ND];
#pragma unroll
            for (int d0 = 0; d0 < ND; ++d0) { kf[2 * d0] = *(const LAS bf16x8*)(Kb + d0 * 32); kf[2 * d0 + 1] = *(const LAS bf16x8*)(Kb + 32 * KSTR + d0 * 32); }
            __builtin_amdgcn_sched_barrier(0);
#pragma unroll
            for (int d0 = 0; d0 < ND; ++d0) { s0 = __builtin_amdgcn_mfma_f32_32x32x16_bf16(kf[2 * d0], qf[d0], s0, 0, 0, 0); s1 = __builtin_amdgcn_mfma_f32_32x32x16_bf16(kf[2 * d0 + 1], qf[d0], s1, 0, 0, 0); }
            s16x4 vt[16];
#pragma unroll
            for (int v = 0; v < 16; ++v) vt[v] = __builtin_bit_cast(s16x4, __builtin_amdgcn_ds_read_tr16_b64_v4i16((LAS s16x4*)(Vb + (v >> 2) * 1024 + ((v >> 1) & 1) * 4096 + (v & 1) * 512)));
            __builtin_amdgcn_sched_barrier(0);
            if constexpr (OWN) { const int kb = 64 * p + 4 * hi;
#pragma unroll
                for (int r = 0; r < 16; ++r) { const int kv = kb + (r & 3) + 8 * (r >> 2); if (kv > qrel) s0[r] = -INFINITY; if (kv + 32 > qrel) s1[r] = -INFINITY; } }
            if constexpr (!FIXREF) {
            float ra = att_max3(s0[0], s0[1], s1[0]), rb = att_max3(s0[2], s0[3], s1[1]); ra = att_max3(ra, s1[2], s1[3]);
#pragma unroll
            for (int r = 4; r < 16; r += 4) { ra = att_max3(ra, s0[r], s0[r + 1]); rb = att_max3(rb, s0[r + 2], s0[r + 3]); ra = att_max3(ra, s1[r], s1[r + 1]); rb = att_max3(rb, s1[r + 2], s1[r + 3]); }
            float rm = fmaxf(ra, rb); rm = fmaxf(rm, __shfl_xor(rm, 32));
            if ((OWN && p == 0) || __any(rm > THR)) {
                const float dl = (OWN && p == 0) ? rm : fmaxf(rm, 0.f); m_run += dl;
                const float fsc = __builtin_amdgcn_exp2f(-dl); l_run *= fsc;
#pragma unroll
                for (int r = 0; r < 16; ++r) { s0[r] -= dl; s1[r] -= dl; o0[r] *= fsc; o1[r] *= fsc; negm[r] = -m_run; }
                cdirty = true;
            }
            }
            float rs0 = 0.f, rs1 = 0.f;
#pragma unroll
            for (int r = 0; r < 16; ++r) { s0[r] = __builtin_amdgcn_exp2f(s0[r]); s1[r] = __builtin_amdgcn_exp2f(s1[r]); rs0 += s0[r]; rs1 += s1[r]; }
            l_run += rs0 + rs1;
            bf16x8 pf[4];
#pragma unroll
            for (int s = 0; s < 2; ++s) { v4u a, b;
                a.x = pg8::cvt_pk_bf16(s0[8 * s + 0], s0[8 * s + 1]); a.y = pg8::cvt_pk_bf16(s0[8 * s + 2], s0[8 * s + 3]); a.z = pg8::cvt_pk_bf16(s0[8 * s + 4], s0[8 * s + 5]); a.w = pg8::cvt_pk_bf16(s0[8 * s + 6], s0[8 * s + 7]);
                b.x = pg8::cvt_pk_bf16(s1[8 * s + 0], s1[8 * s + 1]); b.y = pg8::cvt_pk_bf16(s1[8 * s + 2], s1[8 * s + 3]); b.z = pg8::cvt_pk_bf16(s1[8 * s + 4], s1[8 * s + 5]); b.w = pg8::cvt_pk_bf16(s1[8 * s + 6], s1[8 * s + 7]);
                pf[s] = __builtin_bit_cast(bf16x8, a); pf[2 + s] = __builtin_bit_cast(bf16x8, b); }
#pragma unroll
            for (int s = 0; s < 4; ++s) {
                const bf16x8 va = (bf16x8){vt[4 * s][0], vt[4 * s][1], vt[4 * s][2], vt[4 * s][3], vt[4 * s + 1][0], vt[4 * s + 1][1], vt[4 * s + 1][2], vt[4 * s + 1][3]};
                const bf16x8 vb = (bf16x8){vt[4 * s + 2][0], vt[4 * s + 2][1], vt[4 * s + 2][2], vt[4 * s + 2][3], vt[4 * s + 3][0], vt[4 * s + 3][1], vt[4 * s + 3][2], vt[4 * s + 3][3]};
                o0 = __builtin_amdgcn_mfma_f32_32x32x16_bf16(va, pf[s], o0, 0, 0, 0);
                o1 = __builtin_amdgcn_mfma_f32_32x32x16_bf16(vb, pf[s], o1, 0, 0, 0); }
        }
        if (p + 1 < NT) { const int nb = cb ^ 1;
            *(LAS v4u*)(Kl + nb * KBUF + kst) = kreg; if (k2) *(LAS v4u*)(Kl + nb * KBUF + kst2) = kreg2; *(LAS v4u*)(Vl + nb * VBUF + vst) = vreg; }
        __syncthreads();
        __syncthreads();
    };
    for (int p = 0; p < 4; ++p) slot(p, AttOwn{});
    for (int p = 4; p < NT; ++p) slot(p, AttPast{});
    l_run += __shfl_xor(l_run, 32);
    const float rl = 1.0f / l_run;
    { float ss = 0.f;
#pragma unroll
      for (int r = 0; r < 16; ++r) { const float a = o0[r] * rl, b = o1[r] * rl; ss += a * a + b * b; }
      ss += __shfl_xor(ss, 32);
      if (hi == 0) ((GAS float*)ossq_)[(size_t)(qb * 256 + wid * 32 + r32) * 16] = ss; }
    LAS unsigned char* stg = lds + 65536 + wid * 4608; const float rl16 = rl * 16.0f;
#pragma unroll
    for (int g = 0; g < 4; ++g) {
        *(LAS unsigned*)(stg + r32 * 80 + (8 * g + 4 * hi)) = pk4_fp8(o0[4 * g] * rl16, o0[4 * g + 1] * rl16, o0[4 * g + 2] * rl16, o0[4 * g + 3] * rl16);
        *(LAS unsigned*)(stg + r32 * 80 + (32 + 8 * g + 4 * hi)) = pk4_fp8(o1[4 * g] * rl16, o1[4 * g + 1] * rl16, o1[4 * g + 2] * rl16, o1[4 * g + 3] * rl16); }
    asm volatile("s_waitcnt lgkmcnt(0)" ::: "memory");
    GAS unsigned char* obase = (GAS unsigned char*)Og + (size_t)(qb * 256 + wid * 32) * opitch;
#pragma unroll
    for (int i = 0; i < 2; ++i) { const int row = i * 16 + (lane >> 2), ch = lane & 3; const v4u v = *(const LAS v4u*)(stg + row * 80 + ch * 16); *(GAS v4u*)(obase + (size_t)row * opitch + ch * 16) = v; }
    asm volatile("s_waitcnt lgkmcnt(0)" ::: "memory");
}

__device__ __forceinline__ void transpose_item(const float* W_, int ldw, bf16* WT, int ldt, int k0, int n0, int dr0, int dr1, LAS float* scr, int lane, const float* kgain = nullptr) {
    const GAS float* W = (const GAS float*)W_; const int q = lane & 15, kr = lane >> 4; const bool ld_ok = (q < 8) ? (dr0 >= 0) : (dr1 >= 0);
#pragma unroll 4
    for (int i = 0; i < 16; ++i) { const int kk = 4 * i + kr; f32x4 v = {0.f, 0.f, 0.f, 0.f}; if (ld_ok) v = *(const GAS f32x4*)(W + (size_t)(k0 + kk) * ldw + n0 + 4 * q);
        if (kgain) v = v * ((const GAS float*)kgain)[k0 + kk];
        LAS float* s = scr + kk * 65 + 4 * q; s[0] = v[0]; s[1] = v[1]; s[2] = v[2]; s[3] = v[3]; }
    asm volatile("s_waitcnt lgkmcnt(0)" ::: "memory");
    const int c = lane & 7;
#pragma unroll
    for (int j = 0; j < 8; ++j) { const int n = 8 * j + (lane >> 3); const LAS float* s = scr + (8 * c) * 65 + n; const int dr = (n < 32) ? dr0 : dr1;
        v4u o; o.x = pk2(s[0 * 65], s[1 * 65]); o.y = pk2(s[2 * 65], s[3 * 65]); o.z = pk2(s[4 * 65], s[5 * 65]); o.w = pk2(s[6 * 65], s[7 * 65]);
        if (dr >= 0) *(GAS v4u*)(WT + (size_t)(dr + (n & 31)) * ldt + k0 + 8 * c) = o; }
    asm volatile("s_waitcnt lgkmcnt(0)" ::: "memory");
}

__device__ __forceinline__ void transpose_item8(const float* W_, int ldw, unsigned char* WT8, int ldt, int k0, int n0, int dr0, int dr1, LAS float* scr, int lane, float scale, const float* kgain = nullptr) {
    const GAS float* W = (const GAS float*)W_; const int q = lane & 15, kr = lane >> 4; const bool ld_ok = (q < 8) ? (dr0 >= 0) : (dr1 >= 0);
#pragma unroll 4
    for (int i = 0; i < 16; ++i) { const int kk = 4 * i + kr; f32x4 v = {0.f, 0.f, 0.f, 0.f}; if (ld_ok) v = *(const GAS f32x4*)(W + (size_t)(k0 + kk) * ldw + n0 + 4 * q);
        if (kgain) v = v * ((const GAS float*)kgain)[k0 + kk];
        v = v * scale;
        LAS float* s = scr + kk * 65 + 4 * q; s[0] = v[0]; s[1] = v[1]; s[2] = v[2]; s[3] = v[3]; }
    asm volatile("s_waitcnt lgkmcnt(0)" ::: "memory");
    const int c = lane & 7;
#pragma unroll
    for (int j = 0; j < 8; ++j) { const int n = 8 * j + (lane >> 3); const LAS float* s = scr + (8 * c) * 65 + n; const int dr = (n < 32) ? dr0 : dr1;
        v2u o; o.x = pk4_fp8(s[0 * 65], s[1 * 65], s[2 * 65], s[3 * 65]); o.y = pk4_fp8(s[4 * 65], s[5 * 65], s[6 * 65], s[7 * 65]);
        if (dr >= 0) *(GAS v2u*)((GAS unsigned char*)WT8 + (size_t)(dr + (n & 31)) * ldt + k0 + 8 * c) = o; }
    asm volatile("s_waitcnt lgkmcnt(0)" ::: "memory");
}

struct Args {
    const float* x; const float* attn_g; const float* w_in; const float* qlat_g; const float* w_qup; const float* kvlat_g; const float* w_kvup;
    const float* qhead_g; const float* khead_g; const float* mqhead_g; const float* mkhead_g; const float* onorm_a_g; const float* onorm_b_g; const float* w_out;
    const float* ffn_g; const float* w_rg; const float* b_rg; const float* w_re; const float* b_re; const float* w_gate; const float* w_up; const float* w_down;
    float* out; unsigned char* ws; int ph_lo, ph_hi;
};
enum { PH_PRO = 0, PH_PROJ, PH_UP, PH_ATTN, PH_OUT, PH_ROUTE, PH_GU, PH_D0, NPHASE };

__global__ void __launch_bounds__(512, 2) mk_fwd(Args A) {
    extern __shared__ __attribute__((aligned(16))) unsigned char lds_raw[];
    LAS unsigned char* lds = (LAS unsigned char*)lds_raw;
    const int tid0 = threadIdx.x;
    const int G = gridDim.x, bx = blockIdx.x;
#define NGW (G * 8)
#define PH_BEGIN int tid = threadIdx.x; asm volatile("" : "+v"(tid)); const int lane = tid & 63; const int wave = __builtin_amdgcn_readfirstlane(tid >> 6); const int gw = bx * 8 + wave; \
    const __attribute__((address_space(4))) Args* AP = (const __attribute__((address_space(4))) Args*)__builtin_amdgcn_kernarg_segment_ptr(); asm volatile("" : "+s"(AP)); \
    unsigned char* ws = AP->ws; (void)lane; (void)gw; (void)ws;
#define Win_t ((bf16*)(ws + WS_WIN))
#define Wq_t ((bf16*)(ws + WS_WQ))
#define Wkv_t ((bf16*)(ws + WS_WKV))
#define Wo_t ((bf16*)(ws + WS_WO))
#define Wgu_t ((bf16*)(ws + WS_WGU))
#define Wd_t ((bf16*)(ws + WS_WD))
#define ropeF ((float*)(ws + WS_ROPE))
#define ropeR (((float*)(ws + WS_ROPE)) + 2 * SEQ * 32)
#define kmean ((float*)(ws + WS_KMEAN))
#define XN ((bf16*)(ws + WS_XN))
#define X1B ((bf16*)(ws + WS_X1B))
#define VB ((bf16*)(ws + WS_VB))
#define YH ((bf16*)(ws + WS_YH))
#define Y0B ((bf16*)(ws + WS_Y0))
#define SSQ ((float*)(ws + WS_SSQ))
#define XRS ((float*)(ws + WS_XRS))
#define O8 ((bf16*)(ws + WS_O8))
#define WREF ((float*)(ws + WS_WRE))
#define WRGF ((float*)(ws + WS_WRE + 131072))
#define OSSQ ((float*)(ws + WS_OSSQ))
#define QB ((bf16*)(ws + WS_QB))
#define KB ((bf16*)(ws + WS_KB))
#define QA ((bf16*)(ws + WS_QA))
#define VA ((bf16*)(ws + WS_VA))
#define KA ((bf16*)(ws + WS_KA))
#define QLN ((bf16*)(ws + WS_QLN))
#define KVLN ((bf16*)(ws + WS_KVLN))
#define HB ((bf16*)(ws + WS_H))
#define lists ((pg8::ListEnt*)(ws + WS_LISTS))
    volatile LAS unsigned* MISC = (volatile LAS unsigned*)(lds + LDSCTL_OFF);
    for (int u = tid0; u < (LDS_BYTES - LDSCTL_OFF) / 4; u += 512) ((LAS unsigned*)(lds + LDSCTL_OFF))[u] = 0u;
    __syncthreads();
    XcdBarrier bar = xcd_barrier_post((unsigned*)((gu32*)(A.ws + WS_CTL) + CW_BAR), MISC + 8);
    const int lo = A.ph_lo, hi = A.ph_hi;
#define IN(k) (lo <= (k) && (k) < hi)
#define MOE_SLOT(npn) ((G == 256) ? ((((bx >> 3) / (npn)) * 8 + (bx & 7)) * (npn) + ((bx >> 3) % (npn))) : bx)
#define SEAM(k) do { if (IN(k) && IN((k) + 1)) xcd_barrier(bar); } while (0)

    if (IN(PH_PRO)) { PH_BEGIN
        LAS float* scr = (LAS float*)(lds + wave * 16640);
        constexpr int I_IN = 16 * 31, I_QU = 4 * 12, I_KV = 2 * 16, I_WO = 16 * 16, I_G = 32 * 64, I_U = 32 * 64, I_D = 32 * 64;
        constexpr int NITEMS = I_IN + I_QU + I_KV + I_WO + I_G + I_U + I_D;
        for (int it = gw; it < NITEMS; it += NGW) {
            int r = it;
            if (r < I_IN) { const int kb = r / 31, nb = r % 31; int dr[2];
#pragma unroll
                for (int h2 = 0; h2 < 2; ++h2) { const int gi = 2 * nb + h2;
                    if (gi < 13) dr[h2] = 32 * gi; else if (gi < 45) { const int q = (gi - 13) & 15, hh = q >> 1, bj = q & 1; dr[h2] = (gi < 29 ? 512 : 1024) + (hh >> 2) * 256 + bj * 128 + (hh & 3) * 32; } else if (gi < 61) dr[h2] = 1536 + (gi - 45) * 32; else dr[h2] = -1; }
                transpose_item(AP->w_in, NPROJ_REAL, Win_t, 1024, 64 * kb, 64 * nb, dr[0], dr[1], scr, lane, AP->attn_g); continue; } r -= I_IN;
            if (r < I_QU) { const int kb = r / 12, nb = r % 12; transpose_item(AP->w_qup, 768, Wq_t, 256, 64 * kb, 64 * nb, 64 * nb, 64 * nb + 32, scr, lane, AP->qlat_g); continue; } r -= I_QU;
            if (r < I_KV) { const int kb = r / 16, nb = r % 16; const int n0 = 64 * nb, hh = n0 >> 7, j0 = n0 & 127;
                const int d0 = (j0 < 64) ? ((hh >> 2) * 256 + (hh & 3) * 32) : (512 + hh * 64), d1 = (j0 < 64) ? (d0 + 128) : (d0 + 32);
                transpose_item(AP->w_kvup, 1024, Wkv_t, 256, 64 * kb, n0, d0, d1, scr, lane, AP->kvlat_g); continue; } r -= I_KV;
            if (r < I_WO) { const int kb = r / 16, nb = r % 16; transpose_item8(AP->w_out, 1024, (unsigned char*)Wo_t, 1024, 64 * kb, 64 * nb, 64 * nb, 64 * nb + 32, scr, lane, 32.0f, kb < 8 ? AP->onorm_a_g : AP->onorm_b_g - 512); continue; } r -= I_WO;
            if (r < I_G) { const int e = r >> 6, r2 = r & 63, kb = r2 >> 2, nb = r2 & 3; const int n0 = 64 * nb; const int d0 = (n0 >> 7) * 256 + (n0 & 127);
                transpose_item8(AP->w_gate + (size_t)e * 1024 * 256, 256, (unsigned char*)Wgu_t + (size_t)e * 512 * 1024, 1024, 64 * kb, n0, d0, d0 + 32, scr, lane, 32.0f); continue; } r -= I_G;
            if (r < I_U) { const int e = r >> 6, r2 = r & 63, kb = r2 >> 2, nb = r2 & 3; const int n0 = 64 * nb; const int d0 = (n0 >> 7) * 256 + 128 + (n0 & 127);
                transpose_item8(AP->w_up + (size_t)e * 1024 * 256, 256, (unsigned char*)Wgu_t + (size_t)e * 512 * 1024, 1024, 64 * kb, n0, d0, d0 + 32, scr, lane, 32.0f); continue; } r -= I_U;
            { const int e = r >> 6, r2 = r & 63, kb = r2 >> 4, nb = r2 & 15;
                transpose_item8(AP->w_down + (size_t)e * 256 * 1024, 1024, (unsigned char*)Wd_t + (size_t)e * 1024 * 256, 256, 64 * kb, 64 * nb, 64 * nb, 64 * nb + 32, scr, lane, 16.0f); }
        }
        const int gt = bx * 512 + tid, NGT = G * 512;
        for (int i = gt; i < 96 * 128; i += NGT) *(GAS v4u*)(Win_t + (size_t)416 * 1024 + (size_t)i * 8) = (v4u){0u, 0u, 0u, 0u};
        for (int i = gt; i < 1024 * 16; i += NGT) *(GAS v4u*)(Wkv_t + (size_t)(i >> 4) * 256 + 128 + (i & 15) * 8) = (v4u){0u, 0u, 0u, 0u};
        for (int i = gt; i < SEQ * 48; i += NGT) {
            const int pos = i / 48, f = i % 48; const bool isF = f < 32; const int ff = isF ? f : f - 32;
            const double e = isF ? (double)ff / 32.0 : (double)ff / 16.0;
            const float invf = (float)exp2(-e * 13.287712379549449);
            const float ang = (float)pos * invf;
            const double a = (double)ang; const double kk = rint(a * 0.15915494309189535); const double rr = a - kk * 6.283185307179586;
            const float c = (float)cos(rr), s = (float)sin(rr);
            GAS float* rF = (GAS float*)ropeF; GAS float* rR = (GAS float*)ropeR;
            if (isF) { rF[pos * 32 + ff] = c; rF[SEQ * 32 + pos * 32 + ff] = s; } else { rR[pos * 16 + ff] = c; rR[SEQ * 16 + pos * 16 + ff] = s; }
        }
        for (int i = gt; i < 1024 * 8; i += NGT) { const float gk = AP->ffn_g[i >> 3]; *((GAS f32x4*)WREF + i) = *((const GAS f32x4*)AP->w_re + i) * gk; }
        for (int i = gt; i < 1024; i += NGT) { const float gk = AP->ffn_g[i]; *((GAS f32x4*)WRGF + i) = *((const GAS f32x4*)AP->w_rg + i) * gk; }
        for (int t = gw; t < T; t += 2 * NGW) {
            const int t2 = (t + NGW < T) ? t + NGW : t;
            const GAS f32x4* xr = (const GAS f32x4*)(AP->x + (size_t)t * D) + lane; const GAS f32x4* xr2 = (const GAS f32x4*)(AP->x + (size_t)t2 * D) + lane; f32x4 v[4], w[4]; float s = 0.f, s2 = 0.f;
#pragma unroll
            for (int j = 0; j < 4; ++j) { v[j] = xr[64 * j]; w[j] = xr2[64 * j]; }
#pragma unroll
            for (int j = 0; j < 4; ++j) { s += (v[j].x * v[j].x + v[j].y * v[j].y) + (v[j].z * v[j].z + v[j].w * v[j].w); s2 += (w[j].x * w[j].x + w[j].y * w[j].y) + (w[j].z * w[j].z + w[j].w * w[j].w); }
            const float nr = sqrtf(wave_sum(s) * (1.f / D) + EPS), nr2 = sqrtf(wave_sum(s2) * (1.f / D) + EPS); const float rstd = 1.0f / nr, rstd2 = 1.0f / nr2;
            if (lane == 0) { ((GAS float*)XRS)[t] = nr; ((GAS float*)XRS)[t2] = nr2; }
            GAS unsigned long long* o8 = (GAS unsigned long long*)(XN + (size_t)t * D) + lane; GAS unsigned long long* o82 = (GAS unsigned long long*)(XN + (size_t)t2 * D) + lane;
#pragma unroll
            for (int j = 0; j < 4; ++j) {
                o8[64 * j] = (unsigned long long)pk2(v[j].x * rstd, v[j].y * rstd) | ((unsigned long long)pk2(v[j].z * rstd, v[j].w * rstd) << 32);
                o82[64 * j] = (unsigned long long)pk2(w[j].x * rstd2, w[j].y * rstd2) | ((unsigned long long)pk2(w[j].z * rstd2, w[j].w * rstd2) << 32); }
        }
    }
    SEAM(PH_PRO);

    if (IN(PH_PROJ)) { PH_BEGIN
        pg8::Gemm g{XN, Win_t, T, NPROJ, D}; pg8::StaticOrder S; S.init(T, NPROJ, G, bx);
        pg8::EpiProj E{ws, WS_QLN, WS_KVLN, WS_QB, WS_KB, WS_VB, WS_SSQ, WS_KMEAN, WS_ROPE, AP->mqhead_g, AP->mkhead_g, C2B, EPS, SEQ};
        pg8::gemm_phase<pg8::EpiProj, pg8::StaticOrder, true, true>(lds, g, S, E);
    }
    SEAM(PH_PROJ);

    if (IN(PH_UP)) { PH_BEGIN
        { int K256 = 256; asm volatile("" : "+s"(K256)); pg8::Gemm g{QLN, Wq_t, T, 768, K256}; pg8::StaticOrder S; S.init(T, 768, G, bx); pg8::EpiBf16Rs E{QA, 768, SSQ, 0, 1.0f / 256.0f, EPS};
          pg8::gemm_phase<pg8::EpiBf16Rs, pg8::StaticOrder, true, true>(lds, g, S, E); }
        { int K256 = 256; asm volatile("" : "+s"(K256)); pg8::Gemm g{KVLN, Wkv_t, T, 1024, K256}; pg8::StaticOrder S; S.init(T, 1024, G, bx); pg8::EpiKv E{KA, VA, KVLN, SSQ, ropeR, AP->khead_g, EPS, SEQ};
          pg8::gemm_phase<pg8::EpiKv, pg8::StaticOrder, true, true>(lds, g, S, E); }
    }
    SEAM(PH_UP);

    if (IN(PH_ATTN)) { PH_BEGIN
        bf16* O = O8;
        float brefA, brefB;
        { const GAS float* gq = (const GAS float*)AP->qhead_g; const GAS float* gk = (const GAS float*)AP->khead_g; const GAS float* mq = (const GAS float*)AP->mqhead_g; const GAS float* mk = (const GAS float*)AP->mkhead_g;
          float a = fabsf(gq[lane]), c = fabsf(gk[lane]); if (lane < 32) { a = fmaxf(a, fabsf(gq[64 + lane])); c = fmaxf(c, fabsf(gk[64 + lane])); }
          float e = fabsf(mq[lane]), f = fabsf(mk[lane]);
#pragma unroll
          for (int o = 1; o < 64; o <<= 1) { a = fmaxf(a, __shfl_xor(a, o)); c = fmaxf(c, __shfl_xor(c, o)); e = fmaxf(e, __shfl_xor(e, o)); f = fmaxf(f, __shfl_xor(f, o)); }
          brefA = 96.0f * C2A * a * c * 1.03f; brefB = 64.0f * C2B * e * f * 1.03f; }
        const bool fixA = __builtin_amdgcn_readfirstlane(brefA < 50.0f ? 1 : 0) != 0, fixB = __builtin_amdgcn_readfirstlane(brefB < 50.0f ? 1 : 0) != 0;
        for (int u = bx; u < 512; u += G) {
            const int bh = u & 255, b = bh >> 3, h = bh & 7; const size_t r0 = (size_t)b * SEQ;
            if (u < 256) {
                for (int qb = 7; qb >= 0; --qb) {
                    if (fixA) attn_unit<96, false, true, true>(lds, AP->qhead_g, ropeR, QA + r0 * 768 + h * 96, 768, KA + r0 * 768 + h * 96, 768, VA + r0 * 512 + h * 64, 512, (bf16*)((unsigned char*)O + r0 * 1024 + h * 64), 1024, OSSQ + r0 * 16 + h, qb, nullptr, 0, brefA);
                    else      attn_unit<96, false, true, false>(lds, AP->qhead_g, ropeR, QA + r0 * 768 + h * 96, 768, KA + r0 * 768 + h * 96, 768, VA + r0 * 512 + h * 64, 512, (bf16*)((unsigned char*)O + r0 * 1024 + h * 64), 1024, OSSQ + r0 * 16 + h, qb, nullptr, 0, 0.f); }
            } else {
                for (int qb = 7; qb >= 0; --qb) {
                    if (fixB) attn_unit<64, true, false, true>(lds, nullptr, nullptr, QB + r0 * 512 + h * 64, 512, KB + r0 * 512 + h * 64, 512, VB + r0 * 512 + h * 64, 512, (bf16*)((unsigned char*)O + r0 * 1024 + 512 + h * 64), 1024, OSSQ + r0 * 16 + 8 + h, qb, kmean + ((size_t)b * 8 * NH + h) * 64, NH * 64, brefB);
                    else      attn_unit<64, true, false, false>(lds, nullptr, nullptr, QB + r0 * 512 + h * 64, 512, KB + r0 * 512 + h * 64, 512, VB + r0 * 512 + h * 64, 512, (bf16*)((unsigned char*)O + r0 * 1024 + 512 + h * 64), 1024, OSSQ + r0 * 16 + 8 + h, qb, kmean + ((size_t)b * 8 * NH + h) * 64, NH * 64, 0.f); }
            }
        }
    }
    SEAM(PH_ATTN);

    if (IN(PH_OUT)) { PH_BEGIN
        pg8::Gemm g{O8, Wo_t, T, D, D / 2};        pg8::StaticOrder S; S.init(T, D, G, bx);
        LAS float* rsl = (LAS float*)(lds + RING_BYTES);
        { pg8::Unit uu;
          for (int i = 0; i < 12 && S.next(i, uu); ++i) if (tid < 256) { const GAS f32x4* pq = (const GAS f32x4*)((const GAS float*)OSSQ + (size_t)(uu.pm * 256 + tid) * 16); const f32x4 a0 = pq[0], a1 = pq[1], b0 = pq[2], b1 = pq[3];
              const float sa = ((a0[0] + a0[1]) + (a0[2] + a0[3])) + ((a1[0] + a1[1]) + (a1[2] + a1[3])), sb = ((b0[0] + b0[1]) + (b0[2] + b0[3])) + ((b1[0] + b1[1]) + (b1[2] + b1[3]));
              const float ra = 1.0f / sqrtf(sa * (1.0f / 512.0f) + EPS), rb = 1.0f / sqrtf(sb * (1.0f / 512.0f) + EPS);
              *(LAS f32x2*)(rsl + (i * 256 + tid) * 2) = (f32x2){ra / rb, rb}; }
          __syncthreads(); }
        pg8::EpiOut E{XN, XRS, X1B, rsl};
        pg8::gemm_phase<pg8::EpiOut, pg8::StaticOrder, true, true, false, false, true, 0x7a7a7a7a, 0x7b7b7b7b, true>(lds, g, S, E);
    }
    SEAM(PH_OUT);

    if (IN(PH_ROUTE)) { PH_BEGIN
        LAS float* Wrg = (LAS float*)(lds + P8_WRG); LAS float* xt = (LAS float*)(lds + P8_XT + wave * P8_XT_WAVE); LAS float* wc = (LAS float*)(lds + P8_WC);
        LAS int* rt_g = (LAS int*)(lds + P8_RT); LAS float* rt_w = (LAS float*)(lds + P8_RT + 1024); LAS int* rt_rank = (LAS int*)(lds + P8_RT + 3072);
        LAS int* lcnt = (LAS int*)(lds + P8_RT + 4096); LAS int* lbase = (LAS int*)(lds + P8_RT + 4608); LAS float* rt_rs = (LAS float*)(lds + P8_RT + 5120);
        for (int k = tid; k < 1024; k += 512) *(LAS f32x4*)(Wrg + 4 * k) = *((const GAS f32x4*)WRGF + k);
        __syncthreads();
        const int r32 = lane & 31, kh = lane >> 5;
        for (int chunk = bx; chunk < T / 256; chunk += G) {
            if (tid < NCLS) lcnt[tid] = 0;
            const int rowc = wave * 32 + r32; const size_t row0w = (size_t)chunk * 256 + wave * 32;
            const GAS bf16* xsrc = (const GAS bf16*)X1B + (row0w + (lane >> 4)) * D + 4 * (lane & 15);
            f32x16 accE = {}; float aG0 = 0.f, aG1 = 0.f, aG2 = 0.f, aG3 = 0.f, ssq = 0.f;
            *(LAS f32x4*)(wc + 4 * tid) = *((const GAS f32x4*)WREF + tid);
            v2u xn[8]; f32x4 gvn;
#pragma unroll
            for (int j = 0; j < 8; ++j) xn[j] = *(const GAS v2u*)(xsrc + (size_t)(4 * j) * D);
            gvn = *(const GAS f32x4*)((const GAS float*)AP->ffn_g + 4 * (lane & 15));
#pragma unroll 1
            for (int kc = 0; kc < 16; ++kc) {
                f32x4 st[8];
#pragma unroll
                for (int j = 0; j < 8; ++j) st[j] = (f32x4){bflo(xn[j].x), bfhi(xn[j].x), bflo(xn[j].y), bfhi(xn[j].y)};
                const f32x4 gv = gvn;
                if (kc + 1 < 16) {
#pragma unroll
                    for (int j = 0; j < 8; ++j) xn[j] = *(const GAS v2u*)(xsrc + (size_t)(4 * j) * D + (kc + 1) * 64);
                    gvn = *(const GAS f32x4*)((const GAS float*)AP->ffn_g + (kc + 1) * 64 + 4 * (lane & 15)); }
                f32x4 wnext = {0.f, 0.f, 0.f, 0.f}; if (kc + 1 < 16) wnext = *((const GAS f32x4*)WREF + (kc + 1) * 512 + tid);
#pragma unroll
                for (int j = 0; j < 8; ++j) *(LAS f32x4*)(xt + ((lane >> 4) + 4 * j) * 68 + 4 * (lane & 15)) = st[j];
                if (kc + 1 < 16) *(LAS f32x4*)(wc + ((kc + 1) & 1) * 2048 + 4 * tid) = wnext;
                {
#pragma unroll
                  for (int j = 0; j < 8; ++j) { const f32x4 hv = st[j] * gv;
                      *(GAS unsigned*)((GAS unsigned char*)YH + (size_t)(row0w + (lane >> 4) + 4 * j) * D + kc * 64 + 4 * (lane & 15)) = pk4_fp8(hv[0], hv[1], hv[2], hv[3]); } }
                __syncthreads();
                const LAS float* wcc = wc + (kc & 1) * 2048 + r32;
#pragma unroll
                for (int c = 0; c < 8; ++c) {
                    const f32x4 xv = *(const LAS f32x4*)(xt + r32 * 68 + 8 * c + 4 * kh);
                    ssq += (xv.x * xv.x + xv.y * xv.y) + (xv.z * xv.z + xv.w * xv.w);
#pragma unroll
                    for (int e = 0; e < 4; ++e) { const int kl = 8 * c + 4 * kh + e;
                        const float a = wcc[kl * 32]; accE = __builtin_amdgcn_mfma_f32_32x32x2f32(a, xv[e], accE, 0, 0, 0);
                        const f32x4 wg = *(const LAS f32x4*)(Wrg + 4 * (kc * 64 + kl)); aG0 += xv[e] * wg[0]; aG1 += xv[e] * wg[1]; aG2 += xv[e] * wg[2]; aG3 += xv[e] * wg[3]; }
                }
                __syncthreads();
            }
            ssq += __shfl_xor(ssq, 32); aG0 += __shfl_xor(aG0, 32); aG1 += __shfl_xor(aG1, 32); aG2 += __shfl_xor(aG2, 32); aG3 += __shfl_xor(aG3, 32);
            const float rstd = 1.0f / sqrtf(ssq * (1.f / D) + EPS);
            float lg[4] = {aG0 * rstd + AP->b_rg[0], aG1 * rstd + AP->b_rg[1], aG2 * rstd + AP->b_rg[2], aG3 * rstd + AP->b_rg[3]};
            int gs = 0; float gm = lg[0];
#pragma unroll
            for (int i = 1; i < 4; ++i) if (lg[i] > gm) { gm = lg[i]; gs = i; }
            float den = 0.f;
#pragma unroll
            for (int i = 0; i < 4; ++i) den += __expf(lg[i] - gm);
            const float gwt = 1.0f / den;
            float mine[4];
#pragma unroll
            for (int i = 0; i < 4; ++i) { const float v = (gs == 0) ? accE[i] : (gs == 1) ? accE[4 + i] : (gs == 2) ? accE[8 + i] : accE[12 + i]; mine[i] = v * rstd + AP->b_re[gs * 8 + 4 * kh + i]; }
            float ev[8];
#pragma unroll
            for (int i = 0; i < 4; ++i) { const float oth = __shfl_xor(mine[i], 32); ev[i] = kh ? oth : mine[i]; ev[4 + i] = kh ? mine[i] : oth; }
            int e1 = 0; float v1 = ev[0];
#pragma unroll
            for (int i = 1; i < 8; ++i) if (ev[i] > v1) { v1 = ev[i]; e1 = i; }
            int e2 = -1; float v2 = -INFINITY;
#pragma unroll
            for (int i = 0; i < 8; ++i) if (i != e1 && (e2 < 0 || ev[i] > v2)) { v2 = ev[i]; e2 = i; }
            const float ex = __expf(v2 - v1); const float w1 = gwt / (1.0f + ex), w2 = gwt * ex / (1.0f + ex);
            if (kh == 0) { const int elo = e1 < e2 ? e1 : e2, ehi = e1 < e2 ? e2 : e1;
                rt_g[rowc] = gs * 28 + ((elo * (15 - elo)) >> 1) + (ehi - elo - 1); rt_w[rowc * 2] = e1 < e2 ? w1 : w2; rt_w[rowc * 2 + 1] = e1 < e2 ? w2 : w1; rt_rs[rowc] = rstd; }
            __syncthreads();
            if (tid < 256) rt_rank[tid] = __hip_atomic_fetch_add(&lcnt[rt_g[tid]], 1, __ATOMIC_RELAXED, __HIP_MEMORY_SCOPE_WORKGROUP);
            __syncthreads();
            if (tid < NCLS) { const int n = lcnt[tid]; lbase[tid] = n ? (int)__hip_atomic_fetch_add((gu32*)(ws + WS_CTL) + CW_GCNT + 64 * tid, (unsigned)n, RLX_AGENT) : 0; }
            __syncthreads();
            if (tid < 256) { const int g = rt_g[tid]; v4u ev; ev.x = (unsigned)(chunk * 256 + tid); ev.y = __builtin_bit_cast(unsigned, rt_w[tid * 2]); ev.z = __builtin_bit_cast(unsigned, rt_w[tid * 2 + 1]); ev.w = __builtin_bit_cast(unsigned, rt_rs[tid]);
                ((GAS v4u*)lists)[(size_t)g * LIST_CAP + lbase[g] + rt_rank[tid]] = ev; }
            __syncthreads();
        }
    }
    SEAM(PH_ROUTE);

    LAS int* tp = (LAS int*)(lds + TP_OFF); LAS int* cntl = (LAS int*)(lds + CNT_OFF); LAS int* ptab = (LAS int*)(lds + PT_OFF); LAS int* tpf = (LAS int*)(lds + TPF_OFF); LAS int* tph = (LAS int*)(lds + TPH_OFF);
    if (hi > PH_ROUTE) {
        if (tid0 == 0) { gu32* ctl = (gu32*)(A.ws + WS_CTL); int acc = 0, accf = 0, acch = 0; for (int g = 0; g < NCLS; ++g) { const int n = (int)__hip_atomic_load(ctl + CW_GCNT + 64 * g, RLX_AGENT); cntl[g] = n; tp[g] = acc; acc += (n + 255) >> 8; const int r_ = n & 255; const int nh_ = (r_ != 0 && r_ <= 128) ? 1 : 0; tpf[g] = accf; accf += ((n + 255) >> 8) - nh_; tph[g] = acch; acch += nh_; } tp[NCLS] = acc; tpf[NCLS] = accf; tph[NCLS] = acch;
            int p = 0; for (int lo_ = 0; lo_ < 8; ++lo_) for (int hi_ = lo_ + 1; hi_ < 8; ++hi_) ptab[p++] = lo_ | (hi_ << 4); }
        __syncthreads();
    }

    if (IN(PH_GU)) { PH_BEGIN
        pg8::Gemm g{YH, Wgu_t, 0, 0, D / 2}; pg8::ClsOrder S{tp, 0, G, MOE_SLOT(4), lists};
        pg8::EpiGateUp2 E{HB, lists, cntl};
        pg8::gemm_phase<pg8::EpiGateUp2, pg8::ClsOrder, true, true, true, false, true, 0x7a7a7a7a, 0x7f7f7f7f, true>(lds, g, S, E);
    }
    SEAM(PH_GU);

    if (IN(PH_D0)) { PH_BEGIN
        int K512 = 256; asm volatile("" : "+s"(K512)); pg8::Gemm g{HB, Wd_t, 0, 0, K512};        pg8::ClsOrder S{tp, 1, G, MOE_SLOT(4), lists};
        pg8::EpiDown2 E{AP->out, X1B, lists, cntl};
        pg8::gemm_phase<pg8::EpiDown2, pg8::ClsOrder, true, true, false, true, true, 0x7b7b7b7b, 0x7c7c7c7c, true>(lds, g, S, E);
    }
#undef IN
#undef SEAM
}

extern "C" void kernel_launch(void* const* d_in, const int* in_sizes, int n_in, void* d_out, int out_size, void* d_ws, size_t ws_size, hipStream_t stream) {
    static int grid = 0;
    if (grid == 0) {
        if (n_in != 22 || in_sizes[0] != T * D || out_size != T * D || ws_size < WS_END) { fprintf(stderr, "kernel_launch: unexpected shapes (n_in %d, in0 %d, out %d, ws %zu); nothing launched\n", n_in, n_in > 0 ? in_sizes[0] : -1, out_size, ws_size); grid = -1; return; }
        int dev = 0, cus = 0, per_cu = 0;
        if (hipGetDevice(&dev) != hipSuccess || hipDeviceGetAttribute(&cus, hipDeviceAttributeMultiprocessorCount, dev) != hipSuccess) { grid = -1; return; }
        if (hipFuncSetAttribute((const void*)mk_fwd, hipFuncAttributeMaxDynamicSharedMemorySize, LDS_BYTES) != hipSuccess) { fprintf(stderr, "kernel_launch: hipFuncSetAttribute failed\n"); grid = -1; return; }
        if (hipOccupancyMaxActiveBlocksPerMultiprocessor(&per_cu, (const void*)mk_fwd, 512, LDS_BYTES) != hipSuccess || per_cu < 1) { fprintf(stderr, "kernel_launch: occupancy query says %d\n", per_cu); }
        (void)hipGetLastError();
        grid = cus;
    }
    if (grid < 0) return;
    if (hipMemsetAsync((char*)d_ws + WS_CTL, 0, CTL_ZERO_BYTES, stream) != hipSuccess) return;
    Args a{};
    a.x = (const float*)d_in[0]; a.attn_g = (const float*)d_in[1]; a.w_in = (const float*)d_in[2]; a.qlat_g = (const float*)d_in[3]; a.w_qup = (const float*)d_in[4];
    a.kvlat_g = (const float*)d_in[5]; a.w_kvup = (const float*)d_in[6]; a.qhead_g = (const float*)d_in[7]; a.khead_g = (const float*)d_in[8];
    a.mqhead_g = (const float*)d_in[9]; a.mkhead_g = (const float*)d_in[10]; a.onorm_a_g = (const float*)d_in[11]; a.onorm_b_g = (const float*)d_in[12];
    a.w_out = (const float*)d_in[13]; a.ffn_g = (const float*)d_in[14]; a.w_rg = (const float*)d_in[15]; a.b_rg = (const float*)d_in[16];
    a.w_re = (const float*)d_in[17]; a.b_re = (const float*)d_in[18]; a.w_gate = (const float*)d_in[19]; a.w_up = (const float*)d_in[20]; a.w_down = (const float*)d_in[21];
    a.out = (float*)d_out; a.ws = (unsigned char*)d_ws; a.ph_lo = 0; a.ph_hi = NPHASE;
    hipLaunchKernelGGL(mk_fwd, dim3(grid), dim3(512), LDS_BYTES, stream, a);
    (void)hipPeekAtLastError();
}
```

```cpp
#include <hip/hip_runtime.h>
#include <cstdio>
#include <cstdint>
namespace pg8 {
#define PG8_LAS __attribute__((address_space(3)))
typedef unsigned short bf16_t;
typedef short bf16x8 __attribute__((ext_vector_type(8)));
typedef float f32x4 __attribute__((ext_vector_type(4)));
typedef unsigned u32x4 __attribute__((ext_vector_type(4)));
constexpr int BM = 256, BK = 64, HALF = 128, HTB = HALF * BK * 2  , STAGE_BYTES = 8 * HTB, NXCD = 8, WGM = 8;

__host__ __device__ __forceinline__ int lds_byte(int r, int c) { const int st = (r >> 4) * 2 + (c >> 5), rr = r & 15, cc = c & 31, ob = rr * 64 + cc * 2; return st * 1024 + (ob ^ (((ob >> 9) & 1) << 5)); }
__host__ __device__ __forceinline__ void stage_rc(int b, int& R, int& C) { const int st = b / 1024, sb = b % 1024, swz = sb ^ (((sb >> 9) & 1) << 5); R = (st >> 1) * 16 + swz / 64; C = (st & 1) * 32 + (swz % 64) / 2; }
__host__ __device__ __forceinline__ int perm32(int rho) { const int n = rho >> 4, i = rho & 15; return 8 * (i >> 2) + 4 * n + (i & 3); }

struct Unit { int pm, pn, g0, g1, pn2, q, hf; };
struct Gemm { const bf16_t* A; const bf16_t* Bt; int M, N, K; int lda = 0; };

struct StaticOrder {
    int nM, nN, nwg, G, c;
    __host__ __device__ __forceinline__ void init(int M, int N, int G_, int c_) { nM = M / BM; nN = N / BM; nwg = nM * nN; G = G_; c = c_; }
    __host__ __device__ __forceinline__ bool next(int i, Unit& u) const {
        const long L = (long)i * G + c; if (L >= nwg) return false;
        int wgid = (int)L; { const int q = nwg / NXCD, r = nwg % NXCD, xcd = wgid % NXCD, off = wgid / NXCD; wgid = (xcd < r ? xcd * (q + 1) : r * (q + 1) + (xcd - r) * q) + off; }
        const int nig = WGM * nN, gid = wgid / nig, fm = gid * WGM, gsz = (nM - fm) < WGM ? (nM - fm) : WGM;
        u.pm = fm + ((wgid % nig) % gsz); u.pn = ((wgid % nig) / gsz + gid) % nN; u.g0 = i; u.g1 = 0; u.pn2 = 0; u.q = 0; u.hf = 0; return true;
    }
    __device__ __forceinline__ void a_ready(const Unit&) const {}
    __device__ __forceinline__ void done(const Unit&) const {}
};

__device__ __forceinline__ unsigned cvt_pk_bf16(float lo, float hi) { unsigned r; asm volatile("v_cvt_pk_bf16_f32 %0, %1, %2" : "=v"(r) : "v"(lo), "v"(hi)); return r; }
#define PG8_GAS __attribute__((address_space(1)))
struct ListEnt { int tok; float w_lo; float w_hi; float rstd; };

struct EpiBf16 {
    static constexpr bool PERM = true, AFTER_DRAIN = false, MIDHOOK = false;
    bf16_t* O; int ldc;
    __device__ __forceinline__ void operator()(const f32x4 (&acc)[2][2][4][2], const Unit& u, int wr, int wc, int fr, int fq) const {
        const int row0 = u.pm * BM + wr * 64 + fr; const int col0 = u.pn * BM + wc * 32 + 8 * fq;
#pragma unroll
        for (int ai = 0; ai < 2; ++ai)
#pragma unroll
            for (int m = 0; m < 4; ++m) { bf16_t* rowp = O + (size_t)(row0 + ai * HALF + m * 16) * ldc + col0;
#pragma unroll
                for (int bj = 0; bj < 2; ++bj) { const f32x4 v0 = acc[ai][bj][m][0], v1 = acc[ai][bj][m][1];
                    u32x4 w; w.x = cvt_pk_bf16(v0[0], v0[1]); w.y = cvt_pk_bf16(v0[2], v0[3]); w.z = cvt_pk_bf16(v1[0], v1[1]); w.w = cvt_pk_bf16(v1[2], v1[3]);
                    *(PG8_GAS u32x4*)(rowp + bj * HALF) = w; } }
    }
};
struct EpiBf16Rs {
    static constexpr bool PERM = true, AFTER_DRAIN = false, MIDHOOK = false;
    bf16_t* O; int ldc; const float* ssq; int off; float inv_n, eps;
    __device__ __forceinline__ void operator()(const f32x4 (&acc)[2][2][4][2], const Unit& u, int wr, int wc, int fr, int fq) const {
        const int row0 = u.pm * BM + wr * 64 + fr; const int col0 = u.pn * BM + wc * 32 + 8 * fq;
        float rsv[8];
#pragma unroll
        for (int i = 0; i < 8; ++i) { const f32x4 sq = *(const PG8_GAS f32x4*)(ssq + (size_t)(row0 + (i >> 2) * HALF + (i & 3) * 16) * 8 + off); rsv[i] = __builtin_amdgcn_rsqf(((sq[0] + sq[1]) + (sq[2] + sq[3])) * inv_n + eps); }
#pragma unroll
        for (int ai = 0; ai < 2; ++ai)
#pragma unroll
            for (int m = 0; m < 4; ++m) { const int row = row0 + ai * HALF + m * 16; PG8_GAS bf16_t* rowp = (PG8_GAS bf16_t*)O + (size_t)row * ldc + col0;
                const float rs = rsv[ai * 4 + m];
#pragma unroll
                for (int bj = 0; bj < 2; ++bj) { const f32x4 v0 = acc[ai][bj][m][0] * rs, v1 = acc[ai][bj][m][1] * rs;
                    u32x4 w; w.x = cvt_pk_bf16(v0[0], v0[1]); w.y = cvt_pk_bf16(v0[2], v0[3]); w.z = cvt_pk_bf16(v1[0], v1[1]); w.w = cvt_pk_bf16(v1[2], v1[3]);
                    *(PG8_GAS u32x4*)(rowp + bj * HALF) = w; } }
    }
};
struct EpiProj {
    static constexpr bool PERM = true, AFTER_DRAIN = false, MIDHOOK = false;
    unsigned char* ws; size_t o_qln, o_kvln, o_qb, o_kb, o_vb, o_ssq, o_kmean, o_rope; const float* gq; const float* gk; float qscale, eps; int seq;
    __device__ __forceinline__ void operator()(const f32x4 (&acc)[2][2][4][2], const Unit& u, int wr, int wc, int fr, int fq) const {
        const int pn = u.pn; const int row0 = u.pm * BM + wr * 64 + fr;
        bf16_t* const QLN = (bf16_t*)(ws + o_qln); bf16_t* const KVLN = (bf16_t*)(ws + o_kvln); bf16_t* const QB = (bf16_t*)(ws + o_qb); bf16_t* const KB = (bf16_t*)(ws + o_kb); bf16_t* const VB = (bf16_t*)(ws + o_vb);
        float* const SSQ = (float*)(ws + o_ssq); float* const kmean = (float*)(ws + o_kmean); const float* const rope = (const float*)(ws + o_rope);
        if (pn < 2) {
            PG8_GAS bf16_t* O = (PG8_GAS bf16_t*)(pn ? KVLN : QLN); PG8_GAS float* sq = (PG8_GAS float*)SSQ;
#pragma unroll
            for (int ai = 0; ai < 2; ++ai)
#pragma unroll
                for (int m = 0; m < 4; ++m) { const int row = row0 + ai * HALF + m * 16; PG8_GAS bf16_t* rowp = O + (size_t)row * 256 + wc * 32 + 8 * fq; float ss = 0.f;
#pragma unroll
                    for (int bj = 0; bj < 2; ++bj) { const f32x4 v0 = acc[ai][bj][m][0], v1 = acc[ai][bj][m][1];
                        if (pn == 0 || bj == 0) ss += (v0[0] * v0[0] + v0[1] * v0[1]) + (v0[2] * v0[2] + v0[3] * v0[3]) + (v1[0] * v1[0] + v1[1] * v1[1]) + (v1[2] * v1[2] + v1[3] * v1[3]);
                        u32x4 w; w.x = cvt_pk_bf16(v0[0], v0[1]); w.y = cvt_pk_bf16(v0[2], v0[3]); w.z = cvt_pk_bf16(v1[0], v1[1]); w.w = cvt_pk_bf16(v1[2], v1[3]);
                        *(PG8_GAS u32x4*)(rowp + bj * HALF) = w; }
                    ss += __shfl_xor(ss, 16); ss += __shfl_xor(ss, 32);
                    if (fq == 0) sq[(size_t)row * 8 + pn * 4 + wc] = ss; }
        } else if (pn < 6) {
            const bool isk = pn >= 4; const int head = (pn & 1) * 4 + wc; const float* gp = isk ? gk : gq; asm volatile("" : "+s"(gp)); const float sc = isk ? 1.0f : qscale;
            PG8_GAS bf16_t* O = (PG8_GAS bf16_t*)(isk ? KB : QB);
            f32x4 g0[2], g1[2];
#pragma unroll
            for (int n = 0; n < 2; ++n) { g0[n] = *(const PG8_GAS f32x4*)(gp + 8 * fq + 4 * n); g1[n] = *(const PG8_GAS f32x4*)(gp + 32 + 8 * fq + 4 * n); }
            f32x4 cs0[2] = {{0.f, 0.f, 0.f, 0.f}, {0.f, 0.f, 0.f, 0.f}}, cs1[2] = {{0.f, 0.f, 0.f, 0.f}, {0.f, 0.f, 0.f, 0.f}};
            f32x4 rc[2][4];
            { const int pos0 = row0 & (seq - 1);
#pragma unroll
              for (int n = 0; n < 2; ++n) { rc[0][n] = *(const PG8_GAS f32x4*)(rope + (size_t)pos0 * 32 + 8 * fq + 4 * n); rc[0][2 + n] = *(const PG8_GAS f32x4*)(rope + (size_t)seq * 32 + (size_t)pos0 * 32 + 8 * fq + 4 * n); } }
#pragma unroll
            for (int ai = 0; ai < 2; ++ai)
#pragma unroll
                for (int m = 0; m < 4; ++m) { const int row = row0 + ai * HALF + m * 16; const int gi = ai * 4 + m;
                    if (gi < 7) { const int gn = gi + 1; const int posn = (row0 + (gn >> 2) * HALF + (gn & 3) * 16) & (seq - 1);
#pragma unroll
                        for (int n = 0; n < 2; ++n) { rc[gn & 1][n] = *(const PG8_GAS f32x4*)(rope + (size_t)posn * 32 + 8 * fq + 4 * n); rc[gn & 1][2 + n] = *(const PG8_GAS f32x4*)(rope + (size_t)seq * 32 + (size_t)posn * 32 + 8 * fq + 4 * n); } }
                    float ss = 0.f;
#pragma unroll
                    for (int n = 0; n < 2; ++n) { const f32x4 a = acc[ai][0][m][n], b = acc[ai][1][m][n]; ss += (a[0] * a[0] + a[1] * a[1]) + (a[2] * a[2] + a[3] * a[3]) + (b[0] * b[0] + b[1] * b[1]) + (b[2] * b[2] + b[3] * b[3]); }
                    ss += __shfl_xor(ss, 16); ss += __shfl_xor(ss, 32);
                    const float rs = __builtin_amdgcn_rsqf(ss * (1.0f / 64.0f) + eps);
                    u32x4 w1, w2; unsigned pk1[4], pk2_[4];
#pragma unroll
                    for (int n = 0; n < 2; ++n) { const f32x4 c = rc[gi & 1][n], sn = rc[gi & 1][2 + n];
                        const f32x4 y1 = acc[ai][0][m][n] * rs * g0[n], y2 = acc[ai][1][m][n] * rs * g1[n];
                        const f32x4 o1 = (y1 * c - y2 * sn) * sc, o2 = (y2 * c + y1 * sn) * sc;
                        if (isk) { cs0[n] += o1; cs1[n] += o2; }
                        pk1[2 * n] = cvt_pk_bf16(o1[0], o1[1]); pk1[2 * n + 1] = cvt_pk_bf16(o1[2], o1[3]); pk2_[2 * n] = cvt_pk_bf16(o2[0], o2[1]); pk2_[2 * n + 1] = cvt_pk_bf16(o2[2], o2[3]); }
                    w1.x = pk1[0]; w1.y = pk1[1]; w1.z = pk1[2]; w1.w = pk1[3]; w2.x = pk2_[0]; w2.y = pk2_[1]; w2.z = pk2_[2]; w2.w = pk2_[3];
                    PG8_GAS bf16_t* rowp = O + (size_t)row * 512 + head * 64 + 8 * fq;
                    *(PG8_GAS u32x4*)rowp = w1; *(PG8_GAS u32x4*)(rowp + 32) = w2;
                    asm volatile("" : "+v"(cs0[0]), "+v"(cs0[1]), "+v"(cs1[0]), "+v"(cs1[1]) :: "memory"); }
            if (isk) {
                PG8_GAS float* km = (PG8_GAS float*)kmean + ((size_t)u.pm * 8 + head) * 64;
#pragma unroll
                for (int n = 0; n < 2; ++n)
#pragma unroll
                    for (int j = 0; j < 4; ++j) { float a = cs0[n][j], b = cs1[n][j];
#pragma unroll
                        for (int o = 1; o < 16; o <<= 1) { a += __shfl_xor(a, o); b += __shfl_xor(b, o); }
                        if (fr == 0) { __hip_atomic_fetch_add(km + 8 * fq + 4 * n + j, a * (1.0f / 256.0f), __ATOMIC_RELAXED, __HIP_MEMORY_SCOPE_AGENT); __hip_atomic_fetch_add(km + 32 + 8 * fq + 4 * n + j, b * (1.0f / 256.0f), __ATOMIC_RELAXED, __HIP_MEMORY_SCOPE_AGENT); } }
            }
        } else {
            PG8_GAS bf16_t* O = (PG8_GAS bf16_t*)VB; const int col0 = (pn - 6) * BM + wc * 32 + 8 * fq;
#pragma unroll
            for (int ai = 0; ai < 2; ++ai)
#pragma unroll
                for (int m = 0; m < 4; ++m) { PG8_GAS bf16_t* rowp = O + (size_t)(row0 + ai * HALF + m * 16) * 512 + col0;
#pragma unroll
                    for (int bj = 0; bj < 2; ++bj) { const f32x4 v0 = acc[ai][bj][m][0], v1 = acc[ai][bj][m][1];
                        u32x4 w; w.x = cvt_pk_bf16(v0[0], v0[1]); w.y = cvt_pk_bf16(v0[2], v0[3]); w.z = cvt_pk_bf16(v1[0], v1[1]); w.w = cvt_pk_bf16(v1[2], v1[3]);
                        *(PG8_GAS u32x4*)(rowp + bj * HALF) = w; } }
        }
    }
};
struct EpiKv {
    static constexpr bool PERM = true, AFTER_DRAIN = false, MIDHOOK = false;
    bf16_t* KA; bf16_t* VA; const bf16_t* KVLN; const float* ssq; const float* ropeR; const float* gk; float eps; int seq;
    __device__ __forceinline__ void operator()(const f32x4 (&acc)[2][2][4][2], const Unit& u, int wr, int wc, int fr, int fq) const {
        const int pn = u.pn; const int row0 = u.pm * BM + wr * 64 + fr;
        if (pn < 2) {
            const int head = pn * 4 + wc; const float* gp = gk; asm volatile("" : "+s"(gp));
            f32x4 g0[2], g1[2];
#pragma unroll
            for (int n = 0; n < 2; ++n) { g0[n] = *(const PG8_GAS f32x4*)(gp + 8 * fq + 4 * n); g1[n] = *(const PG8_GAS f32x4*)(gp + 32 + 8 * fq + 4 * n); }
            const f32x4 gr1 = *(const PG8_GAS f32x4*)(gp + 64 + 4 * fq), gr2 = *(const PG8_GAS f32x4*)(gp + 80 + 4 * fq);
            float rlv[8];
#pragma unroll
            for (int i = 0; i < 8; ++i) { const f32x4 sq = *(const PG8_GAS f32x4*)(ssq + (size_t)(row0 + (i >> 2) * HALF + (i & 3) * 16) * 8 + 4); rlv[i] = __builtin_amdgcn_rsqf(((sq[0] + sq[1]) + (sq[2] + sq[3])) * (1.0f / 128.0f) + eps); }
            typedef unsigned u32x2_ __attribute__((ext_vector_type(2)));
            u32x2_ pq[2][2]; f32x4 rq[2][2];
            { const PG8_GAS bf16_t* pe0 = (const PG8_GAS bf16_t*)KVLN + (size_t)row0 * 256 + 128 + 4 * fq; const int pos0 = row0 & (seq - 1);
              pq[0][0] = *(const PG8_GAS u32x2_*)pe0; pq[0][1] = *(const PG8_GAS u32x2_*)(pe0 + 16);
              rq[0][0] = *(const PG8_GAS f32x4*)(ropeR + (size_t)pos0 * 16 + 4 * fq); rq[0][1] = *(const PG8_GAS f32x4*)(ropeR + (size_t)seq * 16 + (size_t)pos0 * 16 + 4 * fq); }
#pragma unroll
            for (int ai = 0; ai < 2; ++ai)
#pragma unroll
                for (int m = 0; m < 4; ++m) { const int row = row0 + ai * HALF + m * 16; const int gi = ai * 4 + m;
                    if (gi < 7) { const int gn = gi + 1; const int rown = row0 + (gn >> 2) * HALF + (gn & 3) * 16; const int posn = rown & (seq - 1); const PG8_GAS bf16_t* pen = (const PG8_GAS bf16_t*)KVLN + (size_t)rown * 256 + 128 + 4 * fq;
                        pq[gn & 1][0] = *(const PG8_GAS u32x2_*)pen; pq[gn & 1][1] = *(const PG8_GAS u32x2_*)(pen + 16);
                        rq[gn & 1][0] = *(const PG8_GAS f32x4*)(ropeR + (size_t)posn * 16 + 4 * fq); rq[gn & 1][1] = *(const PG8_GAS f32x4*)(ropeR + (size_t)seq * 16 + (size_t)posn * 16 + 4 * fq); }
                    const float rl = rlv[gi];
                    const u32x2_ p1 = pq[gi & 1][0], p2 = pq[gi & 1][1];
                    const f32x4 e1 = {__builtin_bit_cast(float, p1.x << 16), __builtin_bit_cast(float, p1.x & 0xffff0000u), __builtin_bit_cast(float, p1.y << 16), __builtin_bit_cast(float, p1.y & 0xffff0000u)};
                    const f32x4 e2 = {__builtin_bit_cast(float, p2.x << 16), __builtin_bit_cast(float, p2.x & 0xffff0000u), __builtin_bit_cast(float, p2.y << 16), __builtin_bit_cast(float, p2.y & 0xffff0000u)};
                    f32x4 x0[2], x1[2]; float ss = (e1[0] * e1[0] + e1[1] * e1[1]) + (e1[2] * e1[2] + e1[3] * e1[3]) + (e2[0] * e2[0] + e2[1] * e2[1]) + (e2[2] * e2[2] + e2[3] * e2[3]);
#pragma unroll
                    for (int n = 0; n < 2; ++n) { x0[n] = acc[ai][0][m][n] * rl; x1[n] = acc[ai][1][m][n] * rl; const f32x4 a = x0[n], b = x1[n];
                        ss += (a[0] * a[0] + a[1] * a[1]) + (a[2] * a[2] + a[3] * a[3]) + (b[0] * b[0] + b[1] * b[1]) + (b[2] * b[2] + b[3] * b[3]); }
                    ss += __shfl_xor(ss, 16); ss += __shfl_xor(ss, 32);
                    const float rs = __builtin_amdgcn_rsqf(ss * (1.0f / 96.0f) + eps);
                    PG8_GAS bf16_t* rowp = (PG8_GAS bf16_t*)KA + (size_t)row * 768 + head * 96;
                    u32x4 w1, w2;
                    { const f32x4 a = x0[0] * rs * g0[0], b = x0[1] * rs * g0[1]; w1.x = cvt_pk_bf16(a[0], a[1]); w1.y = cvt_pk_bf16(a[2], a[3]); w1.z = cvt_pk_bf16(b[0], b[1]); w1.w = cvt_pk_bf16(b[2], b[3]); }
                    { const f32x4 a = x1[0] * rs * g1[0], b = x1[1] * rs * g1[1]; w2.x = cvt_pk_bf16(a[0], a[1]); w2.y = cvt_pk_bf16(a[2], a[3]); w2.z = cvt_pk_bf16(b[0], b[1]); w2.w = cvt_pk_bf16(b[2], b[3]); }
                    *(PG8_GAS u32x4*)(rowp + 8 * fq) = w1; *(PG8_GAS u32x4*)(rowp + 32 + 8 * fq) = w2;
                    const f32x4 c = rq[gi & 1][0], sn = rq[gi & 1][1];
                    const f32x4 y1 = e1 * rs * gr1, y2 = e2 * rs * gr2; const f32x4 o1 = y1 * c - y2 * sn, o2 = y2 * c + y1 * sn;
                    u32x2_ r1, r2; r1.x = cvt_pk_bf16(o1[0], o1[1]); r1.y = cvt_pk_bf16(o1[2], o1[3]); r2.x = cvt_pk_bf16(o2[0], o2[1]); r2.y = cvt_pk_bf16(o2[2], o2[3]);
                    *(PG8_GAS u32x2_*)(rowp + 64 + 4 * fq) = r1; *(PG8_GAS u32x2_*)(rowp + 80 + 4 * fq) = r2;
                    asm volatile("" ::: "memory"); }
        } else {
            const int col0 = (pn - 2) * BM + wc * 32 + 8 * fq;
            float rlv[8];
#pragma unroll
            for (int i = 0; i < 8; ++i) { const f32x4 sq = *(const PG8_GAS f32x4*)(ssq + (size_t)(row0 + (i >> 2) * HALF + (i & 3) * 16) * 8 + 4); rlv[i] = __builtin_amdgcn_rsqf(((sq[0] + sq[1]) + (sq[2] + sq[3])) * (1.0f / 128.0f) + eps); }
#pragma unroll
            for (int ai = 0; ai < 2; ++ai)
#pragma unroll
                for (int m = 0; m < 4; ++m) { const int row = row0 + ai * HALF + m * 16; PG8_GAS bf16_t* rowp = (PG8_GAS bf16_t*)VA + (size_t)row * 512 + col0;
                    const float rl = rlv[ai * 4 + m];
#pragma unroll
                    for (int bj = 0; bj < 2; ++bj) { const f32x4 v0 = acc[ai][bj][m][0] * rl, v1 = acc[ai][bj][m][1] * rl;
                        u32x4 w; w.x = cvt_pk_bf16(v0[0], v0[1]); w.y = cvt_pk_bf16(v0[2], v0[3]); w.z = cvt_pk_bf16(v1[0], v1[1]); w.w = cvt_pk_bf16(v1[2], v1[3]);
                        *(PG8_GAS u32x4*)(rowp + bj * HALF) = w; } }
        }
    }
};
struct EpiOut {
    static constexpr bool PERM = true, AFTER_DRAIN = false, MIDHOOK = true;
    const bf16_t* xn; const float* xrs; bf16_t* x1b; const PG8_LAS float* rsl;
    __device__ __forceinline__ void mid(f32x4 (&acc)[2][2][4][2], const Unit& u, int wr, int wc, int fr, int fq) const {
        const PG8_LAS float* rs = rsl + (u.g0 * 256 + wr * 64 + fr) * 2;
#pragma unroll
        for (int ai = 0; ai < 2; ++ai)
#pragma unroll
            for (int m = 0; m < 4; ++m) { const float ratio = rs[(ai * HALF + m * 16) * 2];
#pragma unroll
                for (int bj = 0; bj < 2; ++bj)
#pragma unroll
                    for (int n = 0; n < 2; ++n) acc[ai][bj][m][n] *= ratio; }
    }
    __device__ __forceinline__ void operator()(const f32x4 (&acc)[2][2][4][2], const Unit& u, int wr, int wc, int fr, int fq) const {
        const int row0 = u.pm * BM + wr * 64 + fr; const int col0 = u.pn * BM + wc * 32 + 8 * fq;
        const PG8_LAS float* rs = rsl + (u.g0 * 256 + wr * 64 + fr) * 2 + 1;
        float xs[8];
#pragma unroll
        for (int i = 0; i < 8; ++i) xs[i] = *(const PG8_GAS float*)(xrs + row0 + (i >> 2) * HALF + (i & 3) * 16);
        u32x4 xr[2][4];
#pragma unroll
        for (int g = 0; g < 2; ++g) { const size_t off = (size_t)(row0 + g * 16) * 1024 + col0;
#pragma unroll
            for (int bj = 0; bj < 2; ++bj) xr[0][g * 2 + bj] = __builtin_nontemporal_load((const PG8_GAS u32x4*)(xn + off + bj * HALF)); }
#pragma unroll
        for (int pr = 0; pr < 4; ++pr) {
            if (pr < 3) {
#pragma unroll
                for (int g = 0; g < 2; ++g) { const int gi = 2 * (pr + 1) + g; const size_t off = (size_t)(row0 + (gi >> 2) * HALF + (gi & 3) * 16) * 1024 + col0;
#pragma unroll
                    for (int bj = 0; bj < 2; ++bj) xr[(pr + 1) & 1][g * 2 + bj] = __builtin_nontemporal_load((const PG8_GAS u32x4*)(xn + off + bj * HALF)); } }
#pragma unroll
            for (int g = 0; g < 2; ++g) { const int gi = 2 * pr + g; const int ai = gi >> 2, m = gi & 3; const size_t off = (size_t)(row0 + ai * HALF + m * 16) * 1024 + col0; const float rb = rs[(ai * HALF + m * 16) * 2]; const float sx = xs[gi];
#pragma unroll
                for (int bj = 0; bj < 2; ++bj) { const size_t p = off + bj * HALF; const u32x4 x = xr[pr & 1][g * 2 + bj];
                    f32x4 x0, x1; x0[0] = __builtin_bit_cast(float, x.x << 16); x0[1] = __builtin_bit_cast(float, x.x & 0xffff0000u); x0[2] = __builtin_bit_cast(float, x.y << 16); x0[3] = __builtin_bit_cast(float, x.y & 0xffff0000u);
                    x1[0] = __builtin_bit_cast(float, x.z << 16); x1[1] = __builtin_bit_cast(float, x.z & 0xffff0000u); x1[2] = __builtin_bit_cast(float, x.w << 16); x1[3] = __builtin_bit_cast(float, x.w & 0xffff0000u);
                    const f32x4 v0 = x0 * sx + acc[ai][bj][m][0] * rb, v1 = x1 * sx + acc[ai][bj][m][1] * rb;
                    u32x4 o; o.x = cvt_pk_bf16(v0[0], v0[1]); o.y = cvt_pk_bf16(v0[2], v0[3]); o.z = cvt_pk_bf16(v1[0], v1[1]); o.w = cvt_pk_bf16(v1[2], v1[3]);
                    *(PG8_GAS u32x4*)(x1b + p) = o; } }
            asm volatile("" ::: "memory"); }
    }
};
struct EpiGateUp2 {
    static constexpr bool PERM = true, AFTER_DRAIN = false, MIDHOOK = false;
    bf16_t* H; const ListEnt* lists; const PG8_LAS int* cnt;
    __device__ __forceinline__ void operator()(const f32x4 (&acc)[2][2][4][2], const Unit& u, int wr, int wc, int fr, int fq) const {
        const int rt0 = wr * 64 + fr; const int col0 = (u.q >> 1) * 256 + (u.q & 1) * 128 + wc * 32 + 8 * fq; const int g = u.g0; const int n_g = cnt[g]; const bool hiexp = (u.q >> 1) != 0;
        const ListEnt* lg = lists + (size_t)g * 65536 + u.g1 * 256;
        float wv[8], rv[8];
#pragma unroll
        for (int i = 0; i < 8; ++i) { const int rt = rt0 + (i >> 2) * HALF + (i & 3) * 16; f32x4 le = {0.f, 0.f, 0.f, 0.f}; if ((u.g1 * 256 + rt) < n_g) le = *(const PG8_GAS f32x4*)((const PG8_GAS ListEnt*)lg + rt); wv[i] = hiexp ? le[2] : le[1]; rv[i] = le[3]; }
#pragma unroll
        for (int ai = 0; ai < 2; ++ai) { if (ai == 1 && u.hf) break;
#pragma unroll
            for (int m = 0; m < 4; ++m) { const int rt = rt0 + ai * HALF + m * 16; const bool valid = (u.g1 * 256 + rt) < n_g;
                const float w = wv[ai * 4 + m], rsd = rv[ai * 4 + m]; (void)valid;
                const float c1 = -1.4426950408889634f * rsd, c2 = (rsd * rsd) * (w * 8.0f);
                unsigned pk[2];
#pragma unroll
                for (int n = 0; n < 2; ++n) { const f32x4 gv = acc[ai][0][m][n], uv = acc[ai][1][m][n];
                    const f32x4 e1 = gv * c1; f32x4 r;
#pragma unroll
                    for (int j = 0; j < 4; ++j) r[j] = __builtin_amdgcn_exp2f(e1[j]);
                    r = r + 1.0f;
#pragma unroll
                    for (int j = 0; j < 4; ++j) r[j] = __builtin_amdgcn_rcpf(r[j]);
                    const f32x4 h = ((gv * uv) * c2) * r;
                    { int w_ = 0; w_ = __builtin_amdgcn_cvt_pk_fp8_f32(h[0], h[1], w_, false); w_ = __builtin_amdgcn_cvt_pk_fp8_f32(h[2], h[3], w_, true); pk[n] = (unsigned)w_; } }
                typedef unsigned u32x2h_ __attribute__((ext_vector_type(2))); u32x2h_ o; o.x = pk[0]; o.y = pk[1];
                *(PG8_GAS u32x2h_*)((PG8_GAS unsigned char*)H + (size_t)(u.pm * BM + rt) * 512 + col0) = o; } }
    }
};
struct EpiDown2 {
    static constexpr bool PERM = true, AFTER_DRAIN = false, MIDHOOK = false;
    float* out; const bf16_t* x1b; const ListEnt* lists; const PG8_LAS int* cnt;
    __device__ __forceinline__ void operator()(const f32x4 (&acc)[2][2][4][2], const Unit& u, int wr, int wc, int fr, int fq) const {
        const int rt0 = wr * 64 + fr; const int col0 = u.q * 256 + wc * 32 + 8 * fq; const int g = u.g0; const int n_g = cnt[g];
        const ListEnt* lg = lists + (size_t)g * 65536 + u.g1 * 256;
        int tokv[8];
#pragma unroll
        for (int i = 0; i < 8; ++i) { const int rt = rt0 + (i >> 2) * HALF + (i & 3) * 16; tokv[i] = ((u.g1 * 256 + rt) < n_g) ? ((const PG8_GAS ListEnt*)lg)[rt].tok : -1; }
#pragma unroll
        for (int ai = 0; ai < 2; ++ai) { if (ai == 1 && u.hf) break;
            u32x4 xb[4][2];
#pragma unroll
            for (int m = 0; m < 4; ++m)
#pragma unroll
                for (int bj = 0; bj < 2; ++bj) { const int tok = tokv[ai * 4 + m]; xb[m][bj] = (u32x4){0u, 0u, 0u, 0u}; if (tok >= 0) xb[m][bj] = *(const PG8_GAS u32x4*)((const PG8_GAS bf16_t*)x1b + (size_t)tok * 1024 + col0 + bj * HALF); }
#pragma unroll
            for (int m = 0; m < 4; ++m) { const int tok = tokv[ai * 4 + m];
                if (tok >= 0) { PG8_GAS float* orow = (PG8_GAS float*)out + (size_t)tok * 1024 + col0;
#pragma unroll
                    for (int bj = 0; bj < 2; ++bj) { PG8_GAS float* p = orow + bj * HALF; const u32x4 x = xb[m][bj];
                        f32x4 a, b; a[0] = __builtin_bit_cast(float, x.x << 16); a[1] = __builtin_bit_cast(float, x.x & 0xffff0000u); a[2] = __builtin_bit_cast(float, x.y << 16); a[3] = __builtin_bit_cast(float, x.y & 0xffff0000u);
                        b[0] = __builtin_bit_cast(float, x.z << 16); b[1] = __builtin_bit_cast(float, x.z & 0xffff0000u); b[2] = __builtin_bit_cast(float, x.w << 16); b[3] = __builtin_bit_cast(float, x.w & 0xffff0000u);
                        *(PG8_GAS f32x4*)p = a + acc[ai][bj][m][0]; *(PG8_GAS f32x4*)(p + 4) = b + acc[ai][bj][m][1]; } } }
            asm volatile("" ::: "memory"); }
    }
};
struct RowOrder { int G, c, nM;
    __device__ __forceinline__ bool next(int i, Unit& u) const { const int pm = c + (i >> 2) * G; if (pm >= nM) return false; u.pm = pm; u.pn = (i + c) & 3; u.g0 = i; u.g1 = 0; u.pn2 = 0; u.q = 0; u.hf = 0; return true; }
    __device__ __forceinline__ void a_ready(const Unit&) const {}
    __device__ __forceinline__ void done(const Unit&) const {}
};
template <class S_> struct SchedHalf { static constexpr bool v = false; };
struct ClsOrder {
    const PG8_LAS int* tp; int mode, G, c; const ListEnt* lists;
    __device__ __forceinline__ int arow(const Unit& u, int row) const { const PG8_LAS int* cnt = tp + 128; const unsigned pos = (unsigned)(u.g1 * 256 + row); const unsigned n = (unsigned)cnt[u.g0]; const PG8_GAS ListEnt* lg = (const PG8_GAS ListEnt*)lists + (size_t)u.g0 * 65536; return lg[pos < n ? pos : 0u].tok; }
    __device__ __forceinline__ bool next(int i, Unit& u) const {
        const PG8_LAS int* cnt = tp + 128; const PG8_LAS int* ptab = tp + 256; const PG8_LAS int* tpf = tp + 320; const PG8_LAS int* tph = tp + 448;
        const int j = c >> 2, q = c & 3, NQ = G >> 2; const int nF = tpf[112], nH = tph[112];
        const int nfj = (j < nF) ? (nF - j + NQ - 1) / NQ : 0;
        int idx; bool hf;
        if (i < nfj) { idx = j + NQ * i; hf = false; }
        else { const int k = i - nfj, R = nF % NQ, Lq = NQ - R; int h;
            if (j >= R) h = (k < 2) ? (j - R) + Lq * k : 2 * Lq + j + NQ * (k - 2); else h = 2 * Lq + j + NQ * k;
            if (h >= nH) return false; idx = h; hf = true; }
        const PG8_LAS int* tb = hf ? tph : tpf;
        const int ln_ = (int)(threadIdx.x & 63u); const bool c0_ = tb[ln_] <= idx; const bool c1_ = (ln_ + 64 < 112) && (tb[ln_ + 64 < 112 ? ln_ + 64 : 0] <= idx);
        const int g = (int)__popcll(__ballot(c0_)) + (int)__popcll(__ballot(c1_)) - 1;
        const int grp = g / 28, pr = ptab[g - grp * 28], lo = pr & 15, hi = pr >> 4;
        const int g1 = hf ? (cnt[g] >> 8) : idx - tb[g];
        u.pm = tp[g] + g1; u.g0 = g; u.g1 = g1; u.q = q; u.hf = hf ? 1 : 0;
        if (mode == 0) { u.pn = (grp * 8 + ((q >> 1) ? hi : lo)) * 2 + (q & 1); u.pn2 = 0; } else { u.pn = (grp * 8 + lo) * 4 + q; u.pn2 = (grp * 8 + hi) * 4 + q; }
        return true;
    }
    __device__ __forceinline__ void a_ready(const Unit&) const {}
    __device__ __forceinline__ void done(const Unit&) const {}
};
template <> struct SchedHalf<ClsOrder> { static constexpr bool v = true; };

struct KzT { static constexpr bool v = true; }; struct KzF { static constexpr bool v = false; };
template <class Epi, class Sched, bool ALIGN_EPI = false, bool SP2 = false, bool GATHER = false, bool KSPLIT = false, bool F8 = false, int SCW = 0x7a7a7a7a, int SCA = 0x7f7f7f7f, bool F8ASM = false, bool ZS = false>
__device__ __forceinline__ void gemm_phase(PG8_LAS unsigned char* lds, const Gemm g, const Sched& S, const Epi& E) {
    const int tid = threadIdx.x, wid = __builtin_amdgcn_readfirstlane(tid >> 6), lane = tid & 63, wr = wid >> 2, wc = wid & 3, fr = lane & 15, fq = lane >> 4;
    const int K = g.K, nt = K / BK; const int LDA = g.lda ? g.lda : K;
    const int PB = KSPLIT ? (K >> 1) : K;
    static_assert(!GATHER || SP2, "gathered A rows: SP2 loop only");
    unsigned voffA[2], voffB[2];
#pragma unroll
    for (int i = 0; i < 2; ++i) { int R, C; stage_rc(tid * 16 + i * 8192, R, C); const int Rb = Epi::PERM ? ((R & ~31) + perm32(R & 31)) : R;
        voffA[i] = (unsigned)(R * LDA + C) * 2u; voffB[i] = (unsigned)(Rb * PB + C) * 2u; }
    const size_t kstep = (size_t)(BK * 2);
    const size_t hstep = (size_t)HALF * LDA * 2;
    const size_t tstep = 2 * hstep;
    const size_t hstepB = (size_t)HALF * PB * 2, tstepB = 2 * hstepB;
    const unsigned ldsw = (unsigned)wid * 1024u;
    const int aoff = lds_byte(wr * 64 + fr, fq * 8), boff = lds_byte(wc * 32 + fr, fq * 8);
#define PG8_SA(b, h) (((b) * 2 + (h)) * HTB)
#define PG8_SB(b, h) ((4 + (b) * 2 + (h)) * HTB)
#define PG8_STAGE(bufoff, gbase, voff) do { _Pragma("unroll") for (int _i = 0; _i < 2; ++_i) \
        __builtin_amdgcn_global_load_lds((const unsigned*)((const char*)(gbase) + (voff)[_i]), (PG8_LAS unsigned*)(lds + (bufoff) + ldsw + _i * 8192), 16, 0, 0); } while (0)
#define PG8_LDA(dst, b, h) do { _Pragma("unroll") for (int m = 0; m < 4; ++m) _Pragma("unroll") for (int k = 0; k < 2; ++k) dst[m][k] = *(const PG8_LAS bf16x8*)(lds + PG8_SA(b, h) + aoff + m * 2048 + k * 1024); } while (0)
#define PG8_LDB(dst, b, h) do { _Pragma("unroll") for (int n = 0; n < 2; ++n) _Pragma("unroll") for (int k = 0; k < 2; ++k) dst[n][k] = *(const PG8_LAS bf16x8*)(lds + PG8_SB(b, h) + boff + n * 2048 + k * 1024); } while (0)
#define PG8_MMA(ai, bj, At, Bt, FZ) do { __builtin_amdgcn_s_setprio(1); _Pragma("unroll") for (int m = 0; m < 4; ++m) _Pragma("unroll") for (int n = 0; n < 2; ++n) { \
        if constexpr (F8) { typedef int v4i_ __attribute__((ext_vector_type(4))); typedef int v8i_ __attribute__((ext_vector_type(8))); \
            const v8i_ w8_ = __builtin_shufflevector(__builtin_bit_cast(v4i_, Bt[n][0]), __builtin_bit_cast(v4i_, Bt[n][1]), 0, 1, 2, 3, 4, 5, 6, 7); \
            const v8i_ a8_ = __builtin_shufflevector(__builtin_bit_cast(v4i_, At[m][0]), __builtin_bit_cast(v4i_, At[m][1]), 0, 1, 2, 3, 4, 5, 6, 7); \
            if constexpr (F8ASM) { \
                if constexpr (FZ) { asm volatile("v_mfma_scale_f32_16x16x128_f8f6f4 %0, %1, %2, 0, %3, %4 op_sel_hi:[0,0,0]" : "+v"(acc[ai][bj][m][n]) : "v"(w8_), "v"(a8_), "v"(SCW), "v"(SCA)); }     \
                else { asm volatile("v_mfma_scale_f32_16x16x128_f8f6f4 %0, %1, %2, %0, %3, %4 op_sel_hi:[0,0,0]" : "+v"(acc[ai][bj][m][n]) : "v"(w8_), "v"(a8_), "v"(SCW), "v"(SCA)); } }     \
            else acc[ai][bj][m][n] = __builtin_amdgcn_mfma_scale_f32_16x16x128_f8f6f4(w8_, a8_, FZ ? (f32x4){0.f, 0.f, 0.f, 0.f} : acc[ai][bj][m][n], 0, 0, 0, SCW, 0, SCA); } \
        else if constexpr (!FZ) { _Pragma("unroll") for (int k = 0; k < 2; ++k) acc[ai][bj][m][n] = __builtin_amdgcn_mfma_f32_16x16x32_bf16(Bt[n][k], At[m][k], acc[ai][bj][m][n], 0, 0, 0); } } \
        if constexpr (FZ && !F8) {     \
            _Pragma("unroll") for (int m = 0; m < 4; ++m) _Pragma("unroll") for (int n = 0; n < 2; ++n) asm volatile("v_mfma_f32_16x16x32_bf16 %0, %1, %2, 0" : "+v"(acc[ai][bj][m][n]) : "v"(Bt[n][0]), "v"(At[m][0])); \
            _Pragma("unroll") for (int m = 0; m < 4; ++m) _Pragma("unroll") for (int n = 0; n < 2; ++n) acc[ai][bj][m][n] = __builtin_amdgcn_mfma_f32_16x16x32_bf16(Bt[n][1], At[m][1], acc[ai][bj][m][n], 0, 0, 0); } \
        __builtin_amdgcn_s_setprio(0); } while (0)
#define PG8_WAIT_V(n) asm volatile("s_waitcnt vmcnt(" #n ")" ::: "memory")
#define PG8_WAIT_L(n) asm volatile("s_waitcnt lgkmcnt(" #n ")" ::: "memory")
#define PG8_BAR __builtin_amdgcn_s_barrier()
#define PG8_SCHED __builtin_amdgcn_sched_barrier(0)
#define PG8_STG_A(b, h, ptr, arr) do { if constexpr (GATHER) { PG8_STAGE(PG8_SA(b, h), (ptr), (arr)[h]); } else { PG8_STAGE(PG8_SA(b, h), (ptr) + ((h) ? hstep : 0), voffA); } } while (0)
    unsigned cv[2][2] = {{0u, 0u}, {0u, 0u}}, nvp[2] = {0u, 0u};
#define PG8_GROWS(dst, unit) do { if constexpr (GATHER) { _Pragma("unroll") for (int _h = 0; _h < 2; ++_h) _Pragma("unroll") for (int _i = 0; _i < 2; ++_i) { int R_, C_; stage_rc(tid * 16 + _i * 8192, R_, C_); \
        dst[_h][_i] = (unsigned)S.arow(unit, _h * HALF + R_) * (unsigned)(K * 2) + (unsigned)(C_ * 2); } } } while (0)
    Unit cur, nxt; int ui = 0;
    if (!S.next(0, cur)) return;
    PG8_GROWS(cv, cur);
#define PG8_GROWS_P(unit) do { _Pragma("unroll") for (int _i = 0; _i < 2; ++_i) { int R_, C_; stage_rc(tid * 16 + _i * 8192, R_, C_); nvp[_i] = (unsigned)S.arow(unit, R_) | ((unsigned)S.arow(unit, HALF + R_) << 16); } } while (0)
#define PG8_UNPACK_NV() do { _Pragma("unroll") for (int _i = 0; _i < 2; ++_i) { int R_, C_; stage_rc(tid * 16 + _i * 8192, R_, C_); cv[0][_i] = (nvp[_i] & 0xffffu) * (unsigned)(K * 2) + (unsigned)(C_ * 2); cv[1][_i] = (nvp[_i] >> 16) * (unsigned)(K * 2) + (unsigned)(C_ * 2); } } while (0)
    f32x4 acc[2][2][4][2];
    if constexpr (!ZS) {
#pragma unroll
    for (int a = 0; a < 2; ++a)
#pragma unroll
        for (int b = 0; b < 2; ++b)
#pragma unroll
            for (int m = 0; m < 4; ++m)
#pragma unroll
                for (int n = 0; n < 2; ++n) acc[a][b][m][n] = (f32x4){0.f, 0.f, 0.f, 0.f}; }
    bf16x8 At[4][2], B0[2][2], B1[2][2];
    const char* cA = (const char*)g.A + (GATHER ? (size_t)0 : (size_t)cur.pm * tstep); const char* cB = (const char*)g.Bt + (size_t)cur.pn * tstepB; const char* cB2 = KSPLIT ? (const char*)g.Bt + (size_t)cur.pn2 * tstepB : cB;
    S.a_ready(cur);
    if constexpr (SP2) {
        PG8_STAGE(PG8_SB(0, 0), cB, voffB); PG8_STAGE(PG8_SB(0, 1), cB + hstepB, voffB); PG8_STG_A(0, 0, cA, cv); PG8_STG_A(0, 1, cA, cv);
        if (wr == 1) PG8_BAR;
        PG8_WAIT_V(2); PG8_BAR;
        PG8_STAGE(PG8_SB(1, 0), cB + kstep, voffB); PG8_STG_A(1, 0, cA + kstep, cv); PG8_STAGE(PG8_SB(1, 1), cB + hstepB + kstep, voffB);
        PG8_WAIT_V(6); PG8_BAR;
    } else {
        PG8_STAGE(PG8_SB(0, 0), cB, voffB); PG8_STAGE(PG8_SA(0, 0), cA, voffA); PG8_STAGE(PG8_SB(0, 1), cB + hstepB, voffB); PG8_STAGE(PG8_SA(0, 1), cA + hstep, voffA);
        if (wr == 1) PG8_BAR;
        PG8_WAIT_V(4); PG8_BAR;
        PG8_STAGE(PG8_SB(1, 0), cB + kstep, voffB); PG8_STAGE(PG8_SA(1, 0), cA + kstep, voffA); PG8_STAGE(PG8_SB(1, 1), cB + hstepB + kstep, voffB);
        PG8_WAIT_V(6); PG8_BAR;
    }
    for (;;) {
        const bool has_next = S.next(ui + 1, nxt);
        const char* nA = (has_next && !GATHER) ? (const char*)g.A + (size_t)nxt.pm * tstep : cA; const char* nB = has_next ? (const char*)g.Bt + (size_t)nxt.pn * tstepB : cB; const char* nB2 = (KSPLIT && has_next) ? (const char*)g.Bt + (size_t)nxt.pn2 * tstepB : cB2;
        if constexpr (GATHER) { if (has_next) { PG8_GROWS_P(nxt); } else { PG8_GROWS_P(cur); } }
        bool hfu = false; if constexpr (SchedHalf<Sched>::v) hfu = (cur.hf != 0);
        const int tspan = Epi::MIDHOOK ? (nt >> 1) : nt;
        if constexpr (ZS) { { const int t = 0;
            const bool last = (t == nt - 2);
            const char* a1 = cA + (size_t)(t + 1) * kstep;
            const char* a2 = last ? nA : cA + (size_t)(t + 2) * kstep; const char* b2 = last ? nB : ((KSPLIT && t + 2 >= (nt >> 1)) ? cB2 + (size_t)(t + 2 - (nt >> 1)) * kstep : cB + (size_t)(t + 2) * kstep);
            const char* a3 = a2 + kstep; const char* b3 = b2 + kstep;
            if (last && has_next) S.a_ready(nxt);
            if constexpr (SP2) {
            PG8_LDB(B0, 0, 0); PG8_LDB(B1, 0, 1); PG8_SCHED; PG8_LDA(At, 0, 0); PG8_STG_A(1, 1, a1, cv);
            if constexpr (GATHER) { if (last) { PG8_UNPACK_NV(); } }
            PG8_WAIT_V(8); PG8_WAIT_L(0); PG8_BAR; PG8_MMA(0, 0, At, B0, true); PG8_MMA(0, 1, At, B1, true); PG8_BAR; PG8_SCHED;
            if (!hfu) { PG8_LDA(At, 0, 1); } PG8_STAGE(PG8_SB(0, 0), b2, voffB); PG8_STAGE(PG8_SB(0, 1), b2 + hstepB, voffB); PG8_STG_A(0, 0, a2, cv);
            PG8_WAIT_V(8); PG8_WAIT_L(0); PG8_BAR; if (!hfu) { PG8_MMA(1, 0, At, B0, true); PG8_MMA(1, 1, At, B1, true); } PG8_BAR; PG8_SCHED;
            PG8_LDB(B0, 1, 0); PG8_LDB(B1, 1, 1); PG8_SCHED; PG8_LDA(At, 1, 0); PG8_STG_A(0, 1, a2, cv);
            PG8_WAIT_V(8); PG8_WAIT_L(0); PG8_BAR; PG8_MMA(0, 0, At, B0, false); PG8_MMA(0, 1, At, B1, false); PG8_BAR; PG8_SCHED;
            if (!hfu) { PG8_LDA(At, 1, 1); } PG8_STAGE(PG8_SB(1, 0), b3, voffB); PG8_STAGE(PG8_SB(1, 1), b3 + hstepB, voffB); PG8_STG_A(1, 0, a3, cv);
            PG8_WAIT_V(8); PG8_WAIT_L(0); PG8_BAR; if (!hfu) { PG8_MMA(1, 0, At, B0, false); PG8_MMA(1, 1, At, B1, false); } PG8_BAR; PG8_SCHED;
            } else {
            PG8_LDB(B0, 0, 0); PG8_SCHED; PG8_LDA(At, 0, 0); PG8_STAGE(PG8_SA(1, 1), a1 + hstep, voffA);
            PG8_WAIT_L(8); PG8_BAR; PG8_WAIT_L(0); PG8_MMA(0, 0, At, B0, true); PG8_BAR; PG8_SCHED;
            PG8_LDB(B1, 0, 1); PG8_STAGE(PG8_SB(0, 0), b2, voffB);
            PG8_BAR; PG8_WAIT_L(0); PG8_MMA(0, 1, At, B1, true); PG8_BAR;
            PG8_LDA(At, 0, 1); PG8_STAGE(PG8_SA(0, 0), a2, voffA);
            PG8_BAR; PG8_WAIT_L(0); PG8_MMA(1, 0, At, B0, true); PG8_BAR; PG8_SCHED;
            PG8_STAGE(PG8_SB(0, 1), b2 + hstepB, voffB);
            PG8_WAIT_V(6); PG8_BAR; PG8_MMA(1, 1, At, B1, true); PG8_BAR;
            PG8_LDB(B0, 1, 0); PG8_SCHED; PG8_LDA(At, 1, 0); PG8_STAGE(PG8_SA(0, 1), a2 + hstep, voffA);
            PG8_WAIT_L(8); PG8_BAR; PG8_WAIT_L(0); PG8_MMA(0, 0, At, B0, false); PG8_BAR; PG8_SCHED;
            PG8_LDB(B1, 1, 1); PG8_STAGE(PG8_SB(1, 0), b3, voffB);
            PG8_BAR; PG8_WAIT_L(0); PG8_MMA(0, 1, At, B1, false); PG8_BAR;
            PG8_LDA(At, 1, 1); PG8_STAGE(PG8_SA(1, 0), a3, voffA);
            PG8_BAR; PG8_WAIT_L(0); PG8_MMA(1, 0, At, B0, false); PG8_BAR; PG8_SCHED;
            PG8_STAGE(PG8_SB(1, 1), b3 + hstepB, voffB);
            PG8_WAIT_V(6); PG8_BAR; PG8_MMA(1, 1, At, B1, false); PG8_BAR;
            }
        } }
        for (int t0 = 0; t0 < nt; t0 += tspan) {
        if constexpr (Epi::MIDHOOK) { if (t0 != 0) E.mid(acc, cur, wr, wc, fr, fq); }
        for (int t = (ZS && t0 == 0) ? 2 : t0; t < t0 + tspan; t += 2) {
            const bool last = (t == nt - 2);
            const char* a1 = cA + (size_t)(t + 1) * kstep;
            const char* a2 = last ? nA : cA + (size_t)(t + 2) * kstep; const char* b2 = last ? nB : ((KSPLIT && t + 2 >= (nt >> 1)) ? cB2 + (size_t)(t + 2 - (nt >> 1)) * kstep : cB + (size_t)(t + 2) * kstep);
            const char* a3 = a2 + kstep; const char* b3 = b2 + kstep;
            if (last && has_next) S.a_ready(nxt);
            if constexpr (SP2) {
            PG8_LDB(B0, 0, 0); PG8_LDB(B1, 0, 1); PG8_SCHED; PG8_LDA(At, 0, 0); PG8_STG_A(1, 1, a1, cv);
            if constexpr (GATHER) { if (last) { PG8_UNPACK_NV(); } }
            PG8_WAIT_V(8); PG8_WAIT_L(0); PG8_BAR; PG8_MMA(0, 0, At, B0, false); PG8_MMA(0, 1, At, B1, false); PG8_BAR; PG8_SCHED;
            if (!hfu) { PG8_LDA(At, 0, 1); } PG8_STAGE(PG8_SB(0, 0), b2, voffB); PG8_STAGE(PG8_SB(0, 1), b2 + hstepB, voffB); PG8_STG_A(0, 0, a2, cv);
            PG8_WAIT_V(8); PG8_WAIT_L(0); PG8_BAR; if (!hfu) { PG8_MMA(1, 0, At, B0, false); PG8_MMA(1, 1, At, B1, false); } PG8_BAR; PG8_SCHED;
            PG8_LDB(B0, 1, 0); PG8_LDB(B1, 1, 1); PG8_SCHED; PG8_LDA(At, 1, 0); PG8_STG_A(0, 1, a2, cv);
            PG8_WAIT_V(8); PG8_WAIT_L(0); PG8_BAR; PG8_MMA(0, 0, At, B0, false); PG8_MMA(0, 1, At, B1, false); PG8_BAR; PG8_SCHED;
            if (!hfu) { PG8_LDA(At, 1, 1); } PG8_STAGE(PG8_SB(1, 0), b3, voffB); PG8_STAGE(PG8_SB(1, 1), b3 + hstepB, voffB); PG8_STG_A(1, 0, a3, cv);
            PG8_WAIT_V(8); PG8_WAIT_L(0); PG8_BAR; if (!hfu) { PG8_MMA(1, 0, At, B0, false); PG8_MMA(1, 1, At, B1, false); } PG8_BAR; PG8_SCHED;
            } else {
            PG8_LDB(B0, 0, 0); PG8_SCHED; PG8_LDA(At, 0, 0); PG8_STAGE(PG8_SA(1, 1), a1 + hstep, voffA);
            PG8_WAIT_L(8); PG8_BAR; PG8_WAIT_L(0); PG8_MMA(0, 0, At, B0, false); PG8_BAR; PG8_SCHED;
            PG8_LDB(B1, 0, 1); PG8_STAGE(PG8_SB(0, 0), b2, voffB);
            PG8_BAR; PG8_WAIT_L(0); PG8_MMA(0, 1, At, B1, false); PG8_BAR;
            PG8_LDA(At, 0, 1); PG8_STAGE(PG8_SA(0, 0), a2, voffA);
            PG8_BAR; PG8_WAIT_L(0); PG8_MMA(1, 0, At, B0, false); PG8_BAR; PG8_SCHED;
            PG8_STAGE(PG8_SB(0, 1), b2 + hstepB, voffB);
            PG8_WAIT_V(6); PG8_BAR; PG8_MMA(1, 1, At, B1, false); PG8_BAR;
            PG8_LDB(B0, 1, 0); PG8_SCHED; PG8_LDA(At, 1, 0); PG8_STAGE(PG8_SA(0, 1), a2 + hstep, voffA);
            PG8_WAIT_L(8); PG8_BAR; PG8_WAIT_L(0); PG8_MMA(0, 0, At, B0, false); PG8_BAR; PG8_SCHED;
            PG8_LDB(B1, 1, 1); PG8_STAGE(PG8_SB(1, 0), b3, voffB);
            PG8_BAR; PG8_WAIT_L(0); PG8_MMA(0, 1, At, B1, false); PG8_BAR;
            PG8_LDA(At, 1, 1); PG8_STAGE(PG8_SA(1, 0), a3, voffA);
            PG8_BAR; PG8_WAIT_L(0); PG8_MMA(1, 0, At, B0, false); PG8_BAR; PG8_SCHED;
            PG8_STAGE(PG8_SB(1, 1), b3 + hstepB, voffB);
            PG8_WAIT_V(6); PG8_BAR; PG8_MMA(1, 1, At, B1, false); PG8_BAR;
            }
        }
        }
        if constexpr (ALIGN_EPI) { if (wr == 0) PG8_BAR; }
        if constexpr (!Epi::AFTER_DRAIN) { int t2 = threadIdx.x; asm volatile("" : "+v"(t2));
            const int wid2 = __builtin_amdgcn_readfirstlane(t2 >> 6), lane2 = t2 & 63; E(acc, cur, wid2 >> 2, wid2 & 3, lane2 & 15, lane2 >> 4); S.done(cur); }
        if (!has_next) break;
        if constexpr (!ZS) {
#pragma unroll
        for (int a = 0; a < 2; ++a)
#pragma unroll
            for (int b = 0; b < 2; ++b)
#pragma unroll
                for (int m = 0; m < 4; ++m)
#pragma unroll
                    for (int n = 0; n < 2; ++n) acc[a][b][m][n] = (f32x4){0.f, 0.f, 0.f, 0.f}; }
        cur = nxt; cA = nA; cB = nB; cB2 = nB2; ++ui;
        if constexpr (ALIGN_EPI) { if (wr == 1) PG8_BAR; }
    }
    PG8_WAIT_V(0);
    if constexpr (!ALIGN_EPI) { if (wr == 0) PG8_BAR; }
    PG8_BAR;
    if constexpr (Epi::AFTER_DRAIN) { E.fused(acc, cur, wr, wc, fr, fq, lds, wid, lane); S.done(cur); }
#undef PG8_SA
#undef PG8_SB
#undef PG8_STAGE
#undef PG8_LDA
#undef PG8_LDB
#undef PG8_MMA
#undef PG8_WAIT_V
#undef PG8_WAIT_L
#undef PG8_BAR
#undef PG8_SCHED
#undef PG8_STG_A
#undef PG8_GROWS
#undef PG8_GROWS_P
#undef PG8_UNPACK_NV
}
}
constexpr int BATCH = 32, SEQ = 2048, D = 1024, T = BATCH * SEQ;
constexpr int NPROJ = 2048;
constexpr int CQ = 0, CKV = 256, CPE = 384, CMQ = 416, CMK = 928, CMV = 1440, NPROJ_REAL = 1952;
constexpr int NH = 8;
constexpr float EPS = 1e-6f;
constexpr float LOG2E = 1.4426950408889634f;
constexpr float C2A = 0.10206207261596575f * LOG2E;
constexpr float C2B = 0.125f * LOG2E;
constexpr int NCLS = 112;
constexpr int LIST_CAP = 65536;

constexpr size_t MiB = 1u << 20;
constexpr size_t WS_CTL = 0, CTL_ZERO_BYTES = 2 * MiB;
constexpr size_t WS_KMEAN = 1 * MiB;
constexpr size_t WS_WIN = 2 * MiB;
constexpr size_t WS_WQ = 6 * MiB;
constexpr size_t WS_WKV = 7 * MiB;
constexpr size_t WS_WO = 8 * MiB;
constexpr size_t WS_WGU = 10 * MiB;
constexpr size_t WS_WD = 42 * MiB;
constexpr size_t WS_ROPE = 58 * MiB;
constexpr size_t WS_WRE = 59 * MiB;
constexpr size_t WS_XRS = 62 * MiB;
constexpr size_t WS_O8 = 320 * MiB;
constexpr size_t WS_SSQ = 60 * MiB;
constexpr size_t WS_XN = 64 * MiB;
constexpr size_t WS_VB = 192 * MiB;
constexpr size_t WS_Y0 = 64 * MiB;
constexpr size_t WS_X1B = 768 * MiB;
constexpr size_t WS_YH = 256 * MiB;
constexpr size_t WS_QB = 448 * MiB;
constexpr size_t WS_KB = 512 * MiB;
constexpr size_t WS_QA = 584 * MiB;
constexpr size_t WS_VA = 680 * MiB;
constexpr size_t WS_KA = 808 * MiB;
constexpr size_t WS_QLN = 904 * MiB;
constexpr size_t WS_KVLN = 936 * MiB;
constexpr size_t WS_LISTS = 648 * MiB;
constexpr size_t WS_OSSQ = 904 * MiB;
constexpr size_t WS_END = 1024 * MiB;
constexpr size_t WS_H = WS_KB;
constexpr int CW_TMO = 0, CW_CODE = 1;
constexpr int CW_BAR = 4096;
constexpr int CW_GCNT = 16384;

constexpr int RING_BYTES = 131072;
constexpr int P8_XT = 0, P8_XT_WAVE = 32 * 68 * 4, P8_WC = 69632, P8_WCB = 13824, P8_WRG = 97280, P8_RT = 113664;
constexpr int LDSCTL_OFF = 155648, LDS_BYTES = 159744;
static_assert(true, "ClsOrder: cnt, ptab, tpf, tph at tp + 512, 1024, 1280, 1792 bytes");
constexpr int TP_OFF = LDSCTL_OFF + 256, CNT_OFF = LDSCTL_OFF + 768, PT_OFF = LDSCTL_OFF + 1280, TPF_OFF = LDSCTL_OFF + 1536, TPH_OFF = LDSCTL_OFF + 2048;

#define GAS __attribute__((address_space(1)))
#define LAS __attribute__((address_space(3)))
typedef unsigned short bf16;
typedef unsigned v4u __attribute__((ext_vector_type(4)));
typedef unsigned v2u __attribute__((ext_vector_type(2)));
typedef float f32x4 __attribute__((ext_vector_type(4)));
typedef float f32x2 __attribute__((ext_vector_type(2)));
typedef float f32x16 __attribute__((ext_vector_type(16)));
typedef short bf16x8 __attribute__((ext_vector_type(8)));
typedef short s16x4 __attribute__((ext_vector_type(4)));
typedef GAS unsigned gu32;
#define RLX_AGENT __ATOMIC_RELAXED, __HIP_MEMORY_SCOPE_AGENT
__device__ __forceinline__ unsigned f2bf(float f) { unsigned u = __builtin_bit_cast(unsigned, f); return (u + 0x7fffu + ((u >> 16) & 1u)) >> 16; }
__device__ __forceinline__ unsigned pk2(float lo, float hi) { return f2bf(lo) | (f2bf(hi) << 16); }
__device__ __forceinline__ float bflo(unsigned w) { return __builtin_bit_cast(float, w << 16); }
__device__ __forceinline__ float bfhi(unsigned w) { return __builtin_bit_cast(float, w & 0xffff0000u); }
__device__ __forceinline__ float wave_sum(float v) {
#pragma unroll
    for (int o = 1; o < 64; o <<= 1) v += __shfl_xor(v, o);
    return v;
}
__device__ __forceinline__ float sum8(float v) { v += __shfl_xor(v, 1); v += __shfl_xor(v, 2); v += __shfl_xor(v, 4); return v; }

#define XB_TMO      128
#define XB_XCNT(j)  (256  + 64 * (j))
#define XB_XSUB(j)  (1280 + 64 * (j))
#define XB_XGEN(j)  (2304 + 64 * (j))
#define XB_TOP      3328
#define XB_TOPGEN   3392
#define XCD_BAR_WORDS 3456
#define XB_SPIN_CAP (1u << 18)

__device__ __forceinline__ unsigned xb_ld(unsigned* p)              { return __hip_atomic_load(p, __ATOMIC_RELAXED, __HIP_MEMORY_SCOPE_AGENT); }
__device__ __forceinline__ unsigned xb_add(unsigned* p, unsigned v) { return __hip_atomic_fetch_add(p, v, __ATOMIC_RELAXED, __HIP_MEMORY_SCOPE_AGENT); }
__device__ __forceinline__ unsigned xb_xcc_id() { return (unsigned)__builtin_amdgcn_s_getreg((3 << 11) | 20) & 0xFu; }
#define XB_SPIN(cond, bar) do { unsigned _sp = 0; while (cond) { __builtin_amdgcn_s_sleep(1); \
    if ((++_sp & 255u) == 0u) { if (xb_ld(&(bar)[XB_TMO])) break; if (_sp > XB_SPIN_CAP) { atomicAdd(&(bar)[XB_TMO], 1u); break; } } } } while (0)

struct XcdBarrier {
    unsigned* bar; unsigned x;
    volatile LAS unsigned* st;
};

__device__ __forceinline__ XcdBarrier xcd_barrier_post(unsigned* bar, volatile LAS unsigned* st) {
    XcdBarrier b; b.bar = bar; b.x = xb_xcc_id(); b.st = st;
    if (threadIdx.x == 0) (void)xb_add(&bar[XB_XCNT(b.x)], 1u);
    return b;
}
__device__ __forceinline__ void xcd_barrier_complete(unsigned* bar, unsigned x, unsigned& nloc, unsigned& nx) {
    const unsigned G = gridDim.x * gridDim.y * gridDim.z;
    unsigned sum, cnt, mine, sp = 0u;
    for (;;) {
        sum = 0u; cnt = 0u; mine = 0u;
#pragma unroll
        for (unsigned j = 0; j < 16; ++j) { const unsigned c = xb_ld(&bar[XB_XCNT(j)]); sum += c; cnt += (c > 0u) ? 1u : 0u; mine = (j == x) ? c : mine; }
        if (sum == G) break;
        __builtin_amdgcn_s_sleep(1);
        if ((++sp & 255u) == 0u) { if (xb_ld(&bar[XB_TMO])) break; if (sp > XB_SPIN_CAP) { atomicAdd(&bar[XB_TMO], 1u); break; } }
    }
    nloc = mine > 0u ? mine : 1u; nx = cnt > 0u ? cnt : 1u;
}

__device__ __forceinline__ void xcd_barrier(const XcdBarrier& b) {
    asm volatile("s_waitcnt vmcnt(0)" ::: "memory");
    __syncthreads();
    if (threadIdx.x == 0) {
        unsigned* bar = b.bar;
        __builtin_amdgcn_s_waitcnt(0);
        unsigned nloc = b.st[0], nx = b.st[1];
        if (nloc == 0u) { xcd_barrier_complete(bar, b.x, nloc, nx); b.st[0] = nloc; b.st[1] = nx; }
        const unsigned old = xb_add(&bar[XB_XSUB(b.x)], 1u);
        const unsigned gen = old / nloc;
        if (old + 1u == (gen + 1u) * nloc) {
            __builtin_amdgcn_fence(__ATOMIC_RELEASE, "agent");
            asm volatile("s_waitcnt vmcnt(0)" ::: "memory");
            const unsigned og = xb_add(&bar[XB_TOP], 1u);
            const unsigned tg = og / nx;
            if (og + 1u == (tg + 1u) * nx) xb_add(&bar[XB_TOPGEN], 1u);
            else XB_SPIN(xb_ld(&bar[XB_TOPGEN]) == tg, bar);
            __builtin_amdgcn_fence(__ATOMIC_ACQUIRE, "agent");
            xb_add(&bar[XB_XGEN(b.x)], 1u);
            asm volatile("s_waitcnt vmcnt(0)" ::: "memory");
        } else {
            XB_SPIN(xb_ld(&bar[XB_XGEN(b.x)]) == gen, bar);
            __builtin_amdgcn_fence(__ATOMIC_ACQUIRE, "agent");
            asm volatile("s_waitcnt vmcnt(0)" ::: "memory");
        }
    }
    __syncthreads();
}


__device__ __forceinline__ float att_max3(float a, float b, float c) { float r; asm("v_max3_f32 %0, %1, %2, %3" : "=v"(r) : "v"(a), "v"(b), "v"(c)); return r; }
__device__ __forceinline__ unsigned pk4_fp8(float a, float b, float c, float d) { int w = 0; w = __builtin_amdgcn_cvt_pk_fp8_f32(a, b, w, false); w = __builtin_amdgcn_cvt_pk_fp8_f32(c, d, w, true); return (unsigned)w; }
struct AttOwn { static constexpr bool v = true; }; struct AttPast { static constexpr bool v = false; };
template <int DQK, bool MOBA, bool QFIN, bool FIXREF>
__device__ __forceinline__ void attn_unit(LAS unsigned char* lds, const float* qgain_, const float* ropeR_, const bf16* Qg_, int qpitch, const bf16* Kg_, int kpitch, const bf16* Vg_, int vpitch, bf16* Og_, int opitch, float* ossq_, int qb, const float* kmp_, int kmstride, float bref) {
    const GAS bf16* Qg = (const GAS bf16*)Qg_; const GAS bf16* Kg = (const GAS bf16*)Kg_; const GAS bf16* Vg = (const GAS bf16*)Vg_; GAS bf16* Og = (GAS bf16*)Og_; const GAS float* kmp = (const GAS float*)kmp_;
    constexpr int ND = DQK / 16, KSTR = DQK * 2 + 16, KBUF = 64 * KSTR, NCH = DQK / 8, VBUF = 8192;
    int tid = threadIdx.x; asm volatile("" : "+v"(tid));
    const int lane = tid & 63, r32 = lane & 31, hi = lane >> 5; const int wid = __builtin_amdgcn_readfirstlane(tid >> 6);
    LAS unsigned char* Kl = lds; LAS unsigned char* Vl = lds + 2 * KBUF;
    const GAS bf16* qrow = Qg + (size_t)(qb * 256 + wid * 32 + r32) * qpitch;
    bf16x8 qf[ND];
#pragma unroll
    for (int d0 = 0; d0 < ND; ++d0) qf[d0] = *(const GAS bf16x8*)(qrow + 16 * d0 + 8 * hi);
    const int krow = (DQK == 64) ? (tid >> 3) : (tid / 12), kch = (DQK == 64) ? (tid & 7) : (tid % 12);
    const int krow2 = (tid + 512) / 12, kch2 = (tid + 512) % 12; const bool k2 = (DQK == 96) && (tid < 256);
    const int vrow = tid >> 3, vch = tid & 7;
    const unsigned kst = (unsigned)(krow * KSTR + kch * 16), kst2 = (unsigned)(krow2 * KSTR + kch2 * 16);
    const unsigned vst = (unsigned)((vch >> 2) * 4096 + (vrow >> 4) * 1024 + ((vrow >> 3) & 1) * 512 + (vrow & 7) * 64 + (vch & 3) * 16);
    const int NT = 4 * (qb + 1);
    auto tile_row0 = [&](int p) -> int { return (p < 4) ? (qb * 256 + p * 64) : ((p - 4) * 64); };
    v4u kreg, kreg2 = {0u, 0u, 0u, 0u}, vreg;
    { const int r0 = tile_row0(0);
      kreg = *(const GAS v4u*)(Kg + (size_t)(r0 + krow) * kpitch + kch * 8); if (k2) kreg2 = *(const GAS v4u*)(Kg + (size_t)(r0 + krow2) * kpitch + kch2 * 8);
      vreg = *(const GAS v4u*)(Vg + (size_t)(r0 + vrow) * vpitch + vch * 8); }
    if (QFIN) {
        const GAS float* qg = (const GAS float*)qgain_; const GAS float* rr = (const GAS float*)ropeR_; const int pos = qb * 256 + wid * 32 + r32;
        float x[ND][8]; float ss = 0.f;
#pragma unroll
        for (int d0 = 0; d0 < ND; ++d0) { const v4u w = __builtin_bit_cast(v4u, qf[d0]);
            x[d0][0] = bflo(w.x); x[d0][1] = bfhi(w.x); x[d0][2] = bflo(w.y); x[d0][3] = bfhi(w.y); x[d0][4] = bflo(w.z); x[d0][5] = bfhi(w.z); x[d0][6] = bflo(w.w); x[d0][7] = bfhi(w.w);
#pragma unroll
            for (int j = 0; j < 8; ++j) ss += x[d0][j] * x[d0][j]; }
        ss += __shfl_xor(ss, 32);
        const float rs = __builtin_amdgcn_rsqf(ss * (1.0f / (float)DQK) + EPS) * C2A;
#pragma unroll
        for (int d0 = 0; d0 < ND; ++d0) { const f32x4 ga = *(const GAS f32x4*)(qg + 16 * d0 + 8 * hi), gb = *(const GAS f32x4*)(qg + 16 * d0 + 8 * hi + 4);
#pragma unroll
            for (int j = 0; j < 4; ++j) { x[d0][j] *= rs * ga[j]; x[d0][4 + j] *= rs * gb[j]; } }
        if (ND == 6) { const f32x4 ca = *(const GAS f32x4*)(rr + pos * 16 + 8 * hi), cb = *(const GAS f32x4*)(rr + pos * 16 + 8 * hi + 4), sa = *(const GAS f32x4*)(rr + SEQ * 16 + pos * 16 + 8 * hi), sb = *(const GAS f32x4*)(rr + SEQ * 16 + pos * 16 + 8 * hi + 4);
#pragma unroll
            for (int j = 0; j < 8; ++j) { const float c = j < 4 ? ca[j & 3] : cb[j & 3], s = j < 4 ? sa[j & 3] : sb[j & 3]; const float y1 = x[ND - 2][j], y2 = x[ND - 1][j]; x[ND - 2][j] = y1 * c - y2 * s; x[ND - 1][j] = y2 * c + y1 * s; } }
#pragma unroll
        for (int d0 = 0; d0 < ND; ++d0) { v4u w; w.x = pg8::cvt_pk_bf16(x[d0][0], x[d0][1]); w.y = pg8::cvt_pk_bf16(x[d0][2], x[d0][3]); w.z = pg8::cvt_pk_bf16(x[d0][4], x[d0][5]); w.w = pg8::cvt_pk_bf16(x[d0][6], x[d0][7]); qf[d0] = __builtin_bit_cast(bf16x8, w); }
    }
    unsigned sel = 0xffu;
    LAS float* kml = (LAS float*)(lds + 110592);
    if (MOBA && qb > 3) kml[tid] = kmp[(size_t)(tid >> 6) * kmstride + (tid & 63)];
    *(LAS v4u*)(Kl + kst) = kreg; if (k2) *(LAS v4u*)(Kl + kst2) = kreg2; *(LAS v4u*)(Vl + vst) = vreg;
    __syncthreads();
    if (MOBA && qb > 3) {
        float gate[8];
#pragma unroll
        for (int n = 0; n < 8; ++n) { float a = 0.f;
            if (n < qb) {
#pragma unroll
                for (int d0 = 0; d0 < ND; ++d0) { const LAS float* km = kml + n * 64 + 16 * d0 + 8 * hi; const f32x4 k0 = *(const LAS f32x4*)km, k1 = *(const LAS f32x4*)(km + 4);
                    const v4u qq = __builtin_bit_cast(v4u, qf[d0]);
                    a += bflo(qq.x) * k0[0] + bfhi(qq.x) * k0[1] + bflo(qq.y) * k0[2] + bfhi(qq.y) * k0[3] + bflo(qq.z) * k1[0] + bfhi(qq.z) * k1[1] + bflo(qq.w) * k1[2] + bfhi(qq.w) * k1[3]; }
                a += __shfl_xor(a, 32); }
            gate[n] = a; asm volatile("" : "+v"(a) :: "memory"); }
        sel = 0u;
#pragma unroll
        for (int n = 0; n < 8; ++n) { int rank = 0;
#pragma unroll
            for (int mm = 0; mm < 8; ++mm) { if (mm != n) { const bool before = (gate[mm] > gate[n]) || (gate[mm] == gate[n] && mm < n); rank += (mm < qb && before) ? 1 : 0; } }
            if (n < qb && rank < 3) sel |= (1u << n); }
    }
    float m_run = 0.f, l_run = 0.f; f32x16 o0 = {}, o1 = {};
    f32x16 cuse = {}; bool cdirty = true;
    f32x16 negm = {};
    if constexpr (FIXREF) {
#pragma unroll
        for (int r = 0; r < 16; ++r) negm[r] = -bref; }
    constexpr float THR = 8.0f;
    const int qrel = wid * 32 + r32;
    const unsigned kfo = (unsigned)(r32 * KSTR + hi * 16);
    const unsigned vfo = (unsigned)(((lane >> 4) & 1) * 32 + (lane & 3) * 8 + (4 * hi + ((lane & 15) >> 2)) * 64);
    auto slot = [&](const int p, auto own_) { constexpr bool OWN = decltype(own_)::v;
        const int cb = p & 1;
        if (p + 1 < NT) { const int r0 = tile_row0(p + 1);
            kreg = *(const GAS v4u*)(Kg + (size_t)(r0 + krow) * kpitch + kch * 8); if (k2) kreg2 = *(const GAS v4u*)(Kg + (size_t)(r0 + krow2) * kpitch + kch2 * 8);
            vreg = *(const GAS v4u*)(Vg + (size_t)(r0 + vrow) * vpitch + vch * 8); }
        const bool need = OWN ? !(p > (wid >> 1)) : true;
        if (need) {
            const LAS unsigned char* Kb = Kl + cb * KBUF + kfo; const LAS unsigned char* Vb = Vl + cb * VBUF + vfo;
            f32x16 s0 = negm, s1 = negm;
            if constexpr (!OWN && MOBA) {
                if (cdirty || (p & 3) == 0) { const bool on = ((sel >> ((p - 4) >> 2)) & 1u) != 0u;
#pragma unroll
                    for (int r = 0; r < 16; ++r) cuse[r] = on ? negm[r] : -1.0e30f;
                    cdirty = false; }
                s0 = cuse; s1 = cuse; }
            bf16x8 kf[2 * ND];
#pragma unroll
            for (int d0 = 0; d0 < ND; ++d0) { kf[2 * d0] = *(const LAS bf16x8*)(Kb + d0 * 32); kf[2 * d0 + 1] = *(const LAS bf16x8*)(Kb + 32 * KSTR + d0 * 32); }
            __builtin_amdgcn_sched_barrier(0);
#pragma unroll
            for (int d0 = 0; d0 < ND; ++d0) { s0 = __builtin_amdgcn_mfma_f32_32x32x16_bf16(kf[2 * d0], qf[d0], s0, 0, 0, 0); s1 = __builtin_amdgcn_mfma_f32_32x32x16_bf16(kf[2 * d0 + 1], qf[d0], s1, 0, 0, 0); }
            s16x4 vt[16];
#pragma unroll
            for (int v = 0; v < 16; ++v) vt[v] = __builtin_bit_cast(s16x4, __builtin_amdgcn_ds_read_tr16_b64_v4i16((LAS s16x4*)(Vb + (v >> 2) * 1024 + ((v >> 1) & 1) * 4096 + (v & 1) * 512)));
            __builtin_amdgcn_sched_barrier(0);
            if (OWN && p == (wid >> 1)) { const int kb = 64 * p + 4 * hi;
#pragma unroll
                for (int r = 0; r < 16; ++r) { const int kv = kb + (r & 3) + 8 * (r >> 2); if (kv > qrel) s0[r] = -INFINITY; if (kv + 32 > qrel) s1[r] = -INFINITY; } }
            if constexpr (!FIXREF) {
            float ra = att_max3(s0[0], s0[1], s1[0]), rb = att_max3(s0[2], s0[3], s1[1]); ra = att_max3(ra, s1[2], s1[3]);
#pragma unroll
            for (int r = 4; r < 16; r += 4) { ra = att_max3(ra, s0[r], s0[r + 1]); rb = att_max3(rb, s0[r + 2], s0[r + 3]); ra = att_max3(ra, s1[r], s1[r + 1]); rb = att_max3(rb, s1[r + 2], s1[r + 3]); }
            float rm = fmaxf(ra, rb); rm = fmaxf(rm, __shfl_xor(rm, 32));
            if ((OWN && p == 0) || __any(rm > THR)) {
                const float dl = (OWN && p == 0) ? rm : fmaxf(rm, 0.f); m_run += dl;
                const float fsc = __builtin_amdgcn_exp2f(-dl); l_run *= fsc;
#pragma unroll
                for (int r = 0; r < 16; ++r) { s0[r] -= dl; s1[r] -= dl; o0[r] *= fsc; o1[r] *= fsc; negm[r] = -m_run; }
                cdirty = true;
            }
            }
            if constexpr (FIXREF) {
#pragma unroll
                for (int r = 0; r < 16; ++r) { s0[r] = __builtin_amdgcn_exp2f(s0[r]); s1[r] = __builtin_amdgcn_exp2f(s1[r]); }
                f32x2 ra = {0.f, 0.f}, rb = {0.f, 0.f};
#pragma unroll
                for (int r = 0; r < 16; r += 2) { ra += (f32x2){s0[r], s0[r + 1]}; rb += (f32x2){s1[r], s1[r + 1]}; }
                ra += rb; l_run += ra[0] + ra[1];
            } else {
            float rs0 = 0.f, rs1 = 0.f;
#pragma unroll
            for (int r = 0; r < 16; ++r) { s0[r] = __builtin_amdgcn_exp2f(s0[r]); s1[r] = __builtin_amdgcn_exp2f(s1[r]); rs0 += s0[r]; rs1 += s1[r]; }
            l_run += rs0 + rs1; }
            bf16x8 pf[4];
#pragma unroll
            for (int s = 0; s < 2; ++s) { v4u a, b;
                a.x = pg8::cvt_pk_bf16(s0[8 * s + 0], s0[8 * s + 1]); a.y = pg8::cvt_pk_bf16(s0[8 * s + 2], s0[8 * s + 3]); a.z = pg8::cvt_pk_bf16(s0[8 * s + 4], s0[8 * s + 5]); a.w = pg8::cvt_pk_bf16(s0[8 * s + 6], s0[8 * s + 7]);
                b.x = pg8::cvt_pk_bf16(s1[8 * s + 0], s1[8 * s + 1]); b.y = pg8::cvt_pk_bf16(s1[8 * s + 2], s1[8 * s + 3]); b.z = pg8::cvt_pk_bf16(s1[8 * s + 4], s1[8 * s + 5]); b.w = pg8::cvt_pk_bf16(s1[8 * s + 6], s1[8 * s + 7]);
                pf[s] = __builtin_bit_cast(bf16x8, a); pf[2 + s] = __builtin_bit_cast(bf16x8, b); }
#pragma unroll
            for (int s = 0; s < 4; ++s) {
                const bf16x8 va = (bf16x8){vt[4 * s][0], vt[4 * s][1], vt[4 * s][2], vt[4 * s][3], vt[4 * s + 1][0], vt[4 * s + 1][1], vt[4 * s + 1][2], vt[4 * s + 1][3]};
                const bf16x8 vb = (bf16x8){vt[4 * s + 2][0], vt[4 * s + 2][1], vt[4 * s + 2][2], vt[4 * s + 2][3], vt[4 * s + 3][0], vt[4 * s + 3][1], vt[4 * s + 3][2], vt[4 * s + 3][3]};
                o0 = __builtin_amdgcn_mfma_f32_32x32x16_bf16(va, pf[s], o0, 0, 0, 0);
                o1 = __builtin_amdgcn_mfma_f32_32x32x16_bf16(vb, pf[s], o1, 0, 0, 0); }
        }
        if (p + 1 < NT) { const int nb = cb ^ 1;
            *(LAS v4u*)(Kl + nb * KBUF + kst) = kreg; if (k2) *(LAS v4u*)(Kl + nb * KBUF + kst2) = kreg2; *(LAS v4u*)(Vl + nb * VBUF + vst) = vreg; }
        __syncthreads();
        __syncthreads();
    };
    for (int p = 0; p < 4; ++p) slot(p, AttOwn{});
    for (int p = 4; p < NT; ++p) slot(p, AttPast{});
    l_run += __shfl_xor(l_run, 32);
    const float rl = 1.0f / l_run;
    { float ss = 0.f;
#pragma unroll
      for (int r = 0; r < 16; ++r) { const float a = o0[r] * rl, b = o1[r] * rl; ss += a * a + b * b; }
      ss += __shfl_xor(ss, 32);
      if (hi == 0) ((GAS float*)ossq_)[(size_t)(qb * 256 + wid * 32 + r32) * 16] = ss; }
    LAS unsigned char* stg = lds + 65536 + wid * 4608; const float rl16 = rl * 16.0f;
#pragma unroll
    for (int g = 0; g < 4; ++g) {
        *(LAS unsigned*)(stg + r32 * 80 + (8 * g + 4 * hi)) = pk4_fp8(o0[4 * g] * rl16, o0[4 * g + 1] * rl16, o0[4 * g + 2] * rl16, o0[4 * g + 3] * rl16);
        *(LAS unsigned*)(stg + r32 * 80 + (32 + 8 * g + 4 * hi)) = pk4_fp8(o1[4 * g] * rl16, o1[4 * g + 1] * rl16, o1[4 * g + 2] * rl16, o1[4 * g + 3] * rl16); }
    asm volatile("s_waitcnt lgkmcnt(0)" ::: "memory");
    GAS unsigned char* obase = (GAS unsigned char*)Og + (size_t)(qb * 256 + wid * 32) * opitch;
#pragma unroll
    for (int i = 0; i < 2; ++i) { const int row = i * 16 + (lane >> 2), ch = lane & 3; const v4u v = *(const LAS v4u*)(stg + row * 80 + ch * 16); *(GAS v4u*)(obase + (size_t)row * opitch + ch * 16) = v; }
    asm volatile("s_waitcnt lgkmcnt(0)" ::: "memory");
}

__device__ __forceinline__ void transpose_item(const float* W_, int ldw, bf16* WT, int ldt, int k0, int n0, int dr0, int dr1, LAS float* scr, int lane, const float* kgain = nullptr) {
    const GAS float* W = (const GAS float*)W_; const int q = lane & 15, kr = lane >> 4; const bool ld_ok = (q < 8) ? (dr0 >= 0) : (dr1 >= 0);
#pragma unroll 4
    for (int i = 0; i < 16; ++i) { const int kk = 4 * i + kr; f32x4 v = {0.f, 0.f, 0.f, 0.f}; if (ld_ok) v = __builtin_nontemporal_load((const GAS f32x4*)(W + (size_t)(k0 + kk) * ldw + n0 + 4 * q));
        if (kgain) v = v * ((const GAS float*)kgain)[k0 + kk];
        LAS float* s = scr + kk * 65 + 4 * q; s[0] = v[0]; s[1] = v[1]; s[2] = v[2]; s[3] = v[3]; }
    asm volatile("s_waitcnt lgkmcnt(0)" ::: "memory");
    const int c = lane & 7;
#pragma unroll
    for (int j = 0; j < 8; ++j) { const int n = 8 * j + (lane >> 3); const LAS float* s = scr + (8 * c) * 65 + n; const int dr = (n < 32) ? dr0 : dr1;
        v4u o; o.x = pk2(s[0 * 65], s[1 * 65]); o.y = pk2(s[2 * 65], s[3 * 65]); o.z = pk2(s[4 * 65], s[5 * 65]); o.w = pk2(s[6 * 65], s[7 * 65]);
        if (dr >= 0) *(GAS v4u*)(WT + (size_t)(dr + (n & 31)) * ldt + k0 + 8 * c) = o; }
    asm volatile("s_waitcnt lgkmcnt(0)" ::: "memory");
}

__device__ __forceinline__ void transpose_item8(const float* W_, int ldw, unsigned char* WT8, int ldt, int k0, int n0, int dr0, int dr1, LAS float* scr, int lane, float scale, const float* kgain = nullptr) {
    const GAS float* W = (const GAS float*)W_; const int q = lane & 15, kr = lane >> 4; const bool ld_ok = (q < 8) ? (dr0 >= 0) : (dr1 >= 0);
#pragma unroll 4
    for (int i = 0; i < 16; ++i) { const int kk = 4 * i + kr; f32x4 v = {0.f, 0.f, 0.f, 0.f}; if (ld_ok) v = __builtin_nontemporal_load((const GAS f32x4*)(W + (size_t)(k0 + kk) * ldw + n0 + 4 * q));
        if (kgain) v = v * ((const GAS float*)kgain)[k0 + kk];
        v = v * scale;
        LAS float* s = scr + kk * 65 + 4 * q; s[0] = v[0]; s[1] = v[1]; s[2] = v[2]; s[3] = v[3]; }
    asm volatile("s_waitcnt lgkmcnt(0)" ::: "memory");
    const int c = lane & 7;
#pragma unroll
    for (int j = 0; j < 8; ++j) { const int n = 8 * j + (lane >> 3); const LAS float* s = scr + (8 * c) * 65 + n; const int dr = (n < 32) ? dr0 : dr1;
        v2u o; o.x = pk4_fp8(s[0 * 65], s[1 * 65], s[2 * 65], s[3 * 65]); o.y = pk4_fp8(s[4 * 65], s[5 * 65], s[6 * 65], s[7 * 65]);
        if (dr >= 0) *(GAS v2u*)((GAS unsigned char*)WT8 + (size_t)(dr + (n & 31)) * ldt + k0 + 8 * c) = o; }
    asm volatile("s_waitcnt lgkmcnt(0)" ::: "memory");
}

struct Args {
    const float* x; const float* attn_g; const float* w_in; const float* qlat_g; const float* w_qup; const float* kvlat_g; const float* w_kvup;
    const float* qhead_g; const float* khead_g; const float* mqhead_g; const float* mkhead_g; const float* onorm_a_g; const float* onorm_b_g; const float* w_out;
    const float* ffn_g; const float* w_rg; const float* b_rg; const float* w_re; const float* b_re; const float* w_gate; const float* w_up; const float* w_down;
    float* out; unsigned char* ws; int ph_lo, ph_hi;
};
enum { PH_PRO = 0, PH_PROJ, PH_UP, PH_ATTN, PH_OUT, PH_ROUTE, PH_GU, PH_D0, NPHASE };

__global__ void __launch_bounds__(512, 2) mk_fwd(Args A) {
    extern __shared__ __attribute__((aligned(16))) unsigned char lds_raw[];
    LAS unsigned char* lds = (LAS unsigned char*)lds_raw;
    const int tid0 = threadIdx.x;
    const int G = gridDim.x, bx = blockIdx.x;
#define NGW (G * 8)
#define PH_BEGIN int tid = threadIdx.x; asm volatile("" : "+v"(tid)); const int lane = tid & 63; const int wave = __builtin_amdgcn_readfirstlane(tid >> 6); const int gw = bx * 8 + wave; \
    const __attribute__((address_space(4))) Args* AP = (const __attribute__((address_space(4))) Args*)__builtin_amdgcn_kernarg_segment_ptr(); asm volatile("" : "+s"(AP)); \
    unsigned char* ws = AP->ws; (void)lane; (void)gw; (void)ws;
#define Win_t ((bf16*)(ws + WS_WIN))
#define Wq_t ((bf16*)(ws + WS_WQ))
#define Wkv_t ((bf16*)(ws + WS_WKV))
#define Wo_t ((bf16*)(ws + WS_WO))
#define Wgu_t ((bf16*)(ws + WS_WGU))
#define Wd_t ((bf16*)(ws + WS_WD))
#define ropeF ((float*)(ws + WS_ROPE))
#define ropeR (((float*)(ws + WS_ROPE)) + 2 * SEQ * 32)
#define kmean ((float*)(ws + WS_KMEAN))
#define XN ((bf16*)(ws + WS_XN))
#define X1B ((bf16*)(ws + WS_X1B))
#define VB ((bf16*)(ws + WS_VB))
#define YH ((bf16*)(ws + WS_YH))
#define Y0B ((bf16*)(ws + WS_Y0))
#define SSQ ((float*)(ws + WS_SSQ))
#define XRS ((float*)(ws + WS_XRS))
#define O8 ((bf16*)(ws + WS_O8))
#define WREF ((float*)(ws + WS_WRE))
#define WRGF ((float*)(ws + WS_WRE + 131072))
#define OSSQ ((float*)(ws + WS_OSSQ))
#define QB ((bf16*)(ws + WS_QB))
#define KB ((bf16*)(ws + WS_KB))
#define QA ((bf16*)(ws + WS_QA))
#define VA ((bf16*)(ws + WS_VA))
#define KA ((bf16*)(ws + WS_KA))
#define QLN ((bf16*)(ws + WS_QLN))
#define KVLN ((bf16*)(ws + WS_KVLN))
#define HB ((bf16*)(ws + WS_H))
#define lists ((pg8::ListEnt*)(ws + WS_LISTS))
    volatile LAS unsigned* MISC = (volatile LAS unsigned*)(lds + LDSCTL_OFF);
    for (int u = tid0; u < (LDS_BYTES - LDSCTL_OFF) / 4; u += 512) ((LAS unsigned*)(lds + LDSCTL_OFF))[u] = 0u;
    __syncthreads();
    XcdBarrier bar = xcd_barrier_post((unsigned*)((gu32*)(A.ws + WS_CTL) + CW_BAR), MISC + 8);
    const int lo = A.ph_lo, hi = A.ph_hi;
#define IN(k) (lo <= (k) && (k) < hi)
#define MOE_SLOT(npn) ((G == 256) ? ((((bx >> 3) / (npn)) * 8 + (bx & 7)) * (npn) + ((bx >> 3) % (npn))) : bx)
#define SEAM(k) do { if (IN(k) && IN((k) + 1)) xcd_barrier(bar); } while (0)

#define LATE_ITEMS \
        { LAS float* scr = (LAS float*)(lds + wave * 16640); constexpr int I_WO = 16 * 16, I_G = 32 * 64, I_U = 32 * 64, I_D = 32 * 64; \
          for (int it = gw; it < I_WO + I_G + I_U + I_D; it += NGW) { int r = it; \
            if (r < I_WO) { const int kb = r / 16, nb = r % 16; transpose_item8(AP->w_out, 1024, (unsigned char*)Wo_t, 1024, 64 * kb, 64 * nb, 64 * nb, 64 * nb + 32, scr, lane, 32.0f, kb < 8 ? AP->onorm_a_g : AP->onorm_b_g - 512); continue; } r -= I_WO; \
            if (r < I_G) { const int e = r >> 6, r2 = r & 63, kb = r2 >> 2, nb = r2 & 3; const int n0 = 64 * nb; const int d0 = (n0 >> 7) * 256 + (n0 & 127); \
                transpose_item8(AP->w_gate + (size_t)e * 1024 * 256, 256, (unsigned char*)Wgu_t + (size_t)e * 512 * 1024, 1024, 64 * kb, n0, d0, d0 + 32, scr, lane, 32.0f); continue; } r -= I_G; \
            if (r < I_U) { const int e = r >> 6, r2 = r & 63, kb = r2 >> 2, nb = r2 & 3; const int n0 = 64 * nb; const int d0 = (n0 >> 7) * 256 + 128 + (n0 & 127); \
                transpose_item8(AP->w_up + (size_t)e * 1024 * 256, 256, (unsigned char*)Wgu_t + (size_t)e * 512 * 1024, 1024, 64 * kb, n0, d0, d0 + 32, scr, lane, 32.0f); continue; } r -= I_U; \
            { const int e = r >> 6, r2 = r & 63, kb = r2 >> 4, nb = r2 & 15; \
                transpose_item8(AP->w_down + (size_t)e * 256 * 1024, 1024, (unsigned char*)Wd_t + (size_t)e * 1024 * 256, 256, 64 * kb, 64 * nb, 64 * nb, 64 * nb + 32, scr, lane, 16.0f); } \
          } \
          __syncthreads(); }
    if (IN(PH_PRO)) { PH_BEGIN
        LAS float* scr = (LAS float*)(lds + wave * 16640);
        constexpr int I_IN = 16 * 31, I_QU = 4 * 12, I_KV = 2 * 16, I_WO = 16 * 16, I_G = 32 * 64, I_U = 32 * 64, I_D = 32 * 64;
        constexpr int NITEMS = I_IN + I_QU + I_KV;
        for (int it = gw; it < NITEMS; it += NGW) {
            int r = it;
            if (r < I_IN) { const int kb = r / 31, nb = r % 31; int dr[2];
#pragma unroll
                for (int h2 = 0; h2 < 2; ++h2) { const int gi = 2 * nb + h2;
                    if (gi < 13) dr[h2] = 32 * gi; else if (gi < 45) { const int q = (gi - 13) & 15, hh = q >> 1, bj = q & 1; dr[h2] = (gi < 29 ? 512 : 1024) + (hh >> 2) * 256 + bj * 128 + (hh & 3) * 32; } else if (gi < 61) dr[h2] = 1536 + (gi - 45) * 32; else dr[h2] = -1; }
                transpose_item(AP->w_in, NPROJ_REAL, Win_t, 1024, 64 * kb, 64 * nb, dr[0], dr[1], scr, lane, AP->attn_g); continue; } r -= I_IN;
            if (r < I_QU) { const int kb = r / 12, nb = r % 12; transpose_item(AP->w_qup, 768, Wq_t, 256, 64 * kb, 64 * nb, 64 * nb, 64 * nb + 32, scr, lane, AP->qlat_g); continue; } r -= I_QU;
            if (r < I_KV) { const int kb = r / 16, nb = r % 16; const int n0 = 64 * nb, hh = n0 >> 7, j0 = n0 & 127;
                const int d0 = (j0 < 64) ? ((hh >> 2) * 256 + (hh & 3) * 32) : (512 + hh * 64), d1 = (j0 < 64) ? (d0 + 128) : (d0 + 32);
                transpose_item(AP->w_kvup, 1024, Wkv_t, 128, 64 * kb, n0, d0, d1, scr, lane, AP->kvlat_g); continue; } r -= I_KV;
        }
        const int gt = bx * 512 + tid, NGT = G * 512;
        for (int i = gt; i < 96 * 128; i += NGT) *(GAS v4u*)(Win_t + (size_t)416 * 1024 + (size_t)i * 8) = (v4u){0u, 0u, 0u, 0u};
        for (int i = gt; i < SEQ * 48; i += NGT) {
            const int pos = i / 48, f = i % 48; const bool isF = f < 32; const int ff = isF ? f : f - 32;
            const double e = isF ? (double)ff / 32.0 : (double)ff / 16.0;
            const float invf = (float)exp2(-e * 13.287712379549449);
            const float ang = (float)pos * invf;
            const double a = (double)ang; const double kk = rint(a * 0.15915494309189535); const double rr = a - kk * 6.283185307179586;
            const float c = (float)cos(rr), s = (float)sin(rr);
            GAS float* rF = (GAS float*)ropeF; GAS float* rR = (GAS float*)ropeR;
            if (isF) { rF[pos * 32 + ff] = c; rF[SEQ * 32 + pos * 32 + ff] = s; } else { rR[pos * 16 + ff] = c; rR[SEQ * 16 + pos * 16 + ff] = s; }
        }
        for (int i = gt; i < 1024 * 8; i += NGT) { const float gk = AP->ffn_g[i >> 3]; *((GAS f32x4*)WREF + i) = *((const GAS f32x4*)AP->w_re + i) * gk; }
        for (int i = gt; i < 1024 * 32; i += NGT) { const int k = i >> 5, e = i & 31; const float w = AP->w_re[i] * AP->ffn_g[k];
            const unsigned hb = __builtin_bit_cast(unsigned, w) & 0xffff0000u; const float r1 = w - __builtin_bit_cast(float, hb);
            const unsigned lb = __builtin_bit_cast(unsigned, r1) & 0xffff0000u; const float r2 = r1 - __builtin_bit_cast(float, lb);
            GAS bf16* dst = (GAS bf16*)(ws + WS_WRE + 262144) + (size_t)(k >> 6) * (3 * 32 * 64) + e * 64 + (k & 63);
            dst[0] = (bf16)(hb >> 16); dst[32 * 64] = (bf16)(lb >> 16); dst[2 * 32 * 64] = (bf16)(pk2(r2, 0.f) & 0xffffu); }
        for (int i = gt; i < 1024; i += NGT) { const float gk = AP->ffn_g[i]; *((GAS f32x4*)WRGF + i) = *((const GAS f32x4*)AP->w_rg + i) * gk; }
        for (int t = gw; t < T; t += 2 * NGW) {
            const int t2 = (t + NGW < T) ? t + NGW : t;
            const GAS f32x4* xr = (const GAS f32x4*)(AP->x + (size_t)t * D) + lane; const GAS f32x4* xr2 = (const GAS f32x4*)(AP->x + (size_t)t2 * D) + lane; f32x4 v[4], w[4]; float s = 0.f, s2 = 0.f;
#pragma unroll
            for (int j = 0; j < 4; ++j) { v[j] = __builtin_nontemporal_load(xr + 64 * j); w[j] = __builtin_nontemporal_load(xr2 + 64 * j); }
#pragma unroll
            for (int j = 0; j < 4; ++j) { s += (v[j].x * v[j].x + v[j].y * v[j].y) + (v[j].z * v[j].z + v[j].w * v[j].w); s2 += (w[j].x * w[j].x + w[j].y * w[j].y) + (w[j].z * w[j].z + w[j].w * w[j].w); }
            const float nr = sqrtf(wave_sum(s) * (1.f / D) + EPS), nr2 = sqrtf(wave_sum(s2) * (1.f / D) + EPS); const float rstd = 1.0f / nr, rstd2 = 1.0f / nr2;
            if (lane == 0) { ((GAS float*)XRS)[t] = nr; ((GAS float*)XRS)[t2] = nr2; }
            GAS unsigned long long* o8 = (GAS unsigned long long*)(XN + (size_t)t * D) + lane; GAS unsigned long long* o82 = (GAS unsigned long long*)(XN + (size_t)t2 * D) + lane;
#pragma unroll
            for (int j = 0; j < 4; ++j) {
                o8[64 * j] = (unsigned long long)pk2(v[j].x * rstd, v[j].y * rstd) | ((unsigned long long)pk2(v[j].z * rstd, v[j].w * rstd) << 32);
                o82[64 * j] = (unsigned long long)pk2(w[j].x * rstd2, w[j].y * rstd2) | ((unsigned long long)pk2(w[j].z * rstd2, w[j].w * rstd2) << 32); }
        }
    }
    SEAM(PH_PRO);

    if (IN(PH_PROJ)) { PH_BEGIN
        pg8::Gemm g{XN, Win_t, T, NPROJ, D}; pg8::StaticOrder S; S.init(T, NPROJ, G, bx);
        pg8::EpiProj E{ws, WS_QLN, WS_KVLN, WS_QB, WS_KB, WS_VB, WS_SSQ, WS_KMEAN, WS_ROPE, AP->mqhead_g, AP->mkhead_g, C2B, EPS, SEQ};
        if (bx & 1) { LATE_ITEMS }
        pg8::gemm_phase<pg8::EpiProj, pg8::StaticOrder, true, true, false, false, false, 0x7a7a7a7a, 0x7f7f7f7f, false, true>(lds, g, S, E);
        if (!(bx & 1)) { LATE_ITEMS }
    }
    SEAM(PH_PROJ);

    if (IN(PH_UP)) { PH_BEGIN
        { int K256 = 256; asm volatile("" : "+s"(K256)); pg8::Gemm g{QLN, Wq_t, T, 768, K256}; pg8::StaticOrder S; S.init(T, 768, G, bx); pg8::EpiBf16Rs E{QA, 768, SSQ, 0, 1.0f / 256.0f, EPS};
          pg8::gemm_phase<pg8::EpiBf16Rs, pg8::StaticOrder, true, true, false, false, false, 0x7a7a7a7a, 0x7f7f7f7f, false, true>(lds, g, S, E); }
        { int K128 = 128; asm volatile("" : "+s"(K128)); pg8::Gemm g{KVLN, Wkv_t, T, 1024, K128, 256}; pg8::StaticOrder S; S.init(T, 1024, G, bx); pg8::EpiKv E{KA, VA, KVLN, SSQ, ropeR, AP->khead_g, EPS, SEQ};
          pg8::gemm_phase<pg8::EpiKv, pg8::StaticOrder, true, true, false, false, false, 0x7a7a7a7a, 0x7f7f7f7f, false, true>(lds, g, S, E); }
    }
    SEAM(PH_UP);

    if (IN(PH_ATTN)) { PH_BEGIN
        bf16* O = O8;
        float brefA, brefB;
        { const GAS float* gq = (const GAS float*)AP->qhead_g; const GAS float* gk = (const GAS float*)AP->khead_g; const GAS float* mq = (const GAS float*)AP->mqhead_g; const GAS float* mk = (const GAS float*)AP->mkhead_g;
          float a = fabsf(gq[lane]), c = fabsf(gk[lane]); if (lane < 32) { a = fmaxf(a, fabsf(gq[64 + lane])); c = fmaxf(c, fabsf(gk[64 + lane])); }
          float e = fabsf(mq[lane]), f = fabsf(mk[lane]);
#pragma unroll
          for (int o = 1; o < 64; o <<= 1) { a = fmaxf(a, __shfl_xor(a, o)); c = fmaxf(c, __shfl_xor(c, o)); e = fmaxf(e, __shfl_xor(e, o)); f = fmaxf(f, __shfl_xor(f, o)); }
          brefA = 96.0f * C2A * a * c * 1.03f; brefB = 64.0f * C2B * e * f * 1.03f; }
        const bool fixA = __builtin_amdgcn_readfirstlane(brefA < 50.0f ? 1 : 0) != 0, fixB = __builtin_amdgcn_readfirstlane(brefB < 50.0f ? 1 : 0) != 0;
        for (int u = bx; u < 512; u += G) {
            const int bh = u & 255, b = bh >> 3, h = bh & 7; const size_t r0 = (size_t)b * SEQ;
            if (u < 256) {
                for (int qb = 7; qb >= 0; --qb) {
                    if (fixA) attn_unit<96, false, true, true>(lds, AP->qhead_g, ropeR, QA + r0 * 768 + h * 96, 768, KA + r0 * 768 + h * 96, 768, VA + r0 * 512 + h * 64, 512, (bf16*)((unsigned char*)O + r0 * 1024 + h * 64), 1024, OSSQ + r0 * 16 + h, qb, nullptr, 0, brefA);
                    else      attn_unit<96, false, true, false>(lds, AP->qhead_g, ropeR, QA + r0 * 768 + h * 96, 768, KA + r0 * 768 + h * 96, 768, VA + r0 * 512 + h * 64, 512, (bf16*)((unsigned char*)O + r0 * 1024 + h * 64), 1024, OSSQ + r0 * 16 + h, qb, nullptr, 0, 0.f); }
            } else {
                for (int qb = 7; qb >= 0; --qb) {
                    if (fixB) attn_unit<64, true, false, true>(lds, nullptr, nullptr, QB + r0 * 512 + h * 64, 512, KB + r0 * 512 + h * 64, 512, VB + r0 * 512 + h * 64, 512, (bf16*)((unsigned char*)O + r0 * 1024 + 512 + h * 64), 1024, OSSQ + r0 * 16 + 8 + h, qb, kmean + ((size_t)b * 8 * NH + h) * 64, NH * 64, brefB);
                    else      attn_unit<64, true, false, false>(lds, nullptr, nullptr, QB + r0 * 512 + h * 64, 512, KB + r0 * 512 + h * 64, 512, VB + r0 * 512 + h * 64, 512, (bf16*)((unsigned char*)O + r0 * 1024 + 512 + h * 64), 1024, OSSQ + r0 * 16 + 8 + h, qb, kmean + ((size_t)b * 8 * NH + h) * 64, NH * 64, 0.f); }
            }
        }
    }
    SEAM(PH_ATTN);

    if (IN(PH_OUT)) { PH_BEGIN
        pg8::Gemm g{O8, Wo_t, T, D, D / 2};        pg8::RowOrder S{G, bx, T / 256};
        LAS float* rsl = (LAS float*)(lds + RING_BYTES);
        { pg8::Unit uu;
          for (int i = 0; i < 12 && S.next(i, uu); i += 4) if (tid < 256) {     const GAS f32x4* pq = (const GAS f32x4*)((const GAS float*)OSSQ + (size_t)(uu.pm * 256 + tid) * 16); const f32x4 a0 = pq[0], a1 = pq[1], b0 = pq[2], b1 = pq[3];
              const float sa = ((a0[0] + a0[1]) + (a0[2] + a0[3])) + ((a1[0] + a1[1]) + (a1[2] + a1[3])), sb = ((b0[0] + b0[1]) + (b0[2] + b0[3])) + ((b1[0] + b1[1]) + (b1[2] + b1[3]));
              const float ra = 1.0f / sqrtf(sa * (1.0f / 512.0f) + EPS), rb = 1.0f / sqrtf(sb * (1.0f / 512.0f) + EPS);
              const f32x2 rv_ = (f32x2){ra / rb, rb};
#pragma unroll
              for (int j = 0; j < 4; ++j) *(LAS f32x2*)(rsl + ((i + j) * 256 + tid) * 2) = rv_; }
          __syncthreads(); }
        pg8::EpiOut E{XN, XRS, X1B, rsl};
        pg8::gemm_phase<pg8::EpiOut, pg8::RowOrder, true, true, false, false, true, 0x7a7a7a7a, 0x7b7b7b7b, true, true>(lds, g, S, E);
    }
    if (IN(PH_OUT) && IN(PH_OUT + 1)) { asm volatile("s_waitcnt vmcnt(0)" ::: "memory"); __syncthreads(); }

    if (IN(PH_ROUTE)) { PH_BEGIN
        LAS float* Wrg = (LAS float*)(lds + P8_WRG); LAS float* xt = (LAS float*)(lds + P8_XT + wave * P8_XT_WAVE); LAS float* wc = (LAS float*)(lds + P8_WC);
        LAS int* rt_g = (LAS int*)(lds + P8_RT); LAS float* rt_w = (LAS float*)(lds + P8_RT + 1024); LAS int* rt_rank = (LAS int*)(lds + P8_RT + 3072);
        LAS int* lcnt = (LAS int*)(lds + P8_RT + 4096); LAS int* lbase = (LAS int*)(lds + P8_RT + 4608); LAS float* rt_rs = (LAS float*)(lds + P8_RT + 5120);
        for (int k = tid; k < 1024; k += 512) *(LAS f32x4*)(Wrg + 4 * k) = *((const GAS f32x4*)WRGF + k);
        __syncthreads();
        const int r32 = lane & 31, kh = lane >> 5;
        for (int chunk = bx; chunk < T / 256; chunk += G) {
            if (tid < NCLS) lcnt[tid] = 0;
            const int rowc = wave * 32 + r32; const size_t row0w = (size_t)chunk * 256 + wave * 32;
            const GAS bf16* xsrc = (const GAS bf16*)X1B + (row0w + (lane >> 4)) * D + 4 * (lane & 15);
            f32x16 accE = {}; f32x4 aGv = {0.f, 0.f, 0.f, 0.f}; float ssq = 0.f;
            const GAS v4u* wrep = (const GAS v4u*)(ws + WS_WRE + 262144);
            const unsigned wl0 = (unsigned)((tid >> 8) * 4608 + ((tid & 255) >> 3) * 144 + (tid & 7) * 16), wl1 = wl0 + 2u * 4608u;
            { *(LAS v4u*)((LAS unsigned char*)wc + wl0) = wrep[tid]; if (tid < 256) *(LAS v4u*)((LAS unsigned char*)wc + wl1) = wrep[512 + tid]; }
            v2u xn[8]; f32x4 gvn;
#pragma unroll
            for (int j = 0; j < 8; ++j) xn[j] = *(const GAS v2u*)(xsrc + (size_t)(4 * j) * D);
            gvn = *(const GAS f32x4*)((const GAS float*)AP->ffn_g + 4 * (lane & 15));
#pragma unroll 1
            for (int kc = 0; kc < 16; ++kc) {
                f32x4 st[8];
#pragma unroll
                for (int j = 0; j < 8; ++j) st[j] = (f32x4){bflo(xn[j].x), bfhi(xn[j].x), bflo(xn[j].y), bfhi(xn[j].y)};
                const f32x4 gv = gvn;
                if (kc + 1 < 16) {
#pragma unroll
                    for (int j = 0; j < 8; ++j) xn[j] = *(const GAS v2u*)(xsrc + (size_t)(4 * j) * D + (kc + 1) * 64);
                    gvn = *(const GAS f32x4*)((const GAS float*)AP->ffn_g + (kc + 1) * 64 + 4 * (lane & 15)); }
                v4u wnext = {0u, 0u, 0u, 0u}, wnext2 = {0u, 0u, 0u, 0u}; if (kc + 1 < 16) { wnext = wrep[(kc + 1) * 768 + tid]; if (tid < 256) wnext2 = wrep[(kc + 1) * 768 + 512 + tid]; }
#pragma unroll
                for (int j = 0; j < 8; ++j) *(LAS f32x4*)(xt + ((lane >> 4) + 4 * j) * 68 + 4 * (lane & 15)) = st[j];
                if (kc + 1 < 16) { LAS unsigned char* wb = (LAS unsigned char*)wc + ((kc + 1) & 1) * P8_WCB; *(LAS v4u*)(wb + wl0) = wnext; if (tid < 256) *(LAS v4u*)(wb + wl1) = wnext2; }
                {
#pragma unroll
                  for (int j = 0; j < 8; ++j) { const f32x4 hv = st[j] * gv;
                      *(GAS unsigned*)((GAS unsigned char*)YH + (size_t)(row0w + (lane >> 4) + 4 * j) * D + kc * 64 + 4 * (lane & 15)) = pk4_fp8(hv[0], hv[1], hv[2], hv[3]); } }
                __syncthreads();
                const LAS unsigned char* wcc = (const LAS unsigned char*)wc + (kc & 1) * P8_WCB + r32 * 144 + kh * 16;
#pragma unroll
                for (int ks = 0; ks < 4; ++ks) {
                    const f32x4 xa = *(const LAS f32x4*)(xt + r32 * 68 + 16 * ks + 8 * kh), xb = *(const LAS f32x4*)(xt + r32 * 68 + 16 * ks + 8 * kh + 4);
                    ssq += ((xa.x * xa.x + xa.y * xa.y) + (xa.z * xa.z + xa.w * xa.w)) + ((xb.x * xb.x + xb.y * xb.y) + (xb.z * xb.z + xb.w * xb.w));
                    v4u xq; xq.x = __builtin_amdgcn_perm(__float_as_uint(xa.y), __float_as_uint(xa.x), 0x07060302u); xq.y = __builtin_amdgcn_perm(__float_as_uint(xa.w), __float_as_uint(xa.z), 0x07060302u);
                    xq.z = __builtin_amdgcn_perm(__float_as_uint(xb.y), __float_as_uint(xb.x), 0x07060302u); xq.w = __builtin_amdgcn_perm(__float_as_uint(xb.w), __float_as_uint(xb.z), 0x07060302u);
                    const bf16x8 xf = __builtin_bit_cast(bf16x8, xq);
#pragma unroll
                    for (int pl = 0; pl < 3; ++pl) { const bf16x8 wf = *(const LAS bf16x8*)(wcc + pl * 4608 + ks * 32); accE = __builtin_amdgcn_mfma_f32_32x32x16_bf16(wf, xf, accE, 0, 0, 0); }
#pragma unroll
                    for (int e = 0; e < 4; ++e) { const int kl = 16 * ks + 8 * kh + e;
                        const f32x4 wg = *(const LAS f32x4*)(Wrg + 4 * (kc * 64 + kl)); const float xe = xa[e]; aGv += wg * xe;
                        const f32x4 wh = *(const LAS f32x4*)(Wrg + 4 * (kc * 64 + kl + 4)); const float xf_ = xb[e]; aGv += wh * xf_; }
                }
                __syncthreads();
            }
            float aG0 = aGv[0], aG1 = aGv[1], aG2 = aGv[2], aG3 = aGv[3];
            ssq += __shfl_xor(ssq, 32); aG0 += __shfl_xor(aG0, 32); aG1 += __shfl_xor(aG1, 32); aG2 += __shfl_xor(aG2, 32); aG3 += __shfl_xor(aG3, 32);
            const float rstd = 1.0f / sqrtf(ssq * (1.f / D) + EPS);
            float lg[4] = {aG0 * rstd + AP->b_rg[0], aG1 * rstd + AP->b_rg[1], aG2 * rstd + AP->b_rg[2], aG3 * rstd + AP->b_rg[3]};
            int gs = 0; float gm = lg[0];
#pragma unroll
            for (int i = 1; i < 4; ++i) if (lg[i] > gm) { gm = lg[i]; gs = i; }
            float den = 0.f;
#pragma unroll
            for (int i = 0; i < 4; ++i) den += __expf(lg[i] - gm);
            const float gwt = 1.0f / den;
            float mine[4];
#pragma unroll
            for (int i = 0; i < 4; ++i) { const float v = (gs == 0) ? accE[i] : (gs == 1) ? accE[4 + i] : (gs == 2) ? accE[8 + i] : accE[12 + i]; mine[i] = v * rstd + AP->b_re[gs * 8 + 4 * kh + i]; }
            float ev[8];
#pragma unroll
            for (int i = 0; i < 4; ++i) { const float oth = __shfl_xor(mine[i], 32); ev[i] = kh ? oth : mine[i]; ev[4 + i] = kh ? mine[i] : oth; }
            int e1 = 0; float v1 = ev[0];
#pragma unroll
            for (int i = 1; i < 8; ++i) if (ev[i] > v1) { v1 = ev[i]; e1 = i; }
            int e2 = -1; float v2 = -INFINITY;
#pragma unroll
            for (int i = 0; i < 8; ++i) if (i != e1 && (e2 < 0 || ev[i] > v2)) { v2 = ev[i]; e2 = i; }
            const float ex = __expf(v2 - v1); const float w1 = gwt / (1.0f + ex), w2 = gwt * ex / (1.0f + ex);
            if (kh == 0) { const int elo = e1 < e2 ? e1 : e2, ehi = e1 < e2 ? e2 : e1;
                rt_g[rowc] = gs * 28 + ((elo * (15 - elo)) >> 1) + (ehi - elo - 1); rt_w[rowc * 2] = e1 < e2 ? w1 : w2; rt_w[rowc * 2 + 1] = e1 < e2 ? w2 : w1; rt_rs[rowc] = rstd; }
            __syncthreads();
            if (tid < 256) rt_rank[tid] = __hip_atomic_fetch_add(&lcnt[rt_g[tid]], 1, __ATOMIC_RELAXED, __HIP_MEMORY_SCOPE_WORKGROUP);
            __syncthreads();
            if (tid < NCLS) { const int n = lcnt[tid]; lbase[tid] = n ? (int)__hip_atomic_fetch_add((gu32*)(ws + WS_CTL) + CW_GCNT + 64 * tid, (unsigned)n, RLX_AGENT) : 0; }
            __syncthreads();
            if (tid < 256) { const int g = rt_g[tid]; v4u ev; ev.x = (unsigned)(chunk * 256 + tid); ev.y = __builtin_bit_cast(unsigned, rt_w[tid * 2]); ev.z = __builtin_bit_cast(unsigned, rt_w[tid * 2 + 1]); ev.w = __builtin_bit_cast(unsigned, rt_rs[tid]);
                ((GAS v4u*)lists)[(size_t)g * LIST_CAP + lbase[g] + rt_rank[tid]] = ev; }
            __syncthreads();
        }
    }
    SEAM(PH_ROUTE);

    LAS int* tp = (LAS int*)(lds + TP_OFF); LAS int* cntl = (LAS int*)(lds + CNT_OFF); LAS int* ptab = (LAS int*)(lds + PT_OFF); LAS int* tpf = (LAS int*)(lds + TPF_OFF); LAS int* tph = (LAS int*)(lds + TPH_OFF);
    if (hi > PH_ROUTE) {
        if (tid0 < NCLS) { gu32* ctl = (gu32*)(A.ws + WS_CTL); cntl[tid0] = (int)__hip_atomic_load(ctl + CW_GCNT + 64 * tid0, RLX_AGENT); }
        if (tid0 == 0) { int p = 0; for (int lo_ = 0; lo_ < 8; ++lo_) for (int hi_ = lo_ + 1; hi_ < 8; ++hi_) ptab[p++] = lo_ | (hi_ << 4); }
        __syncthreads();
        if (tid0 <= NCLS) { int acc = 0, accf = 0, acch = 0;
            for (int g = 0; g < tid0; ++g) { const int n = cntl[g]; const int nb_ = (n + 255) >> 8; const int r_ = n & 255; const int nh_ = (r_ != 0 && r_ <= 128) ? 1 : 0; acc += nb_; accf += nb_ - nh_; acch += nh_; }
            tp[tid0] = acc; tpf[tid0] = accf; tph[tid0] = acch; }
        __syncthreads();
    }

    if (IN(PH_GU)) { PH_BEGIN
        pg8::Gemm g{YH, Wgu_t, 0, 0, D / 2}; pg8::ClsOrder S{tp, 0, G, MOE_SLOT(4), lists};
        pg8::EpiGateUp2 E{HB, lists, cntl};
        pg8::gemm_phase<pg8::EpiGateUp2, pg8::ClsOrder, true, true, true, false, true, 0x7a7a7a7a, 0x7f7f7f7f, true, true>(lds, g, S, E);
    }
    SEAM(PH_GU);

    if (IN(PH_D0)) { PH_BEGIN
        int K512 = 256; asm volatile("" : "+s"(K512)); pg8::Gemm g{HB, Wd_t, 0, 0, K512};        pg8::ClsOrder S{tp, 1, G, MOE_SLOT(4), lists};
        pg8::EpiDown2 E{AP->out, X1B, lists, cntl};
        pg8::gemm_phase<pg8::EpiDown2, pg8::ClsOrder, true, true, false, true, true, 0x7b7b7b7b, 0x7c7c7c7c, true, true>(lds, g, S, E);
    }
#undef IN
#undef SEAM
}

extern "C" void kernel_launch(void* const* d_in, const int* in_sizes, int n_in, void* d_out, int out_size, void* d_ws, size_t ws_size, hipStream_t stream) {
    static int grid = 0;
    if (grid == 0) {
        if (n_in != 22 || in_sizes[0] != T * D || out_size != T * D || ws_size < WS_END) { fprintf(stderr, "kernel_launch: unexpected shapes (n_in %d, in0 %d, out %d, ws %zu); nothing launched\n", n_in, n_in > 0 ? in_sizes[0] : -1, out_size, ws_size); grid = -1; return; }
        int dev = 0, cus = 0, per_cu = 0;
        if (hipGetDevice(&dev) != hipSuccess || hipDeviceGetAttribute(&cus, hipDeviceAttributeMultiprocessorCount, dev) != hipSuccess) { grid = -1; return; }
        if (hipFuncSetAttribute((const void*)mk_fwd, hipFuncAttributeMaxDynamicSharedMemorySize, LDS_BYTES) != hipSuccess) { fprintf(stderr, "kernel_launch: hipFuncSetAttribute failed\n"); grid = -1; return; }
        if (hipOccupancyMaxActiveBlocksPerMultiprocessor(&per_cu, (const void*)mk_fwd, 512, LDS_BYTES) != hipSuccess || per_cu < 1) { fprintf(stderr, "kernel_launch: occupancy query says %d\n", per_cu); }
        (void)hipGetLastError();
        grid = cus;
    }
    if (grid < 0) return;
    if (hipMemsetAsync((char*)d_ws + WS_CTL, 0, CTL_ZERO_BYTES, stream) != hipSuccess) return;
    Args a{};
    a.x = (const float*)d_in[0]; a.attn_g = (const float*)d_in[1]; a.w_in = (const float*)d_in[2]; a.qlat_g = (const float*)d_in[3]; a.w_qup = (const float*)d_in[4];
    a.kvlat_g = (const float*)d_in[5]; a.w_kvup = (const float*)d_in[6]; a.qhead_g = (const float*)d_in[7]; a.khead_g = (const float*)d_in[8];
    a.mqhead_g = (const float*)d_in[9]; a.mkhead_g = (const float*)d_in[10]; a.onorm_a_g = (const float*)d_in[11]; a.onorm_b_g = (const float*)d_in[12];
    a.w_out = (const float*)d_in[13]; a.ffn_g = (const float*)d_in[14]; a.w_rg = (const float*)d_in[15]; a.b_rg = (const float*)d_in[16];
    a.w_re = (const float*)d_in[17]; a.b_re = (const float*)d_in[18]; a.w_gate = (const float*)d_in[19]; a.w_up = (const float*)d_in[20]; a.w_down = (const float*)d_in[21];
    a.out = (float*)d_out; a.ws = (unsigned char*)d_ws; a.ph_lo = 0; a.ph_hi = NPHASE;
    hipLaunchKernelGGL(mk_fwd, dim3(grid), dim3(512), LDS_BYTES, stream, a);
    (void)hipPeekAtLastError();
}
```
